# Optimizing an MI355X kernel written in HIP

```python
import jax, jax.numpy as jnp
from jax import lax
import numpy as np

D_MODEL = 1024
BATCH = 4
SEQ = 4096
DEPTH = 1

CHUNK = 64
POOL_WIDTH = 512
POOL_WINDOWS = (2, 4, 8, 16)
POOL_GROUPS = len(POOL_WINDOWS)
POOL_GROUP_DIM = POOL_WIDTH // POOL_GROUPS
MLSTM_WIDTH = 1024
MLSTM_HEADS = 4
MLSTM_HEAD_DIM = MLSTM_WIDTH // MLSTM_HEADS
CONV_WIDTH = 4
N_BRANCHES = 2
SPLITS = (POOL_WIDTH,
          POOL_WIDTH + MLSTM_WIDTH,
          POOL_WIDTH + 2 * MLSTM_WIDTH,
          POOL_WIDTH + 3 * MLSTM_WIDTH,
          POOL_WIDTH + 3 * MLSTM_WIDTH + 2 * MLSTM_HEADS)
IN_COLS = SPLITS[-1] + N_BRANCHES * D_MODEL
N_EXPERTS = 32
TOP_K = 4
D_FF = D_MODEL
SWIGLU_ALPHA = 1.702
SWIGLU_LIMIT = 7.0
EXPERT_BLOCK = 128
LN_EPS = 1e-5
DEEPNORM_ALPHA = (2.0 * DEPTH) ** 0.25
DEEPNORM_BETA = (8.0 * DEPTH) ** -0.25

kernel_name = 'hybrid_pool_mlstm_moe_encoder'


def layer_norm(x, g, b):
    xf = x.astype(jnp.float32)
    mu = xf.mean(-1, keepdims=True)
    var = jnp.square(xf - mu).mean(-1, keepdims=True)
    return ((xf - mu) * lax.rsqrt(var + LN_EPS) * g + b).astype(x.dtype)


def pool_mixer(p, w_pool, b_pool, ls_pool):
    B, S, _ = p.shape
    pf = p.astype(jnp.float32)
    cs = jnp.pad(jnp.cumsum(pf, axis=1), ((0, 0), (1, 0), (0, 0)))
    t = jnp.arange(S)
    outs = []
    for gi, w in enumerate(POOL_WINDOWS):
        sl = slice(gi * POOL_GROUP_DIM, (gi + 1) * POOL_GROUP_DIM)
        csg = cs[:, :, sl]
        start = jnp.maximum(t + 1 - w, 0)
        win_sum = csg[:, 1:] - csg[:, start]
        cnt = jnp.minimum(t + 1, w).astype(jnp.float32)[None, :, None]
        outs.append(win_sum / cnt - pf[:, :, sl])
    pooled = jnp.stack(outs, axis=2).astype(p.dtype)
    mixed = jnp.einsum('bsgc,gcd->bsgd', pooled, w_pool).reshape(B, S, POOL_WIDTH) + b_pool
    return mixed * ls_pool


def causal_depthwise_conv(u, w, b):
    C = u.shape[-1]
    y = lax.conv_general_dilated(u, w[:, None, :].astype(u.dtype), window_strides=(1,),
                                 padding=[(CONV_WIDTH - 1, 0)],
                                 dimension_numbers=('NWC', 'WIO', 'NWC'),
                                 feature_group_count=C)
    return y + b


def mlstm_chunkwise(q, k, v, i_pre, f_pre):
    B, H, S, Dh = q.shape
    nc = S // CHUNK

    def to_chunks(a):
        return jnp.moveaxis(a.reshape(B, H, nc, CHUNK, *a.shape[3:]), 2, 0)

    log_f = jax.nn.log_sigmoid(f_pre)
    xs = (to_chunks(q), to_chunks(k), to_chunks(v), to_chunks(i_pre), to_chunks(log_f))
    causal = jnp.tril(jnp.ones((CHUNK, CHUNK), dtype=bool))

    def step(carry, inp):
        C, n, m = carry
        qc, kc, vc, ic, lfc = inp
        b = jnp.cumsum(lfc, axis=-1)
        d_log = jnp.where(causal, b[..., :, None] - b[..., None, :] + ic[..., None, :], -jnp.inf)
        m_inter = b + m[..., None]
        m_t = jnp.maximum(m_inter, d_log.max(-1))
        w_intra = jnp.exp(d_log - m_t[..., None])
        s = jnp.einsum('bhtd,bhsd->bhts', qc, kc) * w_intra
        w_inter = jnp.exp(m_inter - m_t)
        num = (jnp.einsum('bhts,bhse->bhte', s, vc)
               + w_inter[..., None] * jnp.einsum('bhed,bhtd->bhte', C, qc))
        den = s.sum(-1) + w_inter * jnp.einsum('bhd,bhtd->bht', n, qc)
        h = num / jnp.maximum(jnp.abs(den), jnp.exp(-m_t))[..., None]
        g = b[..., -1]
        w_log = g[..., None] - b + ic
        m_new = jnp.maximum(g + m, w_log.max(-1))
        decay = jnp.exp(g + m - m_new)
        w_state = jnp.exp(w_log - m_new[..., None])
        C_new = decay[..., None, None] * C + jnp.einsum('bhse,bhsd->bhed', vc * w_state[..., None], kc)
        n_new = decay[..., None] * n + jnp.einsum('bhs,bhsd->bhd', w_state, kc)
        return (C_new, n_new, m_new), h

    init = (jnp.zeros((B, H, Dh, Dh), jnp.float32),
            jnp.zeros((B, H, Dh), jnp.float32),
            jnp.zeros((B, H), jnp.float32))
    _, h = lax.scan(step, init, xs)
    return jnp.moveaxis(h, 0, 2).reshape(B, H, S, Dh)


def hybrid_mixer(xn, w_in, conv_w, conv_b, w_q, w_k, b_if, mh_gain, w_pool, b_pool, ls_pool,
                 w_branch_pool, w_branch_mlstm, w_out):
    B, S, _ = xn.shape
    H, Dh = MLSTM_HEADS, MLSTM_HEAD_DIM
    proj = xn @ w_in
    p, u, v, o_pre, if_pre, gates = jnp.split(proj, list(SPLITS), axis=-1)
    y_pool = pool_mixer(p, w_pool, b_pool, ls_pool) @ w_branch_pool
    uc = jax.nn.silu(causal_depthwise_conv(u, conv_w, conv_b)).reshape(B, S, H, Dh)
    q = jnp.einsum('bshd,hde->bhse', uc, w_q) * (Dh ** -0.5)
    k = jnp.einsum('bshd,hde->bhse', uc, w_k)
    vh = v.reshape(B, S, H, Dh).transpose(0, 2, 1, 3)
    gif = (if_pre + b_if).astype(jnp.float32)
    i_pre = gif[..., :H].transpose(0, 2, 1)
    f_pre = gif[..., H:].transpose(0, 2, 1)
    h = mlstm_chunkwise(q.astype(jnp.float32), k.astype(jnp.float32), vh.astype(jnp.float32), i_pre, f_pre)
    h = h.transpose(0, 2, 1, 3)
    mu = h.mean(-1, keepdims=True)
    var = jnp.square(h - mu).mean(-1, keepdims=True)
    hn = ((h - mu) * lax.rsqrt(var + LN_EPS)).reshape(B, S, MLSTM_WIDTH) * mh_gain
    h_out = (jax.nn.sigmoid(o_pre.astype(jnp.float32)) * hn).astype(xn.dtype)
    y_mlstm = h_out @ w_branch_mlstm
    g = jax.nn.sigmoid(gates.astype(jnp.float32)).reshape(B, S, N_BRANCHES, D_MODEL).astype(xn.dtype)
    merged = g[:, :, 0] * y_pool + g[:, :, 1] * y_mlstm
    return merged @ w_out


def clamped_swiglu(h):
    x_glu, x_lin = h[..., ::2], h[..., 1::2]
    x_glu = jnp.minimum(x_glu, SWIGLU_LIMIT)
    x_lin = jnp.clip(x_lin, -SWIGLU_LIMIT, SWIGLU_LIMIT)
    return x_glu * jax.nn.sigmoid(SWIGLU_ALPHA * x_glu) * (x_lin + 1.0)


def moe_ffn(x, w_router, b_router, w_e1, b_e1, w_e2, b_e2):
    B, S, D = x.shape
    T = B * S
    xt = x.reshape(T, D)
    logits = (xt @ w_router + b_router).astype(jnp.float32)
    top_val, top_idx = lax.top_k(logits, TOP_K)
    gate = jax.nn.softmax(top_val, axis=-1).astype(x.dtype)
    A = T * TOP_K
    e_flat = top_idx.reshape(A).astype(jnp.int32)
    tok_flat = jnp.arange(A, dtype=jnp.int32) // TOP_K
    g_flat = gate.reshape(A)
    order = jnp.argsort(e_flat, stable=True)
    e_sorted = e_flat[order]
    counts = jnp.zeros((N_EXPERTS,), jnp.int32).at[e_flat].add(1)
    padded = (counts + EXPERT_BLOCK - 1) // EXPERT_BLOCK * EXPERT_BLOCK
    start = jnp.cumsum(counts) - counts
    padded_end = jnp.cumsum(padded)
    padded_start = padded_end - padded
    rank = jnp.arange(A, dtype=jnp.int32) - start[e_sorted]
    dest = padded_start[e_sorted] + rank
    n_rows = -(-(A + N_EXPERTS * (EXPERT_BLOCK - 1)) // EXPERT_BLOCK) * EXPERT_BLOCK
    n_blocks = n_rows // EXPERT_BLOCK
    row_tok = jnp.zeros((n_rows,), jnp.int32).at[dest].set(tok_flat[order])
    row_gate = jnp.zeros((n_rows,), x.dtype).at[dest].set(g_flat[order])
    block_e = jnp.minimum(
        jnp.searchsorted(padded_end, jnp.arange(n_blocks, dtype=jnp.int32) * EXPERT_BLOCK, side='right'),
        N_EXPERTS - 1).astype(jnp.int32)
    x_rows = xt[row_tok].reshape(n_blocks, EXPERT_BLOCK, D)

    def expert_block(args):
        xb, e = args
        hb = xb @ w_e1[e] + b_e1[e]
        return clamped_swiglu(hb) @ w_e2[e] + b_e2[e]

    y_rows = lax.map(expert_block, (x_rows, block_e)).reshape(n_rows, D)
    y = jnp.zeros((T, D), x.dtype).at[row_tok].add(y_rows * row_gate[:, None])
    return y.reshape(B, S, D)


def setup_inputs(seed: int = 0) -> dict:
    key = jax.random.key(seed)
    ks = jax.random.split(key, 32)
    f32 = jnp.float32
    L, D, H = DEPTH, D_MODEL, MLSTM_HEADS

    def nrm(k, shape, scale):
        return jax.random.normal(k, shape, f32) * scale

    b_if = jnp.concatenate([
        nrm(ks[8], (L, H), 0.1),
        jnp.broadcast_to(jnp.linspace(3.0, 6.0, H, dtype=f32), (L, H)) + nrm(ks[9], (L, H), 0.1)], axis=-1)
    return {
        'x': nrm(ks[0], (BATCH, SEQ, D), 1.0),
        'ln0_g': 1.0 + nrm(ks[1], (D,), 0.02),
        'ln0_b': nrm(ks[2], (D,), 0.02),
        'w_in': nrm(ks[3], (L, D, IN_COLS), D ** -0.5),
        'conv_w': nrm(ks[4], (L, CONV_WIDTH, MLSTM_WIDTH), CONV_WIDTH ** -0.5),
        'conv_b': nrm(ks[5], (L, MLSTM_WIDTH), 0.02),
        'w_q': nrm(ks[6], (L, H, MLSTM_HEAD_DIM, MLSTM_HEAD_DIM), MLSTM_HEAD_DIM ** -0.5),
        'w_k': nrm(ks[7], (L, H, MLSTM_HEAD_DIM, MLSTM_HEAD_DIM), MLSTM_HEAD_DIM ** -0.5),
        'b_if': b_if,
        'mh_gain': 1.0 + nrm(ks[10], (L, MLSTM_WIDTH), 0.02),
        'w_pool': nrm(ks[11], (L, POOL_GROUPS, POOL_GROUP_DIM, POOL_GROUP_DIM), POOL_GROUP_DIM ** -0.5),
        'b_pool': nrm(ks[12], (L, POOL_WIDTH), 0.02),
        'ls_pool': 1.0 + nrm(ks[13], (L, POOL_WIDTH), 0.02),
        'w_branch_pool': nrm(ks[14], (L, POOL_WIDTH, D), POOL_WIDTH ** -0.5),
        'w_branch_mlstm': nrm(ks[15], (L, MLSTM_WIDTH, D), MLSTM_WIDTH ** -0.5),
        'w_out': nrm(ks[16], (L, D, D), D ** -0.5 * DEEPNORM_BETA),
        'ln1_g': 1.0 + nrm(ks[17], (L, D), 0.02),
        'ln1_b': nrm(ks[18], (L, D), 0.02),
        'w_router': nrm(ks[19], (L, D, N_EXPERTS), D ** -0.5),
        'b_router': nrm(ks[20], (L, N_EXPERTS), 0.01),
        'w_e1': nrm(ks[21], (L, N_EXPERTS, D, 2 * D_FF), D ** -0.5),
        'b_e1': nrm(ks[22], (L, N_EXPERTS, 2 * D_FF), 0.02),
        'w_e2': nrm(ks[23], (L, N_EXPERTS, D_FF, D), D_FF ** -0.5 * DEEPNORM_BETA),
        'b_e2': nrm(ks[24], (L, N_EXPERTS, D), 0.02),
        'ln2_g': 1.0 + nrm(ks[25], (L, D), 0.02),
        'ln2_b': nrm(ks[26], (L, D), 0.02),
    }


def reference(x, ln0_g, ln0_b, w_in, conv_w, conv_b, w_q, w_k, b_if, mh_gain, w_pool, b_pool, ls_pool,
              w_branch_pool, w_branch_mlstm, w_out, ln1_g, ln1_b, w_router, b_router, w_e1, b_e1,
              w_e2, b_e2, ln2_g, ln2_b):
    h = layer_norm(x, ln0_g, ln0_b)
    for l in range(DEPTH):
        mix = hybrid_mixer(h, w_in[l], conv_w[l], conv_b[l], w_q[l], w_k[l], b_if[l], mh_gain[l],
                           w_pool[l], b_pool[l], ls_pool[l], w_branch_pool[l], w_branch_mlstm[l], w_out[l])
        h = layer_norm(DEEPNORM_ALPHA * h + mix, ln1_g[l], ln1_b[l])
        ffn = moe_ffn(h, w_router[l], b_router[l], w_e1[l], b_e1[l], w_e2[l], b_e2[l])
        h = layer_norm(DEEPNORM_ALPHA * h + ffn, ln2_g[l], ln2_b[l])
    return h
```

```cpp
#include <hip/hip_runtime.h>
#include <cstdio>
#include <cstdint>

namespace nv {
constexpr int D = 1024, BATCH = 4, SEQ = 4096, T = BATCH * SEQ;
constexpr int INC = 5640;
constexpr int C_P = 0, C_U = 512, C_V = 1536, C_O = 2560, C_IF = 3584, C_G = 3592;
constexpr int NE = 32, TOPK = 4, NA = T * TOPK;
constexpr float LN_EPS = 1e-5f;
constexpr float ALPHA = 1.189207115002721f;

__device__ __forceinline__ float wsum(float v) {
#pragma unroll
    for (int o = 1; o < 64; o <<= 1) v += __shfl_xor(v, o);
    return v;
}
__device__ __forceinline__ float sigmoidf_(float x) { return 1.f / (1.f + expf(-x)); }

__global__ void k_ln(const float* a, const float* b, const float* g, const float* beta, float* y, float scale, int rows) {
    const int row = blockIdx.x * (blockDim.x >> 6) + (threadIdx.x >> 6), lane = threadIdx.x & 63;
    if (row >= rows) return;
    float v[16]; float s = 0.f;
#pragma unroll
    for (int j = 0; j < 16; ++j) { const int c = lane + 64 * j; float x = a[(size_t)row * D + c] * scale; if (b) x += b[(size_t)row * D + c]; v[j] = x; s += x; }
    const float mu = wsum(s) * (1.f / D); float q = 0.f;
#pragma unroll
    for (int j = 0; j < 16; ++j) { const float d = v[j] - mu; q += d * d; }
    const float rstd = rsqrtf(wsum(q) * (1.f / D) + LN_EPS);
#pragma unroll
    for (int j = 0; j < 16; ++j) { const int c = lane + 64 * j; y[(size_t)row * D + c] = (v[j] - mu) * rstd * g[c] + beta[c]; }
}

struct EpiPlain { static constexpr bool PAIR = false; float* C; const float* bias; int ldc; float scale;
    __device__ void operator()(int m, int n, float v, int z) const { C[(size_t)m * ldc + n] = (v + (bias ? bias[n] : 0.f)) * scale; } };
template <class Epi>
__global__ __launch_bounds__(256) void k_gemm(const float* A, const int* rowidx, const float* B, const int* mcount, const int* mstart,
                                              size_t strideA, size_t strideB, Epi epi, int lda, int ldb, int M, int N, int K, int pad_) {
    const int z = blockIdx.z;
    int Mz = M, m0g = 0;
    if (mcount) { Mz = mcount[z]; m0g = mstart[z]; }
    const int bm = blockIdx.y * 64, bn = blockIdx.x * 64;
    if (bm >= Mz) return;
    A += z * strideA; B += z * strideB;
    __shared__ float As[16][65], Bs[16][65];
    const int tid = threadIdx.x, tx = tid & 15, ty = tid >> 4;
    float acc[4][4] = {};
    const int ar = tid >> 2, ak = (tid & 3) * 4;
    int arow = bm + ar; bool aval = arow < Mz; int asrc = 0;
    if (aval) { const int gr = m0g + arow; asrc = rowidx ? rowidx[gr] : gr; }
    const int bk = tid >> 4, bn4 = (tid & 15) * 4;
    for (int k0 = 0; k0 < K; k0 += 16) {
        float4 av = make_float4(0.f, 0.f, 0.f, 0.f);
        if (aval) av = *(const float4*)(A + (size_t)asrc * lda + k0 + ak);
        As[ak + 0][ar] = av.x; As[ak + 1][ar] = av.y; As[ak + 2][ar] = av.z; As[ak + 3][ar] = av.w;
#pragma unroll
        for (int j = 0; j < 4; ++j) { const int n = bn + bn4 + j; Bs[bk][bn4 + j] = (n < N) ? B[(size_t)(k0 + bk) * ldb + n] : 0.f; }
        __syncthreads();
#pragma unroll
        for (int kk = 0; kk < 16; ++kk) {
            float a[4], b[4];
#pragma unroll
            for (int i = 0; i < 4; ++i) { a[i] = As[kk][ty * 4 + i]; b[i] = Bs[kk][tx * 4 + i]; }
#pragma unroll
            for (int i = 0; i < 4; ++i)
#pragma unroll
                for (int j = 0; j < 4; ++j) acc[i][j] += a[i] * b[j];
        }
        __syncthreads();
    }
#pragma unroll
    for (int i = 0; i < 4; ++i) { const int m = bm + ty * 4 + i; if (m >= Mz) continue;
        if constexpr (Epi::PAIR) {
#pragma unroll
            for (int j = 0; j < 4; j += 2) { const int n = bn + tx * 4 + j; if (n < N) epi.pair(m0g + m, n, acc[i][j], acc[i][j + 1], z); }
        } else {
#pragma unroll
            for (int j = 0; j < 4; ++j) { const int n = bn + tx * 4 + j; if (n < N) epi(m0g + m, n, acc[i][j], z); }
        } }
}

__global__ void k_pool(const float* proj, float* pooled) {
    const size_t i = (size_t)blockIdx.x * blockDim.x + threadIdx.x; if (i >= (size_t)T * 512) return;
    const int c = (int)(i % 512); const int tg = (int)(i / 512); const int t = tg % SEQ;
    const int w = 2 << (c >> 7);
    const int cnt = (t + 1 < w) ? t + 1 : w; float s = 0.f;
    for (int j = 0; j < cnt; ++j) s += proj[(size_t)(tg - j) * INC + C_P + c];
    pooled[i] = s / (float)cnt - proj[(size_t)tg * INC + C_P + c];
}
struct EpiPoolMix { static constexpr bool PAIR = false; float* C; const float* b; const float* ls;
    __device__ void operator()(int m, int n, float v, int z) const { const int c = z * 128 + n; C[(size_t)m * 512 + c] = (v + b[c]) * ls[c]; } };
__global__ void k_conv(const float* proj, const float* cw, const float* cb, float* uc) {
    const size_t i = (size_t)blockIdx.x * blockDim.x + threadIdx.x; if (i >= (size_t)T * 1024) return;
    const int c = (int)(i % 1024); const int tg = (int)(i / 1024); const int t = tg % SEQ;
    float y = cb[c];
#pragma unroll
    for (int j = 0; j < 4; ++j) { const int tt = t - 3 + j; if (tt >= 0) y += proj[(size_t)(tg - 3 + j) * INC + C_U + c] * cw[j * 1024 + c]; }
    uc[i] = y * sigmoidf_(y);
}
struct EpiHead { static constexpr bool PAIR = false; float* C; float scale; int pad;
    __device__ void operator()(int m, int n, float v, int z) const { C[(size_t)m * 1024 + z * 256 + n] = v * scale; } };

constexpr int MB = 16;
__global__ __launch_bounds__(512) void k_mlstm(const float* q, const float* k, const float* proj, const float* b_if, float* hm) {
    const int bh = blockIdx.x >> 1, b = bh >> 2, h = bh & 3;
    const int tid = threadIdx.x, e = (blockIdx.x & 1) * 128 + (tid >> 2), dq = tid & 3;
    __shared__ float sq[MB][256], sk[MB][256], sv[MB][256], si[MB], sf[MB];
    float C[64]; float n[16];
#pragma unroll
    for (int j = 0; j < 64; ++j) C[j] = 0.f;
#pragma unroll
    for (int j = 0; j < 16; ++j) n[j] = 0.f;
    float m = 0.f;
    const int nsub = (e & 3) * 16;
    for (int t0 = 0; t0 < SEQ; t0 += MB) {
        __syncthreads();
        for (int i = tid; i < MB * 256; i += 512) { const int tt = i >> 8, d = i & 255; const size_t tg = (size_t)b * SEQ + t0 + tt;
            sq[tt][d] = q[tg * 1024 + h * 256 + d]; sk[tt][d] = k[tg * 1024 + h * 256 + d]; sv[tt][d] = proj[tg * INC + C_V + h * 256 + d]; }
        if (tid < MB) { const size_t tg = (size_t)b * SEQ + t0 + tid; si[tid] = proj[tg * INC + C_IF + h] + b_if[h]; sf[tid] = proj[tg * INC + C_IF + 4 + h] + b_if[4 + h]; }
        __syncthreads();
        for (int tt = 0; tt < MB; ++tt) {
            const float ip = si[tt], fp = sf[tt];
            const float lf = fminf(fp, 0.f) - log1pf(expf(-fabsf(fp)));
            const float mn = fmaxf(lf + m, ip);
            const float fd = expf(lf + m - mn), iw = expf(ip - mn);
            m = mn;
            const float ve = sv[tt][e] * iw;
            float num = 0.f, den = 0.f;
#pragma unroll
            for (int j = 0; j < 64; ++j) { const float kk = sk[tt][dq * 64 + j]; C[j] = fd * C[j] + ve * kk; num += C[j] * sq[tt][dq * 64 + j]; }
#pragma unroll
            for (int j = 0; j < 16; ++j) { const int d = dq * 64 + nsub + j; n[j] = fd * n[j] + iw * sk[tt][d]; den += n[j] * sq[tt][d]; }
            num += __shfl_xor(num, 1); num += __shfl_xor(num, 2);
            den += __shfl_xor(den, 1); den += __shfl_xor(den, 2); den += __shfl_xor(den, 4); den += __shfl_xor(den, 8);
            if (dq == 0) { const float dn = fmaxf(fabsf(den), expf(-mn)); hm[((size_t)b * SEQ + t0 + tt) * 1024 + h * 256 + e] = num / dn; }
        }
    }
}
__global__ void k_hnorm(float* hm, const float* proj, const float* gain) {
    const int w = blockIdx.x * (blockDim.x >> 6) + (threadIdx.x >> 6), lane = threadIdx.x & 63;
    if (w >= T * 4) return; const int tg = w >> 2, h = w & 3;
    float v[4]; float s = 0.f;
#pragma unroll
    for (int j = 0; j < 4; ++j) { v[j] = hm[(size_t)tg * 1024 + h * 256 + lane + 64 * j]; s += v[j]; }
    const float mu = wsum(s) * (1.f / 256); float qq = 0.f;
#pragma unroll
    for (int j = 0; j < 4; ++j) { const float d = v[j] - mu; qq += d * d; }
    const float rstd = rsqrtf(wsum(qq) * (1.f / 256) + LN_EPS);
#pragma unroll
    for (int j = 0; j < 4; ++j) { const int c = h * 256 + lane + 64 * j; hm[(size_t)tg * 1024 + c] = (v[j] - mu) * rstd * gain[c] * sigmoidf_(proj[(size_t)tg * INC + C_O + c]); }
}
__global__ void k_merge(const float* proj, const float* ypool, float* ymlstm_inout) {
    const size_t i = (size_t)blockIdx.x * blockDim.x + threadIdx.x; if (i >= (size_t)T * 1024) return;
    const int c = (int)(i % 1024); const size_t tg = i / 1024;
    const float g0 = sigmoidf_(proj[tg * INC + C_G + c]), g1 = sigmoidf_(proj[tg * INC + C_G + 1024 + c]);
    ymlstm_inout[i] = g0 * ypool[i] + g1 * ymlstm_inout[i];
}
__global__ void k_router(const float* h1, const float* wr, const float* br, int* top_idx, float* top_gate) {
    const int tg = blockIdx.x * (blockDim.x >> 6) + (threadIdx.x >> 6), lane = threadIdx.x & 63;
    if (tg >= T) return; const int e = lane & 31, half = lane >> 5;
    float s = 0.f;
    for (int kk = 0; kk < 512; ++kk) { const int kx = half * 512 + kk; s += h1[(size_t)tg * D + kx] * wr[kx * NE + e]; }
    s += __shfl_xor(s, 32); s += br[e];
    float val = s; int idxs[4]; float vals[4];
#pragma unroll
    for (int r = 0; r < 4; ++r) {
        float bv = val; int bi = e;
#pragma unroll
        for (int o = 1; o < 32; o <<= 1) { const float ov = __shfl_xor(bv, o); const int oi = __shfl_xor(bi, o); if (ov > bv || (ov == bv && oi < bi)) { bv = ov; bi = oi; } }
        idxs[r] = bi; vals[r] = bv; if (e == bi) val = -INFINITY;
    }
    const float mx = vals[0]; float ex[4], se = 0.f;
#pragma unroll
    for (int r = 0; r < 4; ++r) { ex[r] = expf(vals[r] - mx); se += ex[r]; }
    if (lane < 4) { top_idx[tg * 4 + lane] = idxs[lane]; top_gate[tg * 4 + lane] = ex[lane] / se; }
}
__global__ void k_zero(int* p, int n, int pad_) { const int i = blockIdx.x * blockDim.x + threadIdx.x; if (i < n) p[i] = 0; }
__global__ void k_count(const int* top_idx, int* cnt) { const int i = blockIdx.x * blockDim.x + threadIdx.x; if (i < NA) atomicAdd(&cnt[top_idx[i]], 1); }
__global__ void k_prefix(const int* cnt, int* start, int* fill) { if (threadIdx.x == 0) { int s = 0; for (int e = 0; e < NE; ++e) { start[e] = s; fill[e] = 0; s += cnt[e]; } } }
__global__ void k_place(const int* top_idx, const int* start, int* fill, int* row_tok, int* row_of) {
    const int i = blockIdx.x * blockDim.x + threadIdx.x; if (i >= NA) return;
    const int e = top_idx[i]; const int r = atomicAdd(&fill[e], 1); const int dest = start[e] + r; row_tok[dest] = i >> 2; row_of[i] = dest;
}
struct EpiE1 { static constexpr bool PAIR = true; float* act; const float* b1;
    __device__ void pair(int m, int n, float vg, float vl, int z) const {
        float g = vg + b1[z * 2048 + n], l = vl + b1[z * 2048 + n + 1];
        g = fminf(g, 7.f); l = fminf(fmaxf(l, -7.f), 7.f);
        act[(size_t)m * 1024 + (n >> 1)] = g * sigmoidf_(1.702f * g) * (l + 1.f); } };
struct EpiE2 { static constexpr bool PAIR = false; float* Y; const float* b2; __device__ void operator()(int m, int n, float v, int z) const { Y[(size_t)m * 1024 + n] = v + b2[z * 1024 + n]; } };
__global__ void k_final(const float* h1, const float* Y, const int* row_of, const float* gate, const float* g, const float* beta, float* out) {
    const int tg = blockIdx.x * (blockDim.x >> 6) + (threadIdx.x >> 6), lane = threadIdx.x & 63;
    if (tg >= T) return;
    int ro[4]; float gt[4];
#pragma unroll
    for (int r = 0; r < 4; ++r) { ro[r] = row_of[tg * 4 + r]; gt[r] = gate[tg * 4 + r]; }
    float v[16]; float s = 0.f;
#pragma unroll
    for (int j = 0; j < 16; ++j) { const int c = lane + 64 * j; float x = ALPHA * h1[(size_t)tg * D + c];
#pragma unroll
        for (int r = 0; r < 4; ++r) x += gt[r] * Y[(size_t)ro[r] * 1024 + c];
        v[j] = x; s += x; }
    const float mu = wsum(s) * (1.f / D); float qq = 0.f;
#pragma unroll
    for (int j = 0; j < 16; ++j) { const float d = v[j] - mu; qq += d * d; }
    const float rstd = rsqrtf(wsum(qq) * (1.f / D) + LN_EPS);
#pragma unroll
    for (int j = 0; j < 16; ++j) { const int c = lane + 64 * j; out[(size_t)tg * D + c] = (v[j] - mu) * rstd * g[c] + beta[c]; }
}
}

extern "C" void kernel_launch(void* const* d_in, const int* in_sizes, int n_in, void* d_out, int out_size, void* d_ws, size_t ws_size, hipStream_t stream) {
    using namespace nv;
    const float* x = (const float*)d_in[0]; const float* ln0_g = (const float*)d_in[1]; const float* ln0_b = (const float*)d_in[2];
    const float* w_in = (const float*)d_in[3]; const float* conv_w = (const float*)d_in[4]; const float* conv_b = (const float*)d_in[5];
    const float* w_q = (const float*)d_in[6]; const float* w_k = (const float*)d_in[7]; const float* b_if = (const float*)d_in[8];
    const float* mh_gain = (const float*)d_in[9]; const float* w_pool = (const float*)d_in[10]; const float* b_pool = (const float*)d_in[11];
    const float* ls_pool = (const float*)d_in[12]; const float* w_bp = (const float*)d_in[13]; const float* w_bm = (const float*)d_in[14];
    const float* w_out = (const float*)d_in[15]; const float* ln1_g = (const float*)d_in[16]; const float* ln1_b = (const float*)d_in[17];
    const float* w_router = (const float*)d_in[18]; const float* b_router = (const float*)d_in[19]; const float* w_e1 = (const float*)d_in[20];
    const float* b_e1 = (const float*)d_in[21]; const float* w_e2 = (const float*)d_in[22]; const float* b_e2 = (const float*)d_in[23];
    const float* ln2_g = (const float*)d_in[24]; const float* ln2_b = (const float*)d_in[25];
    float* out = (float*)d_out;
    const size_t MB_ = 1u << 20;
    if (ws_size < 1000 * MB_) { fprintf(stderr, "ws too small: %zu\n", ws_size); return; }
    char* ws = (char*)d_ws;
    float* h0 = (float*)(ws + 0 * MB_);
    float* proj = (float*)(ws + 64 * MB_);
    float* pooled = (float*)(ws + 434 * MB_);
    float* mixed = (float*)(ws + 466 * MB_);
    float* uc = (float*)(ws + 498 * MB_);
    float* qb = (float*)(ws + 562 * MB_);
    float* kb = (float*)(ws + 626 * MB_);
    float* hm = (float*)(ws + 690 * MB_);
    float* ypool = (float*)(ws + 754 * MB_);
    float* ymls = (float*)(ws + 818 * MB_);
    float* mix = (float*)(ws + 882 * MB_);
    int* ctl = (int*)(ws + 946 * MB_);
    int* top_idx = ctl; float* top_gate = (float*)(ctl + NA); int* row_tok = ctl + 2 * NA; int* row_of = ctl + 3 * NA;
    int* cnt = ctl + 4 * NA; int* start = cnt + 64; int* fill = cnt + 128;
    float* act = (float*)(ws + 64 * MB_);
    float* Y = (float*)(ws + 434 * MB_);

    k_ln<<<T / 4, 256, 0, stream>>>(x, nullptr, ln0_g, ln0_b, h0, 1.f, T);
    { EpiPlain e{proj, nullptr, INC, 1.f}; k_gemm<<<dim3((INC + 63) / 64, T / 64, 1), 256, 0, stream>>>(h0, nullptr, w_in, nullptr, nullptr, (size_t)0, (size_t)0, e, D, INC, T, INC, D, 0); }
    k_pool<<<(T * 512) / 256, 256, 0, stream>>>(proj, pooled);
    { EpiPoolMix e{mixed, b_pool, ls_pool}; k_gemm<<<dim3(2, T / 64, 4), 256, 0, stream>>>(pooled, nullptr, w_pool, nullptr, nullptr, (size_t)(128), (size_t)(128 * 128), e, 512, 128, T, 128, 128, 0); }
    { EpiPlain e{ypool, nullptr, D, 1.f}; k_gemm<<<dim3(16, T / 64, 1), 256, 0, stream>>>(mixed, nullptr, w_bp, nullptr, nullptr, (size_t)(0), (size_t)(0), e, 512, D, T, D, 512, 0); }
    k_conv<<<(T * 1024) / 256, 256, 0, stream>>>(proj, conv_w, conv_b, uc);
    { EpiHead e{qb, 0.0625f, 0}; k_gemm<<<dim3(4, T / 64, 4), 256, 0, stream>>>(uc, nullptr, w_q, nullptr, nullptr, (size_t)(256), (size_t)(256 * 256), e, 1024, 256, T, 256, 256, 0); }
    { EpiHead e{kb, 1.f, 0}; k_gemm<<<dim3(4, T / 64, 4), 256, 0, stream>>>(uc, nullptr, w_k, nullptr, nullptr, (size_t)(256), (size_t)(256 * 256), e, 1024, 256, T, 256, 256, 0); }
    k_mlstm<<<32, 512, 0, stream>>>(qb, kb, proj, b_if, hm);
    k_hnorm<<<T, 256, 0, stream>>>(hm, proj, mh_gain);
    { EpiPlain e{ymls, nullptr, D, 1.f}; k_gemm<<<dim3(16, T / 64, 1), 256, 0, stream>>>(hm, nullptr, w_bm, nullptr, nullptr, (size_t)(0), (size_t)(0), e, D, D, T, D, D, 0); }
    k_merge<<<(T * 1024) / 256, 256, 0, stream>>>(proj, ypool, ymls);
    { EpiPlain e{mix, nullptr, D, 1.f}; k_gemm<<<dim3(16, T / 64, 1), 256, 0, stream>>>(ymls, nullptr, w_out, nullptr, nullptr, (size_t)(0), (size_t)(0), e, D, D, T, D, D, 0); }
    k_ln<<<T / 4, 256, 0, stream>>>(h0, mix, ln1_g, ln1_b, mix, ALPHA, T);
    float* h1 = mix;
    k_router<<<T / 4, 256, 0, stream>>>(h1, w_router, b_router, top_idx, top_gate);
    k_zero<<<1, 256, 0, stream>>>(cnt, 192, 0);
    k_count<<<NA / 256, 256, 0, stream>>>(top_idx, cnt);
    k_prefix<<<1, 64, 0, stream>>>(cnt, start, fill);
    k_place<<<NA / 256, 256, 0, stream>>>(top_idx, start, fill, row_tok, row_of);
    { EpiE1 e{act, b_e1}; k_gemm<<<dim3(32, 256, NE), 256, 0, stream>>>(h1, row_tok, w_e1, cnt, start, (size_t)(0), (size_t)((size_t)D * 2048), e, D, 2048, T, 2048, D, 0); }
    { EpiE2 e{Y, b_e2}; k_gemm<<<dim3(16, 256, NE), 256, 0, stream>>>(act, nullptr, w_e2, cnt, start, (size_t)(0), (size_t)((size_t)D * D), e, D, D, T, D, D, 0); }
    k_final<<<T / 4, 256, 0, stream>>>(h1, Y, row_of, top_gate, ln2_g, ln2_b, out);
}
```

```cpp
#include <hip/hip_runtime.h>
#include <cstdio>
#include <cstdint>

#define LAS __attribute__((address_space(3)))
namespace mk {
constexpr int D = 1024, BATCH = 4, SEQ = 4096, T = BATCH * SEQ;
constexpr int INC = 5640;
constexpr int C_P = 0, C_U = 512, C_V = 1536, C_O = 2560, C_IF = 3584, C_G = 3592;
constexpr int NE = 32, TOPK = 4, NA = T * TOPK;
constexpr float LN_EPS = 1e-5f;
constexpr float ALPHA = 1.189207115002721f;
constexpr int NT = 512, NW = 8;
constexpr int LDS_BYTES = 147456, MISC_OFF = 131072 + 320;

#define XB_TMO      128
#define XB_XCNT(j)  (256  + 64 * (j))
#define XB_XSUB(j)  (1280 + 64 * (j))
#define XB_XGEN(j)  (2304 + 64 * (j))
#define XB_TOP      3328
#define XB_TOPGEN   3392
#define XCD_BAR_WORDS 3456
#define XB_SPIN_CAP (1u << 22)
__device__ __forceinline__ unsigned xb_ld(unsigned* p)              { return __hip_atomic_load(p, __ATOMIC_RELAXED, __HIP_MEMORY_SCOPE_AGENT); }
__device__ __forceinline__ unsigned xb_add(unsigned* p, unsigned v) { return __hip_atomic_fetch_add(p, v, __ATOMIC_RELAXED, __HIP_MEMORY_SCOPE_AGENT); }
__device__ __forceinline__ unsigned xb_xcc_id() { return (unsigned)__builtin_amdgcn_s_getreg((3 << 11) | 20) & 0xFu; }
#define XB_SPIN(cond, bar) do { unsigned _sp = 0; while (cond) { __builtin_amdgcn_s_sleep(1); \
    if ((++_sp & 255u) == 0u) { if (xb_ld(&(bar)[XB_TMO])) break; if (_sp > XB_SPIN_CAP) { atomicAdd(&(bar)[XB_TMO], 1u); break; } } } } while (0)
struct XcdBarrier { unsigned* bar; unsigned x; volatile LAS unsigned* st; };
__device__ __forceinline__ XcdBarrier xcd_barrier_post(unsigned* bar, volatile LAS unsigned* st) {
    XcdBarrier b; b.bar = bar; b.x = xb_xcc_id(); b.st = st;
    if (threadIdx.x == 0) (void)xb_add(&bar[XB_XCNT(b.x)], 1u);
    return b;
}
__device__ __forceinline__ void xcd_barrier_complete(unsigned* bar, unsigned x, unsigned& nloc, unsigned& nx) {
    const unsigned G = gridDim.x * gridDim.y * gridDim.z;
    unsigned sum, cnt, mine, sp = 0u;
    for (;;) {
        sum = 0u; cnt = 0u; mine = 0u;
#pragma unroll
        for (unsigned j = 0; j < 16; ++j) { const unsigned c = xb_ld(&bar[XB_XCNT(j)]); sum += c; cnt += (c > 0u) ? 1u : 0u; mine = (j == x) ? c : mine; }
        if (sum == G) break;
        __builtin_amdgcn_s_sleep(1);
        if ((++sp & 255u) == 0u) { if (xb_ld(&bar[XB_TMO])) break; if (sp > XB_SPIN_CAP) { atomicAdd(&bar[XB_TMO], 1u); break; } }
    }
    nloc = mine > 0u ? mine : 1u; nx = cnt > 0u ? cnt : 1u;
}
__device__ __forceinline__ void xcd_barrier(const XcdBarrier& b) {
    asm volatile("s_waitcnt vmcnt(0)" ::: "memory");
    __syncthreads();
    if (threadIdx.x == 0) {
        unsigned* bar = b.bar;
        __builtin_amdgcn_s_waitcnt(0);
        unsigned nloc = b.st[0], nx = b.st[1];
        if (nloc == 0u) { xcd_barrier_complete(bar, b.x, nloc, nx); b.st[0] = nloc; b.st[1] = nx; }
        const unsigned old = xb_add(&bar[XB_XSUB(b.x)], 1u);
        const unsigned gen = old / nloc;
        if (old + 1u == (gen + 1u) * nloc) {
            __builtin_amdgcn_fence(__ATOMIC_RELEASE, "agent");
            asm volatile("s_waitcnt vmcnt(0)" ::: "memory");
            const unsigned og = xb_add(&bar[XB_TOP], 1u);
            const unsigned tg = og / nx;
            if (og + 1u == (tg + 1u) * nx) xb_add(&bar[XB_TOPGEN], 1u);
            else XB_SPIN(xb_ld(&bar[XB_TOPGEN]) == tg, bar);
            __builtin_amdgcn_fence(__ATOMIC_ACQUIRE, "agent");
            xb_add(&bar[XB_XGEN(b.x)], 1u);
            asm volatile("s_waitcnt vmcnt(0)" ::: "memory");
        } else {
            XB_SPIN(xb_ld(&bar[XB_XGEN(b.x)]) == gen, bar);
            __builtin_amdgcn_fence(__ATOMIC_ACQUIRE, "agent");
            asm volatile("s_waitcnt vmcnt(0)" ::: "memory");
        }
    }
    __syncthreads();
}

__device__ __forceinline__ float wsum(float v) {
#pragma unroll
    for (int o = 1; o < 64; o <<= 1) v += __shfl_xor(v, o);
    return v;
}
__device__ __forceinline__ float sigmoidf_(float x) { return 1.f / (1.f + expf(-x)); }

__device__ __forceinline__ void ph_ln(const float* a, const float* b, const float* g, const float* beta, float* y, float scale) {
    const int lane = threadIdx.x & 63, gw = blockIdx.x * NW + (threadIdx.x >> 6), ngw = gridDim.x * NW;
    for (int row = gw; row < T; row += ngw) {
        float v[16]; float s = 0.f;
#pragma unroll
        for (int j = 0; j < 16; ++j) { const int c = lane + 64 * j; float x = a[(size_t)row * D + c] * scale; if (b) x += b[(size_t)row * D + c]; v[j] = x; s += x; }
        const float mu = wsum(s) * (1.f / D); float q = 0.f;
#pragma unroll
        for (int j = 0; j < 16; ++j) { const float d = v[j] - mu; q += d * d; }
        const float rstd = rsqrtf(wsum(q) * (1.f / D) + LN_EPS);
#pragma unroll
        for (int j = 0; j < 16; ++j) { const int c = lane + 64 * j; y[(size_t)row * D + c] = (v[j] - mu) * rstd * g[c] + beta[c]; }
    }
}
struct EpiPlain { static constexpr bool PAIR = false; float* C; int ldc; float scale;
    __device__ void operator()(int m, int n, float v, int z) const { C[(size_t)m * ldc + n] = v * scale; } };
struct EpiPoolMix { static constexpr bool PAIR = false; float* C; const float* b; const float* ls;
    __device__ void operator()(int m, int n, float v, int z) const { const int c = z * 128 + n; C[(size_t)m * 512 + c] = (v + b[c]) * ls[c]; } };
struct EpiHead { static constexpr bool PAIR = false; float* C; float scale;
    __device__ void operator()(int m, int n, float v, int z) const { C[(size_t)m * 1024 + z * 256 + n] = v * scale; } };
struct EpiE1 { static constexpr bool PAIR = true; float* act; const float* b1;
    __device__ void pair(int m, int n, float vg, float vl, int z) const {
        float g = vg + b1[z * 2048 + n], l = vl + b1[z * 2048 + n + 1];
        g = fminf(g, 7.f); l = fminf(fmaxf(l, -7.f), 7.f);
        act[(size_t)m * 1024 + (n >> 1)] = g * sigmoidf_(1.702f * g) * (l + 1.f); } };
struct EpiE2 { static constexpr bool PAIR = false; float* Y; const float* b2;
    __device__ void operator()(int m, int n, float v, int z) const { Y[(size_t)m * 1024 + n] = v + b2[z * 1024 + n]; } };

template <class Epi>
__device__ __forceinline__ void ph_gemm(LAS float* lds, const float* A, const int* rowidx, const float* B, const int* mcount, const int* mstart,
                                        size_t strideA, size_t strideB, const Epi& epi, int lda, int ldb, int M, int N, int K, int nz, int vb0, int nvb) {
    LAS float* As = lds;
    LAS float* Bs = lds + 16 * 129;
    const int tid = threadIdx.x, tx = tid & 15, ty = tid >> 4;
    const int ntn = (N + 63) / 64, ntm = (M + 127) / 128, per_z = ntn * ntm, total = per_z * nz;
    for (int vt = vb0; vt < total; vt += nvb) {
        const int z = vt / per_z, r = vt % per_z, bm = (r / ntn) * 128, bn = (r % ntn) * 64;
        int Mz = M, m0g = 0;
        if (mcount) { Mz = mcount[z]; m0g = mstart[z]; }
        if (bm >= Mz) continue;
        const float* Az = A + z * strideA; const float* Bz = B + z * strideB;
        float acc[4][4] = {};
        const int ar = tid >> 2, ak = (tid & 3) * 4;
        const int arow = bm + ar; const bool aval = arow < Mz; int asrc = 0;
        if (aval) { const int gr = m0g + arow; asrc = rowidx ? rowidx[gr] : gr; }
        const int bk = tid >> 5, bn2 = (tid & 31) * 2;
        for (int k0 = 0; k0 < K; k0 += 16) {
            float4 av = make_float4(0.f, 0.f, 0.f, 0.f);
            if (aval) av = *(const float4*)(Az + (size_t)asrc * lda + k0 + ak);
            As[(ak + 0) * 129 + ar] = av.x; As[(ak + 1) * 129 + ar] = av.y; As[(ak + 2) * 129 + ar] = av.z; As[(ak + 3) * 129 + ar] = av.w;
#pragma unroll
            for (int j = 0; j < 2; ++j) { const int n = bn + bn2 + j; Bs[bk * 65 + bn2 + j] = (n < N) ? Bz[(size_t)(k0 + bk) * ldb + n] : 0.f; }
            __syncthreads();
#pragma unroll
            for (int kk = 0; kk < 16; ++kk) {
                float a[4], b[4];
#pragma unroll
                for (int i = 0; i < 4; ++i) { a[i] = As[kk * 129 + ty * 4 + i]; b[i] = Bs[kk * 65 + tx * 4 + i]; }
#pragma unroll
                for (int i = 0; i < 4; ++i)
#pragma unroll
                    for (int j = 0; j < 4; ++j) acc[i][j] += a[i] * b[j];
            }
            __syncthreads();
        }
#pragma unroll
        for (int i = 0; i < 4; ++i) { const int m = bm + ty * 4 + i; if (m >= Mz) continue;
            if constexpr (Epi::PAIR) {
#pragma unroll
                for (int j = 0; j < 4; j += 2) { const int n = bn + tx * 4 + j; if (n < N) epi.pair(m0g + m, n, acc[i][j], acc[i][j + 1], z); }
            } else {
#pragma unroll
                for (int j = 0; j < 4; ++j) { const int n = bn + tx * 4 + j; if (n < N) epi(m0g + m, n, acc[i][j], z); }
            } }
    }
}
__device__ __forceinline__ void ph_pool_conv(const float* proj, const float* cw, const float* cb, float* pooled, float* uc) {
    const size_t gt = (size_t)blockIdx.x * NT + threadIdx.x, ngt = (size_t)gridDim.x * NT;
    for (size_t i = gt; i < (size_t)T * 512; i += ngt) {
        const int c = (int)(i % 512); const int tg = (int)(i / 512); const int t = tg % SEQ;
        const int w = 2 << (c >> 7);
        const int cnt = (t + 1 < w) ? t + 1 : w; float s = 0.f;
        for (int j = 0; j < cnt; ++j) s += proj[(size_t)(tg - j) * INC + C_P + c];
        pooled[i] = s / (float)cnt - proj[(size_t)tg * INC + C_P + c];
    }
    for (size_t i = gt; i < (size_t)T * 1024; i += ngt) {
        const int c = (int)(i % 1024); const int tg = (int)(i / 1024); const int t = tg % SEQ;
        float y = cb[c];
#pragma unroll
        for (int j = 0; j < 4; ++j) { const int tt = t - 3 + j; if (tt >= 0) y += proj[(size_t)(tg - 3 + j) * INC + C_U + c] * cw[j * 1024 + c]; }
        uc[i] = y * sigmoidf_(y);
    }
}
constexpr int MB = 16;
__device__ __forceinline__ void ph_mlstm(LAS float* lds, int vb, const float* q, const float* k, const float* proj, const float* b_if, float* hm) {
    const int bh = vb >> 1, b = bh >> 2, h = bh & 3;
    const int tid = threadIdx.x, e = (vb & 1) * 128 + (tid >> 2), dq = tid & 3;
    LAS float* sq = lds; LAS float* sk = lds + MB * 256; LAS float* sv = lds + 2 * MB * 256; LAS float* si = lds + 3 * MB * 256; LAS float* sf = si + MB;
    float C[64]; float n[16];
#pragma unroll
    for (int j = 0; j < 64; ++j) C[j] = 0.f;
#pragma unroll
    for (int j = 0; j < 16; ++j) n[j] = 0.f;
    float m = 0.f;
    const int nsub = (e & 3) * 16;
    for (int t0 = 0; t0 < SEQ; t0 += MB) {
        __syncthreads();
        for (int i = tid; i < MB * 256; i += NT) { const int tt = i >> 8, d = i & 255; const size_t tg = (size_t)b * SEQ + t0 + tt;
            sq[tt * 256 + d] = q[tg * 1024 + h * 256 + d]; sk[tt * 256 + d] = k[tg * 1024 + h * 256 + d]; sv[tt * 256 + d] = proj[tg * INC + C_V + h * 256 + d]; }
        if (tid < MB) { const size_t tg = (size_t)b * SEQ + t0 + tid; si[tid] = proj[tg * INC + C_IF + h] + b_if[h]; sf[tid] = proj[tg * INC + C_IF + 4 + h] + b_if[4 + h]; }
        __syncthreads();
        for (int tt = 0; tt < MB; ++tt) {
            const float ip = si[tt], fp = sf[tt];
            const float lf = fminf(fp, 0.f) - log1pf(expf(-fabsf(fp)));
            const float mn = fmaxf(lf + m, ip);
            const float fd = expf(lf + m - mn), iw = expf(ip - mn);
            m = mn;
            const float ve = sv[tt * 256 + e] * iw;
            float num = 0.f, den = 0.f;
#pragma unroll
            for (int j = 0; j < 64; ++j) { const float kk = sk[tt * 256 + dq * 64 + j]; C[j] = fd * C[j] + ve * kk; num += C[j] * sq[tt * 256 + dq * 64 + j]; }
#pragma unroll
            for (int j = 0; j < 16; ++j) { const int d = dq * 64 + nsub + j; n[j] = fd * n[j] + iw * sk[tt * 256 + d]; den += n[j] * sq[tt * 256 + d]; }
            num += __shfl_xor(num, 1); num += __shfl_xor(num, 2);
            den += __shfl_xor(den, 1); den += __shfl_xor(den, 2); den += __shfl_xor(den, 4); den += __shfl_xor(den, 8);
            if (dq == 0) { const float dn = fmaxf(fabsf(den), expf(-mn)); hm[((size_t)b * SEQ + t0 + tt) * 1024 + h * 256 + e] = num / dn; }
        }
    }
    __syncthreads();
}
__device__ __forceinline__ void ph_hnorm(float* hm, const float* proj, const float* gain) {
    const int lane = threadIdx.x & 63, gw = blockIdx.x * NW + (threadIdx.x >> 6), ngw = gridDim.x * NW;
    for (int w = gw; w < T * 4; w += ngw) {
        const int tg = w >> 2, h = w & 3;
        float v[4]; float s = 0.f;
#pragma unroll
        for (int j = 0; j < 4; ++j) { v[j] = hm[(size_t)tg * 1024 + h * 256 + lane + 64 * j]; s += v[j]; }
        const float mu = wsum(s) * (1.f / 256); float qq = 0.f;
#pragma unroll
        for (int j = 0; j < 4; ++j) { const float d = v[j] - mu; qq += d * d; }
        const float rstd = rsqrtf(wsum(qq) * (1.f / 256) + LN_EPS);
#pragma unroll
        for (int j = 0; j < 4; ++j) { const int c = h * 256 + lane + 64 * j; hm[(size_t)tg * 1024 + c] = (v[j] - mu) * rstd * gain[c] * sigmoidf_(proj[(size_t)tg * INC + C_O + c]); }
    }
}
__device__ __forceinline__ void ph_merge(const float* proj, const float* ypool, float* ymls) {
    const size_t gt = (size_t)blockIdx.x * NT + threadIdx.x, ngt = (size_t)gridDim.x * NT;
    for (size_t i = gt; i < (size_t)T * 1024; i += ngt) {
        const int c = (int)(i % 1024); const size_t tg = i / 1024;
        const float g0 = sigmoidf_(proj[tg * INC + C_G + c]), g1 = sigmoidf_(proj[tg * INC + C_G + 1024 + c]);
        ymls[i] = g0 * ypool[i] + g1 * ymls[i];
    }
}
__device__ __forceinline__ void ph_router(const float* h1, const float* wr, const float* br, int* top_idx, float* top_gate, int* cnt) {
    const int lane = threadIdx.x & 63, gw = blockIdx.x * NW + (threadIdx.x >> 6), ngw = gridDim.x * NW;
    for (int tg = gw; tg < T; tg += ngw) {
        const int e = lane & 31, half = lane >> 5;
        float s = 0.f;
        for (int kk = 0; kk < 512; ++kk) { const int kx = half * 512 + kk; s += h1[(size_t)tg * D + kx] * wr[kx * NE + e]; }
        s += __shfl_xor(s, 32); s += br[e];
        float val = s; int idxs[4]; float vals[4];
#pragma unroll
        for (int r = 0; r < 4; ++r) {
            float bv = val; int bi = e;
#pragma unroll
            for (int o = 1; o < 32; o <<= 1) { const float ov = __shfl_xor(bv, o); const int oi = __shfl_xor(bi, o); if (ov > bv || (ov == bv && oi < bi)) { bv = ov; bi = oi; } }
            idxs[r] = bi; vals[r] = bv; if (e == bi) val = -INFINITY;
        }
        const float mx = vals[0]; float ex[4], se = 0.f;
#pragma unroll
        for (int r = 0; r < 4; ++r) { ex[r] = expf(vals[r] - mx); se += ex[r]; }
#pragma unroll
        for (int r = 0; r < 4; ++r) if (lane == r) { top_idx[tg * 4 + r] = idxs[r]; top_gate[tg * 4 + r] = ex[r] / se; atomicAdd(&cnt[idxs[r]], 1); }
    }
}
__device__ __forceinline__ void ph_place(const int* top_idx, const int* start, int* fill, int* row_tok, int* row_of) {
    const int gt = blockIdx.x * NT + threadIdx.x, ngt = gridDim.x * NT;
    for (int i = gt; i < NA; i += ngt) { const int e = top_idx[i]; const int r = atomicAdd(&fill[e], 1); const int dest = start[e] + r; row_tok[dest] = i >> 2; row_of[i] = dest; }
}
__device__ __forceinline__ void ph_final(const float* h1, const float* Y, const int* row_of, const float* gate, const float* g, const float* beta, float* out) {
    const int lane = threadIdx.x & 63, gw = blockIdx.x * NW + (threadIdx.x >> 6), ngw = gridDim.x * NW;
    for (int tg = gw; tg < T; tg += ngw) {
        int ro[4]; float gt[4];
#pragma unroll
        for (int r = 0; r < 4; ++r) { ro[r] = row_of[tg * 4 + r]; gt[r] = gate[tg * 4 + r]; }
        float v[16]; float s = 0.f;
#pragma unroll
        for (int j = 0; j < 16; ++j) { const int c = lane + 64 * j; float x = ALPHA * h1[(size_t)tg * D + c];
#pragma unroll
            for (int r = 0; r < 4; ++r) x += gt[r] * Y[(size_t)ro[r] * 1024 + c];
            v[j] = x; s += x; }
        const float mu = wsum(s) * (1.f / D); float qq = 0.f;
#pragma unroll
        for (int j = 0; j < 16; ++j) { const float d = v[j] - mu; qq += d * d; }
        const float rstd = rsqrtf(wsum(qq) * (1.f / D) + LN_EPS);
#pragma unroll
        for (int j = 0; j < 16; ++j) { const int c = lane + 64 * j; out[(size_t)tg * D + c] = (v[j] - mu) * rstd * g[c] + beta[c]; }
    }
}

struct Args { const float* in[26]; float* out; unsigned char* ws; int ph_lo, ph_hi; };
constexpr size_t MiB = 1u << 20;
constexpr size_t WS_CTL = 0;
constexpr size_t CTL_ZERO_BYTES = 1 * MiB;
constexpr int CW_BAR = 4096;
constexpr int CW_CNT = 16384, CW_START = 16384 + 64, CW_FILL = 16384 + 128;

__global__ void __launch_bounds__(NT, 2) mk_fwd(Args a) {
    extern __shared__ __attribute__((aligned(16))) unsigned char lds_raw[];
    LAS unsigned char* lds = (LAS unsigned char*)lds_raw;
    volatile LAS unsigned* MISC = (volatile LAS unsigned*)(lds + MISC_OFF);
    const int tid = threadIdx.x;
    if (tid < 32) MISC[tid] = 0u;
    __syncthreads();
    unsigned char* ws = a.ws;
    unsigned* ctl = (unsigned*)(ws + WS_CTL);
    XcdBarrier bar = xcd_barrier_post(ctl + CW_BAR, MISC + 8);
    const float* x = a.in[0]; const float* ln0_g = a.in[1]; const float* ln0_b = a.in[2];
    const float* w_in = a.in[3]; const float* conv_w = a.in[4]; const float* conv_b = a.in[5];
    const float* w_q = a.in[6]; const float* w_k = a.in[7]; const float* b_if = a.in[8];
    const float* mh_gain = a.in[9]; const float* w_pool = a.in[10]; const float* b_pool = a.in[11];
    const float* ls_pool = a.in[12]; const float* w_bp = a.in[13]; const float* w_bm = a.in[14];
    const float* w_out = a.in[15]; const float* ln1_g = a.in[16]; const float* ln1_b = a.in[17];
    const float* w_router = a.in[18]; const float* b_router = a.in[19]; const float* w_e1 = a.in[20];
    const float* b_e1 = a.in[21]; const float* w_e2 = a.in[22]; const float* b_e2 = a.in[23];
    const float* ln2_g = a.in[24]; const float* ln2_b = a.in[25];
    float* h0 = (float*)(ws + 2 * MiB);
    float* proj = (float*)(ws + 66 * MiB);
    float* pooled = (float*)(ws + 434 * MiB);
    float* mixed = (float*)(ws + 466 * MiB);
    float* uc = (float*)(ws + 498 * MiB);
    float* qb = (float*)(ws + 562 * MiB);
    float* kb = (float*)(ws + 626 * MiB);
    float* hm = (float*)(ws + 690 * MiB);
    float* ypool = (float*)(ws + 754 * MiB);
    float* ymls = (float*)(ws + 818 * MiB);
    float* mix = (float*)(ws + 882 * MiB);
    int* rt = (int*)(ws + 946 * MiB);
    int* top_idx = rt; float* top_gate = (float*)(rt + NA); int* row_tok = rt + 2 * NA; int* row_of = rt + 3 * NA;
    int* cnt = (int*)ctl + CW_CNT; int* start = (int*)ctl + CW_START; int* fill = (int*)ctl + CW_FILL;
    float* act = (float*)(ws + 66 * MiB);
    float* Y = (float*)(ws + 434 * MiB);
    LAS float* ldsf = (LAS float*)lds;
    const int G = gridDim.x, bx = blockIdx.x;
#define IN(k) (a.ph_lo <= (k) && (k) < a.ph_hi)
#define SEAM(k) do { if (IN(k) && IN((k) + 1)) xcd_barrier(bar); } while (0)
    if (IN(0)) ph_ln(x, nullptr, ln0_g, ln0_b, h0, 1.f);
    SEAM(0);
    if (IN(1)) { EpiPlain e{proj, INC, 1.f}; ph_gemm(ldsf, h0, nullptr, w_in, nullptr, nullptr, 0, 0, e, D, INC, T, INC, D, 1, bx, G); }
    SEAM(1);
    if (IN(2)) ph_pool_conv(proj, conv_w, conv_b, pooled, uc);
    SEAM(2);
    if (IN(3)) {
        { EpiPoolMix e{mixed, b_pool, ls_pool}; ph_gemm(ldsf, pooled, nullptr, w_pool, nullptr, nullptr, 128, 128 * 128, e, 512, 128, T, 128, 128, 4, bx, G); }
        { EpiHead e{qb, 0.0625f}; ph_gemm(ldsf, uc, nullptr, w_q, nullptr, nullptr, 256, 256 * 256, e, 1024, 256, T, 256, 256, 4, bx, G); }
        { EpiHead e{kb, 1.f}; ph_gemm(ldsf, uc, nullptr, w_k, nullptr, nullptr, 256, 256 * 256, e, 1024, 256, T, 256, 256, 4, bx, G); }
    }
    SEAM(3);
    if (IN(4)) {
        if (bx < 32) ph_mlstm(ldsf, bx, qb, kb, proj, b_if, hm);
        else { EpiPlain e{ypool, D, 1.f}; ph_gemm(ldsf, mixed, nullptr, w_bp, nullptr, nullptr, 0, 0, e, 512, D, T, D, 512, 1, bx - 32, G - 32); }
    }
    SEAM(4);
    if (IN(5)) ph_hnorm(hm, proj, mh_gain);
    SEAM(5);
    if (IN(6)) { EpiPlain e{ymls, D, 1.f}; ph_gemm(ldsf, hm, nullptr, w_bm, nullptr, nullptr, 0, 0, e, D, D, T, D, D, 1, bx, G); }
    SEAM(6);
    if (IN(7)) ph_merge(proj, ypool, ymls);
    SEAM(7);
    if (IN(8)) { EpiPlain e{mix, D, 1.f}; ph_gemm(ldsf, ymls, nullptr, w_out, nullptr, nullptr, 0, 0, e, D, D, T, D, D, 1, bx, G); }
    SEAM(8);
    if (IN(9)) ph_ln(h0, mix, ln1_g, ln1_b, mix, ALPHA);
    float* h1 = mix;
    SEAM(9);
    if (IN(10)) ph_router(h1, w_router, b_router, top_idx, top_gate, cnt);
    SEAM(10);
    if (IN(11)) { if (bx == 0 && tid == 0) { int s = 0; for (int e = 0; e < NE; ++e) { start[e] = s; s += cnt[e]; } } }
    SEAM(11);
    if (IN(12)) ph_place(top_idx, start, fill, row_tok, row_of);
    SEAM(12);
    if (IN(13)) { EpiE1 e{act, b_e1}; ph_gemm(ldsf, h1, row_tok, w_e1, cnt, start, 0, (size_t)D * 2048, e, D, 2048, T, 2048, D, NE, bx, G); }
    SEAM(13);
    if (IN(14)) { EpiE2 e{Y, b_e2}; ph_gemm(ldsf, act, nullptr, w_e2, cnt, start, 0, (size_t)D * D, e, D, D, T, D, D, NE, bx, G); }
    SEAM(14);
    if (IN(15)) ph_final(h1, Y, row_of, top_gate, ln2_g, ln2_b, a.out);
}
constexpr int NPH = 16;
}

extern "C" void kernel_launch(void* const* d_in, const int* in_sizes, int n_in, void* d_out, int out_size, void* d_ws, size_t ws_size, hipStream_t stream) {
    using namespace mk;
    static int grid = 0;
    if (grid == 0) {
        if (n_in != 26 || ws_size < 1000 * MiB) { fprintf(stderr, "kernel_launch: unexpected n_in %d / ws %zu\n", n_in, ws_size); grid = -1; return; }
        int dev = 0, cus = 0, per_cu = 0;
        hipGetDevice(&dev); hipDeviceGetAttribute(&cus, hipDeviceAttributeMultiprocessorCount, dev);
        if (hipFuncSetAttribute((const void*)mk_fwd, hipFuncAttributeMaxDynamicSharedMemorySize, LDS_BYTES) != hipSuccess) { fprintf(stderr, "hipFuncSetAttribute failed\n"); grid = -1; return; }
        if (hipOccupancyMaxActiveBlocksPerMultiprocessor(&per_cu, (const void*)mk_fwd, NT, LDS_BYTES) != hipSuccess || per_cu < 1) { fprintf(stderr, "occupancy query failed (%d)\n", per_cu); grid = -1; return; }
        grid = cus * 1;
        fprintf(stderr, "kernel_launch: cus %d per_cu %d grid %d\n", cus, per_cu, grid);
    }
    if (grid < 0) return;
    hipMemsetAsync((char*)d_ws + WS_CTL, 0, CTL_ZERO_BYTES, stream);
    Args a{};
    for (int i = 0; i < 26; ++i) a.in[i] = (const float*)d_in[i];
    a.out = (float*)d_out; a.ws = (unsigned char*)d_ws; a.ph_lo = 0; a.ph_hi = NPH;
    void* args[] = {&a};
    hipError_t e = hipLaunchCooperativeKernel((const void*)mk_fwd, dim3(grid), dim3(NT), args, LDS_BYTES, stream);
    if (e != hipSuccess) fprintf(stderr, "cooperative launch failed: %s (grid %d)\n", hipGetErrorString(e), grid);
}
```

```cpp
#include <hip/hip_runtime.h>
#include <cstdio>
#include <cstdint>

#define LAS __attribute__((address_space(3)))
namespace mk {
constexpr int D = 1024, BATCH = 4, SEQ = 4096, T = BATCH * SEQ;
constexpr int INC = 5640;
constexpr int C_P = 0, C_U = 512, C_V = 1536, C_O = 2560, C_IF = 3584, C_G = 3592;
constexpr int NE = 32, TOPK = 4, NA = T * TOPK;
constexpr float LN_EPS = 1e-5f;
constexpr float ALPHA = 1.189207115002721f;
constexpr int NT = 512, NW = 8;
constexpr int LDS_BYTES = 147456, MISC_OFF = 131072 + 320;

#define XB_TMO      128
#define XB_XCNT(j)  (256  + 64 * (j))
#define XB_XSUB(j)  (1280 + 64 * (j))
#define XB_XGEN(j)  (2304 + 64 * (j))
#define XB_TOP      3328
#define XB_TOPGEN   3392
#define XCD_BAR_WORDS 3456
#define XB_SPIN_CAP (1u << 22)
__device__ __forceinline__ unsigned xb_ld(unsigned* p)              { return __hip_atomic_load(p, __ATOMIC_RELAXED, __HIP_MEMORY_SCOPE_AGENT); }
__device__ __forceinline__ unsigned xb_add(unsigned* p, unsigned v) { return __hip_atomic_fetch_add(p, v, __ATOMIC_RELAXED, __HIP_MEMORY_SCOPE_AGENT); }
__device__ __forceinline__ unsigned xb_xcc_id() { return (unsigned)__builtin_amdgcn_s_getreg((3 << 11) | 20) & 0xFu; }
#define XB_SPIN(cond, bar) do { unsigned _sp = 0; while (cond) { __builtin_amdgcn_s_sleep(1); \
    if ((++_sp & 255u) == 0u) { if (xb_ld(&(bar)[XB_TMO])) break; if (_sp > XB_SPIN_CAP) { atomicAdd(&(bar)[XB_TMO], 1u); break; } } } } while (0)
struct XcdBarrier { unsigned* bar; unsigned x; volatile LAS unsigned* st; };
__device__ __forceinline__ XcdBarrier xcd_barrier_post(unsigned* bar, volatile LAS unsigned* st) {
    XcdBarrier b; b.bar = bar; b.x = xb_xcc_id(); b.st = st;
    if (threadIdx.x == 0) (void)xb_add(&bar[XB_XCNT(b.x)], 1u);
    return b;
}
__device__ __forceinline__ void xcd_barrier_complete(unsigned* bar, unsigned x, unsigned& nloc, unsigned& nx) {
    const unsigned G = gridDim.x * gridDim.y * gridDim.z;
    unsigned sum, cnt, mine, sp = 0u;
    for (;;) {
        sum = 0u; cnt = 0u; mine = 0u;
#pragma unroll
        for (unsigned j = 0; j < 16; ++j) { const unsigned c = xb_ld(&bar[XB_XCNT(j)]); sum += c; cnt += (c > 0u) ? 1u : 0u; mine = (j == x) ? c : mine; }
        if (sum == G) break;
        __builtin_amdgcn_s_sleep(1);
        if ((++sp & 255u) == 0u) { if (xb_ld(&bar[XB_TMO])) break; if (sp > XB_SPIN_CAP) { atomicAdd(&bar[XB_TMO], 1u); break; } }
    }
    nloc = mine > 0u ? mine : 1u; nx = cnt > 0u ? cnt : 1u;
}
__device__ __forceinline__ void xcd_barrier(const XcdBarrier& b) {
    asm volatile("s_waitcnt vmcnt(0)" ::: "memory");
    __syncthreads();
    if (threadIdx.x == 0) {
        unsigned* bar = b.bar;
        __builtin_amdgcn_s_waitcnt(0);
        unsigned nloc = b.st[0], nx = b.st[1];
        if (nloc == 0u) { xcd_barrier_complete(bar, b.x, nloc, nx); b.st[0] = nloc; b.st[1] = nx; }
        const unsigned old = xb_add(&bar[XB_XSUB(b.x)], 1u);
        const unsigned gen = old / nloc;
        if (old + 1u == (gen + 1u) * nloc) {
            __builtin_amdgcn_fence(__ATOMIC_RELEASE, "agent");
            asm volatile("s_waitcnt vmcnt(0)" ::: "memory");
            const unsigned og = xb_add(&bar[XB_TOP], 1u);
            const unsigned tg = og / nx;
            if (og + 1u == (tg + 1u) * nx) xb_add(&bar[XB_TOPGEN], 1u);
            else XB_SPIN(xb_ld(&bar[XB_TOPGEN]) == tg, bar);
            __builtin_amdgcn_fence(__ATOMIC_ACQUIRE, "agent");
            xb_add(&bar[XB_XGEN(b.x)], 1u);
            asm volatile("s_waitcnt vmcnt(0)" ::: "memory");
        } else {
            XB_SPIN(xb_ld(&bar[XB_XGEN(b.x)]) == gen, bar);
            __builtin_amdgcn_fence(__ATOMIC_ACQUIRE, "agent");
            asm volatile("s_waitcnt vmcnt(0)" ::: "memory");
        }
    }
    __syncthreads();
}

__device__ __forceinline__ int tidf() { int t = threadIdx.x; asm volatile("" : "+v"(t)); return t; }
__device__ __forceinline__ float wsum(float v) {
#pragma unroll
    for (int o = 1; o < 64; o <<= 1) v += __shfl_xor(v, o);
    return v;
}
__device__ __forceinline__ float sigmoidf_(float x) { return 1.f / (1.f + expf(-x)); }

__device__ __forceinline__ void ph_ln(const float* a, const float* b, const float* g, const float* beta, float* y, float scale) {
    const int lane = tidf() & 63, gw = blockIdx.x * NW + (tidf() >> 6), ngw = gridDim.x * NW;
    for (int row = gw; row < T; row += ngw) {
        float v[16]; float s = 0.f;
#pragma unroll
        for (int j = 0; j < 16; ++j) { const int c = lane + 64 * j; float x = a[(size_t)row * D + c] * scale; if (b) x += b[(size_t)row * D + c]; v[j] = x; s += x; }
        const float mu = wsum(s) * (1.f / D); float q = 0.f;
#pragma unroll
        for (int j = 0; j < 16; ++j) { const float d = v[j] - mu; q += d * d; }
        const float rstd = rsqrtf(wsum(q) * (1.f / D) + LN_EPS);
#pragma unroll
        for (int j = 0; j < 16; ++j) { const int c = lane + 64 * j; y[(size_t)row * D + c] = (v[j] - mu) * rstd * g[c] + beta[c]; }
    }
}
struct EpiPlain { static constexpr bool PAIR = false; float* C; int ldc; float scale;
    __device__ void operator()(int m, int n, float v, int z) const { C[(size_t)m * ldc + n] = v * scale; } };
struct EpiPoolMix { static constexpr bool PAIR = false; float* C; const float* b; const float* ls;
    __device__ void operator()(int m, int n, float v, int z) const { const int c = z * 128 + n; C[(size_t)m * 512 + c] = (v + b[c]) * ls[c]; } };
struct EpiHead { static constexpr bool PAIR = false; float* C; float scale;
    __device__ void operator()(int m, int n, float v, int z) const { C[(size_t)m * 1024 + z * 256 + n] = v * scale; } };
struct EpiE1 { static constexpr bool PAIR = true; float* act; const float* b1;
    __device__ void pair(int m, int n, float vg, float vl, int z) const {
        float g = vg + b1[z * 2048 + n], l = vl + b1[z * 2048 + n + 1];
        g = fminf(g, 7.f); l = fminf(fmaxf(l, -7.f), 7.f);
        act[(size_t)m * 1024 + (n >> 1)] = g * sigmoidf_(1.702f * g) * (l + 1.f); } };
struct EpiE2 { static constexpr bool PAIR = false; float* Y; const float* b2;
    __device__ void operator()(int m, int n, float v, int z) const { Y[(size_t)m * 1024 + n] = v + b2[z * 1024 + n]; } };

template <class Epi>
__device__ __forceinline__ void ph_gemm(LAS float* lds, const float* A, const int* rowidx, const float* B, const int* mcount, const int* mstart,
                                        size_t strideA, size_t strideB, const Epi& epi, int lda, int ldb, int M, int N, int K, int nz, int vb0, int nvb) {
    LAS float* As = lds;
    LAS float* Bs = lds + 16 * 129;
    const int tid = tidf(), tx = tid & 15, ty = tid >> 4;
    const int ntn = (N + 63) / 64, ntm = (M + 127) / 128, per_z = ntn * ntm, total = per_z * nz;
    for (int vt = vb0; vt < total; vt += nvb) {
        const int z = vt / per_z, r = vt % per_z, bm = (r / ntn) * 128, bn = (r % ntn) * 64;
        int Mz = M, m0g = 0;
        if (mcount) { Mz = mcount[z]; m0g = mstart[z]; }
        if (bm >= Mz) continue;
        const float* Az = A + z * strideA; const float* Bz = B + z * strideB;
        float acc[4][4] = {};
        const int ar = tid >> 2, ak = (tid & 3) * 4;
        const int arow = bm + ar; const bool aval = arow < Mz; int asrc = 0;
        if (aval) { const int gr = m0g + arow; asrc = rowidx ? rowidx[gr] : gr; }
        const int bk = tid >> 5, bn2 = (tid & 31) * 2;
        for (int k0 = 0; k0 < K; k0 += 16) {
            float4 av = make_float4(0.f, 0.f, 0.f, 0.f);
            if (aval) av = *(const float4*)(Az + (size_t)asrc * lda + k0 + ak);
            As[(ak + 0) * 129 + ar] = av.x; As[(ak + 1) * 129 + ar] = av.y; As[(ak + 2) * 129 + ar] = av.z; As[(ak + 3) * 129 + ar] = av.w;
#pragma unroll
            for (int j = 0; j < 2; ++j) { const int n = bn + bn2 + j; Bs[bk * 65 + bn2 + j] = (n < N) ? Bz[(size_t)(k0 + bk) * ldb + n] : 0.f; }
            __syncthreads();
#pragma unroll
            for (int kk = 0; kk < 16; ++kk) {
                float a[4], b[4];
#pragma unroll
                for (int i = 0; i < 4; ++i) { a[i] = As[kk * 129 + ty * 4 + i]; b[i] = Bs[kk * 65 + tx * 4 + i]; }
#pragma unroll
                for (int i = 0; i < 4; ++i)
#pragma unroll
                    for (int j = 0; j < 4; ++j) acc[i][j] += a[i] * b[j];
            }
            __syncthreads();
        }
#pragma unroll
        for (int i = 0; i < 4; ++i) { const int m = bm + ty * 4 + i; if (m >= Mz) continue;
            if constexpr (Epi::PAIR) {
#pragma unroll
                for (int j = 0; j < 4; j += 2) { const int n = bn + tx * 4 + j; if (n < N) epi.pair(m0g + m, n, acc[i][j], acc[i][j + 1], z); }
            } else {
#pragma unroll
                for (int j = 0; j < 4; ++j) { const int n = bn + tx * 4 + j; if (n < N) epi(m0g + m, n, acc[i][j], z); }
            } }
    }
}
__device__ __forceinline__ void ph_pool_conv(const float* proj, const float* cw, const float* cb, float* pooled, float* uc) {
    const size_t gt = (size_t)blockIdx.x * NT + tidf(), ngt = (size_t)gridDim.x * NT;
    for (size_t i = gt; i < (size_t)T * 512; i += ngt) {
        const int c = (int)(i % 512); const int tg = (int)(i / 512); const int t = tg % SEQ;
        const int w = 2 << (c >> 7);
        const int cnt = (t + 1 < w) ? t + 1 : w; float s = 0.f;
        for (int j = 0; j < cnt; ++j) s += proj[(size_t)(tg - j) * INC + C_P + c];
        pooled[i] = s / (float)cnt - proj[(size_t)tg * INC + C_P + c];
    }
    for (size_t i = gt; i < (size_t)T * 1024; i += ngt) {
        const int c = (int)(i % 1024); const int tg = (int)(i / 1024); const int t = tg % SEQ;
        float y = cb[c];
#pragma unroll
        for (int j = 0; j < 4; ++j) { const int tt = t - 3 + j; if (tt >= 0) y += proj[(size_t)(tg - 3 + j) * INC + C_U + c] * cw[j * 1024 + c]; }
        uc[i] = y * sigmoidf_(y);
    }
}
constexpr int MB = 16;
__device__ __forceinline__ void ph_mlstm(LAS float* lds, int vb, const float* q, const float* k, const float* vv, const float* gif, float* hm) {
    const int bh = vb >> 1, b = bh >> 2, h = bh & 3;
    const int tid = tidf(), e = (vb & 1) * 128 + (tid >> 2), dq = tid & 3;
    LAS float* sq = lds; LAS float* sk = lds + MB * 256; LAS float* sv = lds + 2 * MB * 256; LAS float* si = lds + 3 * MB * 256; LAS float* sf = si + MB;
    float C[64]; float n[16];
#pragma unroll
    for (int j = 0; j < 64; ++j) C[j] = 0.f;
#pragma unroll
    for (int j = 0; j < 16; ++j) n[j] = 0.f;
    float m = 0.f;
    const int nsub = (e & 3) * 16;
    for (int t0 = 0; t0 < SEQ; t0 += MB) {
        __syncthreads();
        for (int i = tid; i < MB * 256; i += NT) { const int tt = i >> 8, d = i & 255; const size_t tg = (size_t)b * SEQ + t0 + tt;
            sq[tt * 256 + d] = q[tg * 1024 + h * 256 + d]; sk[tt * 256 + d] = k[tg * 1024 + h * 256 + d]; sv[tt * 256 + d] = vv[tg * 1024 + h * 256 + d]; }
        if (tid < MB) { const size_t tg = (size_t)b * SEQ + t0 + tid; si[tid] = gif[tg * 8 + h]; sf[tid] = gif[tg * 8 + 4 + h]; }
        __syncthreads();
        for (int tt = 0; tt < MB; ++tt) {
            const float ip = si[tt], fp = sf[tt];
            const float lf = fminf(fp, 0.f) - log1pf(expf(-fabsf(fp)));
            const float mn = fmaxf(lf + m, ip);
            const float fd = expf(lf + m - mn), iw = expf(ip - mn);
            m = mn;
            const float ve = sv[tt * 256 + e] * iw;
            float num = 0.f, den = 0.f;
#pragma unroll
            for (int j = 0; j < 64; ++j) { const float kk = sk[tt * 256 + dq * 64 + j]; C[j] = fd * C[j] + ve * kk; num += C[j] * sq[tt * 256 + dq * 64 + j]; }
#pragma unroll
            for (int j = 0; j < 16; ++j) { const int d = dq * 64 + nsub + j; n[j] = fd * n[j] + iw * sk[tt * 256 + d]; den += n[j] * sq[tt * 256 + d]; }
            num += __shfl_xor(num, 1); num += __shfl_xor(num, 2);
            den += __shfl_xor(den, 1); den += __shfl_xor(den, 2); den += __shfl_xor(den, 4); den += __shfl_xor(den, 8);
            if (dq == 0) { const float dn = fmaxf(fabsf(den), expf(-mn)); hm[((size_t)b * SEQ + t0 + tt) * 1024 + h * 256 + e] = num / dn; }
        }
    }
    __syncthreads();
}
__device__ __forceinline__ void ph_hnorm(float* hm, const float* opre, const float* gain) {
    const int lane = tidf() & 63, gw = blockIdx.x * NW + (tidf() >> 6), ngw = gridDim.x * NW;
    for (int w = gw; w < T * 4; w += ngw) {
        const int tg = w >> 2, h = w & 3;
        float v[4]; float s = 0.f;
#pragma unroll
        for (int j = 0; j < 4; ++j) { v[j] = hm[(size_t)tg * 1024 + h * 256 + lane + 64 * j]; s += v[j]; }
        const float mu = wsum(s) * (1.f / 256); float qq = 0.f;
#pragma unroll
        for (int j = 0; j < 4; ++j) { const float d = v[j] - mu; qq += d * d; }
        const float rstd = rsqrtf(wsum(qq) * (1.f / 256) + LN_EPS);
#pragma unroll
        for (int j = 0; j < 4; ++j) { const int c = h * 256 + lane + 64 * j; hm[(size_t)tg * 1024 + c] = (v[j] - mu) * rstd * gain[c] * sigmoidf_(opre[(size_t)tg * 1024 + c]); }
    }
}
__device__ __forceinline__ void ph_merge(const float* gates, const float* ypool, float* ymls) {
    const size_t gt = (size_t)blockIdx.x * NT + tidf(), ngt = (size_t)gridDim.x * NT;
    for (size_t i = gt; i < (size_t)T * 1024; i += ngt) {
        const int c = (int)(i % 1024); const size_t tg = i / 1024;
        const float g0 = sigmoidf_(gates[tg * 2048 + c]), g1 = sigmoidf_(gates[tg * 2048 + 1024 + c]);
        ymls[i] = g0 * ypool[i] + g1 * ymls[i];
    }
}
__device__ __forceinline__ void ph_router(const float* h1, const float* wr, const float* br, int* top_idx, float* top_gate, int* cnt) {
    const int lane = tidf() & 63, gw = blockIdx.x * NW + (tidf() >> 6), ngw = gridDim.x * NW;
    for (int tg = gw; tg < T; tg += ngw) {
        const int e = lane & 31, half = lane >> 5;
        float s = 0.f;
        for (int kk = 0; kk < 512; ++kk) { const int kx = half * 512 + kk; s += h1[(size_t)tg * D + kx] * wr[kx * NE + e]; }
        s += __shfl_xor(s, 32); s += br[e];
        float val = s; int idxs[4]; float vals[4];
#pragma unroll
        for (int r = 0; r < 4; ++r) {
            float bv = val; int bi = e;
#pragma unroll
            for (int o = 1; o < 32; o <<= 1) { const float ov = __shfl_xor(bv, o); const int oi = __shfl_xor(bi, o); if (ov > bv || (ov == bv && oi < bi)) { bv = ov; bi = oi; } }
            idxs[r] = bi; vals[r] = bv; if (e == bi) val = -INFINITY;
        }
        const float mx = vals[0]; float ex[4], se = 0.f;
#pragma unroll
        for (int r = 0; r < 4; ++r) { ex[r] = expf(vals[r] - mx); se += ex[r]; }
#pragma unroll
        for (int r = 0; r < 4; ++r) if (lane == r) { top_idx[tg * 4 + r] = idxs[r]; top_gate[tg * 4 + r] = ex[r] / se; atomicAdd(&cnt[idxs[r]], 1); }
    }
}
__device__ __forceinline__ void ph_place(const int* top_idx, const int* start, int* fill, int* row_tok, int* row_of) {
    const int gt = blockIdx.x * NT + tidf(), ngt = gridDim.x * NT;
    for (int i = gt; i < NA; i += ngt) { const int e = top_idx[i]; const int r = atomicAdd(&fill[e], 1); const int dest = start[e] + r; row_tok[dest] = i >> 2; row_of[i] = dest; }
}
__device__ __forceinline__ void ph_final(const float* h1, const float* Y, const int* row_of, const float* gate, const float* g, const float* beta, float* out) {
    const int lane = tidf() & 63, gw = blockIdx.x * NW + (tidf() >> 6), ngw = gridDim.x * NW;
    for (int tg = gw; tg < T; tg += ngw) {
        int ro[4]; float gt[4];
#pragma unroll
        for (int r = 0; r < 4; ++r) { ro[r] = row_of[tg * 4 + r]; gt[r] = gate[tg * 4 + r]; }
        float v[16]; float s = 0.f;
#pragma unroll
        for (int j = 0; j < 16; ++j) { const int c = lane + 64 * j; float x = ALPHA * h1[(size_t)tg * D + c];
#pragma unroll
            for (int r = 0; r < 4; ++r) x += gt[r] * Y[(size_t)ro[r] * 1024 + c];
            v[j] = x; s += x; }
        const float mu = wsum(s) * (1.f / D); float qq = 0.f;
#pragma unroll
        for (int j = 0; j < 16; ++j) { const float d = v[j] - mu; qq += d * d; }
        const float rstd = rsqrtf(wsum(qq) * (1.f / D) + LN_EPS);
#pragma unroll
        for (int j = 0; j < 16; ++j) { const int c = lane + 64 * j; out[(size_t)tg * D + c] = (v[j] - mu) * rstd * g[c] + beta[c]; }
    }
}


namespace pg {
typedef unsigned short bf16_t;
typedef short bf16x8 __attribute__((ext_vector_type(8)));
typedef float f32x4 __attribute__((ext_vector_type(4)));
typedef float f32x2 __attribute__((ext_vector_type(2)));
typedef unsigned u32x4 __attribute__((ext_vector_type(4)));
typedef unsigned u32x2 __attribute__((ext_vector_type(2)));
constexpr int BM = 256, BK = 64, HALF = 128, HTB = HALF * BK * 2, STAGE_BYTES = 8 * HTB, NXCD = 8, WGM = 8;
__host__ __device__ __forceinline__ int lds_byte(int r, int c) { const int st = (r >> 4) * 2 + (c >> 5), rr = r & 15, cc = c & 31, ob = rr * 64 + cc * 2; return st * 1024 + (ob ^ (((ob >> 9) & 1) << 5)); }
__host__ __device__ __forceinline__ void stage_rc(int b, int& R, int& C) { const int st = b / 1024, sb = b % 1024, swz = sb ^ (((sb >> 9) & 1) << 5); R = (st >> 1) * 16 + swz / 64; C = (st & 1) * 32 + (swz % 64) / 2; }
__host__ __device__ __forceinline__ int perm32(int rho) { const int n = rho >> 4, i = rho & 15; return 8 * (i >> 2) + 4 * n + (i & 3); }
__device__ __forceinline__ unsigned cvt_pk_bf16(float lo, float hi) { unsigned r; asm volatile("v_cvt_pk_bf16_f32 %0, %1, %2" : "=v"(r) : "v"(lo), "v"(hi)); return r; }

struct Unit { const char* A; const char* B; const int* rows; int nvalid; int pm, pn, g, aux; };

struct TileOrder {
    int nM, nN, per_g, nwg, G, c;
    __device__ __forceinline__ void init(int nM_, int nN_, int ng, int G_, int c_) { nM = nM_; nN = nN_; per_g = nM * nN; nwg = per_g * ng; G = G_; c = c_; }
    __device__ __forceinline__ bool tile(int i, int& g, int& pm, int& pn) const {
        const long L = (long)i * G + c; if (L >= nwg) return false;
        int wgid = (int)L; { const int q = nwg / NXCD, r = nwg % NXCD, xcd = wgid % NXCD, off = wgid / NXCD; wgid = (xcd < r ? xcd * (q + 1) : r * (q + 1) + (xcd - r) * q) + off; }
        g = wgid / per_g; wgid -= g * per_g;
        const int nig = WGM * nN, gid = wgid / nig, fm = gid * WGM, gsz = (nM - fm) < WGM ? (nM - fm) : WGM;
        pm = fm + ((wgid % nig) % gsz); pn = (wgid % nig) / gsz; return true;
    }
};

template <class Epi, class Sched, bool GATHER = false>
__device__ __forceinline__ void gemm_phase(LAS unsigned char* lds, const int lda, const int ldb, const int K, const Sched& S, const Epi& E) {
    const int tid = tidf(), wid = __builtin_amdgcn_readfirstlane(tid >> 6), lane = tid & 63, wr = wid >> 2, wc = wid & 3, fr = lane & 15, fq = lane >> 4;
    const int nt = K / BK;
    unsigned voffA[2], voffB[2]; int Rst[2], Cst[2];
#pragma unroll
    for (int i = 0; i < 2; ++i) { int R, C; stage_rc(tid * 16 + i * 8192, R, C); const int Rb = Epi::PERM ? ((R & ~31) + perm32(R & 31)) : R;
        Rst[i] = R; Cst[i] = C; voffA[i] = (unsigned)(R * lda + C) * 2u; voffB[i] = (unsigned)(Rb * ldb + C) * 2u; }
    const size_t kstep = (size_t)(BK * 2);
    const size_t hstepA = GATHER ? 0 : (size_t)HALF * lda * 2, hstepB = (size_t)HALF * ldb * 2;
    const unsigned ldsw = (unsigned)wid * 1024u;
    const int aoff = lds_byte(wr * 64 + fr, fq * 8), boff = lds_byte(wc * 32 + fr, fq * 8);
#define PG_SA(b, h) (((b) * 2 + (h)) * HTB)
#define PG_SB(b, h) ((4 + (b) * 2 + (h)) * HTB)
#define PG_STAGE(bufoff, gbase, voff) do { _Pragma("unroll") for (int _i = 0; _i < 2; ++_i) \
        __builtin_amdgcn_global_load_lds((const unsigned*)((const char*)(gbase) + (voff)[_i]), (LAS unsigned*)(lds + (bufoff) + ldsw + _i * 8192), 16, 0, 0); } while (0)
#define PG_LDA(dst, b, h) do { _Pragma("unroll") for (int m = 0; m < 4; ++m) _Pragma("unroll") for (int k = 0; k < 2; ++k) dst[m][k] = *(const LAS bf16x8*)(lds + PG_SA(b, h) + aoff + m * 2048 + k * 1024); } while (0)
#define PG_LDB(dst, b, h) do { _Pragma("unroll") for (int n = 0; n < 2; ++n) _Pragma("unroll") for (int k = 0; k < 2; ++k) dst[n][k] = *(const LAS bf16x8*)(lds + PG_SB(b, h) + boff + n * 2048 + k * 1024); } while (0)
#define PG_MMA(ai, bj, At, Bt) do { __builtin_amdgcn_s_setprio(1); _Pragma("unroll") for (int m = 0; m < 4; ++m) _Pragma("unroll") for (int n = 0; n < 2; ++n) _Pragma("unroll") for (int k = 0; k < 2; ++k) \
        acc[ai][bj][m][n] = __builtin_amdgcn_mfma_f32_16x16x32_bf16(Bt[n][k], At[m][k], acc[ai][bj][m][n], 0, 0, 0); __builtin_amdgcn_s_setprio(0); } while (0)
#define PG_WAIT_V(n) asm volatile("s_waitcnt vmcnt(" #n ")" ::: "memory")
#define PG_WAIT_L(n) asm volatile("s_waitcnt lgkmcnt(" #n ")" ::: "memory")
#define PG_BAR __builtin_amdgcn_s_barrier()
#define PG_SCHED __builtin_amdgcn_sched_barrier(0)
    Unit cur, nxt; int ui = 0;
    if (!S.next(0, cur)) return;
    f32x4 acc[2][2][4][2];
#pragma unroll
    for (int a = 0; a < 2; ++a)
#pragma unroll
        for (int b = 0; b < 2; ++b)
#pragma unroll
            for (int m = 0; m < 4; ++m)
#pragma unroll
                for (int n = 0; n < 2; ++n) acc[a][b][m][n] = (f32x4){0.f, 0.f, 0.f, 0.f};
    bf16x8 At[4][2], B0[2][2], B1[2][2];
    unsigned gA0[2], gA1[2], nA0[2], nA1[2];
    auto gather_offs = [&](const Unit& u, unsigned (&o0)[2], unsigned (&o1)[2]) {
#pragma unroll
        for (int i = 0; i < 2; ++i) {
            const int r0 = Rst[i], r1 = HALF + Rst[i];
            const int t0 = (r0 < u.nvalid) ? u.rows[r0] : 0, t1 = (r1 < u.nvalid) ? u.rows[r1] : 0;
            o0[i] = (unsigned)(t0 * lda + Cst[i]) * 2u; o1[i] = (unsigned)(t1 * lda + Cst[i]) * 2u; }
    };
    if constexpr (GATHER) { gather_offs(cur, gA0, gA1); } else {
#pragma unroll
        for (int i = 0; i < 2; ++i) { gA0[i] = voffA[i]; gA1[i] = voffA[i]; nA0[i] = voffA[i]; nA1[i] = voffA[i]; } }
    const char* cA = cur.A; const char* cB = cur.B;
    PG_STAGE(PG_SB(0, 0), cB, voffB); PG_STAGE(PG_SB(0, 1), cB + hstepB, voffB); PG_STAGE(PG_SA(0, 0), cA, gA0); PG_STAGE(PG_SA(0, 1), cA + hstepA, gA1);
    if (wr == 1) PG_BAR;
    PG_WAIT_V(2); PG_BAR;
    PG_STAGE(PG_SB(1, 0), cB + kstep, voffB); PG_STAGE(PG_SA(1, 0), cA + kstep, gA0); PG_STAGE(PG_SB(1, 1), cB + hstepB + kstep, voffB);
    PG_WAIT_V(6); PG_BAR;
    for (;;) {
        const bool has_next = S.next(ui + 1, nxt);
        const char* nA = has_next ? nxt.A : cA; const char* nB = has_next ? nxt.B : cB;
        if constexpr (GATHER) { if (has_next) gather_offs(nxt, nA0, nA1); else {
#pragma unroll
            for (int i = 0; i < 2; ++i) { nA0[i] = gA0[i]; nA1[i] = gA1[i]; } } }
#pragma unroll 1
        for (int t = 0; t < nt; t += 2) {
            const bool last = (t == nt - 2);
            const char* a1 = cA + (size_t)(t + 1) * kstep;
            const char* a2 = last ? nA : cA + (size_t)(t + 2) * kstep; const char* b2 = last ? nB : cB + (size_t)(t + 2) * kstep;
            const char* a3 = a2 + kstep; const char* b3 = b2 + kstep;
            unsigned x0[2], x1[2];
#pragma unroll
            for (int i = 0; i < 2; ++i) { x0[i] = (GATHER && last) ? nA0[i] : gA0[i]; x1[i] = (GATHER && last) ? nA1[i] : gA1[i]; }
            PG_LDB(B0, 0, 0); PG_LDB(B1, 0, 1); PG_SCHED; PG_LDA(At, 0, 0); PG_STAGE(PG_SA(1, 1), a1 + hstepA, gA1);
            PG_WAIT_V(8); PG_WAIT_L(0); PG_BAR; PG_MMA(0, 0, At, B0); PG_MMA(0, 1, At, B1); PG_BAR; PG_SCHED;
            PG_LDA(At, 0, 1); PG_STAGE(PG_SB(0, 0), b2, voffB); PG_STAGE(PG_SB(0, 1), b2 + hstepB, voffB); PG_STAGE(PG_SA(0, 0), a2, x0);
            PG_WAIT_V(8); PG_WAIT_L(0); PG_BAR; PG_MMA(1, 0, At, B0); PG_MMA(1, 1, At, B1); PG_BAR; PG_SCHED;
            PG_LDB(B0, 1, 0); PG_LDB(B1, 1, 1); PG_SCHED; PG_LDA(At, 1, 0); PG_STAGE(PG_SA(0, 1), a2 + hstepA, x1);
            PG_WAIT_V(8); PG_WAIT_L(0); PG_BAR; PG_MMA(0, 0, At, B0); PG_MMA(0, 1, At, B1); PG_BAR; PG_SCHED;
            PG_LDA(At, 1, 1); PG_STAGE(PG_SB(1, 0), b3, voffB); PG_STAGE(PG_SB(1, 1), b3 + hstepB, voffB); PG_STAGE(PG_SA(1, 0), a3, x0);
            PG_WAIT_V(8); PG_WAIT_L(0); PG_BAR; PG_MMA(1, 0, At, B0); PG_MMA(1, 1, At, B1); PG_BAR; PG_SCHED;
        }
        if (wr == 0) PG_BAR;
        if constexpr (!Epi::AFTER_DRAIN) { E(acc, cur, wr, wc, fr, fq); }
        if (!has_next) break;
#pragma unroll
        for (int a = 0; a < 2; ++a)
#pragma unroll
            for (int b = 0; b < 2; ++b)
#pragma unroll
                for (int m = 0; m < 4; ++m)
#pragma unroll
                    for (int n = 0; n < 2; ++n) acc[a][b][m][n] = (f32x4){0.f, 0.f, 0.f, 0.f};
        cur = nxt; cA = nA; cB = nB; ++ui;
        if constexpr (GATHER) {
#pragma unroll
            for (int i = 0; i < 2; ++i) { gA0[i] = nA0[i]; gA1[i] = nA1[i]; } }
        if (wr == 1) PG_BAR;
    }
    PG_WAIT_V(0);
    PG_BAR;
    if constexpr (Epi::AFTER_DRAIN) { E.fused(acc, cur, wr, wc, fr, fq, lds, wid, lane); }
#undef PG_SA
#undef PG_SB
#undef PG_STAGE
#undef PG_LDA
#undef PG_LDB
#undef PG_MMA
#undef PG_WAIT_V
#undef PG_WAIT_L
#undef PG_BAR
#undef PG_SCHED
}

struct EpiStoreBf16 {
    static constexpr bool PERM = true, AFTER_DRAIN = false;
    bf16_t* O; int ldc; float scale; int gcol;
    __device__ __forceinline__ void operator()(const f32x4 (&acc)[2][2][4][2], const Unit& u, int wr, int wc, int fr, int fq) const {
        bf16_t* base = O + (size_t)(u.pm * BM + wr * 64 + fr) * ldc + u.g * gcol + u.pn * BM + wc * 32 + 8 * fq;
#pragma unroll
        for (int ai = 0; ai < 2; ++ai)
#pragma unroll
            for (int m = 0; m < 4; ++m) { bf16_t* rowp = base + (size_t)(ai * HALF + m * 16) * ldc;
#pragma unroll
                for (int bj = 0; bj < 2; ++bj) { const f32x4 v0 = acc[ai][bj][m][0] * scale, v1 = acc[ai][bj][m][1] * scale;
                    u32x4 w; w.x = cvt_pk_bf16(v0[0], v0[1]); w.y = cvt_pk_bf16(v0[2], v0[3]); w.z = cvt_pk_bf16(v1[0], v1[1]); w.w = cvt_pk_bf16(v1[2], v1[3]);
                    *(u32x4*)(rowp + bj * HALF) = w; } }
    }
};
}

constexpr int PROJW = 4608;
constexpr int PJ_P = 0, PJ_U = 512, PJ_O = 1536, PJ_G = 2560;
constexpr int WIN_ROWS = 5632;

__device__ __forceinline__ unsigned f2bf(float f) { unsigned u = __builtin_bit_cast(unsigned, f); return (u + 0x7fffu + ((u >> 16) & 1u)) >> 16; }
__device__ __forceinline__ unsigned pk2(float lo, float hi) { return f2bf(lo) | (f2bf(hi) << 16); }
__device__ __forceinline__ float bf2f(unsigned short b) { return __builtin_bit_cast(float, (unsigned)b << 16); }

__device__ __forceinline__ void transpose_item(const float* W, int ldw, int k0, int n0, int ns, pg::bf16_t* WT, size_t drow0, int ldt, LAS float* scr, int lane) {
#pragma unroll 8
    for (int i = 0; i < 32; ++i) { const int kk = 2 * i + (lane >> 5); scr[kk * 33 + (lane & 31)] = W[(size_t)(k0 + kk) * ldw + n0 + ns * (lane & 31)]; }
    asm volatile("s_waitcnt lgkmcnt(0)" ::: "memory");
    const int c = lane & 7;
#pragma unroll
    for (int j = 0; j < 4; ++j) { const int n = (lane >> 3) + 8 * j; const LAS float* s = scr + (8 * c) * 33 + n;
        pg::u32x4 o; o.x = pk2(s[0 * 33], s[1 * 33]); o.y = pk2(s[2 * 33], s[3 * 33]); o.z = pk2(s[4 * 33], s[5 * 33]); o.w = pk2(s[6 * 33], s[7 * 33]);
        *(pg::u32x4*)(WT + (drow0 + n) * ldt + k0 + 8 * c) = o; }
    asm volatile("s_waitcnt lgkmcnt(0)" ::: "memory");
}
__device__ __forceinline__ int win_src_col(int r) { return r < 1536 ? r : (r < 2560 ? r + 1024 : (r < 4608 ? r - 2560 + C_G : r - 4608 + C_V)); }

struct OptBufs {
    pg::bf16_t *WinT, *H0B, *PROJ, *BT2;
    float *gif, *stats;
};
__device__ __forceinline__ void ph_prep_weights(LAS unsigned char* lds, const OptBufs& o, const float* w_in) {
    const int lane = tidf() & 63, wave = tidf() >> 6, gw = blockIdx.x * NW + wave, ngw = gridDim.x * NW;
    LAS float* scr = (LAS float*)(lds + wave * 16384);
    constexpr int I_IN = (WIN_ROWS / 32) * (D / 64);
    for (int it = gw; it < I_IN; it += ngw) { const int rb = it / (D / 64), kb = it % (D / 64);
        transpose_item(w_in, INC, kb * 64, win_src_col(rb * 32), 1, o.WinT, (size_t)rb * 32, D, scr, lane); }
}
__device__ __forceinline__ void ph_ln0(LAS unsigned char* lds, const OptBufs& o, const float* x, const float* g, const float* beta, const float* w_in, const float* b_if) {
    const int tid = tidf(), lane = tid & 63, wave = tid >> 6, gw = blockIdx.x * NW + wave, ngw = gridDim.x * NW;
    LAS float* wif = (LAS float*)lds;
    __syncthreads();
    for (int i = tid; i < 1024 * 8; i += NT) wif[i] = w_in[(size_t)(i >> 3) * INC + C_IF + (i & 7)];
    __syncthreads();
    for (int row = gw; row < T; row += ngw) {
        const pg::f32x4* xr = (const pg::f32x4*)(x + (size_t)row * D) + lane;
        pg::f32x4 v[4]; float s = 0.f;
#pragma unroll
        for (int j = 0; j < 4; ++j) { v[j] = xr[64 * j]; s += (v[j].x + v[j].y) + (v[j].z + v[j].w); }
        const float mean = wsum(s) * (1.f / D); float s2 = 0.f;
#pragma unroll
        for (int j = 0; j < 4; ++j) { v[j] = v[j] - mean; s2 += (v[j].x * v[j].x + v[j].y * v[j].y) + (v[j].z * v[j].z + v[j].w * v[j].w); }
        const float rstd = rsqrtf(wsum(s2) * (1.f / D) + LN_EPS);
        float acc8[8];
#pragma unroll
        for (int q = 0; q < 8; ++q) acc8[q] = 0.f;
        unsigned long long* o8 = (unsigned long long*)(o.H0B + (size_t)row * D) + lane;
#pragma unroll
        for (int j = 0; j < 4; ++j) {
            const int c0 = 256 * j + 4 * lane;
            const pg::f32x4 gg = *(const pg::f32x4*)(g + c0), bb = *(const pg::f32x4*)(beta + c0);
            const pg::f32x4 y = v[j] * rstd * gg + bb;
            o8[64 * j] = (unsigned long long)pk2(y.x, y.y) | ((unsigned long long)pk2(y.z, y.w) << 32);
#pragma unroll
            for (int i = 0; i < 4; ++i) { const LAS float* wr_ = wif + (c0 + i) * 8;
#pragma unroll
                for (int q = 0; q < 8; ++q) acc8[q] += y[i] * wr_[q]; }
        }
#pragma unroll
        for (int q = 0; q < 8; ++q) acc8[q] = wsum(acc8[q]);
        if (lane < 8) { float r = acc8[0];
#pragma unroll
            for (int q = 1; q < 8; ++q) r = (lane == q) ? acc8[q] : r;
            o.gif[(size_t)row * 8 + lane] = r + b_if[lane]; }
        if (lane == 0) { o.stats[(size_t)row * 2] = mean; o.stats[(size_t)row * 2 + 1] = rstd; }
    }
    __syncthreads();
}
struct SchedInproj {
    pg::TileOrder o; const char* A; const char* B;
    __device__ __forceinline__ bool next(int i, pg::Unit& u) const { int g, pm, pn; if (!o.tile(i, g, pm, pn)) return false;
        u.A = A + (size_t)pm * 256 * D * 2; u.B = B + (size_t)pn * 256 * D * 2; u.pm = pm; u.pn = pn; u.g = 0; u.aux = 0; u.rows = nullptr; u.nvalid = 0; return true; }
};
struct SchedVT {
    pg::TileOrder o; const char* A; const char* B;
    __device__ __forceinline__ bool next(int i, pg::Unit& u) const { int g, pm, pn; if (!o.tile(i, g, pm, pn)) return false;
        u.A = A + (size_t)pm * 256 * D * 2; u.B = B + (size_t)pn * 256 * D * 2; u.pm = pm; u.pn = pn; u.g = 0; u.aux = 0; u.rows = nullptr; u.nvalid = 0; return true; }
};
struct EpiVT {
    static constexpr bool PERM = true, AFTER_DRAIN = false;
    pg::bf16_t* BT2;
    __device__ __forceinline__ void operator()(const pg::f32x4 (&acc)[2][2][4][2], const pg::Unit& u, int wr, int wc, int fr, int fq) const {
        const int h = u.pm, b = u.pn >> 4, c = u.pn & 15;
        pg::bf16_t* base = BT2 + ((size_t)((b * 4 + h) * 16 + c) * 256 + wr * 64 + fr) * 512 + wc * 32 + 8 * fq;
#pragma unroll
        for (int ai = 0; ai < 2; ++ai)
#pragma unroll
            for (int m = 0; m < 4; ++m) { pg::bf16_t* rowp = base + (size_t)(ai * 128 + m * 16) * 512;
#pragma unroll
                for (int bj = 0; bj < 2; ++bj) { const pg::f32x4 v0 = acc[ai][bj][m][0], v1 = acc[ai][bj][m][1];
                    pg::u32x4 w; w.x = pg::cvt_pk_bf16(v0[0], v0[1]); w.y = pg::cvt_pk_bf16(v0[2], v0[3]); w.z = pg::cvt_pk_bf16(v1[0], v1[1]); w.w = pg::cvt_pk_bf16(v1[2], v1[3]);
                    *(pg::u32x4*)(rowp + bj * 128) = w; } }
    }
};
__device__ __forceinline__ void ph_inproj(LAS unsigned char* lds, const OptBufs& o) {
    const int G = gridDim.x, bx = blockIdx.x;
    { SchedInproj S; S.o.init(T / 256, PROJW / 256, 1, G, bx); S.A = (const char*)o.H0B; S.B = (const char*)o.WinT;
      pg::EpiStoreBf16 E{o.PROJ, PROJW, 1.f, 0}; pg::gemm_phase<pg::EpiStoreBf16, SchedInproj>(lds, D, D, D, S, E); }
    { SchedVT S; S.o.init(4, T / 256, 1, G, (bx + 128) % G); S.A = (const char*)(o.WinT + (size_t)PROJW * D); S.B = (const char*)o.H0B;
      EpiVT E{o.BT2}; pg::gemm_phase<EpiVT, SchedVT>(lds, D, D, D, S, E); }
}

struct OptBufs2 { pg::bf16_t *WqT, *WkT, *WpoolT, *WbpT, *POOLED, *UC, *MIXED, *Q, *K, *YPOOL; };
__device__ __forceinline__ void ph_prep_weights2(LAS unsigned char* lds, const OptBufs2& o, const float* w_q, const float* w_k, const float* w_pool, const float* w_bp) {
    const int lane = tidf() & 63, wave = tidf() >> 6, gw = blockIdx.x * NW + wave, ngw = gridDim.x * NW;
    LAS float* scr = (LAS float*)(lds + wave * 16384);
    for (int it = gw; it < 2 * 4 * 32; it += ngw) { const int which = it >> 7, r = it & 127, h = r >> 5, nb = (r & 31) >> 2, kb = r & 3;
        transpose_item((which ? w_k : w_q) + (size_t)h * 65536, 256, kb * 64, nb * 32, 1, (which ? o.WkT : o.WqT) + (size_t)h * 65536, (size_t)nb * 32, 256, scr, lane); }
    for (int it = gw; it < 4 * 4 * 2; it += ngw) { const int g = it >> 3, nb = (it & 7) >> 1, kb = it & 1;
        transpose_item(w_pool + (size_t)g * 16384, 128, kb * 64, nb * 32, 1, o.WpoolT + g * 128, (size_t)g * 128 + nb * 32, 512, scr, lane); }
    { const size_t gt = (size_t)blockIdx.x * NT + tidf(), ngt = (size_t)gridDim.x * NT;
      for (size_t ch = gt; ch < 512 * 64; ch += ngt) { const int n = (int)(ch >> 6), k8 = (int)(ch & 63) * 8; if ((n >> 7) != (k8 >> 7)) *(pg::u32x4*)(o.WpoolT + (size_t)n * 512 + k8) = (pg::u32x4){0u, 0u, 0u, 0u}; } }
    for (int it = gw; it < 32 * 8; it += ngw) { const int nb = it >> 3, kb = it & 7;
        transpose_item(w_bp, 1024, kb * 64, nb * 32, 1, o.WbpT, (size_t)nb * 32, 512, scr, lane); }
}
__device__ __forceinline__ void ld8(const pg::bf16_t* p, float (&v)[8]) { const pg::u32x4 w = *(const pg::u32x4*)p;
    v[0] = __builtin_bit_cast(float, w.x << 16); v[1] = __builtin_bit_cast(float, w.x & 0xffff0000u); v[2] = __builtin_bit_cast(float, w.y << 16); v[3] = __builtin_bit_cast(float, w.y & 0xffff0000u);
    v[4] = __builtin_bit_cast(float, w.z << 16); v[5] = __builtin_bit_cast(float, w.z & 0xffff0000u); v[6] = __builtin_bit_cast(float, w.w << 16); v[7] = __builtin_bit_cast(float, w.w & 0xffff0000u); }
__device__ __forceinline__ void st8(pg::bf16_t* p, const float (&v)[8]) { pg::u32x4 w; w.x = pk2(v[0], v[1]); w.y = pk2(v[2], v[3]); w.z = pk2(v[4], v[5]); w.w = pk2(v[6], v[7]); *(pg::u32x4*)p = w; }
__device__ __forceinline__ void ph_poolconv_opt(const pg::bf16_t* PROJ, const float* cw, const float* cb, pg::bf16_t* POOLED, pg::bf16_t* UC) {
    const int gt = blockIdx.x * NT + tidf(), ngt = gridDim.x * NT;
    for (int it = gt; it < 512 * 192; it += ngt) {
        const int run = it / 192, oc = it % 192; const int t0 = run * 32, tpos0 = t0 & (SEQ - 1);
        if (oc < 64) {
            const int c0 = oc * 8, w = 2 << (c0 >> 7);
            float s[8];
#pragma unroll
            for (int q = 0; q < 8; ++q) s[q] = 0.f;
            for (int j = 1; j < w; ++j) if (tpos0 - j >= 0) { float v[8]; ld8(PROJ + (size_t)(t0 - j) * PROJW + PJ_P + c0, v);
#pragma unroll
                for (int q = 0; q < 8; ++q) s[q] += v[q]; }
            for (int i = 0; i < 32; ++i) { const int t = t0 + i, tp = tpos0 + i; float cur[8], o[8]; ld8(PROJ + (size_t)t * PROJW + PJ_P + c0, cur);
                const float inv = 1.f / (float)((tp + 1 < w) ? tp + 1 : w);
#pragma unroll
                for (int q = 0; q < 8; ++q) { s[q] += cur[q]; o[q] = s[q] * inv - cur[q]; }
                st8(POOLED + (size_t)t * 512 + c0, o);
                if (tp - w + 1 >= 0) { float old[8]; ld8(PROJ + (size_t)(t - w + 1) * PROJW + PJ_P + c0, old);
#pragma unroll
                    for (int q = 0; q < 8; ++q) s[q] -= old[q]; } }
        } else {
            const int c0 = (oc - 64) * 8;
            float w0[8], w1[8], w2[8], w3[8], bb[8], u0[8], u1[8], u2[8];
#pragma unroll
            for (int q = 0; q < 8; ++q) { w0[q] = cw[c0 + q]; w1[q] = cw[1024 + c0 + q]; w2[q] = cw[2048 + c0 + q]; w3[q] = cw[3072 + c0 + q]; bb[q] = cb[c0 + q]; u0[q] = 0.f; u1[q] = 0.f; u2[q] = 0.f; }
            if (tpos0 >= 3) ld8(PROJ + (size_t)(t0 - 3) * PROJW + PJ_U + c0, u0);
            if (tpos0 >= 2) ld8(PROJ + (size_t)(t0 - 2) * PROJW + PJ_U + c0, u1);
            if (tpos0 >= 1) ld8(PROJ + (size_t)(t0 - 1) * PROJW + PJ_U + c0, u2);
            for (int i = 0; i < 32; ++i) { const int t = t0 + i; float u3[8], o[8]; ld8(PROJ + (size_t)t * PROJW + PJ_U + c0, u3);
#pragma unroll
                for (int q = 0; q < 8; ++q) { const float y = bb[q] + w0[q] * u0[q] + w1[q] * u1[q] + w2[q] * u2[q] + w3[q] * u3[q]; o[q] = y * sigmoidf_(y); u0[q] = u1[q]; u1[q] = u2[q]; u2[q] = u3[q]; }
                st8(UC + (size_t)t * 1024 + c0, o); }
        }
    }
}
struct SchedG {
    pg::TileOrder o; const char* A; const char* B; size_t gA, gB, tA, tB;
    __device__ __forceinline__ bool next(int i, pg::Unit& u) const { int g, pm, pn; if (!o.tile(i, g, pm, pn)) return false;
        u.A = A + g * gA + pm * tA; u.B = B + g * gB + pn * tB; u.pm = pm; u.pn = pn; u.g = g; u.aux = 0; u.rows = nullptr; u.nvalid = 0; return true; }
};
struct EpiPoolMixB {
    static constexpr bool PERM = true, AFTER_DRAIN = false;
    pg::bf16_t* O; const float* b; const float* ls;
    __device__ __forceinline__ void operator()(const pg::f32x4 (&acc)[2][2][4][2], const pg::Unit& u, int wr, int wc, int fr, int fq) const {
        const int col0 = u.pn * 256 + wc * 32 + 8 * fq;
        pg::bf16_t* base = O + (size_t)(u.pm * 256 + wr * 64 + fr) * 512 + col0;
        pg::f32x4 bv[2][2], lv[2][2];
#pragma unroll
        for (int bj = 0; bj < 2; ++bj)
#pragma unroll
            for (int n = 0; n < 2; ++n) { bv[bj][n] = *(const pg::f32x4*)(b + col0 + bj * 128 + 4 * n); lv[bj][n] = *(const pg::f32x4*)(ls + col0 + bj * 128 + 4 * n); }
#pragma unroll
        for (int ai = 0; ai < 2; ++ai)
#pragma unroll
            for (int m = 0; m < 4; ++m) { pg::bf16_t* rowp = base + (size_t)(ai * 128 + m * 16) * 512;
#pragma unroll
                for (int bj = 0; bj < 2; ++bj) { const pg::f32x4 v0 = (acc[ai][bj][m][0] + bv[bj][0]) * lv[bj][0], v1 = (acc[ai][bj][m][1] + bv[bj][1]) * lv[bj][1];
                    pg::u32x4 w; w.x = pg::cvt_pk_bf16(v0[0], v0[1]); w.y = pg::cvt_pk_bf16(v0[2], v0[3]); w.z = pg::cvt_pk_bf16(v1[0], v1[1]); w.w = pg::cvt_pk_bf16(v1[2], v1[3]);
                    *(pg::u32x4*)(rowp + bj * 128) = w; } }
    }
};
__device__ __forceinline__ void cvt_bf16_f32(const pg::bf16_t* src, size_t lds_, int cols, float* dst, size_t rows) {
    const size_t gt = (size_t)blockIdx.x * NT + tidf(), ngt = (size_t)gridDim.x * NT;
    for (size_t i = gt; i < rows * cols; i += ngt) { const size_t r = i / cols; const int c = (int)(i % cols); dst[i] = bf2f(src[r * lds_ + c]); }
}
__device__ __forceinline__ void ph_adapt_v(const OptBufs& o, float* vv) {
    const size_t gt = (size_t)blockIdx.x * NT + tidf(), ngt = (size_t)gridDim.x * NT;
    for (size_t i = gt; i < (size_t)T * 1024; i += ngt) { const int t = (int)(i >> 10), e = (int)(i & 1023), h = e >> 8, el = e & 255, b = t >> 12, cc = (t & 4095) >> 8, tl = t & 255;
        vv[i] = bf2f(o.BT2[((size_t)((b * 4 + h) * 16 + cc) * 256 + el) * 512 + tl]); }
}


struct OptBufs3 { pg::bf16_t *KaT, *A2, *HOUT; float *U, *rowv, *colv, *winter, *aw, *emt, *den, *un, *decay; };
__device__ __forceinline__ float log_sigmoidf_(float x) { return fminf(x, 0.f) - log1pf(expf(-fabsf(x))); }
__device__ __forceinline__ void scalar_scan_wave(int bh, const float* gif, const OptBufs3& o, int lane) {
    const int b = bh >> 2, h = bh & 3;
    float mc = 0.f;
    for (int c = 0; c < 16; ++c) {
        float bt[4], ip[4], mt[4];
        float bcarry = 0.f, pmcarry = -INFINITY;
#pragma unroll
        for (int sub = 0; sub < 4; ++sub) {
            const size_t t = (size_t)b * SEQ + c * 256 + sub * 64 + lane;
            const float i_ = gif[t * 8 + h], f_ = gif[t * 8 + 4 + h];
            float bs = log_sigmoidf_(f_);
#pragma unroll
            for (int off = 1; off < 64; off <<= 1) { const float v = __shfl_up(bs, off); if (lane >= off) bs += v; }
            const float bb = bcarry + bs;
            float pm = i_ - bb;
#pragma unroll
            for (int off = 1; off < 64; off <<= 1) { const float v = __shfl_up(pm, off); if (lane >= off) pm = fmaxf(pm, v); }
            pm = fmaxf(pm, pmcarry);
            bt[sub] = bb; ip[sub] = i_; mt[sub] = bb + fmaxf(mc, pm);
            bcarry = __shfl(bb, 63); pmcarry = __shfl(pm, 63);
        }
        const float Gc = bcarry, mnext = __shfl(mt[3], 63);
#pragma unroll
        for (int sub = 0; sub < 4; ++sub) {
            const size_t idx = ((size_t)b * SEQ + c * 256 + sub * 64 + lane) * 4 + h;
            o.rowv[idx] = bt[sub] - mt[sub]; o.colv[idx] = ip[sub] - bt[sub];
            o.winter[idx] = expf(bt[sub] + mc - mt[sub]); o.aw[idx] = expf(Gc - bt[sub] + ip[sub] - mnext); o.emt[idx] = expf(-mt[sub]);
        }
        if (lane == 0) o.decay[bh * 16 + c] = expf(Gc + mc - mnext);
        mc = mnext;
    }
}
struct EpiQ {
    static constexpr bool PERM = true, AFTER_DRAIN = false;
    pg::bf16_t* Q; pg::bf16_t* A2; const float* winter;
    __device__ __forceinline__ void operator()(const pg::f32x4 (&acc)[2][2][4][2], const pg::Unit& u, int wr, int wc, int fr, int fq) const {
        const int h = u.g, col0 = wc * 32 + 8 * fq;
#pragma unroll
        for (int ai = 0; ai < 2; ++ai)
#pragma unroll
            for (int m = 0; m < 4; ++m) { const size_t t = (size_t)u.pm * 256 + ai * 128 + wr * 64 + m * 16 + fr; const float wi = winter[t * 4 + h];
#pragma unroll
                for (int bj = 0; bj < 2; ++bj) { const pg::f32x4 v0 = acc[ai][bj][m][0] * 0.0625f, v1 = acc[ai][bj][m][1] * 0.0625f;
                    pg::u32x4 w; w.x = pg::cvt_pk_bf16(v0[0], v0[1]); w.y = pg::cvt_pk_bf16(v0[2], v0[3]); w.z = pg::cvt_pk_bf16(v1[0], v1[1]); w.w = pg::cvt_pk_bf16(v1[2], v1[3]);
                    *(pg::u32x4*)(Q + t * 1024 + h * 256 + col0 + bj * 128) = w;
                    const pg::f32x4 x0 = v0 * wi, x1 = v1 * wi;
                    pg::u32x4 y; y.x = pg::cvt_pk_bf16(x0[0], x0[1]); y.y = pg::cvt_pk_bf16(x0[2], x0[3]); y.z = pg::cvt_pk_bf16(x1[0], x1[1]); y.w = pg::cvt_pk_bf16(x1[2], x1[3]);
                    *(pg::u32x4*)(A2 + t * 2048 + h * 512 + 256 + col0 + bj * 128) = y; }
                asm volatile("" ::: "memory"); }
    }
};
struct EpiKT {
    static constexpr bool PERM = true, AFTER_DRAIN = false;
    pg::bf16_t* KaT; const float* aw;
    __device__ __forceinline__ void operator()(const pg::f32x4 (&acc)[2][2][4][2], const pg::Unit& u, int wr, int wc, int fr, int fq) const {
        const int h = u.g; const size_t t0 = (size_t)u.pn * 256 + wc * 32 + 8 * fq;
#pragma unroll
        for (int bj = 0; bj < 2; ++bj) {
            float a[8];
#pragma unroll
            for (int j = 0; j < 8; ++j) a[j] = aw[(t0 + bj * 128 + j) * 4 + h];
            pg::bf16_t* rowp = KaT + ((size_t)h * 256 + wr * 64 + fr) * T + t0 + bj * 128;
#pragma unroll
            for (int ai = 0; ai < 2; ++ai)
#pragma unroll
                for (int m = 0; m < 4; ++m) { const pg::f32x4 v0 = acc[ai][bj][m][0], v1 = acc[ai][bj][m][1];
                    pg::u32x4 w; w.x = pg::cvt_pk_bf16(v0[0] * a[0], v0[1] * a[1]); w.y = pg::cvt_pk_bf16(v0[2] * a[2], v0[3] * a[3]);
                    w.z = pg::cvt_pk_bf16(v1[0] * a[4], v1[1] * a[5]); w.w = pg::cvt_pk_bf16(v1[2] * a[6], v1[3] * a[7]);
                    *(pg::u32x4*)(rowp + (size_t)(ai * 128 + m * 16) * T) = w; asm volatile("" ::: "memory"); }
        }
    }
};
struct EpiS {
    static constexpr bool PERM = true, AFTER_DRAIN = false;
    pg::bf16_t* A2; const float* rowv; const float* colv; float* den;
    __device__ __forceinline__ void operator()(const pg::f32x4 (&acc)[2][2][4][2], const pg::Unit& u, int wr, int wc, int fr, int fq) const {
        const int bh = u.g >> 4, c = u.g & 15, b = bh >> 2, h = bh & 3; const size_t tok0 = (size_t)b * SEQ + c * 256;
        const int col0 = wc * 32 + 8 * fq;
        const float* cvp = colv + (tok0 + col0) * 4 + h;
#pragma unroll
        for (int ai = 0; ai < 2; ++ai)
#pragma unroll
            for (int m = 0; m < 4; ++m) { const int tl = ai * 128 + wr * 64 + m * 16 + fr; const float rv = rowv[(tok0 + tl) * 4 + h]; float rs = 0.f;
                pg::bf16_t* op = A2 + (tok0 + tl) * 2048 + h * 512 + col0;
#pragma unroll
                for (int bj = 0; bj < 2; ++bj) { float x[8];
#pragma unroll
                    for (int j = 0; j < 8; ++j) { const int sl = col0 + bj * 128 + j; const float a_ = (j < 4) ? acc[ai][bj][m][0][j] : acc[ai][bj][m][1][j - 4];
                        const float w_ = __expf(rv + cvp[(bj * 128 + j) * 4]); x[j] = (sl <= tl) ? a_ * w_ : 0.f; rs += x[j]; }
                    pg::u32x4 w; w.x = pg::cvt_pk_bf16(x[0], x[1]); w.y = pg::cvt_pk_bf16(x[2], x[3]); w.z = pg::cvt_pk_bf16(x[4], x[5]); w.w = pg::cvt_pk_bf16(x[6], x[7]);
                    *(pg::u32x4*)(op + bj * 128) = w; asm volatile("" ::: "memory"); }
                rs += __shfl_xor(rs, 16); rs += __shfl_xor(rs, 32);
                if (fq == 0) atomicAdd(den + (tok0 + tl) * 4 + h, rs);
                asm volatile("" ::: "memory"); }
    }
};
struct EpiF32U {
    static constexpr bool PERM = false, AFTER_DRAIN = false;
    float* C;
    __device__ __forceinline__ void operator()(const pg::f32x4 (&acc)[2][2][4][2], const pg::Unit& u, int wr, int wc, int fr, int fq) const {
        float* base = C + (size_t)u.aux * 65536 + (size_t)(wr * 64 + fr) * 256 + wc * 32 + 4 * fq;
#pragma unroll
        for (int ai = 0; ai < 2; ++ai)
#pragma unroll
            for (int m = 0; m < 4; ++m)
#pragma unroll
                for (int bj = 0; bj < 2; ++bj)
#pragma unroll
                    for (int n = 0; n < 2; ++n) { *(pg::f32x4*)(base + (size_t)(ai * 128 + m * 16) * 256 + bj * 128 + n * 16) = acc[ai][bj][m][n]; if (n) asm volatile("" ::: "memory"); }
    }
};
struct EpiNum {
    static constexpr bool PERM = true, AFTER_DRAIN = true;
    pg::bf16_t* HOUT; const pg::bf16_t* PROJ; const float* den; const float* emt; const float* gain;
    __device__ __forceinline__ void fused(pg::f32x4 (&acc)[2][2][4][2], const pg::Unit& u, int wr, int wc, int fr, int fq, LAS unsigned char* lds, int wid, int lane) const {
        const int bh = u.g >> 4, c = u.g & 15, b = bh >> 2, h = bh & 3; const size_t tok0 = (size_t)b * SEQ + c * 256;
        LAS pg::f32x2* P = (LAS pg::f32x2*)lds; LAS pg::f32x2* Sx = (LAS pg::f32x2*)(lds + 8192);
#pragma unroll
        for (int ai = 0; ai < 2; ++ai)
#pragma unroll
            for (int m = 0; m < 4; ++m) { const int tl = ai * 128 + wr * 64 + m * 16 + fr; const size_t ti = (tok0 + tl) * 4 + h;
                const float inv = 1.f / fmaxf(fabsf(den[ti]), emt[ti]); float s = 0.f;
#pragma unroll
                for (int bj = 0; bj < 2; ++bj)
#pragma unroll
                    for (int n = 0; n < 2; ++n) { acc[ai][bj][m][n] = acc[ai][bj][m][n] * inv; const pg::f32x4 x = acc[ai][bj][m][n]; s += (x[0] + x[1]) + (x[2] + x[3]); }
                s += __shfl_xor(s, 16); s += __shfl_xor(s, 32);
                const float mw = s * (1.f / 64.f); float q = 0.f;
#pragma unroll
                for (int bj = 0; bj < 2; ++bj)
#pragma unroll
                    for (int n = 0; n < 2; ++n) { const pg::f32x4 d = acc[ai][bj][m][n] - mw; q += (d[0] * d[0] + d[1] * d[1]) + (d[2] * d[2] + d[3] * d[3]); }
                q += __shfl_xor(q, 16); q += __shfl_xor(q, 32);
                if (fq == 0) P[tl * 4 + wc] = (pg::f32x2){mw, q}; }
        asm volatile("s_waitcnt lgkmcnt(0)" ::: "memory"); __builtin_amdgcn_s_barrier(); asm volatile("" ::: "memory");
        if (lane < 32) { const int row = wid * 32 + lane;
            const pg::f32x2 a = P[row * 4 + 0], b_ = P[row * 4 + 1], c_ = P[row * 4 + 2], d = P[row * 4 + 3];
            const float mt = (a.x + b_.x + c_.x + d.x) * 0.25f;
            const float da = a.x - mt, db = b_.x - mt, dc = c_.x - mt, dd = d.x - mt;
            const float m2 = (a.y + b_.y) + (c_.y + d.y) + 64.f * ((da * da + db * db) + (dc * dc + dd * dd));
            Sx[row] = (pg::f32x2){mt, rsqrtf(m2 * (1.f / 256.f) + LN_EPS)}; }
        asm volatile("s_waitcnt lgkmcnt(0)" ::: "memory"); __builtin_amdgcn_s_barrier(); asm volatile("" ::: "memory");
        const int col0 = wc * 32 + 8 * fq;
#pragma unroll
        for (int bj = 0; bj < 2; ++bj) { const int e0 = h * 256 + col0 + bj * 128;
            const pg::f32x4 g0 = *(const pg::f32x4*)(gain + e0), g1 = *(const pg::f32x4*)(gain + e0 + 4);
#pragma unroll
            for (int ai = 0; ai < 2; ++ai)
#pragma unroll
                for (int m = 0; m < 4; ++m) { const int tl = ai * 128 + wr * 64 + m * 16 + fr; const pg::f32x2 sr = Sx[tl]; const size_t t = tok0 + tl;
                    float ov[8]; ld8(PROJ + t * PROJW + PJ_O + e0, ov);
                    const pg::f32x4 v0 = (acc[ai][bj][m][0] - sr.x) * sr.y * g0, v1 = (acc[ai][bj][m][1] - sr.x) * sr.y * g1;
                    float r[8];
#pragma unroll
                    for (int j = 0; j < 4; ++j) { r[j] = v0[j] * sigmoidf_(ov[j]); r[4 + j] = v1[j] * sigmoidf_(ov[4 + j]); }
                    st8(HOUT + t * 1024 + e0, r); } }
    }
};
struct SchedG1 { pg::TileOrder o; const char* Q; const char* K;
    __device__ __forceinline__ bool next(int i, pg::Unit& u) const { int g, pm, pn; if (!o.tile(i, g, pm, pn)) return false;
        const int bh = g >> 4, c = g & 15, b = bh >> 2, h = bh & 3; const size_t off = (((size_t)b * SEQ + c * 256) * 1024 + h * 256) * 2;
        u.A = Q + off; u.B = K + off; u.pm = 0; u.pn = 0; u.g = g; u.aux = g; u.rows = nullptr; u.nvalid = 0; return true; } };
struct SchedG2 { pg::TileOrder o; const char* BT2; const char* KaT;
    __device__ __forceinline__ bool next(int i, pg::Unit& u) const { int g, pm, pn; if (!o.tile(i, g, pm, pn)) return false;
        const int bh = g / 15, c = g % 15, b = bh >> 2, h = bh & 3;
        u.A = BT2 + (size_t)(bh * 16 + c) * 256 * 512 * 2; u.B = KaT + (((size_t)h * 256) * T + (size_t)b * SEQ + c * 256) * 2;
        u.pm = 0; u.pn = 0; u.g = bh * 16 + c; u.aux = bh * 16 + c; u.rows = nullptr; u.nvalid = 0; return true; } };
struct SchedG3 { pg::TileOrder o; const char* A2; const char* BT2;
    __device__ __forceinline__ bool next(int i, pg::Unit& u) const { int g, pm, pn; if (!o.tile(i, g, pm, pn)) return false;
        const int bh = g >> 4, c = g & 15, b = bh >> 2, h = bh & 3;
        u.A = A2 + (((size_t)b * SEQ + c * 256) * 2048 + h * 512) * 2; u.B = BT2 + (size_t)g * 256 * 512 * 2; u.pm = 0; u.pn = 0; u.g = g; u.aux = g; u.rows = nullptr; u.nvalid = 0; return true; } };
__device__ __forceinline__ void ph_un(LAS unsigned char* lds, const OptBufs2& o2, const OptBufs3& o3) {
    const int tid = tidf(), d = tid & 255, sh = tid >> 8; LAS float* red = (LAS float*)lds;
    for (int it = blockIdx.x; it < 256; it += gridDim.x) { const int bh = it >> 4, c = it & 15, b = bh >> 2, h = bh & 3; const size_t tok0 = (size_t)b * SEQ + c * 256;
        float s = 0.f;
#pragma unroll 8
        for (int j = 0; j < 128; ++j) { const size_t t = tok0 + sh * 128 + j; s += o3.aw[t * 4 + h] * bf2f(o2.K[t * 1024 + h * 256 + d]); }
        __syncthreads(); if (sh == 1) red[d] = s; __syncthreads();
        if (sh == 0) o3.un[(size_t)it * 256 + d] = s + red[d]; }
    __syncthreads();
}
__device__ __forceinline__ void ph_state_scan(const OptBufs& ob, const OptBufs3& o3) {
    const int gt = blockIdx.x * NT + tidf(), ngt = gridDim.x * NT;
    for (int it = gt; it < 16 * 256 * 64; it += ngt) { const int bh = it >> 14, e = (it >> 6) & 255, d4 = (it & 63) * 4;
        pg::f32x4 C = (pg::f32x4){0.f, 0.f, 0.f, 0.f};
        for (int c = 0; c < 16; ++c) { const size_t g = (size_t)bh * 16 + c;
            pg::u32x2 w; w.x = pk2(C[0], C[1]); w.y = pk2(C[2], C[3]);
            *(pg::u32x2*)(ob.BT2 + (g * 256 + e) * 512 + 256 + d4) = w;
            if (c < 15) { const pg::f32x4 U = *(const pg::f32x4*)(o3.U + g * 65536 + (size_t)e * 256 + d4); C = C * o3.decay[g] + U; } } }
}
__device__ __forceinline__ void ph_den_inter(LAS unsigned char* lds, const OptBufs3& o3) {
    const int tid = tidf(), lane = tid & 63, wave = tid >> 6; LAS float* nn = (LAS float*)lds;
    for (int it = blockIdx.x; it < 256; it += gridDim.x) { const int bh = it >> 4, c = it & 15, b = bh >> 2, h = bh & 3; const size_t tok0 = (size_t)b * SEQ + c * 256;
        __syncthreads();
        if (tid < 256) { float n = 0.f; for (int j = 0; j < c; ++j) n = n * o3.decay[bh * 16 + j] + o3.un[(size_t)(bh * 16 + j) * 256 + tid]; nn[tid] = n; }
        __syncthreads();
        const pg::f32x4 nv = *(const LAS pg::f32x4*)(nn + 4 * lane);
        for (int r = 0; r < 32; ++r) { const size_t t = tok0 + wave * 32 + r;
            const pg::u32x2 w = *(const pg::u32x2*)(o3.A2 + t * 2048 + h * 512 + 256 + 4 * lane);
            float s = __builtin_bit_cast(float, w.x << 16) * nv[0] + __builtin_bit_cast(float, w.x & 0xffff0000u) * nv[1] + __builtin_bit_cast(float, w.y << 16) * nv[2] + __builtin_bit_cast(float, w.y & 0xffff0000u) * nv[3];
            s = wsum(s);
            if (lane == 0) o3.den[t * 4 + h] += s; } }
    __syncthreads();
}

__device__ __forceinline__ void ph_gemms_D(LAS unsigned char* lds, const OptBufs2& o, const OptBufs3& o3, const float* b_pool, const float* ls_pool) {
    const int G = gridDim.x, bx = blockIdx.x;
    { SchedG S; S.o.init(T / 256, 2, 1, G, bx); S.A = (const char*)o.POOLED; S.B = (const char*)o.WpoolT; S.gA = 0; S.gB = 0; S.tA = (size_t)256 * 512 * 2; S.tB = (size_t)256 * 512 * 2;
      EpiPoolMixB E{o.MIXED, b_pool, ls_pool}; pg::gemm_phase<EpiPoolMixB, SchedG>(lds, 512, 512, 512, S, E); }
    { SchedG S; S.o.init(T / 256, 1, 4, G, (bx + 128) % G); S.A = (const char*)o.UC; S.B = (const char*)o.WqT; S.gA = 256 * 2; S.gB = (size_t)65536 * 2; S.tA = (size_t)256 * 1024 * 2; S.tB = 0;
      EpiQ E{o.Q, o3.A2, o3.winter}; pg::gemm_phase<EpiQ, SchedG>(lds, 1024, 256, 256, S, E); }
    { SchedG S; S.o.init(T / 256, 1, 4, G, (bx + 128) % G); S.A = (const char*)o.UC; S.B = (const char*)o.WkT; S.gA = 256 * 2; S.gB = (size_t)65536 * 2; S.tA = (size_t)256 * 1024 * 2; S.tB = 0;
      pg::EpiStoreBf16 E{o.K, 1024, 1.f, 256}; pg::gemm_phase<pg::EpiStoreBf16, SchedG>(lds, 1024, 256, 256, S, E); }
    { SchedG S; S.o.init(1, T / 256, 4, G, bx); S.A = (const char*)o.WkT; S.B = (const char*)o.UC; S.gA = (size_t)65536 * 2; S.gB = 256 * 2; S.tA = 0; S.tB = (size_t)256 * 1024 * 2;
      EpiKT E{o3.KaT, o3.aw}; pg::gemm_phase<EpiKT, SchedG>(lds, 256, 1024, 256, S, E); }
}
__device__ __forceinline__ void ph_gemms_E(LAS unsigned char* lds, const OptBufs& ob, const OptBufs2& o2, const OptBufs3& o3) {
    const int G = gridDim.x, bx = blockIdx.x;
    ph_un(lds, o2, o3);
    { SchedG1 S; S.o.init(1, 1, 256, G, bx); S.Q = (const char*)o2.Q; S.K = (const char*)o2.K;
      EpiS E{o3.A2, o3.rowv, o3.colv, o3.den}; pg::gemm_phase<EpiS, SchedG1>(lds, 1024, 1024, 256, S, E); }
    { SchedG2 S; S.o.init(1, 1, 240, G, bx); S.BT2 = (const char*)ob.BT2; S.KaT = (const char*)o3.KaT;
      EpiF32U E{o3.U}; pg::gemm_phase<EpiF32U, SchedG2>(lds, 512, T, 256, S, E); }
}
__device__ __forceinline__ void ph_gemm_G3(LAS unsigned char* lds, const OptBufs& ob, const OptBufs3& o3, const float* gain) {
    SchedG3 S; S.o.init(1, 1, 256, gridDim.x, blockIdx.x); S.A2 = (const char*)o3.A2; S.BT2 = (const char*)ob.BT2;
    EpiNum E{o3.HOUT, ob.PROJ, o3.den, o3.emt, gain}; pg::gemm_phase<EpiNum, SchedG3>(lds, 2048, 512, 512, S, E);
}
__device__ __forceinline__ void ph_gemm_ypool(LAS unsigned char* lds, const OptBufs2& o) {
    const int G = gridDim.x, bx = blockIdx.x;
    SchedG S; S.o.init(T / 256, 4, 1, G, bx); S.A = (const char*)o.MIXED; S.B = (const char*)o.WbpT; S.gA = 0; S.gB = 0; S.tA = (size_t)256 * 512 * 2; S.tB = (size_t)256 * 512 * 2;
    pg::EpiStoreBf16 E{o.YPOOL, 1024, 1.f, 0}; pg::gemm_phase<pg::EpiStoreBf16, SchedG>(lds, 512, 512, 512, S, E);
}


struct OptBufs4 { pg::bf16_t *WbmT, *WoutT, *MERGED, *H1B; float *Z; int *elist, *erank; float *gate; };
__device__ __forceinline__ void ph_prep_weights4(LAS unsigned char* lds, const OptBufs4& o, const float* w_bm, const float* w_out) {
    const int tid = tidf(), lane = tid & 63, wave = tid >> 6, gw = blockIdx.x * NW + wave, ngw = gridDim.x * NW;
    LAS float* scr = (LAS float*)(lds + wave * 16384);
    for (int it = gw; it < 2 * 32 * 16; it += ngw) { const int which = it >> 9, r = it & 511, nb = r >> 4, kb = r & 15;
        transpose_item(which ? w_out : w_bm, 1024, kb * 64, nb * 32, 1, which ? o.WoutT : o.WbmT, (size_t)nb * 32, 1024, scr, lane); }
}
struct EpiMerge {
    static constexpr bool PERM = true, AFTER_DRAIN = false;
    pg::bf16_t* O; const pg::bf16_t* PROJ; const pg::bf16_t* YPOOL;
    __device__ __forceinline__ void operator()(const pg::f32x4 (&acc)[2][2][4][2], const pg::Unit& u, int wr, int wc, int fr, int fq) const {
        const int col0 = u.pn * 256 + wc * 32 + 8 * fq;
#pragma unroll
        for (int ai = 0; ai < 2; ++ai)
#pragma unroll
            for (int m = 0; m < 4; ++m) { const size_t t = (size_t)u.pm * 256 + ai * 128 + wr * 64 + m * 16 + fr;
#pragma unroll
                for (int bj = 0; bj < 2; ++bj) { const int c = col0 + bj * 128; float g0[8], g1[8], yp[8], r[8];
                    ld8(PROJ + t * PROJW + PJ_G + c, g0); ld8(PROJ + t * PROJW + PJ_G + 1024 + c, g1); ld8(YPOOL + t * 1024 + c, yp);
#pragma unroll
                    for (int j = 0; j < 8; ++j) { const float a_ = (j < 4) ? acc[ai][bj][m][0][j] : acc[ai][bj][m][1][j - 4]; r[j] = sigmoidf_(g0[j]) * yp[j] + sigmoidf_(g1[j]) * a_; }
                    st8(O + t * 1024 + c, r); }
                asm volatile("" ::: "memory"); }
    }
};
struct EpiMixRes {
    static constexpr bool PERM = false, AFTER_DRAIN = false;
    float* Z; const float* x; const float* stats; const float* g; const float* beta;
    __device__ __forceinline__ void operator()(const pg::f32x4 (&acc)[2][2][4][2], const pg::Unit& u, int wr, int wc, int fr, int fq) const {
        const int col0 = u.pn * 256 + wc * 32 + 4 * fq;
#pragma unroll
        for (int ai = 0; ai < 2; ++ai)
#pragma unroll
            for (int m = 0; m < 4; ++m) { const size_t t = (size_t)u.pm * 256 + ai * 128 + wr * 64 + m * 16 + fr; const float mu = stats[t * 2], rstd = stats[t * 2 + 1];
#pragma unroll
                for (int bj = 0; bj < 2; ++bj)
#pragma unroll
                    for (int n = 0; n < 2; ++n) { const int c = col0 + bj * 128 + n * 16;
                        const pg::f32x4 xv = *(const pg::f32x4*)(x + t * 1024 + c), gv = *(const pg::f32x4*)(g + c), bv = *(const pg::f32x4*)(beta + c);
                        *(pg::f32x4*)(Z + t * 1024 + c) = ((xv - mu) * rstd * gv + bv) * ALPHA + acc[ai][bj][m][n]; }
                asm volatile("" ::: "memory"); }
    }
};
__device__ __forceinline__ void ph_gemm_ymls(LAS unsigned char* lds, const OptBufs& ob, const OptBufs2& o2, const OptBufs3& o3, const OptBufs4& o4) {
    SchedG S; S.o.init(T / 256, 4, 1, gridDim.x, blockIdx.x); S.A = (const char*)o3.HOUT; S.B = (const char*)o4.WbmT; S.gA = 0; S.gB = 0; S.tA = (size_t)256 * 1024 * 2; S.tB = (size_t)256 * 1024 * 2;
    EpiMerge E{o4.MERGED, ob.PROJ, o2.YPOOL}; pg::gemm_phase<EpiMerge, SchedG>(lds, 1024, 1024, 1024, S, E);
}
__device__ __forceinline__ void ph_gemm_mix(LAS unsigned char* lds, const OptBufs& ob, const OptBufs4& o4, const float* x, const float* g, const float* beta) {
    SchedG S; S.o.init(T / 256, 4, 1, gridDim.x, blockIdx.x); S.A = (const char*)o4.MERGED; S.B = (const char*)o4.WoutT; S.gA = 0; S.gB = 0; S.tA = (size_t)256 * 1024 * 2; S.tB = (size_t)256 * 1024 * 2;
    EpiMixRes E{o4.Z, x, ob.stats, g, beta}; pg::gemm_phase<EpiMixRes, SchedG>(lds, 1024, 1024, 1024, S, E);
}
__device__ __forceinline__ void ph_ln1_router(LAS unsigned char* lds, const OptBufs4& o, const float* g, const float* beta, const float* wr_, const float* br, int* cnt) {
    const int tid = tidf(), lane = tid & 63, wave = tid >> 6;
    LAS float* wl = (LAS float*)lds;
    LAS int* hist = (LAS int*)(lds + 131072 + 1024);
    LAS int* asg = (LAS int*)(lds + 131072 + 1024 + 256);
    for (int tile = blockIdx.x; tile < T / 64; tile += gridDim.x) {
        __syncthreads();
        for (int i = tid; i < 1024 * 32 / 4; i += NT) *(LAS pg::f32x4*)(wl + 4 * i) = *(const pg::f32x4*)(wr_ + 4 * i);
        if (tid < 64) hist[tid] = 0;
        __syncthreads();
        for (int r = 0; r < 8; ++r) {
            const int tl = wave * 8 + r; const size_t t = (size_t)tile * 64 + tl;
            pg::f32x4* zr = (pg::f32x4*)(o.Z + t * D) + lane;
            pg::f32x4 v[4]; float s = 0.f;
#pragma unroll
            for (int j = 0; j < 4; ++j) { v[j] = zr[64 * j]; s += (v[j].x + v[j].y) + (v[j].z + v[j].w); }
            const float mean = wsum(s) * (1.f / D); float s2 = 0.f;
#pragma unroll
            for (int j = 0; j < 4; ++j) { v[j] = v[j] - mean; s2 += (v[j].x * v[j].x + v[j].y * v[j].y) + (v[j].z * v[j].z + v[j].w * v[j].w); }
            const float rstd = rsqrtf(wsum(s2) * (1.f / D) + LN_EPS);
            unsigned long long* o8 = (unsigned long long*)(o.H1B + t * D) + lane;
            float lg[32];
#pragma unroll
            for (int e = 0; e < 32; ++e) lg[e] = 0.f;
#pragma unroll
            for (int j = 0; j < 4; ++j) { const int c0 = 256 * j + 4 * lane;
                const pg::f32x4 gg = *(const pg::f32x4*)(g + c0), bb = *(const pg::f32x4*)(beta + c0);
                const pg::f32x4 y = v[j] * rstd * gg + bb;
                zr[64 * j] = y;
                o8[64 * j] = (unsigned long long)pk2(y.x, y.y) | ((unsigned long long)pk2(y.z, y.w) << 32);
#pragma unroll
                for (int i = 0; i < 4; ++i) { const LAS pg::f32x4* wrow = (const LAS pg::f32x4*)(wl + (c0 + i) * 32);
#pragma unroll
                    for (int e4 = 0; e4 < 8; ++e4) { const pg::f32x4 w4 = wrow[e4]; lg[4 * e4] += y[i] * w4.x; lg[4 * e4 + 1] += y[i] * w4.y; lg[4 * e4 + 2] += y[i] * w4.z; lg[4 * e4 + 3] += y[i] * w4.w; } } }
            float mine = 0.f;
#pragma unroll
            for (int e = 0; e < 32; ++e) { const float tot = wsum(lg[e]); mine = ((lane & 31) == e) ? tot : mine; }
            mine += br[lane & 31];
            float val = mine; int idxs[4]; float vals[4];
#pragma unroll
            for (int k = 0; k < 4; ++k) {
                float bv = val; int bi = lane & 31;
#pragma unroll
                for (int off = 1; off < 32; off <<= 1) { const float ov = __shfl_xor(bv, off); const int oi = __shfl_xor(bi, off); if (ov > bv || (ov == bv && oi < bi)) { bv = ov; bi = oi; } }
                idxs[k] = bi; vals[k] = bv; if ((lane & 31) == bi) val = -INFINITY;
            }
            float ex[4], se = 0.f;
#pragma unroll
            for (int k = 0; k < 4; ++k) { ex[k] = expf(vals[k] - vals[0]); se += ex[k]; }
#pragma unroll
            for (int k = 0; k < 4; ++k) if (lane == k) { o.gate[t * 4 + k] = ex[k] / se; const int lr = atomicAdd((int*)(hist + idxs[k]), 1); asg[tl * 4 + k] = idxs[k] | (lr << 8); }
        }
        __syncthreads();
        if (tid < 32) hist[32 + tid] = atomicAdd(&cnt[tid], hist[tid]);
        __syncthreads();
        if (tid < 256) { const int a_ = asg[tid], e = a_ & 255, rank = hist[32 + e] + (a_ >> 8); const int t = tile * 64 + (tid >> 2);
            o.elist[e * T + rank] = t; o.erank[(size_t)t * 4 + (tid & 3)] = (e << 16) | rank; }
    }
    __syncthreads();
}
__device__ __forceinline__ void ph_adapt_route(const OptBufs4& o, const int* start, int* row_tok, int* row_of) {
    const int gt = blockIdx.x * NT + tidf(), ngt = gridDim.x * NT;
    for (int i = gt; i < NA; i += ngt) { const int er = o.erank[i], e = er >> 16, rank = er & 0xffff; const int dest = start[e] + rank; row_tok[dest] = i >> 2; row_of[i] = dest; }
}


struct OptBufs5 { pg::bf16_t *We1T, *We2T, *ACT, *Y; float* B1P; };
constexpr int MOE_TAB_OFF = 131072 + 4096;
__device__ __forceinline__ void ph_prep_weights5(LAS unsigned char* lds, const OptBufs5& o, const float* w_e1, const float* b_e1, const float* w_e2) {
    const int tid = tidf(), lane = tid & 63, wave = tid >> 6, gw = blockIdx.x * NW + wave, ngw = gridDim.x * NW;
    LAS float* scr = (LAS float*)(lds + wave * 16384);
    for (int it = gw; it < 32 * 16 * 8 * 4 * 2; it += ngw) { const int bj = it & 1, jb = (it >> 1) & 3, pn = (it >> 3) & 7, kb = (it >> 6) & 15, e = it >> 10;
        transpose_item(w_e1 + (size_t)e * 1024 * 2048, 2048, kb * 64, 2 * (pn * 128 + jb * 32) + bj, 2, o.We1T + (size_t)e * 2048 * 1024, (size_t)pn * 256 + bj * 128 + jb * 32, 1024, scr, lane); }
    for (int it = gw; it < 32 * 32 * 16; it += ngw) { const int kb = it & 15, nb = (it >> 4) & 31, e = it >> 9;
        transpose_item(w_e2 + (size_t)e * 1024 * 1024, 1024, kb * 64, nb * 32, 1, o.We2T + (size_t)e * 1024 * 1024, (size_t)nb * 32, 1024, scr, lane); }
    for (int i = blockIdx.x * NT + tid; i < 32 * 2048; i += gridDim.x * NT) { const int e = i >> 11, r = i & 2047, pn = r >> 8, bj = (r >> 7) & 1, jj = r & 127; o.B1P[i] = b_e1[e * 2048 + 2 * (pn * 128 + jj) + bj]; }
}
__device__ __forceinline__ void moe_build_tab(LAS unsigned char* lds, const int* cnt) {
    LAS int* tab = (LAS int*)(lds + MOE_TAB_OFF);
    __syncthreads();
    if (tidf() == 0) { int s = 0; for (int e = 0; e < NE; ++e) { tab[e] = s; s += (cnt[e] + 255) >> 8; } tab[NE] = s; }
    __syncthreads();
}
struct SchedMoE {
    const LAS int* tab; const int* cnt; const int* elist; const char* A; const char* B; size_t eB; int nN, nwg, G, c, gather;
    __device__ __forceinline__ bool next(int i, pg::Unit& u) const {
        const long L = (long)i * G + c; if (L >= nwg) return false;
        int wgid = (int)L; { const int q = nwg / pg::NXCD, r = nwg % pg::NXCD, xcd = wgid % pg::NXCD, off = wgid / pg::NXCD; wgid = (xcd < r ? xcd * (q + 1) : r * (q + 1) + (xcd - r) * q) + off; }
        const int mg = wgid / nN, pn = wgid - mg * nN;
        int e = 0;
#pragma unroll
        for (int j = 1; j < NE; ++j) e += (tab[j] <= mg) ? 1 : 0;
        e = __builtin_amdgcn_readfirstlane(e);
        const int mt = mg - __builtin_amdgcn_readfirstlane(tab[e]);
        u.g = e; u.pm = mg; u.pn = pn; u.aux = mg * 256;
        u.B = B + (size_t)e * eB + (size_t)pn * 256 * 1024 * 2;
        if (gather) { u.A = A; u.rows = elist + (size_t)e * T + mt * 256; const int rem = __builtin_amdgcn_readfirstlane(cnt[e]) - mt * 256; u.nvalid = rem < 256 ? rem : 256; }
        else { u.A = A + (size_t)mg * 256 * 1024 * 2; u.rows = nullptr; u.nvalid = 0; }
        return true;
    }
};
struct EpiSwiglu {
    static constexpr bool PERM = true, AFTER_DRAIN = false;
    pg::bf16_t* ACT; const float* B1P;
    __device__ __forceinline__ void operator()(const pg::f32x4 (&acc)[2][2][4][2], const pg::Unit& u, int wr, int wc, int fr, int fq) const {
        const int col0 = wc * 32 + 8 * fq; const float* bp = B1P + u.g * 2048 + u.pn * 256 + col0;
        const pg::f32x4 bg0 = *(const pg::f32x4*)(bp), bg1 = *(const pg::f32x4*)(bp + 4), bl0 = *(const pg::f32x4*)(bp + 128), bl1 = *(const pg::f32x4*)(bp + 132);
        pg::bf16_t* base = ACT + (size_t)(u.aux + wr * 64 + fr) * 1024 + u.pn * 128 + col0;
#pragma unroll
        for (int ai = 0; ai < 2; ++ai)
#pragma unroll
            for (int m = 0; m < 4; ++m) { float r[8];
#pragma unroll
                for (int j = 0; j < 8; ++j) { float g = (j < 4) ? acc[ai][0][m][0][j] + bg0[j] : acc[ai][0][m][1][j - 4] + bg1[j - 4];
                    float l = (j < 4) ? acc[ai][1][m][0][j] + bl0[j] : acc[ai][1][m][1][j - 4] + bl1[j - 4];
                    g = fminf(g, 7.f); l = fminf(fmaxf(l, -7.f), 7.f);
                    r[j] = g * (l + 1.f) / (1.f + __expf(-1.702f * g)); }
                st8(base + (size_t)(ai * 128 + m * 16) * 1024, r); asm volatile("" ::: "memory"); }
    }
};
struct EpiY {
    static constexpr bool PERM = true, AFTER_DRAIN = false;
    pg::bf16_t* Y; const float* b2;
    __device__ __forceinline__ void operator()(const pg::f32x4 (&acc)[2][2][4][2], const pg::Unit& u, int wr, int wc, int fr, int fq) const {
        const int col0 = u.pn * 256 + wc * 32 + 8 * fq; const float* bp = b2 + u.g * 1024 + col0;
        pg::bf16_t* base = Y + (size_t)(u.aux + wr * 64 + fr) * 1024 + col0;
#pragma unroll
        for (int bj = 0; bj < 2; ++bj) { const pg::f32x4 b0 = *(const pg::f32x4*)(bp + bj * 128), b1 = *(const pg::f32x4*)(bp + bj * 128 + 4);
#pragma unroll
            for (int ai = 0; ai < 2; ++ai)
#pragma unroll
                for (int m = 0; m < 4; ++m) { const pg::f32x4 v0 = acc[ai][bj][m][0] + b0, v1 = acc[ai][bj][m][1] + b1;
                    pg::u32x4 w; w.x = pg::cvt_pk_bf16(v0[0], v0[1]); w.y = pg::cvt_pk_bf16(v0[2], v0[3]); w.z = pg::cvt_pk_bf16(v1[0], v1[1]); w.w = pg::cvt_pk_bf16(v1[2], v1[3]);
                    *(pg::u32x4*)(base + (size_t)(ai * 128 + m * 16) * 1024 + bj * 128) = w; asm volatile("" ::: "memory"); } }
    }
};
__device__ __forceinline__ void ph_moe1(LAS unsigned char* lds, const OptBufs4& o4, const OptBufs5& o5, const int* cnt) {
    moe_build_tab(lds, cnt);
    SchedMoE S; S.tab = (const LAS int*)(lds + MOE_TAB_OFF); S.cnt = cnt; S.elist = o4.elist; S.A = (const char*)o4.H1B; S.B = (const char*)o5.We1T; S.eB = (size_t)2048 * 1024 * 2;
    S.nN = 8; S.nwg = __builtin_amdgcn_readfirstlane(S.tab[NE]) * 8; S.G = gridDim.x; S.c = blockIdx.x; S.gather = 1;
    EpiSwiglu E{o5.ACT, o5.B1P}; pg::gemm_phase<EpiSwiglu, SchedMoE, true>(lds, 1024, 1024, 1024, S, E);
}
__device__ __forceinline__ void ph_moe2(LAS unsigned char* lds, const OptBufs5& o5, const int* cnt, const float* b_e2) {
    moe_build_tab(lds, cnt);
    SchedMoE S; S.tab = (const LAS int*)(lds + MOE_TAB_OFF); S.cnt = cnt; S.elist = nullptr; S.A = (const char*)o5.ACT; S.B = (const char*)o5.We2T; S.eB = (size_t)1024 * 1024 * 2;
    S.nN = 4; S.nwg = __builtin_amdgcn_readfirstlane(S.tab[NE]) * 4; S.G = gridDim.x; S.c = blockIdx.x; S.gather = 0;
    EpiY E{o5.Y, b_e2}; pg::gemm_phase<EpiY, SchedMoE, false>(lds, 1024, 1024, 1024, S, E);
}
__device__ __forceinline__ void ph_final_opt(LAS unsigned char* lds, const OptBufs4& o4, const OptBufs5& o5, const int* cnt, const float* g, const float* beta, float* out) {
    moe_build_tab(lds, cnt);
    const LAS int* tab = (const LAS int*)(lds + MOE_TAB_OFF);
    const int tid = tidf(), lane = tid & 63, gw = blockIdx.x * NW + (tid >> 6), ngw = gridDim.x * NW;
    for (int t = gw; t < T; t += ngw) {
        size_t ro[4]; float gt[4];
#pragma unroll
        for (int k = 0; k < 4; ++k) { const int er = o4.erank[(size_t)t * 4 + k]; ro[k] = (size_t)(tab[er >> 16] * 256 + (er & 0xffff)) * 1024; gt[k] = o4.gate[(size_t)t * 4 + k]; }
        pg::f32x4 v[4]; float s = 0.f;
#pragma unroll
        for (int j = 0; j < 4; ++j) { const int c0 = 256 * j + 4 * lane;
            pg::f32x4 x = *(const pg::f32x4*)(o4.Z + (size_t)t * D + c0) * ALPHA;
#pragma unroll
            for (int k = 0; k < 4; ++k) { const pg::u32x2 w = *(const pg::u32x2*)(o5.Y + ro[k] + c0);
                x.x += gt[k] * __builtin_bit_cast(float, w.x << 16); x.y += gt[k] * __builtin_bit_cast(float, w.x & 0xffff0000u);
                x.z += gt[k] * __builtin_bit_cast(float, w.y << 16); x.w += gt[k] * __builtin_bit_cast(float, w.y & 0xffff0000u); }
            v[j] = x; s += (x.x + x.y) + (x.z + x.w); }
        const float mean = wsum(s) * (1.f / D); float s2 = 0.f;
#pragma unroll
        for (int j = 0; j < 4; ++j) { v[j] = v[j] - mean; s2 += (v[j].x * v[j].x + v[j].y * v[j].y) + (v[j].z * v[j].z + v[j].w * v[j].w); }
        const float rstd = rsqrtf(wsum(s2) * (1.f / D) + LN_EPS);
#pragma unroll
        for (int j = 0; j < 4; ++j) { const int c0 = 256 * j + 4 * lane;
            *(pg::f32x4*)(out + (size_t)t * D + c0) = v[j] * rstd * *(const pg::f32x4*)(g + c0) + *(const pg::f32x4*)(beta + c0); }
    }
}

__device__ __forceinline__ void ph_adapt1(const OptBufs& o, const float* b_if, float* proj) {
    const size_t gt = (size_t)blockIdx.x * NT + tidf(), ngt = (size_t)gridDim.x * NT;
    for (size_t i = gt; i < (size_t)T * INC; i += ngt) {
        const int c = (int)(i % INC); const int t = (int)(i / INC);
        float v;
        if (c < C_V) v = bf2f(o.PROJ[(size_t)t * PROJW + c]);
        else if (c < C_O) { const int e = c - C_V, h = e >> 8, el = e & 255, b = t >> 12, cc = (t & 4095) >> 8, tl = t & 255;
            v = bf2f(o.BT2[((size_t)((b * 4 + h) * 16 + cc) * 256 + el) * 512 + tl]); }
        else if (c < C_IF) v = bf2f(o.PROJ[(size_t)t * PROJW + c - 1024]);
        else if (c < C_G) v = o.gif[(size_t)t * 8 + (c - C_IF)] - b_if[c - C_IF];
        else v = bf2f(o.PROJ[(size_t)t * PROJW + c - C_G + PJ_G]);
        proj[i] = v;
    }
}

struct Args { const float* in[26]; float* out; unsigned char* ws; int ph_lo, ph_hi; };
constexpr size_t MiB = 1u << 20;
constexpr size_t WS_CTL = 0;
constexpr size_t CTL_ZERO_BYTES = 1 * MiB;
constexpr int CW_BAR = 4096;
constexpr int CW_CNT = 16384, CW_START = 16384 + 64, CW_FILL = 16384 + 128;

__global__ void __launch_bounds__(NT, 2) mk_fwd(Args a) {
    extern __shared__ __attribute__((aligned(16))) unsigned char lds_raw[];
    LAS unsigned char* lds = (LAS unsigned char*)lds_raw;
    volatile LAS unsigned* MISC = (volatile LAS unsigned*)(lds + MISC_OFF);
    const int tid = tidf();
    if (tid < 32) MISC[tid] = 0u;
    __syncthreads();
    unsigned char* ws = a.ws;
    unsigned* ctl = (unsigned*)(ws + WS_CTL);
    XcdBarrier bar = xcd_barrier_post(ctl + CW_BAR, MISC + 8);
    const float* x = a.in[0]; const float* ln0_g = a.in[1]; const float* ln0_b = a.in[2];
    const float* w_in = a.in[3]; const float* conv_w = a.in[4]; const float* conv_b = a.in[5];
    const float* w_q = a.in[6]; const float* w_k = a.in[7]; const float* b_if = a.in[8];
    const float* mh_gain = a.in[9]; const float* w_pool = a.in[10]; const float* b_pool = a.in[11];
    const float* ls_pool = a.in[12]; const float* w_bp = a.in[13]; const float* w_bm = a.in[14];
    const float* w_out = a.in[15]; const float* ln1_g = a.in[16]; const float* ln1_b = a.in[17];
    const float* w_router = a.in[18]; const float* b_router = a.in[19]; const float* w_e1 = a.in[20];
    const float* b_e1 = a.in[21]; const float* w_e2 = a.in[22]; const float* b_e2 = a.in[23];
    const float* ln2_g = a.in[24]; const float* ln2_b = a.in[25];
    OptBufs ob; ob.WinT = (pg::bf16_t*)(ws + 8 * MiB); ob.H0B = (pg::bf16_t*)(ws + 220 * MiB); ob.PROJ = (pg::bf16_t*)(ws + 252 * MiB); ob.BT2 = (pg::bf16_t*)(ws + 396 * MiB);
    ob.gif = (float*)(ws + 1 * MiB); ob.stats = (float*)(ws + 1 * MiB + 512 * 1024);
    OptBufs2 o2; o2.WqT = (pg::bf16_t*)(ws + 19 * MiB); o2.WkT = (pg::bf16_t*)(ws + 19 * MiB + 512 * 1024); o2.WpoolT = (pg::bf16_t*)(ws + 20 * MiB); o2.WbpT = (pg::bf16_t*)(ws + 20 * MiB + 512 * 1024);
    o2.POOLED = (pg::bf16_t*)(ws + 460 * MiB); o2.UC = (pg::bf16_t*)(ws + 476 * MiB); o2.MIXED = (pg::bf16_t*)(ws + 508 * MiB); o2.Q = (pg::bf16_t*)(ws + 524 * MiB); o2.K = (pg::bf16_t*)(ws + 556 * MiB);
    o2.YPOOL = (pg::bf16_t*)(ws + 748 * MiB);
    OptBufs3 o3; o3.KaT = (pg::bf16_t*)(ws + 588 * MiB); o3.A2 = (pg::bf16_t*)(ws + 620 * MiB); o3.U = (float*)(ws + 684 * MiB); o3.HOUT = (pg::bf16_t*)(ws + 780 * MiB);
    { float* sm = (float*)(ws + 2 * MiB); o3.rowv = sm; o3.colv = sm + 65536; o3.winter = sm + 2 * 65536; o3.aw = sm + 3 * 65536; o3.emt = sm + 4 * 65536; o3.den = sm + 5 * 65536; o3.un = sm + 6 * 65536; o3.decay = sm + 7 * 65536; }
    OptBufs4 o4; o4.WbmT = (pg::bf16_t*)(ws + 21 * MiB + 512 * 1024); o4.WoutT = (pg::bf16_t*)(ws + 23 * MiB + 512 * 1024); o4.MERGED = (pg::bf16_t*)(ws + 812 * MiB); o4.Z = (float*)(ws + 844 * MiB); o4.H1B = (pg::bf16_t*)(ws + 908 * MiB);
    o4.elist = (int*)(ws + 4 * MiB); o4.erank = (int*)(ws + 6 * MiB); o4.gate = (float*)(ws + 6 * MiB + 256 * 1024);
    OptBufs5 o5; o5.We1T = (pg::bf16_t*)(ws + 26 * MiB); o5.We2T = (pg::bf16_t*)(ws + 154 * MiB); o5.B1P = (float*)(ws + 7 * MiB);
    o5.ACT = (pg::bf16_t*)(ws + 252 * MiB);
    o5.Y = (pg::bf16_t*)(ws + 396 * MiB);
    int* cnt = (int*)ctl + CW_CNT;
    LAS float* ldsf = (LAS float*)lds;
    const int G = gridDim.x, bx = blockIdx.x;
#define IN(k) (a.ph_lo <= (k) && (k) < a.ph_hi)
#define SEAM(k) do { if (IN(k) && IN((k) + 1)) xcd_barrier(bar); } while (0)
    if (IN(0)) { ph_prep_weights(lds, ob, w_in); ph_prep_weights2(lds, o2, w_q, w_k, w_pool, w_bp); ph_prep_weights4(lds, o4, w_bm, w_out); ph_prep_weights5(lds, o5, w_e1, b_e1, w_e2); ph_ln0(lds, ob, x, ln0_g, ln0_b, w_in, b_if); }
    SEAM(0);
    if (IN(1)) ph_inproj(lds, ob);
    SEAM(1);
    if (IN(2)) { if (bx < 16 && tid < 64) scalar_scan_wave(bx, ob.gif, o3, tid);
                 for (int i = bx * NT + tid; i < T * 4; i += G * NT) o3.den[i] = 0.f;
                 ph_poolconv_opt(ob.PROJ, conv_w, conv_b, o2.POOLED, o2.UC); }
    SEAM(2);
    if (IN(3)) ph_gemms_D(lds, o2, o3, b_pool, ls_pool);
    SEAM(3);
    if (IN(4)) { ph_gemm_ypool(lds, o2); ph_gemms_E(lds, ob, o2, o3); }
    SEAM(4);
    if (IN(5)) { ph_state_scan(ob, o3); ph_den_inter(lds, o3); }
    SEAM(5);
    if (IN(6)) ph_gemm_G3(lds, ob, o3, mh_gain);
    SEAM(6);
    if (IN(7)) ph_gemm_ymls(lds, ob, o2, o3, o4);
    SEAM(7);
    if (IN(8)) ph_gemm_mix(lds, ob, o4, x, ln0_g, ln0_b);
    SEAM(8);
    if (IN(9)) ph_ln1_router(lds, o4, ln1_g, ln1_b, w_router, b_router, cnt);
    SEAM(9);
    if (IN(10)) ph_moe1(lds, o4, o5, cnt);
    SEAM(10);
    if (IN(11)) ph_moe2(lds, o5, cnt, b_e2);
    SEAM(11);
    if (IN(12)) ph_final_opt(lds, o4, o5, cnt, ln2_g, ln2_b, a.out);
}
constexpr int NPH = 13;
}

extern "C" void kernel_launch(void* const* d_in, const int* in_sizes, int n_in, void* d_out, int out_size, void* d_ws, size_t ws_size, hipStream_t stream) {
    using namespace mk;
    static int grid = 0;
    if (grid == 0) {
        if (n_in != 26 || ws_size < 1000 * MiB) { fprintf(stderr, "kernel_launch: unexpected n_in %d / ws %zu\n", n_in, ws_size); grid = -1; return; }
        int dev = 0, cus = 0, per_cu = 0;
        hipGetDevice(&dev); hipDeviceGetAttribute(&cus, hipDeviceAttributeMultiprocessorCount, dev);
        if (hipFuncSetAttribute((const void*)mk_fwd, hipFuncAttributeMaxDynamicSharedMemorySize, LDS_BYTES) != hipSuccess) { fprintf(stderr, "hipFuncSetAttribute failed\n"); grid = -1; return; }
        if (hipOccupancyMaxActiveBlocksPerMultiprocessor(&per_cu, (const void*)mk_fwd, NT, LDS_BYTES) != hipSuccess || per_cu < 1) { fprintf(stderr, "occupancy query failed (%d)\n", per_cu); grid = -1; return; }
        grid = cus * 1;
        fprintf(stderr, "kernel_launch: cus %d per_cu %d grid %d\n", cus, per_cu, grid);
    }
    if (grid < 0) return;
    hipMemsetAsync((char*)d_ws + WS_CTL, 0, CTL_ZERO_BYTES, stream);
    Args a{};
    for (int i = 0; i < 26; ++i) a.in[i] = (const float*)d_in[i];
    a.out = (float*)d_out; a.ws = (unsigned char*)d_ws; a.ph_lo = 0; a.ph_hi = NPH;
    void* args[] = {&a};
    hipError_t e = hipLaunchCooperativeKernel((const void*)mk_fwd, dim3(grid), dim3(NT), args, LDS_BYTES, stream);
    if (e != hipSuccess) fprintf(stderr, "cooperative launch failed: %s (grid %d)\n", hipGetErrorString(e), grid);
}
```

```cpp
#include <hip/hip_runtime.h>
#include <cstdio>
#include <cstdint>

#define LAS __attribute__((address_space(3)))
namespace mk {
constexpr int D = 1024, BATCH = 4, SEQ = 4096, T = BATCH * SEQ;
constexpr int INC = 5640;
constexpr int C_P = 0, C_U = 512, C_V = 1536, C_O = 2560, C_IF = 3584, C_G = 3592;
constexpr int NE = 32, TOPK = 4, NA = T * TOPK;
constexpr float LN_EPS = 1e-5f;
constexpr float ALPHA = 1.189207115002721f;
constexpr int NT = 512, NW = 8;
constexpr int LDS_BYTES = 147456, MISC_OFF = 147456 - 512;

#define XB_TMO      128
#define XB_XCNT(j)  (256  + 64 * (j))
#define XB_XSUB(j)  (1280 + 64 * (j))
#define XB_XGEN(j)  (2304 + 64 * (j))
#define XB_TOP      3328
#define XB_TOPGEN   3392
#define XCD_BAR_WORDS 3456
#define XB_SPIN_CAP (1u << 22)
__device__ __forceinline__ unsigned xb_ld(unsigned* p)              { return __hip_atomic_load(p, __ATOMIC_RELAXED, __HIP_MEMORY_SCOPE_AGENT); }
__device__ __forceinline__ unsigned xb_add(unsigned* p, unsigned v) { return __hip_atomic_fetch_add(p, v, __ATOMIC_RELAXED, __HIP_MEMORY_SCOPE_AGENT); }
__device__ __forceinline__ unsigned xb_xcc_id() { return (unsigned)__builtin_amdgcn_s_getreg((3 << 11) | 20) & 0xFu; }
#define XB_SPIN(cond, bar) do { unsigned _sp = 0; while (cond) { __builtin_amdgcn_s_sleep(1); \
    if ((++_sp & 255u) == 0u) { if (xb_ld(&(bar)[XB_TMO])) break; if (_sp > XB_SPIN_CAP) { atomicAdd(&(bar)[XB_TMO], 1u); break; } } } } while (0)
struct XcdBarrier { unsigned* bar; unsigned x; volatile LAS unsigned* st; };
__device__ __forceinline__ XcdBarrier xcd_barrier_post(unsigned* bar, volatile LAS unsigned* st) {
    XcdBarrier b; b.bar = bar; b.x = xb_xcc_id(); b.st = st;
    if (threadIdx.x == 0) (void)xb_add(&bar[XB_XCNT(b.x)], 1u);
    return b;
}
__device__ __forceinline__ void xcd_barrier_complete(unsigned* bar, unsigned x, unsigned& nloc, unsigned& nx) {
    const unsigned G = gridDim.x * gridDim.y * gridDim.z;
    unsigned sum, cnt, mine, sp = 0u;
    for (;;) {
        sum = 0u; cnt = 0u; mine = 0u;
#pragma unroll
        for (unsigned j = 0; j < 16; ++j) { const unsigned c = xb_ld(&bar[XB_XCNT(j)]); sum += c; cnt += (c > 0u) ? 1u : 0u; mine = (j == x) ? c : mine; }
        if (sum == G) break;
        __builtin_amdgcn_s_sleep(1);
        if ((++sp & 255u) == 0u) { if (xb_ld(&bar[XB_TMO])) break; if (sp > XB_SPIN_CAP) { atomicAdd(&bar[XB_TMO], 1u); break; } }
    }
    nloc = mine > 0u ? mine : 1u; nx = cnt > 0u ? cnt : 1u;
}
__device__ __forceinline__ void xcd_barrier(const XcdBarrier& b) {
    asm volatile("s_waitcnt vmcnt(0)" ::: "memory");
    __syncthreads();
    if (threadIdx.x == 0) {
        unsigned* bar = b.bar;
        __builtin_amdgcn_s_waitcnt(0);
        unsigned nloc = b.st[0], nx = b.st[1];
        if (nloc == 0u) { xcd_barrier_complete(bar, b.x, nloc, nx); b.st[0] = nloc; b.st[1] = nx; }
        const unsigned old = xb_add(&bar[XB_XSUB(b.x)], 1u);
        const unsigned gen = old / nloc;
        if (old + 1u == (gen + 1u) * nloc) {
            __builtin_amdgcn_fence(__ATOMIC_RELEASE, "agent");
            asm volatile("s_waitcnt vmcnt(0)" ::: "memory");
            const unsigned og = xb_add(&bar[XB_TOP], 1u);
            const unsigned tg = og / nx;
            if (og + 1u == (tg + 1u) * nx) xb_add(&bar[XB_TOPGEN], 1u);
            else XB_SPIN(xb_ld(&bar[XB_TOPGEN]) == tg, bar);
            __builtin_amdgcn_fence(__ATOMIC_ACQUIRE, "agent");
            xb_add(&bar[XB_XGEN(b.x)], 1u);
            asm volatile("s_waitcnt vmcnt(0)" ::: "memory");
        } else {
            XB_SPIN(xb_ld(&bar[XB_XGEN(b.x)]) == gen, bar);
            __builtin_amdgcn_fence(__ATOMIC_ACQUIRE, "agent");
            asm volatile("s_waitcnt vmcnt(0)" ::: "memory");
        }
    }
    __syncthreads();
}

__device__ __forceinline__ int tidf() { int t = threadIdx.x; asm volatile("" : "+v"(t)); return t; }
__device__ __forceinline__ float wsum(float v) {
#pragma unroll
    for (int o = 1; o < 64; o <<= 1) v += __shfl_xor(v, o);
    return v;
}
__device__ __forceinline__ float sigmoidf_(float x) { return 1.f / (1.f + expf(-x)); }

__device__ __forceinline__ void ph_ln(const float* a, const float* b, const float* g, const float* beta, float* y, float scale) {
    const int lane = tidf() & 63, gw = blockIdx.x * NW + (tidf() >> 6), ngw = gridDim.x * NW;
    for (int row = gw; row < T; row += ngw) {
        float v[16]; float s = 0.f;
#pragma unroll
        for (int j = 0; j < 16; ++j) { const int c = lane + 64 * j; float x = a[(size_t)row * D + c] * scale; if (b) x += b[(size_t)row * D + c]; v[j] = x; s += x; }
        const float mu = wsum(s) * (1.f / D); float q = 0.f;
#pragma unroll
        for (int j = 0; j < 16; ++j) { const float d = v[j] - mu; q += d * d; }
        const float rstd = rsqrtf(wsum(q) * (1.f / D) + LN_EPS);
#pragma unroll
        for (int j = 0; j < 16; ++j) { const int c = lane + 64 * j; y[(size_t)row * D + c] = (v[j] - mu) * rstd * g[c] + beta[c]; }
    }
}
struct EpiPlain { static constexpr bool PAIR = false; float* C; int ldc; float scale;
    __device__ void operator()(int m, int n, float v, int z) const { C[(size_t)m * ldc + n] = v * scale; } };
struct EpiPoolMix { static constexpr bool PAIR = false; float* C; const float* b; const float* ls;
    __device__ void operator()(int m, int n, float v, int z) const { const int c = z * 128 + n; C[(size_t)m * 512 + c] = (v + b[c]) * ls[c]; } };
struct EpiHead { static constexpr bool PAIR = false; float* C; float scale;
    __device__ void operator()(int m, int n, float v, int z) const { C[(size_t)m * 1024 + z * 256 + n] = v * scale; } };
struct EpiE1 { static constexpr bool PAIR = true; float* act; const float* b1;
    __device__ void pair(int m, int n, float vg, float vl, int z) const {
        float g = vg + b1[z * 2048 + n], l = vl + b1[z * 2048 + n + 1];
        g = fminf(g, 7.f); l = fminf(fmaxf(l, -7.f), 7.f);
        act[(size_t)m * 1024 + (n >> 1)] = g * sigmoidf_(1.702f * g) * (l + 1.f); } };
struct EpiE2 { static constexpr bool PAIR = false; float* Y; const float* b2;
    __device__ void operator()(int m, int n, float v, int z) const { Y[(size_t)m * 1024 + n] = v + b2[z * 1024 + n]; } };

template <class Epi>
__device__ __forceinline__ void ph_gemm(LAS float* lds, const float* A, const int* rowidx, const float* B, const int* mcount, const int* mstart,
                                        size_t strideA, size_t strideB, const Epi& epi, int lda, int ldb, int M, int N, int K, int nz, int vb0, int nvb) {
    LAS float* As = lds;
    LAS float* Bs = lds + 16 * 129;
    const int tid = tidf(), tx = tid & 15, ty = tid >> 4;
    const int ntn = (N + 63) / 64, ntm = (M + 127) / 128, per_z = ntn * ntm, total = per_z * nz;
    for (int vt = vb0; vt < total; vt += nvb) {
        const int z = vt / per_z, r = vt % per_z, bm = (r / ntn) * 128, bn = (r % ntn) * 64;
        int Mz = M, m0g = 0;
        if (mcount) { Mz = mcount[z]; m0g = mstart[z]; }
        if (bm >= Mz) continue;
        const float* Az = A + z * strideA; const float* Bz = B + z * strideB;
        float acc[4][4] = {};
        const int ar = tid >> 2, ak = (tid & 3) * 4;
        const int arow = bm + ar; const bool aval = arow < Mz; int asrc = 0;
        if (aval) { const int gr = m0g + arow; asrc = rowidx ? rowidx[gr] : gr; }
        const int bk = tid >> 5, bn2 = (tid & 31) * 2;
        for (int k0 = 0; k0 < K; k0 += 16) {
            float4 av = make_float4(0.f, 0.f, 0.f, 0.f);
            if (aval) av = *(const float4*)(Az + (size_t)asrc * lda + k0 + ak);
            As[(ak + 0) * 129 + ar] = av.x; As[(ak + 1) * 129 + ar] = av.y; As[(ak + 2) * 129 + ar] = av.z; As[(ak + 3) * 129 + ar] = av.w;
#pragma unroll
            for (int j = 0; j < 2; ++j) { const int n = bn + bn2 + j; Bs[bk * 65 + bn2 + j] = (n < N) ? Bz[(size_t)(k0 + bk) * ldb + n] : 0.f; }
            __syncthreads();
#pragma unroll
            for (int kk = 0; kk < 16; ++kk) {
                float a[4], b[4];
#pragma unroll
                for (int i = 0; i < 4; ++i) { a[i] = As[kk * 129 + ty * 4 + i]; b[i] = Bs[kk * 65 + tx * 4 + i]; }
#pragma unroll
                for (int i = 0; i < 4; ++i)
#pragma unroll
                    for (int j = 0; j < 4; ++j) acc[i][j] += a[i] * b[j];
            }
            __syncthreads();
        }
#pragma unroll
        for (int i = 0; i < 4; ++i) { const int m = bm + ty * 4 + i; if (m >= Mz) continue;
            if constexpr (Epi::PAIR) {
#pragma unroll
                for (int j = 0; j < 4; j += 2) { const int n = bn + tx * 4 + j; if (n < N) epi.pair(m0g + m, n, acc[i][j], acc[i][j + 1], z); }
            } else {
#pragma unroll
                for (int j = 0; j < 4; ++j) { const int n = bn + tx * 4 + j; if (n < N) epi(m0g + m, n, acc[i][j], z); }
            } }
    }
}
__device__ __forceinline__ void ph_pool_conv(const float* proj, const float* cw, const float* cb, float* pooled, float* uc) {
    const size_t gt = (size_t)blockIdx.x * NT + tidf(), ngt = (size_t)gridDim.x * NT;
    for (size_t i = gt; i < (size_t)T * 512; i += ngt) {
        const int c = (int)(i % 512); const int tg = (int)(i / 512); const int t = tg % SEQ;
        const int w = 2 << (c >> 7);
        const int cnt = (t + 1 < w) ? t + 1 : w; float s = 0.f;
        for (int j = 0; j < cnt; ++j) s += proj[(size_t)(tg - j) * INC + C_P + c];
        pooled[i] = s / (float)cnt - proj[(size_t)tg * INC + C_P + c];
    }
    for (size_t i = gt; i < (size_t)T * 1024; i += ngt) {
        const int c = (int)(i % 1024); const int tg = (int)(i / 1024); const int t = tg % SEQ;
        float y = cb[c];
#pragma unroll
        for (int j = 0; j < 4; ++j) { const int tt = t - 3 + j; if (tt >= 0) y += proj[(size_t)(tg - 3 + j) * INC + C_U + c] * cw[j * 1024 + c]; }
        uc[i] = y * sigmoidf_(y);
    }
}
constexpr int MB = 16;
__device__ __forceinline__ void ph_mlstm(LAS float* lds, int vb, const float* q, const float* k, const float* vv, const float* gif, float* hm) {
    const int bh = vb >> 1, b = bh >> 2, h = bh & 3;
    const int tid = tidf(), e = (vb & 1) * 128 + (tid >> 2), dq = tid & 3;
    LAS float* sq = lds; LAS float* sk = lds + MB * 256; LAS float* sv = lds + 2 * MB * 256; LAS float* si = lds + 3 * MB * 256; LAS float* sf = si + MB;
    float C[64]; float n[16];
#pragma unroll
    for (int j = 0; j < 64; ++j) C[j] = 0.f;
#pragma unroll
    for (int j = 0; j < 16; ++j) n[j] = 0.f;
    float m = 0.f;
    const int nsub = (e & 3) * 16;
    for (int t0 = 0; t0 < SEQ; t0 += MB) {
        __syncthreads();
        for (int i = tid; i < MB * 256; i += NT) { const int tt = i >> 8, d = i & 255; const size_t tg = (size_t)b * SEQ + t0 + tt;
            sq[tt * 256 + d] = q[tg * 1024 + h * 256 + d]; sk[tt * 256 + d] = k[tg * 1024 + h * 256 + d]; sv[tt * 256 + d] = vv[tg * 1024 + h * 256 + d]; }
        if (tid < MB) { const size_t tg = (size_t)b * SEQ + t0 + tid; si[tid] = gif[tg * 8 + h]; sf[tid] = gif[tg * 8 + 4 + h]; }
        __syncthreads();
        for (int tt = 0; tt < MB; ++tt) {
            const float ip = si[tt], fp = sf[tt];
            const float lf = fminf(fp, 0.f) - log1pf(expf(-fabsf(fp)));
            const float mn = fmaxf(lf + m, ip);
            const float fd = expf(lf + m - mn), iw = expf(ip - mn);
            m = mn;
            const float ve = sv[tt * 256 + e] * iw;
            float num = 0.f, den = 0.f;
#pragma unroll
            for (int j = 0; j < 64; ++j) { const float kk = sk[tt * 256 + dq * 64 + j]; C[j] = fd * C[j] + ve * kk; num += C[j] * sq[tt * 256 + dq * 64 + j]; }
#pragma unroll
            for (int j = 0; j < 16; ++j) { const int d = dq * 64 + nsub + j; n[j] = fd * n[j] + iw * sk[tt * 256 + d]; den += n[j] * sq[tt * 256 + d]; }
            num += __shfl_xor(num, 1); num += __shfl_xor(num, 2);
            den += __shfl_xor(den, 1); den += __shfl_xor(den, 2); den += __shfl_xor(den, 4); den += __shfl_xor(den, 8);
            if (dq == 0) { const float dn = fmaxf(fabsf(den), expf(-mn)); hm[((size_t)b * SEQ + t0 + tt) * 1024 + h * 256 + e] = num / dn; }
        }
    }
    __syncthreads();
}
__device__ __forceinline__ void ph_hnorm(float* hm, const float* opre, const float* gain) {
    const int lane = tidf() & 63, gw = blockIdx.x * NW + (tidf() >> 6), ngw = gridDim.x * NW;
    for (int w = gw; w < T * 4; w += ngw) {
        const int tg = w >> 2, h = w & 3;
        float v[4]; float s = 0.f;
#pragma unroll
        for (int j = 0; j < 4; ++j) { v[j] = hm[(size_t)tg * 1024 + h * 256 + lane + 64 * j]; s += v[j]; }
        const float mu = wsum(s) * (1.f / 256); float qq = 0.f;
#pragma unroll
        for (int j = 0; j < 4; ++j) { const float d = v[j] - mu; qq += d * d; }
        const float rstd = rsqrtf(wsum(qq) * (1.f / 256) + LN_EPS);
#pragma unroll
        for (int j = 0; j < 4; ++j) { const int c = h * 256 + lane + 64 * j; hm[(size_t)tg * 1024 + c] = (v[j] - mu) * rstd * gain[c] * sigmoidf_(opre[(size_t)tg * 1024 + c]); }
    }
}
__device__ __forceinline__ void ph_merge(const float* gates, const float* ypool, float* ymls) {
    const size_t gt = (size_t)blockIdx.x * NT + tidf(), ngt = (size_t)gridDim.x * NT;
    for (size_t i = gt; i < (size_t)T * 1024; i += ngt) {
        const int c = (int)(i % 1024); const size_t tg = i / 1024;
        const float g0 = sigmoidf_(gates[tg * 2048 + c]), g1 = sigmoidf_(gates[tg * 2048 + 1024 + c]);
        ymls[i] = g0 * ypool[i] + g1 * ymls[i];
    }
}
__device__ __forceinline__ void ph_router(const float* h1, const float* wr, const float* br, int* top_idx, float* top_gate, int* cnt) {
    const int lane = tidf() & 63, gw = blockIdx.x * NW + (tidf() >> 6), ngw = gridDim.x * NW;
    for (int tg = gw; tg < T; tg += ngw) {
        const int e = lane & 31, half = lane >> 5;
        float s = 0.f;
        for (int kk = 0; kk < 512; ++kk) { const int kx = half * 512 + kk; s += h1[(size_t)tg * D + kx] * wr[kx * NE + e]; }
        s += __shfl_xor(s, 32); s += br[e];
        float val = s; int idxs[4]; float vals[4];
#pragma unroll
        for (int r = 0; r < 4; ++r) {
            float bv = val; int bi = e;
#pragma unroll
            for (int o = 1; o < 32; o <<= 1) { const float ov = __shfl_xor(bv, o); const int oi = __shfl_xor(bi, o); if (ov > bv || (ov == bv && oi < bi)) { bv = ov; bi = oi; } }
            idxs[r] = bi; vals[r] = bv; if (e == bi) val = -INFINITY;
        }
        const float mx = vals[0]; float ex[4], se = 0.f;
#pragma unroll
        for (int r = 0; r < 4; ++r) { ex[r] = expf(vals[r] - mx); se += ex[r]; }
#pragma unroll
        for (int r = 0; r < 4; ++r) if (lane == r) { top_idx[tg * 4 + r] = idxs[r]; top_gate[tg * 4 + r] = ex[r] / se; atomicAdd(&cnt[idxs[r]], 1); }
    }
}
__device__ __forceinline__ void ph_place(const int* top_idx, const int* start, int* fill, int* row_tok, int* row_of) {
    const int gt = blockIdx.x * NT + tidf(), ngt = gridDim.x * NT;
    for (int i = gt; i < NA; i += ngt) { const int e = top_idx[i]; const int r = atomicAdd(&fill[e], 1); const int dest = start[e] + r; row_tok[dest] = i >> 2; row_of[i] = dest; }
}
__device__ __forceinline__ void ph_final(const float* h1, const float* Y, const int* row_of, const float* gate, const float* g, const float* beta, float* out) {
    const int lane = tidf() & 63, gw = blockIdx.x * NW + (tidf() >> 6), ngw = gridDim.x * NW;
    for (int tg = gw; tg < T; tg += ngw) {
        int ro[4]; float gt[4];
#pragma unroll
        for (int r = 0; r < 4; ++r) { ro[r] = row_of[tg * 4 + r]; gt[r] = gate[tg * 4 + r]; }
        float v[16]; float s = 0.f;
#pragma unroll
        for (int j = 0; j < 16; ++j) { const int c = lane + 64 * j; float x = ALPHA * h1[(size_t)tg * D + c];
#pragma unroll
            for (int r = 0; r < 4; ++r) x += gt[r] * Y[(size_t)ro[r] * 1024 + c];
            v[j] = x; s += x; }
        const float mu = wsum(s) * (1.f / D); float qq = 0.f;
#pragma unroll
        for (int j = 0; j < 16; ++j) { const float d = v[j] - mu; qq += d * d; }
        const float rstd = rsqrtf(wsum(qq) * (1.f / D) + LN_EPS);
#pragma unroll
        for (int j = 0; j < 16; ++j) { const int c = lane + 64 * j; out[(size_t)tg * D + c] = (v[j] - mu) * rstd * g[c] + beta[c]; }
    }
}


namespace pg {
typedef unsigned short bf16_t;
typedef short bf16x8 __attribute__((ext_vector_type(8)));
typedef float f32x4 __attribute__((ext_vector_type(4)));
typedef float f32x2 __attribute__((ext_vector_type(2)));
typedef unsigned u32x4 __attribute__((ext_vector_type(4)));
typedef unsigned u32x2 __attribute__((ext_vector_type(2)));
constexpr int BM = 256, BK = 64, HALF = 128, HTB = HALF * BK * 2, STAGE_BYTES = 8 * HTB, NXCD = 8, WGM = 8;
__host__ __device__ __forceinline__ int lds_byte(int r, int c) { const int st = (r >> 4) * 2 + (c >> 5), rr = r & 15, cc = c & 31, ob = rr * 64 + cc * 2; return st * 1024 + (ob ^ (((ob >> 9) & 1) << 5)); }
__host__ __device__ __forceinline__ void stage_rc(int b, int& R, int& C) { const int st = b / 1024, sb = b % 1024, swz = sb ^ (((sb >> 9) & 1) << 5); R = (st >> 1) * 16 + swz / 64; C = (st & 1) * 32 + (swz % 64) / 2; }
__host__ __device__ __forceinline__ int perm32(int rho) { const int n = rho >> 4, i = rho & 15; return 8 * (i >> 2) + 4 * n + (i & 3); }
__device__ __forceinline__ unsigned cvt_pk_bf16(float lo, float hi) { unsigned r; asm volatile("v_cvt_pk_bf16_f32 %0, %1, %2" : "=v"(r) : "v"(lo), "v"(hi)); return r; }

struct Unit { const char* A; const char* B; const int* rows; int nvalid; int pm, pn, g, aux; };

struct TileOrder {
    int nM, nN, per_g, nwg, G, c;
    __device__ __forceinline__ void init(int nM_, int nN_, int ng, int G_, int c_) { nM = nM_; nN = nN_; per_g = nM * nN; nwg = per_g * ng; G = G_; c = c_; }
    __device__ __forceinline__ bool tile(int i, int& g, int& pm, int& pn) const {
        const long L = (long)i * G + c; if (L >= nwg) return false;
        int wgid = (int)L; { const int q = nwg / NXCD, r = nwg % NXCD, xcd = wgid % NXCD, off = wgid / NXCD; wgid = (xcd < r ? xcd * (q + 1) : r * (q + 1) + (xcd - r) * q) + off; }
        g = wgid / per_g; wgid -= g * per_g;
        const int nig = WGM * nN, gid = wgid / nig, fm = gid * WGM, gsz = (nM - fm) < WGM ? (nM - fm) : WGM;
        pm = fm + ((wgid % nig) % gsz); pn = (wgid % nig) / gsz; return true;
    }
};

template <class Epi, class Sched, bool GATHER = false>
__device__ __forceinline__ void gemm_phase(LAS unsigned char* lds, const int lda, const int ldb, const int K, const Sched& S, const Epi& E) {
    const int tid = tidf(), wid = __builtin_amdgcn_readfirstlane(tid >> 6), lane = tid & 63, wr = wid >> 2, wc = wid & 3, fr = lane & 15, fq = lane >> 4;
    const int nt = K / BK;
    unsigned voffA[2], voffB[2]; int Rst[2], Cst[2];
#pragma unroll
    for (int i = 0; i < 2; ++i) { int R, C; stage_rc(tid * 16 + i * 8192, R, C); const int Rb = Epi::PERM ? ((R & ~31) + perm32(R & 31)) : R;
        Rst[i] = R; Cst[i] = C; voffA[i] = (unsigned)(R * lda + C) * 2u; voffB[i] = (unsigned)(Rb * ldb + C) * 2u; }
    const size_t kstep = (size_t)(BK * 2);
    const size_t hstepA = GATHER ? 0 : (size_t)HALF * lda * 2, hstepB = (size_t)HALF * ldb * 2;
    const unsigned ldsw = (unsigned)wid * 1024u;
    const int aoff = lds_byte(wr * 64 + fr, fq * 8), boff = lds_byte(wc * 32 + fr, fq * 8);
#define PG_SA(b, h) (((b) * 2 + (h)) * HTB)
#define PG_SB(b, h) ((4 + (b) * 2 + (h)) * HTB)
#define PG_STAGE(bufoff, gbase, voff) do { _Pragma("unroll") for (int _i = 0; _i < 2; ++_i) \
        __builtin_amdgcn_global_load_lds((const unsigned*)((const char*)(gbase) + (voff)[_i]), (LAS unsigned*)(lds + (bufoff) + ldsw + _i * 8192), 16, 0, 0); } while (0)
#define PG_LDA(dst, b, h) do { _Pragma("unroll") for (int m = 0; m < 4; ++m) _Pragma("unroll") for (int k = 0; k < 2; ++k) dst[m][k] = *(const LAS bf16x8*)(lds + PG_SA(b, h) + aoff + m * 2048 + k * 1024); } while (0)
#define PG_LDB(dst, b, h) do { _Pragma("unroll") for (int n = 0; n < 2; ++n) _Pragma("unroll") for (int k = 0; k < 2; ++k) dst[n][k] = *(const LAS bf16x8*)(lds + PG_SB(b, h) + boff + n * 2048 + k * 1024); } while (0)
#define PG_MMA(ai, bj, At, Bt) do { __builtin_amdgcn_s_setprio(1); _Pragma("unroll") for (int m = 0; m < 4; ++m) _Pragma("unroll") for (int n = 0; n < 2; ++n) _Pragma("unroll") for (int k = 0; k < 2; ++k) \
        acc[ai][bj][m][n] = __builtin_amdgcn_mfma_f32_16x16x32_bf16(Bt[n][k], At[m][k], acc[ai][bj][m][n], 0, 0, 0); __builtin_amdgcn_s_setprio(0); } while (0)
#define PG_WAIT_V(n) asm volatile("s_waitcnt vmcnt(" #n ")" ::: "memory")
#define PG_WAIT_L(n) asm volatile("s_waitcnt lgkmcnt(" #n ")" ::: "memory")
#define PG_BAR __builtin_amdgcn_s_barrier()
#define PG_SCHED __builtin_amdgcn_sched_barrier(0)
    Unit cur, nxt; int ui = 0;
    if (!S.next(0, cur)) return;
    f32x4 acc[2][2][4][2];
#pragma unroll
    for (int a = 0; a < 2; ++a)
#pragma unroll
        for (int b = 0; b < 2; ++b)
#pragma unroll
            for (int m = 0; m < 4; ++m)
#pragma unroll
                for (int n = 0; n < 2; ++n) acc[a][b][m][n] = (f32x4){0.f, 0.f, 0.f, 0.f};
    bf16x8 At[4][2], B0[2][2], B1[2][2];
    unsigned gA0[2], gA1[2], nA0[2], nA1[2];
    auto gather_offs = [&](const Unit& u, unsigned (&o0)[2], unsigned (&o1)[2]) {
#pragma unroll
        for (int i = 0; i < 2; ++i) {
            const int r0 = Rst[i], r1 = HALF + Rst[i];
            const int t0 = (r0 < u.nvalid) ? u.rows[r0] : 0, t1 = (r1 < u.nvalid) ? u.rows[r1] : 0;
            o0[i] = (unsigned)(t0 * lda + Cst[i]) * 2u; o1[i] = (unsigned)(t1 * lda + Cst[i]) * 2u; }
    };
    if constexpr (GATHER) { gather_offs(cur, gA0, gA1); } else {
#pragma unroll
        for (int i = 0; i < 2; ++i) { gA0[i] = voffA[i]; gA1[i] = voffA[i]; nA0[i] = voffA[i]; nA1[i] = voffA[i]; } }
    const char* cA = cur.A; const char* cB = cur.B;
    PG_STAGE(PG_SB(0, 0), cB, voffB); PG_STAGE(PG_SB(0, 1), cB + hstepB, voffB); PG_STAGE(PG_SA(0, 0), cA, gA0); PG_STAGE(PG_SA(0, 1), cA + hstepA, gA1);
    if (wr == 1) PG_BAR;
    PG_WAIT_V(2); PG_BAR;
    PG_STAGE(PG_SB(1, 0), cB + kstep, voffB); PG_STAGE(PG_SA(1, 0), cA + kstep, gA0); PG_STAGE(PG_SB(1, 1), cB + hstepB + kstep, voffB);
    PG_WAIT_V(6); PG_BAR;
    for (;;) {
        const bool has_next = S.next(ui + 1, nxt);
        const char* nA = has_next ? nxt.A : cA; const char* nB = has_next ? nxt.B : cB;
        if constexpr (GATHER) { if (has_next) gather_offs(nxt, nA0, nA1); else {
#pragma unroll
            for (int i = 0; i < 2; ++i) { nA0[i] = gA0[i]; nA1[i] = gA1[i]; } } }
#pragma unroll 1
        for (int t = 0; t < nt; t += 2) {
            const bool last = (t == nt - 2);
            const char* a1 = cA + (size_t)(t + 1) * kstep;
            const char* a2 = last ? nA : cA + (size_t)(t + 2) * kstep; const char* b2 = last ? nB : cB + (size_t)(t + 2) * kstep;
            const char* a3 = a2 + kstep; const char* b3 = b2 + kstep;
            unsigned x0[2], x1[2];
#pragma unroll
            for (int i = 0; i < 2; ++i) { x0[i] = (GATHER && last) ? nA0[i] : gA0[i]; x1[i] = (GATHER && last) ? nA1[i] : gA1[i]; }
            PG_LDB(B0, 0, 0); PG_LDB(B1, 0, 1); PG_SCHED; PG_LDA(At, 0, 0); PG_STAGE(PG_SA(1, 1), a1 + hstepA, gA1);
            PG_WAIT_V(8); PG_WAIT_L(0); PG_BAR; PG_MMA(0, 0, At, B0); PG_MMA(0, 1, At, B1); PG_BAR; PG_SCHED;
            PG_LDA(At, 0, 1); PG_STAGE(PG_SB(0, 0), b2, voffB); PG_STAGE(PG_SB(0, 1), b2 + hstepB, voffB); PG_STAGE(PG_SA(0, 0), a2, x0);
            PG_WAIT_V(8); PG_WAIT_L(0); PG_BAR; PG_MMA(1, 0, At, B0); PG_MMA(1, 1, At, B1); PG_BAR; PG_SCHED;
            PG_LDB(B0, 1, 0); PG_LDB(B1, 1, 1); PG_SCHED; PG_LDA(At, 1, 0); PG_STAGE(PG_SA(0, 1), a2 + hstepA, x1);
            PG_WAIT_V(8); PG_WAIT_L(0); PG_BAR; PG_MMA(0, 0, At, B0); PG_MMA(0, 1, At, B1); PG_BAR; PG_SCHED;
            PG_LDA(At, 1, 1); PG_STAGE(PG_SB(1, 0), b3, voffB); PG_STAGE(PG_SB(1, 1), b3 + hstepB, voffB); PG_STAGE(PG_SA(1, 0), a3, x0);
            PG_WAIT_V(8); PG_WAIT_L(0); PG_BAR; PG_MMA(1, 0, At, B0); PG_MMA(1, 1, At, B1); PG_BAR; PG_SCHED;
        }
        if (wr == 0) PG_BAR;
        if constexpr (!Epi::AFTER_DRAIN) { E(acc, cur, wr, wc, fr, fq); }
        if (!has_next) break;
#pragma unroll
        for (int a = 0; a < 2; ++a)
#pragma unroll
            for (int b = 0; b < 2; ++b)
#pragma unroll
                for (int m = 0; m < 4; ++m)
#pragma unroll
                    for (int n = 0; n < 2; ++n) acc[a][b][m][n] = (f32x4){0.f, 0.f, 0.f, 0.f};
        cur = nxt; cA = nA; cB = nB; ++ui;
        if constexpr (GATHER) {
#pragma unroll
            for (int i = 0; i < 2; ++i) { gA0[i] = nA0[i]; gA1[i] = nA1[i]; } }
        if (wr == 1) PG_BAR;
    }
    PG_WAIT_V(0);
    PG_BAR;
    if constexpr (Epi::AFTER_DRAIN) { E.fused(acc, cur, wr, wc, fr, fq, lds, wid, lane); }
#undef PG_SA
#undef PG_SB
#undef PG_STAGE
#undef PG_LDA
#undef PG_LDB
#undef PG_MMA
#undef PG_WAIT_V
#undef PG_WAIT_L
#undef PG_BAR
#undef PG_SCHED
}

struct EpiStoreBf16 {
    static constexpr bool PERM = true, AFTER_DRAIN = false;
    bf16_t* O; int ldc; float scale; int gcol;
    __device__ __forceinline__ void operator()(const f32x4 (&acc)[2][2][4][2], const Unit& u, int wr, int wc, int fr, int fq) const {
        bf16_t* base = O + (size_t)(u.pm * BM + wr * 64 + fr) * ldc + u.g * gcol + u.pn * BM + wc * 32 + 8 * fq;
#pragma unroll
        for (int ai = 0; ai < 2; ++ai)
#pragma unroll
            for (int m = 0; m < 4; ++m) { bf16_t* rowp = base + (size_t)(ai * HALF + m * 16) * ldc;
#pragma unroll
                for (int bj = 0; bj < 2; ++bj) { const f32x4 v0 = acc[ai][bj][m][0] * scale, v1 = acc[ai][bj][m][1] * scale;
                    u32x4 w; w.x = cvt_pk_bf16(v0[0], v0[1]); w.y = cvt_pk_bf16(v0[2], v0[3]); w.z = cvt_pk_bf16(v1[0], v1[1]); w.w = cvt_pk_bf16(v1[2], v1[3]);
                    *(u32x4*)(rowp + bj * HALF) = w; } }
    }
};
}

constexpr int PROJW = 4608;
constexpr int PJ_P = 0, PJ_U = 512, PJ_O = 1536, PJ_G = 2560;
constexpr int WIN_ROWS = 5632;

__device__ __forceinline__ unsigned f2bf(float f) { unsigned u = __builtin_bit_cast(unsigned, f); return (u + 0x7fffu + ((u >> 16) & 1u)) >> 16; }
__device__ __forceinline__ unsigned pk2(float lo, float hi) { return f2bf(lo) | (f2bf(hi) << 16); }
__device__ __forceinline__ float bf2f(unsigned short b) { return __builtin_bit_cast(float, (unsigned)b << 16); }

template <bool INTERLEAVED>
__device__ __forceinline__ void transpose64(const float* W, int ldw, int k0, int n0, pg::bf16_t* WT, size_t drow0, int ldt, LAS float* scr, int lane) {
    pg::f32x4 r[16];
    const float* src = W + (size_t)(k0 + (lane >> 4)) * ldw + n0 + 4 * (lane & 15);
#pragma unroll
    for (int i = 0; i < 16; ++i) r[i] = *(const pg::f32x4*)(src + (size_t)(4 * i) * ldw);
#pragma unroll
    for (int i = 0; i < 16; ++i) { const int k = (lane >> 4) + 4 * i; LAS float* d = scr + (4 * (lane & 15)) * 65 + k;
        d[0] = r[i].x; d[65] = r[i].y; d[130] = r[i].z; d[195] = r[i].w; }
    asm volatile("s_waitcnt lgkmcnt(0)" ::: "memory");
#pragma unroll
    for (int it = 0; it < 8; ++it) { const int nl = (lane >> 3) + 8 * it, kg = lane & 7; const LAS float* p = scr + nl * 65 + 8 * kg;
        pg::u32x4 o; o.x = pk2(p[0], p[1]); o.y = pk2(p[2], p[3]); o.z = pk2(p[4], p[5]); o.w = pk2(p[6], p[7]);
        const size_t drow = INTERLEAVED ? drow0 + (size_t)(nl & 1) * 128 + (nl >> 1) : drow0 + nl;
        *(pg::u32x4*)(WT + drow * ldt + k0 + 8 * kg) = o; }
    asm volatile("s_waitcnt lgkmcnt(0)" ::: "memory");
}
__device__ __forceinline__ int win_src_col(int r) { return r < 1536 ? r : (r < 2560 ? r + 1024 : (r < 4608 ? r - 2560 + C_G : r - 4608 + C_V)); }

struct OptBufs {
    pg::bf16_t *WinT, *H0B, *PROJ, *BT2;
    float *gif, *stats;
};
__device__ __forceinline__ void ph_prep_weights(LAS unsigned char* lds, const OptBufs& o, const float* w_in) {
    const int tid = tidf(), lane = tid & 63, wave = tid >> 6, gw = blockIdx.x * NW + wave, ngw = gridDim.x * NW;
    LAS float* scr = (LAS float*)(lds + wave * 16640);
    constexpr int I_IN = (WIN_ROWS / 64) * (D / 64);
    for (int it = gw; it < I_IN; it += ngw) { const int rb = it / (D / 64), kb = it % (D / 64);
        transpose64<false>(w_in, INC, kb * 64, win_src_col(rb * 64), o.WinT, (size_t)rb * 64, D, scr, lane); }
}
__device__ __forceinline__ void ph_ln0(LAS unsigned char* lds, const OptBufs& o, const float* x, const float* g, const float* beta, const float* w_in, const float* b_if) {
    const int tid = tidf(), lane = tid & 63, wave = tid >> 6, gw = blockIdx.x * NW + wave, ngw = gridDim.x * NW;
    LAS float* wif = (LAS float*)lds;
    __syncthreads();
    for (int i = tid; i < 1024 * 8; i += NT) wif[i] = w_in[(size_t)(i >> 3) * INC + C_IF + (i & 7)];
    __syncthreads();
    for (int row = gw; row < T; row += ngw) {
        const pg::f32x4* xr = (const pg::f32x4*)(x + (size_t)row * D) + lane;
        pg::f32x4 v[4]; float s = 0.f;
#pragma unroll
        for (int j = 0; j < 4; ++j) { v[j] = xr[64 * j]; s += (v[j].x + v[j].y) + (v[j].z + v[j].w); }
        const float mean = wsum(s) * (1.f / D); float s2 = 0.f;
#pragma unroll
        for (int j = 0; j < 4; ++j) { v[j] = v[j] - mean; s2 += (v[j].x * v[j].x + v[j].y * v[j].y) + (v[j].z * v[j].z + v[j].w * v[j].w); }
        const float rstd = rsqrtf(wsum(s2) * (1.f / D) + LN_EPS);
        float acc8[8];
#pragma unroll
        for (int q = 0; q < 8; ++q) acc8[q] = 0.f;
        unsigned long long* o8 = (unsigned long long*)(o.H0B + (size_t)row * D) + lane;
#pragma unroll
        for (int j = 0; j < 4; ++j) {
            const int c0 = 256 * j + 4 * lane;
            const pg::f32x4 gg = *(const pg::f32x4*)(g + c0), bb = *(const pg::f32x4*)(beta + c0);
            const pg::f32x4 y = v[j] * rstd * gg + bb;
            o8[64 * j] = (unsigned long long)pk2(y.x, y.y) | ((unsigned long long)pk2(y.z, y.w) << 32);
#pragma unroll
            for (int i = 0; i < 4; ++i) { const LAS float* wr_ = wif + (c0 + i) * 8;
#pragma unroll
                for (int q = 0; q < 8; ++q) acc8[q] += y[i] * wr_[q]; }
        }
#pragma unroll
        for (int q = 0; q < 8; ++q) acc8[q] = wsum(acc8[q]);
        if (lane < 8) { float r = acc8[0];
#pragma unroll
            for (int q = 1; q < 8; ++q) r = (lane == q) ? acc8[q] : r;
            o.gif[(size_t)row * 8 + lane] = r + b_if[lane]; }
        if (lane == 0) { o.stats[(size_t)row * 2] = mean; o.stats[(size_t)row * 2 + 1] = rstd; }
    }
    __syncthreads();
}
struct SchedInproj {
    pg::TileOrder o; const char* A; const char* B;
    __device__ __forceinline__ bool next(int i, pg::Unit& u) const { int g, pm, pn; if (!o.tile(i, g, pm, pn)) return false;
        u.A = A + (size_t)pm * 256 * D * 2; u.B = B + (size_t)pn * 256 * D * 2; u.pm = pm; u.pn = pn; u.g = 0; u.aux = 0; u.rows = nullptr; u.nvalid = 0; return true; }
};
struct SchedVT {
    pg::TileOrder o; const char* A; const char* B;
    __device__ __forceinline__ bool next(int i, pg::Unit& u) const { int g, pm, pn; if (!o.tile(i, g, pm, pn)) return false;
        u.A = A + (size_t)pm * 256 * D * 2; u.B = B + (size_t)pn * 256 * D * 2; u.pm = pm; u.pn = pn; u.g = 0; u.aux = 0; u.rows = nullptr; u.nvalid = 0; return true; }
};
struct EpiVT {
    static constexpr bool PERM = true, AFTER_DRAIN = false;
    pg::bf16_t* BT2;
    __device__ __forceinline__ void operator()(const pg::f32x4 (&acc)[2][2][4][2], const pg::Unit& u, int wr, int wc, int fr, int fq) const {
        const int h = u.pm, b = u.pn >> 4, c = u.pn & 15;
        pg::bf16_t* base = BT2 + ((size_t)((b * 4 + h) * 16 + c) * 256 + wr * 64 + fr) * 512 + wc * 32 + 8 * fq;
#pragma unroll
        for (int ai = 0; ai < 2; ++ai)
#pragma unroll
            for (int m = 0; m < 4; ++m) { pg::bf16_t* rowp = base + (size_t)(ai * 128 + m * 16) * 512;
#pragma unroll
                for (int bj = 0; bj < 2; ++bj) { const pg::f32x4 v0 = acc[ai][bj][m][0], v1 = acc[ai][bj][m][1];
                    pg::u32x4 w; w.x = pg::cvt_pk_bf16(v0[0], v0[1]); w.y = pg::cvt_pk_bf16(v0[2], v0[3]); w.z = pg::cvt_pk_bf16(v1[0], v1[1]); w.w = pg::cvt_pk_bf16(v1[2], v1[3]);
                    *(pg::u32x4*)(rowp + bj * 128) = w; } }
    }
};
__device__ __forceinline__ void ph_inproj(LAS unsigned char* lds, const OptBufs& o) {
    const int G = gridDim.x, bx = blockIdx.x;
    { SchedInproj S; S.o.init(T / 256, PROJW / 256, 1, G, bx); S.A = (const char*)o.H0B; S.B = (const char*)o.WinT;
      pg::EpiStoreBf16 E{o.PROJ, PROJW, 1.f, 0}; pg::gemm_phase<pg::EpiStoreBf16, SchedInproj>(lds, D, D, D, S, E); }
    { SchedVT S; S.o.init(4, T / 256, 1, G, (bx + 128) % G); S.A = (const char*)(o.WinT + (size_t)PROJW * D); S.B = (const char*)o.H0B;
      EpiVT E{o.BT2}; pg::gemm_phase<EpiVT, SchedVT>(lds, D, D, D, S, E); }
}

struct OptBufs2 { pg::bf16_t *WqT, *WkT, *WpoolT, *WbpT, *POOLED, *UC, *MIXED, *Q, *K, *YPOOL; };
__device__ __forceinline__ void ph_prep_weights2(LAS unsigned char* lds, const OptBufs2& o, const float* w_q, const float* w_k, const float* w_pool, const float* w_bp) {
    const int tid = tidf(), lane = tid & 63, wave = tid >> 6, gw = blockIdx.x * NW + wave, ngw = gridDim.x * NW;
    LAS float* scr = (LAS float*)(lds + wave * 16640);
    for (int it = gw; it < 2 * 4 * 16; it += ngw) { const int which = it >> 6, r = it & 63, h = r >> 4, nb = (r & 15) >> 2, kb = r & 3;
        transpose64<false>((which ? w_k : w_q) + (size_t)h * 65536, 256, kb * 64, nb * 64, (which ? o.WkT : o.WqT) + (size_t)h * 65536, (size_t)nb * 64, 256, scr, lane); }
    for (int it = gw; it < 4 * 2 * 2; it += ngw) { const int g = it >> 2, nb = (it & 3) >> 1, kb = it & 1;
        transpose64<false>(w_pool + (size_t)g * 16384, 128, kb * 64, nb * 64, o.WpoolT + g * 128, (size_t)g * 128 + nb * 64, 512, scr, lane); }
    { const size_t gt = (size_t)blockIdx.x * NT + tid, ngt = (size_t)gridDim.x * NT;
      for (size_t ch = gt; ch < 512 * 64; ch += ngt) { const int n = (int)(ch >> 6), k8 = (int)(ch & 63) * 8; if ((n >> 7) != (k8 >> 7)) *(pg::u32x4*)(o.WpoolT + (size_t)n * 512 + k8) = (pg::u32x4){0u, 0u, 0u, 0u}; } }
    for (int it = gw; it < 16 * 8; it += ngw) { const int nb = it >> 3, kb = it & 7;
        transpose64<false>(w_bp, 1024, kb * 64, nb * 64, o.WbpT, (size_t)nb * 64, 512, scr, lane); }
}
__device__ __forceinline__ void ld8(const pg::bf16_t* p, float (&v)[8]) { const pg::u32x4 w = *(const pg::u32x4*)p;
    v[0] = __builtin_bit_cast(float, w.x << 16); v[1] = __builtin_bit_cast(float, w.x & 0xffff0000u); v[2] = __builtin_bit_cast(float, w.y << 16); v[3] = __builtin_bit_cast(float, w.y & 0xffff0000u);
    v[4] = __builtin_bit_cast(float, w.z << 16); v[5] = __builtin_bit_cast(float, w.z & 0xffff0000u); v[6] = __builtin_bit_cast(float, w.w << 16); v[7] = __builtin_bit_cast(float, w.w & 0xffff0000u); }
__device__ __forceinline__ void st8(pg::bf16_t* p, const float (&v)[8]) { pg::u32x4 w; w.x = pk2(v[0], v[1]); w.y = pk2(v[2], v[3]); w.z = pk2(v[4], v[5]); w.w = pk2(v[6], v[7]); *(pg::u32x4*)p = w; }
__device__ __forceinline__ void ph_poolconv_opt(const pg::bf16_t* PROJ, const float* cw, const float* cb, pg::bf16_t* POOLED, pg::bf16_t* UC) {
    const int gt = blockIdx.x * NT + tidf(), ngt = gridDim.x * NT;
    for (int it = gt; it < 512 * 192; it += ngt) {
        const int run = it / 192, oc = it % 192; const int t0 = run * 32, tpos0 = t0 & (SEQ - 1);
        if (oc < 64) {
            const int c0 = oc * 8, w = 2 << (c0 >> 7);
            const pg::bf16_t* src = PROJ + PJ_P + c0;
            float s[8];
#pragma unroll
            for (int q = 0; q < 8; ++q) s[q] = 0.f;
            { pg::u32x4 hv[15];
#pragma unroll
              for (int j = 1; j < 16; ++j) hv[j - 1] = (j < w && tpos0 - j >= 0) ? *(const pg::u32x4*)(src + (size_t)(t0 - j) * PROJW) : (pg::u32x4){0u, 0u, 0u, 0u};
#pragma unroll
              for (int j = 0; j < 15; ++j) { s[0] += __builtin_bit_cast(float, hv[j].x << 16); s[1] += __builtin_bit_cast(float, hv[j].x & 0xffff0000u); s[2] += __builtin_bit_cast(float, hv[j].y << 16); s[3] += __builtin_bit_cast(float, hv[j].y & 0xffff0000u);
                  s[4] += __builtin_bit_cast(float, hv[j].z << 16); s[5] += __builtin_bit_cast(float, hv[j].z & 0xffff0000u); s[6] += __builtin_bit_cast(float, hv[j].w << 16); s[7] += __builtin_bit_cast(float, hv[j].w & 0xffff0000u); } }
            for (int i0 = 0; i0 < 32; i0 += 8) {
                pg::u32x4 cv[8], ov[8];
#pragma unroll
                for (int i = 0; i < 8; ++i) { const int t = t0 + i0 + i, tp = tpos0 + i0 + i; cv[i] = *(const pg::u32x4*)(src + (size_t)t * PROJW);
                    ov[i] = (tp - w + 1 >= 0) ? *(const pg::u32x4*)(src + (size_t)(t - w + 1) * PROJW) : (pg::u32x4){0u, 0u, 0u, 0u}; }
#pragma unroll
                for (int i = 0; i < 8; ++i) { const int t = t0 + i0 + i, tp = tpos0 + i0 + i; float cur[8], old[8], o[8];
                    cur[0] = __builtin_bit_cast(float, cv[i].x << 16); cur[1] = __builtin_bit_cast(float, cv[i].x & 0xffff0000u); cur[2] = __builtin_bit_cast(float, cv[i].y << 16); cur[3] = __builtin_bit_cast(float, cv[i].y & 0xffff0000u);
                    cur[4] = __builtin_bit_cast(float, cv[i].z << 16); cur[5] = __builtin_bit_cast(float, cv[i].z & 0xffff0000u); cur[6] = __builtin_bit_cast(float, cv[i].w << 16); cur[7] = __builtin_bit_cast(float, cv[i].w & 0xffff0000u);
                    old[0] = __builtin_bit_cast(float, ov[i].x << 16); old[1] = __builtin_bit_cast(float, ov[i].x & 0xffff0000u); old[2] = __builtin_bit_cast(float, ov[i].y << 16); old[3] = __builtin_bit_cast(float, ov[i].y & 0xffff0000u);
                    old[4] = __builtin_bit_cast(float, ov[i].z << 16); old[5] = __builtin_bit_cast(float, ov[i].z & 0xffff0000u); old[6] = __builtin_bit_cast(float, ov[i].w << 16); old[7] = __builtin_bit_cast(float, ov[i].w & 0xffff0000u);
                    const float inv = 1.f / (float)((tp + 1 < w) ? tp + 1 : w);
#pragma unroll
                    for (int q = 0; q < 8; ++q) { s[q] += cur[q]; o[q] = s[q] * inv - cur[q]; s[q] -= old[q]; }
                    st8(POOLED + (size_t)t * 512 + c0, o); }
            }
        } else {
            const int c0 = (oc - 64) * 8;
            const pg::bf16_t* src = PROJ + PJ_U + c0;
            float w0[8], w1[8], w2[8], w3[8], bb[8], u0[8], u1[8], u2[8];
#pragma unroll
            for (int q = 0; q < 8; ++q) { w0[q] = cw[c0 + q]; w1[q] = cw[1024 + c0 + q]; w2[q] = cw[2048 + c0 + q]; w3[q] = cw[3072 + c0 + q]; bb[q] = cb[c0 + q]; u0[q] = 0.f; u1[q] = 0.f; u2[q] = 0.f; }
            if (tpos0 >= 3) ld8(src + (size_t)(t0 - 3) * PROJW, u0);
            if (tpos0 >= 2) ld8(src + (size_t)(t0 - 2) * PROJW, u1);
            if (tpos0 >= 1) ld8(src + (size_t)(t0 - 1) * PROJW, u2);
            for (int i0 = 0; i0 < 32; i0 += 8) {
                pg::u32x4 cv[8];
#pragma unroll
                for (int i = 0; i < 8; ++i) cv[i] = *(const pg::u32x4*)(src + (size_t)(t0 + i0 + i) * PROJW);
#pragma unroll
                for (int i = 0; i < 8; ++i) { float u3[8], o[8];
                    u3[0] = __builtin_bit_cast(float, cv[i].x << 16); u3[1] = __builtin_bit_cast(float, cv[i].x & 0xffff0000u); u3[2] = __builtin_bit_cast(float, cv[i].y << 16); u3[3] = __builtin_bit_cast(float, cv[i].y & 0xffff0000u);
                    u3[4] = __builtin_bit_cast(float, cv[i].z << 16); u3[5] = __builtin_bit_cast(float, cv[i].z & 0xffff0000u); u3[6] = __builtin_bit_cast(float, cv[i].w << 16); u3[7] = __builtin_bit_cast(float, cv[i].w & 0xffff0000u);
#pragma unroll
                    for (int q = 0; q < 8; ++q) { const float y = bb[q] + w0[q] * u0[q] + w1[q] * u1[q] + w2[q] * u2[q] + w3[q] * u3[q]; o[q] = y / (1.f + __expf(-y)); u0[q] = u1[q]; u1[q] = u2[q]; u2[q] = u3[q]; }
                    st8(UC + (size_t)(t0 + i0 + i) * 1024 + c0, o); }
            }
        }
    }
}
struct SchedG {
    pg::TileOrder o; const char* A; const char* B; size_t gA, gB, tA, tB;
    __device__ __forceinline__ bool next(int i, pg::Unit& u) const { int g, pm, pn; if (!o.tile(i, g, pm, pn)) return false;
        u.A = A + g * gA + pm * tA; u.B = B + g * gB + pn * tB; u.pm = pm; u.pn = pn; u.g = g; u.aux = 0; u.rows = nullptr; u.nvalid = 0; return true; }
};
struct EpiPoolMixB {
    static constexpr bool PERM = true, AFTER_DRAIN = false;
    pg::bf16_t* O; const float* b; const float* ls;
    __device__ __forceinline__ void operator()(const pg::f32x4 (&acc)[2][2][4][2], const pg::Unit& u, int wr, int wc, int fr, int fq) const {
        const int col0 = u.pn * 256 + wc * 32 + 8 * fq;
        pg::bf16_t* base = O + (size_t)(u.pm * 256 + wr * 64 + fr) * 512 + col0;
        pg::f32x4 bv[2][2], lv[2][2];
#pragma unroll
        for (int bj = 0; bj < 2; ++bj)
#pragma unroll
            for (int n = 0; n < 2; ++n) { bv[bj][n] = *(const pg::f32x4*)(b + col0 + bj * 128 + 4 * n); lv[bj][n] = *(const pg::f32x4*)(ls + col0 + bj * 128 + 4 * n); }
#pragma unroll
        for (int ai = 0; ai < 2; ++ai)
#pragma unroll
            for (int m = 0; m < 4; ++m) { pg::bf16_t* rowp = base + (size_t)(ai * 128 + m * 16) * 512;
#pragma unroll
                for (int bj = 0; bj < 2; ++bj) { const pg::f32x4 v0 = (acc[ai][bj][m][0] + bv[bj][0]) * lv[bj][0], v1 = (acc[ai][bj][m][1] + bv[bj][1]) * lv[bj][1];
                    pg::u32x4 w; w.x = pg::cvt_pk_bf16(v0[0], v0[1]); w.y = pg::cvt_pk_bf16(v0[2], v0[3]); w.z = pg::cvt_pk_bf16(v1[0], v1[1]); w.w = pg::cvt_pk_bf16(v1[2], v1[3]);
                    *(pg::u32x4*)(rowp + bj * 128) = w; } }
    }
};
__device__ __forceinline__ void cvt_bf16_f32(const pg::bf16_t* src, size_t lds_, int cols, float* dst, size_t rows) {
    const size_t gt = (size_t)blockIdx.x * NT + tidf(), ngt = (size_t)gridDim.x * NT;
    for (size_t i = gt; i < rows * cols; i += ngt) { const size_t r = i / cols; const int c = (int)(i % cols); dst[i] = bf2f(src[r * lds_ + c]); }
}
__device__ __forceinline__ void ph_adapt_v(const OptBufs& o, float* vv) {
    const size_t gt = (size_t)blockIdx.x * NT + tidf(), ngt = (size_t)gridDim.x * NT;
    for (size_t i = gt; i < (size_t)T * 1024; i += ngt) { const int t = (int)(i >> 10), e = (int)(i & 1023), h = e >> 8, el = e & 255, b = t >> 12, cc = (t & 4095) >> 8, tl = t & 255;
        vv[i] = bf2f(o.BT2[((size_t)((b * 4 + h) * 16 + cc) * 256 + el) * 512 + tl]); }
}


struct OptBufs3 { pg::bf16_t *KaT, *A2, *HOUT; float *U, *rowv, *colv, *winter, *aw, *emt, *den, *un, *decay; };
__device__ __forceinline__ float log_sigmoidf_(float x) { return fminf(x, 0.f) - log1pf(expf(-fabsf(x))); }
__device__ __forceinline__ void scalar_scan_wave(int bh, const float* gif, const OptBufs3& o, int lane) {
    const int b = bh >> 2, h = bh & 3;
    float mc = 0.f;
    for (int c = 0; c < 16; ++c) {
        float bs[4], ip[4], pm[4], bt[4], mt[4];
#pragma unroll
        for (int sub = 0; sub < 4; ++sub) { const size_t t = (size_t)b * SEQ + c * 256 + sub * 64 + lane; ip[sub] = gif[t * 8 + h]; bs[sub] = log_sigmoidf_(gif[t * 8 + 4 + h]); }
#pragma unroll
        for (int off = 1; off < 64; off <<= 1) {
#pragma unroll
            for (int sub = 0; sub < 4; ++sub) { const float v = __shfl_up(bs[sub], off); if (lane >= off) bs[sub] += v; } }
        float carry = 0.f;
#pragma unroll
        for (int sub = 0; sub < 4; ++sub) { bt[sub] = carry + bs[sub]; carry += __shfl(bs[sub], 63); pm[sub] = ip[sub] - bt[sub]; }
        const float Gc = carry;
#pragma unroll
        for (int off = 1; off < 64; off <<= 1) {
#pragma unroll
            for (int sub = 0; sub < 4; ++sub) { const float v = __shfl_up(pm[sub], off); if (lane >= off) pm[sub] = fmaxf(pm[sub], v); } }
        float pmc = -INFINITY;
#pragma unroll
        for (int sub = 0; sub < 4; ++sub) { pm[sub] = fmaxf(pm[sub], pmc); pmc = __shfl(pm[sub], 63); mt[sub] = bt[sub] + fmaxf(mc, pm[sub]); }
        const float mnext = __shfl(mt[3], 63);
#pragma unroll
        for (int sub = 0; sub < 4; ++sub) {
            const size_t idx = ((size_t)b * SEQ + c * 256 + sub * 64 + lane) * 4 + h;
            o.rowv[idx] = bt[sub] - mt[sub]; o.colv[idx] = ip[sub] - bt[sub];
            o.winter[idx] = expf(bt[sub] + mc - mt[sub]); o.aw[idx] = expf(Gc - bt[sub] + ip[sub] - mnext); o.emt[idx] = expf(-mt[sub]);
        }
        if (lane == 0) o.decay[bh * 16 + c] = expf(Gc + mc - mnext);
        mc = mnext;
    }
}
struct EpiQ {
    static constexpr bool PERM = true, AFTER_DRAIN = false;
    pg::bf16_t* Q; pg::bf16_t* A2; const float* winter;
    __device__ __forceinline__ void operator()(const pg::f32x4 (&acc)[2][2][4][2], const pg::Unit& u, int wr, int wc, int fr, int fq) const {
        const int h = u.g, col0 = wc * 32 + 8 * fq;
#pragma unroll
        for (int ai = 0; ai < 2; ++ai)
#pragma unroll
            for (int m = 0; m < 4; ++m) { const size_t t = (size_t)u.pm * 256 + ai * 128 + wr * 64 + m * 16 + fr; const float wi = winter[t * 4 + h];
#pragma unroll
                for (int bj = 0; bj < 2; ++bj) { const pg::f32x4 v0 = acc[ai][bj][m][0] * 0.0625f, v1 = acc[ai][bj][m][1] * 0.0625f;
                    pg::u32x4 w; w.x = pg::cvt_pk_bf16(v0[0], v0[1]); w.y = pg::cvt_pk_bf16(v0[2], v0[3]); w.z = pg::cvt_pk_bf16(v1[0], v1[1]); w.w = pg::cvt_pk_bf16(v1[2], v1[3]);
                    *(pg::u32x4*)(Q + t * 1024 + h * 256 + col0 + bj * 128) = w;
                    const pg::f32x4 x0 = v0 * wi, x1 = v1 * wi;
                    pg::u32x4 y; y.x = pg::cvt_pk_bf16(x0[0], x0[1]); y.y = pg::cvt_pk_bf16(x0[2], x0[3]); y.z = pg::cvt_pk_bf16(x1[0], x1[1]); y.w = pg::cvt_pk_bf16(x1[2], x1[3]);
                    *(pg::u32x4*)(A2 + t * 2048 + h * 512 + 256 + col0 + bj * 128) = y; }
                asm volatile("" ::: "memory"); }
    }
};
struct EpiKT {
    static constexpr bool PERM = true, AFTER_DRAIN = false;
    pg::bf16_t* KaT; const float* aw;
    __device__ __forceinline__ void operator()(const pg::f32x4 (&acc)[2][2][4][2], const pg::Unit& u, int wr, int wc, int fr, int fq) const {
        const int h = u.g; const size_t t0 = (size_t)u.pn * 256 + wc * 32 + 8 * fq;
#pragma unroll
        for (int bj = 0; bj < 2; ++bj) {
            float a[8];
#pragma unroll
            for (int j = 0; j < 8; ++j) a[j] = aw[(t0 + bj * 128 + j) * 4 + h];
            pg::bf16_t* rowp = KaT + ((size_t)h * 256 + wr * 64 + fr) * T + t0 + bj * 128;
#pragma unroll
            for (int ai = 0; ai < 2; ++ai)
#pragma unroll
                for (int m = 0; m < 4; ++m) { const pg::f32x4 v0 = acc[ai][bj][m][0], v1 = acc[ai][bj][m][1];
                    pg::u32x4 w; w.x = pg::cvt_pk_bf16(v0[0] * a[0], v0[1] * a[1]); w.y = pg::cvt_pk_bf16(v0[2] * a[2], v0[3] * a[3]);
                    w.z = pg::cvt_pk_bf16(v1[0] * a[4], v1[1] * a[5]); w.w = pg::cvt_pk_bf16(v1[2] * a[6], v1[3] * a[7]);
                    *(pg::u32x4*)(rowp + (size_t)(ai * 128 + m * 16) * T) = w; asm volatile("" ::: "memory"); }
        }
    }
};
struct EpiS {
    static constexpr bool PERM = true, AFTER_DRAIN = false;
    pg::bf16_t* A2; const float* rowv; const float* colv; float* den;
    __device__ __forceinline__ void operator()(const pg::f32x4 (&acc)[2][2][4][2], const pg::Unit& u, int wr, int wc, int fr, int fq) const {
        const int bh = u.g >> 4, c = u.g & 15, b = bh >> 2, h = bh & 3; const size_t tok0 = (size_t)b * SEQ + c * 256;
        const int col0 = wc * 32 + 8 * fq;
        const float* cvp = colv + (tok0 + col0) * 4 + h;
#pragma unroll
        for (int ai = 0; ai < 2; ++ai)
#pragma unroll
            for (int m = 0; m < 4; ++m) { const int tl = ai * 128 + wr * 64 + m * 16 + fr; const float rv = rowv[(tok0 + tl) * 4 + h]; float rs = 0.f;
                pg::bf16_t* op = A2 + (tok0 + tl) * 2048 + h * 512 + col0;
#pragma unroll
                for (int bj = 0; bj < 2; ++bj) { float x[8];
#pragma unroll
                    for (int j = 0; j < 8; ++j) { const int sl = col0 + bj * 128 + j; const float a_ = (j < 4) ? acc[ai][bj][m][0][j] : acc[ai][bj][m][1][j - 4];
                        const float w_ = __expf(rv + cvp[(bj * 128 + j) * 4]); x[j] = (sl <= tl) ? a_ * w_ : 0.f; rs += x[j]; }
                    pg::u32x4 w; w.x = pg::cvt_pk_bf16(x[0], x[1]); w.y = pg::cvt_pk_bf16(x[2], x[3]); w.z = pg::cvt_pk_bf16(x[4], x[5]); w.w = pg::cvt_pk_bf16(x[6], x[7]);
                    *(pg::u32x4*)(op + bj * 128) = w; asm volatile("" ::: "memory"); }
                rs += __shfl_xor(rs, 16); rs += __shfl_xor(rs, 32);
                if (fq == 0) atomicAdd(den + (tok0 + tl) * 4 + h, rs);
                asm volatile("" ::: "memory"); }
    }
};
struct EpiF32U {
    static constexpr bool PERM = false, AFTER_DRAIN = false;
    float* C;
    __device__ __forceinline__ void operator()(const pg::f32x4 (&acc)[2][2][4][2], const pg::Unit& u, int wr, int wc, int fr, int fq) const {
        float* base = C + (size_t)u.aux * 65536 + (size_t)(wr * 64 + fr) * 256 + wc * 32 + 4 * fq;
#pragma unroll
        for (int ai = 0; ai < 2; ++ai)
#pragma unroll
            for (int m = 0; m < 4; ++m)
#pragma unroll
                for (int bj = 0; bj < 2; ++bj)
#pragma unroll
                    for (int n = 0; n < 2; ++n) { *(pg::f32x4*)(base + (size_t)(ai * 128 + m * 16) * 256 + bj * 128 + n * 16) = acc[ai][bj][m][n]; if (n) asm volatile("" ::: "memory"); }
    }
};
struct EpiNum {
    static constexpr bool PERM = true, AFTER_DRAIN = true;
    pg::bf16_t* HOUT; const pg::bf16_t* PROJ; const float* den; const float* emt; const float* gain;
    __device__ __forceinline__ void fused(pg::f32x4 (&acc)[2][2][4][2], const pg::Unit& u, int wr, int wc, int fr, int fq, LAS unsigned char* lds, int wid, int lane) const {
        const int bh = u.g >> 4, c = u.g & 15, b = bh >> 2, h = bh & 3; const size_t tok0 = (size_t)b * SEQ + c * 256;
        LAS pg::f32x2* P = (LAS pg::f32x2*)lds; LAS pg::f32x2* Sx = (LAS pg::f32x2*)(lds + 8192);
#pragma unroll
        for (int ai = 0; ai < 2; ++ai)
#pragma unroll
            for (int m = 0; m < 4; ++m) { const int tl = ai * 128 + wr * 64 + m * 16 + fr; const size_t ti = (tok0 + tl) * 4 + h;
                const float inv = 1.f / fmaxf(fabsf(den[ti]), emt[ti]); float s = 0.f;
#pragma unroll
                for (int bj = 0; bj < 2; ++bj)
#pragma unroll
                    for (int n = 0; n < 2; ++n) { acc[ai][bj][m][n] = acc[ai][bj][m][n] * inv; const pg::f32x4 x = acc[ai][bj][m][n]; s += (x[0] + x[1]) + (x[2] + x[3]); }
                s += __shfl_xor(s, 16); s += __shfl_xor(s, 32);
                const float mw = s * (1.f / 64.f); float q = 0.f;
#pragma unroll
                for (int bj = 0; bj < 2; ++bj)
#pragma unroll
                    for (int n = 0; n < 2; ++n) { const pg::f32x4 d = acc[ai][bj][m][n] - mw; q += (d[0] * d[0] + d[1] * d[1]) + (d[2] * d[2] + d[3] * d[3]); }
                q += __shfl_xor(q, 16); q += __shfl_xor(q, 32);
                if (fq == 0) P[tl * 4 + wc] = (pg::f32x2){mw, q}; }
        asm volatile("s_waitcnt lgkmcnt(0)" ::: "memory"); __builtin_amdgcn_s_barrier(); asm volatile("" ::: "memory");
        if (lane < 32) { const int row = wid * 32 + lane;
            const pg::f32x2 a = P[row * 4 + 0], b_ = P[row * 4 + 1], c_ = P[row * 4 + 2], d = P[row * 4 + 3];
            const float mt = (a.x + b_.x + c_.x + d.x) * 0.25f;
            const float da = a.x - mt, db = b_.x - mt, dc = c_.x - mt, dd = d.x - mt;
            const float m2 = (a.y + b_.y) + (c_.y + d.y) + 64.f * ((da * da + db * db) + (dc * dc + dd * dd));
            Sx[row] = (pg::f32x2){mt, rsqrtf(m2 * (1.f / 256.f) + LN_EPS)}; }
        asm volatile("s_waitcnt lgkmcnt(0)" ::: "memory"); __builtin_amdgcn_s_barrier(); asm volatile("" ::: "memory");
        const int col0 = wc * 32 + 8 * fq;
#pragma unroll
        for (int bj = 0; bj < 2; ++bj) { const int e0 = h * 256 + col0 + bj * 128;
            const pg::f32x4 g0 = *(const pg::f32x4*)(gain + e0), g1 = *(const pg::f32x4*)(gain + e0 + 4);
#pragma unroll
            for (int ai = 0; ai < 2; ++ai)
#pragma unroll
                for (int m = 0; m < 4; ++m) { const int tl = ai * 128 + wr * 64 + m * 16 + fr; const pg::f32x2 sr = Sx[tl]; const size_t t = tok0 + tl;
                    float ov[8]; ld8(PROJ + t * PROJW + PJ_O + e0, ov);
                    const pg::f32x4 v0 = (acc[ai][bj][m][0] - sr.x) * sr.y * g0, v1 = (acc[ai][bj][m][1] - sr.x) * sr.y * g1;
                    float r[8];
#pragma unroll
                    for (int j = 0; j < 4; ++j) { r[j] = v0[j] * sigmoidf_(ov[j]); r[4 + j] = v1[j] * sigmoidf_(ov[4 + j]); }
                    st8(HOUT + t * 1024 + e0, r); } }
    }
};
struct SchedG1 { pg::TileOrder o; const char* Q; const char* K;
    __device__ __forceinline__ bool next(int i, pg::Unit& u) const { int g, pm, pn; if (!o.tile(i, g, pm, pn)) return false;
        const int bh = g >> 4, c = g & 15, b = bh >> 2, h = bh & 3; const size_t off = (((size_t)b * SEQ + c * 256) * 1024 + h * 256) * 2;
        u.A = Q + off; u.B = K + off; u.pm = 0; u.pn = 0; u.g = g; u.aux = g; u.rows = nullptr; u.nvalid = 0; return true; } };
struct SchedG2 { pg::TileOrder o; const char* BT2; const char* KaT;
    __device__ __forceinline__ bool next(int i, pg::Unit& u) const { int g, pm, pn; if (!o.tile(i, g, pm, pn)) return false;
        const int bh = g / 15, c = g % 15, b = bh >> 2, h = bh & 3;
        u.A = BT2 + (size_t)(bh * 16 + c) * 256 * 512 * 2; u.B = KaT + (((size_t)h * 256) * T + (size_t)b * SEQ + c * 256) * 2;
        u.pm = 0; u.pn = 0; u.g = bh * 16 + c; u.aux = bh * 16 + c; u.rows = nullptr; u.nvalid = 0; return true; } };
struct SchedG3 { pg::TileOrder o; const char* A2; const char* BT2;
    __device__ __forceinline__ bool next(int i, pg::Unit& u) const { int g, pm, pn; if (!o.tile(i, g, pm, pn)) return false;
        const int bh = g >> 4, c = g & 15, b = bh >> 2, h = bh & 3;
        u.A = A2 + (((size_t)b * SEQ + c * 256) * 2048 + h * 512) * 2; u.B = BT2 + (size_t)g * 256 * 512 * 2; u.pm = 0; u.pn = 0; u.g = g; u.aux = g; u.rows = nullptr; u.nvalid = 0; return true; } };
__device__ __forceinline__ void ph_un(LAS unsigned char* lds, const OptBufs2& o2, const OptBufs3& o3) {
    const int tid = tidf(), d = tid & 255, sh = tid >> 8; LAS float* red = (LAS float*)lds;
    for (int it = blockIdx.x; it < 256; it += gridDim.x) { const int bh = it >> 4, c = it & 15, b = bh >> 2, h = bh & 3; const size_t tok0 = (size_t)b * SEQ + c * 256;
        float s = 0.f;
#pragma unroll 8
        for (int j = 0; j < 128; ++j) { const size_t t = tok0 + sh * 128 + j; s += o3.aw[t * 4 + h] * bf2f(o2.K[t * 1024 + h * 256 + d]); }
        __syncthreads(); if (sh == 1) red[d] = s; __syncthreads();
        if (sh == 0) o3.un[(size_t)it * 256 + d] = s + red[d]; }
    __syncthreads();
}
__device__ __forceinline__ void ph_state_scan(const OptBufs& ob, const OptBufs3& o3) {
    const int gt = blockIdx.x * NT + tidf(), ngt = gridDim.x * NT;
    for (int it = gt; it < 16 * 256 * 64; it += ngt) { const int bh = it >> 14, e = (it >> 6) & 255, d4 = (it & 63) * 4;
        pg::f32x4 U[15]; float dc[15];
#pragma unroll
        for (int c = 0; c < 15; ++c) { const size_t g = (size_t)bh * 16 + c; U[c] = *(const pg::f32x4*)(o3.U + g * 65536 + (size_t)e * 256 + d4); dc[c] = o3.decay[g]; }
        pg::f32x4 C = (pg::f32x4){0.f, 0.f, 0.f, 0.f};
#pragma unroll
        for (int c = 0; c < 16; ++c) { const size_t g = (size_t)bh * 16 + c;
            pg::u32x2 w; w.x = pk2(C[0], C[1]); w.y = pk2(C[2], C[3]);
            *(pg::u32x2*)(ob.BT2 + (g * 256 + e) * 512 + 256 + d4) = w;
            if (c < 15) C = C * dc[c] + U[c]; } }
}
__device__ __forceinline__ void ph_den_inter(LAS unsigned char* lds, const OptBufs3& o3) {
    const int tid = tidf(), lane = tid & 63, wave = tid >> 6; LAS float* nn = (LAS float*)lds;
    for (int it = blockIdx.x; it < 256; it += gridDim.x) { const int bh = it >> 4, c = it & 15, b = bh >> 2, h = bh & 3; const size_t tok0 = (size_t)b * SEQ + c * 256;
        __syncthreads();
        if (tid < 256) { float n = 0.f; for (int j = 0; j < c; ++j) n = n * o3.decay[bh * 16 + j] + o3.un[(size_t)(bh * 16 + j) * 256 + tid]; nn[tid] = n; }
        __syncthreads();
        const pg::f32x4 nv = *(const LAS pg::f32x4*)(nn + 4 * lane);
        for (int r0 = 0; r0 < 32; r0 += 8) { pg::u32x2 wv[8];
#pragma unroll
            for (int r = 0; r < 8; ++r) wv[r] = *(const pg::u32x2*)(o3.A2 + (tok0 + wave * 32 + r0 + r) * 2048 + h * 512 + 256 + 4 * lane);
#pragma unroll
            for (int r = 0; r < 8; ++r) { const size_t t = tok0 + wave * 32 + r0 + r; const pg::u32x2 w = wv[r];
                float s = __builtin_bit_cast(float, w.x << 16) * nv[0] + __builtin_bit_cast(float, w.x & 0xffff0000u) * nv[1] + __builtin_bit_cast(float, w.y << 16) * nv[2] + __builtin_bit_cast(float, w.y & 0xffff0000u) * nv[3];
                s = wsum(s);
                if (lane == 0) o3.den[t * 4 + h] += s; } } }
    __syncthreads();
}

__device__ __forceinline__ void ph_gemms_D(LAS unsigned char* lds, const OptBufs2& o, const OptBufs3& o3, const float* b_pool, const float* ls_pool) {
    const int G = gridDim.x, bx = blockIdx.x;
    { SchedG S; S.o.init(T / 256, 2, 1, G, bx); S.A = (const char*)o.POOLED; S.B = (const char*)o.WpoolT; S.gA = 0; S.gB = 0; S.tA = (size_t)256 * 512 * 2; S.tB = (size_t)256 * 512 * 2;
      EpiPoolMixB E{o.MIXED, b_pool, ls_pool}; pg::gemm_phase<EpiPoolMixB, SchedG>(lds, 512, 512, 512, S, E); }
    { SchedG S; S.o.init(T / 256, 1, 4, G, (bx + 128) % G); S.A = (const char*)o.UC; S.B = (const char*)o.WqT; S.gA = 256 * 2; S.gB = (size_t)65536 * 2; S.tA = (size_t)256 * 1024 * 2; S.tB = 0;
      EpiQ E{o.Q, o3.A2, o3.winter}; pg::gemm_phase<EpiQ, SchedG>(lds, 1024, 256, 256, S, E); }
    { SchedG S; S.o.init(T / 256, 1, 4, G, (bx + 128) % G); S.A = (const char*)o.UC; S.B = (const char*)o.WkT; S.gA = 256 * 2; S.gB = (size_t)65536 * 2; S.tA = (size_t)256 * 1024 * 2; S.tB = 0;
      pg::EpiStoreBf16 E{o.K, 1024, 1.f, 256}; pg::gemm_phase<pg::EpiStoreBf16, SchedG>(lds, 1024, 256, 256, S, E); }
    { SchedG S; S.o.init(1, T / 256, 4, G, bx); S.A = (const char*)o.WkT; S.B = (const char*)o.UC; S.gA = (size_t)65536 * 2; S.gB = 256 * 2; S.tA = 0; S.tB = (size_t)256 * 1024 * 2;
      EpiKT E{o3.KaT, o3.aw}; pg::gemm_phase<EpiKT, SchedG>(lds, 256, 1024, 256, S, E); }
}
__device__ __forceinline__ void ph_gemms_E(LAS unsigned char* lds, const OptBufs& ob, const OptBufs2& o2, const OptBufs3& o3) {
    const int G = gridDim.x, bx = blockIdx.x;
    ph_un(lds, o2, o3);
    { SchedG1 S; S.o.init(1, 1, 256, G, bx); S.Q = (const char*)o2.Q; S.K = (const char*)o2.K;
      EpiS E{o3.A2, o3.rowv, o3.colv, o3.den}; pg::gemm_phase<EpiS, SchedG1>(lds, 1024, 1024, 256, S, E); }
    { SchedG2 S; S.o.init(1, 1, 240, G, bx); S.BT2 = (const char*)ob.BT2; S.KaT = (const char*)o3.KaT;
      EpiF32U E{o3.U}; pg::gemm_phase<EpiF32U, SchedG2>(lds, 512, T, 256, S, E); }
}
__device__ __forceinline__ void ph_gemm_G3(LAS unsigned char* lds, const OptBufs& ob, const OptBufs3& o3, const float* gain) {
    SchedG3 S; S.o.init(1, 1, 256, gridDim.x, blockIdx.x); S.A2 = (const char*)o3.A2; S.BT2 = (const char*)ob.BT2;
    EpiNum E{o3.HOUT, ob.PROJ, o3.den, o3.emt, gain}; pg::gemm_phase<EpiNum, SchedG3>(lds, 2048, 512, 512, S, E);
}
__device__ __forceinline__ void ph_gemm_ypool(LAS unsigned char* lds, const OptBufs2& o) {
    const int G = gridDim.x, bx = blockIdx.x;
    SchedG S; S.o.init(T / 256, 4, 1, G, bx); S.A = (const char*)o.MIXED; S.B = (const char*)o.WbpT; S.gA = 0; S.gB = 0; S.tA = (size_t)256 * 512 * 2; S.tB = (size_t)256 * 512 * 2;
    pg::EpiStoreBf16 E{o.YPOOL, 1024, 1.f, 0}; pg::gemm_phase<pg::EpiStoreBf16, SchedG>(lds, 512, 512, 512, S, E);
}


struct OptBufs4 { pg::bf16_t *WbmT, *WoutT, *MERGED, *H1B; float *Z; int *elist, *erank; float *gate; };
__device__ __forceinline__ void ph_prep_weights4(LAS unsigned char* lds, const OptBufs4& o, const float* w_bm, const float* w_out) {
    const int tid = tidf(), lane = tid & 63, wave = tid >> 6, gw = blockIdx.x * NW + wave, ngw = gridDim.x * NW;
    LAS float* scr = (LAS float*)(lds + wave * 16640);
    for (int it = gw; it < 2 * 16 * 16; it += ngw) { const int which = it >> 8, r = it & 255, nb = r >> 4, kb = r & 15;
        transpose64<false>(which ? w_out : w_bm, 1024, kb * 64, nb * 64, which ? o.WoutT : o.WbmT, (size_t)nb * 64, 1024, scr, lane); }
}
struct EpiMerge {
    static constexpr bool PERM = true, AFTER_DRAIN = false;
    pg::bf16_t* O; const pg::bf16_t* PROJ; const pg::bf16_t* YPOOL;
    __device__ __forceinline__ void operator()(const pg::f32x4 (&acc)[2][2][4][2], const pg::Unit& u, int wr, int wc, int fr, int fq) const {
        const int col0 = u.pn * 256 + wc * 32 + 8 * fq;
#pragma unroll
        for (int ai = 0; ai < 2; ++ai)
#pragma unroll
            for (int m = 0; m < 4; ++m) { const size_t t = (size_t)u.pm * 256 + ai * 128 + wr * 64 + m * 16 + fr;
#pragma unroll
                for (int bj = 0; bj < 2; ++bj) { const int c = col0 + bj * 128; float g0[8], g1[8], yp[8], r[8];
                    ld8(PROJ + t * PROJW + PJ_G + c, g0); ld8(PROJ + t * PROJW + PJ_G + 1024 + c, g1); ld8(YPOOL + t * 1024 + c, yp);
#pragma unroll
                    for (int j = 0; j < 8; ++j) { const float a_ = (j < 4) ? acc[ai][bj][m][0][j] : acc[ai][bj][m][1][j - 4]; r[j] = sigmoidf_(g0[j]) * yp[j] + sigmoidf_(g1[j]) * a_; }
                    st8(O + t * 1024 + c, r); }
                asm volatile("" ::: "memory"); }
    }
};
struct EpiMixRes {
    static constexpr bool PERM = false, AFTER_DRAIN = false;
    float* Z; const float* x; const float* stats; const float* g; const float* beta;
    __device__ __forceinline__ void operator()(const pg::f32x4 (&acc)[2][2][4][2], const pg::Unit& u, int wr, int wc, int fr, int fq) const {
        const int col0 = u.pn * 256 + wc * 32 + 4 * fq;
#pragma unroll
        for (int ai = 0; ai < 2; ++ai)
#pragma unroll
            for (int m = 0; m < 4; ++m) { const size_t t = (size_t)u.pm * 256 + ai * 128 + wr * 64 + m * 16 + fr; const float mu = stats[t * 2], rstd = stats[t * 2 + 1];
#pragma unroll
                for (int bj = 0; bj < 2; ++bj)
#pragma unroll
                    for (int n = 0; n < 2; ++n) { const int c = col0 + bj * 128 + n * 16;
                        const pg::f32x4 xv = *(const pg::f32x4*)(x + t * 1024 + c), gv = *(const pg::f32x4*)(g + c), bv = *(const pg::f32x4*)(beta + c);
                        *(pg::f32x4*)(Z + t * 1024 + c) = ((xv - mu) * rstd * gv + bv) * ALPHA + acc[ai][bj][m][n]; }
                asm volatile("" ::: "memory"); }
    }
};
__device__ __forceinline__ void ph_gemm_ymls(LAS unsigned char* lds, const OptBufs& ob, const OptBufs2& o2, const OptBufs3& o3, const OptBufs4& o4) {
    SchedG S; S.o.init(T / 256, 4, 1, gridDim.x, blockIdx.x); S.A = (const char*)o3.HOUT; S.B = (const char*)o4.WbmT; S.gA = 0; S.gB = 0; S.tA = (size_t)256 * 1024 * 2; S.tB = (size_t)256 * 1024 * 2;
    EpiMerge E{o4.MERGED, ob.PROJ, o2.YPOOL}; pg::gemm_phase<EpiMerge, SchedG>(lds, 1024, 1024, 1024, S, E);
}
__device__ __forceinline__ void ph_gemm_mix(LAS unsigned char* lds, const OptBufs& ob, const OptBufs4& o4, const float* x, const float* g, const float* beta) {
    SchedG S; S.o.init(T / 256, 4, 1, gridDim.x, blockIdx.x); S.A = (const char*)o4.MERGED; S.B = (const char*)o4.WoutT; S.gA = 0; S.gB = 0; S.tA = (size_t)256 * 1024 * 2; S.tB = (size_t)256 * 1024 * 2;
    EpiMixRes E{o4.Z, x, ob.stats, g, beta}; pg::gemm_phase<EpiMixRes, SchedG>(lds, 1024, 1024, 1024, S, E);
}
__device__ __forceinline__ void ph_ln1_router(LAS unsigned char* lds, const OptBufs4& o, const float* g, const float* beta, const float* wr_, const float* br, int* cnt) {
    const int tid = tidf(), lane = tid & 63, wave = tid >> 6;
    LAS float* wl = (LAS float*)lds;
    LAS int* hist = (LAS int*)(lds + 131072 + 1024);
    LAS int* asg = (LAS int*)(lds + 131072 + 1024 + 256);
    for (int tile = blockIdx.x; tile < T / 64; tile += gridDim.x) {
        __syncthreads();
        for (int i = tid; i < 1024 * 32; i += NT) wl[(i & 31) * 1024 + (i >> 5)] = wr_[i];
        if (tid < 64) hist[tid] = 0;
        __syncthreads();
        for (int r = 0; r < 8; ++r) {
            const int tl = wave * 8 + r; const size_t t = (size_t)tile * 64 + tl;
            pg::f32x4* zr = (pg::f32x4*)(o.Z + t * D) + lane;
            pg::f32x4 v[4]; float s = 0.f;
#pragma unroll
            for (int j = 0; j < 4; ++j) { v[j] = zr[64 * j]; s += (v[j].x + v[j].y) + (v[j].z + v[j].w); }
            const float mean = wsum(s) * (1.f / D); float s2 = 0.f;
#pragma unroll
            for (int j = 0; j < 4; ++j) { v[j] = v[j] - mean; s2 += (v[j].x * v[j].x + v[j].y * v[j].y) + (v[j].z * v[j].z + v[j].w * v[j].w); }
            const float rstd = rsqrtf(wsum(s2) * (1.f / D) + LN_EPS);
            unsigned long long* o8 = (unsigned long long*)(o.H1B + t * D) + lane;
            float lg[32];
#pragma unroll
            for (int e = 0; e < 32; ++e) lg[e] = 0.f;
            pg::f32x4 yv[4];
#pragma unroll
            for (int j = 0; j < 4; ++j) { const int c0 = 256 * j + 4 * lane;
                const pg::f32x4 gg = *(const pg::f32x4*)(g + c0), bb = *(const pg::f32x4*)(beta + c0);
                const pg::f32x4 y = v[j] * rstd * gg + bb; yv[j] = y;
                zr[64 * j] = y;
                o8[64 * j] = (unsigned long long)pk2(y.x, y.y) | ((unsigned long long)pk2(y.z, y.w) << 32); }
#pragma unroll
            for (int e = 0; e < 32; ++e) {
#pragma unroll
                for (int j = 0; j < 4; ++j) { const pg::f32x4 w4 = *(const LAS pg::f32x4*)(wl + e * 1024 + 256 * j + 4 * lane);
                    lg[e] += (yv[j].x * w4.x + yv[j].y * w4.y) + (yv[j].z * w4.z + yv[j].w * w4.w); } }
            float mine;
            { float a16[16];
#pragma unroll
              for (int i = 0; i < 16; ++i) { const bool up = (lane & 32) != 0; const float keep = up ? lg[16 + i] : lg[i], give = up ? lg[i] : lg[16 + i]; a16[i] = keep + __shfl_xor(give, 32); }
              float a8[8];
#pragma unroll
              for (int i = 0; i < 8; ++i) { const bool up = (lane & 16) != 0; const float keep = up ? a16[8 + i] : a16[i], give = up ? a16[i] : a16[8 + i]; a8[i] = keep + __shfl_xor(give, 16); }
              float a4[4];
#pragma unroll
              for (int i = 0; i < 4; ++i) { const bool up = (lane & 8) != 0; const float keep = up ? a8[4 + i] : a8[i], give = up ? a8[i] : a8[4 + i]; a4[i] = keep + __shfl_xor(give, 8); }
              float a2[2];
#pragma unroll
              for (int i = 0; i < 2; ++i) { const bool up = (lane & 4) != 0; const float keep = up ? a4[2 + i] : a4[i], give = up ? a4[i] : a4[2 + i]; a2[i] = keep + __shfl_xor(give, 4); }
              const bool up = (lane & 2) != 0; const float keep = up ? a2[1] : a2[0], give = up ? a2[0] : a2[1];
              float a1 = keep + __shfl_xor(give, 2);
              a1 += __shfl_xor(a1, 1);
              const int el = lane & 31; const int srcl = ((el >> 4) & 1) * 32 + ((el >> 3) & 1) * 16 + ((el >> 2) & 1) * 8 + ((el >> 1) & 1) * 4 + (el & 1) * 2;
              mine = __shfl(a1, srcl); }
            mine += br[lane & 31];
            float val = mine; int idxs[4]; float vals[4];
#pragma unroll
            for (int k = 0; k < 4; ++k) {
                float bv = val; int bi = lane & 31;
#pragma unroll
                for (int off = 1; off < 32; off <<= 1) { const float ov = __shfl_xor(bv, off); const int oi = __shfl_xor(bi, off); if (ov > bv || (ov == bv && oi < bi)) { bv = ov; bi = oi; } }
                idxs[k] = bi; vals[k] = bv; if ((lane & 31) == bi) val = -INFINITY;
            }
            float ex[4], se = 0.f;
#pragma unroll
            for (int k = 0; k < 4; ++k) { ex[k] = expf(vals[k] - vals[0]); se += ex[k]; }
#pragma unroll
            for (int k = 0; k < 4; ++k) if (lane == k) { o.gate[t * 4 + k] = ex[k] / se; const int lr = atomicAdd((int*)(hist + idxs[k]), 1); asg[tl * 4 + k] = idxs[k] | (lr << 8); }
        }
        __syncthreads();
        if (tid < 32) hist[32 + tid] = atomicAdd(&cnt[tid], hist[tid]);
        __syncthreads();
        if (tid < 256) { const int a_ = asg[tid], e = a_ & 255, rank = hist[32 + e] + (a_ >> 8); const int t = tile * 64 + (tid >> 2);
            o.elist[e * T + rank] = t; o.erank[(size_t)t * 4 + (tid & 3)] = (e << 16) | rank; }
    }
    __syncthreads();
}
__device__ __forceinline__ void ph_adapt_route(const OptBufs4& o, const int* start, int* row_tok, int* row_of) {
    const int gt = blockIdx.x * NT + tidf(), ngt = gridDim.x * NT;
    for (int i = gt; i < NA; i += ngt) { const int er = o.erank[i], e = er >> 16, rank = er & 0xffff; const int dest = start[e] + rank; row_tok[dest] = i >> 2; row_of[i] = dest; }
}


struct OptBufs5 { pg::bf16_t *We1T, *We2T, *ACT, *Y; float* B1P; };
constexpr int MOE_TAB_OFF = 131072 + 4096;
__device__ __forceinline__ void ph_prep_weights5(LAS unsigned char* lds, const OptBufs5& o, const float* w_e1, const float* b_e1, const float* w_e2) {
    const int tid = tidf(), lane = tid & 63, wave = tid >> 6, gw = blockIdx.x * NW + wave, ngw = gridDim.x * NW;
    LAS float* scr = (LAS float*)(lds + wave * 16640);
    for (int it = gw; it < 32 * 16 * 32; it += ngw) { const int nb = it & 31, kb = (it >> 5) & 15, e = it >> 9; const int j0 = nb * 32, pn = j0 >> 7, jj0 = j0 & 127;
        transpose64<true>(w_e1 + (size_t)e * 1024 * 2048, 2048, kb * 64, nb * 64, o.We1T + (size_t)e * 2048 * 1024, (size_t)pn * 256 + jj0, 1024, scr, lane); }
    for (int it = gw; it < 32 * 16 * 16; it += ngw) { const int nb = it & 15, kb = (it >> 4) & 15, e = it >> 8;
        transpose64<false>(w_e2 + (size_t)e * 1024 * 1024, 1024, kb * 64, nb * 64, o.We2T + (size_t)e * 1024 * 1024, (size_t)nb * 64, 1024, scr, lane); }
    for (int i = blockIdx.x * NT + tid; i < 32 * 2048; i += gridDim.x * NT) { const int e = i >> 11, r = i & 2047, pn = r >> 8, bj = (r >> 7) & 1, jj = r & 127; o.B1P[i] = b_e1[e * 2048 + 2 * (pn * 128 + jj) + bj]; }
}
__device__ __forceinline__ void moe_build_tab(LAS unsigned char* lds, const int* cnt) {
    LAS int* tab = (LAS int*)(lds + MOE_TAB_OFF);
    __syncthreads();
    if (tidf() == 0) { int s = 0; for (int e = 0; e < NE; ++e) { tab[e] = s; s += (cnt[e] + 255) >> 8; } tab[NE] = s; }
    __syncthreads();
}
struct SchedMoE {
    const LAS int* tab; const int* cnt; const int* elist; const char* A; const char* B; size_t eB; int nN, nwg, G, c, gather;
    __device__ __forceinline__ bool next(int i, pg::Unit& u) const {
        const long L = (long)i * G + c; if (L >= nwg) return false;
        int wgid = (int)L; { const int q = nwg / pg::NXCD, r = nwg % pg::NXCD, xcd = wgid % pg::NXCD, off = wgid / pg::NXCD; wgid = (xcd < r ? xcd * (q + 1) : r * (q + 1) + (xcd - r) * q) + off; }
        const int mg = wgid / nN, pn = wgid - mg * nN;
        int e = 0;
#pragma unroll
        for (int j = 1; j < NE; ++j) e += (tab[j] <= mg) ? 1 : 0;
        e = __builtin_amdgcn_readfirstlane(e);
        const int mt = mg - __builtin_amdgcn_readfirstlane(tab[e]);
        u.g = e; u.pm = mg; u.pn = pn; u.aux = mg * 256;
        u.B = B + (size_t)e * eB + (size_t)pn * 256 * 1024 * 2;
        if (gather) { u.A = A; u.rows = elist + (size_t)e * T + mt * 256; const int rem = __builtin_amdgcn_readfirstlane(cnt[e]) - mt * 256; u.nvalid = rem < 256 ? rem : 256; }
        else { u.A = A + (size_t)mg * 256 * 1024 * 2; u.rows = nullptr; u.nvalid = 0; }
        return true;
    }
};
struct EpiSwiglu {
    static constexpr bool PERM = true, AFTER_DRAIN = false;
    pg::bf16_t* ACT; const float* B1P;
    __device__ __forceinline__ void operator()(const pg::f32x4 (&acc)[2][2][4][2], const pg::Unit& u, int wr, int wc, int fr, int fq) const {
        const int col0 = wc * 32 + 8 * fq; const float* bp = B1P + u.g * 2048 + u.pn * 256 + col0;
        const pg::f32x4 bg0 = *(const pg::f32x4*)(bp), bg1 = *(const pg::f32x4*)(bp + 4), bl0 = *(const pg::f32x4*)(bp + 128), bl1 = *(const pg::f32x4*)(bp + 132);
        pg::bf16_t* base = ACT + (size_t)(u.aux + wr * 64 + fr) * 1024 + u.pn * 128 + col0;
#pragma unroll
        for (int ai = 0; ai < 2; ++ai)
#pragma unroll
            for (int m = 0; m < 4; ++m) { float r[8];
#pragma unroll
                for (int j = 0; j < 8; ++j) { float g = (j < 4) ? acc[ai][0][m][0][j] + bg0[j] : acc[ai][0][m][1][j - 4] + bg1[j - 4];
                    float l = (j < 4) ? acc[ai][1][m][0][j] + bl0[j] : acc[ai][1][m][1][j - 4] + bl1[j - 4];
                    g = fminf(g, 7.f); l = fminf(fmaxf(l, -7.f), 7.f);
                    r[j] = g * (l + 1.f) / (1.f + __expf(-1.702f * g)); }
                st8(base + (size_t)(ai * 128 + m * 16) * 1024, r); asm volatile("" ::: "memory"); }
    }
};
struct EpiY {
    static constexpr bool PERM = true, AFTER_DRAIN = false;
    pg::bf16_t* Y; const float* b2;
    __device__ __forceinline__ void operator()(const pg::f32x4 (&acc)[2][2][4][2], const pg::Unit& u, int wr, int wc, int fr, int fq) const {
        const int col0 = u.pn * 256 + wc * 32 + 8 * fq; const float* bp = b2 + u.g * 1024 + col0;
        pg::bf16_t* base = Y + (size_t)(u.aux + wr * 64 + fr) * 1024 + col0;
#pragma unroll
        for (int bj = 0; bj < 2; ++bj) { const pg::f32x4 b0 = *(const pg::f32x4*)(bp + bj * 128), b1 = *(const pg::f32x4*)(bp + bj * 128 + 4);
#pragma unroll
            for (int ai = 0; ai < 2; ++ai)
#pragma unroll
                for (int m = 0; m < 4; ++m) { const pg::f32x4 v0 = acc[ai][bj][m][0] + b0, v1 = acc[ai][bj][m][1] + b1;
                    pg::u32x4 w; w.x = pg::cvt_pk_bf16(v0[0], v0[1]); w.y = pg::cvt_pk_bf16(v0[2], v0[3]); w.z = pg::cvt_pk_bf16(v1[0], v1[1]); w.w = pg::cvt_pk_bf16(v1[2], v1[3]);
                    *(pg::u32x4*)(base + (size_t)(ai * 128 + m * 16) * 1024 + bj * 128) = w; asm volatile("" ::: "memory"); } }
    }
};
__device__ __forceinline__ void ph_moe1(LAS unsigned char* lds, const OptBufs4& o4, const OptBufs5& o5, const int* cnt) {
    moe_build_tab(lds, cnt);
    SchedMoE S; S.tab = (const LAS int*)(lds + MOE_TAB_OFF); S.cnt = cnt; S.elist = o4.elist; S.A = (const char*)o4.H1B; S.B = (const char*)o5.We1T; S.eB = (size_t)2048 * 1024 * 2;
    S.nN = 8; S.nwg = __builtin_amdgcn_readfirstlane(S.tab[NE]) * 8; S.G = gridDim.x; S.c = blockIdx.x; S.gather = 1;
    EpiSwiglu E{o5.ACT, o5.B1P}; pg::gemm_phase<EpiSwiglu, SchedMoE, true>(lds, 1024, 1024, 1024, S, E);
}
__device__ __forceinline__ void ph_moe2(LAS unsigned char* lds, const OptBufs5& o5, const int* cnt, const float* b_e2) {
    moe_build_tab(lds, cnt);
    SchedMoE S; S.tab = (const LAS int*)(lds + MOE_TAB_OFF); S.cnt = cnt; S.elist = nullptr; S.A = (const char*)o5.ACT; S.B = (const char*)o5.We2T; S.eB = (size_t)1024 * 1024 * 2;
    S.nN = 4; S.nwg = __builtin_amdgcn_readfirstlane(S.tab[NE]) * 4; S.G = gridDim.x; S.c = blockIdx.x; S.gather = 0;
    EpiY E{o5.Y, b_e2}; pg::gemm_phase<EpiY, SchedMoE, false>(lds, 1024, 1024, 1024, S, E);
}
__device__ __forceinline__ void ph_final_opt(LAS unsigned char* lds, const OptBufs4& o4, const OptBufs5& o5, const int* cnt, const float* g, const float* beta, float* out) {
    moe_build_tab(lds, cnt);
    const LAS int* tab = (const LAS int*)(lds + MOE_TAB_OFF);
    const int tid = tidf(), lane = tid & 63, gw = blockIdx.x * NW + (tid >> 6), ngw = gridDim.x * NW;
    for (int t = gw; t < T; t += ngw) {
        size_t ro[4]; float gt[4];
#pragma unroll
        for (int k = 0; k < 4; ++k) { const int er = o4.erank[(size_t)t * 4 + k]; ro[k] = (size_t)(tab[er >> 16] * 256 + (er & 0xffff)) * 1024; gt[k] = o4.gate[(size_t)t * 4 + k]; }
        pg::f32x4 v[4]; float s = 0.f;
#pragma unroll
        for (int j = 0; j < 4; ++j) { const int c0 = 256 * j + 4 * lane;
            pg::f32x4 x = *(const pg::f32x4*)(o4.Z + (size_t)t * D + c0) * ALPHA;
#pragma unroll
            for (int k = 0; k < 4; ++k) { const pg::u32x2 w = *(const pg::u32x2*)(o5.Y + ro[k] + c0);
                x.x += gt[k] * __builtin_bit_cast(float, w.x << 16); x.y += gt[k] * __builtin_bit_cast(float, w.x & 0xffff0000u);
                x.z += gt[k] * __builtin_bit_cast(float, w.y << 16); x.w += gt[k] * __builtin_bit_cast(float, w.y & 0xffff0000u); }
            v[j] = x; s += (x.x + x.y) + (x.z + x.w); }
        const float mean = wsum(s) * (1.f / D); float s2 = 0.f;
#pragma unroll
        for (int j = 0; j < 4; ++j) { v[j] = v[j] - mean; s2 += (v[j].x * v[j].x + v[j].y * v[j].y) + (v[j].z * v[j].z + v[j].w * v[j].w); }
        const float rstd = rsqrtf(wsum(s2) * (1.f / D) + LN_EPS);
#pragma unroll
        for (int j = 0; j < 4; ++j) { const int c0 = 256 * j + 4 * lane;
            *(pg::f32x4*)(out + (size_t)t * D + c0) = v[j] * rstd * *(const pg::f32x4*)(g + c0) + *(const pg::f32x4*)(beta + c0); }
    }
}

__device__ __forceinline__ void ph_adapt1(const OptBufs& o, const float* b_if, float* proj) {
    const size_t gt = (size_t)blockIdx.x * NT + tidf(), ngt = (size_t)gridDim.x * NT;
    for (size_t i = gt; i < (size_t)T * INC; i += ngt) {
        const int c = (int)(i % INC); const int t = (int)(i / INC);
        float v;
        if (c < C_V) v = bf2f(o.PROJ[(size_t)t * PROJW + c]);
        else if (c < C_O) { const int e = c - C_V, h = e >> 8, el = e & 255, b = t >> 12, cc = (t & 4095) >> 8, tl = t & 255;
            v = bf2f(o.BT2[((size_t)((b * 4 + h) * 16 + cc) * 256 + el) * 512 + tl]); }
        else if (c < C_IF) v = bf2f(o.PROJ[(size_t)t * PROJW + c - 1024]);
        else if (c < C_G) v = o.gif[(size_t)t * 8 + (c - C_IF)] - b_if[c - C_IF];
        else v = bf2f(o.PROJ[(size_t)t * PROJW + c - C_G + PJ_G]);
        proj[i] = v;
    }
}

struct Args { const float* in[26]; float* out; unsigned char* ws; int ph_lo, ph_hi; };
constexpr size_t MiB = 1u << 20;
constexpr size_t WS_CTL = 0;
constexpr size_t CTL_ZERO_BYTES = 1 * MiB;
constexpr int CW_BAR = 4096;
constexpr int CW_CNT = 16384, CW_START = 16384 + 64, CW_FILL = 16384 + 128;

__global__ void __launch_bounds__(NT, 2) mk_fwd(Args a) {
    extern __shared__ __attribute__((aligned(16))) unsigned char lds_raw[];
    LAS unsigned char* lds = (LAS unsigned char*)lds_raw;
    volatile LAS unsigned* MISC = (volatile LAS unsigned*)(lds + MISC_OFF);
    const int tid = tidf();
    if (tid < 32) MISC[tid] = 0u;
    __syncthreads();
    unsigned char* ws = a.ws;
    unsigned* ctl = (unsigned*)(ws + WS_CTL);
    XcdBarrier bar = xcd_barrier_post(ctl + CW_BAR, MISC + 8);
    const float* x = a.in[0]; const float* ln0_g = a.in[1]; const float* ln0_b = a.in[2];
    const float* w_in = a.in[3]; const float* conv_w = a.in[4]; const float* conv_b = a.in[5];
    const float* w_q = a.in[6]; const float* w_k = a.in[7]; const float* b_if = a.in[8];
    const float* mh_gain = a.in[9]; const float* w_pool = a.in[10]; const float* b_pool = a.in[11];
    const float* ls_pool = a.in[12]; const float* w_bp = a.in[13]; const float* w_bm = a.in[14];
    const float* w_out = a.in[15]; const float* ln1_g = a.in[16]; const float* ln1_b = a.in[17];
    const float* w_router = a.in[18]; const float* b_router = a.in[19]; const float* w_e1 = a.in[20];
    const float* b_e1 = a.in[21]; const float* w_e2 = a.in[22]; const float* b_e2 = a.in[23];
    const float* ln2_g = a.in[24]; const float* ln2_b = a.in[25];
    OptBufs ob; ob.WinT = (pg::bf16_t*)(ws + 8 * MiB); ob.H0B = (pg::bf16_t*)(ws + 220 * MiB); ob.PROJ = (pg::bf16_t*)(ws + 252 * MiB); ob.BT2 = (pg::bf16_t*)(ws + 396 * MiB);
    ob.gif = (float*)(ws + 1 * MiB); ob.stats = (float*)(ws + 1 * MiB + 512 * 1024);
    OptBufs2 o2; o2.WqT = (pg::bf16_t*)(ws + 19 * MiB); o2.WkT = (pg::bf16_t*)(ws + 19 * MiB + 512 * 1024); o2.WpoolT = (pg::bf16_t*)(ws + 20 * MiB); o2.WbpT = (pg::bf16_t*)(ws + 20 * MiB + 512 * 1024);
    o2.POOLED = (pg::bf16_t*)(ws + 460 * MiB); o2.UC = (pg::bf16_t*)(ws + 476 * MiB); o2.MIXED = (pg::bf16_t*)(ws + 508 * MiB); o2.Q = (pg::bf16_t*)(ws + 524 * MiB); o2.K = (pg::bf16_t*)(ws + 556 * MiB);
    o2.YPOOL = (pg::bf16_t*)(ws + 748 * MiB);
    OptBufs3 o3; o3.KaT = (pg::bf16_t*)(ws + 588 * MiB); o3.A2 = (pg::bf16_t*)(ws + 620 * MiB); o3.U = (float*)(ws + 684 * MiB); o3.HOUT = (pg::bf16_t*)(ws + 780 * MiB);
    { float* sm = (float*)(ws + 2 * MiB); o3.rowv = sm; o3.colv = sm + 65536; o3.winter = sm + 2 * 65536; o3.aw = sm + 3 * 65536; o3.emt = sm + 4 * 65536; o3.den = sm + 5 * 65536; o3.un = sm + 6 * 65536; o3.decay = sm + 7 * 65536; }
    OptBufs4 o4; o4.WbmT = (pg::bf16_t*)(ws + 21 * MiB + 512 * 1024); o4.WoutT = (pg::bf16_t*)(ws + 23 * MiB + 512 * 1024); o4.MERGED = (pg::bf16_t*)(ws + 812 * MiB); o4.Z = (float*)(ws + 844 * MiB); o4.H1B = (pg::bf16_t*)(ws + 908 * MiB);
    o4.elist = (int*)(ws + 4 * MiB); o4.erank = (int*)(ws + 6 * MiB); o4.gate = (float*)(ws + 6 * MiB + 256 * 1024);
    OptBufs5 o5; o5.We1T = (pg::bf16_t*)(ws + 26 * MiB); o5.We2T = (pg::bf16_t*)(ws + 154 * MiB); o5.B1P = (float*)(ws + 7 * MiB);
    o5.ACT = (pg::bf16_t*)(ws + 252 * MiB);
    o5.Y = (pg::bf16_t*)(ws + 396 * MiB);
    int* cnt = (int*)ctl + CW_CNT;
    LAS float* ldsf = (LAS float*)lds;
    const int G = gridDim.x, bx = blockIdx.x;
#define IN(k) (a.ph_lo <= (k) && (k) < a.ph_hi)
#define SEAM(k) do { if (IN(k) && IN((k) + 1)) xcd_barrier(bar); } while (0)
    if (IN(0)) { ph_prep_weights(lds, ob, w_in); ph_prep_weights2(lds, o2, w_q, w_k, w_pool, w_bp); ph_prep_weights4(lds, o4, w_bm, w_out); ph_prep_weights5(lds, o5, w_e1, b_e1, w_e2); ph_ln0(lds, ob, x, ln0_g, ln0_b, w_in, b_if); }
    SEAM(0);
    if (IN(1)) ph_inproj(lds, ob);
    SEAM(1);
    if (IN(2)) { if (bx < 16 && tid < 64) scalar_scan_wave(bx, ob.gif, o3, tid);
                 for (int i = bx * NT + tid; i < T * 4; i += G * NT) o3.den[i] = 0.f;
                 ph_poolconv_opt(ob.PROJ, conv_w, conv_b, o2.POOLED, o2.UC); }
    SEAM(2);
    if (IN(3)) ph_gemms_D(lds, o2, o3, b_pool, ls_pool);
    SEAM(3);
    if (IN(4)) { ph_gemm_ypool(lds, o2); ph_gemms_E(lds, ob, o2, o3); }
    SEAM(4);
    if (IN(5)) { ph_state_scan(ob, o3); ph_den_inter(lds, o3); }
    SEAM(5);
    if (IN(6)) ph_gemm_G3(lds, ob, o3, mh_gain);
    SEAM(6);
    if (IN(7)) ph_gemm_ymls(lds, ob, o2, o3, o4);
    SEAM(7);
    if (IN(8)) ph_gemm_mix(lds, ob, o4, x, ln0_g, ln0_b);
    SEAM(8);
    if (IN(9)) ph_ln1_router(lds, o4, ln1_g, ln1_b, w_router, b_router, cnt);
    SEAM(9);
    if (IN(10)) ph_moe1(lds, o4, o5, cnt);
    SEAM(10);
    if (IN(11)) ph_moe2(lds, o5, cnt, b_e2);
    SEAM(11);
    if (IN(12)) ph_final_opt(lds, o4, o5, cnt, ln2_g, ln2_b, a.out);
}
constexpr int NPH = 13;
}

extern "C" void kernel_launch(void* const* d_in, const int* in_sizes, int n_in, void* d_out, int out_size, void* d_ws, size_t ws_size, hipStream_t stream) {
    using namespace mk;
    static int grid = 0;
    if (grid == 0) {
        if (n_in != 26 || ws_size < 1000 * MiB) { fprintf(stderr, "kernel_launch: unexpected n_in %d / ws %zu\n", n_in, ws_size); grid = -1; return; }
        int dev = 0, cus = 0, per_cu = 0;
        hipGetDevice(&dev); hipDeviceGetAttribute(&cus, hipDeviceAttributeMultiprocessorCount, dev);
        if (hipFuncSetAttribute((const void*)mk_fwd, hipFuncAttributeMaxDynamicSharedMemorySize, LDS_BYTES) != hipSuccess) { fprintf(stderr, "hipFuncSetAttribute failed\n"); grid = -1; return; }
        if (hipOccupancyMaxActiveBlocksPerMultiprocessor(&per_cu, (const void*)mk_fwd, NT, LDS_BYTES) != hipSuccess || per_cu < 1) { fprintf(stderr, "occupancy query failed (%d)\n", per_cu); grid = -1; return; }
        grid = cus * 1;
        fprintf(stderr, "kernel_launch: cus %d per_cu %d grid %d\n", cus, per_cu, grid);
    }
    if (grid < 0) return;
    hipMemsetAsync((char*)d_ws + WS_CTL, 0, CTL_ZERO_BYTES, stream);
    Args a{};
    for (int i = 0; i < 26; ++i) a.in[i] = (const float*)d_in[i];
    a.out = (float*)d_out; a.ws = (unsigned char*)d_ws; a.ph_lo = 0; a.ph_hi = NPH;
    void* args[] = {&a};
    hipError_t e = hipLaunchCooperativeKernel((const void*)mk_fwd, dim3(grid), dim3(NT), args, LDS_BYTES, stream);
    if (e != hipSuccess) fprintf(stderr, "cooperative launch failed: %s (grid %d)\n", hipGetErrorString(e), grid);
}
```

```cpp
#include <hip/hip_runtime.h>
#include <cstdio>
#include <cstdint>

#define LAS __attribute__((address_space(3)))
#ifndef PROBE_PH
#define PROBE_PH -1
#endif
#define PROBE_MODE 7
namespace mk {
constexpr int D = 1024, BATCH = 4, SEQ = 4096, T = BATCH * SEQ;
constexpr int INC = 5640;
constexpr int C_P = 0, C_U = 512, C_V = 1536, C_O = 2560, C_IF = 3584, C_G = 3592;
constexpr int NE = 32, TOPK = 4, NA = T * TOPK;
constexpr float LN_EPS = 1e-5f;
constexpr float ALPHA = 1.189207115002721f;
constexpr int NT = 512, NW = 8;
constexpr int LDS_BYTES = 147456, MISC_OFF = 147456 - 512;

#define XB_TMO      128
#define XB_XCNT(j)  (256  + 64 * (j))
#define XB_XSUB(j)  (1280 + 64 * (j))
#define XB_XGEN(j)  (2304 + 64 * (j))
#define XB_TOP      3328
#define XB_TOPGEN   3392
#define XCD_BAR_WORDS 3456
#define XB_SPIN_CAP (1u << 22)
__device__ __forceinline__ unsigned xb_ld(unsigned* p)              { return __hip_atomic_load(p, __ATOMIC_RELAXED, __HIP_MEMORY_SCOPE_AGENT); }
__device__ __forceinline__ unsigned xb_add(unsigned* p, unsigned v) { return __hip_atomic_fetch_add(p, v, __ATOMIC_RELAXED, __HIP_MEMORY_SCOPE_AGENT); }
__device__ __forceinline__ unsigned xb_xcc_id() { return (unsigned)__builtin_amdgcn_s_getreg((3 << 11) | 20) & 0xFu; }
#define XB_SPIN(cond, bar) do { unsigned _sp = 0; while (cond) { __builtin_amdgcn_s_sleep(1); \
    if ((++_sp & 255u) == 0u) { if (xb_ld(&(bar)[XB_TMO])) break; if (_sp > XB_SPIN_CAP) { atomicAdd(&(bar)[XB_TMO], 1u); break; } } } } while (0)
struct XcdBarrier { unsigned* bar; unsigned x; volatile LAS unsigned* st; };
__device__ __forceinline__ XcdBarrier xcd_barrier_post(unsigned* bar, volatile LAS unsigned* st) {
    XcdBarrier b; b.bar = bar; b.x = xb_xcc_id(); b.st = st;
    if (threadIdx.x == 0) (void)xb_add(&bar[XB_XCNT(b.x)], 1u);
    return b;
}
__device__ __forceinline__ void xcd_barrier_complete(unsigned* bar, unsigned x, unsigned& nloc, unsigned& nx) {
    const unsigned G = gridDim.x * gridDim.y * gridDim.z;
    unsigned sum, cnt, mine, sp = 0u;
    for (;;) {
        sum = 0u; cnt = 0u; mine = 0u;
#pragma unroll
        for (unsigned j = 0; j < 16; ++j) { const unsigned c = xb_ld(&bar[XB_XCNT(j)]); sum += c; cnt += (c > 0u) ? 1u : 0u; mine = (j == x) ? c : mine; }
        if (sum == G) break;
        __builtin_amdgcn_s_sleep(1);
        if ((++sp & 255u) == 0u) { if (xb_ld(&bar[XB_TMO])) break; if (sp > XB_SPIN_CAP) { atomicAdd(&bar[XB_TMO], 1u); break; } }
    }
    nloc = mine > 0u ? mine : 1u; nx = cnt > 0u ? cnt : 1u;
}
__device__ __forceinline__ void xcd_barrier(const XcdBarrier& b) {
    asm volatile("s_waitcnt vmcnt(0)" ::: "memory");
    __syncthreads();
    if (threadIdx.x == 0) {
        unsigned* bar = b.bar;
        __builtin_amdgcn_s_waitcnt(0);
        unsigned nloc = b.st[0], nx = b.st[1];
        if (nloc == 0u) { xcd_barrier_complete(bar, b.x, nloc, nx); b.st[0] = nloc; b.st[1] = nx; }
        const unsigned old = xb_add(&bar[XB_XSUB(b.x)], 1u);
        const unsigned gen = old / nloc;
        if (old + 1u == (gen + 1u) * nloc) {
            __builtin_amdgcn_fence(__ATOMIC_RELEASE, "agent");
            asm volatile("s_waitcnt vmcnt(0)" ::: "memory");
            const unsigned og = xb_add(&bar[XB_TOP], 1u);
            const unsigned tg = og / nx;
            if (og + 1u == (tg + 1u) * nx) xb_add(&bar[XB_TOPGEN], 1u);
            else XB_SPIN(xb_ld(&bar[XB_TOPGEN]) == tg, bar);
            __builtin_amdgcn_fence(__ATOMIC_ACQUIRE, "agent");
            xb_add(&bar[XB_XGEN(b.x)], 1u);
            asm volatile("s_waitcnt vmcnt(0)" ::: "memory");
        } else {
            XB_SPIN(xb_ld(&bar[XB_XGEN(b.x)]) == gen, bar);
            __builtin_amdgcn_fence(__ATOMIC_ACQUIRE, "agent");
            asm volatile("s_waitcnt vmcnt(0)" ::: "memory");
        }
    }
    __syncthreads();
}

__device__ __forceinline__ int tidf() { int t = threadIdx.x; asm volatile("" : "+v"(t)); return t; }
__device__ __forceinline__ float wsum(float v) {
#pragma unroll
    for (int o = 1; o < 64; o <<= 1) v += __shfl_xor(v, o);
    return v;
}
__device__ __forceinline__ float sigmoidf_(float x) { return 1.f / (1.f + expf(-x)); }

__device__ __forceinline__ void ph_ln(const float* a, const float* b, const float* g, const float* beta, float* y, float scale) {
    const int lane = tidf() & 63, gw = blockIdx.x * NW + (tidf() >> 6), ngw = gridDim.x * NW;
    for (int row = gw; row < T; row += ngw) {
        float v[16]; float s = 0.f;
#pragma unroll
        for (int j = 0; j < 16; ++j) { const int c = lane + 64 * j; float x = a[(size_t)row * D + c] * scale; if (b) x += b[(size_t)row * D + c]; v[j] = x; s += x; }
        const float mu = wsum(s) * (1.f / D); float q = 0.f;
#pragma unroll
        for (int j = 0; j < 16; ++j) { const float d = v[j] - mu; q += d * d; }
        const float rstd = rsqrtf(wsum(q) * (1.f / D) + LN_EPS);
#pragma unroll
        for (int j = 0; j < 16; ++j) { const int c = lane + 64 * j; y[(size_t)row * D + c] = (v[j] - mu) * rstd * g[c] + beta[c]; }
    }
}
struct EpiPlain { static constexpr bool PAIR = false; float* C; int ldc; float scale;
    __device__ void operator()(int m, int n, float v, int z) const { C[(size_t)m * ldc + n] = v * scale; } };
struct EpiPoolMix { static constexpr bool PAIR = false; float* C; const float* b; const float* ls;
    __device__ void operator()(int m, int n, float v, int z) const { const int c = z * 128 + n; C[(size_t)m * 512 + c] = (v + b[c]) * ls[c]; } };
struct EpiHead { static constexpr bool PAIR = false; float* C; float scale;
    __device__ void operator()(int m, int n, float v, int z) const { C[(size_t)m * 1024 + z * 256 + n] = v * scale; } };
struct EpiE1 { static constexpr bool PAIR = true; float* act; const float* b1;
    __device__ void pair(int m, int n, float vg, float vl, int z) const {
        float g = vg + b1[z * 2048 + n], l = vl + b1[z * 2048 + n + 1];
        g = fminf(g, 7.f); l = fminf(fmaxf(l, -7.f), 7.f);
        act[(size_t)m * 1024 + (n >> 1)] = g * sigmoidf_(1.702f * g) * (l + 1.f); } };
struct EpiE2 { static constexpr bool PAIR = false; float* Y; const float* b2;
    __device__ void operator()(int m, int n, float v, int z) const { Y[(size_t)m * 1024 + n] = v + b2[z * 1024 + n]; } };

template <class Epi>
__device__ __forceinline__ void ph_gemm(LAS float* lds, const float* A, const int* rowidx, const float* B, const int* mcount, const int* mstart,
                                        size_t strideA, size_t strideB, const Epi& epi, int lda, int ldb, int M, int N, int K, int nz, int vb0, int nvb) {
    LAS float* As = lds;
    LAS float* Bs = lds + 16 * 129;
    const int tid = tidf(), tx = tid & 15, ty = tid >> 4;
    const int ntn = (N + 63) / 64, ntm = (M + 127) / 128, per_z = ntn * ntm, total = per_z * nz;
    for (int vt = vb0; vt < total; vt += nvb) {
        const int z = vt / per_z, r = vt % per_z, bm = (r / ntn) * 128, bn = (r % ntn) * 64;
        int Mz = M, m0g = 0;
        if (mcount) { Mz = mcount[z]; m0g = mstart[z]; }
        if (bm >= Mz) continue;
        const float* Az = A + z * strideA; const float* Bz = B + z * strideB;
        float acc[4][4] = {};
        const int ar = tid >> 2, ak = (tid & 3) * 4;
        const int arow = bm + ar; const bool aval = arow < Mz; int asrc = 0;
        if (aval) { const int gr = m0g + arow; asrc = rowidx ? rowidx[gr] : gr; }
        const int bk = tid >> 5, bn2 = (tid & 31) * 2;
        for (int k0 = 0; k0 < K; k0 += 16) {
            float4 av = make_float4(0.f, 0.f, 0.f, 0.f);
            if (aval) av = *(const float4*)(Az + (size_t)asrc * lda + k0 + ak);
            As[(ak + 0) * 129 + ar] = av.x; As[(ak + 1) * 129 + ar] = av.y; As[(ak + 2) * 129 + ar] = av.z; As[(ak + 3) * 129 + ar] = av.w;
#pragma unroll
            for (int j = 0; j < 2; ++j) { const int n = bn + bn2 + j; Bs[bk * 65 + bn2 + j] = (n < N) ? Bz[(size_t)(k0 + bk) * ldb + n] : 0.f; }
            __syncthreads();
#pragma unroll
            for (int kk = 0; kk < 16; ++kk) {
                float a[4], b[4];
#pragma unroll
                for (int i = 0; i < 4; ++i) { a[i] = As[kk * 129 + ty * 4 + i]; b[i] = Bs[kk * 65 + tx * 4 + i]; }
#pragma unroll
                for (int i = 0; i < 4; ++i)
#pragma unroll
                    for (int j = 0; j < 4; ++j) acc[i][j] += a[i] * b[j];
            }
            __syncthreads();
        }
#pragma unroll
        for (int i = 0; i < 4; ++i) { const int m = bm + ty * 4 + i; if (m >= Mz) continue;
            if constexpr (Epi::PAIR) {
#pragma unroll
                for (int j = 0; j < 4; j += 2) { const int n = bn + tx * 4 + j; if (n < N) epi.pair(m0g + m, n, acc[i][j], acc[i][j + 1], z); }
            } else {
#pragma unroll
                for (int j = 0; j < 4; ++j) { const int n = bn + tx * 4 + j; if (n < N) epi(m0g + m, n, acc[i][j], z); }
            } }
    }
}
__device__ __forceinline__ void ph_pool_conv(const float* proj, const float* cw, const float* cb, float* pooled, float* uc) {
    const size_t gt = (size_t)blockIdx.x * NT + tidf(), ngt = (size_t)gridDim.x * NT;
    for (size_t i = gt; i < (size_t)T * 512; i += ngt) {
        const int c = (int)(i % 512); const int tg = (int)(i / 512); const int t = tg % SEQ;
        const int w = 2 << (c >> 7);
        const int cnt = (t + 1 < w) ? t + 1 : w; float s = 0.f;
        for (int j = 0; j < cnt; ++j) s += proj[(size_t)(tg - j) * INC + C_P + c];
        pooled[i] = s / (float)cnt - proj[(size_t)tg * INC + C_P + c];
    }
    for (size_t i = gt; i < (size_t)T * 1024; i += ngt) {
        const int c = (int)(i % 1024); const int tg = (int)(i / 1024); const int t = tg % SEQ;
        float y = cb[c];
#pragma unroll
        for (int j = 0; j < 4; ++j) { const int tt = t - 3 + j; if (tt >= 0) y += proj[(size_t)(tg - 3 + j) * INC + C_U + c] * cw[j * 1024 + c]; }
        uc[i] = y * sigmoidf_(y);
    }
}
constexpr int MB = 16;
__device__ __forceinline__ void ph_mlstm(LAS float* lds, int vb, const float* q, const float* k, const float* vv, const float* gif, float* hm) {
    const int bh = vb >> 1, b = bh >> 2, h = bh & 3;
    const int tid = tidf(), e = (vb & 1) * 128 + (tid >> 2), dq = tid & 3;
    LAS float* sq = lds; LAS float* sk = lds + MB * 256; LAS float* sv = lds + 2 * MB * 256; LAS float* si = lds + 3 * MB * 256; LAS float* sf = si + MB;
    float C[64]; float n[16];
#pragma unroll
    for (int j = 0; j < 64; ++j) C[j] = 0.f;
#pragma unroll
    for (int j = 0; j < 16; ++j) n[j] = 0.f;
    float m = 0.f;
    const int nsub = (e & 3) * 16;
    for (int t0 = 0; t0 < SEQ; t0 += MB) {
        __syncthreads();
        for (int i = tid; i < MB * 256; i += NT) { const int tt = i >> 8, d = i & 255; const size_t tg = (size_t)b * SEQ + t0 + tt;
            sq[tt * 256 + d] = q[tg * 1024 + h * 256 + d]; sk[tt * 256 + d] = k[tg * 1024 + h * 256 + d]; sv[tt * 256 + d] = vv[tg * 1024 + h * 256 + d]; }
        if (tid < MB) { const size_t tg = (size_t)b * SEQ + t0 + tid; si[tid] = gif[tg * 8 + h]; sf[tid] = gif[tg * 8 + 4 + h]; }
        __syncthreads();
        for (int tt = 0; tt < MB; ++tt) {
            const float ip = si[tt], fp = sf[tt];
            const float lf = fminf(fp, 0.f) - log1pf(expf(-fabsf(fp)));
            const float mn = fmaxf(lf + m, ip);
            const float fd = expf(lf + m - mn), iw = expf(ip - mn);
            m = mn;
            const float ve = sv[tt * 256 + e] * iw;
            float num = 0.f, den = 0.f;
#pragma unroll
            for (int j = 0; j < 64; ++j) { const float kk = sk[tt * 256 + dq * 64 + j]; C[j] = fd * C[j] + ve * kk; num += C[j] * sq[tt * 256 + dq * 64 + j]; }
#pragma unroll
            for (int j = 0; j < 16; ++j) { const int d = dq * 64 + nsub + j; n[j] = fd * n[j] + iw * sk[tt * 256 + d]; den += n[j] * sq[tt * 256 + d]; }
            num += __shfl_xor(num, 1); num += __shfl_xor(num, 2);
            den += __shfl_xor(den, 1); den += __shfl_xor(den, 2); den += __shfl_xor(den, 4); den += __shfl_xor(den, 8);
            if (dq == 0) { const float dn = fmaxf(fabsf(den), expf(-mn)); hm[((size_t)b * SEQ + t0 + tt) * 1024 + h * 256 + e] = num / dn; }
        }
    }
    __syncthreads();
}
__device__ __forceinline__ void ph_hnorm(float* hm, const float* opre, const float* gain) {
    const int lane = tidf() & 63, gw = blockIdx.x * NW + (tidf() >> 6), ngw = gridDim.x * NW;
    for (int w = gw; w < T * 4; w += ngw) {
        const int tg = w >> 2, h = w & 3;
        float v[4]; float s = 0.f;
#pragma unroll
        for (int j = 0; j < 4; ++j) { v[j] = hm[(size_t)tg * 1024 + h * 256 + lane + 64 * j]; s += v[j]; }
        const float mu = wsum(s) * (1.f / 256); float qq = 0.f;
#pragma unroll
        for (int j = 0; j < 4; ++j) { const float d = v[j] - mu; qq += d * d; }
        const float rstd = rsqrtf(wsum(qq) * (1.f / 256) + LN_EPS);
#pragma unroll
        for (int j = 0; j < 4; ++j) { const int c = h * 256 + lane + 64 * j; hm[(size_t)tg * 1024 + c] = (v[j] - mu) * rstd * gain[c] * sigmoidf_(opre[(size_t)tg * 1024 + c]); }
    }
}
__device__ __forceinline__ void ph_merge(const float* gates, const float* ypool, float* ymls) {
    const size_t gt = (size_t)blockIdx.x * NT + tidf(), ngt = (size_t)gridDim.x * NT;
    for (size_t i = gt; i < (size_t)T * 1024; i += ngt) {
        const int c = (int)(i % 1024); const size_t tg = i / 1024;
        const float g0 = sigmoidf_(gates[tg * 2048 + c]), g1 = sigmoidf_(gates[tg * 2048 + 1024 + c]);
        ymls[i] = g0 * ypool[i] + g1 * ymls[i];
    }
}
__device__ __forceinline__ void ph_router(const float* h1, const float* wr, const float* br, int* top_idx, float* top_gate, int* cnt) {
    const int lane = tidf() & 63, gw = blockIdx.x * NW + (tidf() >> 6), ngw = gridDim.x * NW;
    for (int tg = gw; tg < T; tg += ngw) {
        const int e = lane & 31, half = lane >> 5;
        float s = 0.f;
        for (int kk = 0; kk < 512; ++kk) { const int kx = half * 512 + kk; s += h1[(size_t)tg * D + kx] * wr[kx * NE + e]; }
        s += __shfl_xor(s, 32); s += br[e];
        float val = s; int idxs[4]; float vals[4];
#pragma unroll
        for (int r = 0; r < 4; ++r) {
            float bv = val; int bi = e;
#pragma unroll
            for (int o = 1; o < 32; o <<= 1) { const float ov = __shfl_xor(bv, o); const int oi = __shfl_xor(bi, o); if (ov > bv || (ov == bv && oi < bi)) { bv = ov; bi = oi; } }
            idxs[r] = bi; vals[r] = bv; if (e == bi) val = -INFINITY;
        }
        const float mx = vals[0]; float ex[4], se = 0.f;
#pragma unroll
        for (int r = 0; r < 4; ++r) { ex[r] = expf(vals[r] - mx); se += ex[r]; }
#pragma unroll
        for (int r = 0; r < 4; ++r) if (lane == r) { top_idx[tg * 4 + r] = idxs[r]; top_gate[tg * 4 + r] = ex[r] / se; atomicAdd(&cnt[idxs[r]], 1); }
    }
}
__device__ __forceinline__ void ph_place(const int* top_idx, const int* start, int* fill, int* row_tok, int* row_of) {
    const int gt = blockIdx.x * NT + tidf(), ngt = gridDim.x * NT;
    for (int i = gt; i < NA; i += ngt) { const int e = top_idx[i]; const int r = atomicAdd(&fill[e], 1); const int dest = start[e] + r; row_tok[dest] = i >> 2; row_of[i] = dest; }
}
__device__ __forceinline__ void ph_final(const float* h1, const float* Y, const int* row_of, const float* gate, const float* g, const float* beta, float* out) {
    const int lane = tidf() & 63, gw = blockIdx.x * NW + (tidf() >> 6), ngw = gridDim.x * NW;
    for (int tg = gw; tg < T; tg += ngw) {
        int ro[4]; float gt[4];
#pragma unroll
        for (int r = 0; r < 4; ++r) { ro[r] = row_of[tg * 4 + r]; gt[r] = gate[tg * 4 + r]; }
        float v[16]; float s = 0.f;
#pragma unroll
        for (int j = 0; j < 16; ++j) { const int c = lane + 64 * j; float x = ALPHA * h1[(size_t)tg * D + c];
#pragma unroll
            for (int r = 0; r < 4; ++r) x += gt[r] * Y[(size_t)ro[r] * 1024 + c];
            v[j] = x; s += x; }
        const float mu = wsum(s) * (1.f / D); float qq = 0.f;
#pragma unroll
        for (int j = 0; j < 16; ++j) { const float d = v[j] - mu; qq += d * d; }
        const float rstd = rsqrtf(wsum(qq) * (1.f / D) + LN_EPS);
#pragma unroll
        for (int j = 0; j < 16; ++j) { const int c = lane + 64 * j; out[(size_t)tg * D + c] = (v[j] - mu) * rstd * g[c] + beta[c]; }
    }
}


namespace pg {
typedef unsigned short bf16_t;
typedef short bf16x8 __attribute__((ext_vector_type(8)));
typedef float f32x4 __attribute__((ext_vector_type(4)));
typedef float f32x2 __attribute__((ext_vector_type(2)));
typedef unsigned u32x4 __attribute__((ext_vector_type(4)));
typedef unsigned u32x2 __attribute__((ext_vector_type(2)));
constexpr int BM = 256, BK = 64, HALF = 128, HTB = HALF * BK * 2, STAGE_BYTES = 8 * HTB, NXCD = 8, WGM = 8;
__host__ __device__ __forceinline__ int lds_byte(int r, int c) { const int st = (r >> 4) * 2 + (c >> 5), rr = r & 15, cc = c & 31, ob = rr * 64 + cc * 2; return st * 1024 + (ob ^ (((ob >> 9) & 1) << 5)); }
__host__ __device__ __forceinline__ void stage_rc(int b, int& R, int& C) { const int st = b / 1024, sb = b % 1024, swz = sb ^ (((sb >> 9) & 1) << 5); R = (st >> 1) * 16 + swz / 64; C = (st & 1) * 32 + (swz % 64) / 2; }
__host__ __device__ __forceinline__ int perm32(int rho) { const int n = rho >> 4, i = rho & 15; return 8 * (i >> 2) + 4 * n + (i & 3); }
__device__ __forceinline__ unsigned cvt_pk_bf16(float lo, float hi) { unsigned r; asm volatile("v_cvt_pk_bf16_f32 %0, %1, %2" : "=v"(r) : "v"(lo), "v"(hi)); return r; }

struct Unit { const char* A; const char* B; const int* rows; int nvalid; int pm, pn, g, aux; };

struct TileOrder {
    int nM, nN, per_g, nwg, G, c;
    __device__ __forceinline__ void init(int nM_, int nN_, int ng, int G_, int c_) { nM = nM_; nN = nN_; per_g = nM * nN; nwg = per_g * ng; G = G_; c = c_; }
    __device__ __forceinline__ bool tile(int i, int& g, int& pm, int& pn) const {
        const long L = (long)i * G + c; if (L >= nwg) return false;
        int wgid = (int)L; { const int q = nwg / NXCD, r = nwg % NXCD, xcd = wgid % NXCD, off = wgid / NXCD; wgid = (xcd < r ? xcd * (q + 1) : r * (q + 1) + (xcd - r) * q) + off; }
        g = wgid / per_g; wgid -= g * per_g;
        const int nig = WGM * nN, gid = wgid / nig, fm = gid * WGM, gsz = (nM - fm) < WGM ? (nM - fm) : WGM;
        pm = fm + ((wgid % nig) % gsz); pn = (wgid % nig) / gsz; return true;
    }
};

typedef int i32x8 __attribute__((ext_vector_type(8)));
typedef int i32x4 __attribute__((ext_vector_type(4)));
template <class Epi, class Sched, bool GATHER = false, bool FP8 = false>
__device__ __forceinline__ void gemm_phase(LAS unsigned char* lds, const int lda, const int ldb, const int K, const Sched& S, const Epi& E) {
    const int tid = tidf(), wid = __builtin_amdgcn_readfirstlane(tid >> 6), lane = tid & 63, wr = wid >> 2, wc = wid & 3, fr = lane & 15, fq = lane >> 4;
    const int nt = K / BK;
    unsigned voffA[2], voffB[2]; int Rst[2], Cst[2];
#pragma unroll
    for (int i = 0; i < 2; ++i) { int R, C; stage_rc(tid * 16 + i * 8192, R, C); const int Rb = Epi::PERM ? ((R & ~31) + perm32(R & 31)) : R;
        Rst[i] = R; Cst[i] = C; voffA[i] = (unsigned)(R * lda + C) * 2u; voffB[i] = (unsigned)(Rb * ldb + C) * 2u; }
    const size_t kstep = (size_t)(BK * 2);
    const size_t hstepA = GATHER ? 0 : (size_t)HALF * lda * 2, hstepB = (size_t)HALF * ldb * 2;
    const unsigned ldsw = (unsigned)wid * 1024u;
    const int aoff = lds_byte(wr * 64 + fr, fq * 8), boff = lds_byte(wc * 32 + fr, fq * 8);
#define PG_SA(b, h) (((b) * 2 + (h)) * HTB)
#define PG_SB(b, h) ((4 + (b) * 2 + (h)) * HTB)
#define PG_STAGE(bufoff, gbase, voff) do { _Pragma("unroll") for (int _i = 0; _i < 2; ++_i) \
        __builtin_amdgcn_global_load_lds((const unsigned*)((const char*)(gbase) + (voff)[_i]), (LAS unsigned*)(lds + (bufoff) + ldsw + _i * 8192), 16, 0, 0); } while (0)
#define PG_LDA(dst, b, h) do { _Pragma("unroll") for (int m = 0; m < 4; ++m) { if constexpr (FP8) { \
        const i32x4 _lo = *(const LAS i32x4*)(lds + PG_SA(b, h) + aoff + m * 2048), _hi = *(const LAS i32x4*)(lds + PG_SA(b, h) + aoff + m * 2048 + 1024); \
        dst##8[m] = __builtin_shufflevector(_lo, _hi, 0, 1, 2, 3, 4, 5, 6, 7); } \
        else { _Pragma("unroll") for (int k = 0; k < 2; ++k) dst[m][k] = *(const LAS bf16x8*)(lds + PG_SA(b, h) + aoff + m * 2048 + k * 1024); } } } while (0)
#define PG_LDB(dst, b, h) do { _Pragma("unroll") for (int n = 0; n < 2; ++n) { if constexpr (FP8) { \
        const i32x4 _lo = *(const LAS i32x4*)(lds + PG_SB(b, h) + boff + n * 2048), _hi = *(const LAS i32x4*)(lds + PG_SB(b, h) + boff + n * 2048 + 1024); \
        dst##8[n] = __builtin_shufflevector(_lo, _hi, 0, 1, 2, 3, 4, 5, 6, 7); } \
        else { _Pragma("unroll") for (int k = 0; k < 2; ++k) dst[n][k] = *(const LAS bf16x8*)(lds + PG_SB(b, h) + boff + n * 2048 + k * 1024); } } } while (0)
#define PG_MMA(ai, bj, At, Bt) do { __builtin_amdgcn_s_setprio(1); _Pragma("unroll") for (int m = 0; m < 4; ++m) _Pragma("unroll") for (int n = 0; n < 2; ++n) { \
        if constexpr (FP8) asm volatile("v_mfma_scale_f32_16x16x128_f8f6f4 %0, %1, %2, %0, %3, %4 op_sel_hi:[0,0,0]" : "+v"(acc[ai][bj][m][n]) : "v"(Bt##8[n]), "v"(At##8[m]), "v"(sc_w), "v"(sc_a)); \
        else { _Pragma("unroll") for (int k = 0; k < 2; ++k) acc[ai][bj][m][n] = __builtin_amdgcn_mfma_f32_16x16x32_bf16(Bt[n][k], At[m][k], acc[ai][bj][m][n], 0, 0, 0); } } \
        __builtin_amdgcn_s_setprio(0); } while (0)
#define PG_WAIT_V(n) asm volatile("s_waitcnt vmcnt(" #n ")" ::: "memory")
#define PG_WAIT_L(n) asm volatile("s_waitcnt lgkmcnt(" #n ")" ::: "memory")
#define PG_BAR __builtin_amdgcn_s_barrier()
#define PG_SCHED __builtin_amdgcn_sched_barrier(0)
    Unit cur, nxt; int ui = 0;
    if (!S.next(0, cur)) return;
    f32x4 acc[2][2][4][2];
#pragma unroll
    for (int a = 0; a < 2; ++a)
#pragma unroll
        for (int b = 0; b < 2; ++b)
#pragma unroll
            for (int m = 0; m < 4; ++m)
#pragma unroll
                for (int n = 0; n < 2; ++n) acc[a][b][m][n] = (f32x4){0.f, 0.f, 0.f, 0.f};
    bf16x8 At[4][2], B0[2][2], B1[2][2]; i32x8 At8[4], B08[2], B18[2]; const int sc_w = 0x79797979, sc_a = 0x7f7f7f7f;
    unsigned gA0[2], gA1[2], nA0[2], nA1[2];
    auto gather_offs = [&](const Unit& u, unsigned (&o0)[2], unsigned (&o1)[2]) {
#pragma unroll
        for (int i = 0; i < 2; ++i) {
            const int r0 = Rst[i], r1 = HALF + Rst[i];
            const int t0 = (r0 < u.nvalid) ? u.rows[r0] : 0, t1 = (r1 < u.nvalid) ? u.rows[r1] : 0;
            o0[i] = (unsigned)(t0 * lda + Cst[i]) * 2u; o1[i] = (unsigned)(t1 * lda + Cst[i]) * 2u; }
    };
    if constexpr (GATHER) { gather_offs(cur, gA0, gA1); } else {
#pragma unroll
        for (int i = 0; i < 2; ++i) { gA0[i] = voffA[i]; gA1[i] = voffA[i]; nA0[i] = voffA[i]; nA1[i] = voffA[i]; } }
    const char* cA = cur.A; const char* cB = cur.B;
    PG_STAGE(PG_SB(0, 0), cB, voffB); PG_STAGE(PG_SB(0, 1), cB + hstepB, voffB); PG_STAGE(PG_SA(0, 0), cA, gA0); PG_STAGE(PG_SA(0, 1), cA + hstepA, gA1);
    if (wr == 1) PG_BAR;
    PG_WAIT_V(2); PG_BAR;
    PG_STAGE(PG_SB(1, 0), cB + kstep, voffB); PG_STAGE(PG_SA(1, 0), cA + kstep, gA0); PG_STAGE(PG_SB(1, 1), cB + hstepB + kstep, voffB);
    PG_WAIT_V(6); PG_BAR;
    for (;;) {
        const bool has_next = S.next(ui + 1, nxt);
        const char* nA = has_next ? nxt.A : cA; const char* nB = has_next ? nxt.B : cB;
        if constexpr (GATHER) { if (has_next) gather_offs(nxt, nA0, nA1); else {
#pragma unroll
            for (int i = 0; i < 2; ++i) { nA0[i] = gA0[i]; nA1[i] = gA1[i]; } } }
#pragma unroll 1
        for (int t = 0; t < nt; t += 2) {
            const bool last = (t == nt - 2);
            const char* a1 = cA + (size_t)(t + 1) * kstep;
            const char* a2 = last ? nA : cA + (size_t)(t + 2) * kstep; const char* b2 = last ? nB : cB + (size_t)(t + 2) * kstep;
            const char* a3 = a2 + kstep; const char* b3 = b2 + kstep;
            unsigned x0[2], x1[2];
#pragma unroll
            for (int i = 0; i < 2; ++i) { x0[i] = (GATHER && last) ? nA0[i] : gA0[i]; x1[i] = (GATHER && last) ? nA1[i] : gA1[i]; }
            PG_LDB(B0, 0, 0); PG_LDB(B1, 0, 1); PG_SCHED; PG_LDA(At, 0, 0); PG_STAGE(PG_SA(1, 1), a1 + hstepA, gA1);
            PG_WAIT_V(8); PG_WAIT_L(0); PG_BAR; PG_MMA(0, 0, At, B0); PG_MMA(0, 1, At, B1); PG_BAR; PG_SCHED;
            PG_LDA(At, 0, 1); PG_STAGE(PG_SB(0, 0), b2, voffB); PG_STAGE(PG_SB(0, 1), b2 + hstepB, voffB); PG_STAGE(PG_SA(0, 0), a2, x0);
            PG_WAIT_V(8); PG_WAIT_L(0); PG_BAR; PG_MMA(1, 0, At, B0); PG_MMA(1, 1, At, B1); PG_BAR; PG_SCHED;
            PG_LDB(B0, 1, 0); PG_LDB(B1, 1, 1); PG_SCHED; PG_LDA(At, 1, 0); PG_STAGE(PG_SA(0, 1), a2 + hstepA, x1);
            PG_WAIT_V(8); PG_WAIT_L(0); PG_BAR; PG_MMA(0, 0, At, B0); PG_MMA(0, 1, At, B1); PG_BAR; PG_SCHED;
            PG_LDA(At, 1, 1); PG_STAGE(PG_SB(1, 0), b3, voffB); PG_STAGE(PG_SB(1, 1), b3 + hstepB, voffB); PG_STAGE(PG_SA(1, 0), a3, x0);
            PG_WAIT_V(8); PG_WAIT_L(0); PG_BAR; PG_MMA(1, 0, At, B0); PG_MMA(1, 1, At, B1); PG_BAR; PG_SCHED;
        }
        if (wr == 0) PG_BAR;
        if constexpr (FP8) asm volatile("s_nop 15\n\ts_nop 15" ::: "memory");
        if constexpr (!Epi::AFTER_DRAIN) { E(acc, cur, wr, wc, fr, fq); }
        if (!has_next) break;
#pragma unroll
        for (int a = 0; a < 2; ++a)
#pragma unroll
            for (int b = 0; b < 2; ++b)
#pragma unroll
                for (int m = 0; m < 4; ++m)
#pragma unroll
                    for (int n = 0; n < 2; ++n) acc[a][b][m][n] = (f32x4){0.f, 0.f, 0.f, 0.f};
        cur = nxt; cA = nA; cB = nB; ++ui;
        if constexpr (GATHER) {
#pragma unroll
            for (int i = 0; i < 2; ++i) { gA0[i] = nA0[i]; gA1[i] = nA1[i]; } }
        if (wr == 1) PG_BAR;
    }
    PG_WAIT_V(0);
    PG_BAR;
    if constexpr (Epi::AFTER_DRAIN) { E.fused(acc, cur, wr, wc, fr, fq, lds, wid, lane); }
#undef PG_SA
#undef PG_SB
#undef PG_STAGE
#undef PG_LDA
#undef PG_LDB
#undef PG_MMA
#undef PG_WAIT_V
#undef PG_WAIT_L
#undef PG_BAR
#undef PG_SCHED
}

struct EpiStoreBf16 {
    static constexpr bool PERM = true, AFTER_DRAIN = false;
    bf16_t* O; int ldc; float scale; int gcol;
    __device__ __forceinline__ void operator()(const f32x4 (&acc)[2][2][4][2], const Unit& u, int wr, int wc, int fr, int fq) const {
        bf16_t* base = O + (size_t)(u.pm * BM + wr * 64 + fr) * ldc + u.g * gcol + u.pn * BM + wc * 32 + 8 * fq;
#pragma unroll
        for (int ai = 0; ai < 2; ++ai)
#pragma unroll
            for (int m = 0; m < 4; ++m) { bf16_t* rowp = base + (size_t)(ai * HALF + m * 16) * ldc;
#pragma unroll
                for (int bj = 0; bj < 2; ++bj) { const f32x4 v0 = acc[ai][bj][m][0] * scale, v1 = acc[ai][bj][m][1] * scale;
                    u32x4 w; w.x = cvt_pk_bf16(v0[0], v0[1]); w.y = cvt_pk_bf16(v0[2], v0[3]); w.z = cvt_pk_bf16(v1[0], v1[1]); w.w = cvt_pk_bf16(v1[2], v1[3]);
                    *(u32x4*)(rowp + bj * HALF) = w; } }
    }
};
}

constexpr int PROJW = 4608;
constexpr int PJ_P = 0, PJ_U = 512, PJ_O = 1536, PJ_G = 2560;
constexpr int WIN_ROWS = 5632;

__device__ __forceinline__ unsigned f2bf(float f) { unsigned u = __builtin_bit_cast(unsigned, f); return (u + 0x7fffu + ((u >> 16) & 1u)) >> 16; }
__device__ __forceinline__ unsigned pk2(float lo, float hi) { return f2bf(lo) | (f2bf(hi) << 16); }
__device__ __forceinline__ float bf2f(unsigned short b) { return __builtin_bit_cast(float, (unsigned)b << 16); }

struct TItem { const float* src; pg::bf16_t* dst; int ldw, ldt, inter, valid, fp8; };
__device__ __forceinline__ void titem_load(const TItem& it, pg::f32x4 (&r)[16], int lane) {
    const float* src = it.src + (size_t)(lane >> 4) * it.ldw + 4 * (lane & 15);
#pragma unroll
    for (int i = 0; i < 16; ++i) r[i] = *(const pg::f32x4*)(src + (size_t)(4 * i) * it.ldw);
}
__device__ __forceinline__ void titem_store(const TItem& it, const pg::f32x4 (&r)[16], LAS float* scr, int lane) {
#pragma unroll
    for (int i = 0; i < 16; ++i) { const int k = (lane >> 4) + 4 * i; LAS float* d = scr + (4 * (lane & 15)) * 65 + k;
        d[0] = r[i].x; d[65] = r[i].y; d[130] = r[i].z; d[195] = r[i].w; }
    asm volatile("s_waitcnt lgkmcnt(0)" ::: "memory");
#pragma unroll
    for (int itr = 0; itr < 8; ++itr) { const int nl = (lane >> 3) + 8 * itr, kg = lane & 7; const LAS float* p = scr + nl * 65 + 8 * kg;
        const size_t drow = it.inter ? (size_t)(nl & 1) * 128 + (nl >> 1) : (size_t)nl;
        if (it.fp8) { int w0 = __builtin_amdgcn_cvt_pk_fp8_f32(p[0] * 64.f, p[1] * 64.f, 0, false); w0 = __builtin_amdgcn_cvt_pk_fp8_f32(p[2] * 64.f, p[3] * 64.f, w0, true);
            int w1 = __builtin_amdgcn_cvt_pk_fp8_f32(p[4] * 64.f, p[5] * 64.f, 0, false); w1 = __builtin_amdgcn_cvt_pk_fp8_f32(p[6] * 64.f, p[7] * 64.f, w1, true);
            *(pg::u32x2*)((unsigned char*)it.dst + drow * it.ldt + 8 * kg) = (pg::u32x2){(unsigned)w0, (unsigned)w1}; }
        else { pg::u32x4 o; o.x = pk2(p[0], p[1]); o.y = pk2(p[2], p[3]); o.z = pk2(p[4], p[5]); o.w = pk2(p[6], p[7]);
            *(pg::u32x4*)(it.dst + drow * it.ldt + 8 * kg) = o; } }
    asm volatile("s_waitcnt lgkmcnt(0)" ::: "memory");
}
__device__ __forceinline__ int win_src_col(int r) { return r < 1536 ? r : (r < 2560 ? r + 1024 : (r < 4608 ? r - 2560 + C_G : r - 4608 + C_V)); }

struct OptBufs {
    pg::bf16_t *WinT, *H0B, *PROJ, *BT2;
    float *gif, *stats;
};
__device__ __forceinline__ void ph_ln0(LAS unsigned char* lds, const OptBufs& o, const float* x, const float* g, const float* beta, const float* w_in, const float* b_if) {
    const int tid = tidf(), lane = tid & 63, wave = tid >> 6, gw = blockIdx.x * NW + wave, ngw = gridDim.x * NW;
    LAS float* wif = (LAS float*)lds;
    __syncthreads();
    for (int i = tid; i < 1024 * 8; i += NT) wif[(i & 7) * 1024 + (i >> 3)] = w_in[(size_t)(i >> 3) * INC + C_IF + (i & 7)];
    __syncthreads();
    for (int row = gw; row < T; row += ngw) {
        const pg::f32x4* xr = (const pg::f32x4*)(x + (size_t)row * D) + lane;
        pg::f32x4 v[4]; float s = 0.f;
#pragma unroll
        for (int j = 0; j < 4; ++j) { v[j] = xr[64 * j]; s += (v[j].x + v[j].y) + (v[j].z + v[j].w); }
        const float mean = wsum(s) * (1.f / D); float s2 = 0.f;
#pragma unroll
        for (int j = 0; j < 4; ++j) { v[j] = v[j] - mean; s2 += (v[j].x * v[j].x + v[j].y * v[j].y) + (v[j].z * v[j].z + v[j].w * v[j].w); }
        const float rstd = rsqrtf(wsum(s2) * (1.f / D) + LN_EPS);
        float acc8[8];
#pragma unroll
        for (int q = 0; q < 8; ++q) acc8[q] = 0.f;
        unsigned long long* o8 = (unsigned long long*)(o.H0B + (size_t)row * D) + lane;
#pragma unroll
        for (int j = 0; j < 4; ++j) {
            const int c0 = 256 * j + 4 * lane;
            const pg::f32x4 gg = *(const pg::f32x4*)(g + c0), bb = *(const pg::f32x4*)(beta + c0);
            const pg::f32x4 y = v[j] * rstd * gg + bb;
            o8[64 * j] = (unsigned long long)pk2(y.x, y.y) | ((unsigned long long)pk2(y.z, y.w) << 32);
#pragma unroll
            for (int q = 0; q < 8; ++q) { const pg::f32x4 w4 = *(const LAS pg::f32x4*)(wif + q * 1024 + c0); acc8[q] += (y.x * w4.x + y.y * w4.y) + (y.z * w4.z + y.w * w4.w); }
        }
#pragma unroll
        for (int q = 0; q < 8; ++q) acc8[q] = wsum(acc8[q]);
        if (lane < 8) { float r = acc8[0];
#pragma unroll
            for (int q = 1; q < 8; ++q) r = (lane == q) ? acc8[q] : r;
            o.gif[(size_t)row * 8 + lane] = r + b_if[lane]; }
        if (lane == 0) { o.stats[(size_t)row * 2] = mean; o.stats[(size_t)row * 2 + 1] = rstd; }
    }
    __syncthreads();
}
struct SchedInproj {
    pg::TileOrder o; const char* A; const char* B;
    __device__ __forceinline__ bool next(int i, pg::Unit& u) const { int g, pm, pn; if (!o.tile(i, g, pm, pn)) return false;
        u.A = A + (size_t)pm * 256 * D * 2; u.B = B + (size_t)pn * 256 * D * 2; u.pm = pm; u.pn = pn; u.g = 0; u.aux = 0; u.rows = nullptr; u.nvalid = 0; return true; }
};
struct SchedVT {
    pg::TileOrder o; const char* A; const char* B;
    __device__ __forceinline__ bool next(int i, pg::Unit& u) const { int g, pm, pn; if (!o.tile(i, g, pm, pn)) return false;
        u.A = A + (size_t)pm * 256 * D * 2; u.B = B + (size_t)pn * 256 * D * 2; u.pm = pm; u.pn = pn; u.g = 0; u.aux = 0; u.rows = nullptr; u.nvalid = 0; return true; }
};
struct EpiVT {
    static constexpr bool PERM = true, AFTER_DRAIN = false;
    pg::bf16_t* BT2;
    __device__ __forceinline__ void operator()(const pg::f32x4 (&acc)[2][2][4][2], const pg::Unit& u, int wr, int wc, int fr, int fq) const {
        const int h = u.pm, b = u.pn >> 4, c = u.pn & 15;
        pg::bf16_t* base = BT2 + ((size_t)((b * 4 + h) * 16 + c) * 256 + wr * 64 + fr) * 512 + wc * 32 + 8 * fq;
#pragma unroll
        for (int ai = 0; ai < 2; ++ai)
#pragma unroll
            for (int m = 0; m < 4; ++m) { pg::bf16_t* rowp = base + (size_t)(ai * 128 + m * 16) * 512;
#pragma unroll
                for (int bj = 0; bj < 2; ++bj) { const pg::f32x4 v0 = acc[ai][bj][m][0], v1 = acc[ai][bj][m][1];
                    pg::u32x4 w; w.x = pg::cvt_pk_bf16(v0[0], v0[1]); w.y = pg::cvt_pk_bf16(v0[2], v0[3]); w.z = pg::cvt_pk_bf16(v1[0], v1[1]); w.w = pg::cvt_pk_bf16(v1[2], v1[3]);
                    *(pg::u32x4*)(rowp + bj * 128) = w; } }
    }
};
__device__ __forceinline__ void ph_inproj(LAS unsigned char* lds, const OptBufs& o) {
    const int G = gridDim.x, bx = blockIdx.x;
    { SchedInproj S; S.o.init(T / 256, PROJW / 256, 1, G, bx); S.A = (const char*)o.H0B; S.B = (const char*)o.WinT;
      pg::EpiStoreBf16 E{o.PROJ, PROJW, 1.f, 0}; pg::gemm_phase<pg::EpiStoreBf16, SchedInproj>(lds, D, D, D, S, E); }
    { SchedVT S; S.o.init(4, T / 256, 1, G, (bx + 128) % G); S.A = (const char*)(o.WinT + (size_t)PROJW * D); S.B = (const char*)o.H0B;
      EpiVT E{o.BT2}; pg::gemm_phase<EpiVT, SchedVT>(lds, D, D, D, S, E); }
}

struct OptBufs2 { pg::bf16_t *WqT, *WkT, *WpoolT, *WbpT, *POOLED, *UC, *MIXED, *Q, *K, *YPOOL; };
__device__ __forceinline__ void ld8(const pg::bf16_t* p, float (&v)[8]) { const pg::u32x4 w = *(const pg::u32x4*)p;
    v[0] = __builtin_bit_cast(float, w.x << 16); v[1] = __builtin_bit_cast(float, w.x & 0xffff0000u); v[2] = __builtin_bit_cast(float, w.y << 16); v[3] = __builtin_bit_cast(float, w.y & 0xffff0000u);
    v[4] = __builtin_bit_cast(float, w.z << 16); v[5] = __builtin_bit_cast(float, w.z & 0xffff0000u); v[6] = __builtin_bit_cast(float, w.w << 16); v[7] = __builtin_bit_cast(float, w.w & 0xffff0000u); }
__device__ __forceinline__ void st8(pg::bf16_t* p, const float (&v)[8]) { pg::u32x4 w; w.x = pk2(v[0], v[1]); w.y = pk2(v[2], v[3]); w.z = pk2(v[4], v[5]); w.w = pk2(v[6], v[7]); *(pg::u32x4*)p = w; }
__device__ __forceinline__ void ph_poolconv_opt(const pg::bf16_t* PROJ, const float* cw, const float* cb, pg::bf16_t* POOLED, pg::bf16_t* UC) {
    const int gt = blockIdx.x * NT + tidf(), ngt = gridDim.x * NT;
    for (int it = gt; it < 512 * 192; it += ngt) {
        const int run = it / 192, oc = it % 192; const int t0 = run * 32, tpos0 = t0 & (SEQ - 1);
        if (oc < 64) {
            const int c0 = oc * 8, w = 2 << (c0 >> 7);
            const pg::bf16_t* src = PROJ + PJ_P + c0;
            float s[8];
#pragma unroll
            for (int q = 0; q < 8; ++q) s[q] = 0.f;
            { pg::u32x4 hv[15];
#pragma unroll
              for (int j = 1; j < 16; ++j) hv[j - 1] = (j < w && tpos0 - j >= 0) ? *(const pg::u32x4*)(src + (size_t)(t0 - j) * PROJW) : (pg::u32x4){0u, 0u, 0u, 0u};
#pragma unroll
              for (int j = 0; j < 15; ++j) { s[0] += __builtin_bit_cast(float, hv[j].x << 16); s[1] += __builtin_bit_cast(float, hv[j].x & 0xffff0000u); s[2] += __builtin_bit_cast(float, hv[j].y << 16); s[3] += __builtin_bit_cast(float, hv[j].y & 0xffff0000u);
                  s[4] += __builtin_bit_cast(float, hv[j].z << 16); s[5] += __builtin_bit_cast(float, hv[j].z & 0xffff0000u); s[6] += __builtin_bit_cast(float, hv[j].w << 16); s[7] += __builtin_bit_cast(float, hv[j].w & 0xffff0000u); } }
            for (int i0 = 0; i0 < 32; i0 += 8) {
                pg::u32x4 cv[8], ov[8];
#pragma unroll
                for (int i = 0; i < 8; ++i) { const int t = t0 + i0 + i, tp = tpos0 + i0 + i; cv[i] = *(const pg::u32x4*)(src + (size_t)t * PROJW);
                    ov[i] = (tp - w + 1 >= 0) ? *(const pg::u32x4*)(src + (size_t)(t - w + 1) * PROJW) : (pg::u32x4){0u, 0u, 0u, 0u}; }
#pragma unroll
                for (int i = 0; i < 8; ++i) { const int t = t0 + i0 + i, tp = tpos0 + i0 + i; float cur[8], old[8], o[8];
                    cur[0] = __builtin_bit_cast(float, cv[i].x << 16); cur[1] = __builtin_bit_cast(float, cv[i].x & 0xffff0000u); cur[2] = __builtin_bit_cast(float, cv[i].y << 16); cur[3] = __builtin_bit_cast(float, cv[i].y & 0xffff0000u);
                    cur[4] = __builtin_bit_cast(float, cv[i].z << 16); cur[5] = __builtin_bit_cast(float, cv[i].z & 0xffff0000u); cur[6] = __builtin_bit_cast(float, cv[i].w << 16); cur[7] = __builtin_bit_cast(float, cv[i].w & 0xffff0000u);
                    old[0] = __builtin_bit_cast(float, ov[i].x << 16); old[1] = __builtin_bit_cast(float, ov[i].x & 0xffff0000u); old[2] = __builtin_bit_cast(float, ov[i].y << 16); old[3] = __builtin_bit_cast(float, ov[i].y & 0xffff0000u);
                    old[4] = __builtin_bit_cast(float, ov[i].z << 16); old[5] = __builtin_bit_cast(float, ov[i].z & 0xffff0000u); old[6] = __builtin_bit_cast(float, ov[i].w << 16); old[7] = __builtin_bit_cast(float, ov[i].w & 0xffff0000u);
                    const float inv = 1.f / (float)((tp + 1 < w) ? tp + 1 : w);
#pragma unroll
                    for (int q = 0; q < 8; ++q) { s[q] += cur[q]; o[q] = s[q] * inv - cur[q]; s[q] -= old[q]; }
                    st8(POOLED + (size_t)t * 512 + c0, o); }
            }
        } else {
            const int c0 = (oc - 64) * 8;
            const pg::bf16_t* src = PROJ + PJ_U + c0;
            float w0[8], w1[8], w2[8], w3[8], bb[8], u0[8], u1[8], u2[8];
#pragma unroll
            for (int q = 0; q < 8; ++q) { w0[q] = cw[c0 + q]; w1[q] = cw[1024 + c0 + q]; w2[q] = cw[2048 + c0 + q]; w3[q] = cw[3072 + c0 + q]; bb[q] = cb[c0 + q]; u0[q] = 0.f; u1[q] = 0.f; u2[q] = 0.f; }
            if (tpos0 >= 3) ld8(src + (size_t)(t0 - 3) * PROJW, u0);
            if (tpos0 >= 2) ld8(src + (size_t)(t0 - 2) * PROJW, u1);
            if (tpos0 >= 1) ld8(src + (size_t)(t0 - 1) * PROJW, u2);
            for (int i0 = 0; i0 < 32; i0 += 8) {
                pg::u32x4 cv[8];
#pragma unroll
                for (int i = 0; i < 8; ++i) cv[i] = *(const pg::u32x4*)(src + (size_t)(t0 + i0 + i) * PROJW);
#pragma unroll
                for (int i = 0; i < 8; ++i) { float u3[8], o[8];
                    u3[0] = __builtin_bit_cast(float, cv[i].x << 16); u3[1] = __builtin_bit_cast(float, cv[i].x & 0xffff0000u); u3[2] = __builtin_bit_cast(float, cv[i].y << 16); u3[3] = __builtin_bit_cast(float, cv[i].y & 0xffff0000u);
                    u3[4] = __builtin_bit_cast(float, cv[i].z << 16); u3[5] = __builtin_bit_cast(float, cv[i].z & 0xffff0000u); u3[6] = __builtin_bit_cast(float, cv[i].w << 16); u3[7] = __builtin_bit_cast(float, cv[i].w & 0xffff0000u);
#pragma unroll
                    for (int q = 0; q < 8; ++q) { const float y = bb[q] + w0[q] * u0[q] + w1[q] * u1[q] + w2[q] * u2[q] + w3[q] * u3[q]; o[q] = y / (1.f + __expf(-y)); u0[q] = u1[q]; u1[q] = u2[q]; u2[q] = u3[q]; }
                    st8(UC + (size_t)(t0 + i0 + i) * 1024 + c0, o); }
            }
        }
    }
}
struct SchedG {
    pg::TileOrder o; const char* A; const char* B; size_t gA, gB, tA, tB;
    __device__ __forceinline__ bool next(int i, pg::Unit& u) const { int g, pm, pn; if (!o.tile(i, g, pm, pn)) return false;
        u.A = A + g * gA + pm * tA; u.B = B + g * gB + pn * tB; u.pm = pm; u.pn = pn; u.g = g; u.aux = 0; u.rows = nullptr; u.nvalid = 0; return true; }
};
struct EpiPoolMixB {
    static constexpr bool PERM = true, AFTER_DRAIN = false;
    pg::bf16_t* O; const float* b; const float* ls;
    __device__ __forceinline__ void operator()(const pg::f32x4 (&acc)[2][2][4][2], const pg::Unit& u, int wr, int wc, int fr, int fq) const {
        const int col0 = u.pn * 256 + wc * 32 + 8 * fq;
        pg::bf16_t* base = O + (size_t)(u.pm * 256 + wr * 64 + fr) * 512 + col0;
        pg::f32x4 bv[2][2], lv[2][2];
#pragma unroll
        for (int bj = 0; bj < 2; ++bj)
#pragma unroll
            for (int n = 0; n < 2; ++n) { bv[bj][n] = *(const pg::f32x4*)(b + col0 + bj * 128 + 4 * n); lv[bj][n] = *(const pg::f32x4*)(ls + col0 + bj * 128 + 4 * n); }
#pragma unroll
        for (int ai = 0; ai < 2; ++ai)
#pragma unroll
            for (int m = 0; m < 4; ++m) { pg::bf16_t* rowp = base + (size_t)(ai * 128 + m * 16) * 512;
#pragma unroll
                for (int bj = 0; bj < 2; ++bj) { const pg::f32x4 v0 = (acc[ai][bj][m][0] + bv[bj][0]) * lv[bj][0], v1 = (acc[ai][bj][m][1] + bv[bj][1]) * lv[bj][1];
                    pg::u32x4 w; w.x = pg::cvt_pk_bf16(v0[0], v0[1]); w.y = pg::cvt_pk_bf16(v0[2], v0[3]); w.z = pg::cvt_pk_bf16(v1[0], v1[1]); w.w = pg::cvt_pk_bf16(v1[2], v1[3]);
                    *(pg::u32x4*)(rowp + bj * 128) = w; } }
    }
};
__device__ __forceinline__ void cvt_bf16_f32(const pg::bf16_t* src, size_t lds_, int cols, float* dst, size_t rows) {
    const size_t gt = (size_t)blockIdx.x * NT + tidf(), ngt = (size_t)gridDim.x * NT;
    for (size_t i = gt; i < rows * cols; i += ngt) { const size_t r = i / cols; const int c = (int)(i % cols); dst[i] = bf2f(src[r * lds_ + c]); }
}
__device__ __forceinline__ void ph_adapt_v(const OptBufs& o, float* vv) {
    const size_t gt = (size_t)blockIdx.x * NT + tidf(), ngt = (size_t)gridDim.x * NT;
    for (size_t i = gt; i < (size_t)T * 1024; i += ngt) { const int t = (int)(i >> 10), e = (int)(i & 1023), h = e >> 8, el = e & 255, b = t >> 12, cc = (t & 4095) >> 8, tl = t & 255;
        vv[i] = bf2f(o.BT2[((size_t)((b * 4 + h) * 16 + cc) * 256 + el) * 512 + tl]); }
}


struct OptBufs3 { pg::bf16_t *KaT, *A2, *HOUT; float *U, *rowv, *colv, *winter, *aw, *emt, *den, *un, *decay; };
__device__ __forceinline__ float log_sigmoidf_(float x) { return fminf(x, 0.f) - log1pf(expf(-fabsf(x))); }
__device__ __forceinline__ void scalar_scan_wave(int bh, const float* gif, const OptBufs3& o, int lane) {
    const int b = bh >> 2, h = bh & 3;
    float mc = 0.f;
    float nip[4], nfp[4];
#pragma unroll
    for (int sub = 0; sub < 4; ++sub) { const size_t t = (size_t)b * SEQ + sub * 64 + lane; nip[sub] = gif[t * 8 + h]; nfp[sub] = gif[t * 8 + 4 + h]; }
    for (int c = 0; c < 16; ++c) {
        float bs[4], ip[4], pm[4], bt[4], mt[4];
#pragma unroll
        for (int sub = 0; sub < 4; ++sub) { ip[sub] = nip[sub]; bs[sub] = log_sigmoidf_(nfp[sub]); }
        if (c < 15) {
#pragma unroll
            for (int sub = 0; sub < 4; ++sub) { const size_t t = (size_t)b * SEQ + (c + 1) * 256 + sub * 64 + lane; nip[sub] = gif[t * 8 + h]; nfp[sub] = gif[t * 8 + 4 + h]; } }
#pragma unroll
        for (int off = 1; off < 64; off <<= 1) {
#pragma unroll
            for (int sub = 0; sub < 4; ++sub) { const float v = __shfl_up(bs[sub], off); if (lane >= off) bs[sub] += v; } }
        float carry = 0.f;
#pragma unroll
        for (int sub = 0; sub < 4; ++sub) { bt[sub] = carry + bs[sub]; carry += __shfl(bs[sub], 63); pm[sub] = ip[sub] - bt[sub]; }
        const float Gc = carry;
#pragma unroll
        for (int off = 1; off < 64; off <<= 1) {
#pragma unroll
            for (int sub = 0; sub < 4; ++sub) { const float v = __shfl_up(pm[sub], off); if (lane >= off) pm[sub] = fmaxf(pm[sub], v); } }
        float pmc = -INFINITY;
#pragma unroll
        for (int sub = 0; sub < 4; ++sub) { pm[sub] = fmaxf(pm[sub], pmc); pmc = __shfl(pm[sub], 63); mt[sub] = bt[sub] + fmaxf(mc, pm[sub]); }
        const float mnext = __shfl(mt[3], 63);
#pragma unroll
        for (int sub = 0; sub < 4; ++sub) {
            const size_t idx = ((size_t)b * SEQ + c * 256 + sub * 64 + lane) * 4 + h;
            o.rowv[idx] = bt[sub] - mt[sub]; o.colv[idx] = ip[sub] - bt[sub];
            o.winter[idx] = expf(bt[sub] + mc - mt[sub]); o.aw[idx] = expf(Gc - bt[sub] + ip[sub] - mnext); o.emt[idx] = expf(-mt[sub]);
        }
        if (lane == 0) o.decay[bh * 16 + c] = expf(Gc + mc - mnext);
        mc = mnext;
    }
}
struct EpiQ {
    static constexpr bool PERM = true, AFTER_DRAIN = false;
    pg::bf16_t* Q; pg::bf16_t* A2; const float* winter;
    __device__ __forceinline__ void operator()(const pg::f32x4 (&acc)[2][2][4][2], const pg::Unit& u, int wr, int wc, int fr, int fq) const {
        const int h = u.g, col0 = wc * 32 + 8 * fq;
#pragma unroll
        for (int ai = 0; ai < 2; ++ai)
#pragma unroll
            for (int m = 0; m < 4; ++m) { const size_t t = (size_t)u.pm * 256 + ai * 128 + wr * 64 + m * 16 + fr; const float wi = winter[t * 4 + h];
#pragma unroll
                for (int bj = 0; bj < 2; ++bj) { const pg::f32x4 v0 = acc[ai][bj][m][0] * 0.0625f, v1 = acc[ai][bj][m][1] * 0.0625f;
                    pg::u32x4 w; w.x = pg::cvt_pk_bf16(v0[0], v0[1]); w.y = pg::cvt_pk_bf16(v0[2], v0[3]); w.z = pg::cvt_pk_bf16(v1[0], v1[1]); w.w = pg::cvt_pk_bf16(v1[2], v1[3]);
                    *(pg::u32x4*)(Q + t * 1024 + h * 256 + col0 + bj * 128) = w;
                    const pg::f32x4 x0 = v0 * wi, x1 = v1 * wi;
                    pg::u32x4 y; y.x = pg::cvt_pk_bf16(x0[0], x0[1]); y.y = pg::cvt_pk_bf16(x0[2], x0[3]); y.z = pg::cvt_pk_bf16(x1[0], x1[1]); y.w = pg::cvt_pk_bf16(x1[2], x1[3]);
                    *(pg::u32x4*)(A2 + t * 2048 + h * 512 + 256 + col0 + bj * 128) = y; }
                asm volatile("" ::: "memory"); }
    }
};
struct EpiKT {
    static constexpr bool PERM = true, AFTER_DRAIN = false;
    pg::bf16_t* KaT; const float* aw;
    __device__ __forceinline__ void operator()(const pg::f32x4 (&acc)[2][2][4][2], const pg::Unit& u, int wr, int wc, int fr, int fq) const {
        const int h = u.g; const size_t t0 = (size_t)u.pn * 256 + wc * 32 + 8 * fq;
#pragma unroll
        for (int bj = 0; bj < 2; ++bj) {
            float a[8];
#pragma unroll
            for (int j = 0; j < 8; ++j) a[j] = aw[(t0 + bj * 128 + j) * 4 + h];
            pg::bf16_t* rowp = KaT + ((size_t)h * 256 + wr * 64 + fr) * T + t0 + bj * 128;
#pragma unroll
            for (int ai = 0; ai < 2; ++ai)
#pragma unroll
                for (int m = 0; m < 4; ++m) { const pg::f32x4 v0 = acc[ai][bj][m][0], v1 = acc[ai][bj][m][1];
                    pg::u32x4 w; w.x = pg::cvt_pk_bf16(v0[0] * a[0], v0[1] * a[1]); w.y = pg::cvt_pk_bf16(v0[2] * a[2], v0[3] * a[3]);
                    w.z = pg::cvt_pk_bf16(v1[0] * a[4], v1[1] * a[5]); w.w = pg::cvt_pk_bf16(v1[2] * a[6], v1[3] * a[7]);
                    *(pg::u32x4*)(rowp + (size_t)(ai * 128 + m * 16) * T) = w; asm volatile("" ::: "memory"); }
        }
    }
};
struct EpiS {
    static constexpr bool PERM = true, AFTER_DRAIN = false;
    pg::bf16_t* A2; const float* rowv; const float* colv; float* den;
    __device__ __forceinline__ void operator()(const pg::f32x4 (&acc)[2][2][4][2], const pg::Unit& u, int wr, int wc, int fr, int fq) const {
        const int bh = u.g >> 4, c = u.g & 15, b = bh >> 2, h = bh & 3; const size_t tok0 = (size_t)b * SEQ + c * 256;
        const int col0 = wc * 32 + 8 * fq;
        const float* cvp = colv + (tok0 + col0) * 4 + h;
#pragma unroll
        for (int ai = 0; ai < 2; ++ai)
#pragma unroll
            for (int m = 0; m < 4; ++m) { const int tl = ai * 128 + wr * 64 + m * 16 + fr; const float rv = rowv[(tok0 + tl) * 4 + h]; float rs = 0.f;
                pg::bf16_t* op = A2 + (tok0 + tl) * 2048 + h * 512 + col0;
#pragma unroll
                for (int bj = 0; bj < 2; ++bj) { float x[8];
#pragma unroll
                    for (int j = 0; j < 8; ++j) { const int sl = col0 + bj * 128 + j; const float a_ = (j < 4) ? acc[ai][bj][m][0][j] : acc[ai][bj][m][1][j - 4];
                        const float w_ = __expf(rv + cvp[(bj * 128 + j) * 4]); x[j] = (sl <= tl) ? a_ * w_ : 0.f; rs += x[j]; }
                    pg::u32x4 w; w.x = pg::cvt_pk_bf16(x[0], x[1]); w.y = pg::cvt_pk_bf16(x[2], x[3]); w.z = pg::cvt_pk_bf16(x[4], x[5]); w.w = pg::cvt_pk_bf16(x[6], x[7]);
                    *(pg::u32x4*)(op + bj * 128) = w; asm volatile("" ::: "memory"); }
                rs += __shfl_xor(rs, 16); rs += __shfl_xor(rs, 32);
                if (fq == 0) atomicAdd(den + (tok0 + tl) * 4 + h, rs);
                asm volatile("" ::: "memory"); }
    }
};
struct EpiF32U {
    static constexpr bool PERM = false, AFTER_DRAIN = false;
    float* C;
    __device__ __forceinline__ void operator()(const pg::f32x4 (&acc)[2][2][4][2], const pg::Unit& u, int wr, int wc, int fr, int fq) const {
        float* base = C + (size_t)u.aux * 65536 + (size_t)(wr * 64 + fr) * 256 + wc * 32 + 4 * fq;
#pragma unroll
        for (int ai = 0; ai < 2; ++ai)
#pragma unroll
            for (int m = 0; m < 4; ++m)
#pragma unroll
                for (int bj = 0; bj < 2; ++bj)
#pragma unroll
                    for (int n = 0; n < 2; ++n) { *(pg::f32x4*)(base + (size_t)(ai * 128 + m * 16) * 256 + bj * 128 + n * 16) = acc[ai][bj][m][n]; if (n) asm volatile("" ::: "memory"); }
    }
};
struct EpiNum {
    static constexpr bool PERM = true, AFTER_DRAIN = true;
    pg::bf16_t* HOUT; const pg::bf16_t* PROJ; const float* den; const float* emt; const float* gain;
    __device__ __forceinline__ void fused(pg::f32x4 (&acc)[2][2][4][2], const pg::Unit& u, int wr, int wc, int fr, int fq, LAS unsigned char* lds, int wid, int lane) const {
        const int bh = u.g >> 4, c = u.g & 15, b = bh >> 2, h = bh & 3; const size_t tok0 = (size_t)b * SEQ + c * 256;
        LAS pg::f32x2* P = (LAS pg::f32x2*)lds; LAS pg::f32x2* Sx = (LAS pg::f32x2*)(lds + 8192);
#pragma unroll
        for (int ai = 0; ai < 2; ++ai)
#pragma unroll
            for (int m = 0; m < 4; ++m) { const int tl = ai * 128 + wr * 64 + m * 16 + fr; const size_t ti = (tok0 + tl) * 4 + h;
                const float inv = 1.f / fmaxf(fabsf(den[ti]), emt[ti]); float s = 0.f;
#pragma unroll
                for (int bj = 0; bj < 2; ++bj)
#pragma unroll
                    for (int n = 0; n < 2; ++n) { acc[ai][bj][m][n] = acc[ai][bj][m][n] * inv; const pg::f32x4 x = acc[ai][bj][m][n]; s += (x[0] + x[1]) + (x[2] + x[3]); }
                s += __shfl_xor(s, 16); s += __shfl_xor(s, 32);
                const float mw = s * (1.f / 64.f); float q = 0.f;
#pragma unroll
                for (int bj = 0; bj < 2; ++bj)
#pragma unroll
                    for (int n = 0; n < 2; ++n) { const pg::f32x4 d = acc[ai][bj][m][n] - mw; q += (d[0] * d[0] + d[1] * d[1]) + (d[2] * d[2] + d[3] * d[3]); }
                q += __shfl_xor(q, 16); q += __shfl_xor(q, 32);
                if (fq == 0) P[tl * 4 + wc] = (pg::f32x2){mw, q}; }
        asm volatile("s_waitcnt lgkmcnt(0)" ::: "memory"); __builtin_amdgcn_s_barrier(); asm volatile("" ::: "memory");
        if (lane < 32) { const int row = wid * 32 + lane;
            const pg::f32x2 a = P[row * 4 + 0], b_ = P[row * 4 + 1], c_ = P[row * 4 + 2], d = P[row * 4 + 3];
            const float mt = (a.x + b_.x + c_.x + d.x) * 0.25f;
            const float da = a.x - mt, db = b_.x - mt, dc = c_.x - mt, dd = d.x - mt;
            const float m2 = (a.y + b_.y) + (c_.y + d.y) + 64.f * ((da * da + db * db) + (dc * dc + dd * dd));
            Sx[row] = (pg::f32x2){mt, rsqrtf(m2 * (1.f / 256.f) + LN_EPS)}; }
        asm volatile("s_waitcnt lgkmcnt(0)" ::: "memory"); __builtin_amdgcn_s_barrier(); asm volatile("" ::: "memory");
        const int col0 = wc * 32 + 8 * fq;
#pragma unroll
        for (int bj = 0; bj < 2; ++bj) { const int e0 = h * 256 + col0 + bj * 128;
            const pg::f32x4 g0 = *(const pg::f32x4*)(gain + e0), g1 = *(const pg::f32x4*)(gain + e0 + 4);
#pragma unroll
            for (int ai = 0; ai < 2; ++ai)
#pragma unroll
                for (int m = 0; m < 4; ++m) { const int tl = ai * 128 + wr * 64 + m * 16 + fr; const pg::f32x2 sr = Sx[tl]; const size_t t = tok0 + tl;
                    float ov[8]; ld8(PROJ + t * PROJW + PJ_O + e0, ov);
                    const pg::f32x4 v0 = (acc[ai][bj][m][0] - sr.x) * sr.y * g0, v1 = (acc[ai][bj][m][1] - sr.x) * sr.y * g1;
                    float r[8];
#pragma unroll
                    for (int j = 0; j < 4; ++j) { r[j] = v0[j] * sigmoidf_(ov[j]); r[4 + j] = v1[j] * sigmoidf_(ov[4 + j]); }
                    st8(HOUT + t * 1024 + e0, r); } }
    }
};
struct SchedG1 { pg::TileOrder o; const char* Q; const char* K;
    __device__ __forceinline__ bool next(int i, pg::Unit& u) const { int g, pm, pn; if (!o.tile(i, g, pm, pn)) return false;
        const int bh = g >> 4, c = g & 15, b = bh >> 2, h = bh & 3; const size_t off = (((size_t)b * SEQ + c * 256) * 1024 + h * 256) * 2;
        u.A = Q + off; u.B = K + off; u.pm = 0; u.pn = 0; u.g = g; u.aux = g; u.rows = nullptr; u.nvalid = 0; return true; } };
struct SchedG2 { pg::TileOrder o; const char* BT2; const char* KaT;
    __device__ __forceinline__ bool next(int i, pg::Unit& u) const { int g, pm, pn; if (!o.tile(i, g, pm, pn)) return false;
        const int bh = g / 15, c = g % 15, b = bh >> 2, h = bh & 3;
        u.A = BT2 + (size_t)(bh * 16 + c) * 256 * 512 * 2; u.B = KaT + (((size_t)h * 256) * T + (size_t)b * SEQ + c * 256) * 2;
        u.pm = 0; u.pn = 0; u.g = bh * 16 + c; u.aux = bh * 16 + c; u.rows = nullptr; u.nvalid = 0; return true; } };
struct SchedG3 { pg::TileOrder o; const char* A2; const char* BT2;
    __device__ __forceinline__ bool next(int i, pg::Unit& u) const { int g, pm, pn; if (!o.tile(i, g, pm, pn)) return false;
        const int bh = g >> 4, c = g & 15, b = bh >> 2, h = bh & 3;
        u.A = A2 + (((size_t)b * SEQ + c * 256) * 2048 + h * 512) * 2; u.B = BT2 + (size_t)g * 256 * 512 * 2; u.pm = 0; u.pn = 0; u.g = g; u.aux = g; u.rows = nullptr; u.nvalid = 0; return true; } };
__device__ __forceinline__ void ph_un(LAS unsigned char* lds, const OptBufs2& o2, const OptBufs3& o3) {
    const int tid = tidf(), d = tid & 255, sh = tid >> 8; LAS float* red = (LAS float*)lds;
    for (int it = blockIdx.x; it < 256; it += gridDim.x) { const int bh = it >> 4, c = it & 15, b = bh >> 2, h = bh & 3; const size_t tok0 = (size_t)b * SEQ + c * 256;
        float s = 0.f;
#pragma unroll 8
        for (int j = 0; j < 128; ++j) { const size_t t = tok0 + sh * 128 + j; s += o3.aw[t * 4 + h] * bf2f(o2.K[t * 1024 + h * 256 + d]); }
        __syncthreads(); if (sh == 1) red[d] = s; __syncthreads();
        if (sh == 0) o3.un[(size_t)it * 256 + d] = s + red[d]; }
    __syncthreads();
}
__device__ __forceinline__ void ph_state_scan(const OptBufs& ob, const OptBufs3& o3) {
    const int gt = blockIdx.x * NT + tidf(), ngt = gridDim.x * NT;
    for (int it = gt; it < 16 * 256 * 64; it += ngt) { const int bh = it >> 14, e = (it >> 6) & 255, d4 = (it & 63) * 4;
        pg::f32x4 U[15]; float dc[15];
#pragma unroll
        for (int c = 0; c < 15; ++c) { const size_t g = (size_t)bh * 16 + c; U[c] = *(const pg::f32x4*)(o3.U + g * 65536 + (size_t)e * 256 + d4); dc[c] = o3.decay[g]; }
        pg::f32x4 C = (pg::f32x4){0.f, 0.f, 0.f, 0.f};
#pragma unroll
        for (int c = 0; c < 16; ++c) { const size_t g = (size_t)bh * 16 + c;
            pg::u32x2 w; w.x = pk2(C[0], C[1]); w.y = pk2(C[2], C[3]);
            *(pg::u32x2*)(ob.BT2 + (g * 256 + e) * 512 + 256 + d4) = w;
            if (c < 15) C = C * dc[c] + U[c]; } }
}
__device__ __forceinline__ void ph_den_inter(LAS unsigned char* lds, const OptBufs3& o3) {
    const int tid = tidf(), lane = tid & 63, wave = tid >> 6; LAS float* nn = (LAS float*)lds;
    for (int it = blockIdx.x; it < 256; it += gridDim.x) { const int bh = it >> 4, c = it & 15, b = bh >> 2, h = bh & 3; const size_t tok0 = (size_t)b * SEQ + c * 256;
        __syncthreads();
        if (tid < 256) { float n = 0.f; for (int j = 0; j < c; ++j) n = n * o3.decay[bh * 16 + j] + o3.un[(size_t)(bh * 16 + j) * 256 + tid]; nn[tid] = n; }
        __syncthreads();
        const pg::f32x4 nv = *(const LAS pg::f32x4*)(nn + 4 * lane);
        for (int r0 = 0; r0 < 32; r0 += 8) { pg::u32x2 wv[8];
#pragma unroll
            for (int r = 0; r < 8; ++r) wv[r] = *(const pg::u32x2*)(o3.A2 + (tok0 + wave * 32 + r0 + r) * 2048 + h * 512 + 256 + 4 * lane);
#pragma unroll
            for (int r = 0; r < 8; ++r) { const size_t t = tok0 + wave * 32 + r0 + r; const pg::u32x2 w = wv[r];
                float s = __builtin_bit_cast(float, w.x << 16) * nv[0] + __builtin_bit_cast(float, w.x & 0xffff0000u) * nv[1] + __builtin_bit_cast(float, w.y << 16) * nv[2] + __builtin_bit_cast(float, w.y & 0xffff0000u) * nv[3];
                s = wsum(s);
                if (lane == 0) o3.den[t * 4 + h] += s; } } }
    __syncthreads();
}

__device__ __forceinline__ void ph_gemms_D(LAS unsigned char* lds, const OptBufs2& o, const OptBufs3& o3, const float* b_pool, const float* ls_pool) {
    const int G = gridDim.x, bx = blockIdx.x;
    { SchedG S; S.o.init(T / 256, 2, 1, G, bx); S.A = (const char*)o.POOLED; S.B = (const char*)o.WpoolT; S.gA = 0; S.gB = 0; S.tA = (size_t)256 * 512 * 2; S.tB = (size_t)256 * 512 * 2;
      EpiPoolMixB E{o.MIXED, b_pool, ls_pool}; pg::gemm_phase<EpiPoolMixB, SchedG>(lds, 512, 512, 512, S, E); }
    { SchedG S; S.o.init(T / 256, 1, 4, G, (bx + 128) % G); S.A = (const char*)o.UC; S.B = (const char*)o.WqT; S.gA = 256 * 2; S.gB = (size_t)65536 * 2; S.tA = (size_t)256 * 1024 * 2; S.tB = 0;
      EpiQ E{o.Q, o3.A2, o3.winter}; pg::gemm_phase<EpiQ, SchedG>(lds, 1024, 256, 256, S, E); }
    { SchedG S; S.o.init(T / 256, 1, 4, G, (bx + 128) % G); S.A = (const char*)o.UC; S.B = (const char*)o.WkT; S.gA = 256 * 2; S.gB = (size_t)65536 * 2; S.tA = (size_t)256 * 1024 * 2; S.tB = 0;
      pg::EpiStoreBf16 E{o.K, 1024, 1.f, 256}; pg::gemm_phase<pg::EpiStoreBf16, SchedG>(lds, 1024, 256, 256, S, E); }
    { SchedG S; S.o.init(1, T / 256, 4, G, bx); S.A = (const char*)o.WkT; S.B = (const char*)o.UC; S.gA = (size_t)65536 * 2; S.gB = 256 * 2; S.tA = 0; S.tB = (size_t)256 * 1024 * 2;
      EpiKT E{o3.KaT, o3.aw}; pg::gemm_phase<EpiKT, SchedG>(lds, 256, 1024, 256, S, E); }
}
__device__ __forceinline__ void ph_gemms_E(LAS unsigned char* lds, const OptBufs& ob, const OptBufs2& o2, const OptBufs3& o3) {
    const int G = gridDim.x, bx = blockIdx.x;
    ph_un(lds, o2, o3);
    { SchedG1 S; S.o.init(1, 1, 256, G, bx); S.Q = (const char*)o2.Q; S.K = (const char*)o2.K;
      EpiS E{o3.A2, o3.rowv, o3.colv, o3.den}; pg::gemm_phase<EpiS, SchedG1>(lds, 1024, 1024, 256, S, E); }
    { SchedG2 S; S.o.init(1, 1, 240, G, bx); S.BT2 = (const char*)ob.BT2; S.KaT = (const char*)o3.KaT;
      EpiF32U E{o3.U}; pg::gemm_phase<EpiF32U, SchedG2>(lds, 512, T, 256, S, E); }
}
__device__ __forceinline__ void ph_gemm_G3(LAS unsigned char* lds, const OptBufs& ob, const OptBufs3& o3, const float* gain) {
    SchedG3 S; S.o.init(1, 1, 256, gridDim.x, blockIdx.x); S.A2 = (const char*)o3.A2; S.BT2 = (const char*)ob.BT2;
    EpiNum E{o3.HOUT, ob.PROJ, o3.den, o3.emt, gain}; pg::gemm_phase<EpiNum, SchedG3>(lds, 2048, 512, 512, S, E);
}
__device__ __forceinline__ void ph_gemm_ypool(LAS unsigned char* lds, const OptBufs2& o) {
    const int G = gridDim.x, bx = blockIdx.x;
    SchedG S; S.o.init(T / 256, 4, 1, G, bx); S.A = (const char*)o.MIXED; S.B = (const char*)o.WbpT; S.gA = 0; S.gB = 0; S.tA = (size_t)256 * 512 * 2; S.tB = (size_t)256 * 512 * 2;
    pg::EpiStoreBf16 E{o.YPOOL, 1024, 1.f, 0}; pg::gemm_phase<pg::EpiStoreBf16, SchedG>(lds, 512, 512, 512, S, E);
}


struct OptBufs4 { pg::bf16_t *WbmT, *WoutT, *MERGED, *H1B; float *Z; int *elist, *erank; float *gate; };
struct EpiMerge {
    static constexpr bool PERM = true, AFTER_DRAIN = false;
    pg::bf16_t* O; const pg::bf16_t* PROJ; const pg::bf16_t* YPOOL;
    __device__ __forceinline__ void operator()(const pg::f32x4 (&acc)[2][2][4][2], const pg::Unit& u, int wr, int wc, int fr, int fq) const {
        const int col0 = u.pn * 256 + wc * 32 + 8 * fq;
#pragma unroll
        for (int ai = 0; ai < 2; ++ai)
#pragma unroll
            for (int m = 0; m < 4; ++m) { const size_t t = (size_t)u.pm * 256 + ai * 128 + wr * 64 + m * 16 + fr;
#pragma unroll
                for (int bj = 0; bj < 2; ++bj) { const int c = col0 + bj * 128; float g0[8], g1[8], yp[8], r[8];
                    ld8(PROJ + t * PROJW + PJ_G + c, g0); ld8(PROJ + t * PROJW + PJ_G + 1024 + c, g1); ld8(YPOOL + t * 1024 + c, yp);
#pragma unroll
                    for (int j = 0; j < 8; ++j) { const float a_ = (j < 4) ? acc[ai][bj][m][0][j] : acc[ai][bj][m][1][j - 4]; r[j] = sigmoidf_(g0[j]) * yp[j] + sigmoidf_(g1[j]) * a_; }
                    st8(O + t * 1024 + c, r); }
                asm volatile("" ::: "memory"); }
    }
};
struct EpiMixRes {
    static constexpr bool PERM = false, AFTER_DRAIN = false;
    float* Z; const float* x; const float* stats; const float* g; const float* beta;
    __device__ __forceinline__ void operator()(const pg::f32x4 (&acc)[2][2][4][2], const pg::Unit& u, int wr, int wc, int fr, int fq) const {
        const int col0 = u.pn * 256 + wc * 32 + 4 * fq;
#pragma unroll
        for (int ai = 0; ai < 2; ++ai)
#pragma unroll
            for (int m = 0; m < 4; ++m) { const size_t t = (size_t)u.pm * 256 + ai * 128 + wr * 64 + m * 16 + fr; const float mu = stats[t * 2], rstd = stats[t * 2 + 1];
#pragma unroll
                for (int bj = 0; bj < 2; ++bj)
#pragma unroll
                    for (int n = 0; n < 2; ++n) { const int c = col0 + bj * 128 + n * 16;
                        const pg::f32x4 xv = *(const pg::f32x4*)(x + t * 1024 + c), gv = *(const pg::f32x4*)(g + c), bv = *(const pg::f32x4*)(beta + c);
                        *(pg::f32x4*)(Z + t * 1024 + c) = ((xv - mu) * rstd * gv + bv) * ALPHA + acc[ai][bj][m][n]; }
                asm volatile("" ::: "memory"); }
    }
};
__device__ __forceinline__ void ph_gemm_ymls(LAS unsigned char* lds, const OptBufs& ob, const OptBufs2& o2, const OptBufs3& o3, const OptBufs4& o4) {
    SchedG S; S.o.init(T / 256, 4, 1, gridDim.x, blockIdx.x); S.A = (const char*)o3.HOUT; S.B = (const char*)o4.WbmT; S.gA = 0; S.gB = 0; S.tA = (size_t)256 * 1024 * 2; S.tB = (size_t)256 * 1024 * 2;
    EpiMerge E{o4.MERGED, ob.PROJ, o2.YPOOL}; pg::gemm_phase<EpiMerge, SchedG>(lds, 1024, 1024, 1024, S, E);
}
__device__ __forceinline__ void ph_gemm_mix(LAS unsigned char* lds, const OptBufs& ob, const OptBufs4& o4, const float* x, const float* g, const float* beta) {
    SchedG S; S.o.init(T / 256, 4, 1, gridDim.x, blockIdx.x); S.A = (const char*)o4.MERGED; S.B = (const char*)o4.WoutT; S.gA = 0; S.gB = 0; S.tA = (size_t)256 * 1024 * 2; S.tB = (size_t)256 * 1024 * 2;
    EpiMixRes E{o4.Z, x, ob.stats, g, beta}; pg::gemm_phase<EpiMixRes, SchedG>(lds, 1024, 1024, 1024, S, E);
}
typedef float f32x16 __attribute__((ext_vector_type(16)));
__device__ __forceinline__ void ph_ln1_router(LAS unsigned char* lds, const OptBufs4& o, const float* Zin, const float* g, const float* beta, const float* wr_, const float* br, int* cnt, int mode = 7) {
    const int tid = tidf(), lane = tid & 63, wave = tid >> 6;
    LAS float* part = (LAS float*)lds;
    LAS float* L = (LAS float*)(lds + 65536);
    LAS int* hist = (LAS int*)(lds + 131072 + 1024);
    LAS int* asg = (LAS int*)(lds + 131072 + 1024 + 256);
    for (int tile = blockIdx.x; tile < T / 64; tile += gridDim.x) {
        __syncthreads();
        if (tid < 64) hist[tid] = 0;
        const size_t tbase = (size_t)tile * 64 + wave * 8;
        pg::f32x4 va[4];
#pragma unroll
        for (int j = 0; j < 4; ++j) va[j] = ((const pg::f32x4*)(Zin + tbase * D) + lane)[64 * j];
        for (int r = 0; r < ((mode & 1) ? 8 : 0); ++r) {
            pg::f32x4 na[4];
            if (r < 7) {
#pragma unroll
                for (int j = 0; j < 4; ++j) na[j] = ((const pg::f32x4*)(Zin + (tbase + r + 1) * D) + lane)[64 * j]; }
            float sa = 0.f;
#pragma unroll
            for (int j = 0; j < 4; ++j) sa += (va[j].x + va[j].y) + (va[j].z + va[j].w);
            const float ma = wsum(sa) * (1.f / D); float qa = 0.f;
#pragma unroll
            for (int j = 0; j < 4; ++j) { va[j] = va[j] - ma; qa += (va[j].x * va[j].x + va[j].y * va[j].y) + (va[j].z * va[j].z + va[j].w * va[j].w); }
            const float ra = rsqrtf(wsum(qa) * (1.f / D) + LN_EPS);
            const size_t ta = tbase + r;
#pragma unroll
            for (int j = 0; j < 4; ++j) { const int c0 = 256 * j + 4 * lane;
                const pg::f32x4 gg = *(const pg::f32x4*)(g + c0), bb = *(const pg::f32x4*)(beta + c0);
                const pg::f32x4 y = va[j] * ra * gg + bb;
                *(pg::f32x4*)(o.Z + ta * D + c0) = y;
                { int w0 = __builtin_amdgcn_cvt_pk_fp8_f32(y.x, y.y, 0, false); w0 = __builtin_amdgcn_cvt_pk_fp8_f32(y.z, y.w, w0, true); *(int*)((unsigned char*)o.H1B + ta * D + c0) = w0; } }
#pragma unroll
            for (int j = 0; j < 4; ++j) va[j] = na[j];
        }
        asm volatile("s_waitcnt vmcnt(0)" ::: "memory");
        __syncthreads();
        if (mode & 2) { const int hh = lane >> 5, el = lane & 31, kb = wave * 128 + 64 * hh;
          f32x16 acc0, acc1;
#pragma unroll
          for (int i = 0; i < 16; ++i) { acc0[i] = 0.f; acc1[i] = 0.f; }
          const float* a0 = o.Z + ((size_t)tile * 64 + el) * D + kb; const float* a1 = a0 + (size_t)32 * D;
          const float* wp = wr_ + (size_t)kb * 32 + el;
#pragma unroll 1
          for (int half = 0; half < 2; ++half) {
              float bw[32]; pg::f32x4 av0[8], av1[8];
#pragma unroll
              for (int s_ = 0; s_ < 32; ++s_) bw[s_] = wp[(size_t)(half * 32 + s_) * 32];
#pragma unroll
              for (int q = 0; q < 8; ++q) { av0[q] = *(const pg::f32x4*)(a0 + half * 32 + 4 * q); av1[q] = *(const pg::f32x4*)(a1 + half * 32 + 4 * q); }
#pragma unroll
              for (int q = 0; q < 8; ++q) {
                  acc0 = __builtin_amdgcn_mfma_f32_32x32x2f32(av0[q].x, bw[4 * q + 0], acc0, 0, 0, 0); acc1 = __builtin_amdgcn_mfma_f32_32x32x2f32(av1[q].x, bw[4 * q + 0], acc1, 0, 0, 0);
                  acc0 = __builtin_amdgcn_mfma_f32_32x32x2f32(av0[q].y, bw[4 * q + 1], acc0, 0, 0, 0); acc1 = __builtin_amdgcn_mfma_f32_32x32x2f32(av1[q].y, bw[4 * q + 1], acc1, 0, 0, 0);
                  acc0 = __builtin_amdgcn_mfma_f32_32x32x2f32(av0[q].z, bw[4 * q + 2], acc0, 0, 0, 0); acc1 = __builtin_amdgcn_mfma_f32_32x32x2f32(av1[q].z, bw[4 * q + 2], acc1, 0, 0, 0);
                  acc0 = __builtin_amdgcn_mfma_f32_32x32x2f32(av0[q].w, bw[4 * q + 3], acc0, 0, 0, 0); acc1 = __builtin_amdgcn_mfma_f32_32x32x2f32(av1[q].w, bw[4 * q + 3], acc1, 0, 0, 0); }
          }
#pragma unroll
          for (int i = 0; i < 16; ++i) { part[((wave * 2 + 0) * 16 + i) * 64 + lane] = acc0[i]; part[((wave * 2 + 1) * 16 + i) * 64 + lane] = acc1[i]; }
        }
        __syncthreads();
#pragma unroll
        for (int i = 0; i < 4; ++i) { const int idx = tid + 512 * i; float sum = 0.f;
#pragma unroll
            for (int w = 0; w < 8; ++w) sum += part[w * 2048 + idx];
            const int mt = idx >> 10, rg = (idx >> 6) & 15, l2 = idx & 63, tok = mt * 32 + (rg & 3) + 8 * (rg >> 2) + 4 * (l2 >> 5), e = l2 & 31;
            L[tok * 33 + e] = sum + br[e]; }
        __syncthreads();
        if (tid < 64 && (mode & 4)) { const LAS float* lr_ = L + tid * 33; int i0 = -1, i1 = -1, i2 = -1, i3 = -1; float v0 = 0.f, v1 = 0.f, v2 = 0.f, v3 = 0.f;
#pragma unroll
            for (int k = 0; k < 4; ++k) { float bv = -INFINITY; int bi = 0;
                for (int e = 0; e < 32; ++e) { const float x = lr_[e]; if (e != i0 && e != i1 && e != i2 && x > bv) { bv = x; bi = e; } }
                if (k == 0) { i0 = bi; v0 = bv; } else if (k == 1) { i1 = bi; v1 = bv; } else if (k == 2) { i2 = bi; v2 = bv; } else { i3 = bi; v3 = bv; } }
            const float e1 = expf(v1 - v0), e2 = expf(v2 - v0), e3 = expf(v3 - v0), inv = 1.f / (1.f + e1 + e2 + e3);
            const size_t t = (size_t)tile * 64 + tid;
            *(pg::f32x4*)(o.gate + t * 4) = (pg::f32x4){inv, e1 * inv, e2 * inv, e3 * inv};
            const int r0 = atomicAdd((int*)(hist + i0), 1), r1 = atomicAdd((int*)(hist + i1), 1), r2 = atomicAdd((int*)(hist + i2), 1), r3 = atomicAdd((int*)(hist + i3), 1);
            asg[tid * 4 + 0] = i0 | (r0 << 8); asg[tid * 4 + 1] = i1 | (r1 << 8); asg[tid * 4 + 2] = i2 | (r2 << 8); asg[tid * 4 + 3] = i3 | (r3 << 8); }
        __syncthreads();
        if (tid < 32) hist[32 + tid] = atomicAdd(&cnt[tid], hist[tid]);
        __syncthreads();
        if (tid < 256) { const int a_ = asg[tid], e = a_ & 255, rank = hist[32 + e] + (a_ >> 8); const int t = tile * 64 + (tid >> 2);
            o.elist[e * T + rank] = t; o.erank[(size_t)t * 4 + (tid & 3)] = (e << 16) | rank; }
    }
    __syncthreads();
}
__device__ __forceinline__ void ph_adapt_route(const OptBufs4& o, const int* start, int* row_tok, int* row_of) {
    const int gt = blockIdx.x * NT + tidf(), ngt = gridDim.x * NT;
    for (int i = gt; i < NA; i += ngt) { const int er = o.erank[i], e = er >> 16, rank = er & 0xffff; const int dest = start[e] + rank; row_tok[dest] = i >> 2; row_of[i] = dest; }
}


struct OptBufs5 { pg::bf16_t *We1T, *We2T, *ACT, *Y; float* B1P; };
constexpr int MOE_TAB_OFF = 131072 + 4096;
__device__ __forceinline__ void moe_build_tab(LAS unsigned char* lds, const int* cnt) {
    LAS int* tab = (LAS int*)(lds + MOE_TAB_OFF);
    __syncthreads();
    if (tidf() == 0) { int s = 0; for (int e = 0; e < NE; ++e) { tab[e] = s; s += (cnt[e] + 255) >> 8; } tab[NE] = s; }
    __syncthreads();
}
struct SchedMoE {
    const LAS int* tab; const int* cnt; const int* elist; const char* A; const char* B; size_t eB; int nN, nwg, G, c, gather;
    __device__ __forceinline__ bool next(int i, pg::Unit& u) const {
        const long L = (long)i * G + c; if (L >= nwg) return false;
        int wgid = (int)L; { const int q = nwg / pg::NXCD, r = nwg % pg::NXCD, xcd = wgid % pg::NXCD, off = wgid / pg::NXCD; wgid = (xcd < r ? xcd * (q + 1) : r * (q + 1) + (xcd - r) * q) + off; }
        const int mg = wgid / nN, pn = wgid - mg * nN;
        int e = 0;
#pragma unroll
        for (int j = 1; j < NE; ++j) e += (tab[j] <= mg) ? 1 : 0;
        e = __builtin_amdgcn_readfirstlane(e);
        const int mt = mg - __builtin_amdgcn_readfirstlane(tab[e]);
        u.g = e; u.pm = mg; u.pn = pn; u.aux = mg * 256;
        u.B = B + (size_t)e * eB + (size_t)pn * 256 * 1024;
        if (gather) { u.A = A; u.rows = elist + (size_t)e * T + mt * 256; const int rem = __builtin_amdgcn_readfirstlane(cnt[e]) - mt * 256; u.nvalid = rem < 256 ? rem : 256; }
        else { u.A = A + (size_t)mg * 256 * 1024; u.rows = nullptr; u.nvalid = 0; }
        return true;
    }
};
struct EpiSwiglu {
    static constexpr bool PERM = true, AFTER_DRAIN = false;
    unsigned char* ACT; const float* B1P;
    __device__ __forceinline__ void operator()(const pg::f32x4 (&acc)[2][2][4][2], const pg::Unit& u, int wr, int wc, int fr, int fq) const {
        const int col0 = wc * 32 + 8 * fq; const float* bp = B1P + u.g * 2048 + u.pn * 256 + col0;
        const pg::f32x4 bg0 = *(const pg::f32x4*)(bp), bg1 = *(const pg::f32x4*)(bp + 4), bl0 = *(const pg::f32x4*)(bp + 128), bl1 = *(const pg::f32x4*)(bp + 132);
        unsigned char* base = ACT + (size_t)(u.aux + wr * 64 + fr) * 1024 + u.pn * 128 + col0;
#pragma unroll
        for (int ai = 0; ai < 2; ++ai)
#pragma unroll
            for (int m = 0; m < 4; ++m) { float r[8];
#pragma unroll
                for (int j = 0; j < 8; ++j) { float g = (j < 4) ? acc[ai][0][m][0][j] + bg0[j] : acc[ai][0][m][1][j - 4] + bg1[j - 4];
                    float l = (j < 4) ? acc[ai][1][m][0][j] + bl0[j] : acc[ai][1][m][1][j - 4] + bl1[j - 4];
                    g = fminf(g, 7.f); l = fminf(fmaxf(l, -7.f), 7.f);
                    r[j] = g * (l + 1.f) / (1.f + __expf(-1.702f * g)); }
                { int w0 = __builtin_amdgcn_cvt_pk_fp8_f32(r[0], r[1], 0, false); w0 = __builtin_amdgcn_cvt_pk_fp8_f32(r[2], r[3], w0, true);
                  int w1 = __builtin_amdgcn_cvt_pk_fp8_f32(r[4], r[5], 0, false); w1 = __builtin_amdgcn_cvt_pk_fp8_f32(r[6], r[7], w1, true);
                  *(pg::u32x2*)(base + (size_t)(ai * 128 + m * 16) * 1024) = (pg::u32x2){(unsigned)w0, (unsigned)w1}; }
                asm volatile("" ::: "memory"); }
    }
};
struct EpiY {
    static constexpr bool PERM = true, AFTER_DRAIN = false;
    pg::bf16_t* Y; const float* b2;
    __device__ __forceinline__ void operator()(const pg::f32x4 (&acc)[2][2][4][2], const pg::Unit& u, int wr, int wc, int fr, int fq) const {
        const int col0 = u.pn * 256 + wc * 32 + 8 * fq; const float* bp = b2 + u.g * 1024 + col0;
        pg::bf16_t* base = Y + (size_t)(u.aux + wr * 64 + fr) * 1024 + col0;
#pragma unroll
        for (int bj = 0; bj < 2; ++bj) { const pg::f32x4 b0 = *(const pg::f32x4*)(bp + bj * 128), b1 = *(const pg::f32x4*)(bp + bj * 128 + 4);
#pragma unroll
            for (int ai = 0; ai < 2; ++ai)
#pragma unroll
                for (int m = 0; m < 4; ++m) { const pg::f32x4 v0 = acc[ai][bj][m][0] + b0, v1 = acc[ai][bj][m][1] + b1;
                    pg::u32x4 w; w.x = pg::cvt_pk_bf16(v0[0], v0[1]); w.y = pg::cvt_pk_bf16(v0[2], v0[3]); w.z = pg::cvt_pk_bf16(v1[0], v1[1]); w.w = pg::cvt_pk_bf16(v1[2], v1[3]);
                    *(pg::u32x4*)(base + (size_t)(ai * 128 + m * 16) * 1024 + bj * 128) = w; asm volatile("" ::: "memory"); } }
    }
};
__device__ __forceinline__ void ph_moe1(LAS unsigned char* lds, const OptBufs4& o4, const OptBufs5& o5, const int* cnt) {
    moe_build_tab(lds, cnt);
    SchedMoE S; S.tab = (const LAS int*)(lds + MOE_TAB_OFF); S.cnt = cnt; S.elist = o4.elist; S.A = (const char*)o4.H1B; S.B = (const char*)o5.We1T; S.eB = (size_t)2048 * 1024;
    S.nN = 8; S.nwg = __builtin_amdgcn_readfirstlane(S.tab[NE]) * 8; S.G = gridDim.x; S.c = blockIdx.x; S.gather = 1;
    EpiSwiglu E{(unsigned char*)o5.ACT, o5.B1P}; pg::gemm_phase<EpiSwiglu, SchedMoE, true, true>(lds, 512, 512, 512, S, E);
}
__device__ __forceinline__ void ph_moe2(LAS unsigned char* lds, const OptBufs5& o5, const int* cnt, const float* b_e2) {
    moe_build_tab(lds, cnt);
    SchedMoE S; S.tab = (const LAS int*)(lds + MOE_TAB_OFF); S.cnt = cnt; S.elist = nullptr; S.A = (const char*)o5.ACT; S.B = (const char*)o5.We2T; S.eB = (size_t)1024 * 1024;
    S.nN = 4; S.nwg = __builtin_amdgcn_readfirstlane(S.tab[NE]) * 4; S.G = gridDim.x; S.c = blockIdx.x; S.gather = 0;
    EpiY E{o5.Y, b_e2}; pg::gemm_phase<EpiY, SchedMoE, false, true>(lds, 512, 512, 512, S, E);
}
__device__ __forceinline__ void ph_final_opt(LAS unsigned char* lds, const OptBufs4& o4, const OptBufs5& o5, const int* cnt, const float* g, const float* beta, float* out) {
    moe_build_tab(lds, cnt);
    const LAS int* tab = (const LAS int*)(lds + MOE_TAB_OFF);
    const int tid = tidf(), lane = tid & 63, gw = blockIdx.x * NW + (tid >> 6), ngw = gridDim.x * NW;
    for (int t = gw; t < T; t += ngw) {
        size_t ro[4]; float gt[4];
#pragma unroll
        for (int k = 0; k < 4; ++k) { const int er = o4.erank[(size_t)t * 4 + k]; ro[k] = (size_t)(tab[er >> 16] * 256 + (er & 0xffff)) * 1024; gt[k] = o4.gate[(size_t)t * 4 + k]; }
        pg::f32x4 v[4]; float s = 0.f;
#pragma unroll
        for (int j = 0; j < 4; ++j) { const int c0 = 256 * j + 4 * lane;
            pg::f32x4 x = *(const pg::f32x4*)(o4.Z + (size_t)t * D + c0) * ALPHA;
#pragma unroll
            for (int k = 0; k < 4; ++k) { const pg::u32x2 w = *(const pg::u32x2*)(o5.Y + ro[k] + c0);
                x.x += gt[k] * __builtin_bit_cast(float, w.x << 16); x.y += gt[k] * __builtin_bit_cast(float, w.x & 0xffff0000u);
                x.z += gt[k] * __builtin_bit_cast(float, w.y << 16); x.w += gt[k] * __builtin_bit_cast(float, w.y & 0xffff0000u); }
            v[j] = x; s += (x.x + x.y) + (x.z + x.w); }
        const float mean = wsum(s) * (1.f / D); float s2 = 0.f;
#pragma unroll
        for (int j = 0; j < 4; ++j) { v[j] = v[j] - mean; s2 += (v[j].x * v[j].x + v[j].y * v[j].y) + (v[j].z * v[j].z + v[j].w * v[j].w); }
        const float rstd = rsqrtf(wsum(s2) * (1.f / D) + LN_EPS);
#pragma unroll
        for (int j = 0; j < 4; ++j) { const int c0 = 256 * j + 4 * lane;
            *(pg::f32x4*)(out + (size_t)t * D + c0) = v[j] * rstd * *(const pg::f32x4*)(g + c0) + *(const pg::f32x4*)(beta + c0); }
    }
}

__device__ __forceinline__ void ph_adapt1(const OptBufs& o, const float* b_if, float* proj) {
    const size_t gt = (size_t)blockIdx.x * NT + tidf(), ngt = (size_t)gridDim.x * NT;
    for (size_t i = gt; i < (size_t)T * INC; i += ngt) {
        const int c = (int)(i % INC); const int t = (int)(i / INC);
        float v;
        if (c < C_V) v = bf2f(o.PROJ[(size_t)t * PROJW + c]);
        else if (c < C_O) { const int e = c - C_V, h = e >> 8, el = e & 255, b = t >> 12, cc = (t & 4095) >> 8, tl = t & 255;
            v = bf2f(o.BT2[((size_t)((b * 4 + h) * 16 + cc) * 256 + el) * 512 + tl]); }
        else if (c < C_IF) v = bf2f(o.PROJ[(size_t)t * PROJW + c - 1024]);
        else if (c < C_G) v = o.gif[(size_t)t * 8 + (c - C_IF)] - b_if[c - C_IF];
        else v = bf2f(o.PROJ[(size_t)t * PROJW + c - C_G + PJ_G]);
        proj[i] = v;
    }
}

struct PrepSrc { const float *w_in, *w_q, *w_k, *w_pool, *w_bp, *w_bm, *w_out, *w_e1, *w_e2, *b_e1; };
constexpr int TI_E1 = 16384, TI_E2 = 8192, TI_IN = (WIN_ROWS / 64) * 16, TI_MO = 512, TI_QK = 128, TI_BP = 128, TI_PL = 16;
constexpr int TI_TOTAL = TI_E1 + TI_E2 + TI_IN + TI_MO + TI_QK + TI_BP + TI_PL;
__device__ __forceinline__ TItem titem_decode(int it, const PrepSrc& p, const OptBufs& ob, const OptBufs2& o2, const OptBufs4& o4, const OptBufs5& o5) {
    TItem t; t.inter = 0; t.fp8 = 0; t.valid = it < TI_TOTAL; t.src = p.w_in; t.dst = ob.WinT; t.ldw = 64; t.ldt = 64;
    if (!t.valid) return t;
    if (it < TI_E1) { const int nb = it & 31, kb = (it >> 5) & 15, e = it >> 9, j0 = nb * 32, pn = j0 >> 7, jj0 = j0 & 127;
        t.src = p.w_e1 + (size_t)e * 1024 * 2048 + (size_t)(kb * 64) * 2048 + nb * 64; t.dst = (pg::bf16_t*)((unsigned char*)o5.We1T + (size_t)e * 2048 * 1024 + (size_t)(pn * 256 + jj0) * 1024 + kb * 64); t.ldw = 2048; t.ldt = 1024; t.inter = 1; t.fp8 = 1; return t; }
    it -= TI_E1;
    if (it < TI_E2) { const int nb = it & 15, kb = (it >> 4) & 15, e = it >> 8;
        t.src = p.w_e2 + (size_t)e * 1024 * 1024 + (size_t)(kb * 64) * 1024 + nb * 64; t.dst = (pg::bf16_t*)((unsigned char*)o5.We2T + (size_t)e * 1024 * 1024 + (size_t)(nb * 64) * 1024 + kb * 64); t.ldw = 1024; t.ldt = 1024; t.fp8 = 1; return t; }
    it -= TI_E2;
    if (it < TI_IN) { const int rb = it >> 4, kb = it & 15;
        t.src = p.w_in + (size_t)(kb * 64) * INC + win_src_col(rb * 64); t.dst = ob.WinT + (size_t)(rb * 64) * D + kb * 64; t.ldw = INC; t.ldt = D; return t; }
    it -= TI_IN;
    if (it < TI_MO) { const int which = it >> 8, r = it & 255, nb = r >> 4, kb = r & 15;
        t.src = (which ? p.w_out : p.w_bm) + (size_t)(kb * 64) * 1024 + nb * 64; t.dst = (which ? o4.WoutT : o4.WbmT) + (size_t)(nb * 64) * 1024 + kb * 64; t.ldw = 1024; t.ldt = 1024; return t; }
    it -= TI_MO;
    if (it < TI_QK) { const int which = it >> 6, r = it & 63, h = r >> 4, nb = (r & 15) >> 2, kb = r & 3;
        t.src = (which ? p.w_k : p.w_q) + (size_t)h * 65536 + (size_t)(kb * 64) * 256 + nb * 64; t.dst = (which ? o2.WkT : o2.WqT) + (size_t)h * 65536 + (size_t)(nb * 64) * 256 + kb * 64; t.ldw = 256; t.ldt = 256; return t; }
    it -= TI_QK;
    if (it < TI_BP) { const int nb = it >> 3, kb = it & 7;
        t.src = p.w_bp + (size_t)(kb * 64) * 1024 + nb * 64; t.dst = o2.WbpT + (size_t)(nb * 64) * 512 + kb * 64; t.ldw = 1024; t.ldt = 512; return t; }
    it -= TI_BP;
    { const int g = it >> 2, nb = (it & 3) >> 1, kb = it & 1;
        t.src = p.w_pool + (size_t)g * 16384 + (size_t)(kb * 64) * 128 + nb * 64; t.dst = o2.WpoolT + (size_t)(g * 128 + nb * 64) * 512 + g * 128 + kb * 64; t.ldw = 128; t.ldt = 512; return t; }
}
__device__ __forceinline__ void ph_prep_all(LAS unsigned char* lds, const PrepSrc& p, const OptBufs& ob, const OptBufs2& o2, const OptBufs4& o4, const OptBufs5& o5) {
    const int tid = tidf(), lane = tid & 63, wave = tid >> 6, gw = blockIdx.x * NW + wave, ngw = gridDim.x * NW;
    LAS float* scr = (LAS float*)(lds + wave * 16640);
    int it = gw; TItem cur = titem_decode(it, p, ob, o2, o4, o5);
    pg::f32x4 r[16];
    if (cur.valid) titem_load(cur, r, lane);
    while (cur.valid) {
        const int nx = it + ngw; const TItem nxt = titem_decode(nx, p, ob, o2, o4, o5);
        pg::f32x4 rn[16];
        if (nxt.valid) titem_load(nxt, rn, lane);
        titem_store(cur, r, scr, lane);
#pragma unroll
        for (int i = 0; i < 16; ++i) r[i] = rn[i];
        cur = nxt; it = nx;
    }
    { const size_t gt = (size_t)blockIdx.x * NT + tid, ngt = (size_t)gridDim.x * NT;
      for (size_t ch = gt; ch < 512 * 64; ch += ngt) { const int n = (int)(ch >> 6), k8 = (int)(ch & 63) * 8; if ((n >> 7) != (k8 >> 7)) *(pg::u32x4*)(o2.WpoolT + (size_t)n * 512 + k8) = (pg::u32x4){0u, 0u, 0u, 0u}; } }
    for (int i = blockIdx.x * NT + tid; i < 32 * 2048; i += gridDim.x * NT) { const int e = i >> 11, rr = i & 2047, pn = rr >> 8, bj = (rr >> 7) & 1, jj = rr & 127; o5.B1P[i] = p.b_e1[e * 2048 + 2 * (pn * 128 + jj) + bj]; }
}

struct Args { const float* in[26]; float* out; unsigned char* ws; int ph_lo, ph_hi; };
constexpr size_t MiB = 1u << 20;
constexpr size_t WS_CTL = 0;
constexpr size_t CTL_ZERO_BYTES = 1 * MiB;
constexpr int CW_BAR = 4096;
constexpr int CW_CNT = 16384, CW_START = 16384 + 64, CW_FILL = 16384 + 128;

__global__ void __launch_bounds__(NT, 2) mk_fwd(Args a) {
    extern __shared__ __attribute__((aligned(16))) unsigned char lds_raw[];
    LAS unsigned char* lds = (LAS unsigned char*)lds_raw;
    volatile LAS unsigned* MISC = (volatile LAS unsigned*)(lds + MISC_OFF);
    const int tid = tidf();
    if (tid < 32) MISC[tid] = 0u;
    __syncthreads();
    unsigned char* ws = a.ws;
    unsigned* ctl = (unsigned*)(ws + WS_CTL);
    XcdBarrier bar = xcd_barrier_post(ctl + CW_BAR, MISC + 8);
    const float* x = a.in[0]; const float* ln0_g = a.in[1]; const float* ln0_b = a.in[2];
    const float* w_in = a.in[3]; const float* conv_w = a.in[4]; const float* conv_b = a.in[5];
    const float* w_q = a.in[6]; const float* w_k = a.in[7]; const float* b_if = a.in[8];
    const float* mh_gain = a.in[9]; const float* w_pool = a.in[10]; const float* b_pool = a.in[11];
    const float* ls_pool = a.in[12]; const float* w_bp = a.in[13]; const float* w_bm = a.in[14];
    const float* w_out = a.in[15]; const float* ln1_g = a.in[16]; const float* ln1_b = a.in[17];
    const float* w_router = a.in[18]; const float* b_router = a.in[19]; const float* w_e1 = a.in[20];
    const float* b_e1 = a.in[21]; const float* w_e2 = a.in[22]; const float* b_e2 = a.in[23];
    const float* ln2_g = a.in[24]; const float* ln2_b = a.in[25];
    OptBufs ob; ob.WinT = (pg::bf16_t*)(ws + 8 * MiB); ob.H0B = (pg::bf16_t*)(ws + 220 * MiB); ob.PROJ = (pg::bf16_t*)(ws + 252 * MiB); ob.BT2 = (pg::bf16_t*)(ws + 396 * MiB);
    ob.gif = (float*)(ws + 1 * MiB); ob.stats = (float*)(ws + 1 * MiB + 512 * 1024);
    OptBufs2 o2; o2.WqT = (pg::bf16_t*)(ws + 19 * MiB); o2.WkT = (pg::bf16_t*)(ws + 19 * MiB + 512 * 1024); o2.WpoolT = (pg::bf16_t*)(ws + 20 * MiB); o2.WbpT = (pg::bf16_t*)(ws + 20 * MiB + 512 * 1024);
    o2.POOLED = (pg::bf16_t*)(ws + 460 * MiB); o2.UC = (pg::bf16_t*)(ws + 476 * MiB); o2.MIXED = (pg::bf16_t*)(ws + 508 * MiB); o2.Q = (pg::bf16_t*)(ws + 524 * MiB); o2.K = (pg::bf16_t*)(ws + 556 * MiB);
    o2.YPOOL = (pg::bf16_t*)(ws + 748 * MiB);
    OptBufs3 o3; o3.KaT = (pg::bf16_t*)(ws + 588 * MiB); o3.A2 = (pg::bf16_t*)(ws + 620 * MiB); o3.U = (float*)(ws + 684 * MiB); o3.HOUT = (pg::bf16_t*)(ws + 780 * MiB);
    { float* sm = (float*)(ws + 2 * MiB); o3.rowv = sm; o3.colv = sm + 65536; o3.winter = sm + 2 * 65536; o3.aw = sm + 3 * 65536; o3.emt = sm + 4 * 65536; o3.den = sm + 5 * 65536; o3.un = sm + 6 * 65536; o3.decay = sm + 7 * 65536; }
    OptBufs4 o4; o4.WbmT = (pg::bf16_t*)(ws + 21 * MiB + 512 * 1024); o4.WoutT = (pg::bf16_t*)(ws + 23 * MiB + 512 * 1024); o4.MERGED = (pg::bf16_t*)(ws + 812 * MiB); o4.Z = (float*)(ws + 844 * MiB); o4.H1B = (pg::bf16_t*)(ws + 908 * MiB);
    o4.elist = (int*)(ws + 4 * MiB); o4.erank = (int*)(ws + 6 * MiB); o4.gate = (float*)(ws + 6 * MiB + 256 * 1024);
    OptBufs5 o5; o5.We1T = (pg::bf16_t*)(ws + 26 * MiB); o5.We2T = (pg::bf16_t*)(ws + 154 * MiB); o5.B1P = (float*)(ws + 7 * MiB);
    o5.ACT = (pg::bf16_t*)(ws + 252 * MiB);
    o5.Y = (pg::bf16_t*)(ws + 396 * MiB);
    int* cnt = (int*)ctl + CW_CNT;
    LAS float* ldsf = (LAS float*)lds;
    const int G = gridDim.x, bx = blockIdx.x;
#define IN(k) (a.ph_lo <= (k) && (k) < a.ph_hi)
#define SEAM(k) do { if (IN(k) && IN((k) + 1)) xcd_barrier(bar); } while (0)
    if (IN(0)) { PrepSrc ps{w_in, w_q, w_k, w_pool, w_bp, w_bm, w_out, w_e1, w_e2, b_e1}; ph_prep_all(lds, ps, ob, o2, o4, o5); ph_ln0(lds, ob, x, ln0_g, ln0_b, w_in, b_if);
#if PROBE_PH == 0
        { xcd_barrier(bar); if (PROBE_MODE & 1) ph_prep_all(lds, ps, ob, o2, o4, o5); if (PROBE_MODE & 2) ph_ln0(lds, ob, x, ln0_g, ln0_b, w_in, b_if); }
#endif
    }
    SEAM(0);
    if (IN(1)) ph_inproj(lds, ob);
    SEAM(1);
    if (IN(2)) { if (bx >= G - 16 && tid < 64) scalar_scan_wave(bx - (G - 16), ob.gif, o3, tid);
                 for (int i = bx * NT + tid; i < T * 4; i += G * NT) o3.den[i] = 0.f;
                 ph_poolconv_opt(ob.PROJ, conv_w, conv_b, o2.POOLED, o2.UC); }
    SEAM(2);
    if (IN(3)) ph_gemms_D(lds, o2, o3, b_pool, ls_pool);
    SEAM(3);
    if (IN(4)) { ph_gemm_ypool(lds, o2); ph_gemms_E(lds, ob, o2, o3);
#if PROBE_PH == 4
        { xcd_barrier(bar); OptBufs3 d3 = o3; d3.den = (float*)(ws + 980 * MiB); ph_gemm_ypool(lds, o2); ph_gemms_E(lds, ob, o2, d3); }
#endif
    }
    SEAM(4);
    if (IN(5)) { ph_state_scan(ob, o3); ph_den_inter(lds, o3);
#if PROBE_PH == 5
        { xcd_barrier(bar); OptBufs3 d3 = o3; d3.den = (float*)(ws + 980 * MiB); ph_state_scan(ob, d3); ph_den_inter(lds, d3); }
#endif
    }
    SEAM(5);
    if (IN(6)) ph_gemm_G3(lds, ob, o3, mh_gain);
    SEAM(6);
    if (IN(7)) ph_gemm_ymls(lds, ob, o2, o3, o4);
    SEAM(7);
    if (IN(8)) ph_gemm_mix(lds, ob, o4, x, ln0_g, ln0_b);
    SEAM(8);
    if (IN(9)) { ph_ln1_router(lds, o4, o4.Z, ln1_g, ln1_b, w_router, b_router, cnt);
#if PROBE_PH == 9
        { xcd_barrier(bar); OptBufs4 d4 = o4; d4.Z = (float*)(ws + 684 * MiB); d4.H1B = (pg::bf16_t*)(ws + 588 * MiB); d4.elist = (int*)(ws + 980 * MiB); d4.erank = (int*)(ws + 984 * MiB); d4.gate = (float*)(ws + 986 * MiB);
          ph_ln1_router(lds, d4, o4.Z, ln1_g, ln1_b, w_router, b_router, cnt + 256, PROBE_MODE); }
#endif
    }
    SEAM(9);
    if (IN(10)) ph_moe1(lds, o4, o5, cnt);
    SEAM(10);
    if (IN(11)) ph_moe2(lds, o5, cnt, b_e2);
    SEAM(11);
    if (IN(12)) { ph_final_opt(lds, o4, o5, cnt, ln2_g, ln2_b, a.out);
#if PROBE_PH == 12
        { xcd_barrier(bar); ph_final_opt(lds, o4, o5, cnt, ln2_g, ln2_b, a.out); }
#endif
    }
}
constexpr int NPH = 13;
}

extern "C" void kernel_launch(void* const* d_in, const int* in_sizes, int n_in, void* d_out, int out_size, void* d_ws, size_t ws_size, hipStream_t stream) {
    using namespace mk;
    static int grid = 0;
    if (grid == 0) {
        if (n_in != 26 || ws_size < 1000 * MiB) { fprintf(stderr, "kernel_launch: unexpected n_in %d / ws %zu\n", n_in, ws_size); grid = -1; return; }
        int dev = 0, cus = 0, per_cu = 0;
        hipGetDevice(&dev); hipDeviceGetAttribute(&cus, hipDeviceAttributeMultiprocessorCount, dev);
        if (hipFuncSetAttribute((const void*)mk_fwd, hipFuncAttributeMaxDynamicSharedMemorySize, LDS_BYTES) != hipSuccess) { fprintf(stderr, "hipFuncSetAttribute failed\n"); grid = -1; return; }
        if (hipOccupancyMaxActiveBlocksPerMultiprocessor(&per_cu, (const void*)mk_fwd, NT, LDS_BYTES) != hipSuccess || per_cu < 1) { fprintf(stderr, "occupancy query failed (%d)\n", per_cu); grid = -1; return; }
        grid = cus * 1;
        fprintf(stderr, "kernel_launch: cus %d per_cu %d grid %d\n", cus, per_cu, grid);
    }
    if (grid < 0) return;
    hipMemsetAsync((char*)d_ws + WS_CTL, 0, CTL_ZERO_BYTES, stream);
    Args a{};
    for (int i = 0; i < 26; ++i) a.in[i] = (const float*)d_in[i];
    a.out = (float*)d_out; a.ws = (unsigned char*)d_ws; a.ph_lo = 0; a.ph_hi = NPH;
    void* args[] = {&a};
    hipError_t e = hipLaunchCooperativeKernel((const void*)mk_fwd, dim3(grid), dim3(NT), args, LDS_BYTES, stream);
    if (e != hipSuccess) fprintf(stderr, "cooperative launch failed: %s (grid %d)\n", hipGetErrorString(e), grid);
}
```

```cpp
#include <hip/hip_runtime.h>
#include <cstdio>
#include <cstdint>

#define LAS __attribute__((address_space(3)))
#ifndef PROBE_PH
#define PROBE_PH -1
#endif
#define PROBE_MODE 7
namespace mk {
constexpr int D = 1024, BATCH = 4, SEQ = 4096, T = BATCH * SEQ;
constexpr int INC = 5640;
constexpr int C_P = 0, C_U = 512, C_V = 1536, C_O = 2560, C_IF = 3584, C_G = 3592;
constexpr int NE = 32, TOPK = 4, NA = T * TOPK;
constexpr float LN_EPS = 1e-5f;
constexpr float ALPHA = 1.189207115002721f;
constexpr int NT = 512, NW = 8;
constexpr int LDS_BYTES = 147456, MISC_OFF = 147456 - 512;

#define XB_TMO      128
#define XB_XCNT(j)  (256  + 64 * (j))
#define XB_XSUB(j)  (1280 + 64 * (j))
#define XB_XGEN(j)  (2304 + 64 * (j))
#define XB_TOP      3328
#define XB_TOPGEN   3392
#define XCD_BAR_WORDS 3456
#define XB_SPIN_CAP (1u << 22)
__device__ __forceinline__ unsigned xb_ld(unsigned* p)              { return __hip_atomic_load(p, __ATOMIC_RELAXED, __HIP_MEMORY_SCOPE_AGENT); }
__device__ __forceinline__ unsigned xb_add(unsigned* p, unsigned v) { return __hip_atomic_fetch_add(p, v, __ATOMIC_RELAXED, __HIP_MEMORY_SCOPE_AGENT); }
__device__ __forceinline__ unsigned xb_xcc_id() { return (unsigned)__builtin_amdgcn_s_getreg((3 << 11) | 20) & 0xFu; }
#define XB_SPIN(cond, bar) do { unsigned _sp = 0; while (cond) { __builtin_amdgcn_s_sleep(1); \
    if ((++_sp & 255u) == 0u) { if (xb_ld(&(bar)[XB_TMO])) break; if (_sp > XB_SPIN_CAP) { atomicAdd(&(bar)[XB_TMO], 1u); break; } } } } while (0)
struct XcdBarrier { unsigned* bar; unsigned x; volatile LAS unsigned* st; };
__device__ __forceinline__ XcdBarrier xcd_barrier_post(unsigned* bar, volatile LAS unsigned* st) {
    XcdBarrier b; b.bar = bar; b.x = xb_xcc_id(); b.st = st;
    if (threadIdx.x == 0) (void)xb_add(&bar[XB_XCNT(b.x)], 1u);
    return b;
}
__device__ __forceinline__ void xcd_barrier_complete(unsigned* bar, unsigned x, unsigned& nloc, unsigned& nx) {
    const unsigned G = gridDim.x * gridDim.y * gridDim.z;
    unsigned sum, cnt, mine, sp = 0u;
    for (;;) {
        sum = 0u; cnt = 0u; mine = 0u;
#pragma unroll
        for (unsigned j = 0; j < 16; ++j) { const unsigned c = xb_ld(&bar[XB_XCNT(j)]); sum += c; cnt += (c > 0u) ? 1u : 0u; mine = (j == x) ? c : mine; }
        if (sum == G) break;
        __builtin_amdgcn_s_sleep(1);
        if ((++sp & 255u) == 0u) { if (xb_ld(&bar[XB_TMO])) break; if (sp > XB_SPIN_CAP) { atomicAdd(&bar[XB_TMO], 1u); break; } }
    }
    nloc = mine > 0u ? mine : 1u; nx = cnt > 0u ? cnt : 1u;
}
__device__ __forceinline__ void xcd_barrier(const XcdBarrier& b) {
    asm volatile("s_waitcnt vmcnt(0)" ::: "memory");
    __syncthreads();
    if (threadIdx.x == 0) {
        unsigned* bar = b.bar;
        __builtin_amdgcn_s_waitcnt(0);
        unsigned nloc = b.st[0], nx = b.st[1];
        if (nloc == 0u) { xcd_barrier_complete(bar, b.x, nloc, nx); b.st[0] = nloc; b.st[1] = nx; }
        const unsigned old = xb_add(&bar[XB_XSUB(b.x)], 1u);
        const unsigned gen = old / nloc;
        if (old + 1u == (gen + 1u) * nloc) {
            __builtin_amdgcn_fence(__ATOMIC_RELEASE, "agent");
            asm volatile("s_waitcnt vmcnt(0)" ::: "memory");
            const unsigned og = xb_add(&bar[XB_TOP], 1u);
            const unsigned tg = og / nx;
            if (og + 1u == (tg + 1u) * nx) xb_add(&bar[XB_TOPGEN], 1u);
            else XB_SPIN(xb_ld(&bar[XB_TOPGEN]) == tg, bar);
            __builtin_amdgcn_fence(__ATOMIC_ACQUIRE, "agent");
            xb_add(&bar[XB_XGEN(b.x)], 1u);
            asm volatile("s_waitcnt vmcnt(0)" ::: "memory");
        } else {
            XB_SPIN(xb_ld(&bar[XB_XGEN(b.x)]) == gen, bar);
            __builtin_amdgcn_fence(__ATOMIC_ACQUIRE, "agent");
            asm volatile("s_waitcnt vmcnt(0)" ::: "memory");
        }
    }
    __syncthreads();
}

__device__ __forceinline__ int tidf() { int t = threadIdx.x; asm volatile("" : "+v"(t)); return t; }
__device__ __forceinline__ float wsum(float v) {
#pragma unroll
    for (int o = 1; o < 64; o <<= 1) v += __shfl_xor(v, o);
    return v;
}
__device__ __forceinline__ float sigmoidf_(float x) { return 1.f / (1.f + expf(-x)); }
__device__ __forceinline__ float fsigmoid(float x) { return __builtin_amdgcn_rcpf(1.f + __expf(-x)); }

__device__ __forceinline__ void ph_ln(const float* a, const float* b, const float* g, const float* beta, float* y, float scale) {
    const int lane = tidf() & 63, gw = blockIdx.x * NW + (tidf() >> 6), ngw = gridDim.x * NW;
    for (int row = gw; row < T; row += ngw) {
        float v[16]; float s = 0.f;
#pragma unroll
        for (int j = 0; j < 16; ++j) { const int c = lane + 64 * j; float x = a[(size_t)row * D + c] * scale; if (b) x += b[(size_t)row * D + c]; v[j] = x; s += x; }
        const float mu = wsum(s) * (1.f / D); float q = 0.f;
#pragma unroll
        for (int j = 0; j < 16; ++j) { const float d = v[j] - mu; q += d * d; }
        const float rstd = rsqrtf(wsum(q) * (1.f / D) + LN_EPS);
#pragma unroll
        for (int j = 0; j < 16; ++j) { const int c = lane + 64 * j; y[(size_t)row * D + c] = (v[j] - mu) * rstd * g[c] + beta[c]; }
    }
}
struct EpiPlain { static constexpr bool PAIR = false; float* C; int ldc; float scale;
    __device__ void operator()(int m, int n, float v, int z) const { C[(size_t)m * ldc + n] = v * scale; } };
struct EpiPoolMix { static constexpr bool PAIR = false; float* C; const float* b; const float* ls;
    __device__ void operator()(int m, int n, float v, int z) const { const int c = z * 128 + n; C[(size_t)m * 512 + c] = (v + b[c]) * ls[c]; } };
struct EpiHead { static constexpr bool PAIR = false; float* C; float scale;
    __device__ void operator()(int m, int n, float v, int z) const { C[(size_t)m * 1024 + z * 256 + n] = v * scale; } };
struct EpiE1 { static constexpr bool PAIR = true; float* act; const float* b1;
    __device__ void pair(int m, int n, float vg, float vl, int z) const {
        float g = vg + b1[z * 2048 + n], l = vl + b1[z * 2048 + n + 1];
        g = fminf(g, 7.f); l = fminf(fmaxf(l, -7.f), 7.f);
        act[(size_t)m * 1024 + (n >> 1)] = g * sigmoidf_(1.702f * g) * (l + 1.f); } };
struct EpiE2 { static constexpr bool PAIR = false; float* Y; const float* b2;
    __device__ void operator()(int m, int n, float v, int z) const { Y[(size_t)m * 1024 + n] = v + b2[z * 1024 + n]; } };

template <class Epi>
__device__ __forceinline__ void ph_gemm(LAS float* lds, const float* A, const int* rowidx, const float* B, const int* mcount, const int* mstart,
                                        size_t strideA, size_t strideB, const Epi& epi, int lda, int ldb, int M, int N, int K, int nz, int vb0, int nvb) {
    LAS float* As = lds;
    LAS float* Bs = lds + 16 * 129;
    const int tid = tidf(), tx = tid & 15, ty = tid >> 4;
    const int ntn = (N + 63) / 64, ntm = (M + 127) / 128, per_z = ntn * ntm, total = per_z * nz;
    for (int vt = vb0; vt < total; vt += nvb) {
        const int z = vt / per_z, r = vt % per_z, bm = (r / ntn) * 128, bn = (r % ntn) * 64;
        int Mz = M, m0g = 0;
        if (mcount) { Mz = mcount[z]; m0g = mstart[z]; }
        if (bm >= Mz) continue;
        const float* Az = A + z * strideA; const float* Bz = B + z * strideB;
        float acc[4][4] = {};
        const int ar = tid >> 2, ak = (tid & 3) * 4;
        const int arow = bm + ar; const bool aval = arow < Mz; int asrc = 0;
        if (aval) { const int gr = m0g + arow; asrc = rowidx ? rowidx[gr] : gr; }
        const int bk = tid >> 5, bn2 = (tid & 31) * 2;
        for (int k0 = 0; k0 < K; k0 += 16) {
            float4 av = make_float4(0.f, 0.f, 0.f, 0.f);
            if (aval) av = *(const float4*)(Az + (size_t)asrc * lda + k0 + ak);
            As[(ak + 0) * 129 + ar] = av.x; As[(ak + 1) * 129 + ar] = av.y; As[(ak + 2) * 129 + ar] = av.z; As[(ak + 3) * 129 + ar] = av.w;
#pragma unroll
            for (int j = 0; j < 2; ++j) { const int n = bn + bn2 + j; Bs[bk * 65 + bn2 + j] = (n < N) ? Bz[(size_t)(k0 + bk) * ldb + n] : 0.f; }
            __syncthreads();
#pragma unroll
            for (int kk = 0; kk < 16; ++kk) {
                float a[4], b[4];
#pragma unroll
                for (int i = 0; i < 4; ++i) { a[i] = As[kk * 129 + ty * 4 + i]; b[i] = Bs[kk * 65 + tx * 4 + i]; }
#pragma unroll
                for (int i = 0; i < 4; ++i)
#pragma unroll
                    for (int j = 0; j < 4; ++j) acc[i][j] += a[i] * b[j];
            }
            __syncthreads();
        }
#pragma unroll
        for (int i = 0; i < 4; ++i) { const int m = bm + ty * 4 + i; if (m >= Mz) continue;
            if constexpr (Epi::PAIR) {
#pragma unroll
                for (int j = 0; j < 4; j += 2) { const int n = bn + tx * 4 + j; if (n < N) epi.pair(m0g + m, n, acc[i][j], acc[i][j + 1], z); }
            } else {
#pragma unroll
                for (int j = 0; j < 4; ++j) { const int n = bn + tx * 4 + j; if (n < N) epi(m0g + m, n, acc[i][j], z); }
            } }
    }
}
__device__ __forceinline__ void ph_pool_conv(const float* proj, const float* cw, const float* cb, float* pooled, float* uc) {
    const size_t gt = (size_t)blockIdx.x * NT + tidf(), ngt = (size_t)gridDim.x * NT;
    for (size_t i = gt; i < (size_t)T * 512; i += ngt) {
        const int c = (int)(i % 512); const int tg = (int)(i / 512); const int t = tg % SEQ;
        const int w = 2 << (c >> 7);
        const int cnt = (t + 1 < w) ? t + 1 : w; float s = 0.f;
        for (int j = 0; j < cnt; ++j) s += proj[(size_t)(tg - j) * INC + C_P + c];
        pooled[i] = s / (float)cnt - proj[(size_t)tg * INC + C_P + c];
    }
    for (size_t i = gt; i < (size_t)T * 1024; i += ngt) {
        const int c = (int)(i % 1024); const int tg = (int)(i / 1024); const int t = tg % SEQ;
        float y = cb[c];
#pragma unroll
        for (int j = 0; j < 4; ++j) { const int tt = t - 3 + j; if (tt >= 0) y += proj[(size_t)(tg - 3 + j) * INC + C_U + c] * cw[j * 1024 + c]; }
        uc[i] = y * sigmoidf_(y);
    }
}
constexpr int MB = 16;
__device__ __forceinline__ void ph_mlstm(LAS float* lds, int vb, const float* q, const float* k, const float* vv, const float* gif, float* hm) {
    const int bh = vb >> 1, b = bh >> 2, h = bh & 3;
    const int tid = tidf(), e = (vb & 1) * 128 + (tid >> 2), dq = tid & 3;
    LAS float* sq = lds; LAS float* sk = lds + MB * 256; LAS float* sv = lds + 2 * MB * 256; LAS float* si = lds + 3 * MB * 256; LAS float* sf = si + MB;
    float C[64]; float n[16];
#pragma unroll
    for (int j = 0; j < 64; ++j) C[j] = 0.f;
#pragma unroll
    for (int j = 0; j < 16; ++j) n[j] = 0.f;
    float m = 0.f;
    const int nsub = (e & 3) * 16;
    for (int t0 = 0; t0 < SEQ; t0 += MB) {
        __syncthreads();
        for (int i = tid; i < MB * 256; i += NT) { const int tt = i >> 8, d = i & 255; const size_t tg = (size_t)b * SEQ + t0 + tt;
            sq[tt * 256 + d] = q[tg * 1024 + h * 256 + d]; sk[tt * 256 + d] = k[tg * 1024 + h * 256 + d]; sv[tt * 256 + d] = vv[tg * 1024 + h * 256 + d]; }
        if (tid < MB) { const size_t tg = (size_t)b * SEQ + t0 + tid; si[tid] = gif[tg * 8 + h]; sf[tid] = gif[tg * 8 + 4 + h]; }
        __syncthreads();
        for (int tt = 0; tt < MB; ++tt) {
            const float ip = si[tt], fp = sf[tt];
            const float lf = fminf(fp, 0.f) - log1pf(expf(-fabsf(fp)));
            const float mn = fmaxf(lf + m, ip);
            const float fd = expf(lf + m - mn), iw = expf(ip - mn);
            m = mn;
            const float ve = sv[tt * 256 + e] * iw;
            float num = 0.f, den = 0.f;
#pragma unroll
            for (int j = 0; j < 64; ++j) { const float kk = sk[tt * 256 + dq * 64 + j]; C[j] = fd * C[j] + ve * kk; num += C[j] * sq[tt * 256 + dq * 64 + j]; }
#pragma unroll
            for (int j = 0; j < 16; ++j) { const int d = dq * 64 + nsub + j; n[j] = fd * n[j] + iw * sk[tt * 256 + d]; den += n[j] * sq[tt * 256 + d]; }
            num += __shfl_xor(num, 1); num += __shfl_xor(num, 2);
            den += __shfl_xor(den, 1); den += __shfl_xor(den, 2); den += __shfl_xor(den, 4); den += __shfl_xor(den, 8);
            if (dq == 0) { const float dn = fmaxf(fabsf(den), expf(-mn)); hm[((size_t)b * SEQ + t0 + tt) * 1024 + h * 256 + e] = num / dn; }
        }
    }
    __syncthreads();
}
__device__ __forceinline__ void ph_hnorm(float* hm, const float* opre, const float* gain) {
    const int lane = tidf() & 63, gw = blockIdx.x * NW + (tidf() >> 6), ngw = gridDim.x * NW;
    for (int w = gw; w < T * 4; w += ngw) {
        const int tg = w >> 2, h = w & 3;
        float v[4]; float s = 0.f;
#pragma unroll
        for (int j = 0; j < 4; ++j) { v[j] = hm[(size_t)tg * 1024 + h * 256 + lane + 64 * j]; s += v[j]; }
        const float mu = wsum(s) * (1.f / 256); float qq = 0.f;
#pragma unroll
        for (int j = 0; j < 4; ++j) { const float d = v[j] - mu; qq += d * d; }
        const float rstd = rsqrtf(wsum(qq) * (1.f / 256) + LN_EPS);
#pragma unroll
        for (int j = 0; j < 4; ++j) { const int c = h * 256 + lane + 64 * j; hm[(size_t)tg * 1024 + c] = (v[j] - mu) * rstd * gain[c] * sigmoidf_(opre[(size_t)tg * 1024 + c]); }
    }
}
__device__ __forceinline__ void ph_merge(const float* gates, const float* ypool, float* ymls) {
    const size_t gt = (size_t)blockIdx.x * NT + tidf(), ngt = (size_t)gridDim.x * NT;
    for (size_t i = gt; i < (size_t)T * 1024; i += ngt) {
        const int c = (int)(i % 1024); const size_t tg = i / 1024;
        const float g0 = sigmoidf_(gates[tg * 2048 + c]), g1 = sigmoidf_(gates[tg * 2048 + 1024 + c]);
        ymls[i] = g0 * ypool[i] + g1 * ymls[i];
    }
}
__device__ __forceinline__ void ph_router(const float* h1, const float* wr, const float* br, int* top_idx, float* top_gate, int* cnt) {
    const int lane = tidf() & 63, gw = blockIdx.x * NW + (tidf() >> 6), ngw = gridDim.x * NW;
    for (int tg = gw; tg < T; tg += ngw) {
        const int e = lane & 31, half = lane >> 5;
        float s = 0.f;
        for (int kk = 0; kk < 512; ++kk) { const int kx = half * 512 + kk; s += h1[(size_t)tg * D + kx] * wr[kx * NE + e]; }
        s += __shfl_xor(s, 32); s += br[e];
        float val = s; int idxs[4]; float vals[4];
#pragma unroll
        for (int r = 0; r < 4; ++r) {
            float bv = val; int bi = e;
#pragma unroll
            for (int o = 1; o < 32; o <<= 1) { const float ov = __shfl_xor(bv, o); const int oi = __shfl_xor(bi, o); if (ov > bv || (ov == bv && oi < bi)) { bv = ov; bi = oi; } }
            idxs[r] = bi; vals[r] = bv; if (e == bi) val = -INFINITY;
        }
        const float mx = vals[0]; float ex[4], se = 0.f;
#pragma unroll
        for (int r = 0; r < 4; ++r) { ex[r] = expf(vals[r] - mx); se += ex[r]; }
#pragma unroll
        for (int r = 0; r < 4; ++r) if (lane == r) { top_idx[tg * 4 + r] = idxs[r]; top_gate[tg * 4 + r] = ex[r] / se; atomicAdd(&cnt[idxs[r]], 1); }
    }
}
__device__ __forceinline__ void ph_place(const int* top_idx, const int* start, int* fill, int* row_tok, int* row_of) {
    const int gt = blockIdx.x * NT + tidf(), ngt = gridDim.x * NT;
    for (int i = gt; i < NA; i += ngt) { const int e = top_idx[i]; const int r = atomicAdd(&fill[e], 1); const int dest = start[e] + r; row_tok[dest] = i >> 2; row_of[i] = dest; }
}
__device__ __forceinline__ void ph_final(const float* h1, const float* Y, const int* row_of, const float* gate, const float* g, const float* beta, float* out) {
    const int lane = tidf() & 63, gw = blockIdx.x * NW + (tidf() >> 6), ngw = gridDim.x * NW;
    for (int tg = gw; tg < T; tg += ngw) {
        int ro[4]; float gt[4];
#pragma unroll
        for (int r = 0; r < 4; ++r) { ro[r] = row_of[tg * 4 + r]; gt[r] = gate[tg * 4 + r]; }
        float v[16]; float s = 0.f;
#pragma unroll
        for (int j = 0; j < 16; ++j) { const int c = lane + 64 * j; float x = ALPHA * h1[(size_t)tg * D + c];
#pragma unroll
            for (int r = 0; r < 4; ++r) x += gt[r] * Y[(size_t)ro[r] * 1024 + c];
            v[j] = x; s += x; }
        const float mu = wsum(s) * (1.f / D); float qq = 0.f;
#pragma unroll
        for (int j = 0; j < 16; ++j) { const float d = v[j] - mu; qq += d * d; }
        const float rstd = rsqrtf(wsum(qq) * (1.f / D) + LN_EPS);
#pragma unroll
        for (int j = 0; j < 16; ++j) { const int c = lane + 64 * j; out[(size_t)tg * D + c] = (v[j] - mu) * rstd * g[c] + beta[c]; }
    }
}


namespace pg {
typedef unsigned short bf16_t;
typedef short bf16x8 __attribute__((ext_vector_type(8)));
typedef float f32x4 __attribute__((ext_vector_type(4)));
typedef float f32x2 __attribute__((ext_vector_type(2)));
typedef unsigned u32x4 __attribute__((ext_vector_type(4)));
typedef unsigned u32x2 __attribute__((ext_vector_type(2)));
constexpr int BM = 256, BK = 64, HALF = 128, HTB = HALF * BK * 2, STAGE_BYTES = 8 * HTB, NXCD = 8, WGM = 8;
__host__ __device__ __forceinline__ int lds_byte(int r, int c) { const int st = (r >> 4) * 2 + (c >> 5), rr = r & 15, cc = c & 31, ob = rr * 64 + cc * 2; return st * 1024 + (ob ^ (((ob >> 9) & 1) << 5)); }
__host__ __device__ __forceinline__ void stage_rc(int b, int& R, int& C) { const int st = b / 1024, sb = b % 1024, swz = sb ^ (((sb >> 9) & 1) << 5); R = (st >> 1) * 16 + swz / 64; C = (st & 1) * 32 + (swz % 64) / 2; }
__host__ __device__ __forceinline__ int perm32(int rho) { const int n = rho >> 4, i = rho & 15; return 8 * (i >> 2) + 4 * n + (i & 3); }
__device__ __forceinline__ unsigned cvt_pk_bf16(float lo, float hi) { unsigned r; asm volatile("v_cvt_pk_bf16_f32 %0, %1, %2" : "=v"(r) : "v"(lo), "v"(hi)); return r; }

struct Unit { const char* A; const char* B; const int* rows; int nvalid; int pm, pn, g, aux; };

struct TileOrder {
    int nM, nN, per_g, nwg, G, c;
    __device__ __forceinline__ void init(int nM_, int nN_, int ng, int G_, int c_) { nM = nM_; nN = nN_; per_g = nM * nN; nwg = per_g * ng; G = G_; c = c_; }
    __device__ __forceinline__ bool tile(int i, int& g, int& pm, int& pn) const {
        const long L = (long)i * G + c; if (L >= nwg) return false;
        int wgid = (int)L; { const int q = nwg / NXCD, r = nwg % NXCD, xcd = wgid % NXCD, off = wgid / NXCD; wgid = (xcd < r ? xcd * (q + 1) : r * (q + 1) + (xcd - r) * q) + off; }
        g = wgid / per_g; wgid -= g * per_g;
        const int nig = WGM * nN, gid = wgid / nig, fm = gid * WGM, gsz = (nM - fm) < WGM ? (nM - fm) : WGM;
        pm = fm + ((wgid % nig) % gsz); pn = (wgid % nig) / gsz; return true;
    }
};

typedef int i32x8 __attribute__((ext_vector_type(8)));
typedef int i32x4 __attribute__((ext_vector_type(4)));
template <class Epi, class Sched, bool GATHER = false, bool FP8 = false>
__device__ __forceinline__ void gemm_phase(LAS unsigned char* lds, const int lda, const int ldb, const int K, const Sched& S, const Epi& E) {
    const int tid = tidf(), wid = __builtin_amdgcn_readfirstlane(tid >> 6), lane = tid & 63, wr = wid >> 2, wc = wid & 3, fr = lane & 15, fq = lane >> 4;
    const int nt = K / BK;
    unsigned voffA[2], voffB[2];
#pragma unroll
    for (int i = 0; i < 2; ++i) { int R, C; stage_rc(tid * 16 + i * 8192, R, C); const int Rb = Epi::PERM ? ((R & ~31) + perm32(R & 31)) : R;
        voffA[i] = (unsigned)(R * lda + C) * 2u; voffB[i] = (unsigned)(Rb * ldb + C) * 2u; }
    const size_t kstep = (size_t)(BK * 2);
    const size_t hstepA = GATHER ? 0 : (size_t)HALF * lda * 2, hstepB = (size_t)HALF * ldb * 2;
    const unsigned ldsw = (unsigned)wid * 1024u;
    const int aoff = lds_byte(wr * 64 + fr, fq * 8), boff = lds_byte(wc * 32 + fr, fq * 8);
#define PG_SA(b, h) (((b) * 2 + (h)) * HTB)
#define PG_SB(b, h) ((4 + (b) * 2 + (h)) * HTB)
#define PG_STAGE(bufoff, gbase, voff) do { _Pragma("unroll") for (int _i = 0; _i < 2; ++_i) \
        __builtin_amdgcn_global_load_lds((const unsigned*)((const char*)(gbase) + (voff)[_i]), (LAS unsigned*)(lds + (bufoff) + ldsw + _i * 8192), 16, 0, 0); } while (0)
#define PG_LDA(dst, b, h) do { _Pragma("unroll") for (int m = 0; m < 4; ++m) { if constexpr (FP8) { \
        const i32x4 _lo = *(const LAS i32x4*)(lds + PG_SA(b, h) + aoff + m * 2048), _hi = *(const LAS i32x4*)(lds + PG_SA(b, h) + aoff + m * 2048 + 1024); \
        dst##8[m] = __builtin_shufflevector(_lo, _hi, 0, 1, 2, 3, 4, 5, 6, 7); } \
        else { _Pragma("unroll") for (int k = 0; k < 2; ++k) dst[m][k] = *(const LAS bf16x8*)(lds + PG_SA(b, h) + aoff + m * 2048 + k * 1024); } } } while (0)
#define PG_LDB(dst, b, h) do { _Pragma("unroll") for (int n = 0; n < 2; ++n) { if constexpr (FP8) { \
        const i32x4 _lo = *(const LAS i32x4*)(lds + PG_SB(b, h) + boff + n * 2048), _hi = *(const LAS i32x4*)(lds + PG_SB(b, h) + boff + n * 2048 + 1024); \
        dst##8[n] = __builtin_shufflevector(_lo, _hi, 0, 1, 2, 3, 4, 5, 6, 7); } \
        else { _Pragma("unroll") for (int k = 0; k < 2; ++k) dst[n][k] = *(const LAS bf16x8*)(lds + PG_SB(b, h) + boff + n * 2048 + k * 1024); } } } while (0)
#define PG_MMA(ai, bj, At, Bt) do { __builtin_amdgcn_s_setprio(1); _Pragma("unroll") for (int m = 0; m < 4; ++m) _Pragma("unroll") for (int n = 0; n < 2; ++n) { \
        if constexpr (FP8) asm volatile("v_mfma_scale_f32_16x16x128_f8f6f4 %0, %1, %2, %0, %3, %4 op_sel_hi:[0,0,0]" : "+v"(acc[ai][bj][m][n]) : "v"(Bt##8[n]), "v"(At##8[m]), "v"(sc_w), "v"(sc_a)); \
        else { _Pragma("unroll") for (int k = 0; k < 2; ++k) acc[ai][bj][m][n] = __builtin_amdgcn_mfma_f32_16x16x32_bf16(Bt[n][k], At[m][k], acc[ai][bj][m][n], 0, 0, 0); } } \
        __builtin_amdgcn_s_setprio(0); } while (0)
#define PG_WAIT_V(n) asm volatile("s_waitcnt vmcnt(" #n ")" ::: "memory")
#define PG_WAIT_L(n) asm volatile("s_waitcnt lgkmcnt(" #n ")" ::: "memory")
#define PG_BAR __builtin_amdgcn_s_barrier()
#define PG_SCHED __builtin_amdgcn_sched_barrier(0)
    Unit cur, nxt; int ui = 0;
    if (!S.next(0, cur)) return;
    f32x4 acc[2][2][4][2];
    f32x4 bini[2][2];
#pragma unroll
    for (int b = 0; b < 2; ++b)
#pragma unroll
        for (int n = 0; n < 2; ++n) bini[b][n] = (f32x4){0.f, 0.f, 0.f, 0.f};
    if constexpr (Epi::BIAS) { const float* bp = E.bias_base(cur) + wc * 32 + (Epi::PERM ? 8 * fq : 4 * fq);
#pragma unroll
        for (int b = 0; b < 2; ++b)
#pragma unroll
            for (int n = 0; n < 2; ++n) bini[b][n] = *(const f32x4*)(bp + b * HALF + (Epi::PERM ? 4 * n : 16 * n)); }
#pragma unroll
    for (int a = 0; a < 2; ++a)
#pragma unroll
        for (int b = 0; b < 2; ++b)
#pragma unroll
            for (int m = 0; m < 4; ++m)
#pragma unroll
                for (int n = 0; n < 2; ++n) acc[a][b][m][n] = bini[b][n];
    bf16x8 At[4][2], B0[2][2], B1[2][2]; i32x8 At8[4], B08[2], B18[2]; const int sc_w = 0x79797979, sc_a = 0x7f7f7f7f;
    unsigned gA0[2], gA1[2], nA0[2], nA1[2];
    auto gather_offs = [&](const Unit& u, unsigned (&o0)[2], unsigned (&o1)[2]) {
#pragma unroll
        for (int i = 0; i < 2; ++i) { int R_, C_; stage_rc(tid * 16 + i * 8192, R_, C_);
            const int r0 = R_, r1 = HALF + R_;
            const int t0 = (r0 < u.nvalid) ? u.rows[r0] : 0, t1 = (r1 < u.nvalid) ? u.rows[r1] : 0;
            o0[i] = (unsigned)(t0 * lda + C_) * 2u; o1[i] = (unsigned)(t1 * lda + C_) * 2u; }
    };
    if constexpr (GATHER) { gather_offs(cur, gA0, gA1); } else {
#pragma unroll
        for (int i = 0; i < 2; ++i) { gA0[i] = voffA[i]; gA1[i] = voffA[i]; nA0[i] = voffA[i]; nA1[i] = voffA[i]; } }
    const char* cA = cur.A; const char* cB = cur.B;
    PG_STAGE(PG_SB(0, 0), cB, voffB); PG_STAGE(PG_SB(0, 1), cB + hstepB, voffB); PG_STAGE(PG_SA(0, 0), cA, gA0); PG_STAGE(PG_SA(0, 1), cA + hstepA, gA1);
    if (wr == 1) PG_BAR;
    PG_WAIT_V(2); PG_BAR;
    PG_STAGE(PG_SB(1, 0), cB + kstep, voffB); PG_STAGE(PG_SA(1, 0), cA + kstep, gA0); PG_STAGE(PG_SB(1, 1), cB + hstepB + kstep, voffB);
    PG_WAIT_V(6); PG_BAR;
    for (;;) {
        const bool has_next = S.next(ui + 1, nxt);
        const char* nA = has_next ? nxt.A : cA; const char* nB = has_next ? nxt.B : cB;
        if constexpr (GATHER) { if (has_next) gather_offs(nxt, nA0, nA1); else {
#pragma unroll
            for (int i = 0; i < 2; ++i) { nA0[i] = gA0[i]; nA1[i] = gA1[i]; } } }
#pragma unroll 1
        for (int t = 0; t < nt; t += 2) {
            const bool last = (t == nt - 2);
            const char* a1 = cA + (size_t)(t + 1) * kstep;
            const char* a2 = last ? nA : cA + (size_t)(t + 2) * kstep; const char* b2 = last ? nB : cB + (size_t)(t + 2) * kstep;
            const char* a3 = a2 + kstep; const char* b3 = b2 + kstep;
            unsigned x0[2], x1[2];
#pragma unroll
            for (int i = 0; i < 2; ++i) { x0[i] = (GATHER && last) ? nA0[i] : gA0[i]; x1[i] = (GATHER && last) ? nA1[i] : gA1[i]; }
            PG_LDB(B0, 0, 0); PG_LDB(B1, 0, 1); PG_SCHED; PG_LDA(At, 0, 0); PG_STAGE(PG_SA(1, 1), a1 + hstepA, gA1);
            PG_WAIT_V(8); PG_WAIT_L(0); PG_BAR; PG_MMA(0, 0, At, B0); PG_MMA(0, 1, At, B1); PG_BAR; PG_SCHED;
            PG_LDA(At, 0, 1); PG_STAGE(PG_SB(0, 0), b2, voffB); PG_STAGE(PG_SB(0, 1), b2 + hstepB, voffB); PG_STAGE(PG_SA(0, 0), a2, x0);
            PG_WAIT_V(8); PG_WAIT_L(0); PG_BAR; PG_MMA(1, 0, At, B0); PG_MMA(1, 1, At, B1); PG_BAR; PG_SCHED;
            PG_LDB(B0, 1, 0); PG_LDB(B1, 1, 1); PG_SCHED; PG_LDA(At, 1, 0); PG_STAGE(PG_SA(0, 1), a2 + hstepA, x1);
            PG_WAIT_V(8); PG_WAIT_L(0); PG_BAR; PG_MMA(0, 0, At, B0); PG_MMA(0, 1, At, B1); PG_BAR; PG_SCHED;
            PG_LDA(At, 1, 1); PG_STAGE(PG_SB(1, 0), b3, voffB); PG_STAGE(PG_SB(1, 1), b3 + hstepB, voffB); PG_STAGE(PG_SA(1, 0), a3, x0);
            PG_WAIT_V(8); PG_WAIT_L(0); PG_BAR; PG_MMA(1, 0, At, B0); PG_MMA(1, 1, At, B1); PG_BAR; PG_SCHED;
        }
        if (wr == 0) PG_BAR;
        if constexpr (FP8) asm volatile("s_nop 15\n\ts_nop 15" ::: "memory");
        if constexpr (Epi::BIAS && !GATHER) { if (has_next) { const float* bp = E.bias_base(nxt) + wc * 32 + (Epi::PERM ? 8 * fq : 4 * fq);
#pragma unroll
            for (int b = 0; b < 2; ++b)
#pragma unroll
                for (int n = 0; n < 2; ++n) bini[b][n] = *(const f32x4*)(bp + b * HALF + (Epi::PERM ? 4 * n : 16 * n)); } }
        if constexpr (!Epi::AFTER_DRAIN) { E(acc, cur, wr, wc, fr, fq); }
        if (!has_next) break;
        if constexpr (Epi::BIAS && GATHER) { const float* bp = E.bias_base(nxt) + wc * 32 + (Epi::PERM ? 8 * fq : 4 * fq);
#pragma unroll
            for (int b = 0; b < 2; ++b)
#pragma unroll
                for (int n = 0; n < 2; ++n) bini[b][n] = *(const f32x4*)(bp + b * HALF + (Epi::PERM ? 4 * n : 16 * n)); }
#pragma unroll
        for (int a = 0; a < 2; ++a)
#pragma unroll
            for (int b = 0; b < 2; ++b)
#pragma unroll
                for (int m = 0; m < 4; ++m)
#pragma unroll
                    for (int n = 0; n < 2; ++n) acc[a][b][m][n] = bini[b][n];
        cur = nxt; cA = nA; cB = nB; ++ui;
        if constexpr (GATHER) {
#pragma unroll
            for (int i = 0; i < 2; ++i) { gA0[i] = nA0[i]; gA1[i] = nA1[i]; } }
        if (wr == 1) PG_BAR;
    }
    PG_WAIT_V(0);
    PG_BAR;
    if constexpr (Epi::AFTER_DRAIN) { E.fused(acc, cur, wr, wc, fr, fq, lds, wid, lane); }
#undef PG_SA
#undef PG_SB
#undef PG_STAGE
#undef PG_LDA
#undef PG_LDB
#undef PG_MMA
#undef PG_WAIT_V
#undef PG_WAIT_L
#undef PG_BAR
#undef PG_SCHED
}

struct EpiStoreBf16 {
    static constexpr bool PERM = true, AFTER_DRAIN = false, BIAS = false;
    bf16_t* O; int ldc; float scale; int gcol;
    __device__ __forceinline__ void operator()(const f32x4 (&acc)[2][2][4][2], const Unit& u, int wr, int wc, int fr, int fq) const {
        bf16_t* base = O + (size_t)(u.pm * BM + wr * 64 + fr) * ldc + u.g * gcol + u.pn * BM + wc * 32 + 8 * fq;
#pragma unroll
        for (int ai = 0; ai < 2; ++ai)
#pragma unroll
            for (int m = 0; m < 4; ++m) { bf16_t* rowp = base + (size_t)(ai * HALF + m * 16) * ldc;
#pragma unroll
                for (int bj = 0; bj < 2; ++bj) { const f32x4 v0 = acc[ai][bj][m][0] * scale, v1 = acc[ai][bj][m][1] * scale;
                    u32x4 w; w.x = cvt_pk_bf16(v0[0], v0[1]); w.y = cvt_pk_bf16(v0[2], v0[3]); w.z = cvt_pk_bf16(v1[0], v1[1]); w.w = cvt_pk_bf16(v1[2], v1[3]);
                    *(u32x4*)(rowp + bj * HALF) = w; } }
    }
};
}

constexpr int PROJW = 4608;
constexpr int PJ_P = 0, PJ_U = 512, PJ_O = 1536, PJ_G = 2560;
constexpr int WIN_ROWS = 5632;

__device__ __forceinline__ unsigned f2bf(float f) { unsigned u = __builtin_bit_cast(unsigned, f); return (u + 0x7fffu + ((u >> 16) & 1u)) >> 16; }
__device__ __forceinline__ unsigned pk2(float lo, float hi) { return f2bf(lo) | (f2bf(hi) << 16); }
__device__ __forceinline__ float bf2f(unsigned short b) { return __builtin_bit_cast(float, (unsigned)b << 16); }

struct TItem { const float* src; pg::bf16_t* dst; int ldw, ldt, inter, valid, fp8; };
__device__ __forceinline__ void titem_load(const TItem& it, pg::f32x4 (&r)[16], int lane) {
    const float* src = it.src + (size_t)(lane >> 4) * it.ldw + 4 * (lane & 15);
#pragma unroll
    for (int i = 0; i < 16; ++i) r[i] = *(const pg::f32x4*)(src + (size_t)(4 * i) * it.ldw);
}
__device__ __forceinline__ void titem_store(const TItem& it, const pg::f32x4 (&r)[16], LAS float* scr, int lane) {
#pragma unroll
    for (int i = 0; i < 16; ++i) { const int k = (lane >> 4) + 4 * i; LAS float* d = scr + (4 * (lane & 15)) * 65 + k;
        d[0] = r[i].x; d[65] = r[i].y; d[130] = r[i].z; d[195] = r[i].w; }
    asm volatile("s_waitcnt lgkmcnt(0)" ::: "memory");
#pragma unroll
    for (int itr = 0; itr < 8; ++itr) { const int nl = (lane >> 3) + 8 * itr, kg = lane & 7; const LAS float* p = scr + nl * 65 + 8 * kg;
        const size_t drow = it.inter ? (size_t)(nl & 1) * 128 + (nl >> 1) : (size_t)nl;
        if (it.fp8) { int w0 = __builtin_amdgcn_cvt_pk_fp8_f32(p[0] * 64.f, p[1] * 64.f, 0, false); w0 = __builtin_amdgcn_cvt_pk_fp8_f32(p[2] * 64.f, p[3] * 64.f, w0, true);
            int w1 = __builtin_amdgcn_cvt_pk_fp8_f32(p[4] * 64.f, p[5] * 64.f, 0, false); w1 = __builtin_amdgcn_cvt_pk_fp8_f32(p[6] * 64.f, p[7] * 64.f, w1, true);
            *(pg::u32x2*)((unsigned char*)it.dst + drow * it.ldt + 8 * kg) = (pg::u32x2){(unsigned)w0, (unsigned)w1}; }
        else { pg::u32x4 o; o.x = pk2(p[0], p[1]); o.y = pk2(p[2], p[3]); o.z = pk2(p[4], p[5]); o.w = pk2(p[6], p[7]);
            *(pg::u32x4*)(it.dst + drow * it.ldt + 8 * kg) = o; } }
    asm volatile("s_waitcnt lgkmcnt(0)" ::: "memory");
}
__device__ __forceinline__ int win_src_col(int r) { return r < 1536 ? r : (r < 2560 ? r + 1024 : (r < 4608 ? r - 2560 + C_G : r - 4608 + C_V)); }

struct OptBufs {
    pg::bf16_t *WinT, *H0B, *PROJ, *BT2;
    float *gif, *stats;
};
__device__ __forceinline__ void ph_ln0(LAS unsigned char* lds, const OptBufs& o, const float* x, const float* g, const float* beta, const float* w_in, const float* b_if) {
    const int tid = tidf(), lane = tid & 63, wave = tid >> 6, gw = blockIdx.x * NW + wave, ngw = gridDim.x * NW;
    LAS float* wif = (LAS float*)lds;
    __syncthreads();
    for (int i = tid; i < 1024 * 8; i += NT) wif[(i & 7) * 1024 + (i >> 3)] = w_in[(size_t)(i >> 3) * INC + C_IF + (i & 7)];
    __syncthreads();
    for (int row = gw; row < T; row += ngw) {
        const pg::f32x4* xr = (const pg::f32x4*)(x + (size_t)row * D) + lane;
        pg::f32x4 v[4]; float s = 0.f;
#pragma unroll
        for (int j = 0; j < 4; ++j) { v[j] = xr[64 * j]; s += (v[j].x + v[j].y) + (v[j].z + v[j].w); }
        const float mean = wsum(s) * (1.f / D); float s2 = 0.f;
#pragma unroll
        for (int j = 0; j < 4; ++j) { v[j] = v[j] - mean; s2 += (v[j].x * v[j].x + v[j].y * v[j].y) + (v[j].z * v[j].z + v[j].w * v[j].w); }
        const float rstd = rsqrtf(wsum(s2) * (1.f / D) + LN_EPS);
        float acc8[8];
#pragma unroll
        for (int q = 0; q < 8; ++q) acc8[q] = 0.f;
        unsigned long long* o8 = (unsigned long long*)(o.H0B + (size_t)row * D) + lane;
#pragma unroll
        for (int j = 0; j < 4; ++j) {
            const int c0 = 256 * j + 4 * lane;
            const pg::f32x4 gg = *(const pg::f32x4*)(g + c0), bb = *(const pg::f32x4*)(beta + c0);
            const pg::f32x4 y = v[j] * rstd * gg + bb;
            o8[64 * j] = (unsigned long long)pk2(y.x, y.y) | ((unsigned long long)pk2(y.z, y.w) << 32);
#pragma unroll
            for (int q = 0; q < 8; ++q) { const pg::f32x4 w4 = *(const LAS pg::f32x4*)(wif + q * 1024 + c0); acc8[q] += (y.x * w4.x + y.y * w4.y) + (y.z * w4.z + y.w * w4.w); }
        }
#pragma unroll
        for (int q = 0; q < 8; ++q) acc8[q] = wsum(acc8[q]);
        if (lane < 8) { float r = acc8[0];
#pragma unroll
            for (int q = 1; q < 8; ++q) r = (lane == q) ? acc8[q] : r;
            o.gif[(size_t)row * 8 + lane] = r + b_if[lane]; }
        if (lane == 0) { o.stats[(size_t)row * 2] = mean; o.stats[(size_t)row * 2 + 1] = rstd; }
    }
    __syncthreads();
}
struct SchedInproj {
    pg::TileOrder o; const char* A; const char* B;
    __device__ __forceinline__ bool next(int i, pg::Unit& u) const { int g, pm, pn; if (!o.tile(i, g, pm, pn)) return false;
        u.A = A + (size_t)pm * 256 * D * 2; u.B = B + (size_t)pn * 256 * D * 2; u.pm = pm; u.pn = pn; u.g = 0; u.aux = 0; u.rows = nullptr; u.nvalid = 0; return true; }
};
struct SchedVT {
    pg::TileOrder o; const char* A; const char* B;
    __device__ __forceinline__ bool next(int i, pg::Unit& u) const { int g, pm, pn; if (!o.tile(i, g, pm, pn)) return false;
        u.A = A + (size_t)pm * 256 * D * 2; u.B = B + (size_t)pn * 256 * D * 2; u.pm = pm; u.pn = pn; u.g = 0; u.aux = 0; u.rows = nullptr; u.nvalid = 0; return true; }
};
struct EpiVT {
    static constexpr bool PERM = true, AFTER_DRAIN = false, BIAS = false;
    pg::bf16_t* BT2;
    __device__ __forceinline__ void operator()(const pg::f32x4 (&acc)[2][2][4][2], const pg::Unit& u, int wr, int wc, int fr, int fq) const {
        const int h = u.pm, b = u.pn >> 4, c = u.pn & 15;
        pg::bf16_t* base = BT2 + ((size_t)((b * 4 + h) * 16 + c) * 256 + wr * 64 + fr) * 512 + wc * 32 + 8 * fq;
#pragma unroll
        for (int ai = 0; ai < 2; ++ai)
#pragma unroll
            for (int m = 0; m < 4; ++m) { pg::bf16_t* rowp = base + (size_t)(ai * 128 + m * 16) * 512;
#pragma unroll
                for (int bj = 0; bj < 2; ++bj) { const pg::f32x4 v0 = acc[ai][bj][m][0], v1 = acc[ai][bj][m][1];
                    pg::u32x4 w; w.x = pg::cvt_pk_bf16(v0[0], v0[1]); w.y = pg::cvt_pk_bf16(v0[2], v0[3]); w.z = pg::cvt_pk_bf16(v1[0], v1[1]); w.w = pg::cvt_pk_bf16(v1[2], v1[3]);
                    *(pg::u32x4*)(rowp + bj * 128) = w; } }
    }
};
__device__ __forceinline__ void ph_inproj(LAS unsigned char* lds, const OptBufs& o) {
    const int G = gridDim.x, bx = blockIdx.x;
    { SchedInproj S; S.o.init(T / 256, PROJW / 256, 1, G, bx); S.A = (const char*)o.H0B; S.B = (const char*)o.WinT;
      pg::EpiStoreBf16 E{o.PROJ, PROJW, 1.f, 0}; pg::gemm_phase<pg::EpiStoreBf16, SchedInproj>(lds, D, D, D, S, E); }
    { SchedVT S; S.o.init(4, T / 256, 1, G, (bx + 128) % G); S.A = (const char*)(o.WinT + (size_t)PROJW * D); S.B = (const char*)o.H0B;
      EpiVT E{o.BT2}; pg::gemm_phase<EpiVT, SchedVT>(lds, D, D, D, S, E); }
}

struct OptBufs2 { pg::bf16_t *WqT, *WkT, *WpoolT, *WbpT, *POOLED, *UC, *MIXED, *Q, *K, *YPOOL; };
__device__ __forceinline__ void ld8(const pg::bf16_t* p, float (&v)[8]) { const pg::u32x4 w = *(const pg::u32x4*)p;
    v[0] = __builtin_bit_cast(float, w.x << 16); v[1] = __builtin_bit_cast(float, w.x & 0xffff0000u); v[2] = __builtin_bit_cast(float, w.y << 16); v[3] = __builtin_bit_cast(float, w.y & 0xffff0000u);
    v[4] = __builtin_bit_cast(float, w.z << 16); v[5] = __builtin_bit_cast(float, w.z & 0xffff0000u); v[6] = __builtin_bit_cast(float, w.w << 16); v[7] = __builtin_bit_cast(float, w.w & 0xffff0000u); }
__device__ __forceinline__ void st8(pg::bf16_t* p, const float (&v)[8]) { pg::u32x4 w; w.x = pk2(v[0], v[1]); w.y = pk2(v[2], v[3]); w.z = pk2(v[4], v[5]); w.w = pk2(v[6], v[7]); *(pg::u32x4*)p = w; }
__device__ __forceinline__ void ph_poolconv_opt(const pg::bf16_t* PROJ, const float* cw, const float* cb, pg::bf16_t* POOLED, pg::bf16_t* UC) {
    const int gt = blockIdx.x * NT + tidf(), ngt = gridDim.x * NT;
    for (int it = gt; it < 512 * 192; it += ngt) {
        const int run = it / 192, oc = it % 192; const int t0 = run * 32, tpos0 = t0 & (SEQ - 1);
        if (oc < 64) {
            const int c0 = oc * 8, w = 2 << (c0 >> 7);
            const pg::bf16_t* src = PROJ + PJ_P + c0;
            float s[8];
#pragma unroll
            for (int q = 0; q < 8; ++q) s[q] = 0.f;
            { pg::u32x4 hv[15];
#pragma unroll
              for (int j = 1; j < 16; ++j) hv[j - 1] = (j < w && tpos0 - j >= 0) ? *(const pg::u32x4*)(src + (size_t)(t0 - j) * PROJW) : (pg::u32x4){0u, 0u, 0u, 0u};
#pragma unroll
              for (int j = 0; j < 15; ++j) { s[0] += __builtin_bit_cast(float, hv[j].x << 16); s[1] += __builtin_bit_cast(float, hv[j].x & 0xffff0000u); s[2] += __builtin_bit_cast(float, hv[j].y << 16); s[3] += __builtin_bit_cast(float, hv[j].y & 0xffff0000u);
                  s[4] += __builtin_bit_cast(float, hv[j].z << 16); s[5] += __builtin_bit_cast(float, hv[j].z & 0xffff0000u); s[6] += __builtin_bit_cast(float, hv[j].w << 16); s[7] += __builtin_bit_cast(float, hv[j].w & 0xffff0000u); } }
            for (int i0 = 0; i0 < 32; i0 += 8) {
                pg::u32x4 cv[8], ov[8];
#pragma unroll
                for (int i = 0; i < 8; ++i) { const int t = t0 + i0 + i, tp = tpos0 + i0 + i; cv[i] = *(const pg::u32x4*)(src + (size_t)t * PROJW);
                    ov[i] = (tp - w + 1 >= 0) ? *(const pg::u32x4*)(src + (size_t)(t - w + 1) * PROJW) : (pg::u32x4){0u, 0u, 0u, 0u}; }
#pragma unroll
                for (int i = 0; i < 8; ++i) { const int t = t0 + i0 + i, tp = tpos0 + i0 + i; float cur[8], old[8], o[8];
                    cur[0] = __builtin_bit_cast(float, cv[i].x << 16); cur[1] = __builtin_bit_cast(float, cv[i].x & 0xffff0000u); cur[2] = __builtin_bit_cast(float, cv[i].y << 16); cur[3] = __builtin_bit_cast(float, cv[i].y & 0xffff0000u);
                    cur[4] = __builtin_bit_cast(float, cv[i].z << 16); cur[5] = __builtin_bit_cast(float, cv[i].z & 0xffff0000u); cur[6] = __builtin_bit_cast(float, cv[i].w << 16); cur[7] = __builtin_bit_cast(float, cv[i].w & 0xffff0000u);
                    old[0] = __builtin_bit_cast(float, ov[i].x << 16); old[1] = __builtin_bit_cast(float, ov[i].x & 0xffff0000u); old[2] = __builtin_bit_cast(float, ov[i].y << 16); old[3] = __builtin_bit_cast(float, ov[i].y & 0xffff0000u);
                    old[4] = __builtin_bit_cast(float, ov[i].z << 16); old[5] = __builtin_bit_cast(float, ov[i].z & 0xffff0000u); old[6] = __builtin_bit_cast(float, ov[i].w << 16); old[7] = __builtin_bit_cast(float, ov[i].w & 0xffff0000u);
                    const float inv = 1.f / (float)((tp + 1 < w) ? tp + 1 : w);
#pragma unroll
                    for (int q = 0; q < 8; ++q) { s[q] += cur[q]; o[q] = s[q] * inv - cur[q]; s[q] -= old[q]; }
                    st8(POOLED + (size_t)t * 512 + c0, o); }
            }
        } else {
            const int c0 = (oc - 64) * 8;
            const pg::bf16_t* src = PROJ + PJ_U + c0;
            float w0[8], w1[8], w2[8], w3[8], bb[8], u0[8], u1[8], u2[8];
#pragma unroll
            for (int q = 0; q < 8; ++q) { w0[q] = cw[c0 + q]; w1[q] = cw[1024 + c0 + q]; w2[q] = cw[2048 + c0 + q]; w3[q] = cw[3072 + c0 + q]; bb[q] = cb[c0 + q]; u0[q] = 0.f; u1[q] = 0.f; u2[q] = 0.f; }
            if (tpos0 >= 3) ld8(src + (size_t)(t0 - 3) * PROJW, u0);
            if (tpos0 >= 2) ld8(src + (size_t)(t0 - 2) * PROJW, u1);
            if (tpos0 >= 1) ld8(src + (size_t)(t0 - 1) * PROJW, u2);
            for (int i0 = 0; i0 < 32; i0 += 8) {
                pg::u32x4 cv[8];
#pragma unroll
                for (int i = 0; i < 8; ++i) cv[i] = *(const pg::u32x4*)(src + (size_t)(t0 + i0 + i) * PROJW);
#pragma unroll
                for (int i = 0; i < 8; ++i) { float u3[8], o[8];
                    u3[0] = __builtin_bit_cast(float, cv[i].x << 16); u3[1] = __builtin_bit_cast(float, cv[i].x & 0xffff0000u); u3[2] = __builtin_bit_cast(float, cv[i].y << 16); u3[3] = __builtin_bit_cast(float, cv[i].y & 0xffff0000u);
                    u3[4] = __builtin_bit_cast(float, cv[i].z << 16); u3[5] = __builtin_bit_cast(float, cv[i].z & 0xffff0000u); u3[6] = __builtin_bit_cast(float, cv[i].w << 16); u3[7] = __builtin_bit_cast(float, cv[i].w & 0xffff0000u);
#pragma unroll
                    for (int q = 0; q < 8; ++q) { const float y = bb[q] + w0[q] * u0[q] + w1[q] * u1[q] + w2[q] * u2[q] + w3[q] * u3[q]; o[q] = y * __builtin_amdgcn_rcpf(1.f + __expf(-y)); u0[q] = u1[q]; u1[q] = u2[q]; u2[q] = u3[q]; }
                    st8(UC + (size_t)(t0 + i0 + i) * 1024 + c0, o); }
            }
        }
    }
}
struct SchedG {
    pg::TileOrder o; const char* A; const char* B; size_t gA, gB, tA, tB;
    __device__ __forceinline__ bool next(int i, pg::Unit& u) const { int g, pm, pn; if (!o.tile(i, g, pm, pn)) return false;
        u.A = A + g * gA + pm * tA; u.B = B + g * gB + pn * tB; u.pm = pm; u.pn = pn; u.g = g; u.aux = 0; u.rows = nullptr; u.nvalid = 0; return true; }
};
struct EpiPoolMixB {
    static constexpr bool PERM = true, AFTER_DRAIN = false, BIAS = false;
    pg::bf16_t* O; const float* b; const float* ls;
    __device__ __forceinline__ void operator()(const pg::f32x4 (&acc)[2][2][4][2], const pg::Unit& u, int wr, int wc, int fr, int fq) const {
        const int col0 = u.pn * 256 + wc * 32 + 8 * fq;
        pg::bf16_t* base = O + (size_t)(u.pm * 256 + wr * 64 + fr) * 512 + col0;
        pg::f32x4 bv[2][2], lv[2][2];
#pragma unroll
        for (int bj = 0; bj < 2; ++bj)
#pragma unroll
            for (int n = 0; n < 2; ++n) { bv[bj][n] = *(const pg::f32x4*)(b + col0 + bj * 128 + 4 * n); lv[bj][n] = *(const pg::f32x4*)(ls + col0 + bj * 128 + 4 * n); }
#pragma unroll
        for (int ai = 0; ai < 2; ++ai)
#pragma unroll
            for (int m = 0; m < 4; ++m) { pg::bf16_t* rowp = base + (size_t)(ai * 128 + m * 16) * 512;
#pragma unroll
                for (int bj = 0; bj < 2; ++bj) { const pg::f32x4 v0 = (acc[ai][bj][m][0] + bv[bj][0]) * lv[bj][0], v1 = (acc[ai][bj][m][1] + bv[bj][1]) * lv[bj][1];
                    pg::u32x4 w; w.x = pg::cvt_pk_bf16(v0[0], v0[1]); w.y = pg::cvt_pk_bf16(v0[2], v0[3]); w.z = pg::cvt_pk_bf16(v1[0], v1[1]); w.w = pg::cvt_pk_bf16(v1[2], v1[3]);
                    *(pg::u32x4*)(rowp + bj * 128) = w; } }
    }
};
__device__ __forceinline__ void cvt_bf16_f32(const pg::bf16_t* src, size_t lds_, int cols, float* dst, size_t rows) {
    const size_t gt = (size_t)blockIdx.x * NT + tidf(), ngt = (size_t)gridDim.x * NT;
    for (size_t i = gt; i < rows * cols; i += ngt) { const size_t r = i / cols; const int c = (int)(i % cols); dst[i] = bf2f(src[r * lds_ + c]); }
}
__device__ __forceinline__ void ph_adapt_v(const OptBufs& o, float* vv) {
    const size_t gt = (size_t)blockIdx.x * NT + tidf(), ngt = (size_t)gridDim.x * NT;
    for (size_t i = gt; i < (size_t)T * 1024; i += ngt) { const int t = (int)(i >> 10), e = (int)(i & 1023), h = e >> 8, el = e & 255, b = t >> 12, cc = (t & 4095) >> 8, tl = t & 255;
        vv[i] = bf2f(o.BT2[((size_t)((b * 4 + h) * 16 + cc) * 256 + el) * 512 + tl]); }
}


struct OptBufs3 { pg::bf16_t *KaT, *A2, *HOUT; float *U, *rowv, *colv, *winter, *aw, *emt, *den, *un, *decay; };
__device__ __forceinline__ float log_sigmoidf_(float x) { return fminf(x, 0.f) - log1pf(expf(-fabsf(x))); }
__device__ __forceinline__ void scalar_scan_wg(LAS unsigned char* lds, int bh, const float* gif, const OptBufs3& o) {
    const int tid = tidf(), lane = tid & 63, wave = tid >> 6, b = bh >> 2, h = bh & 3;
    LAS float* sum = (LAS float*)lds;
    float bt[2][4], ip[2][4], pm[2][4];
#pragma unroll
    for (int cc = 0; cc < 2; ++cc) { const int c = wave * 2 + cc;
        float bs[4];
#pragma unroll
        for (int sub = 0; sub < 4; ++sub) { const size_t t = (size_t)b * SEQ + c * 256 + sub * 64 + lane; ip[cc][sub] = gif[t * 8 + h]; bs[sub] = log_sigmoidf_(gif[t * 8 + 4 + h]); }
#pragma unroll
        for (int off = 1; off < 64; off <<= 1) {
#pragma unroll
            for (int sub = 0; sub < 4; ++sub) { const float v = __shfl_up(bs[sub], off); if (lane >= off) bs[sub] += v; } }
        float carry = 0.f;
#pragma unroll
        for (int sub = 0; sub < 4; ++sub) { bt[cc][sub] = carry + bs[sub]; carry += __shfl(bs[sub], 63); pm[cc][sub] = ip[cc][sub] - bt[cc][sub]; }
#pragma unroll
        for (int off = 1; off < 64; off <<= 1) {
#pragma unroll
            for (int sub = 0; sub < 4; ++sub) { const float v = __shfl_up(pm[cc][sub], off); if (lane >= off) pm[cc][sub] = fmaxf(pm[cc][sub], v); } }
        float pmc = -INFINITY;
#pragma unroll
        for (int sub = 0; sub < 4; ++sub) { pm[cc][sub] = fmaxf(pm[cc][sub], pmc); pmc = __shfl(pm[cc][sub], 63); }
        if (lane == 0) { sum[c * 2] = carry; sum[c * 2 + 1] = pmc; }
    }
    __syncthreads();
    float mc = 0.f;
    for (int c = 0; c < wave * 2; ++c) mc = sum[c * 2] + fmaxf(mc, sum[c * 2 + 1]);
#pragma unroll
    for (int cc = 0; cc < 2; ++cc) { const int c = wave * 2 + cc; const float Gc = sum[c * 2], mnext = Gc + fmaxf(mc, sum[c * 2 + 1]);
#pragma unroll
        for (int sub = 0; sub < 4; ++sub) { const float mt = bt[cc][sub] + fmaxf(mc, pm[cc][sub]);
            const size_t idx = ((size_t)b * SEQ + c * 256 + sub * 64 + lane) * 4 + h;
            o.rowv[idx] = bt[cc][sub] - mt; o.colv[idx] = ip[cc][sub] - bt[cc][sub];
            o.winter[idx] = expf(bt[cc][sub] + mc - mt); o.aw[idx] = expf(Gc - bt[cc][sub] + ip[cc][sub] - mnext); o.emt[idx] = expf(-mt); }
        if (lane == 0) o.decay[bh * 16 + c] = expf(Gc + mc - mnext);
        mc = mnext; }
    __syncthreads();
}
struct EpiQ {
    static constexpr bool PERM = true, AFTER_DRAIN = false, BIAS = false;
    pg::bf16_t* Q; pg::bf16_t* A2; const float* winter;
    __device__ __forceinline__ void operator()(const pg::f32x4 (&acc)[2][2][4][2], const pg::Unit& u, int wr, int wc, int fr, int fq) const {
        const int h = u.g, col0 = wc * 32 + 8 * fq;
#pragma unroll
        for (int ai = 0; ai < 2; ++ai)
#pragma unroll
            for (int m = 0; m < 4; ++m) { const size_t t = (size_t)u.pm * 256 + ai * 128 + wr * 64 + m * 16 + fr; const float wi = winter[t * 4 + h];
#pragma unroll
                for (int bj = 0; bj < 2; ++bj) { const pg::f32x4 v0 = acc[ai][bj][m][0] * 0.0625f, v1 = acc[ai][bj][m][1] * 0.0625f;
                    pg::u32x4 w; w.x = pg::cvt_pk_bf16(v0[0], v0[1]); w.y = pg::cvt_pk_bf16(v0[2], v0[3]); w.z = pg::cvt_pk_bf16(v1[0], v1[1]); w.w = pg::cvt_pk_bf16(v1[2], v1[3]);
                    *(pg::u32x4*)(Q + t * 1024 + h * 256 + col0 + bj * 128) = w;
                    const pg::f32x4 x0 = v0 * wi, x1 = v1 * wi;
                    pg::u32x4 y; y.x = pg::cvt_pk_bf16(x0[0], x0[1]); y.y = pg::cvt_pk_bf16(x0[2], x0[3]); y.z = pg::cvt_pk_bf16(x1[0], x1[1]); y.w = pg::cvt_pk_bf16(x1[2], x1[3]);
                    *(pg::u32x4*)(A2 + t * 2048 + h * 512 + 256 + col0 + bj * 128) = y; }
                asm volatile("" ::: "memory"); }
    }
};
struct EpiKT {
    static constexpr bool PERM = true, AFTER_DRAIN = false, BIAS = false;
    pg::bf16_t* KaT; const float* aw;
    __device__ __forceinline__ void operator()(const pg::f32x4 (&acc)[2][2][4][2], const pg::Unit& u, int wr, int wc, int fr, int fq) const {
        const int h = u.g; const size_t t0 = (size_t)u.pn * 256 + wc * 32 + 8 * fq;
#pragma unroll
        for (int bj = 0; bj < 2; ++bj) {
            float a[8];
#pragma unroll
            for (int j = 0; j < 8; ++j) a[j] = aw[(t0 + bj * 128 + j) * 4 + h];
            pg::bf16_t* rowp = KaT + ((size_t)h * 256 + wr * 64 + fr) * T + t0 + bj * 128;
#pragma unroll
            for (int ai = 0; ai < 2; ++ai)
#pragma unroll
                for (int m = 0; m < 4; ++m) { const pg::f32x4 v0 = acc[ai][bj][m][0], v1 = acc[ai][bj][m][1];
                    pg::u32x4 w; w.x = pg::cvt_pk_bf16(v0[0] * a[0], v0[1] * a[1]); w.y = pg::cvt_pk_bf16(v0[2] * a[2], v0[3] * a[3]);
                    w.z = pg::cvt_pk_bf16(v1[0] * a[4], v1[1] * a[5]); w.w = pg::cvt_pk_bf16(v1[2] * a[6], v1[3] * a[7]);
                    *(pg::u32x4*)(rowp + (size_t)(ai * 128 + m * 16) * T) = w; asm volatile("" ::: "memory"); }
        }
    }
};
struct EpiS {
    static constexpr bool PERM = true, AFTER_DRAIN = false, BIAS = false;
    pg::bf16_t* A2; const float* rowv; const float* colv; float* den;
    __device__ __forceinline__ void operator()(const pg::f32x4 (&acc)[2][2][4][2], const pg::Unit& u, int wr, int wc, int fr, int fq) const {
        const int bh = u.g >> 4, c = u.g & 15, b = bh >> 2, h = bh & 3; const size_t tok0 = (size_t)b * SEQ + c * 256;
        const int col0 = wc * 32 + 8 * fq;
        const float* cvp = colv + (tok0 + col0) * 4 + h;
#pragma unroll
        for (int ai = 0; ai < 2; ++ai)
#pragma unroll
            for (int m = 0; m < 4; ++m) { const int tl = ai * 128 + wr * 64 + m * 16 + fr; const float rv = rowv[(tok0 + tl) * 4 + h]; float rs = 0.f;
                pg::bf16_t* op = A2 + (tok0 + tl) * 2048 + h * 512 + col0;
#pragma unroll
                for (int bj = 0; bj < 2; ++bj) { float x[8];
#pragma unroll
                    for (int j = 0; j < 8; ++j) { const int sl = col0 + bj * 128 + j; const float a_ = (j < 4) ? acc[ai][bj][m][0][j] : acc[ai][bj][m][1][j - 4];
                        const float w_ = __expf(rv + cvp[(bj * 128 + j) * 4]); x[j] = (sl <= tl) ? a_ * w_ : 0.f; rs += x[j]; }
                    pg::u32x4 w; w.x = pg::cvt_pk_bf16(x[0], x[1]); w.y = pg::cvt_pk_bf16(x[2], x[3]); w.z = pg::cvt_pk_bf16(x[4], x[5]); w.w = pg::cvt_pk_bf16(x[6], x[7]);
                    *(pg::u32x4*)(op + bj * 128) = w; asm volatile("" ::: "memory"); }
                rs += __shfl_xor(rs, 16); rs += __shfl_xor(rs, 32);
                if (fq == 0) atomicAdd(den + (tok0 + tl) * 4 + h, rs);
                asm volatile("" ::: "memory"); }
    }
};
struct EpiF32U {
    static constexpr bool PERM = false, AFTER_DRAIN = false, BIAS = false;
    float* C;
    __device__ __forceinline__ void operator()(const pg::f32x4 (&acc)[2][2][4][2], const pg::Unit& u, int wr, int wc, int fr, int fq) const {
        float* base = C + (size_t)u.aux * 65536 + (size_t)(wr * 64 + fr) * 256 + wc * 32 + 4 * fq;
#pragma unroll
        for (int ai = 0; ai < 2; ++ai)
#pragma unroll
            for (int m = 0; m < 4; ++m)
#pragma unroll
                for (int bj = 0; bj < 2; ++bj)
#pragma unroll
                    for (int n = 0; n < 2; ++n) { *(pg::f32x4*)(base + (size_t)(ai * 128 + m * 16) * 256 + bj * 128 + n * 16) = acc[ai][bj][m][n]; if (n) asm volatile("" ::: "memory"); }
    }
};
struct EpiNum {
    static constexpr bool PERM = true, AFTER_DRAIN = true, BIAS = false;
    pg::bf16_t* HOUT; const pg::bf16_t* PROJ; const float* den; const float* emt; const float* gain;
    __device__ __forceinline__ void fused(pg::f32x4 (&acc)[2][2][4][2], const pg::Unit& u, int wr, int wc, int fr, int fq, LAS unsigned char* lds, int wid, int lane) const {
        const int bh = u.g >> 4, c = u.g & 15, b = bh >> 2, h = bh & 3; const size_t tok0 = (size_t)b * SEQ + c * 256;
        LAS pg::f32x2* P = (LAS pg::f32x2*)lds; LAS pg::f32x2* Sx = (LAS pg::f32x2*)(lds + 8192);
#pragma unroll
        for (int ai = 0; ai < 2; ++ai)
#pragma unroll
            for (int m = 0; m < 4; ++m) { const int tl = ai * 128 + wr * 64 + m * 16 + fr; const size_t ti = (tok0 + tl) * 4 + h;
                const float inv = __builtin_amdgcn_rcpf(fmaxf(fabsf(den[ti]), emt[ti])); float s = 0.f;
#pragma unroll
                for (int bj = 0; bj < 2; ++bj)
#pragma unroll
                    for (int n = 0; n < 2; ++n) { acc[ai][bj][m][n] = acc[ai][bj][m][n] * inv; const pg::f32x4 x = acc[ai][bj][m][n]; s += (x[0] + x[1]) + (x[2] + x[3]); }
                s += __shfl_xor(s, 16); s += __shfl_xor(s, 32);
                const float mw = s * (1.f / 64.f); float q = 0.f;
#pragma unroll
                for (int bj = 0; bj < 2; ++bj)
#pragma unroll
                    for (int n = 0; n < 2; ++n) { const pg::f32x4 d = acc[ai][bj][m][n] - mw; q += (d[0] * d[0] + d[1] * d[1]) + (d[2] * d[2] + d[3] * d[3]); }
                q += __shfl_xor(q, 16); q += __shfl_xor(q, 32);
                if (fq == 0) P[tl * 4 + wc] = (pg::f32x2){mw, q}; }
        asm volatile("s_waitcnt lgkmcnt(0)" ::: "memory"); __builtin_amdgcn_s_barrier(); asm volatile("" ::: "memory");
        if (lane < 32) { const int row = wid * 32 + lane;
            const pg::f32x2 a = P[row * 4 + 0], b_ = P[row * 4 + 1], c_ = P[row * 4 + 2], d = P[row * 4 + 3];
            const float mt = (a.x + b_.x + c_.x + d.x) * 0.25f;
            const float da = a.x - mt, db = b_.x - mt, dc = c_.x - mt, dd = d.x - mt;
            const float m2 = (a.y + b_.y) + (c_.y + d.y) + 64.f * ((da * da + db * db) + (dc * dc + dd * dd));
            Sx[row] = (pg::f32x2){mt, rsqrtf(m2 * (1.f / 256.f) + LN_EPS)}; }
        asm volatile("s_waitcnt lgkmcnt(0)" ::: "memory"); __builtin_amdgcn_s_barrier(); asm volatile("" ::: "memory");
        const int col0 = wc * 32 + 8 * fq;
#pragma unroll
        for (int bj = 0; bj < 2; ++bj) { const int e0 = h * 256 + col0 + bj * 128;
            const pg::f32x4 g0 = *(const pg::f32x4*)(gain + e0), g1 = *(const pg::f32x4*)(gain + e0 + 4);
#pragma unroll
            for (int ai = 0; ai < 2; ++ai)
#pragma unroll
                for (int m = 0; m < 4; ++m) { const int tl = ai * 128 + wr * 64 + m * 16 + fr; const pg::f32x2 sr = Sx[tl]; const size_t t = tok0 + tl;
                    float ov[8]; ld8(PROJ + t * PROJW + PJ_O + e0, ov);
                    const pg::f32x4 v0 = (acc[ai][bj][m][0] - sr.x) * sr.y * g0, v1 = (acc[ai][bj][m][1] - sr.x) * sr.y * g1;
                    float r[8];
#pragma unroll
                    for (int j = 0; j < 4; ++j) { r[j] = v0[j] * fsigmoid(ov[j]); r[4 + j] = v1[j] * fsigmoid(ov[4 + j]); }
                    st8(HOUT + t * 1024 + e0, r); } }
    }
};
struct SchedG1 { pg::TileOrder o; const char* Q; const char* K;
    __device__ __forceinline__ bool next(int i, pg::Unit& u) const { int g, pm, pn; if (!o.tile(i, g, pm, pn)) return false;
        const int bh = g >> 4, c = g & 15, b = bh >> 2, h = bh & 3; const size_t off = (((size_t)b * SEQ + c * 256) * 1024 + h * 256) * 2;
        u.A = Q + off; u.B = K + off; u.pm = 0; u.pn = 0; u.g = g; u.aux = g; u.rows = nullptr; u.nvalid = 0; return true; } };
struct SchedG2 { pg::TileOrder o; const char* BT2; const char* KaT;
    __device__ __forceinline__ bool next(int i, pg::Unit& u) const { int g, pm, pn; if (!o.tile(i, g, pm, pn)) return false;
        const int bh = g / 15, c = g % 15, b = bh >> 2, h = bh & 3;
        u.A = BT2 + (size_t)(bh * 16 + c) * 256 * 512 * 2; u.B = KaT + (((size_t)h * 256) * T + (size_t)b * SEQ + c * 256) * 2;
        u.pm = 0; u.pn = 0; u.g = bh * 16 + c; u.aux = bh * 16 + c; u.rows = nullptr; u.nvalid = 0; return true; } };
struct SchedG3 { pg::TileOrder o; const char* A2; const char* BT2;
    __device__ __forceinline__ bool next(int i, pg::Unit& u) const { int g, pm, pn; if (!o.tile(i, g, pm, pn)) return false;
        const int bh = g >> 4, c = g & 15, b = bh >> 2, h = bh & 3;
        u.A = A2 + (((size_t)b * SEQ + c * 256) * 2048 + h * 512) * 2; u.B = BT2 + (size_t)g * 256 * 512 * 2; u.pm = 0; u.pn = 0; u.g = g; u.aux = g; u.rows = nullptr; u.nvalid = 0; return true; } };
__device__ __forceinline__ void ph_un(LAS unsigned char* lds, const OptBufs2& o2, const OptBufs3& o3) {
    const int tid = tidf(), d = tid & 255, sh = tid >> 8; LAS float* red = (LAS float*)lds;
    for (int it = blockIdx.x; it < 256; it += gridDim.x) { const int bh = it >> 4, c = it & 15, b = bh >> 2, h = bh & 3; const size_t tok0 = (size_t)b * SEQ + c * 256;
        float s = 0.f;
#pragma unroll 8
        for (int j = 0; j < 128; ++j) { const size_t t = tok0 + sh * 128 + j; s += o3.aw[t * 4 + h] * bf2f(o2.K[t * 1024 + h * 256 + d]); }
        __syncthreads(); if (sh == 1) red[d] = s; __syncthreads();
        if (sh == 0) o3.un[(size_t)it * 256 + d] = s + red[d]; }
    __syncthreads();
}
__device__ __forceinline__ void ph_state_scan(const OptBufs& ob, const OptBufs3& o3) {
    const int gt = blockIdx.x * NT + tidf(), ngt = gridDim.x * NT;
    for (int it = gt; it < 16 * 256 * 64; it += ngt) { const int bh = it >> 14, e = (it >> 6) & 255, d4 = (it & 63) * 4;
        pg::f32x4 U[15]; float dc[15];
#pragma unroll
        for (int c = 0; c < 15; ++c) { const size_t g = (size_t)bh * 16 + c; U[c] = *(const pg::f32x4*)(o3.U + g * 65536 + (size_t)e * 256 + d4); dc[c] = o3.decay[g]; }
        pg::f32x4 C = (pg::f32x4){0.f, 0.f, 0.f, 0.f};
#pragma unroll
        for (int c = 0; c < 16; ++c) { const size_t g = (size_t)bh * 16 + c;
            pg::u32x2 w; w.x = pk2(C[0], C[1]); w.y = pk2(C[2], C[3]);
            *(pg::u32x2*)(ob.BT2 + (g * 256 + e) * 512 + 256 + d4) = w;
            if (c < 15) C = C * dc[c] + U[c]; } }
}
__device__ __forceinline__ void ph_den_inter(LAS unsigned char* lds, const OptBufs3& o3) {
    const int tid = tidf(), lane = tid & 63, wave = tid >> 6; LAS float* nn = (LAS float*)lds;
    for (int it = blockIdx.x; it < 256; it += gridDim.x) { const int bh = it >> 4, c = it & 15, b = bh >> 2, h = bh & 3; const size_t tok0 = (size_t)b * SEQ + c * 256;
        __syncthreads();
        if (tid < 256) { float n = 0.f; for (int j = 0; j < c; ++j) n = n * o3.decay[bh * 16 + j] + o3.un[(size_t)(bh * 16 + j) * 256 + tid]; nn[tid] = n; }
        __syncthreads();
        const pg::f32x4 nv = *(const LAS pg::f32x4*)(nn + 4 * lane);
        for (int r0 = 0; r0 < 32; r0 += 8) { pg::u32x2 wv[8];
#pragma unroll
            for (int r = 0; r < 8; ++r) wv[r] = *(const pg::u32x2*)(o3.A2 + (tok0 + wave * 32 + r0 + r) * 2048 + h * 512 + 256 + 4 * lane);
#pragma unroll
            for (int r = 0; r < 8; ++r) { const size_t t = tok0 + wave * 32 + r0 + r; const pg::u32x2 w = wv[r];
                float s = __builtin_bit_cast(float, w.x << 16) * nv[0] + __builtin_bit_cast(float, w.x & 0xffff0000u) * nv[1] + __builtin_bit_cast(float, w.y << 16) * nv[2] + __builtin_bit_cast(float, w.y & 0xffff0000u) * nv[3];
                s = wsum(s);
                if (lane == 0) o3.den[t * 4 + h] += s; } } }
    __syncthreads();
}

__device__ __forceinline__ void ph_gemms_D(LAS unsigned char* lds, const OptBufs2& o, const OptBufs3& o3, const float* b_pool, const float* ls_pool) {
    const int G = gridDim.x, bx = blockIdx.x;
    { SchedG S; S.o.init(T / 256, 2, 1, G, bx); S.A = (const char*)o.POOLED; S.B = (const char*)o.WpoolT; S.gA = 0; S.gB = 0; S.tA = (size_t)256 * 512 * 2; S.tB = (size_t)256 * 512 * 2;
      EpiPoolMixB E{o.MIXED, b_pool, ls_pool}; pg::gemm_phase<EpiPoolMixB, SchedG>(lds, 512, 512, 512, S, E); }
    { SchedG S; S.o.init(T / 256, 1, 4, G, (bx + 128) % G); S.A = (const char*)o.UC; S.B = (const char*)o.WqT; S.gA = 256 * 2; S.gB = (size_t)65536 * 2; S.tA = (size_t)256 * 1024 * 2; S.tB = 0;
      EpiQ E{o.Q, o3.A2, o3.winter}; pg::gemm_phase<EpiQ, SchedG>(lds, 1024, 256, 256, S, E); }
    { SchedG S; S.o.init(T / 256, 1, 4, G, (bx + 128) % G); S.A = (const char*)o.UC; S.B = (const char*)o.WkT; S.gA = 256 * 2; S.gB = (size_t)65536 * 2; S.tA = (size_t)256 * 1024 * 2; S.tB = 0;
      pg::EpiStoreBf16 E{o.K, 1024, 1.f, 256}; pg::gemm_phase<pg::EpiStoreBf16, SchedG>(lds, 1024, 256, 256, S, E); }
    { SchedG S; S.o.init(1, T / 256, 4, G, bx); S.A = (const char*)o.WkT; S.B = (const char*)o.UC; S.gA = (size_t)65536 * 2; S.gB = 256 * 2; S.tA = 0; S.tB = (size_t)256 * 1024 * 2;
      EpiKT E{o3.KaT, o3.aw}; pg::gemm_phase<EpiKT, SchedG>(lds, 256, 1024, 256, S, E); }
}
__device__ __forceinline__ void ph_gemms_E(LAS unsigned char* lds, const OptBufs& ob, const OptBufs2& o2, const OptBufs3& o3) {
    const int G = gridDim.x, bx = blockIdx.x;
    ph_un(lds, o2, o3);
    { SchedG1 S; S.o.init(1, 1, 256, G, bx); S.Q = (const char*)o2.Q; S.K = (const char*)o2.K;
      EpiS E{o3.A2, o3.rowv, o3.colv, o3.den}; pg::gemm_phase<EpiS, SchedG1>(lds, 1024, 1024, 256, S, E); }
    { SchedG2 S; S.o.init(1, 1, 240, G, bx); S.BT2 = (const char*)ob.BT2; S.KaT = (const char*)o3.KaT;
      EpiF32U E{o3.U}; pg::gemm_phase<EpiF32U, SchedG2>(lds, 512, T, 256, S, E); }
}
__device__ __forceinline__ void ph_gemm_G3(LAS unsigned char* lds, const OptBufs& ob, const OptBufs3& o3, const float* gain) {
    SchedG3 S; S.o.init(1, 1, 256, gridDim.x, blockIdx.x); S.A2 = (const char*)o3.A2; S.BT2 = (const char*)ob.BT2;
    EpiNum E{o3.HOUT, ob.PROJ, o3.den, o3.emt, gain}; pg::gemm_phase<EpiNum, SchedG3>(lds, 2048, 512, 512, S, E);
}
__device__ __forceinline__ void ph_gemm_ypool(LAS unsigned char* lds, const OptBufs2& o) {
    const int G = gridDim.x, bx = blockIdx.x;
    SchedG S; S.o.init(T / 256, 4, 1, G, bx); S.A = (const char*)o.MIXED; S.B = (const char*)o.WbpT; S.gA = 0; S.gB = 0; S.tA = (size_t)256 * 512 * 2; S.tB = (size_t)256 * 512 * 2;
    pg::EpiStoreBf16 E{o.YPOOL, 1024, 1.f, 0}; pg::gemm_phase<pg::EpiStoreBf16, SchedG>(lds, 512, 512, 512, S, E);
}


struct OptBufs4 { pg::bf16_t *WbmT, *WoutT, *MERGED, *H1B; unsigned char* H1Q; float *Z, *WRP, *CGB; int *elist, *erank; float *gate; };
struct EpiMerge {
    static constexpr bool PERM = true, AFTER_DRAIN = false, BIAS = false;
    pg::bf16_t* O; const pg::bf16_t* PROJ; const pg::bf16_t* YPOOL;
    __device__ __forceinline__ void operator()(const pg::f32x4 (&acc)[2][2][4][2], const pg::Unit& u, int wr, int wc, int fr, int fq) const {
        const int col0 = u.pn * 256 + wc * 32 + 8 * fq;
#pragma unroll
        for (int ai = 0; ai < 2; ++ai)
#pragma unroll
            for (int m = 0; m < 4; ++m) { const size_t t = (size_t)u.pm * 256 + ai * 128 + wr * 64 + m * 16 + fr;
#pragma unroll
                for (int bj = 0; bj < 2; ++bj) { const int c = col0 + bj * 128; float g0[8], g1[8], yp[8], r[8];
                    ld8(PROJ + t * PROJW + PJ_G + c, g0); ld8(PROJ + t * PROJW + PJ_G + 1024 + c, g1); ld8(YPOOL + t * 1024 + c, yp);
#pragma unroll
                    for (int j = 0; j < 8; ++j) { const float a_ = (j < 4) ? acc[ai][bj][m][0][j] : acc[ai][bj][m][1][j - 4]; r[j] = fsigmoid(g0[j]) * yp[j] + fsigmoid(g1[j]) * a_; }
                    st8(O + t * 1024 + c, r); }
                asm volatile("" ::: "memory"); }
    }
};
struct EpiMixRes {
    static constexpr bool PERM = false, AFTER_DRAIN = false, BIAS = false;
    float* Z; const float* x; const float* stats; const float* g; const float* beta;
    __device__ __forceinline__ void operator()(const pg::f32x4 (&acc)[2][2][4][2], const pg::Unit& u, int wr, int wc, int fr, int fq) const {
        const int col0 = u.pn * 256 + wc * 32 + 4 * fq;
#pragma unroll
        for (int ai = 0; ai < 2; ++ai)
#pragma unroll
            for (int m = 0; m < 4; ++m) { const size_t t = (size_t)u.pm * 256 + ai * 128 + wr * 64 + m * 16 + fr; const float mu = stats[t * 2], rstd = stats[t * 2 + 1];
#pragma unroll
                for (int bj = 0; bj < 2; ++bj)
#pragma unroll
                    for (int n = 0; n < 2; ++n) { const int c = col0 + bj * 128 + n * 16;
                        const pg::f32x4 xv = *(const pg::f32x4*)(x + t * 1024 + c), gv = *(const pg::f32x4*)(g + c), bv = *(const pg::f32x4*)(beta + c);
                        *(pg::f32x4*)(Z + t * 1024 + c) = ((xv - mu) * rstd * gv + bv) * ALPHA + acc[ai][bj][m][n]; }
                asm volatile("" ::: "memory"); }
    }
};
__device__ __forceinline__ void ph_gemm_ymls(LAS unsigned char* lds, const OptBufs& ob, const OptBufs2& o2, const OptBufs3& o3, const OptBufs4& o4) {
    SchedG S; S.o.init(T / 256, 4, 1, gridDim.x, blockIdx.x); S.A = (const char*)o3.HOUT; S.B = (const char*)o4.WbmT; S.gA = 0; S.gB = 0; S.tA = (size_t)256 * 1024 * 2; S.tB = (size_t)256 * 1024 * 2;
    EpiMerge E{o4.MERGED, ob.PROJ, o2.YPOOL}; pg::gemm_phase<EpiMerge, SchedG>(lds, 1024, 1024, 1024, S, E);
}
__device__ __forceinline__ void ph_gemm_mix(LAS unsigned char* lds, const OptBufs& ob, const OptBufs4& o4, const float* x, const float* g, const float* beta) {
    SchedG S; S.o.init(T / 256, 4, 1, gridDim.x, blockIdx.x); S.A = (const char*)o4.MERGED; S.B = (const char*)o4.WoutT; S.gA = 0; S.gB = 0; S.tA = (size_t)256 * 1024 * 2; S.tB = (size_t)256 * 1024 * 2;
    EpiMixRes E{o4.Z, x, ob.stats, g, beta}; pg::gemm_phase<EpiMixRes, SchedG>(lds, 1024, 1024, 1024, S, E);
}
typedef float f32x16 __attribute__((ext_vector_type(16)));
__device__ __forceinline__ void ph_router_prep(const OptBufs4& o, const float* g, const float* beta, const float* wr_, const float* br) {
    const int gt = blockIdx.x * NT + tidf(), ngt = gridDim.x * NT;
    for (int i = gt; i < 1024 * 32; i += ngt) o.WRP[i] = g[i >> 5] * wr_[i];
    const int gw = gt >> 6, lane = gt & 63;
    if (gw < 64) { const int e = gw & 31; const float* vsrc = (gw < 32) ? g : beta; float s_ = 0.f;
#pragma unroll
        for (int i = 0; i < 16; ++i) { const int k = lane + 64 * i; s_ += vsrc[k] * wr_[k * 32 + e]; }
        s_ = wsum(s_);
        if (lane == 0) o.CGB[gw] = s_ + ((gw < 32) ? 0.f : br[e]); }
}
__device__ __forceinline__ void ph_ln1_router(LAS unsigned char* lds, const OptBufs4& o, const float* Zin, const float* g, const float* beta, int* cnt, int mode = 7) {
    const int tid = tidf(), lane = tid & 63, wave = tid >> 6;
    LAS float* part = (LAS float*)lds;
    LAS float* stg = (LAS float*)(lds + wave * 9216);
    LAS float* L = (LAS float*)(lds + 81920);
    LAS float* st = (LAS float*)(lds + 81920 + 8448);
    LAS int* hist = (LAS int*)(lds + 131072 + 1024);
    LAS int* asg = (LAS int*)(lds + 131072 + 1024 + 256);
    for (int tile = blockIdx.x; tile < T / 64; tile += gridDim.x) {
        __syncthreads();
        if (tid < 64) hist[tid] = 0;
        const size_t tbase = (size_t)tile * 64 + wave * 8;
        pg::f32x4 va[4];
#pragma unroll
        for (int j = 0; j < 4; ++j) va[j] = ((const pg::f32x4*)(Zin + tbase * D) + lane)[64 * j];
        for (int r = 0; r < ((mode & 1) ? 8 : 0); ++r) {
            pg::f32x4 na[4];
            if (r < 7) {
#pragma unroll
                for (int j = 0; j < 4; ++j) na[j] = ((const pg::f32x4*)(Zin + (tbase + r + 1) * D) + lane)[64 * j]; }
            float sa = 0.f;
#pragma unroll
            for (int j = 0; j < 4; ++j) sa += (va[j].x + va[j].y) + (va[j].z + va[j].w);
            const float ma = wsum(sa) * (1.f / D); float qa = 0.f;
#pragma unroll
            for (int j = 0; j < 4; ++j) { va[j] = va[j] - ma; qa += (va[j].x * va[j].x + va[j].y * va[j].y) + (va[j].z * va[j].z + va[j].w * va[j].w); }
            const float ra = rsqrtf(wsum(qa) * (1.f / D) + LN_EPS);
            const size_t ta = tbase + r;
            if (lane == 0) { st[(wave * 8 + r) * 2] = ma; st[(wave * 8 + r) * 2 + 1] = ra; }
#pragma unroll
            for (int j = 0; j < 4; ++j) { const int c0 = 256 * j + 4 * lane;
                const pg::f32x4 gg = *(const pg::f32x4*)(g + c0), bb = *(const pg::f32x4*)(beta + c0);
                const pg::f32x4 y = va[j] * ra * gg + bb;
                *(unsigned long long*)(o.H1B + ta * D + c0) = (unsigned long long)pk2(y.x, y.y) | ((unsigned long long)pk2(y.z, y.w) << 32);
                int w0 = __builtin_amdgcn_cvt_pk_fp8_f32(y.x, y.y, 0, false); w0 = __builtin_amdgcn_cvt_pk_fp8_f32(y.z, y.w, w0, true); *(int*)(o.H1Q + ta * D + c0) = w0; }
#pragma unroll
            for (int j = 0; j < 4; ++j) va[j] = na[j];
        }
        if (mode & 2) { const int hh = lane >> 5, el = lane & 31, kb = wave * 128;
          f32x16 acc0, acc1;
#pragma unroll
          for (int i = 0; i < 16; ++i) { acc0[i] = 0.f; acc1[i] = 0.f; }
          const float* zt = Zin + (size_t)tile * 64 * D + kb;
          pg::f32x4 zv[8];
#pragma unroll
          for (int it = 0; it < 8; ++it) zv[it] = *(const pg::f32x4*)(zt + (size_t)(it * 8 + (lane >> 3)) * D + 4 * (lane & 7));
#pragma unroll 1
          for (int sub = 0; sub < 4; ++sub) {
              float bw[16];
#pragma unroll
              for (int s_ = 0; s_ < 16; ++s_) bw[s_] = o.WRP[(size_t)(kb + 32 * sub + 16 * hh + s_) * 32 + el];
#pragma unroll
              for (int it = 0; it < 8; ++it) *(LAS pg::f32x4*)(stg + (it * 8 + (lane >> 3)) * 36 + 4 * (lane & 7)) = zv[it];
              if (sub < 3) {
#pragma unroll
                  for (int it = 0; it < 8; ++it) zv[it] = *(const pg::f32x4*)(zt + (size_t)(it * 8 + (lane >> 3)) * D + 32 * (sub + 1) + 4 * (lane & 7)); }
              asm volatile("s_waitcnt lgkmcnt(0)" ::: "memory");
              pg::f32x4 a0[4], a1[4];
#pragma unroll
              for (int q = 0; q < 4; ++q) { a0[q] = *(const LAS pg::f32x4*)(stg + el * 36 + 16 * hh + 4 * q); a1[q] = *(const LAS pg::f32x4*)(stg + (32 + el) * 36 + 16 * hh + 4 * q); }
#pragma unroll
              for (int q = 0; q < 4; ++q) {
                  acc0 = __builtin_amdgcn_mfma_f32_32x32x2f32(a0[q].x, bw[4 * q + 0], acc0, 0, 0, 0); acc1 = __builtin_amdgcn_mfma_f32_32x32x2f32(a1[q].x, bw[4 * q + 0], acc1, 0, 0, 0);
                  acc0 = __builtin_amdgcn_mfma_f32_32x32x2f32(a0[q].y, bw[4 * q + 1], acc0, 0, 0, 0); acc1 = __builtin_amdgcn_mfma_f32_32x32x2f32(a1[q].y, bw[4 * q + 1], acc1, 0, 0, 0);
                  acc0 = __builtin_amdgcn_mfma_f32_32x32x2f32(a0[q].z, bw[4 * q + 2], acc0, 0, 0, 0); acc1 = __builtin_amdgcn_mfma_f32_32x32x2f32(a1[q].z, bw[4 * q + 2], acc1, 0, 0, 0);
                  acc0 = __builtin_amdgcn_mfma_f32_32x32x2f32(a0[q].w, bw[4 * q + 3], acc0, 0, 0, 0); acc1 = __builtin_amdgcn_mfma_f32_32x32x2f32(a1[q].w, bw[4 * q + 3], acc1, 0, 0, 0); }
              asm volatile("s_waitcnt lgkmcnt(0)" ::: "memory");
          }
          __syncthreads();
#pragma unroll
          for (int i = 0; i < 16; ++i) { part[((wave * 2 + 0) * 16 + i) * 64 + lane] = acc0[i]; part[((wave * 2 + 1) * 16 + i) * 64 + lane] = acc1[i]; }
        } else __syncthreads();
        __syncthreads();
#pragma unroll
        for (int i = 0; i < 4; ++i) { const int idx = tid + 512 * i; float sum = 0.f;
#pragma unroll
            for (int w = 0; w < 8; ++w) sum += part[w * 2048 + idx];
            const int mt = idx >> 10, rg = (idx >> 6) & 15, l2 = idx & 63, tok = mt * 32 + (rg & 3) + 8 * (rg >> 2) + 4 * (l2 >> 5), e = l2 & 31;
            L[tok * 33 + e] = st[tok * 2 + 1] * (sum - st[tok * 2] * o.CGB[e]) + o.CGB[32 + e]; }
        __syncthreads();
        if (tid < 64 && (mode & 4)) { const LAS float* lr_ = L + tid * 33; int i0 = -1, i1 = -1, i2 = -1, i3 = -1; float v0 = 0.f, v1 = 0.f, v2 = 0.f, v3 = 0.f;
#pragma unroll
            for (int k = 0; k < 4; ++k) { float bv = -INFINITY; int bi = 0;
                for (int e = 0; e < 32; ++e) { const float x = lr_[e]; if (e != i0 && e != i1 && e != i2 && x > bv) { bv = x; bi = e; } }
                if (k == 0) { i0 = bi; v0 = bv; } else if (k == 1) { i1 = bi; v1 = bv; } else if (k == 2) { i2 = bi; v2 = bv; } else { i3 = bi; v3 = bv; } }
            const float e1 = expf(v1 - v0), e2 = expf(v2 - v0), e3 = expf(v3 - v0), inv = 1.f / (1.f + e1 + e2 + e3);
            const size_t t = (size_t)tile * 64 + tid;
            *(pg::f32x4*)(o.gate + t * 4) = (pg::f32x4){inv, e1 * inv, e2 * inv, e3 * inv};
            const int r0 = atomicAdd((int*)(hist + i0), 1), r1 = atomicAdd((int*)(hist + i1), 1), r2 = atomicAdd((int*)(hist + i2), 1), r3 = atomicAdd((int*)(hist + i3), 1);
            asg[tid * 4 + 0] = i0 | (r0 << 8); asg[tid * 4 + 1] = i1 | (r1 << 8); asg[tid * 4 + 2] = i2 | (r2 << 8); asg[tid * 4 + 3] = i3 | (r3 << 8); }
        __syncthreads();
        if (tid < 32) hist[32 + tid] = atomicAdd(&cnt[tid], hist[tid]);
        __syncthreads();
        if (tid < 256) { const int a_ = asg[tid], e = a_ & 255, rank = hist[32 + e] + (a_ >> 8); const int t = tile * 64 + (tid >> 2);
            o.elist[e * T + rank] = t; o.erank[(size_t)t * 4 + (tid & 3)] = (e << 16) | rank; }
    }
    __syncthreads();
}
__device__ __forceinline__ void ph_adapt_route(const OptBufs4& o, const int* start, int* row_tok, int* row_of) {
    const int gt = blockIdx.x * NT + tidf(), ngt = gridDim.x * NT;
    for (int i = gt; i < NA; i += ngt) { const int er = o.erank[i], e = er >> 16, rank = er & 0xffff; const int dest = start[e] + rank; row_tok[dest] = i >> 2; row_of[i] = dest; }
}


struct OptBufs5 { pg::bf16_t *We1T, *We2T, *ACT, *Y; float* B1P; };
constexpr int MOE_TAB_OFF = 131072 + 4096;
__device__ __forceinline__ void moe_build_tab(LAS unsigned char* lds, const int* cnt) {
    LAS int* tab = (LAS int*)(lds + MOE_TAB_OFF);
    __syncthreads();
    if (tidf() == 0) { int s = 0; for (int e = 0; e < NE; ++e) { const int c = cnt[e]; tab[e] = s; tab[40 + e] = c; s += (c + 255) >> 8; } tab[NE] = s; }
    __syncthreads();
}
struct SchedMoE {
    const LAS int* tab; const int* cnt; const int* elist; const char* A; const char* B; size_t eB; int nN, nwg, G, c, gather;
    __device__ __forceinline__ bool next(int i, pg::Unit& u) const {
        const long L = (long)i * G + c; if (L >= nwg) return false;
        int wgid = (int)L; { const int q = nwg / pg::NXCD, r = nwg % pg::NXCD, xcd = wgid % pg::NXCD, off = wgid / pg::NXCD; wgid = (xcd < r ? xcd * (q + 1) : r * (q + 1) + (xcd - r) * q) + off; }
        const int mg = wgid / nN, pn = wgid - mg * nN;
        const int ln = tidf() & 63, tv = tab[ln < NE ? ln : NE];
        const int e = __builtin_amdgcn_readfirstlane(__popcll(__ballot(ln >= 1 && ln < NE && tv <= mg)));
        const int mt = mg - __builtin_amdgcn_readlane(tv, e);
        u.g = e; u.pm = mg; u.pn = pn; u.aux = mg * 256;
        u.B = B + (size_t)e * eB + (size_t)pn * 256 * 1024;
        if (gather) { u.A = A; u.rows = elist + (size_t)e * T + mt * 256; const int rem = __builtin_amdgcn_readfirstlane(tab[40 + e]) - mt * 256; u.nvalid = rem < 256 ? rem : 256; }
        else { u.A = A + (size_t)mg * 256 * 1024; u.rows = nullptr; u.nvalid = 0; }
        return true;
    }
};
struct EpiSwiglu {
    static constexpr bool PERM = true, AFTER_DRAIN = false, BIAS = true;
    unsigned char* ACT; const float* B1P;
    __device__ __forceinline__ const float* bias_base(const pg::Unit& u) const { return B1P + u.g * 2048 + u.pn * 256; }
    __device__ __forceinline__ void operator()(const pg::f32x4 (&acc)[2][2][4][2], const pg::Unit& u, int wr, int wc, int fr, int fq) const {
        const int col0 = wc * 32 + 8 * fq;
        unsigned char* base = ACT + (size_t)(u.aux + wr * 64 + fr) * 1024 + u.pn * 128 + col0;
#pragma unroll
        for (int ai = 0; ai < 2; ++ai)
#pragma unroll
            for (int m = 0; m < 4; ++m) { float r[8];
#pragma unroll
                for (int j = 0; j < 8; ++j) { float g = (j < 4) ? acc[ai][0][m][0][j] : acc[ai][0][m][1][j - 4];
                    float l = (j < 4) ? acc[ai][1][m][0][j] : acc[ai][1][m][1][j - 4];
                    g = fminf(g, 7.f); l = fminf(fmaxf(l, -7.f), 7.f);
                    r[j] = g * (l + 1.f) * __builtin_amdgcn_rcpf(1.f + __expf(-1.702f * g)); }
                { int w0 = __builtin_amdgcn_cvt_pk_fp8_f32(r[0], r[1], 0, false); w0 = __builtin_amdgcn_cvt_pk_fp8_f32(r[2], r[3], w0, true);
                  int w1 = __builtin_amdgcn_cvt_pk_fp8_f32(r[4], r[5], 0, false); w1 = __builtin_amdgcn_cvt_pk_fp8_f32(r[6], r[7], w1, true);
                  *(pg::u32x2*)(base + (size_t)(ai * 128 + m * 16) * 1024) = (pg::u32x2){(unsigned)w0, (unsigned)w1}; }
                asm volatile("" ::: "memory"); }
    }
};
struct EpiY {
    static constexpr bool PERM = true, AFTER_DRAIN = false, BIAS = true;
    pg::bf16_t* Y; const float* b2;
    __device__ __forceinline__ const float* bias_base(const pg::Unit& u) const { return b2 + u.g * 1024 + u.pn * 256; }
    __device__ __forceinline__ void operator()(const pg::f32x4 (&acc)[2][2][4][2], const pg::Unit& u, int wr, int wc, int fr, int fq) const {
        const int col0 = u.pn * 256 + wc * 32 + 8 * fq;
        pg::bf16_t* base = Y + (size_t)(u.aux + wr * 64 + fr) * 1024 + col0;
#pragma unroll
        for (int bj = 0; bj < 2; ++bj)
#pragma unroll
            for (int ai = 0; ai < 2; ++ai)
#pragma unroll
                for (int m = 0; m < 4; ++m) { const pg::f32x4 v0 = acc[ai][bj][m][0], v1 = acc[ai][bj][m][1];
                    pg::u32x4 w; w.x = pg::cvt_pk_bf16(v0[0], v0[1]); w.y = pg::cvt_pk_bf16(v0[2], v0[3]); w.z = pg::cvt_pk_bf16(v1[0], v1[1]); w.w = pg::cvt_pk_bf16(v1[2], v1[3]);
                    *(pg::u32x4*)(base + (size_t)(ai * 128 + m * 16) * 1024 + bj * 128) = w; asm volatile("" ::: "memory"); }
    }
};
struct EpiNull { static constexpr bool PERM = true, AFTER_DRAIN = false, BIAS = false;
    float* sink;
    __device__ __forceinline__ void operator()(const pg::f32x4 (&acc)[2][2][4][2], const pg::Unit& u, int wr, int wc, int fr, int fq) const {
        float s_ = 0.f;
#pragma unroll
        for (int ai = 0; ai < 2; ++ai)
#pragma unroll
            for (int bj = 0; bj < 2; ++bj)
#pragma unroll
                for (int m = 0; m < 4; ++m)
#pragma unroll
                    for (int n = 0; n < 2; ++n) s_ += acc[ai][bj][m][n][0];
        if (s_ == 1.2345e30f) sink[0] = s_; } };
__device__ __forceinline__ void ph_moe1_probe(LAS unsigned char* lds, const OptBufs4& o4, const OptBufs5& o5, const int* cnt, int mode, unsigned char* dummy) {
    moe_build_tab(lds, cnt);
    SchedMoE S; S.tab = (const LAS int*)(lds + MOE_TAB_OFF); S.cnt = cnt; S.elist = o4.elist; S.A = (const char*)o4.H1Q; S.B = (const char*)o5.We1T; S.eB = (size_t)2048 * 1024;
    S.nN = 8; S.nwg = __builtin_amdgcn_readfirstlane(S.tab[NE]) * 8; S.G = gridDim.x; S.c = blockIdx.x; S.gather = 1;
    if (mode == 0) { EpiSwiglu E{dummy, o5.B1P}; pg::gemm_phase<EpiSwiglu, SchedMoE, true, true>(lds, 512, 512, 512, S, E); }
    if (mode == 1) { S.gather = 0; S.A = (const char*)o5.ACT; EpiSwiglu E{dummy, o5.B1P}; pg::gemm_phase<EpiSwiglu, SchedMoE, false, true>(lds, 512, 512, 512, S, E); }
    if (mode == 2) { EpiNull E{(float*)dummy}; pg::gemm_phase<EpiNull, SchedMoE, true, true>(lds, 512, 512, 512, S, E); }
    if (mode == 3) { S.gather = 0; S.A = (const char*)o5.ACT; EpiNull E{(float*)dummy}; pg::gemm_phase<EpiNull, SchedMoE, false, true>(lds, 512, 512, 512, S, E); }
}
__device__ __forceinline__ void ph_moe1(LAS unsigned char* lds, const OptBufs4& o4, const OptBufs5& o5, const int* cnt) {
    moe_build_tab(lds, cnt);
    SchedMoE S; S.tab = (const LAS int*)(lds + MOE_TAB_OFF); S.cnt = cnt; S.elist = o4.elist; S.A = (const char*)o4.H1Q; S.B = (const char*)o5.We1T; S.eB = (size_t)2048 * 1024;
    S.nN = 8; S.nwg = __builtin_amdgcn_readfirstlane(S.tab[NE]) * 8; S.G = gridDim.x; S.c = blockIdx.x; S.gather = 1;
    EpiSwiglu E{(unsigned char*)o5.ACT, o5.B1P}; pg::gemm_phase<EpiSwiglu, SchedMoE, true, true>(lds, 512, 512, 512, S, E);
}
__device__ __forceinline__ void ph_moe2(LAS unsigned char* lds, const OptBufs5& o5, const int* cnt, const float* b_e2) {
    moe_build_tab(lds, cnt);
    SchedMoE S; S.tab = (const LAS int*)(lds + MOE_TAB_OFF); S.cnt = cnt; S.elist = nullptr; S.A = (const char*)o5.ACT; S.B = (const char*)o5.We2T; S.eB = (size_t)1024 * 1024;
    S.nN = 4; S.nwg = __builtin_amdgcn_readfirstlane(S.tab[NE]) * 4; S.G = gridDim.x; S.c = blockIdx.x; S.gather = 0;
    EpiY E{o5.Y, b_e2}; pg::gemm_phase<EpiY, SchedMoE, false, true>(lds, 512, 512, 512, S, E);
}
__device__ __forceinline__ void ph_final_opt(LAS unsigned char* lds, const OptBufs4& o4, const OptBufs5& o5, const int* cnt, const float* g, const float* beta, float* out) {
    moe_build_tab(lds, cnt);
    const LAS int* tab = (const LAS int*)(lds + MOE_TAB_OFF);
    const int tid = tidf(), lane = tid & 63, gw = blockIdx.x * NW + (tid >> 6), ngw = gridDim.x * NW;
    for (int t = gw; t < T; t += ngw) {
        size_t ro[4]; float gt[4];
#pragma unroll
        for (int k = 0; k < 4; ++k) { const int er = o4.erank[(size_t)t * 4 + k]; ro[k] = (size_t)(tab[er >> 16] * 256 + (er & 0xffff)) * 1024; gt[k] = o4.gate[(size_t)t * 4 + k]; }
        pg::f32x4 v[4]; float s = 0.f;
#pragma unroll
        for (int j = 0; j < 4; ++j) { const int c0 = 256 * j + 4 * lane;
            pg::f32x4 x; { const pg::u32x2 hw = *(const pg::u32x2*)(o4.H1B + (size_t)t * D + c0); x.x = __builtin_bit_cast(float, hw.x << 16) * ALPHA; x.y = __builtin_bit_cast(float, hw.x & 0xffff0000u) * ALPHA; x.z = __builtin_bit_cast(float, hw.y << 16) * ALPHA; x.w = __builtin_bit_cast(float, hw.y & 0xffff0000u) * ALPHA; }
#pragma unroll
            for (int k = 0; k < 4; ++k) { const pg::u32x2 w = *(const pg::u32x2*)(o5.Y + ro[k] + c0);
                x.x += gt[k] * __builtin_bit_cast(float, w.x << 16); x.y += gt[k] * __builtin_bit_cast(float, w.x & 0xffff0000u);
                x.z += gt[k] * __builtin_bit_cast(float, w.y << 16); x.w += gt[k] * __builtin_bit_cast(float, w.y & 0xffff0000u); }
            v[j] = x; s += (x.x + x.y) + (x.z + x.w); }
        const float mean = wsum(s) * (1.f / D); float s2 = 0.f;
#pragma unroll
        for (int j = 0; j < 4; ++j) { v[j] = v[j] - mean; s2 += (v[j].x * v[j].x + v[j].y * v[j].y) + (v[j].z * v[j].z + v[j].w * v[j].w); }
        const float rstd = rsqrtf(wsum(s2) * (1.f / D) + LN_EPS);
#pragma unroll
        for (int j = 0; j < 4; ++j) { const int c0 = 256 * j + 4 * lane;
            *(pg::f32x4*)(out + (size_t)t * D + c0) = v[j] * rstd * *(const pg::f32x4*)(g + c0) + *(const pg::f32x4*)(beta + c0); }
    }
}

__device__ __forceinline__ void ph_adapt1(const OptBufs& o, const float* b_if, float* proj) {
    const size_t gt = (size_t)blockIdx.x * NT + tidf(), ngt = (size_t)gridDim.x * NT;
    for (size_t i = gt; i < (size_t)T * INC; i += ngt) {
        const int c = (int)(i % INC); const int t = (int)(i / INC);
        float v;
        if (c < C_V) v = bf2f(o.PROJ[(size_t)t * PROJW + c]);
        else if (c < C_O) { const int e = c - C_V, h = e >> 8, el = e & 255, b = t >> 12, cc = (t & 4095) >> 8, tl = t & 255;
            v = bf2f(o.BT2[((size_t)((b * 4 + h) * 16 + cc) * 256 + el) * 512 + tl]); }
        else if (c < C_IF) v = bf2f(o.PROJ[(size_t)t * PROJW + c - 1024]);
        else if (c < C_G) v = o.gif[(size_t)t * 8 + (c - C_IF)] - b_if[c - C_IF];
        else v = bf2f(o.PROJ[(size_t)t * PROJW + c - C_G + PJ_G]);
        proj[i] = v;
    }
}

struct PrepSrc { const float *w_in, *w_q, *w_k, *w_pool, *w_bp, *w_bm, *w_out, *w_e1, *w_e2, *b_e1; };
constexpr int TI_E1 = 16384, TI_E2 = 8192, TI_IN = (WIN_ROWS / 64) * 16, TI_MO = 512, TI_QK = 128, TI_BP = 128, TI_PL = 16;
constexpr int TI_TOTAL = TI_E1 + TI_E2 + TI_IN + TI_MO + TI_QK + TI_BP + TI_PL;
__device__ __forceinline__ TItem titem_decode(int it, const PrepSrc& p, const OptBufs& ob, const OptBufs2& o2, const OptBufs4& o4, const OptBufs5& o5) {
    TItem t; t.inter = 0; t.fp8 = 0; t.valid = it < TI_TOTAL; t.src = p.w_in; t.dst = ob.WinT; t.ldw = 64; t.ldt = 64;
    if (!t.valid) return t;
    if (it < TI_E1) { const int nb = it & 31, kb = (it >> 5) & 15, e = it >> 9, j0 = nb * 32, pn = j0 >> 7, jj0 = j0 & 127;
        t.src = p.w_e1 + (size_t)e * 1024 * 2048 + (size_t)(kb * 64) * 2048 + nb * 64; t.dst = (pg::bf16_t*)((unsigned char*)o5.We1T + (size_t)e * 2048 * 1024 + (size_t)(pn * 256 + jj0) * 1024 + kb * 64); t.ldw = 2048; t.ldt = 1024; t.inter = 1; t.fp8 = 1; return t; }
    it -= TI_E1;
    if (it < TI_E2) { const int nb = it & 15, kb = (it >> 4) & 15, e = it >> 8;
        t.src = p.w_e2 + (size_t)e * 1024 * 1024 + (size_t)(kb * 64) * 1024 + nb * 64; t.dst = (pg::bf16_t*)((unsigned char*)o5.We2T + (size_t)e * 1024 * 1024 + (size_t)(nb * 64) * 1024 + kb * 64); t.ldw = 1024; t.ldt = 1024; t.fp8 = 1; return t; }
    it -= TI_E2;
    if (it < TI_IN) { const int rb = it >> 4, kb = it & 15;
        t.src = p.w_in + (size_t)(kb * 64) * INC + win_src_col(rb * 64); t.dst = ob.WinT + (size_t)(rb * 64) * D + kb * 64; t.ldw = INC; t.ldt = D; return t; }
    it -= TI_IN;
    if (it < TI_MO) { const int which = it >> 8, r = it & 255, nb = r >> 4, kb = r & 15;
        t.src = (which ? p.w_out : p.w_bm) + (size_t)(kb * 64) * 1024 + nb * 64; t.dst = (which ? o4.WoutT : o4.WbmT) + (size_t)(nb * 64) * 1024 + kb * 64; t.ldw = 1024; t.ldt = 1024; return t; }
    it -= TI_MO;
    if (it < TI_QK) { const int which = it >> 6, r = it & 63, h = r >> 4, nb = (r & 15) >> 2, kb = r & 3;
        t.src = (which ? p.w_k : p.w_q) + (size_t)h * 65536 + (size_t)(kb * 64) * 256 + nb * 64; t.dst = (which ? o2.WkT : o2.WqT) + (size_t)h * 65536 + (size_t)(nb * 64) * 256 + kb * 64; t.ldw = 256; t.ldt = 256; return t; }
    it -= TI_QK;
    if (it < TI_BP) { const int nb = it >> 3, kb = it & 7;
        t.src = p.w_bp + (size_t)(kb * 64) * 1024 + nb * 64; t.dst = o2.WbpT + (size_t)(nb * 64) * 512 + kb * 64; t.ldw = 1024; t.ldt = 512; return t; }
    it -= TI_BP;
    { const int g = it >> 2, nb = (it & 3) >> 1, kb = it & 1;
        t.src = p.w_pool + (size_t)g * 16384 + (size_t)(kb * 64) * 128 + nb * 64; t.dst = o2.WpoolT + (size_t)(g * 128 + nb * 64) * 512 + g * 128 + kb * 64; t.ldw = 128; t.ldt = 512; return t; }
}
__device__ __forceinline__ void ph_prep_all(LAS unsigned char* lds, const PrepSrc& p, const OptBufs& ob, const OptBufs2& o2, const OptBufs4& o4, const OptBufs5& o5) {
    const int tid = tidf(), lane = tid & 63, wave = tid >> 6, gw = blockIdx.x * NW + wave, ngw = gridDim.x * NW;
    LAS float* scr = (LAS float*)(lds + wave * 16640);
    int it = gw; TItem cur = titem_decode(it, p, ob, o2, o4, o5);
    pg::f32x4 r[16];
    if (cur.valid) titem_load(cur, r, lane);
    while (cur.valid) {
        const int nx = it + ngw; const TItem nxt = titem_decode(nx, p, ob, o2, o4, o5);
        pg::f32x4 rn[16];
        if (nxt.valid) titem_load(nxt, rn, lane);
        titem_store(cur, r, scr, lane);
#pragma unroll
        for (int i = 0; i < 16; ++i) r[i] = rn[i];
        cur = nxt; it = nx;
    }
    { const size_t gt = (size_t)blockIdx.x * NT + tid, ngt = (size_t)gridDim.x * NT;
      for (size_t ch = gt; ch < 512 * 64; ch += ngt) { const int n = (int)(ch >> 6), k8 = (int)(ch & 63) * 8; if ((n >> 7) != (k8 >> 7)) *(pg::u32x4*)(o2.WpoolT + (size_t)n * 512 + k8) = (pg::u32x4){0u, 0u, 0u, 0u}; } }
    for (int i = blockIdx.x * NT + tid; i < 32 * 2048; i += gridDim.x * NT) { const int e = i >> 11, rr = i & 2047, pn = rr >> 8, bj = (rr >> 7) & 1, jj = rr & 127; o5.B1P[i] = p.b_e1[e * 2048 + 2 * (pn * 128 + jj) + bj]; }
}

struct Args { const float* in[26]; float* out; unsigned char* ws; int ph_lo, ph_hi; };
constexpr size_t MiB = 1u << 20;
constexpr size_t WS_CTL = 0;
constexpr size_t CTL_ZERO_BYTES = 1 * MiB;
constexpr int CW_BAR = 4096;
constexpr int CW_CNT = 16384, CW_START = 16384 + 64, CW_FILL = 16384 + 128;

__global__ void __launch_bounds__(NT, 2) mk_fwd(Args a) {
    extern __shared__ __attribute__((aligned(16))) unsigned char lds_raw[];
    LAS unsigned char* lds = (LAS unsigned char*)lds_raw;
    volatile LAS unsigned* MISC = (volatile LAS unsigned*)(lds + MISC_OFF);
    const int tid = tidf();
    if (tid < 32) MISC[tid] = 0u;
    __syncthreads();
    unsigned char* ws = a.ws;
    unsigned* ctl = (unsigned*)(ws + WS_CTL);
    XcdBarrier bar = xcd_barrier_post(ctl + CW_BAR, MISC + 8);
    const float* x = a.in[0]; const float* ln0_g = a.in[1]; const float* ln0_b = a.in[2];
    const float* w_in = a.in[3]; const float* conv_w = a.in[4]; const float* conv_b = a.in[5];
    const float* w_q = a.in[6]; const float* w_k = a.in[7]; const float* b_if = a.in[8];
    const float* mh_gain = a.in[9]; const float* w_pool = a.in[10]; const float* b_pool = a.in[11];
    const float* ls_pool = a.in[12]; const float* w_bp = a.in[13]; const float* w_bm = a.in[14];
    const float* w_out = a.in[15]; const float* ln1_g = a.in[16]; const float* ln1_b = a.in[17];
    const float* w_router = a.in[18]; const float* b_router = a.in[19]; const float* w_e1 = a.in[20];
    const float* b_e1 = a.in[21]; const float* w_e2 = a.in[22]; const float* b_e2 = a.in[23];
    const float* ln2_g = a.in[24]; const float* ln2_b = a.in[25];
    OptBufs ob; ob.WinT = (pg::bf16_t*)(ws + 8 * MiB); ob.H0B = (pg::bf16_t*)(ws + 220 * MiB); ob.PROJ = (pg::bf16_t*)(ws + 252 * MiB); ob.BT2 = (pg::bf16_t*)(ws + 396 * MiB);
    ob.gif = (float*)(ws + 1 * MiB); ob.stats = (float*)(ws + 1 * MiB + 512 * 1024);
    OptBufs2 o2; o2.WqT = (pg::bf16_t*)(ws + 19 * MiB); o2.WkT = (pg::bf16_t*)(ws + 19 * MiB + 512 * 1024); o2.WpoolT = (pg::bf16_t*)(ws + 20 * MiB); o2.WbpT = (pg::bf16_t*)(ws + 20 * MiB + 512 * 1024);
    o2.POOLED = (pg::bf16_t*)(ws + 460 * MiB); o2.UC = (pg::bf16_t*)(ws + 476 * MiB); o2.MIXED = (pg::bf16_t*)(ws + 508 * MiB); o2.Q = (pg::bf16_t*)(ws + 524 * MiB); o2.K = (pg::bf16_t*)(ws + 556 * MiB);
    o2.YPOOL = (pg::bf16_t*)(ws + 748 * MiB);
    OptBufs3 o3; o3.KaT = (pg::bf16_t*)(ws + 588 * MiB); o3.A2 = (pg::bf16_t*)(ws + 620 * MiB); o3.U = (float*)(ws + 684 * MiB); o3.HOUT = (pg::bf16_t*)(ws + 780 * MiB);
    { float* sm = (float*)(ws + 2 * MiB); o3.rowv = sm; o3.colv = sm + 65536; o3.winter = sm + 2 * 65536; o3.aw = sm + 3 * 65536; o3.emt = sm + 4 * 65536; o3.den = sm + 5 * 65536; o3.un = sm + 6 * 65536; o3.decay = sm + 7 * 65536; }
    OptBufs4 o4; o4.WbmT = (pg::bf16_t*)(ws + 21 * MiB + 512 * 1024); o4.WoutT = (pg::bf16_t*)(ws + 23 * MiB + 512 * 1024); o4.MERGED = (pg::bf16_t*)(ws + 812 * MiB); o4.Z = (float*)(ws + 844 * MiB); o4.H1B = (pg::bf16_t*)(ws + 908 * MiB); o4.H1Q = (unsigned char*)(ws + 940 * MiB); o4.WRP = (float*)(ws + 7 * MiB + 512 * 1024); o4.CGB = (float*)(ws + 7 * MiB + 768 * 1024);
    o4.elist = (int*)(ws + 4 * MiB); o4.erank = (int*)(ws + 6 * MiB); o4.gate = (float*)(ws + 6 * MiB + 256 * 1024);
    OptBufs5 o5; o5.We1T = (pg::bf16_t*)(ws + 26 * MiB); o5.We2T = (pg::bf16_t*)(ws + 154 * MiB); o5.B1P = (float*)(ws + 7 * MiB);
    o5.ACT = (pg::bf16_t*)(ws + 252 * MiB);
    o5.Y = (pg::bf16_t*)(ws + 396 * MiB);
    int* cnt = (int*)ctl + CW_CNT;
    LAS float* ldsf = (LAS float*)lds;
    const int G = gridDim.x, bx = blockIdx.x;
#define IN(k) (a.ph_lo <= (k) && (k) < a.ph_hi)
#define SEAM(k) do { if (IN(k) && IN((k) + 1)) xcd_barrier(bar); } while (0)
    if (IN(0)) { PrepSrc ps{w_in, w_q, w_k, w_pool, w_bp, w_bm, w_out, w_e1, w_e2, b_e1}; ph_prep_all(lds, ps, ob, o2, o4, o5); ph_router_prep(o4, ln1_g, ln1_b, w_router, b_router); ph_ln0(lds, ob, x, ln0_g, ln0_b, w_in, b_if);
#if PROBE_PH == 0
        { xcd_barrier(bar); if (PROBE_MODE & 1) ph_prep_all(lds, ps, ob, o2, o4, o5); if (PROBE_MODE & 2) ph_ln0(lds, ob, x, ln0_g, ln0_b, w_in, b_if); }
#endif
    }
    SEAM(0);
    if (IN(1)) ph_inproj(lds, ob);
    SEAM(1);
    if (IN(2)) { if (bx >= G - 16) scalar_scan_wg(lds, bx - (G - 16), ob.gif, o3);
                 for (int i = bx * NT + tid; i < T * 4; i += G * NT) o3.den[i] = 0.f;
                 ph_poolconv_opt(ob.PROJ, conv_w, conv_b, o2.POOLED, o2.UC); }
    SEAM(2);
    if (IN(3)) ph_gemms_D(lds, o2, o3, b_pool, ls_pool);
    SEAM(3);
    if (IN(4)) { ph_gemm_ypool(lds, o2); ph_gemms_E(lds, ob, o2, o3);
#if PROBE_PH == 4
        { xcd_barrier(bar); OptBufs3 d3 = o3; d3.den = (float*)(ws + 980 * MiB); ph_gemm_ypool(lds, o2); ph_gemms_E(lds, ob, o2, d3); }
#endif
    }
    SEAM(4);
    if (IN(5)) { ph_state_scan(ob, o3); ph_den_inter(lds, o3);
#if PROBE_PH == 5
        { xcd_barrier(bar); OptBufs3 d3 = o3; d3.den = (float*)(ws + 980 * MiB); ph_state_scan(ob, d3); ph_den_inter(lds, d3); }
#endif
    }
    SEAM(5);
    if (IN(6)) ph_gemm_G3(lds, ob, o3, mh_gain);
    SEAM(6);
    if (IN(7)) ph_gemm_ymls(lds, ob, o2, o3, o4);
    SEAM(7);
    if (IN(8)) ph_gemm_mix(lds, ob, o4, x, ln0_g, ln0_b);
    SEAM(8);
    if (IN(9)) { ph_ln1_router(lds, o4, o4.Z, ln1_g, ln1_b, cnt);
#if PROBE_PH == 9
        { xcd_barrier(bar); OptBufs4 d4 = o4; d4.Z = (float*)(ws + 684 * MiB); d4.H1B = (pg::bf16_t*)(ws + 588 * MiB); d4.H1Q = (unsigned char*)(ws + 620 * MiB); d4.elist = (int*)(ws + 980 * MiB); d4.erank = (int*)(ws + 984 * MiB); d4.gate = (float*)(ws + 986 * MiB);
          ph_ln1_router(lds, d4, o4.Z, ln1_g, ln1_b, cnt + 256, PROBE_MODE); }
#endif
    }
    SEAM(9);
    if (IN(10)) { ph_moe1(lds, o4, o5, cnt);
#if PROBE_PH == 10
        { xcd_barrier(bar); ph_moe1_probe(lds, o4, o5, cnt, PROBE_MODE, (unsigned char*)(ws + 956 * MiB)); }
#endif
    }
    SEAM(10);
    if (IN(11)) ph_moe2(lds, o5, cnt, b_e2);
    SEAM(11);
    if (IN(12)) { ph_final_opt(lds, o4, o5, cnt, ln2_g, ln2_b, a.out);
#if PROBE_PH == 12
        { xcd_barrier(bar); ph_final_opt(lds, o4, o5, cnt, ln2_g, ln2_b, a.out); }
#endif
    }
}
constexpr int NPH = 13;
}

extern "C" void kernel_launch(void* const* d_in, const int* in_sizes, int n_in, void* d_out, int out_size, void* d_ws, size_t ws_size, hipStream_t stream) {
    using namespace mk;
    static int grid = 0;
    if (grid == 0) {
        if (n_in != 26 || ws_size < 1000 * MiB) { fprintf(stderr, "kernel_launch: unexpected n_in %d / ws %zu\n", n_in, ws_size); grid = -1; return; }
        int dev = 0, cus = 0, per_cu = 0;
        hipGetDevice(&dev); hipDeviceGetAttribute(&cus, hipDeviceAttributeMultiprocessorCount, dev);
        if (hipFuncSetAttribute((const void*)mk_fwd, hipFuncAttributeMaxDynamicSharedMemorySize, LDS_BYTES) != hipSuccess) { fprintf(stderr, "hipFuncSetAttribute failed\n"); grid = -1; return; }
        if (hipOccupancyMaxActiveBlocksPerMultiprocessor(&per_cu, (const void*)mk_fwd, NT, LDS_BYTES) != hipSuccess || per_cu < 1) { fprintf(stderr, "occupancy query failed (%d)\n", per_cu); grid = -1; return; }
        grid = cus * 1;
        fprintf(stderr, "kernel_launch: cus %d per_cu %d grid %d\n", cus, per_cu, grid);
    }
    if (grid < 0) return;
    hipMemsetAsync((char*)d_ws + WS_CTL, 0, CTL_ZERO_BYTES, stream);
    Args a{};
    for (int i = 0; i < 26; ++i) a.in[i] = (const float*)d_in[i];
    a.out = (float*)d_out; a.ws = (unsigned char*)d_ws; a.ph_lo = 0; a.ph_hi = NPH;
    void* args[] = {&a};
    hipError_t e = hipLaunchCooperativeKernel((const void*)mk_fwd, dim3(grid), dim3(NT), args, LDS_BYTES, stream);
    if (e != hipSuccess) fprintf(stderr, "cooperative launch failed: %s (grid %d)\n", hipGetErrorString(e), grid);
}
```

```cpp
#include <hip/hip_runtime.h>
#include <cstdio>
#include <cstdint>

#define LAS __attribute__((address_space(3)))
#ifndef PROBE_PH
#define PROBE_PH -1
#endif
#define PROBE_MODE 7
namespace mk {
constexpr int D = 1024, BATCH = 4, SEQ = 4096, T = BATCH * SEQ;
constexpr int INC = 5640;
constexpr int C_P = 0, C_U = 512, C_V = 1536, C_O = 2560, C_IF = 3584, C_G = 3592;
constexpr int NE = 32, TOPK = 4, NA = T * TOPK;
constexpr float LN_EPS = 1e-5f;
constexpr float ALPHA = 1.189207115002721f;
constexpr int NT = 512, NW = 8;
constexpr int LDS_BYTES = 147456, MISC_OFF = 147456 - 512;

#define XB_TMO      128
#define XB_XCNT(j)  (256  + 64 * (j))
#define XB_XSUB(j)  (1280 + 64 * (j))
#define XB_XGEN(j)  (2304 + 64 * (j))
#define XB_TOP      3328
#define XB_TOPGEN   3392
#define XCD_BAR_WORDS 3456
#define XB_SPIN_CAP (1u << 22)
__device__ __forceinline__ unsigned xb_ld(unsigned* p)              { return __hip_atomic_load(p, __ATOMIC_RELAXED, __HIP_MEMORY_SCOPE_AGENT); }
__device__ __forceinline__ unsigned xb_add(unsigned* p, unsigned v) { return __hip_atomic_fetch_add(p, v, __ATOMIC_RELAXED, __HIP_MEMORY_SCOPE_AGENT); }
__device__ __forceinline__ unsigned xb_xcc_id() { return (unsigned)__builtin_amdgcn_s_getreg((3 << 11) | 20) & 0xFu; }
#define XB_SPIN(cond, bar) do { unsigned _sp = 0; while (cond) { __builtin_amdgcn_s_sleep(1); \
    if ((++_sp & 255u) == 0u) { if (xb_ld(&(bar)[XB_TMO])) break; if (_sp > XB_SPIN_CAP) { atomicAdd(&(bar)[XB_TMO], 1u); break; } } } } while (0)
struct XcdBarrier { unsigned* bar; unsigned x; volatile LAS unsigned* st; };
__device__ __forceinline__ XcdBarrier xcd_barrier_post(unsigned* bar, volatile LAS unsigned* st) {
    XcdBarrier b; b.bar = bar; b.x = xb_xcc_id(); b.st = st;
    if (threadIdx.x == 0) (void)xb_add(&bar[XB_XCNT(b.x)], 1u);
    return b;
}
__device__ __forceinline__ void xcd_barrier_complete(unsigned* bar, unsigned x, unsigned& nloc, unsigned& nx) {
    const unsigned G = gridDim.x * gridDim.y * gridDim.z;
    unsigned sum, cnt, mine, sp = 0u;
    for (;;) {
        sum = 0u; cnt = 0u; mine = 0u;
#pragma unroll
        for (unsigned j = 0; j < 16; ++j) { const unsigned c = xb_ld(&bar[XB_XCNT(j)]); sum += c; cnt += (c > 0u) ? 1u : 0u; mine = (j == x) ? c : mine; }
        if (sum == G) break;
        __builtin_amdgcn_s_sleep(1);
        if ((++sp & 255u) == 0u) { if (xb_ld(&bar[XB_TMO])) break; if (sp > XB_SPIN_CAP) { atomicAdd(&bar[XB_TMO], 1u); break; } }
    }
    nloc = mine > 0u ? mine : 1u; nx = cnt > 0u ? cnt : 1u;
}
__device__ __forceinline__ void xcd_barrier(const XcdBarrier& b) {
    asm volatile("s_waitcnt vmcnt(0)" ::: "memory");
    __syncthreads();
    if (threadIdx.x == 0) {
        unsigned* bar = b.bar;
        __builtin_amdgcn_s_waitcnt(0);
        unsigned nloc = b.st[0], nx = b.st[1];
        if (nloc == 0u) { xcd_barrier_complete(bar, b.x, nloc, nx); b.st[0] = nloc; b.st[1] = nx; }
        const unsigned old = xb_add(&bar[XB_XSUB(b.x)], 1u);
        const unsigned gen = old / nloc;
        if (old + 1u == (gen + 1u) * nloc) {
            __builtin_amdgcn_fence(__ATOMIC_RELEASE, "agent");
            asm volatile("s_waitcnt vmcnt(0)" ::: "memory");
            const unsigned og = xb_add(&bar[XB_TOP], 1u);
            const unsigned tg = og / nx;
            if (og + 1u == (tg + 1u) * nx) xb_add(&bar[XB_TOPGEN], 1u);
            else XB_SPIN(xb_ld(&bar[XB_TOPGEN]) == tg, bar);
            __builtin_amdgcn_fence(__ATOMIC_ACQUIRE, "agent");
            xb_add(&bar[XB_XGEN(b.x)], 1u);
            asm volatile("s_waitcnt vmcnt(0)" ::: "memory");
        } else {
            XB_SPIN(xb_ld(&bar[XB_XGEN(b.x)]) == gen, bar);
            __builtin_amdgcn_fence(__ATOMIC_ACQUIRE, "agent");
            asm volatile("s_waitcnt vmcnt(0)" ::: "memory");
        }
    }
    __syncthreads();
}

__device__ __forceinline__ int tidf() { int t = threadIdx.x; asm volatile("" : "+v"(t)); return t; }
__device__ __forceinline__ float wsum(float v) {
#pragma unroll
    for (int o = 1; o < 64; o <<= 1) v += __shfl_xor(v, o);
    return v;
}
__device__ __forceinline__ float sigmoidf_(float x) { return 1.f / (1.f + expf(-x)); }
__device__ __forceinline__ float fsigmoid(float x) { return __builtin_amdgcn_rcpf(1.f + __expf(-x)); }

__device__ __forceinline__ void ph_ln(const float* a, const float* b, const float* g, const float* beta, float* y, float scale) {
    const int lane = tidf() & 63, gw = blockIdx.x * NW + (tidf() >> 6), ngw = gridDim.x * NW;
    for (int row = gw; row < T; row += ngw) {
        float v[16]; float s = 0.f;
#pragma unroll
        for (int j = 0; j < 16; ++j) { const int c = lane + 64 * j; float x = a[(size_t)row * D + c] * scale; if (b) x += b[(size_t)row * D + c]; v[j] = x; s += x; }
        const float mu = wsum(s) * (1.f / D); float q = 0.f;
#pragma unroll
        for (int j = 0; j < 16; ++j) { const float d = v[j] - mu; q += d * d; }
        const float rstd = rsqrtf(wsum(q) * (1.f / D) + LN_EPS);
#pragma unroll
        for (int j = 0; j < 16; ++j) { const int c = lane + 64 * j; y[(size_t)row * D + c] = (v[j] - mu) * rstd * g[c] + beta[c]; }
    }
}
struct EpiPlain { static constexpr bool PAIR = false; float* C; int ldc; float scale;
    __device__ void operator()(int m, int n, float v, int z) const { C[(size_t)m * ldc + n] = v * scale; } };
struct EpiPoolMix { static constexpr bool PAIR = false; float* C; const float* b; const float* ls;
    __device__ void operator()(int m, int n, float v, int z) const { const int c = z * 128 + n; C[(size_t)m * 512 + c] = (v + b[c]) * ls[c]; } };
struct EpiHead { static constexpr bool PAIR = false; float* C; float scale;
    __device__ void operator()(int m, int n, float v, int z) const { C[(size_t)m * 1024 + z * 256 + n] = v * scale; } };
struct EpiE1 { static constexpr bool PAIR = true; float* act; const float* b1;
    __device__ void pair(int m, int n, float vg, float vl, int z) const {
        float g = vg + b1[z * 2048 + n], l = vl + b1[z * 2048 + n + 1];
        g = fminf(g, 7.f); l = fminf(fmaxf(l, -7.f), 7.f);
        act[(size_t)m * 1024 + (n >> 1)] = g * sigmoidf_(1.702f * g) * (l + 1.f); } };
struct EpiE2 { static constexpr bool PAIR = false; float* Y; const float* b2;
    __device__ void operator()(int m, int n, float v, int z) const { Y[(size_t)m * 1024 + n] = v + b2[z * 1024 + n]; } };

template <class Epi>
__device__ __forceinline__ void ph_gemm(LAS float* lds, const float* A, const int* rowidx, const float* B, const int* mcount, const int* mstart,
                                        size_t strideA, size_t strideB, const Epi& epi, int lda, int ldb, int M, int N, int K, int nz, int vb0, int nvb) {
    LAS float* As = lds;
    LAS float* Bs = lds + 16 * 129;
    const int tid = tidf(), tx = tid & 15, ty = tid >> 4;
    const int ntn = (N + 63) / 64, ntm = (M + 127) / 128, per_z = ntn * ntm, total = per_z * nz;
    for (int vt = vb0; vt < total; vt += nvb) {
        const int z = vt / per_z, r = vt % per_z, bm = (r / ntn) * 128, bn = (r % ntn) * 64;
        int Mz = M, m0g = 0;
        if (mcount) { Mz = mcount[z]; m0g = mstart[z]; }
        if (bm >= Mz) continue;
        const float* Az = A + z * strideA; const float* Bz = B + z * strideB;
        float acc[4][4] = {};
        const int ar = tid >> 2, ak = (tid & 3) * 4;
        const int arow = bm + ar; const bool aval = arow < Mz; int asrc = 0;
        if (aval) { const int gr = m0g + arow; asrc = rowidx ? rowidx[gr] : gr; }
        const int bk = tid >> 5, bn2 = (tid & 31) * 2;
        for (int k0 = 0; k0 < K; k0 += 16) {
            float4 av = make_float4(0.f, 0.f, 0.f, 0.f);
            if (aval) av = *(const float4*)(Az + (size_t)asrc * lda + k0 + ak);
            As[(ak + 0) * 129 + ar] = av.x; As[(ak + 1) * 129 + ar] = av.y; As[(ak + 2) * 129 + ar] = av.z; As[(ak + 3) * 129 + ar] = av.w;
#pragma unroll
            for (int j = 0; j < 2; ++j) { const int n = bn + bn2 + j; Bs[bk * 65 + bn2 + j] = (n < N) ? Bz[(size_t)(k0 + bk) * ldb + n] : 0.f; }
            __syncthreads();
#pragma unroll
            for (int kk = 0; kk < 16; ++kk) {
                float a[4], b[4];
#pragma unroll
                for (int i = 0; i < 4; ++i) { a[i] = As[kk * 129 + ty * 4 + i]; b[i] = Bs[kk * 65 + tx * 4 + i]; }
#pragma unroll
                for (int i = 0; i < 4; ++i)
#pragma unroll
                    for (int j = 0; j < 4; ++j) acc[i][j] += a[i] * b[j];
            }
            __syncthreads();
        }
#pragma unroll
        for (int i = 0; i < 4; ++i) { const int m = bm + ty * 4 + i; if (m >= Mz) continue;
            if constexpr (Epi::PAIR) {
#pragma unroll
                for (int j = 0; j < 4; j += 2) { const int n = bn + tx * 4 + j; if (n < N) epi.pair(m0g + m, n, acc[i][j], acc[i][j + 1], z); }
            } else {
#pragma unroll
                for (int j = 0; j < 4; ++j) { const int n = bn + tx * 4 + j; if (n < N) epi(m0g + m, n, acc[i][j], z); }
            } }
    }
}
__device__ __forceinline__ void ph_pool_conv(const float* proj, const float* cw, const float* cb, float* pooled, float* uc) {
    const size_t gt = (size_t)blockIdx.x * NT + tidf(), ngt = (size_t)gridDim.x * NT;
    for (size_t i = gt; i < (size_t)T * 512; i += ngt) {
        const int c = (int)(i % 512); const int tg = (int)(i / 512); const int t = tg % SEQ;
        const int w = 2 << (c >> 7);
        const int cnt = (t + 1 < w) ? t + 1 : w; float s = 0.f;
        for (int j = 0; j < cnt; ++j) s += proj[(size_t)(tg - j) * INC + C_P + c];
        pooled[i] = s / (float)cnt - proj[(size_t)tg * INC + C_P + c];
    }
    for (size_t i = gt; i < (size_t)T * 1024; i += ngt) {
        const int c = (int)(i % 1024); const int tg = (int)(i / 1024); const int t = tg % SEQ;
        float y = cb[c];
#pragma unroll
        for (int j = 0; j < 4; ++j) { const int tt = t - 3 + j; if (tt >= 0) y += proj[(size_t)(tg - 3 + j) * INC + C_U + c] * cw[j * 1024 + c]; }
        uc[i] = y * sigmoidf_(y);
    }
}
constexpr int MB = 16;
__device__ __forceinline__ void ph_mlstm(LAS float* lds, int vb, const float* q, const float* k, const float* vv, const float* gif, float* hm) {
    const int bh = vb >> 1, b = bh >> 2, h = bh & 3;
    const int tid = tidf(), e = (vb & 1) * 128 + (tid >> 2), dq = tid & 3;
    LAS float* sq = lds; LAS float* sk = lds + MB * 256; LAS float* sv = lds + 2 * MB * 256; LAS float* si = lds + 3 * MB * 256; LAS float* sf = si + MB;
    float C[64]; float n[16];
#pragma unroll
    for (int j = 0; j < 64; ++j) C[j] = 0.f;
#pragma unroll
    for (int j = 0; j < 16; ++j) n[j] = 0.f;
    float m = 0.f;
    const int nsub = (e & 3) * 16;
    for (int t0 = 0; t0 < SEQ; t0 += MB) {
        __syncthreads();
        for (int i = tid; i < MB * 256; i += NT) { const int tt = i >> 8, d = i & 255; const size_t tg = (size_t)b * SEQ + t0 + tt;
            sq[tt * 256 + d] = q[tg * 1024 + h * 256 + d]; sk[tt * 256 + d] = k[tg * 1024 + h * 256 + d]; sv[tt * 256 + d] = vv[tg * 1024 + h * 256 + d]; }
        if (tid < MB) { const size_t tg = (size_t)b * SEQ + t0 + tid; si[tid] = gif[tg * 8 + h]; sf[tid] = gif[tg * 8 + 4 + h]; }
        __syncthreads();
        for (int tt = 0; tt < MB; ++tt) {
            const float ip = si[tt], fp = sf[tt];
            const float lf = fminf(fp, 0.f) - log1pf(expf(-fabsf(fp)));
            const float mn = fmaxf(lf + m, ip);
            const float fd = expf(lf + m - mn), iw = expf(ip - mn);
            m = mn;
            const float ve = sv[tt * 256 + e] * iw;
            float num = 0.f, den = 0.f;
#pragma unroll
            for (int j = 0; j < 64; ++j) { const float kk = sk[tt * 256 + dq * 64 + j]; C[j] = fd * C[j] + ve * kk; num += C[j] * sq[tt * 256 + dq * 64 + j]; }
#pragma unroll
            for (int j = 0; j < 16; ++j) { const int d = dq * 64 + nsub + j; n[j] = fd * n[j] + iw * sk[tt * 256 + d]; den += n[j] * sq[tt * 256 + d]; }
            num += __shfl_xor(num, 1); num += __shfl_xor(num, 2);
            den += __shfl_xor(den, 1); den += __shfl_xor(den, 2); den += __shfl_xor(den, 4); den += __shfl_xor(den, 8);
            if (dq == 0) { const float dn = fmaxf(fabsf(den), expf(-mn)); hm[((size_t)b * SEQ + t0 + tt) * 1024 + h * 256 + e] = num / dn; }
        }
    }
    __syncthreads();
}
__device__ __forceinline__ void ph_hnorm(float* hm, const float* opre, const float* gain) {
    const int lane = tidf() & 63, gw = blockIdx.x * NW + (tidf() >> 6), ngw = gridDim.x * NW;
    for (int w = gw; w < T * 4; w += ngw) {
        const int tg = w >> 2, h = w & 3;
        float v[4]; float s = 0.f;
#pragma unroll
        for (int j = 0; j < 4; ++j) { v[j] = hm[(size_t)tg * 1024 + h * 256 + lane + 64 * j]; s += v[j]; }
        const float mu = wsum(s) * (1.f / 256); float qq = 0.f;
#pragma unroll
        for (int j = 0; j < 4; ++j) { const float d = v[j] - mu; qq += d * d; }
        const float rstd = rsqrtf(wsum(qq) * (1.f / 256) + LN_EPS);
#pragma unroll
        for (int j = 0; j < 4; ++j) { const int c = h * 256 + lane + 64 * j; hm[(size_t)tg * 1024 + c] = (v[j] - mu) * rstd * gain[c] * sigmoidf_(opre[(size_t)tg * 1024 + c]); }
    }
}
__device__ __forceinline__ void ph_merge(const float* gates, const float* ypool, float* ymls) {
    const size_t gt = (size_t)blockIdx.x * NT + tidf(), ngt = (size_t)gridDim.x * NT;
    for (size_t i = gt; i < (size_t)T * 1024; i += ngt) {
        const int c = (int)(i % 1024); const size_t tg = i / 1024;
        const float g0 = sigmoidf_(gates[tg * 2048 + c]), g1 = sigmoidf_(gates[tg * 2048 + 1024 + c]);
        ymls[i] = g0 * ypool[i] + g1 * ymls[i];
    }
}
__device__ __forceinline__ void ph_router(const float* h1, const float* wr, const float* br, int* top_idx, float* top_gate, int* cnt) {
    const int lane = tidf() & 63, gw = blockIdx.x * NW + (tidf() >> 6), ngw = gridDim.x * NW;
    for (int tg = gw; tg < T; tg += ngw) {
        const int e = lane & 31, half = lane >> 5;
        float s = 0.f;
        for (int kk = 0; kk < 512; ++kk) { const int kx = half * 512 + kk; s += h1[(size_t)tg * D + kx] * wr[kx * NE + e]; }
        s += __shfl_xor(s, 32); s += br[e];
        float val = s; int idxs[4]; float vals[4];
#pragma unroll
        for (int r = 0; r < 4; ++r) {
            float bv = val; int bi = e;
#pragma unroll
            for (int o = 1; o < 32; o <<= 1) { const float ov = __shfl_xor(bv, o); const int oi = __shfl_xor(bi, o); if (ov > bv || (ov == bv && oi < bi)) { bv = ov; bi = oi; } }
            idxs[r] = bi; vals[r] = bv; if (e == bi) val = -INFINITY;
        }
        const float mx = vals[0]; float ex[4], se = 0.f;
#pragma unroll
        for (int r = 0; r < 4; ++r) { ex[r] = expf(vals[r] - mx); se += ex[r]; }
#pragma unroll
        for (int r = 0; r < 4; ++r) if (lane == r) { top_idx[tg * 4 + r] = idxs[r]; top_gate[tg * 4 + r] = ex[r] / se; atomicAdd(&cnt[idxs[r]], 1); }
    }
}
__device__ __forceinline__ void ph_place(const int* top_idx, const int* start, int* fill, int* row_tok, int* row_of) {
    const int gt = blockIdx.x * NT + tidf(), ngt = gridDim.x * NT;
    for (int i = gt; i < NA; i += ngt) { const int e = top_idx[i]; const int r = atomicAdd(&fill[e], 1); const int dest = start[e] + r; row_tok[dest] = i >> 2; row_of[i] = dest; }
}
__device__ __forceinline__ void ph_final(const float* h1, const float* Y, const int* row_of, const float* gate, const float* g, const float* beta, float* out) {
    const int lane = tidf() & 63, gw = blockIdx.x * NW + (tidf() >> 6), ngw = gridDim.x * NW;
    for (int tg = gw; tg < T; tg += ngw) {
        int ro[4]; float gt[4];
#pragma unroll
        for (int r = 0; r < 4; ++r) { ro[r] = row_of[tg * 4 + r]; gt[r] = gate[tg * 4 + r]; }
        float v[16]; float s = 0.f;
#pragma unroll
        for (int j = 0; j < 16; ++j) { const int c = lane + 64 * j; float x = ALPHA * h1[(size_t)tg * D + c];
#pragma unroll
            for (int r = 0; r < 4; ++r) x += gt[r] * Y[(size_t)ro[r] * 1024 + c];
            v[j] = x; s += x; }
        const float mu = wsum(s) * (1.f / D); float qq = 0.f;
#pragma unroll
        for (int j = 0; j < 16; ++j) { const float d = v[j] - mu; qq += d * d; }
        const float rstd = rsqrtf(wsum(qq) * (1.f / D) + LN_EPS);
#pragma unroll
        for (int j = 0; j < 16; ++j) { const int c = lane + 64 * j; out[(size_t)tg * D + c] = (v[j] - mu) * rstd * g[c] + beta[c]; }
    }
}


namespace pg {
typedef unsigned short bf16_t;
typedef short bf16x8 __attribute__((ext_vector_type(8)));
typedef float f32x4 __attribute__((ext_vector_type(4)));
typedef float f32x2 __attribute__((ext_vector_type(2)));
typedef unsigned u32x4 __attribute__((ext_vector_type(4)));
typedef unsigned u32x2 __attribute__((ext_vector_type(2)));
constexpr int BM = 256, BK = 64, HALF = 128, HTB = HALF * BK * 2, STAGE_BYTES = 8 * HTB, NXCD = 8, WGM = 8;
__host__ __device__ __forceinline__ int lds_byte(int r, int c) { const int st = (r >> 4) * 2 + (c >> 5), rr = r & 15, cc = c & 31, ob = rr * 64 + cc * 2; return st * 1024 + (ob ^ (((ob >> 9) & 1) << 5)); }
__host__ __device__ __forceinline__ void stage_rc(int b, int& R, int& C) { const int st = b / 1024, sb = b % 1024, swz = sb ^ (((sb >> 9) & 1) << 5); R = (st >> 1) * 16 + swz / 64; C = (st & 1) * 32 + (swz % 64) / 2; }
__host__ __device__ __forceinline__ int perm32(int rho) { const int n = rho >> 4, i = rho & 15; return 8 * (i >> 2) + 4 * n + (i & 3); }
__device__ __forceinline__ unsigned cvt_pk_bf16(float lo, float hi) { unsigned r; asm volatile("v_cvt_pk_bf16_f32 %0, %1, %2" : "=v"(r) : "v"(lo), "v"(hi)); return r; }

struct Unit { const char* A; const char* B; const int* rows; int nvalid; int pm, pn, g, aux; };

struct TileOrder {
    int nM, nN, per_g, nwg, G, c;
    __device__ __forceinline__ void init(int nM_, int nN_, int ng, int G_, int c_) { nM = nM_; nN = nN_; per_g = nM * nN; nwg = per_g * ng; G = G_; c = c_; }
    __device__ __forceinline__ bool tile(int i, int& g, int& pm, int& pn) const {
        const long L = (long)i * G + c; if (L >= nwg) return false;
        int wgid = (int)L; { const int q = nwg / NXCD, r = nwg % NXCD, xcd = wgid % NXCD, off = wgid / NXCD; wgid = (xcd < r ? xcd * (q + 1) : r * (q + 1) + (xcd - r) * q) + off; }
        g = wgid / per_g; wgid -= g * per_g;
        const int nig = WGM * nN, gid = wgid / nig, fm = gid * WGM, gsz = (nM - fm) < WGM ? (nM - fm) : WGM;
        pm = fm + ((wgid % nig) % gsz); pn = (wgid % nig) / gsz; return true;
    }
};

typedef int i32x8 __attribute__((ext_vector_type(8)));
typedef int i32x4 __attribute__((ext_vector_type(4)));
template <class Epi, class Sched, bool GATHER = false, bool FP8 = false>
__device__ __forceinline__ void gemm_phase(LAS unsigned char* lds, const int lda, const int ldb, const int K, const Sched& S, const Epi& E) {
    const int tid = tidf(), wid = __builtin_amdgcn_readfirstlane(tid >> 6), lane = tid & 63, wr = wid >> 2, wc = wid & 3, fr = lane & 15, fq = lane >> 4;
    const int nt = K / BK;
    unsigned voffA[2], voffB[2];
#pragma unroll
    for (int i = 0; i < 2; ++i) { int R, C; stage_rc(tid * 16 + i * 8192, R, C); const int Rb = Epi::PERM ? ((R & ~31) + perm32(R & 31)) : R;
        voffA[i] = (unsigned)(R * lda + C) * 2u; voffB[i] = (unsigned)(Rb * ldb + C) * 2u; }
    const size_t kstep = (size_t)(BK * 2);
    const size_t hstepA = GATHER ? 0 : (size_t)HALF * lda * 2, hstepB = (size_t)HALF * ldb * 2;
    const unsigned ldsw = (unsigned)wid * 1024u;
    const int aoff = lds_byte(wr * 64 + fr, fq * 8), boff = lds_byte(wc * 32 + fr, fq * 8);
#define PG_SA(b, h) (((b) * 2 + (h)) * HTB)
#define PG_SB(b, h) ((4 + (b) * 2 + (h)) * HTB)
#define PG_STAGE(bufoff, gbase, voff) do { _Pragma("unroll") for (int _i = 0; _i < 2; ++_i) \
        __builtin_amdgcn_global_load_lds((const unsigned*)((const char*)(gbase) + (voff)[_i]), (LAS unsigned*)(lds + (bufoff) + ldsw + _i * 8192), 16, 0, 0); } while (0)
#define PG_LDA(dst, b, h) do { _Pragma("unroll") for (int m = 0; m < 4; ++m) { if constexpr (FP8) { \
        const i32x4 _lo = *(const LAS i32x4*)(lds + PG_SA(b, h) + aoff + m * 2048), _hi = *(const LAS i32x4*)(lds + PG_SA(b, h) + aoff + m * 2048 + 1024); \
        dst##8[m] = __builtin_shufflevector(_lo, _hi, 0, 1, 2, 3, 4, 5, 6, 7); } \
        else { _Pragma("unroll") for (int k = 0; k < 2; ++k) dst[m][k] = *(const LAS bf16x8*)(lds + PG_SA(b, h) + aoff + m * 2048 + k * 1024); } } } while (0)
#define PG_LDB(dst, b, h) do { _Pragma("unroll") for (int n = 0; n < 2; ++n) { if constexpr (FP8) { \
        const i32x4 _lo = *(const LAS i32x4*)(lds + PG_SB(b, h) + boff + n * 2048), _hi = *(const LAS i32x4*)(lds + PG_SB(b, h) + boff + n * 2048 + 1024); \
        dst##8[n] = __builtin_shufflevector(_lo, _hi, 0, 1, 2, 3, 4, 5, 6, 7); } \
        else { _Pragma("unroll") for (int k = 0; k < 2; ++k) dst[n][k] = *(const LAS bf16x8*)(lds + PG_SB(b, h) + boff + n * 2048 + k * 1024); } } } while (0)
#define PG_MMA(ai, bj, At, Bt) do { __builtin_amdgcn_s_setprio(1); _Pragma("unroll") for (int m = 0; m < 4; ++m) _Pragma("unroll") for (int n = 0; n < 2; ++n) { \
        if constexpr (FP8) asm volatile("v_mfma_scale_f32_16x16x128_f8f6f4 %0, %1, %2, %0, %3, %4 op_sel_hi:[0,0,0]" : "+v"(acc[ai][bj][m][n]) : "v"(Bt##8[n]), "v"(At##8[m]), "v"(sc_w), "v"(sc_a)); \
        else { _Pragma("unroll") for (int k = 0; k < 2; ++k) acc[ai][bj][m][n] = __builtin_amdgcn_mfma_f32_16x16x32_bf16(Bt[n][k], At[m][k], acc[ai][bj][m][n], 0, 0, 0); } } \
        __builtin_amdgcn_s_setprio(0); } while (0)
#define PG_WAIT_V(n) asm volatile("s_waitcnt vmcnt(" #n ")" ::: "memory")
#define PG_WAIT_L(n) asm volatile("s_waitcnt lgkmcnt(" #n ")" ::: "memory")
#define PG_BAR __builtin_amdgcn_s_barrier()
#define PG_SCHED __builtin_amdgcn_sched_barrier(0)
    Unit cur, nxt; int ui = 0;
    if (!S.next(0, cur)) return;
    f32x4 acc[2][2][4][2];
    f32x4 bini[2][2];
#pragma unroll
    for (int b = 0; b < 2; ++b)
#pragma unroll
        for (int n = 0; n < 2; ++n) bini[b][n] = (f32x4){0.f, 0.f, 0.f, 0.f};
    if constexpr (Epi::BIAS) { const float* bp = E.bias_base(cur) + wc * 32 + (Epi::PERM ? 8 * fq : 4 * fq);
#pragma unroll
        for (int b = 0; b < 2; ++b)
#pragma unroll
            for (int n = 0; n < 2; ++n) bini[b][n] = *(const f32x4*)(bp + b * HALF + (Epi::PERM ? 4 * n : 16 * n)); }
#pragma unroll
    for (int a = 0; a < 2; ++a)
#pragma unroll
        for (int b = 0; b < 2; ++b)
#pragma unroll
            for (int m = 0; m < 4; ++m)
#pragma unroll
                for (int n = 0; n < 2; ++n) acc[a][b][m][n] = bini[b][n];
    bf16x8 At[4][2], B0[2][2], B1[2][2]; i32x8 At8[4], B08[2], B18[2]; const int sc_w = 0x79797979, sc_a = 0x7f7f7f7f;
    unsigned gA0[2], gA1[2], nA0[2], nA1[2];
    auto gather_offs = [&](const Unit& u, unsigned (&o0)[2], unsigned (&o1)[2]) {
#pragma unroll
        for (int i = 0; i < 2; ++i) { int R_, C_; stage_rc(tid * 16 + i * 8192, R_, C_);
            const int r0 = R_, r1 = HALF + R_;
            const int t0 = (r0 < u.nvalid) ? u.rows[r0] : 0, t1 = (r1 < u.nvalid) ? u.rows[r1] : 0;
            o0[i] = (unsigned)(t0 * lda + C_) * 2u; o1[i] = (unsigned)(t1 * lda + C_) * 2u; }
    };
    if constexpr (GATHER) { gather_offs(cur, gA0, gA1); } else {
#pragma unroll
        for (int i = 0; i < 2; ++i) { gA0[i] = voffA[i]; gA1[i] = voffA[i]; nA0[i] = voffA[i]; nA1[i] = voffA[i]; } }
    const char* cA = cur.A; const char* cB = cur.B;
    PG_STAGE(PG_SB(0, 0), cB, voffB); PG_STAGE(PG_SB(0, 1), cB + hstepB, voffB); PG_STAGE(PG_SA(0, 0), cA, gA0); PG_STAGE(PG_SA(0, 1), cA + hstepA, gA1);
    if (wr == 1) PG_BAR;
    PG_WAIT_V(2); PG_BAR;
    PG_STAGE(PG_SB(1, 0), cB + kstep, voffB); PG_STAGE(PG_SA(1, 0), cA + kstep, gA0); PG_STAGE(PG_SB(1, 1), cB + hstepB + kstep, voffB);
    PG_WAIT_V(6); PG_BAR;
    for (;;) {
        const bool has_next = S.next(ui + 1, nxt);
        const char* nA = has_next ? nxt.A : cA; const char* nB = has_next ? nxt.B : cB;
        if constexpr (GATHER) { if (has_next) gather_offs(nxt, nA0, nA1); else {
#pragma unroll
            for (int i = 0; i < 2; ++i) { nA0[i] = gA0[i]; nA1[i] = gA1[i]; } } }
#pragma unroll 1
        for (int t = 0; t < nt; t += 2) {
            const bool last = (t == nt - 2);
            const char* a1 = cA + (size_t)(t + 1) * kstep;
            const char* a2 = last ? nA : cA + (size_t)(t + 2) * kstep; const char* b2 = last ? nB : cB + (size_t)(t + 2) * kstep;
            const char* a3 = a2 + kstep; const char* b3 = b2 + kstep;
            unsigned x0[2], x1[2];
#pragma unroll
            for (int i = 0; i < 2; ++i) { x0[i] = (GATHER && last) ? nA0[i] : gA0[i]; x1[i] = (GATHER && last) ? nA1[i] : gA1[i]; }
            PG_LDB(B0, 0, 0); PG_LDB(B1, 0, 1); PG_SCHED; PG_LDA(At, 0, 0); PG_STAGE(PG_SA(1, 1), a1 + hstepA, gA1);
            PG_WAIT_V(8); PG_WAIT_L(0); PG_BAR; PG_MMA(0, 0, At, B0); PG_MMA(0, 1, At, B1); PG_BAR; PG_SCHED;
            PG_LDA(At, 0, 1); PG_STAGE(PG_SB(0, 0), b2, voffB); PG_STAGE(PG_SB(0, 1), b2 + hstepB, voffB); PG_STAGE(PG_SA(0, 0), a2, x0);
            PG_WAIT_V(8); PG_WAIT_L(0); PG_BAR; PG_MMA(1, 0, At, B0); PG_MMA(1, 1, At, B1); PG_BAR; PG_SCHED;
            PG_LDB(B0, 1, 0); PG_LDB(B1, 1, 1); PG_SCHED; PG_LDA(At, 1, 0); PG_STAGE(PG_SA(0, 1), a2 + hstepA, x1);
            PG_WAIT_V(8); PG_WAIT_L(0); PG_BAR; PG_MMA(0, 0, At, B0); PG_MMA(0, 1, At, B1); PG_BAR; PG_SCHED;
            PG_LDA(At, 1, 1); PG_STAGE(PG_SB(1, 0), b3, voffB); PG_STAGE(PG_SB(1, 1), b3 + hstepB, voffB); PG_STAGE(PG_SA(1, 0), a3, x0);
            PG_WAIT_V(8); PG_WAIT_L(0); PG_BAR; PG_MMA(1, 0, At, B0); PG_MMA(1, 1, At, B1); PG_BAR; PG_SCHED;
        }
        if (wr == 0) PG_BAR;
        if constexpr (FP8) asm volatile("s_nop 15\n\ts_nop 15" ::: "memory");
        if constexpr (Epi::BIAS && !GATHER) { if (has_next) { const float* bp = E.bias_base(nxt) + wc * 32 + (Epi::PERM ? 8 * fq : 4 * fq);
#pragma unroll
            for (int b = 0; b < 2; ++b)
#pragma unroll
                for (int n = 0; n < 2; ++n) bini[b][n] = *(const f32x4*)(bp + b * HALF + (Epi::PERM ? 4 * n : 16 * n)); } }
        if constexpr (!Epi::AFTER_DRAIN) { E(acc, cur, wr, wc, fr, fq); }
        if (!has_next) break;
        if constexpr (Epi::BIAS && GATHER) { const float* bp = E.bias_base(nxt) + wc * 32 + (Epi::PERM ? 8 * fq : 4 * fq);
#pragma unroll
            for (int b = 0; b < 2; ++b)
#pragma unroll
                for (int n = 0; n < 2; ++n) bini[b][n] = *(const f32x4*)(bp + b * HALF + (Epi::PERM ? 4 * n : 16 * n)); }
#pragma unroll
        for (int a = 0; a < 2; ++a)
#pragma unroll
            for (int b = 0; b < 2; ++b)
#pragma unroll
                for (int m = 0; m < 4; ++m)
#pragma unroll
                    for (int n = 0; n < 2; ++n) acc[a][b][m][n] = bini[b][n];
        cur = nxt; cA = nA; cB = nB; ++ui;
        if constexpr (GATHER) {
#pragma unroll
            for (int i = 0; i < 2; ++i) { gA0[i] = nA0[i]; gA1[i] = nA1[i]; } }
        if (wr == 1) PG_BAR;
    }
    PG_WAIT_V(0);
    PG_BAR;
    if constexpr (Epi::AFTER_DRAIN) { E.fused(acc, cur, wr, wc, fr, fq, lds, wid, lane); }
#undef PG_SA
#undef PG_SB
#undef PG_STAGE
#undef PG_LDA
#undef PG_LDB
#undef PG_MMA
#undef PG_WAIT_V
#undef PG_WAIT_L
#undef PG_BAR
#undef PG_SCHED
}

struct EpiStoreBf16 {
    static constexpr bool PERM = true, AFTER_DRAIN = false, BIAS = false;
    bf16_t* O; int ldc; float scale; int gcol;
    __device__ __forceinline__ void operator()(const f32x4 (&acc)[2][2][4][2], const Unit& u, int wr, int wc, int fr, int fq) const {
        bf16_t* base = O + (size_t)(u.pm * BM + wr * 64 + fr) * ldc + u.g * gcol + u.pn * BM + wc * 32 + 8 * fq;
#pragma unroll
        for (int ai = 0; ai < 2; ++ai)
#pragma unroll
            for (int m = 0; m < 4; ++m) { bf16_t* rowp = base + (size_t)(ai * HALF + m * 16) * ldc;
#pragma unroll
                for (int bj = 0; bj < 2; ++bj) { const f32x4 v0 = acc[ai][bj][m][0] * scale, v1 = acc[ai][bj][m][1] * scale;
                    u32x4 w; w.x = cvt_pk_bf16(v0[0], v0[1]); w.y = cvt_pk_bf16(v0[2], v0[3]); w.z = cvt_pk_bf16(v1[0], v1[1]); w.w = cvt_pk_bf16(v1[2], v1[3]);
                    *(u32x4*)(rowp + bj * HALF) = w; } }
    }
};
}

constexpr int PROJW = 4608;
constexpr int PJ_P = 0, PJ_U = 512, PJ_O = 1536, PJ_G = 2560;
constexpr int WIN_ROWS = 5632;

__device__ __forceinline__ unsigned f2bf(float f) { unsigned u = __builtin_bit_cast(unsigned, f); return (u + 0x7fffu + ((u >> 16) & 1u)) >> 16; }
__device__ __forceinline__ unsigned pk2(float lo, float hi) { return f2bf(lo) | (f2bf(hi) << 16); }
__device__ __forceinline__ float bf2f(unsigned short b) { return __builtin_bit_cast(float, (unsigned)b << 16); }

struct TItem { const float* src; pg::bf16_t* dst; int ldw, ldt, inter, valid, fp8; };
__device__ __forceinline__ void titem_load(const TItem& it, pg::f32x4 (&r)[16], int lane) {
    const float* src = it.src + (size_t)(lane >> 4) * it.ldw + 4 * (lane & 15);
#pragma unroll
    for (int i = 0; i < 16; ++i) r[i] = *(const pg::f32x4*)(src + (size_t)(4 * i) * it.ldw);
}
__device__ __forceinline__ void titem_store(const TItem& it, const pg::f32x4 (&r)[16], LAS float* scr, int lane) {
#pragma unroll
    for (int i = 0; i < 16; ++i) { const int k = (lane >> 4) + 4 * i; LAS float* d = scr + (4 * (lane & 15)) * 65 + k;
        d[0] = r[i].x; d[65] = r[i].y; d[130] = r[i].z; d[195] = r[i].w; }
    asm volatile("s_waitcnt lgkmcnt(0)" ::: "memory");
#pragma unroll
    for (int itr = 0; itr < 8; ++itr) { const int nl = (lane >> 3) + 8 * itr, kg = lane & 7; const LAS float* p = scr + nl * 65 + 8 * kg;
        const size_t drow = it.inter ? (size_t)(nl & 1) * 128 + (nl >> 1) : (size_t)nl;
        if (it.fp8) { int w0 = __builtin_amdgcn_cvt_pk_fp8_f32(p[0] * 64.f, p[1] * 64.f, 0, false); w0 = __builtin_amdgcn_cvt_pk_fp8_f32(p[2] * 64.f, p[3] * 64.f, w0, true);
            int w1 = __builtin_amdgcn_cvt_pk_fp8_f32(p[4] * 64.f, p[5] * 64.f, 0, false); w1 = __builtin_amdgcn_cvt_pk_fp8_f32(p[6] * 64.f, p[7] * 64.f, w1, true);
            *(pg::u32x2*)((unsigned char*)it.dst + drow * it.ldt + 8 * kg) = (pg::u32x2){(unsigned)w0, (unsigned)w1}; }
        else { pg::u32x4 o; o.x = pk2(p[0], p[1]); o.y = pk2(p[2], p[3]); o.z = pk2(p[4], p[5]); o.w = pk2(p[6], p[7]);
            *(pg::u32x4*)(it.dst + drow * it.ldt + 8 * kg) = o; } }
    asm volatile("s_waitcnt lgkmcnt(0)" ::: "memory");
}
__device__ __forceinline__ int win_src_col(int r) { return r < 1536 ? r : (r < 2560 ? r + 1024 : (r < 4608 ? r - 2560 + C_G : r - 4608 + C_V)); }

struct OptBufs {
    pg::bf16_t *WinT, *H0B, *PROJ, *BT2; unsigned char *WinQ, *H0Q;
    float *gif, *stats;
};
__device__ __forceinline__ void ph_ln0(LAS unsigned char* lds, const OptBufs& o, const float* x, const float* g, const float* beta, const float* w_in, const float* b_if) {
    const int tid = tidf(), lane = tid & 63, wave = tid >> 6, gw = blockIdx.x * NW + wave, ngw = gridDim.x * NW;
    LAS float* wif = (LAS float*)lds;
    __syncthreads();
    for (int i = tid; i < 1024 * 8; i += NT) wif[(i & 7) * 1024 + (i >> 3)] = w_in[(size_t)(i >> 3) * INC + C_IF + (i & 7)];
    __syncthreads();
    for (int row = gw; row < T; row += ngw) {
        const pg::f32x4* xr = (const pg::f32x4*)(x + (size_t)row * D) + lane;
        pg::f32x4 v[4]; float s = 0.f;
#pragma unroll
        for (int j = 0; j < 4; ++j) { v[j] = xr[64 * j]; s += (v[j].x + v[j].y) + (v[j].z + v[j].w); }
        const float mean = wsum(s) * (1.f / D); float s2 = 0.f;
#pragma unroll
        for (int j = 0; j < 4; ++j) { v[j] = v[j] - mean; s2 += (v[j].x * v[j].x + v[j].y * v[j].y) + (v[j].z * v[j].z + v[j].w * v[j].w); }
        const float rstd = rsqrtf(wsum(s2) * (1.f / D) + LN_EPS);
        float acc8[8];
#pragma unroll
        for (int q = 0; q < 8; ++q) acc8[q] = 0.f;
        unsigned long long* o8 = (unsigned long long*)(o.H0B + (size_t)row * D) + lane;
#pragma unroll
        for (int j = 0; j < 4; ++j) {
            const int c0 = 256 * j + 4 * lane;
            const pg::f32x4 gg = *(const pg::f32x4*)(g + c0), bb = *(const pg::f32x4*)(beta + c0);
            const pg::f32x4 y = v[j] * rstd * gg + bb;
            o8[64 * j] = (unsigned long long)pk2(y.x, y.y) | ((unsigned long long)pk2(y.z, y.w) << 32);
            { int w0 = __builtin_amdgcn_cvt_pk_fp8_f32(y.x, y.y, 0, false); w0 = __builtin_amdgcn_cvt_pk_fp8_f32(y.z, y.w, w0, true); *(int*)(o.H0Q + (size_t)row * D + c0) = w0; }
#pragma unroll
            for (int q = 0; q < 8; ++q) { const pg::f32x4 w4 = *(const LAS pg::f32x4*)(wif + q * 1024 + c0); acc8[q] += (y.x * w4.x + y.y * w4.y) + (y.z * w4.z + y.w * w4.w); }
        }
#pragma unroll
        for (int q = 0; q < 8; ++q) acc8[q] = wsum(acc8[q]);
        if (lane < 8) { float r = acc8[0];
#pragma unroll
            for (int q = 1; q < 8; ++q) r = (lane == q) ? acc8[q] : r;
            o.gif[(size_t)row * 8 + lane] = r + b_if[lane]; }
        if (lane == 0) { o.stats[(size_t)row * 2] = mean; o.stats[(size_t)row * 2 + 1] = rstd; }
    }
    __syncthreads();
}
struct SchedInproj {
    pg::TileOrder o; const char* A; const char* B; size_t rowbytes;
    __device__ __forceinline__ bool next(int i, pg::Unit& u) const { int g, pm, pn; if (!o.tile(i, g, pm, pn)) return false;
        u.A = A + (size_t)pm * 256 * rowbytes; u.B = B + (size_t)pn * 256 * rowbytes; u.pm = pm; u.pn = pn; u.g = 0; u.aux = 0; u.rows = nullptr; u.nvalid = 0; return true; }
};
struct SchedVT {
    pg::TileOrder o; const char* A; const char* B;
    __device__ __forceinline__ bool next(int i, pg::Unit& u) const { int g, pm, pn; if (!o.tile(i, g, pm, pn)) return false;
        u.A = A + (size_t)pm * 256 * D * 2; u.B = B + (size_t)pn * 256 * D * 2; u.pm = pm; u.pn = pn; u.g = 0; u.aux = 0; u.rows = nullptr; u.nvalid = 0; return true; }
};
struct EpiVT {
    static constexpr bool PERM = true, AFTER_DRAIN = false, BIAS = false;
    pg::bf16_t* BT2;
    __device__ __forceinline__ void operator()(const pg::f32x4 (&acc)[2][2][4][2], const pg::Unit& u, int wr, int wc, int fr, int fq) const {
        const int h = u.pm, b = u.pn >> 4, c = u.pn & 15;
        pg::bf16_t* base = BT2 + ((size_t)((b * 4 + h) * 16 + c) * 256 + wr * 64 + fr) * 512 + wc * 32 + 8 * fq;
#pragma unroll
        for (int ai = 0; ai < 2; ++ai)
#pragma unroll
            for (int m = 0; m < 4; ++m) { pg::bf16_t* rowp = base + (size_t)(ai * 128 + m * 16) * 512;
#pragma unroll
                for (int bj = 0; bj < 2; ++bj) { const pg::f32x4 v0 = acc[ai][bj][m][0], v1 = acc[ai][bj][m][1];
                    pg::u32x4 w; w.x = pg::cvt_pk_bf16(v0[0], v0[1]); w.y = pg::cvt_pk_bf16(v0[2], v0[3]); w.z = pg::cvt_pk_bf16(v1[0], v1[1]); w.w = pg::cvt_pk_bf16(v1[2], v1[3]);
                    *(pg::u32x4*)(rowp + bj * 128) = w; } }
    }
};
__device__ __forceinline__ void ph_inproj(LAS unsigned char* lds, const OptBufs& o) {
    const int G = gridDim.x, bx = blockIdx.x;
    { SchedInproj S; S.o.init(T / 256, 12, 1, G, bx); S.A = (const char*)o.H0Q; S.B = (const char*)o.WinQ; S.rowbytes = D;
      pg::EpiStoreBf16 E{o.PROJ + PJ_O, PROJW, 1.f, 0}; pg::gemm_phase<pg::EpiStoreBf16, SchedInproj, false, true>(lds, D / 2, D / 2, D / 2, S, E); }
    { SchedInproj S; S.o.init(T / 256, 6, 1, G, bx); S.A = (const char*)o.H0B; S.B = (const char*)o.WinT; S.rowbytes = (size_t)D * 2;
      pg::EpiStoreBf16 E{o.PROJ, PROJW, 1.f, 0}; pg::gemm_phase<pg::EpiStoreBf16, SchedInproj>(lds, D, D, D, S, E); }
    { SchedVT S; S.o.init(4, T / 256, 1, G, (bx + 128) % G); S.A = (const char*)(o.WinT + (size_t)PROJW * D); S.B = (const char*)o.H0B;
      EpiVT E{o.BT2}; pg::gemm_phase<EpiVT, SchedVT>(lds, D, D, D, S, E); }
}

struct OptBufs2 { pg::bf16_t *WqT, *WkT, *WpoolT, *WbpT, *POOLED, *UC, *MIXED, *Q, *K, *YPOOL; };
__device__ __forceinline__ void ld8(const pg::bf16_t* p, float (&v)[8]) { const pg::u32x4 w = *(const pg::u32x4*)p;
    v[0] = __builtin_bit_cast(float, w.x << 16); v[1] = __builtin_bit_cast(float, w.x & 0xffff0000u); v[2] = __builtin_bit_cast(float, w.y << 16); v[3] = __builtin_bit_cast(float, w.y & 0xffff0000u);
    v[4] = __builtin_bit_cast(float, w.z << 16); v[5] = __builtin_bit_cast(float, w.z & 0xffff0000u); v[6] = __builtin_bit_cast(float, w.w << 16); v[7] = __builtin_bit_cast(float, w.w & 0xffff0000u); }
__device__ __forceinline__ void st8(pg::bf16_t* p, const float (&v)[8]) { pg::u32x4 w; w.x = pk2(v[0], v[1]); w.y = pk2(v[2], v[3]); w.z = pk2(v[4], v[5]); w.w = pk2(v[6], v[7]); *(pg::u32x4*)p = w; }
__device__ __forceinline__ void ph_poolconv_opt(const pg::bf16_t* PROJ, const float* cw, const float* cb, pg::bf16_t* POOLED, pg::bf16_t* UC) {
    const int gt = blockIdx.x * NT + tidf(), ngt = gridDim.x * NT;
    for (int it = gt; it < 512 * 192; it += ngt) {
        const int run = it / 192, oc = it % 192; const int t0 = run * 32, tpos0 = t0 & (SEQ - 1);
        if (oc < 64) {
            const int c0 = oc * 8, w = 2 << (c0 >> 7);
            const pg::bf16_t* src = PROJ + PJ_P + c0;
            float s[8];
#pragma unroll
            for (int q = 0; q < 8; ++q) s[q] = 0.f;
            { pg::u32x4 hv[15];
#pragma unroll
              for (int j = 1; j < 16; ++j) hv[j - 1] = (j < w && tpos0 - j >= 0) ? *(const pg::u32x4*)(src + (size_t)(t0 - j) * PROJW) : (pg::u32x4){0u, 0u, 0u, 0u};
#pragma unroll
              for (int j = 0; j < 15; ++j) { s[0] += __builtin_bit_cast(float, hv[j].x << 16); s[1] += __builtin_bit_cast(float, hv[j].x & 0xffff0000u); s[2] += __builtin_bit_cast(float, hv[j].y << 16); s[3] += __builtin_bit_cast(float, hv[j].y & 0xffff0000u);
                  s[4] += __builtin_bit_cast(float, hv[j].z << 16); s[5] += __builtin_bit_cast(float, hv[j].z & 0xffff0000u); s[6] += __builtin_bit_cast(float, hv[j].w << 16); s[7] += __builtin_bit_cast(float, hv[j].w & 0xffff0000u); } }
            for (int i0 = 0; i0 < 32; i0 += 8) {
                pg::u32x4 cv[8], ov[8];
#pragma unroll
                for (int i = 0; i < 8; ++i) { const int t = t0 + i0 + i, tp = tpos0 + i0 + i; cv[i] = *(const pg::u32x4*)(src + (size_t)t * PROJW);
                    ov[i] = (tp - w + 1 >= 0) ? *(const pg::u32x4*)(src + (size_t)(t - w + 1) * PROJW) : (pg::u32x4){0u, 0u, 0u, 0u}; }
#pragma unroll
                for (int i = 0; i < 8; ++i) { const int t = t0 + i0 + i, tp = tpos0 + i0 + i; float cur[8], old[8], o[8];
                    cur[0] = __builtin_bit_cast(float, cv[i].x << 16); cur[1] = __builtin_bit_cast(float, cv[i].x & 0xffff0000u); cur[2] = __builtin_bit_cast(float, cv[i].y << 16); cur[3] = __builtin_bit_cast(float, cv[i].y & 0xffff0000u);
                    cur[4] = __builtin_bit_cast(float, cv[i].z << 16); cur[5] = __builtin_bit_cast(float, cv[i].z & 0xffff0000u); cur[6] = __builtin_bit_cast(float, cv[i].w << 16); cur[7] = __builtin_bit_cast(float, cv[i].w & 0xffff0000u);
                    old[0] = __builtin_bit_cast(float, ov[i].x << 16); old[1] = __builtin_bit_cast(float, ov[i].x & 0xffff0000u); old[2] = __builtin_bit_cast(float, ov[i].y << 16); old[3] = __builtin_bit_cast(float, ov[i].y & 0xffff0000u);
                    old[4] = __builtin_bit_cast(float, ov[i].z << 16); old[5] = __builtin_bit_cast(float, ov[i].z & 0xffff0000u); old[6] = __builtin_bit_cast(float, ov[i].w << 16); old[7] = __builtin_bit_cast(float, ov[i].w & 0xffff0000u);
                    const float inv = 1.f / (float)((tp + 1 < w) ? tp + 1 : w);
#pragma unroll
                    for (int q = 0; q < 8; ++q) { s[q] += cur[q]; o[q] = s[q] * inv - cur[q]; s[q] -= old[q]; }
                    st8(POOLED + (size_t)t * 512 + c0, o); }
            }
        } else {
            const int c0 = (oc - 64) * 8;
            const pg::bf16_t* src = PROJ + PJ_U + c0;
            float w0[8], w1[8], w2[8], w3[8], bb[8], u0[8], u1[8], u2[8];
#pragma unroll
            for (int q = 0; q < 8; ++q) { w0[q] = cw[c0 + q]; w1[q] = cw[1024 + c0 + q]; w2[q] = cw[2048 + c0 + q]; w3[q] = cw[3072 + c0 + q]; bb[q] = cb[c0 + q]; u0[q] = 0.f; u1[q] = 0.f; u2[q] = 0.f; }
            if (tpos0 >= 3) ld8(src + (size_t)(t0 - 3) * PROJW, u0);
            if (tpos0 >= 2) ld8(src + (size_t)(t0 - 2) * PROJW, u1);
            if (tpos0 >= 1) ld8(src + (size_t)(t0 - 1) * PROJW, u2);
            for (int i0 = 0; i0 < 32; i0 += 8) {
                pg::u32x4 cv[8];
#pragma unroll
                for (int i = 0; i < 8; ++i) cv[i] = *(const pg::u32x4*)(src + (size_t)(t0 + i0 + i) * PROJW);
#pragma unroll
                for (int i = 0; i < 8; ++i) { float u3[8], o[8];
                    u3[0] = __builtin_bit_cast(float, cv[i].x << 16); u3[1] = __builtin_bit_cast(float, cv[i].x & 0xffff0000u); u3[2] = __builtin_bit_cast(float, cv[i].y << 16); u3[3] = __builtin_bit_cast(float, cv[i].y & 0xffff0000u);
                    u3[4] = __builtin_bit_cast(float, cv[i].z << 16); u3[5] = __builtin_bit_cast(float, cv[i].z & 0xffff0000u); u3[6] = __builtin_bit_cast(float, cv[i].w << 16); u3[7] = __builtin_bit_cast(float, cv[i].w & 0xffff0000u);
#pragma unroll
                    for (int q = 0; q < 8; ++q) { const float y = bb[q] + w0[q] * u0[q] + w1[q] * u1[q] + w2[q] * u2[q] + w3[q] * u3[q]; o[q] = y * __builtin_amdgcn_rcpf(1.f + __expf(-y)); u0[q] = u1[q]; u1[q] = u2[q]; u2[q] = u3[q]; }
                    st8(UC + (size_t)(t0 + i0 + i) * 1024 + c0, o); }
            }
        }
    }
}
struct SchedG {
    pg::TileOrder o; const char* A; const char* B; size_t gA, gB, tA, tB;
    __device__ __forceinline__ bool next(int i, pg::Unit& u) const { int g, pm, pn; if (!o.tile(i, g, pm, pn)) return false;
        u.A = A + g * gA + pm * tA; u.B = B + g * gB + pn * tB; u.pm = pm; u.pn = pn; u.g = g; u.aux = 0; u.rows = nullptr; u.nvalid = 0; return true; }
};
struct EpiPoolMixB {
    static constexpr bool PERM = true, AFTER_DRAIN = false, BIAS = false;
    pg::bf16_t* O; const float* b; const float* ls;
    __device__ __forceinline__ void operator()(const pg::f32x4 (&acc)[2][2][4][2], const pg::Unit& u, int wr, int wc, int fr, int fq) const {
        const int col0 = u.pn * 256 + wc * 32 + 8 * fq;
        pg::bf16_t* base = O + (size_t)(u.pm * 256 + wr * 64 + fr) * 512 + col0;
        pg::f32x4 bv[2][2], lv[2][2];
#pragma unroll
        for (int bj = 0; bj < 2; ++bj)
#pragma unroll
            for (int n = 0; n < 2; ++n) { bv[bj][n] = *(const pg::f32x4*)(b + col0 + bj * 128 + 4 * n); lv[bj][n] = *(const pg::f32x4*)(ls + col0 + bj * 128 + 4 * n); }
#pragma unroll
        for (int ai = 0; ai < 2; ++ai)
#pragma unroll
            for (int m = 0; m < 4; ++m) { pg::bf16_t* rowp = base + (size_t)(ai * 128 + m * 16) * 512;
#pragma unroll
                for (int bj = 0; bj < 2; ++bj) { const pg::f32x4 v0 = (acc[ai][bj][m][0] + bv[bj][0]) * lv[bj][0], v1 = (acc[ai][bj][m][1] + bv[bj][1]) * lv[bj][1];
                    pg::u32x4 w; w.x = pg::cvt_pk_bf16(v0[0], v0[1]); w.y = pg::cvt_pk_bf16(v0[2], v0[3]); w.z = pg::cvt_pk_bf16(v1[0], v1[1]); w.w = pg::cvt_pk_bf16(v1[2], v1[3]);
                    *(pg::u32x4*)(rowp + bj * 128) = w; } }
    }
};
__device__ __forceinline__ void cvt_bf16_f32(const pg::bf16_t* src, size_t lds_, int cols, float* dst, size_t rows) {
    const size_t gt = (size_t)blockIdx.x * NT + tidf(), ngt = (size_t)gridDim.x * NT;
    for (size_t i = gt; i < rows * cols; i += ngt) { const size_t r = i / cols; const int c = (int)(i % cols); dst[i] = bf2f(src[r * lds_ + c]); }
}
__device__ __forceinline__ void ph_adapt_v(const OptBufs& o, float* vv) {
    const size_t gt = (size_t)blockIdx.x * NT + tidf(), ngt = (size_t)gridDim.x * NT;
    for (size_t i = gt; i < (size_t)T * 1024; i += ngt) { const int t = (int)(i >> 10), e = (int)(i & 1023), h = e >> 8, el = e & 255, b = t >> 12, cc = (t & 4095) >> 8, tl = t & 255;
        vv[i] = bf2f(o.BT2[((size_t)((b * 4 + h) * 16 + cc) * 256 + el) * 512 + tl]); }
}


struct OptBufs3 { pg::bf16_t *KaT, *A2, *HOUT; float *U, *rowv, *colv, *winter, *aw, *emt, *den, *un, *decay; };
__device__ __forceinline__ float log_sigmoidf_(float x) { return fminf(x, 0.f) - log1pf(expf(-fabsf(x))); }
__device__ __forceinline__ void scalar_scan_wg(LAS unsigned char* lds, int bh, const float* gif, const OptBufs3& o) {
    const int tid = tidf(), lane = tid & 63, wave = tid >> 6, b = bh >> 2, h = bh & 3;
    LAS float* sum = (LAS float*)lds;
    float bt[2][4], ip[2][4], pm[2][4];
#pragma unroll
    for (int cc = 0; cc < 2; ++cc) { const int c = wave * 2 + cc;
        float bs[4];
#pragma unroll
        for (int sub = 0; sub < 4; ++sub) { const size_t t = (size_t)b * SEQ + c * 256 + sub * 64 + lane; ip[cc][sub] = gif[t * 8 + h]; bs[sub] = log_sigmoidf_(gif[t * 8 + 4 + h]); }
#pragma unroll
        for (int off = 1; off < 64; off <<= 1) {
#pragma unroll
            for (int sub = 0; sub < 4; ++sub) { const float v = __shfl_up(bs[sub], off); if (lane >= off) bs[sub] += v; } }
        float carry = 0.f;
#pragma unroll
        for (int sub = 0; sub < 4; ++sub) { bt[cc][sub] = carry + bs[sub]; carry += __shfl(bs[sub], 63); pm[cc][sub] = ip[cc][sub] - bt[cc][sub]; }
#pragma unroll
        for (int off = 1; off < 64; off <<= 1) {
#pragma unroll
            for (int sub = 0; sub < 4; ++sub) { const float v = __shfl_up(pm[cc][sub], off); if (lane >= off) pm[cc][sub] = fmaxf(pm[cc][sub], v); } }
        float pmc = -INFINITY;
#pragma unroll
        for (int sub = 0; sub < 4; ++sub) { pm[cc][sub] = fmaxf(pm[cc][sub], pmc); pmc = __shfl(pm[cc][sub], 63); }
        if (lane == 0) { sum[c * 2] = carry; sum[c * 2 + 1] = pmc; }
    }
    __syncthreads();
    float mc = 0.f;
    for (int c = 0; c < wave * 2; ++c) mc = sum[c * 2] + fmaxf(mc, sum[c * 2 + 1]);
#pragma unroll
    for (int cc = 0; cc < 2; ++cc) { const int c = wave * 2 + cc; const float Gc = sum[c * 2], mnext = Gc + fmaxf(mc, sum[c * 2 + 1]);
#pragma unroll
        for (int sub = 0; sub < 4; ++sub) { const float mt = bt[cc][sub] + fmaxf(mc, pm[cc][sub]);
            const size_t idx = ((size_t)b * SEQ + c * 256 + sub * 64 + lane) * 4 + h;
            o.rowv[idx] = bt[cc][sub] - mt; o.colv[idx] = ip[cc][sub] - bt[cc][sub];
            o.winter[idx] = expf(bt[cc][sub] + mc - mt); o.aw[idx] = expf(Gc - bt[cc][sub] + ip[cc][sub] - mnext); o.emt[idx] = expf(-mt); }
        if (lane == 0) o.decay[bh * 16 + c] = expf(Gc + mc - mnext);
        mc = mnext; }
    __syncthreads();
}
struct EpiQ {
    static constexpr bool PERM = true, AFTER_DRAIN = false, BIAS = false;
    pg::bf16_t* Q; pg::bf16_t* A2; const float* winter;
    __device__ __forceinline__ void operator()(const pg::f32x4 (&acc)[2][2][4][2], const pg::Unit& u, int wr, int wc, int fr, int fq) const {
        const int h = u.g, col0 = wc * 32 + 8 * fq;
#pragma unroll
        for (int ai = 0; ai < 2; ++ai)
#pragma unroll
            for (int m = 0; m < 4; ++m) { const size_t t = (size_t)u.pm * 256 + ai * 128 + wr * 64 + m * 16 + fr; const float wi = winter[t * 4 + h];
#pragma unroll
                for (int bj = 0; bj < 2; ++bj) { const pg::f32x4 v0 = acc[ai][bj][m][0] * 0.0625f, v1 = acc[ai][bj][m][1] * 0.0625f;
                    pg::u32x4 w; w.x = pg::cvt_pk_bf16(v0[0], v0[1]); w.y = pg::cvt_pk_bf16(v0[2], v0[3]); w.z = pg::cvt_pk_bf16(v1[0], v1[1]); w.w = pg::cvt_pk_bf16(v1[2], v1[3]);
                    *(pg::u32x4*)(Q + t * 1024 + h * 256 + col0 + bj * 128) = w;
                    const pg::f32x4 x0 = v0 * wi, x1 = v1 * wi;
                    pg::u32x4 y; y.x = pg::cvt_pk_bf16(x0[0], x0[1]); y.y = pg::cvt_pk_bf16(x0[2], x0[3]); y.z = pg::cvt_pk_bf16(x1[0], x1[1]); y.w = pg::cvt_pk_bf16(x1[2], x1[3]);
                    *(pg::u32x4*)(A2 + t * 2048 + h * 512 + 256 + col0 + bj * 128) = y; }
                asm volatile("" ::: "memory"); }
    }
};
struct EpiKT {
    static constexpr bool PERM = true, AFTER_DRAIN = false, BIAS = false;
    pg::bf16_t* KaT; const float* aw;
    __device__ __forceinline__ void operator()(const pg::f32x4 (&acc)[2][2][4][2], const pg::Unit& u, int wr, int wc, int fr, int fq) const {
        const int h = u.g; const size_t t0 = (size_t)u.pn * 256 + wc * 32 + 8 * fq;
#pragma unroll
        for (int bj = 0; bj < 2; ++bj) {
            float a[8];
#pragma unroll
            for (int j = 0; j < 8; ++j) a[j] = aw[(t0 + bj * 128 + j) * 4 + h];
            pg::bf16_t* rowp = KaT + ((size_t)h * 256 + wr * 64 + fr) * T + t0 + bj * 128;
#pragma unroll
            for (int ai = 0; ai < 2; ++ai)
#pragma unroll
                for (int m = 0; m < 4; ++m) { const pg::f32x4 v0 = acc[ai][bj][m][0], v1 = acc[ai][bj][m][1];
                    pg::u32x4 w; w.x = pg::cvt_pk_bf16(v0[0] * a[0], v0[1] * a[1]); w.y = pg::cvt_pk_bf16(v0[2] * a[2], v0[3] * a[3]);
                    w.z = pg::cvt_pk_bf16(v1[0] * a[4], v1[1] * a[5]); w.w = pg::cvt_pk_bf16(v1[2] * a[6], v1[3] * a[7]);
                    *(pg::u32x4*)(rowp + (size_t)(ai * 128 + m * 16) * T) = w; asm volatile("" ::: "memory"); }
        }
    }
};
struct EpiS {
    static constexpr bool PERM = true, AFTER_DRAIN = false, BIAS = false;
    pg::bf16_t* A2; const float* rowv; const float* colv; float* den;
    __device__ __forceinline__ void operator()(const pg::f32x4 (&acc)[2][2][4][2], const pg::Unit& u, int wr, int wc, int fr, int fq) const {
        const int bh = u.g >> 4, c = u.g & 15, b = bh >> 2, h = bh & 3; const size_t tok0 = (size_t)b * SEQ + c * 256;
        const int col0 = wc * 32 + 8 * fq;
        const float* cvp = colv + (tok0 + col0) * 4 + h;
#pragma unroll
        for (int ai = 0; ai < 2; ++ai)
#pragma unroll
            for (int m = 0; m < 4; ++m) { const int tl = ai * 128 + wr * 64 + m * 16 + fr; const float rv = rowv[(tok0 + tl) * 4 + h]; float rs = 0.f;
                pg::bf16_t* op = A2 + (tok0 + tl) * 2048 + h * 512 + col0;
#pragma unroll
                for (int bj = 0; bj < 2; ++bj) { float x[8];
#pragma unroll
                    for (int j = 0; j < 8; ++j) { const int sl = col0 + bj * 128 + j; const float a_ = (j < 4) ? acc[ai][bj][m][0][j] : acc[ai][bj][m][1][j - 4];
                        const float w_ = __expf(rv + cvp[(bj * 128 + j) * 4]); x[j] = (sl <= tl) ? a_ * w_ : 0.f; rs += x[j]; }
                    pg::u32x4 w; w.x = pg::cvt_pk_bf16(x[0], x[1]); w.y = pg::cvt_pk_bf16(x[2], x[3]); w.z = pg::cvt_pk_bf16(x[4], x[5]); w.w = pg::cvt_pk_bf16(x[6], x[7]);
                    *(pg::u32x4*)(op + bj * 128) = w; asm volatile("" ::: "memory"); }
                rs += __shfl_xor(rs, 16); rs += __shfl_xor(rs, 32);
                if (fq == 0) atomicAdd(den + (tok0 + tl) * 4 + h, rs);
                asm volatile("" ::: "memory"); }
    }
};
struct EpiF32U {
    static constexpr bool PERM = false, AFTER_DRAIN = false, BIAS = false;
    float* C;
    __device__ __forceinline__ void operator()(const pg::f32x4 (&acc)[2][2][4][2], const pg::Unit& u, int wr, int wc, int fr, int fq) const {
        float* base = C + (size_t)u.aux * 65536 + (size_t)(wr * 64 + fr) * 256 + wc * 32 + 4 * fq;
#pragma unroll
        for (int ai = 0; ai < 2; ++ai)
#pragma unroll
            for (int m = 0; m < 4; ++m)
#pragma unroll
                for (int bj = 0; bj < 2; ++bj)
#pragma unroll
                    for (int n = 0; n < 2; ++n) { *(pg::f32x4*)(base + (size_t)(ai * 128 + m * 16) * 256 + bj * 128 + n * 16) = acc[ai][bj][m][n]; if (n) asm volatile("" ::: "memory"); }
    }
};
struct EpiNum {
    static constexpr bool PERM = true, AFTER_DRAIN = true, BIAS = false;
    pg::bf16_t* HOUT; const pg::bf16_t* PROJ; const float* den; const float* emt; const float* gain;
    __device__ __forceinline__ void fused(pg::f32x4 (&acc)[2][2][4][2], const pg::Unit& u, int wr, int wc, int fr, int fq, LAS unsigned char* lds, int wid, int lane) const {
        const int bh = u.g >> 4, c = u.g & 15, b = bh >> 2, h = bh & 3; const size_t tok0 = (size_t)b * SEQ + c * 256;
        LAS pg::f32x2* P = (LAS pg::f32x2*)lds; LAS pg::f32x2* Sx = (LAS pg::f32x2*)(lds + 8192);
#pragma unroll
        for (int ai = 0; ai < 2; ++ai)
#pragma unroll
            for (int m = 0; m < 4; ++m) { const int tl = ai * 128 + wr * 64 + m * 16 + fr; const size_t ti = (tok0 + tl) * 4 + h;
                const float inv = __builtin_amdgcn_rcpf(fmaxf(fabsf(den[ti]), emt[ti])); float s = 0.f;
#pragma unroll
                for (int bj = 0; bj < 2; ++bj)
#pragma unroll
                    for (int n = 0; n < 2; ++n) { acc[ai][bj][m][n] = acc[ai][bj][m][n] * inv; const pg::f32x4 x = acc[ai][bj][m][n]; s += (x[0] + x[1]) + (x[2] + x[3]); }
                s += __shfl_xor(s, 16); s += __shfl_xor(s, 32);
                const float mw = s * (1.f / 64.f); float q = 0.f;
#pragma unroll
                for (int bj = 0; bj < 2; ++bj)
#pragma unroll
                    for (int n = 0; n < 2; ++n) { const pg::f32x4 d = acc[ai][bj][m][n] - mw; q += (d[0] * d[0] + d[1] * d[1]) + (d[2] * d[2] + d[3] * d[3]); }
                q += __shfl_xor(q, 16); q += __shfl_xor(q, 32);
                if (fq == 0) P[tl * 4 + wc] = (pg::f32x2){mw, q}; }
        asm volatile("s_waitcnt lgkmcnt(0)" ::: "memory"); __builtin_amdgcn_s_barrier(); asm volatile("" ::: "memory");
        if (lane < 32) { const int row = wid * 32 + lane;
            const pg::f32x2 a = P[row * 4 + 0], b_ = P[row * 4 + 1], c_ = P[row * 4 + 2], d = P[row * 4 + 3];
            const float mt = (a.x + b_.x + c_.x + d.x) * 0.25f;
            const float da = a.x - mt, db = b_.x - mt, dc = c_.x - mt, dd = d.x - mt;
            const float m2 = (a.y + b_.y) + (c_.y + d.y) + 64.f * ((da * da + db * db) + (dc * dc + dd * dd));
            Sx[row] = (pg::f32x2){mt, rsqrtf(m2 * (1.f / 256.f) + LN_EPS)}; }
        asm volatile("s_waitcnt lgkmcnt(0)" ::: "memory"); __builtin_amdgcn_s_barrier(); asm volatile("" ::: "memory");
        const int col0 = wc * 32 + 8 * fq;
#pragma unroll
        for (int bj = 0; bj < 2; ++bj) { const int e0 = h * 256 + col0 + bj * 128;
            const pg::f32x4 g0 = *(const pg::f32x4*)(gain + e0), g1 = *(const pg::f32x4*)(gain + e0 + 4);
#pragma unroll
            for (int ai = 0; ai < 2; ++ai)
#pragma unroll
                for (int m = 0; m < 4; ++m) { const int tl = ai * 128 + wr * 64 + m * 16 + fr; const pg::f32x2 sr = Sx[tl]; const size_t t = tok0 + tl;
                    float ov[8]; ld8(PROJ + t * PROJW + PJ_O + e0, ov);
                    const pg::f32x4 v0 = (acc[ai][bj][m][0] - sr.x) * sr.y * g0, v1 = (acc[ai][bj][m][1] - sr.x) * sr.y * g1;
                    float r[8];
#pragma unroll
                    for (int j = 0; j < 4; ++j) { r[j] = v0[j] * fsigmoid(ov[j]); r[4 + j] = v1[j] * fsigmoid(ov[4 + j]); }
                    st8(HOUT + t * 1024 + e0, r); } }
    }
};
struct SchedG1 { pg::TileOrder o; const char* Q; const char* K;
    __device__ __forceinline__ bool next(int i, pg::Unit& u) const { int g, pm, pn; if (!o.tile(i, g, pm, pn)) return false;
        const int bh = g >> 4, c = g & 15, b = bh >> 2, h = bh & 3; const size_t off = (((size_t)b * SEQ + c * 256) * 1024 + h * 256) * 2;
        u.A = Q + off; u.B = K + off; u.pm = 0; u.pn = 0; u.g = g; u.aux = g; u.rows = nullptr; u.nvalid = 0; return true; } };
struct SchedG2 { pg::TileOrder o; const char* BT2; const char* KaT;
    __device__ __forceinline__ bool next(int i, pg::Unit& u) const { int g, pm, pn; if (!o.tile(i, g, pm, pn)) return false;
        const int bh = g / 15, c = g % 15, b = bh >> 2, h = bh & 3;
        u.A = BT2 + (size_t)(bh * 16 + c) * 256 * 512 * 2; u.B = KaT + (((size_t)h * 256) * T + (size_t)b * SEQ + c * 256) * 2;
        u.pm = 0; u.pn = 0; u.g = bh * 16 + c; u.aux = bh * 16 + c; u.rows = nullptr; u.nvalid = 0; return true; } };
struct SchedG3 { pg::TileOrder o; const char* A2; const char* BT2;
    __device__ __forceinline__ bool next(int i, pg::Unit& u) const { int g, pm, pn; if (!o.tile(i, g, pm, pn)) return false;
        const int bh = g >> 4, c = g & 15, b = bh >> 2, h = bh & 3;
        u.A = A2 + (((size_t)b * SEQ + c * 256) * 2048 + h * 512) * 2; u.B = BT2 + (size_t)g * 256 * 512 * 2; u.pm = 0; u.pn = 0; u.g = g; u.aux = g; u.rows = nullptr; u.nvalid = 0; return true; } };
__device__ __forceinline__ void ph_un(LAS unsigned char* lds, const OptBufs2& o2, const OptBufs3& o3) {
    const int tid = tidf(), d = tid & 255, sh = tid >> 8; LAS float* red = (LAS float*)lds;
    for (int it = blockIdx.x; it < 256; it += gridDim.x) { const int bh = it >> 4, c = it & 15, b = bh >> 2, h = bh & 3; const size_t tok0 = (size_t)b * SEQ + c * 256;
        float s = 0.f;
#pragma unroll 8
        for (int j = 0; j < 128; ++j) { const size_t t = tok0 + sh * 128 + j; s += o3.aw[t * 4 + h] * bf2f(o2.K[t * 1024 + h * 256 + d]); }
        __syncthreads(); if (sh == 1) red[d] = s; __syncthreads();
        if (sh == 0) o3.un[(size_t)it * 256 + d] = s + red[d]; }
    __syncthreads();
}
__device__ __forceinline__ void ph_state_scan(const OptBufs& ob, const OptBufs3& o3) {
    const int gt = blockIdx.x * NT + tidf(), ngt = gridDim.x * NT;
    for (int it = gt; it < 16 * 256 * 64; it += ngt) { const int bh = it >> 14, e = (it >> 6) & 255, d4 = (it & 63) * 4;
        pg::f32x4 U[15]; float dc[15];
#pragma unroll
        for (int c = 0; c < 15; ++c) { const size_t g = (size_t)bh * 16 + c; U[c] = *(const pg::f32x4*)(o3.U + g * 65536 + (size_t)e * 256 + d4); dc[c] = o3.decay[g]; }
        pg::f32x4 C = (pg::f32x4){0.f, 0.f, 0.f, 0.f};
#pragma unroll
        for (int c = 0; c < 16; ++c) { const size_t g = (size_t)bh * 16 + c;
            pg::u32x2 w; w.x = pk2(C[0], C[1]); w.y = pk2(C[2], C[3]);
            *(pg::u32x2*)(ob.BT2 + (g * 256 + e) * 512 + 256 + d4) = w;
            if (c < 15) C = C * dc[c] + U[c]; } }
}
__device__ __forceinline__ void ph_den_inter(LAS unsigned char* lds, const OptBufs3& o3) {
    const int tid = tidf(), lane = tid & 63, wave = tid >> 6; LAS float* nn = (LAS float*)lds;
    for (int it = blockIdx.x; it < 256; it += gridDim.x) { const int bh = it >> 4, c = it & 15, b = bh >> 2, h = bh & 3; const size_t tok0 = (size_t)b * SEQ + c * 256;
        __syncthreads();
        if (tid < 256) { float n = 0.f; for (int j = 0; j < c; ++j) n = n * o3.decay[bh * 16 + j] + o3.un[(size_t)(bh * 16 + j) * 256 + tid]; nn[tid] = n; }
        __syncthreads();
        const pg::f32x4 nv = *(const LAS pg::f32x4*)(nn + 4 * lane);
        for (int r0 = 0; r0 < 32; r0 += 8) { pg::u32x2 wv[8];
#pragma unroll
            for (int r = 0; r < 8; ++r) wv[r] = *(const pg::u32x2*)(o3.A2 + (tok0 + wave * 32 + r0 + r) * 2048 + h * 512 + 256 + 4 * lane);
#pragma unroll
            for (int r = 0; r < 8; ++r) { const size_t t = tok0 + wave * 32 + r0 + r; const pg::u32x2 w = wv[r];
                float s = __builtin_bit_cast(float, w.x << 16) * nv[0] + __builtin_bit_cast(float, w.x & 0xffff0000u) * nv[1] + __builtin_bit_cast(float, w.y << 16) * nv[2] + __builtin_bit_cast(float, w.y & 0xffff0000u) * nv[3];
                s = wsum(s);
                if (lane == 0) o3.den[t * 4 + h] += s; } } }
    __syncthreads();
}

__device__ __forceinline__ void ph_gemms_D(LAS unsigned char* lds, const OptBufs2& o, const OptBufs3& o3, const float* b_pool, const float* ls_pool) {
    const int G = gridDim.x, bx = blockIdx.x;
    { SchedG S; S.o.init(T / 256, 2, 1, G, bx); S.A = (const char*)o.POOLED; S.B = (const char*)o.WpoolT; S.gA = 0; S.gB = 0; S.tA = (size_t)256 * 512 * 2; S.tB = (size_t)256 * 512 * 2;
      EpiPoolMixB E{o.MIXED, b_pool, ls_pool}; pg::gemm_phase<EpiPoolMixB, SchedG>(lds, 512, 512, 512, S, E); }
    { SchedG S; S.o.init(T / 256, 1, 4, G, (bx + 128) % G); S.A = (const char*)o.UC; S.B = (const char*)o.WqT; S.gA = 256 * 2; S.gB = (size_t)65536 * 2; S.tA = (size_t)256 * 1024 * 2; S.tB = 0;
      EpiQ E{o.Q, o3.A2, o3.winter}; pg::gemm_phase<EpiQ, SchedG>(lds, 1024, 256, 256, S, E); }
    { SchedG S; S.o.init(T / 256, 1, 4, G, (bx + 128) % G); S.A = (const char*)o.UC; S.B = (const char*)o.WkT; S.gA = 256 * 2; S.gB = (size_t)65536 * 2; S.tA = (size_t)256 * 1024 * 2; S.tB = 0;
      pg::EpiStoreBf16 E{o.K, 1024, 1.f, 256}; pg::gemm_phase<pg::EpiStoreBf16, SchedG>(lds, 1024, 256, 256, S, E); }
    { SchedG S; S.o.init(1, T / 256, 4, G, bx); S.A = (const char*)o.WkT; S.B = (const char*)o.UC; S.gA = (size_t)65536 * 2; S.gB = 256 * 2; S.tA = 0; S.tB = (size_t)256 * 1024 * 2;
      EpiKT E{o3.KaT, o3.aw}; pg::gemm_phase<EpiKT, SchedG>(lds, 256, 1024, 256, S, E); }
}
__device__ __forceinline__ void ph_gemms_E(LAS unsigned char* lds, const OptBufs& ob, const OptBufs2& o2, const OptBufs3& o3) {
    const int G = gridDim.x, bx = blockIdx.x;
    ph_un(lds, o2, o3);
    { SchedG1 S; S.o.init(1, 1, 256, G, bx); S.Q = (const char*)o2.Q; S.K = (const char*)o2.K;
      EpiS E{o3.A2, o3.rowv, o3.colv, o3.den}; pg::gemm_phase<EpiS, SchedG1>(lds, 1024, 1024, 256, S, E); }
    { SchedG2 S; S.o.init(1, 1, 240, G, bx); S.BT2 = (const char*)ob.BT2; S.KaT = (const char*)o3.KaT;
      EpiF32U E{o3.U}; pg::gemm_phase<EpiF32U, SchedG2>(lds, 512, T, 256, S, E); }
}
__device__ __forceinline__ void ph_gemm_G3(LAS unsigned char* lds, const OptBufs& ob, const OptBufs3& o3, const float* gain) {
    SchedG3 S; S.o.init(1, 1, 256, gridDim.x, blockIdx.x); S.A2 = (const char*)o3.A2; S.BT2 = (const char*)ob.BT2;
    EpiNum E{o3.HOUT, ob.PROJ, o3.den, o3.emt, gain}; pg::gemm_phase<EpiNum, SchedG3>(lds, 2048, 512, 512, S, E);
}
__device__ __forceinline__ void ph_gemm_ypool(LAS unsigned char* lds, const OptBufs2& o) {
    const int G = gridDim.x, bx = blockIdx.x;
    SchedG S; S.o.init(T / 256, 4, 1, G, bx); S.A = (const char*)o.MIXED; S.B = (const char*)o.WbpT; S.gA = 0; S.gB = 0; S.tA = (size_t)256 * 512 * 2; S.tB = (size_t)256 * 512 * 2;
    pg::EpiStoreBf16 E{o.YPOOL, 1024, 1.f, 0}; pg::gemm_phase<pg::EpiStoreBf16, SchedG>(lds, 512, 512, 512, S, E);
}


struct OptBufs4 { pg::bf16_t *WbmT, *WoutT, *MERGED, *H1B; unsigned char* H1Q; float *Z, *WRP, *CGB; int *elist, *erank; float *gate; };
struct EpiMerge {
    static constexpr bool PERM = true, AFTER_DRAIN = false, BIAS = false;
    pg::bf16_t* O; const pg::bf16_t* PROJ; const pg::bf16_t* YPOOL;
    __device__ __forceinline__ void operator()(const pg::f32x4 (&acc)[2][2][4][2], const pg::Unit& u, int wr, int wc, int fr, int fq) const {
        const int col0 = u.pn * 256 + wc * 32 + 8 * fq;
#pragma unroll
        for (int ai = 0; ai < 2; ++ai)
#pragma unroll
            for (int m = 0; m < 4; ++m) { const size_t t = (size_t)u.pm * 256 + ai * 128 + wr * 64 + m * 16 + fr;
#pragma unroll
                for (int bj = 0; bj < 2; ++bj) { const int c = col0 + bj * 128; float g0[8], g1[8], yp[8], r[8];
                    ld8(PROJ + t * PROJW + PJ_G + c, g0); ld8(PROJ + t * PROJW + PJ_G + 1024 + c, g1); ld8(YPOOL + t * 1024 + c, yp);
#pragma unroll
                    for (int j = 0; j < 8; ++j) { const float a_ = (j < 4) ? acc[ai][bj][m][0][j] : acc[ai][bj][m][1][j - 4]; r[j] = fsigmoid(g0[j]) * yp[j] + fsigmoid(g1[j]) * a_; }
                    st8(O + t * 1024 + c, r); }
                asm volatile("" ::: "memory"); }
    }
};
struct EpiMixRes {
    static constexpr bool PERM = false, AFTER_DRAIN = false, BIAS = false;
    float* Z; const float* x; const float* stats; const float* g; const float* beta;
    __device__ __forceinline__ void operator()(const pg::f32x4 (&acc)[2][2][4][2], const pg::Unit& u, int wr, int wc, int fr, int fq) const {
        const int col0 = u.pn * 256 + wc * 32 + 4 * fq;
#pragma unroll
        for (int ai = 0; ai < 2; ++ai)
#pragma unroll
            for (int m = 0; m < 4; ++m) { const size_t t = (size_t)u.pm * 256 + ai * 128 + wr * 64 + m * 16 + fr; const float mu = stats[t * 2], rstd = stats[t * 2 + 1];
#pragma unroll
                for (int bj = 0; bj < 2; ++bj)
#pragma unroll
                    for (int n = 0; n < 2; ++n) { const int c = col0 + bj * 128 + n * 16;
                        const pg::f32x4 xv = *(const pg::f32x4*)(x + t * 1024 + c), gv = *(const pg::f32x4*)(g + c), bv = *(const pg::f32x4*)(beta + c);
                        *(pg::f32x4*)(Z + t * 1024 + c) = ((xv - mu) * rstd * gv + bv) * ALPHA + acc[ai][bj][m][n]; }
                asm volatile("" ::: "memory"); }
    }
};
__device__ __forceinline__ void ph_gemm_ymls(LAS unsigned char* lds, const OptBufs& ob, const OptBufs2& o2, const OptBufs3& o3, const OptBufs4& o4) {
    SchedG S; S.o.init(T / 256, 4, 1, gridDim.x, blockIdx.x); S.A = (const char*)o3.HOUT; S.B = (const char*)o4.WbmT; S.gA = 0; S.gB = 0; S.tA = (size_t)256 * 1024 * 2; S.tB = (size_t)256 * 1024 * 2;
    EpiMerge E{o4.MERGED, ob.PROJ, o2.YPOOL}; pg::gemm_phase<EpiMerge, SchedG>(lds, 1024, 1024, 1024, S, E);
}
__device__ __forceinline__ void ph_gemm_mix(LAS unsigned char* lds, const OptBufs& ob, const OptBufs4& o4, const float* x, const float* g, const float* beta) {
    SchedG S; S.o.init(T / 256, 4, 1, gridDim.x, blockIdx.x); S.A = (const char*)o4.MERGED; S.B = (const char*)o4.WoutT; S.gA = 0; S.gB = 0; S.tA = (size_t)256 * 1024 * 2; S.tB = (size_t)256 * 1024 * 2;
    EpiMixRes E{o4.Z, x, ob.stats, g, beta}; pg::gemm_phase<EpiMixRes, SchedG>(lds, 1024, 1024, 1024, S, E);
}
typedef float f32x16 __attribute__((ext_vector_type(16)));
__device__ __forceinline__ void ph_router_prep(const OptBufs4& o, const float* g, const float* beta, const float* wr_, const float* br) {
    const int gt = blockIdx.x * NT + tidf(), ngt = gridDim.x * NT;
    for (int i = gt; i < 1024 * 32; i += ngt) o.WRP[i] = g[i >> 5] * wr_[i];
    const int gw = gt >> 6, lane = gt & 63;
    if (gw < 64) { const int e = gw & 31; const float* vsrc = (gw < 32) ? g : beta; float s_ = 0.f;
#pragma unroll
        for (int i = 0; i < 16; ++i) { const int k = lane + 64 * i; s_ += vsrc[k] * wr_[k * 32 + e]; }
        s_ = wsum(s_);
        if (lane == 0) o.CGB[gw] = s_ + ((gw < 32) ? 0.f : br[e]); }
}
__device__ __forceinline__ void ph_ln1_router(LAS unsigned char* lds, const OptBufs4& o, const float* Zin, const float* g, const float* beta, int* cnt, int mode = 7) {
    const int tid = tidf(), lane = tid & 63, wave = tid >> 6;
    LAS float* part = (LAS float*)lds;
    LAS float* stg = (LAS float*)(lds + wave * 9216);
    LAS float* L = (LAS float*)(lds + 81920);
    LAS float* st = (LAS float*)(lds + 81920 + 8448);
    LAS int* hist = (LAS int*)(lds + 131072 + 1024);
    LAS int* asg = (LAS int*)(lds + 131072 + 1024 + 256);
    for (int tile = blockIdx.x; tile < T / 64; tile += gridDim.x) {
        __syncthreads();
        if (tid < 64) hist[tid] = 0;
        const size_t tbase = (size_t)tile * 64 + wave * 8;
        pg::f32x4 va[4];
#pragma unroll
        for (int j = 0; j < 4; ++j) va[j] = ((const pg::f32x4*)(Zin + tbase * D) + lane)[64 * j];
        for (int r = 0; r < ((mode & 1) ? 8 : 0); ++r) {
            pg::f32x4 na[4];
            if (r < 7) {
#pragma unroll
                for (int j = 0; j < 4; ++j) na[j] = ((const pg::f32x4*)(Zin + (tbase + r + 1) * D) + lane)[64 * j]; }
            float sa = 0.f;
#pragma unroll
            for (int j = 0; j < 4; ++j) sa += (va[j].x + va[j].y) + (va[j].z + va[j].w);
            const float ma = wsum(sa) * (1.f / D); float qa = 0.f;
#pragma unroll
            for (int j = 0; j < 4; ++j) { va[j] = va[j] - ma; qa += (va[j].x * va[j].x + va[j].y * va[j].y) + (va[j].z * va[j].z + va[j].w * va[j].w); }
            const float ra = rsqrtf(wsum(qa) * (1.f / D) + LN_EPS);
            const size_t ta = tbase + r;
            if (lane == 0) { st[(wave * 8 + r) * 2] = ma; st[(wave * 8 + r) * 2 + 1] = ra; }
#pragma unroll
            for (int j = 0; j < 4; ++j) { const int c0 = 256 * j + 4 * lane;
                const pg::f32x4 gg = *(const pg::f32x4*)(g + c0), bb = *(const pg::f32x4*)(beta + c0);
                const pg::f32x4 y = va[j] * ra * gg + bb;
                *(unsigned long long*)(o.H1B + ta * D + c0) = (unsigned long long)pk2(y.x, y.y) | ((unsigned long long)pk2(y.z, y.w) << 32);
                int w0 = __builtin_amdgcn_cvt_pk_fp8_f32(y.x, y.y, 0, false); w0 = __builtin_amdgcn_cvt_pk_fp8_f32(y.z, y.w, w0, true); *(int*)(o.H1Q + ta * D + c0) = w0; }
#pragma unroll
            for (int j = 0; j < 4; ++j) va[j] = na[j];
        }
        if (mode & 2) { const int hh = lane >> 5, el = lane & 31, kb = wave * 128;
          f32x16 acc0, acc1;
#pragma unroll
          for (int i = 0; i < 16; ++i) { acc0[i] = 0.f; acc1[i] = 0.f; }
          const float* zt = Zin + (size_t)tile * 64 * D + kb;
          pg::f32x4 zv[8];
#pragma unroll
          for (int it = 0; it < 8; ++it) zv[it] = *(const pg::f32x4*)(zt + (size_t)(it * 8 + (lane >> 3)) * D + 4 * (lane & 7));
#pragma unroll 1
          for (int sub = 0; sub < 4; ++sub) {
              float bw[16];
#pragma unroll
              for (int s_ = 0; s_ < 16; ++s_) bw[s_] = o.WRP[(size_t)(kb + 32 * sub + 16 * hh + s_) * 32 + el];
#pragma unroll
              for (int it = 0; it < 8; ++it) *(LAS pg::f32x4*)(stg + (it * 8 + (lane >> 3)) * 36 + 4 * (lane & 7)) = zv[it];
              if (sub < 3) {
#pragma unroll
                  for (int it = 0; it < 8; ++it) zv[it] = *(const pg::f32x4*)(zt + (size_t)(it * 8 + (lane >> 3)) * D + 32 * (sub + 1) + 4 * (lane & 7)); }
              asm volatile("s_waitcnt lgkmcnt(0)" ::: "memory");
              pg::f32x4 a0[4], a1[4];
#pragma unroll
              for (int q = 0; q < 4; ++q) { a0[q] = *(const LAS pg::f32x4*)(stg + el * 36 + 16 * hh + 4 * q); a1[q] = *(const LAS pg::f32x4*)(stg + (32 + el) * 36 + 16 * hh + 4 * q); }
#pragma unroll
              for (int q = 0; q < 4; ++q) {
                  acc0 = __builtin_amdgcn_mfma_f32_32x32x2f32(a0[q].x, bw[4 * q + 0], acc0, 0, 0, 0); acc1 = __builtin_amdgcn_mfma_f32_32x32x2f32(a1[q].x, bw[4 * q + 0], acc1, 0, 0, 0);
                  acc0 = __builtin_amdgcn_mfma_f32_32x32x2f32(a0[q].y, bw[4 * q + 1], acc0, 0, 0, 0); acc1 = __builtin_amdgcn_mfma_f32_32x32x2f32(a1[q].y, bw[4 * q + 1], acc1, 0, 0, 0);
                  acc0 = __builtin_amdgcn_mfma_f32_32x32x2f32(a0[q].z, bw[4 * q + 2], acc0, 0, 0, 0); acc1 = __builtin_amdgcn_mfma_f32_32x32x2f32(a1[q].z, bw[4 * q + 2], acc1, 0, 0, 0);
                  acc0 = __builtin_amdgcn_mfma_f32_32x32x2f32(a0[q].w, bw[4 * q + 3], acc0, 0, 0, 0); acc1 = __builtin_amdgcn_mfma_f32_32x32x2f32(a1[q].w, bw[4 * q + 3], acc1, 0, 0, 0); }
              asm volatile("s_waitcnt lgkmcnt(0)" ::: "memory");
          }
          __syncthreads();
#pragma unroll
          for (int i = 0; i < 16; ++i) { part[((wave * 2 + 0) * 16 + i) * 64 + lane] = acc0[i]; part[((wave * 2 + 1) * 16 + i) * 64 + lane] = acc1[i]; }
        } else __syncthreads();
        __syncthreads();
#pragma unroll
        for (int i = 0; i < 4; ++i) { const int idx = tid + 512 * i; float sum = 0.f;
#pragma unroll
            for (int w = 0; w < 8; ++w) sum += part[w * 2048 + idx];
            const int mt = idx >> 10, rg = (idx >> 6) & 15, l2 = idx & 63, tok = mt * 32 + (rg & 3) + 8 * (rg >> 2) + 4 * (l2 >> 5), e = l2 & 31;
            L[tok * 33 + e] = st[tok * 2 + 1] * (sum - st[tok * 2] * o.CGB[e]) + o.CGB[32 + e]; }
        __syncthreads();
        if (tid < 64 && (mode & 4)) { const LAS float* lr_ = L + tid * 33; int i0 = -1, i1 = -1, i2 = -1, i3 = -1; float v0 = 0.f, v1 = 0.f, v2 = 0.f, v3 = 0.f;
#pragma unroll
            for (int k = 0; k < 4; ++k) { float bv = -INFINITY; int bi = 0;
                for (int e = 0; e < 32; ++e) { const float x = lr_[e]; if (e != i0 && e != i1 && e != i2 && x > bv) { bv = x; bi = e; } }
                if (k == 0) { i0 = bi; v0 = bv; } else if (k == 1) { i1 = bi; v1 = bv; } else if (k == 2) { i2 = bi; v2 = bv; } else { i3 = bi; v3 = bv; } }
            const float e1 = expf(v1 - v0), e2 = expf(v2 - v0), e3 = expf(v3 - v0), inv = 1.f / (1.f + e1 + e2 + e3);
            const size_t t = (size_t)tile * 64 + tid;
            *(pg::f32x4*)(o.gate + t * 4) = (pg::f32x4){inv, e1 * inv, e2 * inv, e3 * inv};
            const int r0 = atomicAdd((int*)(hist + i0), 1), r1 = atomicAdd((int*)(hist + i1), 1), r2 = atomicAdd((int*)(hist + i2), 1), r3 = atomicAdd((int*)(hist + i3), 1);
            asg[tid * 4 + 0] = i0 | (r0 << 8); asg[tid * 4 + 1] = i1 | (r1 << 8); asg[tid * 4 + 2] = i2 | (r2 << 8); asg[tid * 4 + 3] = i3 | (r3 << 8); }
        __syncthreads();
        if (tid < 32) hist[32 + tid] = atomicAdd(&cnt[tid], hist[tid]);
        __syncthreads();
        if (tid < 256) { const int a_ = asg[tid], e = a_ & 255, rank = hist[32 + e] + (a_ >> 8); const int t = tile * 64 + (tid >> 2);
            o.elist[e * T + rank] = t; o.erank[(size_t)t * 4 + (tid & 3)] = (e << 16) | rank; }
    }
    __syncthreads();
}
__device__ __forceinline__ void ph_adapt_route(const OptBufs4& o, const int* start, int* row_tok, int* row_of) {
    const int gt = blockIdx.x * NT + tidf(), ngt = gridDim.x * NT;
    for (int i = gt; i < NA; i += ngt) { const int er = o.erank[i], e = er >> 16, rank = er & 0xffff; const int dest = start[e] + rank; row_tok[dest] = i >> 2; row_of[i] = dest; }
}


struct OptBufs5 { pg::bf16_t *We1T, *We2T, *ACT, *Y; float* B1P; };
constexpr int MOE_TAB_OFF = 131072 + 4096;
__device__ __forceinline__ void moe_build_tab(LAS unsigned char* lds, const int* cnt) {
    LAS int* tab = (LAS int*)(lds + MOE_TAB_OFF);
    __syncthreads();
    if (tidf() == 0) { int s = 0; for (int e = 0; e < NE; ++e) { const int c = cnt[e]; tab[e] = s; tab[40 + e] = c; s += (c + 255) >> 8; } tab[NE] = s; }
    __syncthreads();
}
struct SchedMoE {
    const LAS int* tab; const int* cnt; const int* elist; const char* A; const char* B; size_t eB; int nN, nwg, G, c, gather;
    __device__ __forceinline__ bool next(int i, pg::Unit& u) const {
        const long L = (long)i * G + c; if (L >= nwg) return false;
        int wgid = (int)L; { const int q = nwg / pg::NXCD, r = nwg % pg::NXCD, xcd = wgid % pg::NXCD, off = wgid / pg::NXCD; wgid = (xcd < r ? xcd * (q + 1) : r * (q + 1) + (xcd - r) * q) + off; }
        const int mg = wgid / nN, pn = wgid - mg * nN;
        const int ln = tidf() & 63, tv = tab[ln < NE ? ln : NE];
        const int e = __builtin_amdgcn_readfirstlane(__popcll(__ballot(ln >= 1 && ln < NE && tv <= mg)));
        const int mt = mg - __builtin_amdgcn_readlane(tv, e);
        u.g = e; u.pm = mg; u.pn = pn; u.aux = mg * 256;
        u.B = B + (size_t)e * eB + (size_t)pn * 256 * 1024;
        if (gather) { u.A = A; u.rows = elist + (size_t)e * T + mt * 256; const int rem = __builtin_amdgcn_readfirstlane(tab[40 + e]) - mt * 256; u.nvalid = rem < 256 ? rem : 256; }
        else { u.A = A + (size_t)mg * 256 * 1024; u.rows = nullptr; u.nvalid = 0; }
        return true;
    }
};
struct EpiSwiglu {
    static constexpr bool PERM = true, AFTER_DRAIN = false, BIAS = true;
    unsigned char* ACT; const float* B1P;
    __device__ __forceinline__ const float* bias_base(const pg::Unit& u) const { return B1P + u.g * 2048 + u.pn * 256; }
    __device__ __forceinline__ void operator()(const pg::f32x4 (&acc)[2][2][4][2], const pg::Unit& u, int wr, int wc, int fr, int fq) const {
        const int col0 = wc * 32 + 8 * fq;
        unsigned char* base = ACT + (size_t)(u.aux + wr * 64 + fr) * 1024 + u.pn * 128 + col0;
#pragma unroll
        for (int ai = 0; ai < 2; ++ai)
#pragma unroll
            for (int m = 0; m < 4; ++m) { float r[8];
#pragma unroll
                for (int j = 0; j < 8; ++j) { float g = (j < 4) ? acc[ai][0][m][0][j] : acc[ai][0][m][1][j - 4];
                    float l = (j < 4) ? acc[ai][1][m][0][j] : acc[ai][1][m][1][j - 4];
                    g = fminf(g, 7.f); l = fminf(fmaxf(l, -7.f), 7.f);
                    r[j] = g * (l + 1.f) * __builtin_amdgcn_rcpf(1.f + __expf(-1.702f * g)); }
                { int w0 = __builtin_amdgcn_cvt_pk_fp8_f32(r[0], r[1], 0, false); w0 = __builtin_amdgcn_cvt_pk_fp8_f32(r[2], r[3], w0, true);
                  int w1 = __builtin_amdgcn_cvt_pk_fp8_f32(r[4], r[5], 0, false); w1 = __builtin_amdgcn_cvt_pk_fp8_f32(r[6], r[7], w1, true);
                  *(pg::u32x2*)(base + (size_t)(ai * 128 + m * 16) * 1024) = (pg::u32x2){(unsigned)w0, (unsigned)w1}; }
                asm volatile("" ::: "memory"); }
    }
};
struct EpiY {
    static constexpr bool PERM = true, AFTER_DRAIN = false, BIAS = true;
    pg::bf16_t* Y; const float* b2;
    __device__ __forceinline__ const float* bias_base(const pg::Unit& u) const { return b2 + u.g * 1024 + u.pn * 256; }
    __device__ __forceinline__ void operator()(const pg::f32x4 (&acc)[2][2][4][2], const pg::Unit& u, int wr, int wc, int fr, int fq) const {
        const int col0 = u.pn * 256 + wc * 32 + 8 * fq;
        pg::bf16_t* base = Y + (size_t)(u.aux + wr * 64 + fr) * 1024 + col0;
#pragma unroll
        for (int bj = 0; bj < 2; ++bj)
#pragma unroll
            for (int ai = 0; ai < 2; ++ai)
#pragma unroll
                for (int m = 0; m < 4; ++m) { const pg::f32x4 v0 = acc[ai][bj][m][0], v1 = acc[ai][bj][m][1];
                    pg::u32x4 w; w.x = pg::cvt_pk_bf16(v0[0], v0[1]); w.y = pg::cvt_pk_bf16(v0[2], v0[3]); w.z = pg::cvt_pk_bf16(v1[0], v1[1]); w.w = pg::cvt_pk_bf16(v1[2], v1[3]);
                    *(pg::u32x4*)(base + (size_t)(ai * 128 + m * 16) * 1024 + bj * 128) = w; asm volatile("" ::: "memory"); }
    }
};
struct EpiNull { static constexpr bool PERM = true, AFTER_DRAIN = false, BIAS = false;
    float* sink;
    __device__ __forceinline__ void operator()(const pg::f32x4 (&acc)[2][2][4][2], const pg::Unit& u, int wr, int wc, int fr, int fq) const {
        float s_ = 0.f;
#pragma unroll
        for (int ai = 0; ai < 2; ++ai)
#pragma unroll
            for (int bj = 0; bj < 2; ++bj)
#pragma unroll
                for (int m = 0; m < 4; ++m)
#pragma unroll
                    for (int n = 0; n < 2; ++n) s_ += acc[ai][bj][m][n][0];
        if (s_ == 1.2345e30f) sink[0] = s_; } };
__device__ __forceinline__ void ph_moe1_probe(LAS unsigned char* lds, const OptBufs4& o4, const OptBufs5& o5, const int* cnt, int mode, unsigned char* dummy) {
    moe_build_tab(lds, cnt);
    SchedMoE S; S.tab = (const LAS int*)(lds + MOE_TAB_OFF); S.cnt = cnt; S.elist = o4.elist; S.A = (const char*)o4.H1Q; S.B = (const char*)o5.We1T; S.eB = (size_t)2048 * 1024;
    S.nN = 8; S.nwg = __builtin_amdgcn_readfirstlane(S.tab[NE]) * 8; S.G = gridDim.x; S.c = blockIdx.x; S.gather = 1;
    if (mode == 0) { EpiSwiglu E{dummy, o5.B1P}; pg::gemm_phase<EpiSwiglu, SchedMoE, true, true>(lds, 512, 512, 512, S, E); }
    if (mode == 1) { S.gather = 0; S.A = (const char*)o5.ACT; EpiSwiglu E{dummy, o5.B1P}; pg::gemm_phase<EpiSwiglu, SchedMoE, false, true>(lds, 512, 512, 512, S, E); }
    if (mode == 2) { EpiNull E{(float*)dummy}; pg::gemm_phase<EpiNull, SchedMoE, true, true>(lds, 512, 512, 512, S, E); }
    if (mode == 3) { S.gather = 0; S.A = (const char*)o5.ACT; EpiNull E{(float*)dummy}; pg::gemm_phase<EpiNull, SchedMoE, false, true>(lds, 512, 512, 512, S, E); }
}
__device__ __forceinline__ void ph_moe1(LAS unsigned char* lds, const OptBufs4& o4, const OptBufs5& o5, const int* cnt) {
    moe_build_tab(lds, cnt);
    SchedMoE S; S.tab = (const LAS int*)(lds + MOE_TAB_OFF); S.cnt = cnt; S.elist = o4.elist; S.A = (const char*)o4.H1Q; S.B = (const char*)o5.We1T; S.eB = (size_t)2048 * 1024;
    S.nN = 8; S.nwg = __builtin_amdgcn_readfirstlane(S.tab[NE]) * 8; S.G = gridDim.x; S.c = blockIdx.x; S.gather = 1;
    EpiSwiglu E{(unsigned char*)o5.ACT, o5.B1P}; pg::gemm_phase<EpiSwiglu, SchedMoE, true, true>(lds, 512, 512, 512, S, E);
}
__device__ __forceinline__ void ph_moe2(LAS unsigned char* lds, const OptBufs5& o5, const int* cnt, const float* b_e2) {
    moe_build_tab(lds, cnt);
    SchedMoE S; S.tab = (const LAS int*)(lds + MOE_TAB_OFF); S.cnt = cnt; S.elist = nullptr; S.A = (const char*)o5.ACT; S.B = (const char*)o5.We2T; S.eB = (size_t)1024 * 1024;
    S.nN = 4; S.nwg = __builtin_amdgcn_readfirstlane(S.tab[NE]) * 4; S.G = gridDim.x; S.c = blockIdx.x; S.gather = 0;
    EpiY E{o5.Y, b_e2}; pg::gemm_phase<EpiY, SchedMoE, false, true>(lds, 512, 512, 512, S, E);
}
__device__ __forceinline__ void ph_final_opt(LAS unsigned char* lds, const OptBufs4& o4, const OptBufs5& o5, const int* cnt, const float* g, const float* beta, float* out) {
    moe_build_tab(lds, cnt);
    const LAS int* tab = (const LAS int*)(lds + MOE_TAB_OFF);
    const int tid = tidf(), lane = tid & 63, gw = blockIdx.x * NW + (tid >> 6), ngw = gridDim.x * NW;
    for (int t = gw; t < T; t += ngw) {
        size_t ro[4]; float gt[4];
#pragma unroll
        for (int k = 0; k < 4; ++k) { const int er = o4.erank[(size_t)t * 4 + k]; ro[k] = (size_t)(tab[er >> 16] * 256 + (er & 0xffff)) * 1024; gt[k] = o4.gate[(size_t)t * 4 + k]; }
        pg::f32x4 v[4]; float s = 0.f;
#pragma unroll
        for (int j = 0; j < 4; ++j) { const int c0 = 256 * j + 4 * lane;
            pg::f32x4 x; { const pg::u32x2 hw = *(const pg::u32x2*)(o4.H1B + (size_t)t * D + c0); x.x = __builtin_bit_cast(float, hw.x << 16) * ALPHA; x.y = __builtin_bit_cast(float, hw.x & 0xffff0000u) * ALPHA; x.z = __builtin_bit_cast(float, hw.y << 16) * ALPHA; x.w = __builtin_bit_cast(float, hw.y & 0xffff0000u) * ALPHA; }
#pragma unroll
            for (int k = 0; k < 4; ++k) { const pg::u32x2 w = *(const pg::u32x2*)(o5.Y + ro[k] + c0);
                x.x += gt[k] * __builtin_bit_cast(float, w.x << 16); x.y += gt[k] * __builtin_bit_cast(float, w.x & 0xffff0000u);
                x.z += gt[k] * __builtin_bit_cast(float, w.y << 16); x.w += gt[k] * __builtin_bit_cast(float, w.y & 0xffff0000u); }
            v[j] = x; s += (x.x + x.y) + (x.z + x.w); }
        const float mean = wsum(s) * (1.f / D); float s2 = 0.f;
#pragma unroll
        for (int j = 0; j < 4; ++j) { v[j] = v[j] - mean; s2 += (v[j].x * v[j].x + v[j].y * v[j].y) + (v[j].z * v[j].z + v[j].w * v[j].w); }
        const float rstd = rsqrtf(wsum(s2) * (1.f / D) + LN_EPS);
#pragma unroll
        for (int j = 0; j < 4; ++j) { const int c0 = 256 * j + 4 * lane;
            *(pg::f32x4*)(out + (size_t)t * D + c0) = v[j] * rstd * *(const pg::f32x4*)(g + c0) + *(const pg::f32x4*)(beta + c0); }
    }
}

__device__ __forceinline__ void ph_adapt1(const OptBufs& o, const float* b_if, float* proj) {
    const size_t gt = (size_t)blockIdx.x * NT + tidf(), ngt = (size_t)gridDim.x * NT;
    for (size_t i = gt; i < (size_t)T * INC; i += ngt) {
        const int c = (int)(i % INC); const int t = (int)(i / INC);
        float v;
        if (c < C_V) v = bf2f(o.PROJ[(size_t)t * PROJW + c]);
        else if (c < C_O) { const int e = c - C_V, h = e >> 8, el = e & 255, b = t >> 12, cc = (t & 4095) >> 8, tl = t & 255;
            v = bf2f(o.BT2[((size_t)((b * 4 + h) * 16 + cc) * 256 + el) * 512 + tl]); }
        else if (c < C_IF) v = bf2f(o.PROJ[(size_t)t * PROJW + c - 1024]);
        else if (c < C_G) v = o.gif[(size_t)t * 8 + (c - C_IF)] - b_if[c - C_IF];
        else v = bf2f(o.PROJ[(size_t)t * PROJW + c - C_G + PJ_G]);
        proj[i] = v;
    }
}

struct PrepSrc { const float *w_in, *w_q, *w_k, *w_pool, *w_bp, *w_bm, *w_out, *w_e1, *w_e2, *b_e1; };
constexpr int TI_E1 = 16384, TI_E2 = 8192, TI_IN = (WIN_ROWS / 64) * 16, TI_MO = 512, TI_QK = 128, TI_BP = 128, TI_PL = 16;
constexpr int TI_TOTAL = TI_E1 + TI_E2 + TI_IN + TI_MO + TI_QK + TI_BP + TI_PL;
__device__ __forceinline__ TItem titem_decode(int it, const PrepSrc& p, const OptBufs& ob, const OptBufs2& o2, const OptBufs4& o4, const OptBufs5& o5) {
    TItem t; t.inter = 0; t.fp8 = 0; t.valid = it < TI_TOTAL; t.src = p.w_in; t.dst = ob.WinT; t.ldw = 64; t.ldt = 64;
    if (!t.valid) return t;
    if (it < TI_E1) { const int nb = it & 31, kb = (it >> 5) & 15, e = it >> 9, j0 = nb * 32, pn = j0 >> 7, jj0 = j0 & 127;
        t.src = p.w_e1 + (size_t)e * 1024 * 2048 + (size_t)(kb * 64) * 2048 + nb * 64; t.dst = (pg::bf16_t*)((unsigned char*)o5.We1T + (size_t)e * 2048 * 1024 + (size_t)(pn * 256 + jj0) * 1024 + kb * 64); t.ldw = 2048; t.ldt = 1024; t.inter = 1; t.fp8 = 1; return t; }
    it -= TI_E1;
    if (it < TI_E2) { const int nb = it & 15, kb = (it >> 4) & 15, e = it >> 8;
        t.src = p.w_e2 + (size_t)e * 1024 * 1024 + (size_t)(kb * 64) * 1024 + nb * 64; t.dst = (pg::bf16_t*)((unsigned char*)o5.We2T + (size_t)e * 1024 * 1024 + (size_t)(nb * 64) * 1024 + kb * 64); t.ldw = 1024; t.ldt = 1024; t.fp8 = 1; return t; }
    it -= TI_E2;
    if (it < TI_IN) { const int rb = it >> 4, kb = it & 15;
        t.src = p.w_in + (size_t)(kb * 64) * INC + win_src_col(rb * 64); t.ldw = INC; t.ldt = D;
        if (rb * 64 >= PJ_O && rb * 64 < PROJW) { t.dst = (pg::bf16_t*)(ob.WinQ + (size_t)(rb * 64 - PJ_O) * D + kb * 64); t.fp8 = 1; }
        else t.dst = ob.WinT + (size_t)(rb * 64) * D + kb * 64;
        return t; }
    it -= TI_IN;
    if (it < TI_MO) { const int which = it >> 8, r = it & 255, nb = r >> 4, kb = r & 15;
        t.src = (which ? p.w_out : p.w_bm) + (size_t)(kb * 64) * 1024 + nb * 64; t.dst = (which ? o4.WoutT : o4.WbmT) + (size_t)(nb * 64) * 1024 + kb * 64; t.ldw = 1024; t.ldt = 1024; return t; }
    it -= TI_MO;
    if (it < TI_QK) { const int which = it >> 6, r = it & 63, h = r >> 4, nb = (r & 15) >> 2, kb = r & 3;
        t.src = (which ? p.w_k : p.w_q) + (size_t)h * 65536 + (size_t)(kb * 64) * 256 + nb * 64; t.dst = (which ? o2.WkT : o2.WqT) + (size_t)h * 65536 + (size_t)(nb * 64) * 256 + kb * 64; t.ldw = 256; t.ldt = 256; return t; }
    it -= TI_QK;
    if (it < TI_BP) { const int nb = it >> 3, kb = it & 7;
        t.src = p.w_bp + (size_t)(kb * 64) * 1024 + nb * 64; t.dst = o2.WbpT + (size_t)(nb * 64) * 512 + kb * 64; t.ldw = 1024; t.ldt = 512; return t; }
    it -= TI_BP;
    { const int g = it >> 2, nb = (it & 3) >> 1, kb = it & 1;
        t.src = p.w_pool + (size_t)g * 16384 + (size_t)(kb * 64) * 128 + nb * 64; t.dst = o2.WpoolT + (size_t)(g * 128 + nb * 64) * 512 + g * 128 + kb * 64; t.ldw = 128; t.ldt = 512; return t; }
}
__device__ __forceinline__ void ph_prep_all(LAS unsigned char* lds, const PrepSrc& p, const OptBufs& ob, const OptBufs2& o2, const OptBufs4& o4, const OptBufs5& o5) {
    const int tid = tidf(), lane = tid & 63, wave = tid >> 6, gw = blockIdx.x * NW + wave, ngw = gridDim.x * NW;
    LAS float* scr = (LAS float*)(lds + wave * 16640);
    int it = gw; TItem cur = titem_decode(it, p, ob, o2, o4, o5);
    pg::f32x4 r[16];
    if (cur.valid) titem_load(cur, r, lane);
    while (cur.valid) {
        const int nx = it + ngw; const TItem nxt = titem_decode(nx, p, ob, o2, o4, o5);
        pg::f32x4 rn[16];
        if (nxt.valid) titem_load(nxt, rn, lane);
        titem_store(cur, r, scr, lane);
#pragma unroll
        for (int i = 0; i < 16; ++i) r[i] = rn[i];
        cur = nxt; it = nx;
    }
    { const size_t gt = (size_t)blockIdx.x * NT + tid, ngt = (size_t)gridDim.x * NT;
      for (size_t ch = gt; ch < 512 * 64; ch += ngt) { const int n = (int)(ch >> 6), k8 = (int)(ch & 63) * 8; if ((n >> 7) != (k8 >> 7)) *(pg::u32x4*)(o2.WpoolT + (size_t)n * 512 + k8) = (pg::u32x4){0u, 0u, 0u, 0u}; } }
    for (int i = blockIdx.x * NT + tid; i < 32 * 2048; i += gridDim.x * NT) { const int e = i >> 11, rr = i & 2047, pn = rr >> 8, bj = (rr >> 7) & 1, jj = rr & 127; o5.B1P[i] = p.b_e1[e * 2048 + 2 * (pn * 128 + jj) + bj]; }
}

struct Args { const float* in[26]; float* out; unsigned char* ws; int ph_lo, ph_hi; };
constexpr size_t MiB = 1u << 20;
constexpr size_t WS_CTL = 0;
constexpr size_t CTL_ZERO_BYTES = 1 * MiB;
constexpr int CW_BAR = 4096;
constexpr int CW_CNT = 16384, CW_START = 16384 + 64, CW_FILL = 16384 + 128;

__global__ void __launch_bounds__(NT, 2) mk_fwd(Args a) {
    extern __shared__ __attribute__((aligned(16))) unsigned char lds_raw[];
    LAS unsigned char* lds = (LAS unsigned char*)lds_raw;
    volatile LAS unsigned* MISC = (volatile LAS unsigned*)(lds + MISC_OFF);
    const int tid = tidf();
    if (tid < 32) MISC[tid] = 0u;
    __syncthreads();
    unsigned char* ws = a.ws;
    unsigned* ctl = (unsigned*)(ws + WS_CTL);
    XcdBarrier bar = xcd_barrier_post(ctl + CW_BAR, MISC + 8);
    const float* x = a.in[0]; const float* ln0_g = a.in[1]; const float* ln0_b = a.in[2];
    const float* w_in = a.in[3]; const float* conv_w = a.in[4]; const float* conv_b = a.in[5];
    const float* w_q = a.in[6]; const float* w_k = a.in[7]; const float* b_if = a.in[8];
    const float* mh_gain = a.in[9]; const float* w_pool = a.in[10]; const float* b_pool = a.in[11];
    const float* ls_pool = a.in[12]; const float* w_bp = a.in[13]; const float* w_bm = a.in[14];
    const float* w_out = a.in[15]; const float* ln1_g = a.in[16]; const float* ln1_b = a.in[17];
    const float* w_router = a.in[18]; const float* b_router = a.in[19]; const float* w_e1 = a.in[20];
    const float* b_e1 = a.in[21]; const float* w_e2 = a.in[22]; const float* b_e2 = a.in[23];
    const float* ln2_g = a.in[24]; const float* ln2_b = a.in[25];
    OptBufs ob; ob.WinT = (pg::bf16_t*)(ws + 8 * MiB); ob.H0B = (pg::bf16_t*)(ws + 220 * MiB); ob.PROJ = (pg::bf16_t*)(ws + 252 * MiB); ob.BT2 = (pg::bf16_t*)(ws + 396 * MiB);
    ob.gif = (float*)(ws + 1 * MiB); ob.stats = (float*)(ws + 1 * MiB + 512 * 1024); ob.WinQ = (unsigned char*)(ws + 214 * MiB); ob.H0Q = (unsigned char*)(ws + 972 * MiB);
    OptBufs2 o2; o2.WqT = (pg::bf16_t*)(ws + 19 * MiB); o2.WkT = (pg::bf16_t*)(ws + 19 * MiB + 512 * 1024); o2.WpoolT = (pg::bf16_t*)(ws + 20 * MiB); o2.WbpT = (pg::bf16_t*)(ws + 20 * MiB + 512 * 1024);
    o2.POOLED = (pg::bf16_t*)(ws + 460 * MiB); o2.UC = (pg::bf16_t*)(ws + 476 * MiB); o2.MIXED = (pg::bf16_t*)(ws + 508 * MiB); o2.Q = (pg::bf16_t*)(ws + 524 * MiB); o2.K = (pg::bf16_t*)(ws + 556 * MiB);
    o2.YPOOL = (pg::bf16_t*)(ws + 748 * MiB);
    OptBufs3 o3; o3.KaT = (pg::bf16_t*)(ws + 588 * MiB); o3.A2 = (pg::bf16_t*)(ws + 620 * MiB); o3.U = (float*)(ws + 684 * MiB); o3.HOUT = (pg::bf16_t*)(ws + 780 * MiB);
    { float* sm = (float*)(ws + 2 * MiB); o3.rowv = sm; o3.colv = sm + 65536; o3.winter = sm + 2 * 65536; o3.aw = sm + 3 * 65536; o3.emt = sm + 4 * 65536; o3.den = sm + 5 * 65536; o3.un = sm + 6 * 65536; o3.decay = sm + 7 * 65536; }
    OptBufs4 o4; o4.WbmT = (pg::bf16_t*)(ws + 21 * MiB + 512 * 1024); o4.WoutT = (pg::bf16_t*)(ws + 23 * MiB + 512 * 1024); o4.MERGED = (pg::bf16_t*)(ws + 812 * MiB); o4.Z = (float*)(ws + 844 * MiB); o4.H1B = (pg::bf16_t*)(ws + 908 * MiB); o4.H1Q = (unsigned char*)(ws + 940 * MiB); o4.WRP = (float*)(ws + 7 * MiB + 512 * 1024); o4.CGB = (float*)(ws + 7 * MiB + 768 * 1024);
    o4.elist = (int*)(ws + 4 * MiB); o4.erank = (int*)(ws + 6 * MiB); o4.gate = (float*)(ws + 6 * MiB + 256 * 1024);
    OptBufs5 o5; o5.We1T = (pg::bf16_t*)(ws + 26 * MiB); o5.We2T = (pg::bf16_t*)(ws + 154 * MiB); o5.B1P = (float*)(ws + 7 * MiB);
    o5.ACT = (pg::bf16_t*)(ws + 252 * MiB);
    o5.Y = (pg::bf16_t*)(ws + 396 * MiB);
    int* cnt = (int*)ctl + CW_CNT;
    LAS float* ldsf = (LAS float*)lds;
    const int G = gridDim.x, bx = blockIdx.x;
#define IN(k) (a.ph_lo <= (k) && (k) < a.ph_hi)
#define SEAM(k) do { if (IN(k) && IN((k) + 1)) xcd_barrier(bar); } while (0)
    if (IN(0)) { PrepSrc ps{w_in, w_q, w_k, w_pool, w_bp, w_bm, w_out, w_e1, w_e2, b_e1}; ph_prep_all(lds, ps, ob, o2, o4, o5); ph_router_prep(o4, ln1_g, ln1_b, w_router, b_router); ph_ln0(lds, ob, x, ln0_g, ln0_b, w_in, b_if);
#if PROBE_PH == 0
        { xcd_barrier(bar); if (PROBE_MODE & 1) ph_prep_all(lds, ps, ob, o2, o4, o5); if (PROBE_MODE & 2) ph_ln0(lds, ob, x, ln0_g, ln0_b, w_in, b_if); }
#endif
    }
    SEAM(0);
    if (IN(1)) ph_inproj(lds, ob);
    SEAM(1);
    if (IN(2)) { if (bx >= G - 16) scalar_scan_wg(lds, bx - (G - 16), ob.gif, o3);
                 for (int i = bx * NT + tid; i < T * 4; i += G * NT) o3.den[i] = 0.f;
                 ph_poolconv_opt(ob.PROJ, conv_w, conv_b, o2.POOLED, o2.UC); }
    SEAM(2);
    if (IN(3)) ph_gemms_D(lds, o2, o3, b_pool, ls_pool);
    SEAM(3);
    if (IN(4)) { ph_gemm_ypool(lds, o2); ph_gemms_E(lds, ob, o2, o3);
#if PROBE_PH == 4
        { xcd_barrier(bar); OptBufs3 d3 = o3; d3.den = (float*)(ws + 980 * MiB); ph_gemm_ypool(lds, o2); ph_gemms_E(lds, ob, o2, d3); }
#endif
    }
    SEAM(4);
    if (IN(5)) { ph_state_scan(ob, o3); ph_den_inter(lds, o3);
#if PROBE_PH == 5
        { xcd_barrier(bar); OptBufs3 d3 = o3; d3.den = (float*)(ws + 980 * MiB); ph_state_scan(ob, d3); ph_den_inter(lds, d3); }
#endif
    }
    SEAM(5);
    if (IN(6)) ph_gemm_G3(lds, ob, o3, mh_gain);
    SEAM(6);
    if (IN(7)) ph_gemm_ymls(lds, ob, o2, o3, o4);
    SEAM(7);
    if (IN(8)) ph_gemm_mix(lds, ob, o4, x, ln0_g, ln0_b);
    SEAM(8);
    if (IN(9)) { ph_ln1_router(lds, o4, o4.Z, ln1_g, ln1_b, cnt);
#if PROBE_PH == 9
        { xcd_barrier(bar); OptBufs4 d4 = o4; d4.Z = (float*)(ws + 684 * MiB); d4.H1B = (pg::bf16_t*)(ws + 588 * MiB); d4.H1Q = (unsigned char*)(ws + 620 * MiB); d4.elist = (int*)(ws + 980 * MiB); d4.erank = (int*)(ws + 984 * MiB); d4.gate = (float*)(ws + 986 * MiB);
          ph_ln1_router(lds, d4, o4.Z, ln1_g, ln1_b, cnt + 256, PROBE_MODE); }
#endif
    }
    SEAM(9);
    if (IN(10)) { ph_moe1(lds, o4, o5, cnt);
#if PROBE_PH == 10
        { xcd_barrier(bar); ph_moe1_probe(lds, o4, o5, cnt, PROBE_MODE, (unsigned char*)(ws + 956 * MiB)); }
#endif
    }
    SEAM(10);
    if (IN(11)) ph_moe2(lds, o5, cnt, b_e2);
    SEAM(11);
    if (IN(12)) { ph_final_opt(lds, o4, o5, cnt, ln2_g, ln2_b, a.out);
#if PROBE_PH == 12
        { xcd_barrier(bar); ph_final_opt(lds, o4, o5, cnt, ln2_g, ln2_b, a.out); }
#endif
    }
}
constexpr int NPH = 13;
}

extern "C" void kernel_launch(void* const* d_in, const int* in_sizes, int n_in, void* d_out, int out_size, void* d_ws, size_t ws_size, hipStream_t stream) {
    using namespace mk;
    static int grid = 0;
    if (grid == 0) {
        if (n_in != 26 || ws_size < 1000 * MiB) { fprintf(stderr, "kernel_launch: unexpected n_in %d / ws %zu\n", n_in, ws_size); grid = -1; return; }
        int dev = 0, cus = 0, per_cu = 0;
        hipGetDevice(&dev); hipDeviceGetAttribute(&cus, hipDeviceAttributeMultiprocessorCount, dev);
        if (hipFuncSetAttribute((const void*)mk_fwd, hipFuncAttributeMaxDynamicSharedMemorySize, LDS_BYTES) != hipSuccess) { fprintf(stderr, "hipFuncSetAttribute failed\n"); grid = -1; return; }
        if (hipOccupancyMaxActiveBlocksPerMultiprocessor(&per_cu, (const void*)mk_fwd, NT, LDS_BYTES) != hipSuccess || per_cu < 1) { fprintf(stderr, "occupancy query failed (%d)\n", per_cu); grid = -1; return; }
        grid = cus * 1;
        fprintf(stderr, "kernel_launch: cus %d per_cu %d grid %d\n", cus, per_cu, grid);
    }
    if (grid < 0) return;
    hipMemsetAsync((char*)d_ws + WS_CTL, 0, CTL_ZERO_BYTES, stream);
    Args a{};
    for (int i = 0; i < 26; ++i) a.in[i] = (const float*)d_in[i];
    a.out = (float*)d_out; a.ws = (unsigned char*)d_ws; a.ph_lo = 0; a.ph_hi = NPH;
    void* args[] = {&a};
    hipError_t e = hipLaunchCooperativeKernel((const void*)mk_fwd, dim3(grid), dim3(NT), args, LDS_BYTES, stream);
    if (e != hipSuccess) fprintf(stderr, "cooperative launch failed: %s (grid %d)\n", hipGetErrorString(e), grid);
}
```

```cpp
#include <hip/hip_runtime.h>
#include <cstdio>
#include <cstdint>

#define LAS __attribute__((address_space(3)))
#ifndef PROBE_PH
#define PROBE_PH -1
#endif
#define PROBE_MODE 7
namespace mk {
constexpr int D = 1024, BATCH = 4, SEQ = 4096, T = BATCH * SEQ;
constexpr int INC = 5640;
constexpr int C_P = 0, C_U = 512, C_V = 1536, C_O = 2560, C_IF = 3584, C_G = 3592;
constexpr int NE = 32, TOPK = 4, NA = T * TOPK;
constexpr float LN_EPS = 1e-5f;
constexpr float ALPHA = 1.189207115002721f;
constexpr int NT = 512, NW = 8;
constexpr int LDS_BYTES = 147456, MISC_OFF = 147456 - 512;

#define XB_TMO      128
#define XB_XCNT(j)  (256  + 64 * (j))
#define XB_XSUB(j)  (1280 + 64 * (j))
#define XB_XGEN(j)  (2304 + 64 * (j))
#define XB_TOP      3328
#define XB_TOPGEN   3392
#define XCD_BAR_WORDS 3456
#define XB_SPIN_CAP (1u << 22)
__device__ __forceinline__ unsigned xb_ld(unsigned* p)              { return __hip_atomic_load(p, __ATOMIC_RELAXED, __HIP_MEMORY_SCOPE_AGENT); }
__device__ __forceinline__ unsigned xb_add(unsigned* p, unsigned v) { return __hip_atomic_fetch_add(p, v, __ATOMIC_RELAXED, __HIP_MEMORY_SCOPE_AGENT); }
__device__ __forceinline__ unsigned xb_xcc_id() { return (unsigned)__builtin_amdgcn_s_getreg((3 << 11) | 20) & 0xFu; }
#define XB_SPIN(cond, bar) do { unsigned _sp = 0; while (cond) { __builtin_amdgcn_s_sleep(1); \
    if ((++_sp & 255u) == 0u) { if (xb_ld(&(bar)[XB_TMO])) break; if (_sp > XB_SPIN_CAP) { atomicAdd(&(bar)[XB_TMO], 1u); break; } } } } while (0)
struct XcdBarrier { unsigned* bar; unsigned x; volatile LAS unsigned* st; };
__device__ __forceinline__ XcdBarrier xcd_barrier_post(unsigned* bar, volatile LAS unsigned* st) {
    XcdBarrier b; b.bar = bar; b.x = xb_xcc_id(); b.st = st;
    if (threadIdx.x == 0) (void)xb_add(&bar[XB_XCNT(b.x)], 1u);
    return b;
}
__device__ __forceinline__ void xcd_barrier_complete(unsigned* bar, unsigned x, unsigned& nloc, unsigned& nx) {
    const unsigned G = gridDim.x * gridDim.y * gridDim.z;
    unsigned sum, cnt, mine, sp = 0u;
    for (;;) {
        sum = 0u; cnt = 0u; mine = 0u;
#pragma unroll
        for (unsigned j = 0; j < 16; ++j) { const unsigned c = xb_ld(&bar[XB_XCNT(j)]); sum += c; cnt += (c > 0u) ? 1u : 0u; mine = (j == x) ? c : mine; }
        if (sum == G) break;
        __builtin_amdgcn_s_sleep(1);
        if ((++sp & 255u) == 0u) { if (xb_ld(&bar[XB_TMO])) break; if (sp > XB_SPIN_CAP) { atomicAdd(&bar[XB_TMO], 1u); break; } }
    }
    nloc = mine > 0u ? mine : 1u; nx = cnt > 0u ? cnt : 1u;
}
__device__ __forceinline__ void xcd_barrier(const XcdBarrier& b) {
    asm volatile("s_waitcnt vmcnt(0)" ::: "memory");
    __syncthreads();
    if (threadIdx.x == 0) {
        unsigned* bar = b.bar;
        __builtin_amdgcn_s_waitcnt(0);
        unsigned nloc = b.st[0], nx = b.st[1];
        if (nloc == 0u) { xcd_barrier_complete(bar, b.x, nloc, nx); b.st[0] = nloc; b.st[1] = nx; }
        const unsigned old = xb_add(&bar[XB_XSUB(b.x)], 1u);
        const unsigned gen = old / nloc;
        if (old + 1u == (gen + 1u) * nloc) {
            __builtin_amdgcn_fence(__ATOMIC_RELEASE, "agent");
            asm volatile("s_waitcnt vmcnt(0)" ::: "memory");
            const unsigned og = xb_add(&bar[XB_TOP], 1u);
            const unsigned tg = og / nx;
            if (og + 1u == (tg + 1u) * nx) xb_add(&bar[XB_TOPGEN], 1u);
            else XB_SPIN(xb_ld(&bar[XB_TOPGEN]) == tg, bar);
            __builtin_amdgcn_fence(__ATOMIC_ACQUIRE, "agent");
            xb_add(&bar[XB_XGEN(b.x)], 1u);
            asm volatile("s_waitcnt vmcnt(0)" ::: "memory");
        } else {
            XB_SPIN(xb_ld(&bar[XB_XGEN(b.x)]) == gen, bar);
            __builtin_amdgcn_fence(__ATOMIC_ACQUIRE, "agent");
            asm volatile("s_waitcnt vmcnt(0)" ::: "memory");
        }
    }
    __syncthreads();
}

__device__ __forceinline__ int tidf() { int t = threadIdx.x; asm volatile("" : "+v"(t)); return t; }
__device__ __forceinline__ float wsum(float v) {
#pragma unroll
    for (int o = 1; o < 64; o <<= 1) v += __shfl_xor(v, o);
    return v;
}
__device__ __forceinline__ float sigmoidf_(float x) { return 1.f / (1.f + expf(-x)); }
__device__ __forceinline__ float fsigmoid(float x) { return __builtin_amdgcn_rcpf(1.f + __expf(-x)); }

__device__ __forceinline__ void ph_ln(const float* a, const float* b, const float* g, const float* beta, float* y, float scale) {
    const int lane = tidf() & 63, gw = blockIdx.x * NW + (tidf() >> 6), ngw = gridDim.x * NW;
    for (int row = gw; row < T; row += ngw) {
        float v[16]; float s = 0.f;
#pragma unroll
        for (int j = 0; j < 16; ++j) { const int c = lane + 64 * j; float x = a[(size_t)row * D + c] * scale; if (b) x += b[(size_t)row * D + c]; v[j] = x; s += x; }
        const float mu = wsum(s) * (1.f / D); float q = 0.f;
#pragma unroll
        for (int j = 0; j < 16; ++j) { const float d = v[j] - mu; q += d * d; }
        const float rstd = rsqrtf(wsum(q) * (1.f / D) + LN_EPS);
#pragma unroll
        for (int j = 0; j < 16; ++j) { const int c = lane + 64 * j; y[(size_t)row * D + c] = (v[j] - mu) * rstd * g[c] + beta[c]; }
    }
}
struct EpiPlain { static constexpr bool PAIR = false; float* C; int ldc; float scale;
    __device__ void operator()(int m, int n, float v, int z) const { C[(size_t)m * ldc + n] = v * scale; } };
struct EpiPoolMix { static constexpr bool PAIR = false; float* C; const float* b; const float* ls;
    __device__ void operator()(int m, int n, float v, int z) const { const int c = z * 128 + n; C[(size_t)m * 512 + c] = (v + b[c]) * ls[c]; } };
struct EpiHead { static constexpr bool PAIR = false; float* C; float scale;
    __device__ void operator()(int m, int n, float v, int z) const { C[(size_t)m * 1024 + z * 256 + n] = v * scale; } };
struct EpiE1 { static constexpr bool PAIR = true; float* act; const float* b1;
    __device__ void pair(int m, int n, float vg, float vl, int z) const {
        float g = vg + b1[z * 2048 + n], l = vl + b1[z * 2048 + n + 1];
        g = fminf(g, 7.f); l = fminf(fmaxf(l, -7.f), 7.f);
        act[(size_t)m * 1024 + (n >> 1)] = g * sigmoidf_(1.702f * g) * (l + 1.f); } };
struct EpiE2 { static constexpr bool PAIR = false; float* Y; const float* b2;
    __device__ void operator()(int m, int n, float v, int z) const { Y[(size_t)m * 1024 + n] = v + b2[z * 1024 + n]; } };

template <class Epi>
__device__ __forceinline__ void ph_gemm(LAS float* lds, const float* A, const int* rowidx, const float* B, const int* mcount, const int* mstart,
                                        size_t strideA, size_t strideB, const Epi& epi, int lda, int ldb, int M, int N, int K, int nz, int vb0, int nvb) {
    LAS float* As = lds;
    LAS float* Bs = lds + 16 * 129;
    const int tid = tidf(), tx = tid & 15, ty = tid >> 4;
    const int ntn = (N + 63) / 64, ntm = (M + 127) / 128, per_z = ntn * ntm, total = per_z * nz;
    for (int vt = vb0; vt < total; vt += nvb) {
        const int z = vt / per_z, r = vt % per_z, bm = (r / ntn) * 128, bn = (r % ntn) * 64;
        int Mz = M, m0g = 0;
        if (mcount) { Mz = mcount[z]; m0g = mstart[z]; }
        if (bm >= Mz) continue;
        const float* Az = A + z * strideA; const float* Bz = B + z * strideB;
        float acc[4][4] = {};
        const int ar = tid >> 2, ak = (tid & 3) * 4;
        const int arow = bm + ar; const bool aval = arow < Mz; int asrc = 0;
        if (aval) { const int gr = m0g + arow; asrc = rowidx ? rowidx[gr] : gr; }
        const int bk = tid >> 5, bn2 = (tid & 31) * 2;
        for (int k0 = 0; k0 < K; k0 += 16) {
            float4 av = make_float4(0.f, 0.f, 0.f, 0.f);
            if (aval) av = *(const float4*)(Az + (size_t)asrc * lda + k0 + ak);
            As[(ak + 0) * 129 + ar] = av.x; As[(ak + 1) * 129 + ar] = av.y; As[(ak + 2) * 129 + ar] = av.z; As[(ak + 3) * 129 + ar] = av.w;
#pragma unroll
            for (int j = 0; j < 2; ++j) { const int n = bn + bn2 + j; Bs[bk * 65 + bn2 + j] = (n < N) ? Bz[(size_t)(k0 + bk) * ldb + n] : 0.f; }
            __syncthreads();
#pragma unroll
            for (int kk = 0; kk < 16; ++kk) {
                float a[4], b[4];
#pragma unroll
                for (int i = 0; i < 4; ++i) { a[i] = As[kk * 129 + ty * 4 + i]; b[i] = Bs[kk * 65 + tx * 4 + i]; }
#pragma unroll
                for (int i = 0; i < 4; ++i)
#pragma unroll
                    for (int j = 0; j < 4; ++j) acc[i][j] += a[i] * b[j];
            }
            __syncthreads();
        }
#pragma unroll
        for (int i = 0; i < 4; ++i) { const int m = bm + ty * 4 + i; if (m >= Mz) continue;
            if constexpr (Epi::PAIR) {
#pragma unroll
                for (int j = 0; j < 4; j += 2) { const int n = bn + tx * 4 + j; if (n < N) epi.pair(m0g + m, n, acc[i][j], acc[i][j + 1], z); }
            } else {
#pragma unroll
                for (int j = 0; j < 4; ++j) { const int n = bn + tx * 4 + j; if (n < N) epi(m0g + m, n, acc[i][j], z); }
            } }
    }
}
__device__ __forceinline__ void ph_pool_conv(const float* proj, const float* cw, const float* cb, float* pooled, float* uc) {
    const size_t gt = (size_t)blockIdx.x * NT + tidf(), ngt = (size_t)gridDim.x * NT;
    for (size_t i = gt; i < (size_t)T * 512; i += ngt) {
        const int c = (int)(i % 512); const int tg = (int)(i / 512); const int t = tg % SEQ;
        const int w = 2 << (c >> 7);
        const int cnt = (t + 1 < w) ? t + 1 : w; float s = 0.f;
        for (int j = 0; j < cnt; ++j) s += proj[(size_t)(tg - j) * INC + C_P + c];
        pooled[i] = s / (float)cnt - proj[(size_t)tg * INC + C_P + c];
    }
    for (size_t i = gt; i < (size_t)T * 1024; i += ngt) {
        const int c = (int)(i % 1024); const int tg = (int)(i / 1024); const int t = tg % SEQ;
        float y = cb[c];
#pragma unroll
        for (int j = 0; j < 4; ++j) { const int tt = t - 3 + j; if (tt >= 0) y += proj[(size_t)(tg - 3 + j) * INC + C_U + c] * cw[j * 1024 + c]; }
        uc[i] = y * sigmoidf_(y);
    }
}
constexpr int MB = 16;
__device__ __forceinline__ void ph_mlstm(LAS float* lds, int vb, const float* q, const float* k, const float* vv, const float* gif, float* hm) {
    const int bh = vb >> 1, b = bh >> 2, h = bh & 3;
    const int tid = tidf(), e = (vb & 1) * 128 + (tid >> 2), dq = tid & 3;
    LAS float* sq = lds; LAS float* sk = lds + MB * 256; LAS float* sv = lds + 2 * MB * 256; LAS float* si = lds + 3 * MB * 256; LAS float* sf = si + MB;
    float C[64]; float n[16];
#pragma unroll
    for (int j = 0; j < 64; ++j) C[j] = 0.f;
#pragma unroll
    for (int j = 0; j < 16; ++j) n[j] = 0.f;
    float m = 0.f;
    const int nsub = (e & 3) * 16;
    for (int t0 = 0; t0 < SEQ; t0 += MB) {
        __syncthreads();
        for (int i = tid; i < MB * 256; i += NT) { const int tt = i >> 8, d = i & 255; const size_t tg = (size_t)b * SEQ + t0 + tt;
            sq[tt * 256 + d] = q[tg * 1024 + h * 256 + d]; sk[tt * 256 + d] = k[tg * 1024 + h * 256 + d]; sv[tt * 256 + d] = vv[tg * 1024 + h * 256 + d]; }
        if (tid < MB) { const size_t tg = (size_t)b * SEQ + t0 + tid; si[tid] = gif[tg * 8 + h]; sf[tid] = gif[tg * 8 + 4 + h]; }
        __syncthreads();
        for (int tt = 0; tt < MB; ++tt) {
            const float ip = si[tt], fp = sf[tt];
            const float lf = fminf(fp, 0.f) - log1pf(expf(-fabsf(fp)));
            const float mn = fmaxf(lf + m, ip);
            const float fd = expf(lf + m - mn), iw = expf(ip - mn);
            m = mn;
            const float ve = sv[tt * 256 + e] * iw;
            float num = 0.f, den = 0.f;
#pragma unroll
            for (int j = 0; j < 64; ++j) { const float kk = sk[tt * 256 + dq * 64 + j]; C[j] = fd * C[j] + ve * kk; num += C[j] * sq[tt * 256 + dq * 64 + j]; }
#pragma unroll
            for (int j = 0; j < 16; ++j) { const int d = dq * 64 + nsub + j; n[j] = fd * n[j] + iw * sk[tt * 256 + d]; den += n[j] * sq[tt * 256 + d]; }
            num += __shfl_xor(num, 1); num += __shfl_xor(num, 2);
            den += __shfl_xor(den, 1); den += __shfl_xor(den, 2); den += __shfl_xor(den, 4); den += __shfl_xor(den, 8);
            if (dq == 0) { const float dn = fmaxf(fabsf(den), expf(-mn)); hm[((size_t)b * SEQ + t0 + tt) * 1024 + h * 256 + e] = num / dn; }
        }
    }
    __syncthreads();
}
__device__ __forceinline__ void ph_hnorm(float* hm, const float* opre, const float* gain) {
    const int lane = tidf() & 63, gw = blockIdx.x * NW + (tidf() >> 6), ngw = gridDim.x * NW;
    for (int w = gw; w < T * 4; w += ngw) {
        const int tg = w >> 2, h = w & 3;
        float v[4]; float s = 0.f;
#pragma unroll
        for (int j = 0; j < 4; ++j) { v[j] = hm[(size_t)tg * 1024 + h * 256 + lane + 64 * j]; s += v[j]; }
        const float mu = wsum(s) * (1.f / 256); float qq = 0.f;
#pragma unroll
        for (int j = 0; j < 4; ++j) { const float d = v[j] - mu; qq += d * d; }
        const float rstd = rsqrtf(wsum(qq) * (1.f / 256) + LN_EPS);
#pragma unroll
        for (int j = 0; j < 4; ++j) { const int c = h * 256 + lane + 64 * j; hm[(size_t)tg * 1024 + c] = (v[j] - mu) * rstd * gain[c] * sigmoidf_(opre[(size_t)tg * 1024 + c]); }
    }
}
__device__ __forceinline__ void ph_merge(const float* gates, const float* ypool, float* ymls) {
    const size_t gt = (size_t)blockIdx.x * NT + tidf(), ngt = (size_t)gridDim.x * NT;
    for (size_t i = gt; i < (size_t)T * 1024; i += ngt) {
        const int c = (int)(i % 1024); const size_t tg = i / 1024;
        const float g0 = sigmoidf_(gates[tg * 2048 + c]), g1 = sigmoidf_(gates[tg * 2048 + 1024 + c]);
        ymls[i] = g0 * ypool[i] + g1 * ymls[i];
    }
}
__device__ __forceinline__ void ph_router(const float* h1, const float* wr, const float* br, int* top_idx, float* top_gate, int* cnt) {
    const int lane = tidf() & 63, gw = blockIdx.x * NW + (tidf() >> 6), ngw = gridDim.x * NW;
    for (int tg = gw; tg < T; tg += ngw) {
        const int e = lane & 31, half = lane >> 5;
        float s = 0.f;
        for (int kk = 0; kk < 512; ++kk) { const int kx = half * 512 + kk; s += h1[(size_t)tg * D + kx] * wr[kx * NE + e]; }
        s += __shfl_xor(s, 32); s += br[e];
        float val = s; int idxs[4]; float vals[4];
#pragma unroll
        for (int r = 0; r < 4; ++r) {
            float bv = val; int bi = e;
#pragma unroll
            for (int o = 1; o < 32; o <<= 1) { const float ov = __shfl_xor(bv, o); const int oi = __shfl_xor(bi, o); if (ov > bv || (ov == bv && oi < bi)) { bv = ov; bi = oi; } }
            idxs[r] = bi; vals[r] = bv; if (e == bi) val = -INFINITY;
        }
        const float mx = vals[0]; float ex[4], se = 0.f;
#pragma unroll
        for (int r = 0; r < 4; ++r) { ex[r] = expf(vals[r] - mx); se += ex[r]; }
#pragma unroll
        for (int r = 0; r < 4; ++r) if (lane == r) { top_idx[tg * 4 + r] = idxs[r]; top_gate[tg * 4 + r] = ex[r] / se; atomicAdd(&cnt[idxs[r]], 1); }
    }
}
__device__ __forceinline__ void ph_place(const int* top_idx, const int* start, int* fill, int* row_tok, int* row_of) {
    const int gt = blockIdx.x * NT + tidf(), ngt = gridDim.x * NT;
    for (int i = gt; i < NA; i += ngt) { const int e = top_idx[i]; const int r = atomicAdd(&fill[e], 1); const int dest = start[e] + r; row_tok[dest] = i >> 2; row_of[i] = dest; }
}
__device__ __forceinline__ void ph_final(const float* h1, const float* Y, const int* row_of, const float* gate, const float* g, const float* beta, float* out) {
    const int lane = tidf() & 63, gw = blockIdx.x * NW + (tidf() >> 6), ngw = gridDim.x * NW;
    for (int tg = gw; tg < T; tg += ngw) {
        int ro[4]; float gt[4];
#pragma unroll
        for (int r = 0; r < 4; ++r) { ro[r] = row_of[tg * 4 + r]; gt[r] = gate[tg * 4 + r]; }
        float v[16]; float s = 0.f;
#pragma unroll
        for (int j = 0; j < 16; ++j) { const int c = lane + 64 * j; float x = ALPHA * h1[(size_t)tg * D + c];
#pragma unroll
            for (int r = 0; r < 4; ++r) x += gt[r] * Y[(size_t)ro[r] * 1024 + c];
            v[j] = x; s += x; }
        const float mu = wsum(s) * (1.f / D); float qq = 0.f;
#pragma unroll
        for (int j = 0; j < 16; ++j) { const float d = v[j] - mu; qq += d * d; }
        const float rstd = rsqrtf(wsum(qq) * (1.f / D) + LN_EPS);
#pragma unroll
        for (int j = 0; j < 16; ++j) { const int c = lane + 64 * j; out[(size_t)tg * D + c] = (v[j] - mu) * rstd * g[c] + beta[c]; }
    }
}


namespace pg {
typedef unsigned short bf16_t;
typedef short bf16x8 __attribute__((ext_vector_type(8)));
typedef float f32x4 __attribute__((ext_vector_type(4)));
typedef float f32x2 __attribute__((ext_vector_type(2)));
typedef unsigned u32x4 __attribute__((ext_vector_type(4)));
typedef unsigned u32x2 __attribute__((ext_vector_type(2)));
constexpr int BM = 256, BK = 64, HALF = 128, HTB = HALF * BK * 2, STAGE_BYTES = 8 * HTB, NXCD = 8, WGM = 8;
__host__ __device__ __forceinline__ int lds_byte(int r, int c) { const int st = (r >> 4) * 2 + (c >> 5), rr = r & 15, cc = c & 31, ob = rr * 64 + cc * 2; return st * 1024 + (ob ^ (((ob >> 9) & 1) << 5)); }
__host__ __device__ __forceinline__ void stage_rc(int b, int& R, int& C) { const int st = b / 1024, sb = b % 1024, swz = sb ^ (((sb >> 9) & 1) << 5); R = (st >> 1) * 16 + swz / 64; C = (st & 1) * 32 + (swz % 64) / 2; }
__host__ __device__ __forceinline__ int perm32(int rho) { const int n = rho >> 4, i = rho & 15; return 8 * (i >> 2) + 4 * n + (i & 3); }
__device__ __forceinline__ unsigned cvt_pk_bf16(float lo, float hi) { unsigned r; asm volatile("v_cvt_pk_bf16_f32 %0, %1, %2" : "=v"(r) : "v"(lo), "v"(hi)); return r; }

struct Unit { const char* A; const char* B; const int* rows; int nvalid; int pm, pn, g, aux; };

struct TileOrder {
    int nM, nN, per_g, nwg, G, c;
    __device__ __forceinline__ void init(int nM_, int nN_, int ng, int G_, int c_) { nM = nM_; nN = nN_; per_g = nM * nN; nwg = per_g * ng; G = G_; c = c_; }
    __device__ __forceinline__ bool tile(int i, int& g, int& pm, int& pn) const {
        const long L = (long)i * G + c; if (L >= nwg) return false;
        int wgid = (int)L; { const int q = nwg / NXCD, r = nwg % NXCD, xcd = wgid % NXCD, off = wgid / NXCD; wgid = (xcd < r ? xcd * (q + 1) : r * (q + 1) + (xcd - r) * q) + off; }
        g = wgid / per_g; wgid -= g * per_g;
        const int nig = WGM * nN, gid = wgid / nig, fm = gid * WGM, gsz = (nM - fm) < WGM ? (nM - fm) : WGM;
        pm = fm + ((wgid % nig) % gsz); pn = (wgid % nig) / gsz; return true;
    }
};

typedef int i32x8 __attribute__((ext_vector_type(8)));
typedef int i32x4 __attribute__((ext_vector_type(4)));
template <class Epi, class Sched, bool GATHER = false, bool FP8 = false>
__device__ __forceinline__ void gemm_phase(LAS unsigned char* lds, const int lda, const int ldb, const int K, const Sched& S, const Epi& E) {
    const int tid = tidf(), wid = __builtin_amdgcn_readfirstlane(tid >> 6), lane = tid & 63, wr = wid >> 2, wc = wid & 3, fr = lane & 15, fq = lane >> 4;
    const int nt = K / BK;
    unsigned voffA[2], voffB[2];
#pragma unroll
    for (int i = 0; i < 2; ++i) { int R, C; stage_rc(tid * 16 + i * 8192, R, C); const int Rb = Epi::PERM ? ((R & ~31) + perm32(R & 31)) : R;
        voffA[i] = (unsigned)(R * lda + C) * 2u; voffB[i] = (unsigned)(Rb * ldb + C) * 2u; }
    const size_t kstep = (size_t)(BK * 2);
    const size_t hstepA = GATHER ? 0 : (size_t)HALF * lda * 2, hstepB = (size_t)HALF * ldb * 2;
    const unsigned ldsw = (unsigned)wid * 1024u;
    const int aoff = lds_byte(wr * 64 + fr, fq * 8), boff = lds_byte(wc * 32 + fr, fq * 8);
#define PG_SA(b, h) (((b) * 2 + (h)) * HTB)
#define PG_SB(b, h) ((4 + (b) * 2 + (h)) * HTB)
#define PG_STAGE(bufoff, gbase, voff) do { _Pragma("unroll") for (int _i = 0; _i < 2; ++_i) \
        __builtin_amdgcn_global_load_lds((const unsigned*)((const char*)(gbase) + (voff)[_i]), (LAS unsigned*)(lds + (bufoff) + ldsw + _i * 8192), 16, 0, 0); } while (0)
#define PG_LDA(dst, b, h) do { _Pragma("unroll") for (int m = 0; m < 4; ++m) { if constexpr (FP8) { \
        const i32x4 _lo = *(const LAS i32x4*)(lds + PG_SA(b, h) + aoff + m * 2048), _hi = *(const LAS i32x4*)(lds + PG_SA(b, h) + aoff + m * 2048 + 1024); \
        dst##8[m] = __builtin_shufflevector(_lo, _hi, 0, 1, 2, 3, 4, 5, 6, 7); } \
        else { _Pragma("unroll") for (int k = 0; k < 2; ++k) dst[m][k] = *(const LAS bf16x8*)(lds + PG_SA(b, h) + aoff + m * 2048 + k * 1024); } } } while (0)
#define PG_LDB(dst, b, h) do { _Pragma("unroll") for (int n = 0; n < 2; ++n) { if constexpr (FP8) { \
        const i32x4 _lo = *(const LAS i32x4*)(lds + PG_SB(b, h) + boff + n * 2048), _hi = *(const LAS i32x4*)(lds + PG_SB(b, h) + boff + n * 2048 + 1024); \
        dst##8[n] = __builtin_shufflevector(_lo, _hi, 0, 1, 2, 3, 4, 5, 6, 7); } \
        else { _Pragma("unroll") for (int k = 0; k < 2; ++k) dst[n][k] = *(const LAS bf16x8*)(lds + PG_SB(b, h) + boff + n * 2048 + k * 1024); } } } while (0)
#define PG_MMA(ai, bj, At, Bt) do { __builtin_amdgcn_s_setprio(1); _Pragma("unroll") for (int m = 0; m < 4; ++m) _Pragma("unroll") for (int n = 0; n < 2; ++n) { \
        if constexpr (FP8) asm volatile("v_mfma_scale_f32_16x16x128_f8f6f4 %0, %1, %2, %0, %3, %4 op_sel_hi:[0,0,0]" : "+v"(acc[ai][bj][m][n]) : "v"(Bt##8[n]), "v"(At##8[m]), "v"(sc_w), "v"(sc_a)); \
        else { _Pragma("unroll") for (int k = 0; k < 2; ++k) acc[ai][bj][m][n] = __builtin_amdgcn_mfma_f32_16x16x32_bf16(Bt[n][k], At[m][k], acc[ai][bj][m][n], 0, 0, 0); } } \
        __builtin_amdgcn_s_setprio(0); } while (0)
#define PG_WAIT_V(n) asm volatile("s_waitcnt vmcnt(" #n ")" ::: "memory")
#define PG_WAIT_L(n) asm volatile("s_waitcnt lgkmcnt(" #n ")" ::: "memory")
#define PG_BAR __builtin_amdgcn_s_barrier()
#define PG_SCHED __builtin_amdgcn_sched_barrier(0)
    Unit cur, nxt; int ui = 0;
    if (!S.next(0, cur)) return;
    f32x4 acc[2][2][4][2];
    f32x4 bini[2][2];
#pragma unroll
    for (int b = 0; b < 2; ++b)
#pragma unroll
        for (int n = 0; n < 2; ++n) bini[b][n] = (f32x4){0.f, 0.f, 0.f, 0.f};
    if constexpr (Epi::BIAS) { const float* bp = E.bias_base(cur) + wc * 32 + (Epi::PERM ? 8 * fq : 4 * fq);
#pragma unroll
        for (int b = 0; b < 2; ++b)
#pragma unroll
            for (int n = 0; n < 2; ++n) bini[b][n] = *(const f32x4*)(bp + b * HALF + (Epi::PERM ? 4 * n : 16 * n)); }
#pragma unroll
    for (int a = 0; a < 2; ++a)
#pragma unroll
        for (int b = 0; b < 2; ++b)
#pragma unroll
            for (int m = 0; m < 4; ++m)
#pragma unroll
                for (int n = 0; n < 2; ++n) acc[a][b][m][n] = bini[b][n];
    bf16x8 At[4][2], B0[2][2], B1[2][2]; i32x8 At8[4], B08[2], B18[2]; const int sc_w = 0x79797979, sc_a = 0x7f7f7f7f;
    unsigned gA0[2], gA1[2], nA0[2], nA1[2];
    auto gather_offs = [&](const Unit& u, unsigned (&o0)[2], unsigned (&o1)[2]) {
#pragma unroll
        for (int i = 0; i < 2; ++i) { int R_, C_; stage_rc(tid * 16 + i * 8192, R_, C_);
            const int r0 = R_, r1 = HALF + R_;
            const int t0 = (r0 < u.nvalid) ? u.rows[r0] : 0, t1 = (r1 < u.nvalid) ? u.rows[r1] : 0;
            o0[i] = (unsigned)(t0 * lda + C_) * 2u; o1[i] = (unsigned)(t1 * lda + C_) * 2u; }
    };
    if constexpr (GATHER) { gather_offs(cur, gA0, gA1); } else {
#pragma unroll
        for (int i = 0; i < 2; ++i) { gA0[i] = voffA[i]; gA1[i] = voffA[i]; nA0[i] = voffA[i]; nA1[i] = voffA[i]; } }
    const char* cA = cur.A; const char* cB = cur.B;
    PG_STAGE(PG_SB(0, 0), cB, voffB); PG_STAGE(PG_SB(0, 1), cB + hstepB, voffB); PG_STAGE(PG_SA(0, 0), cA, gA0); PG_STAGE(PG_SA(0, 1), cA + hstepA, gA1);
    if (wr == 1) PG_BAR;
    PG_WAIT_V(2); PG_BAR;
    PG_STAGE(PG_SB(1, 0), cB + kstep, voffB); PG_STAGE(PG_SA(1, 0), cA + kstep, gA0); PG_STAGE(PG_SB(1, 1), cB + hstepB + kstep, voffB);
    PG_WAIT_V(6); PG_BAR;
    for (;;) {
        const bool has_next = S.next(ui + 1, nxt);
        const char* nA = has_next ? nxt.A : cA; const char* nB = has_next ? nxt.B : cB;
        if constexpr (GATHER) { if (has_next) gather_offs(nxt, nA0, nA1); else {
#pragma unroll
            for (int i = 0; i < 2; ++i) { nA0[i] = gA0[i]; nA1[i] = gA1[i]; } } }
#pragma unroll 1
        for (int t = 0; t < nt; t += 2) {
            const bool last = (t == nt - 2);
            const char* a1 = cA + (size_t)(t + 1) * kstep;
            const char* a2 = last ? nA : cA + (size_t)(t + 2) * kstep; const char* b2 = last ? nB : cB + (size_t)(t + 2) * kstep;
            const char* a3 = a2 + kstep; const char* b3 = b2 + kstep;
            unsigned x0[2], x1[2];
#pragma unroll
            for (int i = 0; i < 2; ++i) { x0[i] = (GATHER && last) ? nA0[i] : gA0[i]; x1[i] = (GATHER && last) ? nA1[i] : gA1[i]; }
            PG_LDB(B0, 0, 0); PG_LDB(B1, 0, 1); PG_SCHED; PG_LDA(At, 0, 0); PG_STAGE(PG_SA(1, 1), a1 + hstepA, gA1);
            PG_WAIT_V(8); PG_WAIT_L(0); PG_BAR; PG_MMA(0, 0, At, B0); PG_MMA(0, 1, At, B1); PG_BAR; PG_SCHED;
            PG_LDA(At, 0, 1); PG_STAGE(PG_SB(0, 0), b2, voffB); PG_STAGE(PG_SB(0, 1), b2 + hstepB, voffB); PG_STAGE(PG_SA(0, 0), a2, x0);
            PG_WAIT_V(8); PG_WAIT_L(0); PG_BAR; PG_MMA(1, 0, At, B0); PG_MMA(1, 1, At, B1); PG_BAR; PG_SCHED;
            PG_LDB(B0, 1, 0); PG_LDB(B1, 1, 1); PG_SCHED; PG_LDA(At, 1, 0); PG_STAGE(PG_SA(0, 1), a2 + hstepA, x1);
            PG_WAIT_V(8); PG_WAIT_L(0); PG_BAR; PG_MMA(0, 0, At, B0); PG_MMA(0, 1, At, B1); PG_BAR; PG_SCHED;
            PG_LDA(At, 1, 1); PG_STAGE(PG_SB(1, 0), b3, voffB); PG_STAGE(PG_SB(1, 1), b3 + hstepB, voffB); PG_STAGE(PG_SA(1, 0), a3, x0);
            PG_WAIT_V(8); PG_WAIT_L(0); PG_BAR; PG_MMA(1, 0, At, B0); PG_MMA(1, 1, At, B1); PG_BAR; PG_SCHED;
        }
        if (wr == 0) PG_BAR;
        if constexpr (FP8) asm volatile("s_nop 15\n\ts_nop 15" ::: "memory");
        if constexpr (Epi::BIAS && !GATHER) { if (has_next) { const float* bp = E.bias_base(nxt) + wc * 32 + (Epi::PERM ? 8 * fq : 4 * fq);
#pragma unroll
            for (int b = 0; b < 2; ++b)
#pragma unroll
                for (int n = 0; n < 2; ++n) bini[b][n] = *(const f32x4*)(bp + b * HALF + (Epi::PERM ? 4 * n : 16 * n)); } }
        if constexpr (!Epi::AFTER_DRAIN) { E(acc, cur, wr, wc, fr, fq); }
        if (!has_next) break;
        if constexpr (Epi::BIAS && GATHER) { const float* bp = E.bias_base(nxt) + wc * 32 + (Epi::PERM ? 8 * fq : 4 * fq);
#pragma unroll
            for (int b = 0; b < 2; ++b)
#pragma unroll
                for (int n = 0; n < 2; ++n) bini[b][n] = *(const f32x4*)(bp + b * HALF + (Epi::PERM ? 4 * n : 16 * n)); }
#pragma unroll
        for (int a = 0; a < 2; ++a)
#pragma unroll
            for (int b = 0; b < 2; ++b)
#pragma unroll
                for (int m = 0; m < 4; ++m)
#pragma unroll
                    for (int n = 0; n < 2; ++n) acc[a][b][m][n] = bini[b][n];
        cur = nxt; cA = nA; cB = nB; ++ui;
        if constexpr (GATHER) {
#pragma unroll
            for (int i = 0; i < 2; ++i) { gA0[i] = nA0[i]; gA1[i] = nA1[i]; } }
        if (wr == 1) PG_BAR;
    }
    PG_WAIT_V(0);
    PG_BAR;
    if constexpr (Epi::AFTER_DRAIN) { E.fused(acc, cur, wr, wc, fr, fq, lds, wid, lane); }
#undef PG_SA
#undef PG_SB
#undef PG_STAGE
#undef PG_LDA
#undef PG_LDB
#undef PG_MMA
#undef PG_WAIT_V
#undef PG_WAIT_L
#undef PG_BAR
#undef PG_SCHED
}

struct EpiStoreBf16 {
    static constexpr bool PERM = true, AFTER_DRAIN = false, BIAS = false;
    bf16_t* O; int ldc; float scale; int gcol;
    __device__ __forceinline__ void operator()(const f32x4 (&acc)[2][2][4][2], const Unit& u, int wr, int wc, int fr, int fq) const {
        bf16_t* base = O + (size_t)(u.pm * BM + wr * 64 + fr) * ldc + u.g * gcol + u.pn * BM + wc * 32 + 8 * fq;
#pragma unroll
        for (int ai = 0; ai < 2; ++ai)
#pragma unroll
            for (int m = 0; m < 4; ++m) { bf16_t* rowp = base + (size_t)(ai * HALF + m * 16) * ldc;
#pragma unroll
                for (int bj = 0; bj < 2; ++bj) { const f32x4 v0 = acc[ai][bj][m][0] * scale, v1 = acc[ai][bj][m][1] * scale;
                    u32x4 w; w.x = cvt_pk_bf16(v0[0], v0[1]); w.y = cvt_pk_bf16(v0[2], v0[3]); w.z = cvt_pk_bf16(v1[0], v1[1]); w.w = cvt_pk_bf16(v1[2], v1[3]);
                    *(u32x4*)(rowp + bj * HALF) = w; } }
    }
};
}

constexpr int PROJW = 4608;
constexpr int PJ_P = 0, PJ_U = 512, PJ_O = 1536, PJ_G = 2560;
constexpr int PROJLD = 1536;
constexpr int WIN_ROWS = 5632;

__device__ __forceinline__ unsigned f2bf(float f) { unsigned u = __builtin_bit_cast(unsigned, f); return (u + 0x7fffu + ((u >> 16) & 1u)) >> 16; }
__device__ __forceinline__ unsigned pk2(float lo, float hi) { return f2bf(lo) | (f2bf(hi) << 16); }
__device__ __forceinline__ float bf2f(unsigned short b) { return __builtin_bit_cast(float, (unsigned)b << 16); }

struct TItem { const float* src; pg::bf16_t* dst; int ldw, ldt, inter, valid, fp8; };
__device__ __forceinline__ void titem_load(const TItem& it, pg::f32x4 (&r)[16], int lane) {
    const float* src = it.src + (size_t)(4 * (lane >> 4)) * it.ldw + 4 * (lane & 15);
#pragma unroll
    for (int i = 0; i < 4; ++i)
#pragma unroll
        for (int kk = 0; kk < 4; ++kk) r[4 * i + kk] = *(const pg::f32x4*)(src + (size_t)(16 * i + kk) * it.ldw);
}
__device__ __forceinline__ void titem_store(const TItem& it, const pg::f32x4 (&r)[16], LAS float* scr, int lane) {
    const int ka = lane >> 4, nb = lane & 15, sw = nb & 7;
#pragma unroll
    for (int i = 0; i < 4; ++i) { const int a = ka + 4 * i;
        LAS float* d = scr + (4 * nb) * 64 + 4 * (a ^ sw);
        *(LAS pg::f32x4*)(d)       = (pg::f32x4){r[4 * i].x, r[4 * i + 1].x, r[4 * i + 2].x, r[4 * i + 3].x};
        *(LAS pg::f32x4*)(d + 64)  = (pg::f32x4){r[4 * i].y, r[4 * i + 1].y, r[4 * i + 2].y, r[4 * i + 3].y};
        *(LAS pg::f32x4*)(d + 128) = (pg::f32x4){r[4 * i].z, r[4 * i + 1].z, r[4 * i + 2].z, r[4 * i + 3].z};
        *(LAS pg::f32x4*)(d + 192) = (pg::f32x4){r[4 * i].w, r[4 * i + 1].w, r[4 * i + 2].w, r[4 * i + 3].w}; }
    asm volatile("s_waitcnt lgkmcnt(0)" ::: "memory");
#pragma unroll
    for (int itr = 0; itr < 8; ++itr) { const int nl = (lane >> 3) + 8 * itr, kg = lane & 7, sn = (nl >> 2) & 7;
        const pg::f32x4 p0 = *(const LAS pg::f32x4*)(scr + nl * 64 + 4 * ((2 * kg) ^ sn)), p1 = *(const LAS pg::f32x4*)(scr + nl * 64 + 4 * ((2 * kg + 1) ^ sn));
        const size_t drow = it.inter ? (size_t)(nl & 1) * 128 + (nl >> 1) : (size_t)nl;
        if (it.fp8) { int w0 = __builtin_amdgcn_cvt_pk_fp8_f32(p0.x * 64.f, p0.y * 64.f, 0, false); w0 = __builtin_amdgcn_cvt_pk_fp8_f32(p0.z * 64.f, p0.w * 64.f, w0, true);
            int w1 = __builtin_amdgcn_cvt_pk_fp8_f32(p1.x * 64.f, p1.y * 64.f, 0, false); w1 = __builtin_amdgcn_cvt_pk_fp8_f32(p1.z * 64.f, p1.w * 64.f, w1, true);
            *(pg::u32x2*)((unsigned char*)it.dst + drow * it.ldt + 8 * kg) = (pg::u32x2){(unsigned)w0, (unsigned)w1}; }
        else { pg::u32x4 o; o.x = pk2(p0.x, p0.y); o.y = pk2(p0.z, p0.w); o.z = pk2(p1.x, p1.y); o.w = pk2(p1.z, p1.w);
            *(pg::u32x4*)(it.dst + drow * it.ldt + 8 * kg) = o; } }
    asm volatile("s_waitcnt lgkmcnt(0)" ::: "memory");
}
__device__ __forceinline__ int win_src_col(int r) { return r < 1536 ? r : (r < 2560 ? r + 1024 : (r < 4608 ? r - 2560 + C_G : r - 4608 + C_V)); }

struct OptBufs {
    pg::bf16_t *WinT, *H0B, *PROJ, *BT2; unsigned char *WinQ, *H0Q, *OGQ;
    float *gif, *stats;
};
__device__ __forceinline__ void ph_ln0(LAS unsigned char* lds, const OptBufs& o, const float* x, const float* g, const float* beta, const float* w_in, const float* b_if) {
    const int tid = tidf(), lane = tid & 63, wave = tid >> 6, gw = blockIdx.x * NW + wave, ngw = gridDim.x * NW;
    LAS float* wif = (LAS float*)lds;
    __syncthreads();
    for (int i = tid; i < 1024 * 8; i += NT) wif[(i & 7) * 1024 + (i >> 3)] = w_in[(size_t)(i >> 3) * INC + C_IF + (i & 7)];
    __syncthreads();
    pg::f32x4 v[4];
    if (gw < T) {
#pragma unroll
        for (int j = 0; j < 4; ++j) v[j] = ((const pg::f32x4*)(x + (size_t)gw * D) + lane)[64 * j]; }
    for (int row = gw; row < T; row += ngw) {
        pg::f32x4 nv[4];
        if (row + ngw < T) {
#pragma unroll
            for (int j = 0; j < 4; ++j) nv[j] = ((const pg::f32x4*)(x + (size_t)(row + ngw) * D) + lane)[64 * j]; }
        float s = 0.f;
#pragma unroll
        for (int j = 0; j < 4; ++j) s += (v[j].x + v[j].y) + (v[j].z + v[j].w);
        const float mean = wsum(s) * (1.f / D); float s2 = 0.f;
#pragma unroll
        for (int j = 0; j < 4; ++j) { v[j] = v[j] - mean; s2 += (v[j].x * v[j].x + v[j].y * v[j].y) + (v[j].z * v[j].z + v[j].w * v[j].w); }
        const float rstd = rsqrtf(wsum(s2) * (1.f / D) + LN_EPS);
        float acc8[8];
#pragma unroll
        for (int q = 0; q < 8; ++q) acc8[q] = 0.f;
        unsigned long long* o8 = (unsigned long long*)(o.H0B + (size_t)row * D) + lane;
#pragma unroll
        for (int j = 0; j < 4; ++j) {
            const int c0 = 256 * j + 4 * lane;
            const pg::f32x4 gg = *(const pg::f32x4*)(g + c0), bb = *(const pg::f32x4*)(beta + c0);
            const pg::f32x4 y = v[j] * rstd * gg + bb;
            o8[64 * j] = (unsigned long long)pk2(y.x, y.y) | ((unsigned long long)pk2(y.z, y.w) << 32);
            { int w0 = __builtin_amdgcn_cvt_pk_fp8_f32(y.x, y.y, 0, false); w0 = __builtin_amdgcn_cvt_pk_fp8_f32(y.z, y.w, w0, true); *(int*)(o.H0Q + (size_t)row * D + c0) = w0; }
#pragma unroll
            for (int q = 0; q < 8; ++q) { const pg::f32x4 w4 = *(const LAS pg::f32x4*)(wif + q * 1024 + c0); acc8[q] += (y.x * w4.x + y.y * w4.y) + (y.z * w4.z + y.w * w4.w); }
        }
        float r_;
        { float a4[4];
#pragma unroll
          for (int i = 0; i < 4; ++i) { const bool up = (lane & 32) != 0; const float keep = up ? acc8[4 + i] : acc8[i], give = up ? acc8[i] : acc8[4 + i]; a4[i] = keep + __shfl_xor(give, 32); }
          float a2[2];
#pragma unroll
          for (int i = 0; i < 2; ++i) { const bool up = (lane & 16) != 0; const float keep = up ? a4[2 + i] : a4[i], give = up ? a4[i] : a4[2 + i]; a2[i] = keep + __shfl_xor(give, 16); }
          const bool up = (lane & 8) != 0; const float keep = up ? a2[1] : a2[0], give = up ? a2[0] : a2[1];
          r_ = keep + __shfl_xor(give, 8);
          r_ += __shfl_xor(r_, 4); r_ += __shfl_xor(r_, 2); r_ += __shfl_xor(r_, 1); }
        if ((lane & 7) == 0) { const int q = lane >> 3; o.gif[(size_t)row * 8 + q] = r_ + b_if[q]; }
        if (lane == 0) { o.stats[(size_t)row * 2] = mean; o.stats[(size_t)row * 2 + 1] = rstd; }
#pragma unroll
        for (int j = 0; j < 4; ++j) v[j] = nv[j];
    }
    __syncthreads();
}
struct SchedInproj {
    pg::TileOrder o; const char* A; const char* B; size_t rowbytes;
    __device__ __forceinline__ bool next(int i, pg::Unit& u) const { int g, pm, pn; if (!o.tile(i, g, pm, pn)) return false;
        u.A = A + (size_t)pm * 256 * rowbytes; u.B = B + (size_t)pn * 256 * rowbytes; u.pm = pm; u.pn = pn; u.g = 0; u.aux = 0; u.rows = nullptr; u.nvalid = 0; return true; }
};
struct SchedVT {
    pg::TileOrder o; const char* A; const char* B;
    __device__ __forceinline__ bool next(int i, pg::Unit& u) const { int g, pm, pn; if (!o.tile(i, g, pm, pn)) return false;
        u.A = A + (size_t)pm * 256 * D * 2; u.B = B + (size_t)pn * 256 * D * 2; u.pm = pm; u.pn = pn; u.g = 0; u.aux = 0; u.rows = nullptr; u.nvalid = 0; return true; }
};
struct EpiVT {
    static constexpr bool PERM = true, AFTER_DRAIN = false, BIAS = false;
    pg::bf16_t* BT2;
    __device__ __forceinline__ void operator()(const pg::f32x4 (&acc)[2][2][4][2], const pg::Unit& u, int wr, int wc, int fr, int fq) const {
        const int h = u.pm, b = u.pn >> 4, c = u.pn & 15;
        pg::bf16_t* base = BT2 + ((size_t)((b * 4 + h) * 16 + c) * 256 + wr * 64 + fr) * 512 + wc * 32 + 8 * fq;
#pragma unroll
        for (int ai = 0; ai < 2; ++ai)
#pragma unroll
            for (int m = 0; m < 4; ++m) { pg::bf16_t* rowp = base + (size_t)(ai * 128 + m * 16) * 512;
#pragma unroll
                for (int bj = 0; bj < 2; ++bj) { const pg::f32x4 v0 = acc[ai][bj][m][0], v1 = acc[ai][bj][m][1];
                    pg::u32x4 w; w.x = pg::cvt_pk_bf16(v0[0], v0[1]); w.y = pg::cvt_pk_bf16(v0[2], v0[3]); w.z = pg::cvt_pk_bf16(v1[0], v1[1]); w.w = pg::cvt_pk_bf16(v1[2], v1[3]);
                    *(pg::u32x4*)(rowp + bj * 128) = w; } }
    }
};
struct EpiOGQ {
    static constexpr bool PERM = true, AFTER_DRAIN = false, BIAS = false;
    unsigned char* O;
    __device__ __forceinline__ void operator()(const pg::f32x4 (&acc)[2][2][4][2], const pg::Unit& u, int wr, int wc, int fr, int fq) const {
        unsigned char* base = O + (size_t)(u.pm * 256 + wr * 64 + fr) * 3072 + u.pn * 256 + (wc * 4 + fq) * 16;
#pragma unroll
        for (int ai = 0; ai < 2; ++ai)
#pragma unroll
            for (int m = 0; m < 4; ++m) { pg::u32x4 w;
                { const pg::f32x4 v0 = acc[ai][0][m][0], v1 = acc[ai][0][m][1];
                  int p = __builtin_amdgcn_cvt_pk_fp8_f32(v0[0], v0[1], 0, false); p = __builtin_amdgcn_cvt_pk_fp8_f32(v0[2], v0[3], p, true); w.x = (unsigned)p;
                  p = __builtin_amdgcn_cvt_pk_fp8_f32(v1[0], v1[1], 0, false); p = __builtin_amdgcn_cvt_pk_fp8_f32(v1[2], v1[3], p, true); w.y = (unsigned)p; }
                { const pg::f32x4 v0 = acc[ai][1][m][0], v1 = acc[ai][1][m][1];
                  int p = __builtin_amdgcn_cvt_pk_fp8_f32(v0[0], v0[1], 0, false); p = __builtin_amdgcn_cvt_pk_fp8_f32(v0[2], v0[3], p, true); w.z = (unsigned)p;
                  p = __builtin_amdgcn_cvt_pk_fp8_f32(v1[0], v1[1], 0, false); p = __builtin_amdgcn_cvt_pk_fp8_f32(v1[2], v1[3], p, true); w.w = (unsigned)p; }
                *(pg::u32x4*)(base + (size_t)(ai * 128 + m * 16) * 3072) = w; asm volatile("" ::: "memory"); }
    }
};
__device__ __forceinline__ void fp8x4_to_f32(unsigned w, float (&o)[4]) {
    const pg::f32x2 lo = __builtin_amdgcn_cvt_pk_f32_fp8((int)w, false), hi = __builtin_amdgcn_cvt_pk_f32_fp8((int)w, true);
    o[0] = lo.x; o[1] = lo.y; o[2] = hi.x; o[3] = hi.y;
}
__device__ __forceinline__ void ph_inproj(LAS unsigned char* lds, const OptBufs& o) {
    const int G = gridDim.x, bx = blockIdx.x;
    { SchedInproj S; S.o.init(T / 256, 12, 1, G, bx); S.A = (const char*)o.H0Q; S.B = (const char*)o.WinQ; S.rowbytes = D;
      EpiOGQ E{o.OGQ}; pg::gemm_phase<EpiOGQ, SchedInproj, false, true>(lds, D / 2, D / 2, D / 2, S, E); }
    { SchedInproj S; S.o.init(T / 256, 6, 1, G, bx); S.A = (const char*)o.H0B; S.B = (const char*)o.WinT; S.rowbytes = (size_t)D * 2;
      pg::EpiStoreBf16 E{o.PROJ, PROJLD, 1.f, 0}; pg::gemm_phase<pg::EpiStoreBf16, SchedInproj>(lds, D, D, D, S, E); }
    { SchedVT S; S.o.init(4, T / 256, 1, G, (bx + 128) % G); S.A = (const char*)(o.WinT + (size_t)PROJW * D); S.B = (const char*)o.H0B;
      EpiVT E{o.BT2}; pg::gemm_phase<EpiVT, SchedVT>(lds, D, D, D, S, E); }
}

struct OptBufs2 { pg::bf16_t *WqT, *WkT, *WpoolT, *WbpT, *POOLED, *UC, *MIXED, *Q, *K, *YPOOL; };
__device__ __forceinline__ void ld8(const pg::bf16_t* p, float (&v)[8]) { const pg::u32x4 w = *(const pg::u32x4*)p;
    v[0] = __builtin_bit_cast(float, w.x << 16); v[1] = __builtin_bit_cast(float, w.x & 0xffff0000u); v[2] = __builtin_bit_cast(float, w.y << 16); v[3] = __builtin_bit_cast(float, w.y & 0xffff0000u);
    v[4] = __builtin_bit_cast(float, w.z << 16); v[5] = __builtin_bit_cast(float, w.z & 0xffff0000u); v[6] = __builtin_bit_cast(float, w.w << 16); v[7] = __builtin_bit_cast(float, w.w & 0xffff0000u); }
__device__ __forceinline__ void st8(pg::bf16_t* p, const float (&v)[8]) { pg::u32x4 w; w.x = pk2(v[0], v[1]); w.y = pk2(v[2], v[3]); w.z = pk2(v[4], v[5]); w.w = pk2(v[6], v[7]); *(pg::u32x4*)p = w; }
__device__ __forceinline__ void ph_poolconv_opt(const pg::bf16_t* PROJ, const float* cw, const float* cb, pg::bf16_t* POOLED, pg::bf16_t* UC) {
    const int gt = blockIdx.x * NT + tidf(), ngt = gridDim.x * NT;
    for (int it = gt; it < 512 * 192; it += ngt) {
        const int run = it / 192, oc = it % 192; const int t0 = run * 32, tpos0 = t0 & (SEQ - 1);
        if (oc < 64) {
            const int c0 = oc * 8, w = 2 << (c0 >> 7);
            const pg::bf16_t* src = PROJ + PJ_P + c0;
            float s[8];
#pragma unroll
            for (int q = 0; q < 8; ++q) s[q] = 0.f;
            { pg::u32x4 hv[15];
#pragma unroll
              for (int j = 1; j < 16; ++j) hv[j - 1] = (j < w && tpos0 - j >= 0) ? *(const pg::u32x4*)(src + (size_t)(t0 - j) * PROJLD) : (pg::u32x4){0u, 0u, 0u, 0u};
#pragma unroll
              for (int j = 0; j < 15; ++j) { s[0] += __builtin_bit_cast(float, hv[j].x << 16); s[1] += __builtin_bit_cast(float, hv[j].x & 0xffff0000u); s[2] += __builtin_bit_cast(float, hv[j].y << 16); s[3] += __builtin_bit_cast(float, hv[j].y & 0xffff0000u);
                  s[4] += __builtin_bit_cast(float, hv[j].z << 16); s[5] += __builtin_bit_cast(float, hv[j].z & 0xffff0000u); s[6] += __builtin_bit_cast(float, hv[j].w << 16); s[7] += __builtin_bit_cast(float, hv[j].w & 0xffff0000u); } }
            for (int i0 = 0; i0 < 32; i0 += 8) {
                pg::u32x4 cv[8], ov[8];
#pragma unroll
                for (int i = 0; i < 8; ++i) { const int t = t0 + i0 + i, tp = tpos0 + i0 + i; cv[i] = *(const pg::u32x4*)(src + (size_t)t * PROJLD);
                    ov[i] = (tp - w + 1 >= 0) ? *(const pg::u32x4*)(src + (size_t)(t - w + 1) * PROJLD) : (pg::u32x4){0u, 0u, 0u, 0u}; }
#pragma unroll
                for (int i = 0; i < 8; ++i) { const int t = t0 + i0 + i, tp = tpos0 + i0 + i; float cur[8], old[8], o[8];
                    cur[0] = __builtin_bit_cast(float, cv[i].x << 16); cur[1] = __builtin_bit_cast(float, cv[i].x & 0xffff0000u); cur[2] = __builtin_bit_cast(float, cv[i].y << 16); cur[3] = __builtin_bit_cast(float, cv[i].y & 0xffff0000u);
                    cur[4] = __builtin_bit_cast(float, cv[i].z << 16); cur[5] = __builtin_bit_cast(float, cv[i].z & 0xffff0000u); cur[6] = __builtin_bit_cast(float, cv[i].w << 16); cur[7] = __builtin_bit_cast(float, cv[i].w & 0xffff0000u);
                    old[0] = __builtin_bit_cast(float, ov[i].x << 16); old[1] = __builtin_bit_cast(float, ov[i].x & 0xffff0000u); old[2] = __builtin_bit_cast(float, ov[i].y << 16); old[3] = __builtin_bit_cast(float, ov[i].y & 0xffff0000u);
                    old[4] = __builtin_bit_cast(float, ov[i].z << 16); old[5] = __builtin_bit_cast(float, ov[i].z & 0xffff0000u); old[6] = __builtin_bit_cast(float, ov[i].w << 16); old[7] = __builtin_bit_cast(float, ov[i].w & 0xffff0000u);
                    const float inv = 1.f / (float)((tp + 1 < w) ? tp + 1 : w);
#pragma unroll
                    for (int q = 0; q < 8; ++q) { s[q] += cur[q]; o[q] = s[q] * inv - cur[q]; s[q] -= old[q]; }
                    st8(POOLED + (size_t)t * 512 + c0, o); }
            }
        } else {
            const int c0 = (oc - 64) * 8;
            const pg::bf16_t* src = PROJ + PJ_U + c0;
            float w0[8], w1[8], w2[8], w3[8], bb[8], u0[8], u1[8], u2[8];
#pragma unroll
            for (int q = 0; q < 8; ++q) { w0[q] = cw[c0 + q]; w1[q] = cw[1024 + c0 + q]; w2[q] = cw[2048 + c0 + q]; w3[q] = cw[3072 + c0 + q]; bb[q] = cb[c0 + q]; u0[q] = 0.f; u1[q] = 0.f; u2[q] = 0.f; }
            if (tpos0 >= 3) ld8(src + (size_t)(t0 - 3) * PROJLD, u0);
            if (tpos0 >= 2) ld8(src + (size_t)(t0 - 2) * PROJLD, u1);
            if (tpos0 >= 1) ld8(src + (size_t)(t0 - 1) * PROJLD, u2);
            for (int i0 = 0; i0 < 32; i0 += 8) {
                pg::u32x4 cv[8];
#pragma unroll
                for (int i = 0; i < 8; ++i) cv[i] = *(const pg::u32x4*)(src + (size_t)(t0 + i0 + i) * PROJLD);
#pragma unroll
                for (int i = 0; i < 8; ++i) { float u3[8], o[8];
                    u3[0] = __builtin_bit_cast(float, cv[i].x << 16); u3[1] = __builtin_bit_cast(float, cv[i].x & 0xffff0000u); u3[2] = __builtin_bit_cast(float, cv[i].y << 16); u3[3] = __builtin_bit_cast(float, cv[i].y & 0xffff0000u);
                    u3[4] = __builtin_bit_cast(float, cv[i].z << 16); u3[5] = __builtin_bit_cast(float, cv[i].z & 0xffff0000u); u3[6] = __builtin_bit_cast(float, cv[i].w << 16); u3[7] = __builtin_bit_cast(float, cv[i].w & 0xffff0000u);
#pragma unroll
                    for (int q = 0; q < 8; ++q) { const float y = bb[q] + w0[q] * u0[q] + w1[q] * u1[q] + w2[q] * u2[q] + w3[q] * u3[q]; o[q] = y * __builtin_amdgcn_rcpf(1.f + __expf(-y)); u0[q] = u1[q]; u1[q] = u2[q]; u2[q] = u3[q]; }
                    st8(UC + (size_t)(t0 + i0 + i) * 1024 + c0, o); }
            }
        }
    }
}
struct SchedG {
    pg::TileOrder o; const char* A; const char* B; size_t gA, gB, tA, tB;
    __device__ __forceinline__ bool next(int i, pg::Unit& u) const { int g, pm, pn; if (!o.tile(i, g, pm, pn)) return false;
        u.A = A + g * gA + pm * tA; u.B = B + g * gB + pn * tB; u.pm = pm; u.pn = pn; u.g = g; u.aux = 0; u.rows = nullptr; u.nvalid = 0; return true; }
};
struct EpiPoolMixB {
    static constexpr bool PERM = true, AFTER_DRAIN = false, BIAS = false;
    pg::bf16_t* O; const float* b; const float* ls;
    __device__ __forceinline__ void operator()(const pg::f32x4 (&acc)[2][2][4][2], const pg::Unit& u, int wr, int wc, int fr, int fq) const {
        const int col0 = u.pn * 256 + wc * 32 + 8 * fq;
        pg::bf16_t* base = O + (size_t)(u.pm * 256 + wr * 64 + fr) * 512 + col0;
        pg::f32x4 bv[2][2], lv[2][2];
#pragma unroll
        for (int bj = 0; bj < 2; ++bj)
#pragma unroll
            for (int n = 0; n < 2; ++n) { bv[bj][n] = *(const pg::f32x4*)(b + col0 + bj * 128 + 4 * n); lv[bj][n] = *(const pg::f32x4*)(ls + col0 + bj * 128 + 4 * n); }
#pragma unroll
        for (int ai = 0; ai < 2; ++ai)
#pragma unroll
            for (int m = 0; m < 4; ++m) { pg::bf16_t* rowp = base + (size_t)(ai * 128 + m * 16) * 512;
#pragma unroll
                for (int bj = 0; bj < 2; ++bj) { const pg::f32x4 v0 = (acc[ai][bj][m][0] + bv[bj][0]) * lv[bj][0], v1 = (acc[ai][bj][m][1] + bv[bj][1]) * lv[bj][1];
                    pg::u32x4 w; w.x = pg::cvt_pk_bf16(v0[0], v0[1]); w.y = pg::cvt_pk_bf16(v0[2], v0[3]); w.z = pg::cvt_pk_bf16(v1[0], v1[1]); w.w = pg::cvt_pk_bf16(v1[2], v1[3]);
                    *(pg::u32x4*)(rowp + bj * 128) = w; } }
    }
};
__device__ __forceinline__ void cvt_bf16_f32(const pg::bf16_t* src, size_t lds_, int cols, float* dst, size_t rows) {
    const size_t gt = (size_t)blockIdx.x * NT + tidf(), ngt = (size_t)gridDim.x * NT;
    for (size_t i = gt; i < rows * cols; i += ngt) { const size_t r = i / cols; const int c = (int)(i % cols); dst[i] = bf2f(src[r * lds_ + c]); }
}
__device__ __forceinline__ void ph_adapt_v(const OptBufs& o, float* vv) {
    const size_t gt = (size_t)blockIdx.x * NT + tidf(), ngt = (size_t)gridDim.x * NT;
    for (size_t i = gt; i < (size_t)T * 1024; i += ngt) { const int t = (int)(i >> 10), e = (int)(i & 1023), h = e >> 8, el = e & 255, b = t >> 12, cc = (t & 4095) >> 8, tl = t & 255;
        vv[i] = bf2f(o.BT2[((size_t)((b * 4 + h) * 16 + cc) * 256 + el) * 512 + tl]); }
}


struct OptBufs3 { pg::bf16_t *KaT, *A2, *HOUT; float *U, *rowv, *colv, *winter, *aw, *emt, *den, *un, *decay; };
__device__ __forceinline__ float log_sigmoidf_(float x) { return fminf(x, 0.f) - log1pf(expf(-fabsf(x))); }
__device__ __forceinline__ void scalar_scan_wg(LAS unsigned char* lds, int bh, const float* gif, const OptBufs3& o) {
    const int tid = tidf(), lane = tid & 63, wave = tid >> 6, b = bh >> 2, h = bh & 3;
    LAS float* sum = (LAS float*)lds;
    float bt[2][4], ip[2][4], pm[2][4];
#pragma unroll
    for (int cc = 0; cc < 2; ++cc) { const int c = wave * 2 + cc;
        float bs[4];
#pragma unroll
        for (int sub = 0; sub < 4; ++sub) { const size_t t = (size_t)b * SEQ + c * 256 + sub * 64 + lane; ip[cc][sub] = gif[t * 8 + h]; bs[sub] = log_sigmoidf_(gif[t * 8 + 4 + h]); }
#pragma unroll
        for (int off = 1; off < 64; off <<= 1) {
#pragma unroll
            for (int sub = 0; sub < 4; ++sub) { const float v = __shfl_up(bs[sub], off); if (lane >= off) bs[sub] += v; } }
        float carry = 0.f;
#pragma unroll
        for (int sub = 0; sub < 4; ++sub) { bt[cc][sub] = carry + bs[sub]; carry += __shfl(bs[sub], 63); pm[cc][sub] = ip[cc][sub] - bt[cc][sub]; }
#pragma unroll
        for (int off = 1; off < 64; off <<= 1) {
#pragma unroll
            for (int sub = 0; sub < 4; ++sub) { const float v = __shfl_up(pm[cc][sub], off); if (lane >= off) pm[cc][sub] = fmaxf(pm[cc][sub], v); } }
        float pmc = -INFINITY;
#pragma unroll
        for (int sub = 0; sub < 4; ++sub) { pm[cc][sub] = fmaxf(pm[cc][sub], pmc); pmc = __shfl(pm[cc][sub], 63); }
        if (lane == 0) { sum[c * 2] = carry; sum[c * 2 + 1] = pmc; }
    }
    __syncthreads();
    float mc = 0.f;
    for (int c = 0; c < wave * 2; ++c) mc = sum[c * 2] + fmaxf(mc, sum[c * 2 + 1]);
#pragma unroll
    for (int cc = 0; cc < 2; ++cc) { const int c = wave * 2 + cc; const float Gc = sum[c * 2], mnext = Gc + fmaxf(mc, sum[c * 2 + 1]);
#pragma unroll
        for (int sub = 0; sub < 4; ++sub) { const float mt = bt[cc][sub] + fmaxf(mc, pm[cc][sub]);
            const size_t idx = ((size_t)b * SEQ + c * 256 + sub * 64 + lane) * 4 + h;
            o.rowv[idx] = bt[cc][sub] - mt; o.colv[idx] = ip[cc][sub] - bt[cc][sub];
            o.winter[idx] = expf(bt[cc][sub] + mc - mt); o.aw[idx] = expf(Gc - bt[cc][sub] + ip[cc][sub] - mnext); o.emt[idx] = expf(-mt); }
        if (lane == 0) o.decay[bh * 16 + c] = expf(Gc + mc - mnext);
        mc = mnext; }
    __syncthreads();
}
struct EpiQ {
    static constexpr bool PERM = true, AFTER_DRAIN = false, BIAS = false;
    pg::bf16_t* Q; pg::bf16_t* A2; const float* winter;
    __device__ __forceinline__ void operator()(const pg::f32x4 (&acc)[2][2][4][2], const pg::Unit& u, int wr, int wc, int fr, int fq) const {
        const int h = u.g, col0 = wc * 32 + 8 * fq;
#pragma unroll
        for (int ai = 0; ai < 2; ++ai)
#pragma unroll
            for (int m = 0; m < 4; ++m) { const size_t t = (size_t)u.pm * 256 + ai * 128 + wr * 64 + m * 16 + fr; const float wi = winter[t * 4 + h];
#pragma unroll
                for (int bj = 0; bj < 2; ++bj) { const pg::f32x4 v0 = acc[ai][bj][m][0] * 0.0625f, v1 = acc[ai][bj][m][1] * 0.0625f;
                    pg::u32x4 w; w.x = pg::cvt_pk_bf16(v0[0], v0[1]); w.y = pg::cvt_pk_bf16(v0[2], v0[3]); w.z = pg::cvt_pk_bf16(v1[0], v1[1]); w.w = pg::cvt_pk_bf16(v1[2], v1[3]);
                    *(pg::u32x4*)(Q + t * 1024 + h * 256 + col0 + bj * 128) = w;
                    const pg::f32x4 x0 = v0 * wi, x1 = v1 * wi;
                    pg::u32x4 y; y.x = pg::cvt_pk_bf16(x0[0], x0[1]); y.y = pg::cvt_pk_bf16(x0[2], x0[3]); y.z = pg::cvt_pk_bf16(x1[0], x1[1]); y.w = pg::cvt_pk_bf16(x1[2], x1[3]);
                    *(pg::u32x4*)(A2 + t * 2048 + h * 512 + 256 + col0 + bj * 128) = y; }
                asm volatile("" ::: "memory"); }
    }
};
struct EpiKT {
    static constexpr bool PERM = true, AFTER_DRAIN = false, BIAS = false;
    pg::bf16_t* KaT; const float* aw;
    __device__ __forceinline__ void operator()(const pg::f32x4 (&acc)[2][2][4][2], const pg::Unit& u, int wr, int wc, int fr, int fq) const {
        const int h = u.g; const size_t t0 = (size_t)u.pn * 256 + wc * 32 + 8 * fq;
#pragma unroll
        for (int bj = 0; bj < 2; ++bj) {
            float a[8];
#pragma unroll
            for (int j = 0; j < 8; ++j) a[j] = aw[(t0 + bj * 128 + j) * 4 + h];
            pg::bf16_t* rowp = KaT + ((size_t)h * 256 + wr * 64 + fr) * T + t0 + bj * 128;
#pragma unroll
            for (int ai = 0; ai < 2; ++ai)
#pragma unroll
                for (int m = 0; m < 4; ++m) { const pg::f32x4 v0 = acc[ai][bj][m][0], v1 = acc[ai][bj][m][1];
                    pg::u32x4 w; w.x = pg::cvt_pk_bf16(v0[0] * a[0], v0[1] * a[1]); w.y = pg::cvt_pk_bf16(v0[2] * a[2], v0[3] * a[3]);
                    w.z = pg::cvt_pk_bf16(v1[0] * a[4], v1[1] * a[5]); w.w = pg::cvt_pk_bf16(v1[2] * a[6], v1[3] * a[7]);
                    *(pg::u32x4*)(rowp + (size_t)(ai * 128 + m * 16) * T) = w; asm volatile("" ::: "memory"); }
        }
    }
};
struct EpiS {
    static constexpr bool PERM = true, AFTER_DRAIN = false, BIAS = false;
    pg::bf16_t* A2; const float* rowv; const float* colv; float* den;
    __device__ __forceinline__ void operator()(const pg::f32x4 (&acc)[2][2][4][2], const pg::Unit& u, int wr, int wc, int fr, int fq) const {
        const int bh = u.g >> 4, c = u.g & 15, b = bh >> 2, h = bh & 3; const size_t tok0 = (size_t)b * SEQ + c * 256;
        const int col0 = wc * 32 + 8 * fq;
        const float* cvp = colv + (tok0 + col0) * 4 + h;
#pragma unroll
        for (int ai = 0; ai < 2; ++ai)
#pragma unroll
            for (int m = 0; m < 4; ++m) { const int tl = ai * 128 + wr * 64 + m * 16 + fr; const float rv = rowv[(tok0 + tl) * 4 + h]; float rs = 0.f;
                pg::bf16_t* op = A2 + (tok0 + tl) * 2048 + h * 512 + col0;
#pragma unroll
                for (int bj = 0; bj < 2; ++bj) { float x[8];
#pragma unroll
                    for (int j = 0; j < 8; ++j) { const int sl = col0 + bj * 128 + j; const float a_ = (j < 4) ? acc[ai][bj][m][0][j] : acc[ai][bj][m][1][j - 4];
                        const float w_ = __expf(rv + cvp[(bj * 128 + j) * 4]); x[j] = (sl <= tl) ? a_ * w_ : 0.f; rs += x[j]; }
                    pg::u32x4 w; w.x = pg::cvt_pk_bf16(x[0], x[1]); w.y = pg::cvt_pk_bf16(x[2], x[3]); w.z = pg::cvt_pk_bf16(x[4], x[5]); w.w = pg::cvt_pk_bf16(x[6], x[7]);
                    *(pg::u32x4*)(op + bj * 128) = w; asm volatile("" ::: "memory"); }
                rs += __shfl_xor(rs, 16); rs += __shfl_xor(rs, 32);
                if (fq == 0) atomicAdd(den + (tok0 + tl) * 4 + h, rs);
                asm volatile("" ::: "memory"); }
    }
};
struct EpiF32U {
    static constexpr bool PERM = false, AFTER_DRAIN = false, BIAS = false;
    float* C;
    __device__ __forceinline__ void operator()(const pg::f32x4 (&acc)[2][2][4][2], const pg::Unit& u, int wr, int wc, int fr, int fq) const {
        float* base = C + (size_t)u.aux * 65536 + (size_t)(wr * 64 + fr) * 256 + wc * 32 + 4 * fq;
#pragma unroll
        for (int ai = 0; ai < 2; ++ai)
#pragma unroll
            for (int m = 0; m < 4; ++m)
#pragma unroll
                for (int bj = 0; bj < 2; ++bj)
#pragma unroll
                    for (int n = 0; n < 2; ++n) { *(pg::f32x4*)(base + (size_t)(ai * 128 + m * 16) * 256 + bj * 128 + n * 16) = acc[ai][bj][m][n]; if (n) asm volatile("" ::: "memory"); }
    }
};
struct EpiNum {
    static constexpr bool PERM = true, AFTER_DRAIN = true, BIAS = false;
    pg::bf16_t* HOUT; const unsigned char* OGQ; const float* den; const float* emt; const float* gain;
    __device__ __forceinline__ void fused(pg::f32x4 (&acc)[2][2][4][2], const pg::Unit& u, int wr, int wc, int fr, int fq, LAS unsigned char* lds, int wid, int lane) const {
        const int bh = u.g >> 4, c = u.g & 15, b = bh >> 2, h = bh & 3; const size_t tok0 = (size_t)b * SEQ + c * 256;
        LAS pg::f32x2* P = (LAS pg::f32x2*)lds; LAS pg::f32x2* Sx = (LAS pg::f32x2*)(lds + 8192);
#pragma unroll
        for (int ai = 0; ai < 2; ++ai)
#pragma unroll
            for (int m = 0; m < 4; ++m) { const int tl = ai * 128 + wr * 64 + m * 16 + fr; const size_t ti = (tok0 + tl) * 4 + h;
                const float inv = __builtin_amdgcn_rcpf(fmaxf(fabsf(den[ti]), emt[ti])); float s = 0.f;
#pragma unroll
                for (int bj = 0; bj < 2; ++bj)
#pragma unroll
                    for (int n = 0; n < 2; ++n) { acc[ai][bj][m][n] = acc[ai][bj][m][n] * inv; const pg::f32x4 x = acc[ai][bj][m][n]; s += (x[0] + x[1]) + (x[2] + x[3]); }
                s += __shfl_xor(s, 16); s += __shfl_xor(s, 32);
                const float mw = s * (1.f / 64.f); float q = 0.f;
#pragma unroll
                for (int bj = 0; bj < 2; ++bj)
#pragma unroll
                    for (int n = 0; n < 2; ++n) { const pg::f32x4 d = acc[ai][bj][m][n] - mw; q += (d[0] * d[0] + d[1] * d[1]) + (d[2] * d[2] + d[3] * d[3]); }
                q += __shfl_xor(q, 16); q += __shfl_xor(q, 32);
                if (fq == 0) P[tl * 4 + wc] = (pg::f32x2){mw, q}; }
        asm volatile("s_waitcnt lgkmcnt(0)" ::: "memory"); __builtin_amdgcn_s_barrier(); asm volatile("" ::: "memory");
        if (lane < 32) { const int row = wid * 32 + lane;
            const pg::f32x2 a = P[row * 4 + 0], b_ = P[row * 4 + 1], c_ = P[row * 4 + 2], d = P[row * 4 + 3];
            const float mt = (a.x + b_.x + c_.x + d.x) * 0.25f;
            const float da = a.x - mt, db = b_.x - mt, dc = c_.x - mt, dd = d.x - mt;
            const float m2 = (a.y + b_.y) + (c_.y + d.y) + 64.f * ((da * da + db * db) + (dc * dc + dd * dd));
            Sx[row] = (pg::f32x2){mt, rsqrtf(m2 * (1.f / 256.f) + LN_EPS)}; }
        asm volatile("s_waitcnt lgkmcnt(0)" ::: "memory"); __builtin_amdgcn_s_barrier(); asm volatile("" ::: "memory");
        const int col0 = wc * 32 + 8 * fq;
        pg::f32x4 gn[2][2];
#pragma unroll
        for (int bj = 0; bj < 2; ++bj) { gn[bj][0] = *(const pg::f32x4*)(gain + h * 256 + col0 + bj * 128); gn[bj][1] = *(const pg::f32x4*)(gain + h * 256 + col0 + bj * 128 + 4); }
#pragma unroll
        for (int ai = 0; ai < 2; ++ai)
#pragma unroll
            for (int m = 0; m < 4; ++m) { const int tl = ai * 128 + wr * 64 + m * 16 + fr; const pg::f32x2 sr = Sx[tl]; const size_t t = tok0 + tl;
                const pg::u32x4 ow = *(const pg::u32x4*)(OGQ + t * 3072 + h * 256 + (wc * 4 + fq) * 16);
#pragma unroll
                for (int bj = 0; bj < 2; ++bj) { const int e0 = h * 256 + col0 + bj * 128; float o0[4], o1[4];
                    fp8x4_to_f32(bj ? ow.z : ow.x, o0); fp8x4_to_f32(bj ? ow.w : ow.y, o1);
                    const pg::f32x4 v0 = (acc[ai][bj][m][0] - sr.x) * sr.y * gn[bj][0], v1 = (acc[ai][bj][m][1] - sr.x) * sr.y * gn[bj][1];
                    float r[8];
#pragma unroll
                    for (int j = 0; j < 4; ++j) { r[j] = v0[j] * fsigmoid(o0[j]); r[4 + j] = v1[j] * fsigmoid(o1[j]); }
                    st8(HOUT + t * 1024 + e0, r); } }
    }
};
struct SchedG1 { pg::TileOrder o; const char* Q; const char* K;
    __device__ __forceinline__ bool next(int i, pg::Unit& u) const { int g, pm, pn; if (!o.tile(i, g, pm, pn)) return false;
        const int bh = g >> 4, c = g & 15, b = bh >> 2, h = bh & 3; const size_t off = (((size_t)b * SEQ + c * 256) * 1024 + h * 256) * 2;
        u.A = Q + off; u.B = K + off; u.pm = 0; u.pn = 0; u.g = g; u.aux = g; u.rows = nullptr; u.nvalid = 0; return true; } };
struct SchedG2 { pg::TileOrder o; const char* BT2; const char* KaT;
    __device__ __forceinline__ bool next(int i, pg::Unit& u) const { int g, pm, pn; if (!o.tile(i, g, pm, pn)) return false;
        const int bh = g / 15, c = g % 15, b = bh >> 2, h = bh & 3;
        u.A = BT2 + (size_t)(bh * 16 + c) * 256 * 512 * 2; u.B = KaT + (((size_t)h * 256) * T + (size_t)b * SEQ + c * 256) * 2;
        u.pm = 0; u.pn = 0; u.g = bh * 16 + c; u.aux = bh * 16 + c; u.rows = nullptr; u.nvalid = 0; return true; } };
struct SchedG3 { pg::TileOrder o; const char* A2; const char* BT2;
    __device__ __forceinline__ bool next(int i, pg::Unit& u) const { int g, pm, pn; if (!o.tile(i, g, pm, pn)) return false;
        const int bh = g >> 4, c = g & 15, b = bh >> 2, h = bh & 3;
        u.A = A2 + (((size_t)b * SEQ + c * 256) * 2048 + h * 512) * 2; u.B = BT2 + (size_t)g * 256 * 512 * 2; u.pm = 0; u.pn = 0; u.g = g; u.aux = g; u.rows = nullptr; u.nvalid = 0; return true; } };
__device__ __forceinline__ void ph_un(LAS unsigned char* lds, const OptBufs2& o2, const OptBufs3& o3) {
    const int tid = tidf(), d = tid & 255, sh = tid >> 8; LAS float* red = (LAS float*)lds;
    for (int it = blockIdx.x; it < 256; it += gridDim.x) { const int bh = it >> 4, c = it & 15, b = bh >> 2, h = bh & 3; const size_t tok0 = (size_t)b * SEQ + c * 256;
        float s = 0.f;
#pragma unroll 8
        for (int j = 0; j < 128; ++j) { const size_t t = tok0 + sh * 128 + j; s += o3.aw[t * 4 + h] * bf2f(o2.K[t * 1024 + h * 256 + d]); }
        __syncthreads(); if (sh == 1) red[d] = s; __syncthreads();
        if (sh == 0) o3.un[(size_t)it * 256 + d] = s + red[d]; }
    __syncthreads();
}
__device__ __forceinline__ void ph_state_scan(const OptBufs& ob, const OptBufs3& o3) {
    const int gt = blockIdx.x * NT + tidf(), ngt = gridDim.x * NT;
    for (int it = gt; it < 16 * 256 * 64; it += ngt) { const int bh = it >> 14, e = (it >> 6) & 255, d4 = (it & 63) * 4;
        pg::f32x4 U[15]; float dc[15];
#pragma unroll
        for (int c = 0; c < 15; ++c) { const size_t g = (size_t)bh * 16 + c; U[c] = *(const pg::f32x4*)(o3.U + g * 65536 + (size_t)e * 256 + d4); dc[c] = o3.decay[g]; }
        pg::f32x4 C = (pg::f32x4){0.f, 0.f, 0.f, 0.f};
#pragma unroll
        for (int c = 0; c < 16; ++c) { const size_t g = (size_t)bh * 16 + c;
            pg::u32x2 w; w.x = pk2(C[0], C[1]); w.y = pk2(C[2], C[3]);
            *(pg::u32x2*)(ob.BT2 + (g * 256 + e) * 512 + 256 + d4) = w;
            if (c < 15) C = C * dc[c] + U[c]; } }
}
__device__ __forceinline__ void ph_den_inter(LAS unsigned char* lds, const OptBufs3& o3) {
    const int tid = tidf(), lane = tid & 63, wave = tid >> 6; LAS float* nn = (LAS float*)lds;
    for (int it = blockIdx.x; it < 256; it += gridDim.x) { const int bh = it >> 4, c = it & 15, b = bh >> 2, h = bh & 3; const size_t tok0 = (size_t)b * SEQ + c * 256;
        __syncthreads();
        if (tid < 256) { float n = 0.f; for (int j = 0; j < c; ++j) n = n * o3.decay[bh * 16 + j] + o3.un[(size_t)(bh * 16 + j) * 256 + tid]; nn[tid] = n; }
        __syncthreads();
        const pg::f32x4 nv = *(const LAS pg::f32x4*)(nn + 4 * lane);
        for (int r0 = 0; r0 < 32; r0 += 8) { pg::u32x2 wv[8];
#pragma unroll
            for (int r = 0; r < 8; ++r) wv[r] = *(const pg::u32x2*)(o3.A2 + (tok0 + wave * 32 + r0 + r) * 2048 + h * 512 + 256 + 4 * lane);
#pragma unroll
            for (int r = 0; r < 8; ++r) { const size_t t = tok0 + wave * 32 + r0 + r; const pg::u32x2 w = wv[r];
                float s = __builtin_bit_cast(float, w.x << 16) * nv[0] + __builtin_bit_cast(float, w.x & 0xffff0000u) * nv[1] + __builtin_bit_cast(float, w.y << 16) * nv[2] + __builtin_bit_cast(float, w.y & 0xffff0000u) * nv[3];
                s = wsum(s);
                if (lane == 0) o3.den[t * 4 + h] += s; } } }
    __syncthreads();
}

__device__ __forceinline__ void ph_gemms_D(LAS unsigned char* lds, const OptBufs2& o, const OptBufs3& o3, const float* b_pool, const float* ls_pool) {
    const int G = gridDim.x, bx = blockIdx.x;
    { SchedG S; S.o.init(T / 256, 2, 1, G, bx); S.A = (const char*)o.POOLED; S.B = (const char*)o.WpoolT; S.gA = 0; S.gB = 0; S.tA = (size_t)256 * 512 * 2; S.tB = (size_t)256 * 512 * 2;
      EpiPoolMixB E{o.MIXED, b_pool, ls_pool}; pg::gemm_phase<EpiPoolMixB, SchedG>(lds, 512, 512, 512, S, E); }
    { SchedG S; S.o.init(T / 256, 1, 4, G, (bx + 128) % G); S.A = (const char*)o.UC; S.B = (const char*)o.WqT; S.gA = 256 * 2; S.gB = (size_t)65536 * 2; S.tA = (size_t)256 * 1024 * 2; S.tB = 0;
      EpiQ E{o.Q, o3.A2, o3.winter}; pg::gemm_phase<EpiQ, SchedG>(lds, 1024, 256, 256, S, E); }
    { SchedG S; S.o.init(T / 256, 1, 4, G, (bx + 128) % G); S.A = (const char*)o.UC; S.B = (const char*)o.WkT; S.gA = 256 * 2; S.gB = (size_t)65536 * 2; S.tA = (size_t)256 * 1024 * 2; S.tB = 0;
      pg::EpiStoreBf16 E{o.K, 1024, 1.f, 256}; pg::gemm_phase<pg::EpiStoreBf16, SchedG>(lds, 1024, 256, 256, S, E); }
    { SchedG S; S.o.init(1, T / 256, 4, G, bx); S.A = (const char*)o.WkT; S.B = (const char*)o.UC; S.gA = (size_t)65536 * 2; S.gB = 256 * 2; S.tA = 0; S.tB = (size_t)256 * 1024 * 2;
      EpiKT E{o3.KaT, o3.aw}; pg::gemm_phase<EpiKT, SchedG>(lds, 256, 1024, 256, S, E); }
}
__device__ __forceinline__ void ph_gemms_E(LAS unsigned char* lds, const OptBufs& ob, const OptBufs2& o2, const OptBufs3& o3) {
    const int G = gridDim.x, bx = blockIdx.x;
    ph_un(lds, o2, o3);
    { SchedG1 S; S.o.init(1, 1, 256, G, bx); S.Q = (const char*)o2.Q; S.K = (const char*)o2.K;
      EpiS E{o3.A2, o3.rowv, o3.colv, o3.den}; pg::gemm_phase<EpiS, SchedG1>(lds, 1024, 1024, 256, S, E); }
    { SchedG2 S; S.o.init(1, 1, 240, G, bx); S.BT2 = (const char*)ob.BT2; S.KaT = (const char*)o3.KaT;
      EpiF32U E{o3.U}; pg::gemm_phase<EpiF32U, SchedG2>(lds, 512, T, 256, S, E); }
}
__device__ __forceinline__ void ph_gemm_G3(LAS unsigned char* lds, const OptBufs& ob, const OptBufs3& o3, const float* gain) {
    SchedG3 S; S.o.init(1, 1, 256, gridDim.x, blockIdx.x); S.A2 = (const char*)o3.A2; S.BT2 = (const char*)ob.BT2;
    EpiNum E{o3.HOUT, ob.OGQ, o3.den, o3.emt, gain}; pg::gemm_phase<EpiNum, SchedG3>(lds, 2048, 512, 512, S, E);
}
__device__ __forceinline__ void ph_gemm_ypool(LAS unsigned char* lds, const OptBufs2& o) {
    const int G = gridDim.x, bx = blockIdx.x;
    SchedG S; S.o.init(T / 256, 4, 1, G, bx); S.A = (const char*)o.MIXED; S.B = (const char*)o.WbpT; S.gA = 0; S.gB = 0; S.tA = (size_t)256 * 512 * 2; S.tB = (size_t)256 * 512 * 2;
    pg::EpiStoreBf16 E{o.YPOOL, 1024, 1.f, 0}; pg::gemm_phase<pg::EpiStoreBf16, SchedG>(lds, 512, 512, 512, S, E);
}


struct OptBufs4 { pg::bf16_t *WbmT, *WoutT, *MERGED, *H1B; unsigned char* H1Q; float *Z, *WRP, *CGB; int *elist, *erank; float *gate; };
struct EpiMerge {
    static constexpr bool PERM = true, AFTER_DRAIN = false, BIAS = false;
    pg::bf16_t* O; const unsigned char* OGQ; const pg::bf16_t* YPOOL;
    __device__ __forceinline__ void operator()(const pg::f32x4 (&acc)[2][2][4][2], const pg::Unit& u, int wr, int wc, int fr, int fq) const {
        const int col0 = u.pn * 256 + wc * 32 + 8 * fq;
#pragma unroll
        for (int ai = 0; ai < 2; ++ai)
#pragma unroll
            for (int m = 0; m < 4; ++m) { const size_t t = (size_t)u.pm * 256 + ai * 128 + wr * 64 + m * 16 + fr;
                const unsigned char* gp = OGQ + t * 3072 + (4 + u.pn) * 256 + (wc * 4 + fq) * 16;
                const pg::u32x4 w0 = *(const pg::u32x4*)gp, w1 = *(const pg::u32x4*)(gp + 1024);
#pragma unroll
                for (int bj = 0; bj < 2; ++bj) { const int c = col0 + bj * 128; float g0[8], g1[8], yp[8], r[8]; float f[4];
                    fp8x4_to_f32(bj ? w0.z : w0.x, f); g0[0] = f[0]; g0[1] = f[1]; g0[2] = f[2]; g0[3] = f[3];
                    fp8x4_to_f32(bj ? w0.w : w0.y, f); g0[4] = f[0]; g0[5] = f[1]; g0[6] = f[2]; g0[7] = f[3];
                    fp8x4_to_f32(bj ? w1.z : w1.x, f); g1[0] = f[0]; g1[1] = f[1]; g1[2] = f[2]; g1[3] = f[3];
                    fp8x4_to_f32(bj ? w1.w : w1.y, f); g1[4] = f[0]; g1[5] = f[1]; g1[6] = f[2]; g1[7] = f[3];
                    ld8(YPOOL + t * 1024 + c, yp);
#pragma unroll
                    for (int j = 0; j < 8; ++j) { const float a_ = (j < 4) ? acc[ai][bj][m][0][j] : acc[ai][bj][m][1][j - 4]; r[j] = fsigmoid(g0[j]) * yp[j] + fsigmoid(g1[j]) * a_; }
                    st8(O + t * 1024 + c, r); }
                asm volatile("" ::: "memory"); }
    }
};
struct EpiMixRes {
    static constexpr bool PERM = false, AFTER_DRAIN = false, BIAS = false;
    float* Z; const float* x; const float* stats; const float* g; const float* beta;
    __device__ __forceinline__ void operator()(const pg::f32x4 (&acc)[2][2][4][2], const pg::Unit& u, int wr, int wc, int fr, int fq) const {
        const int col0 = u.pn * 256 + wc * 32 + 4 * fq;
#pragma unroll
        for (int ai = 0; ai < 2; ++ai)
#pragma unroll
            for (int m = 0; m < 4; ++m) { const size_t t = (size_t)u.pm * 256 + ai * 128 + wr * 64 + m * 16 + fr; const float mu = stats[t * 2], rstd = stats[t * 2 + 1];
#pragma unroll
                for (int bj = 0; bj < 2; ++bj)
#pragma unroll
                    for (int n = 0; n < 2; ++n) { const int c = col0 + bj * 128 + n * 16;
                        const pg::f32x4 xv = *(const pg::f32x4*)(x + t * 1024 + c), gv = *(const pg::f32x4*)(g + c), bv = *(const pg::f32x4*)(beta + c);
                        *(pg::f32x4*)(Z + t * 1024 + c) = ((xv - mu) * rstd * gv + bv) * ALPHA + acc[ai][bj][m][n]; }
                asm volatile("" ::: "memory"); }
    }
};
__device__ __forceinline__ void ph_gemm_ymls(LAS unsigned char* lds, const OptBufs& ob, const OptBufs2& o2, const OptBufs3& o3, const OptBufs4& o4) {
    SchedG S; S.o.init(T / 256, 4, 1, gridDim.x, blockIdx.x); S.A = (const char*)o3.HOUT; S.B = (const char*)o4.WbmT; S.gA = 0; S.gB = 0; S.tA = (size_t)256 * 1024 * 2; S.tB = (size_t)256 * 1024 * 2;
    EpiMerge E{o4.MERGED, ob.OGQ, o2.YPOOL}; pg::gemm_phase<EpiMerge, SchedG>(lds, 1024, 1024, 1024, S, E);
}
__device__ __forceinline__ void ph_gemm_mix(LAS unsigned char* lds, const OptBufs& ob, const OptBufs4& o4, const float* x, const float* g, const float* beta) {
    SchedG S; S.o.init(T / 256, 4, 1, gridDim.x, blockIdx.x); S.A = (const char*)o4.MERGED; S.B = (const char*)o4.WoutT; S.gA = 0; S.gB = 0; S.tA = (size_t)256 * 1024 * 2; S.tB = (size_t)256 * 1024 * 2;
    EpiMixRes E{o4.Z, x, ob.stats, g, beta}; pg::gemm_phase<EpiMixRes, SchedG>(lds, 1024, 1024, 1024, S, E);
}
typedef float f32x16 __attribute__((ext_vector_type(16)));
__device__ __forceinline__ void ph_router_prep(const OptBufs4& o, const float* g, const float* beta, const float* wr_, const float* br) {
    const int gt = blockIdx.x * NT + tidf(), ngt = gridDim.x * NT;
    for (int i = gt; i < 1024 * 32; i += ngt) o.WRP[i] = g[i >> 5] * wr_[i];
    const int gw = gt >> 6, lane = gt & 63;
    if (gw < 64) { const int e = gw & 31; const float* vsrc = (gw < 32) ? g : beta; float s_ = 0.f;
#pragma unroll
        for (int i = 0; i < 16; ++i) { const int k = lane + 64 * i; s_ += vsrc[k] * wr_[k * 32 + e]; }
        s_ = wsum(s_);
        if (lane == 0) o.CGB[gw] = s_ + ((gw < 32) ? 0.f : br[e]); }
}
__device__ __forceinline__ void ph_ln1_router(LAS unsigned char* lds, const OptBufs4& o, const float* Zin, const float* g, const float* beta, int* cnt, int mode = 7) {
    const int tid = tidf(), lane = tid & 63, wave = tid >> 6;
    LAS float* part = (LAS float*)lds;
    LAS float* stg = (LAS float*)(lds + wave * 9216);
    LAS float* L = (LAS float*)(lds + 81920);
    LAS float* st = (LAS float*)(lds + 81920 + 8448);
    LAS int* hist = (LAS int*)(lds + 131072 + 1024);
    LAS int* asg = (LAS int*)(lds + 131072 + 1024 + 256);
    for (int tile = blockIdx.x; tile < T / 64; tile += gridDim.x) {
        __syncthreads();
        if (tid < 64) hist[tid] = 0;
        const size_t tbase = (size_t)tile * 64 + wave * 8;
        pg::f32x4 va[4];
#pragma unroll
        for (int j = 0; j < 4; ++j) va[j] = ((const pg::f32x4*)(Zin + tbase * D) + lane)[64 * j];
        for (int r = 0; r < ((mode & 1) ? 8 : 0); ++r) {
            pg::f32x4 na[4];
            if (r < 7) {
#pragma unroll
                for (int j = 0; j < 4; ++j) na[j] = ((const pg::f32x4*)(Zin + (tbase + r + 1) * D) + lane)[64 * j]; }
            float sa = 0.f;
#pragma unroll
            for (int j = 0; j < 4; ++j) sa += (va[j].x + va[j].y) + (va[j].z + va[j].w);
            const float ma = wsum(sa) * (1.f / D); float qa = 0.f;
#pragma unroll
            for (int j = 0; j < 4; ++j) { va[j] = va[j] - ma; qa += (va[j].x * va[j].x + va[j].y * va[j].y) + (va[j].z * va[j].z + va[j].w * va[j].w); }
            const float ra = rsqrtf(wsum(qa) * (1.f / D) + LN_EPS);
            const size_t ta = tbase + r;
            if (lane == 0) { st[(wave * 8 + r) * 2] = ma; st[(wave * 8 + r) * 2 + 1] = ra; }
#pragma unroll
            for (int j = 0; j < 4; ++j) { const int c0 = 256 * j + 4 * lane;
                const pg::f32x4 gg = *(const pg::f32x4*)(g + c0), bb = *(const pg::f32x4*)(beta + c0);
                const pg::f32x4 y = va[j] * ra * gg + bb;
                *(unsigned long long*)(o.H1B + ta * D + c0) = (unsigned long long)pk2(y.x, y.y) | ((unsigned long long)pk2(y.z, y.w) << 32);
                int w0 = __builtin_amdgcn_cvt_pk_fp8_f32(y.x, y.y, 0, false); w0 = __builtin_amdgcn_cvt_pk_fp8_f32(y.z, y.w, w0, true); *(int*)(o.H1Q + ta * D + c0) = w0; }
#pragma unroll
            for (int j = 0; j < 4; ++j) va[j] = na[j];
        }
        if (mode & 2) { const int hh = lane >> 5, el = lane & 31, kb = wave * 128;
          f32x16 acc0, acc1;
#pragma unroll
          for (int i = 0; i < 16; ++i) { acc0[i] = 0.f; acc1[i] = 0.f; }
          const float* zt = Zin + (size_t)tile * 64 * D + kb;
          pg::f32x4 zv[8];
#pragma unroll
          for (int it = 0; it < 8; ++it) zv[it] = *(const pg::f32x4*)(zt + (size_t)(it * 8 + (lane >> 3)) * D + 4 * (lane & 7));
#pragma unroll 1
          for (int sub = 0; sub < 4; ++sub) {
              float bw[16];
#pragma unroll
              for (int s_ = 0; s_ < 16; ++s_) bw[s_] = o.WRP[(size_t)(kb + 32 * sub + 16 * hh + s_) * 32 + el];
#pragma unroll
              for (int it = 0; it < 8; ++it) *(LAS pg::f32x4*)(stg + (it * 8 + (lane >> 3)) * 36 + 4 * (lane & 7)) = zv[it];
              if (sub < 3) {
#pragma unroll
                  for (int it = 0; it < 8; ++it) zv[it] = *(const pg::f32x4*)(zt + (size_t)(it * 8 + (lane >> 3)) * D + 32 * (sub + 1) + 4 * (lane & 7)); }
              asm volatile("s_waitcnt lgkmcnt(0)" ::: "memory");
              pg::f32x4 a0[4], a1[4];
#pragma unroll
              for (int q = 0; q < 4; ++q) { a0[q] = *(const LAS pg::f32x4*)(stg + el * 36 + 16 * hh + 4 * q); a1[q] = *(const LAS pg::f32x4*)(stg + (32 + el) * 36 + 16 * hh + 4 * q); }
#pragma unroll
              for (int q = 0; q < 4; ++q) {
                  acc0 = __builtin_amdgcn_mfma_f32_32x32x2f32(a0[q].x, bw[4 * q + 0], acc0, 0, 0, 0); acc1 = __builtin_amdgcn_mfma_f32_32x32x2f32(a1[q].x, bw[4 * q + 0], acc1, 0, 0, 0);
                  acc0 = __builtin_amdgcn_mfma_f32_32x32x2f32(a0[q].y, bw[4 * q + 1], acc0, 0, 0, 0); acc1 = __builtin_amdgcn_mfma_f32_32x32x2f32(a1[q].y, bw[4 * q + 1], acc1, 0, 0, 0);
                  acc0 = __builtin_amdgcn_mfma_f32_32x32x2f32(a0[q].z, bw[4 * q + 2], acc0, 0, 0, 0); acc1 = __builtin_amdgcn_mfma_f32_32x32x2f32(a1[q].z, bw[4 * q + 2], acc1, 0, 0, 0);
                  acc0 = __builtin_amdgcn_mfma_f32_32x32x2f32(a0[q].w, bw[4 * q + 3], acc0, 0, 0, 0); acc1 = __builtin_amdgcn_mfma_f32_32x32x2f32(a1[q].w, bw[4 * q + 3], acc1, 0, 0, 0); }
              asm volatile("s_waitcnt lgkmcnt(0)" ::: "memory");
          }
          __syncthreads();
#pragma unroll
          for (int i = 0; i < 16; ++i) { part[((wave * 2 + 0) * 16 + i) * 64 + lane] = acc0[i]; part[((wave * 2 + 1) * 16 + i) * 64 + lane] = acc1[i]; }
        } else __syncthreads();
        __syncthreads();
#pragma unroll
        for (int i = 0; i < 4; ++i) { const int idx = tid + 512 * i; float sum = 0.f;
#pragma unroll
            for (int w = 0; w < 8; ++w) sum += part[w * 2048 + idx];
            const int mt = idx >> 10, rg = (idx >> 6) & 15, l2 = idx & 63, tok = mt * 32 + (rg & 3) + 8 * (rg >> 2) + 4 * (l2 >> 5), e = l2 & 31;
            L[tok * 33 + e] = st[tok * 2 + 1] * (sum - st[tok * 2] * o.CGB[e]) + o.CGB[32 + e]; }
        __syncthreads();
        if (tid < 64 && (mode & 4)) { const LAS float* lr_ = L + tid * 33; int i0 = -1, i1 = -1, i2 = -1, i3 = -1; float v0 = 0.f, v1 = 0.f, v2 = 0.f, v3 = 0.f;
#pragma unroll
            for (int k = 0; k < 4; ++k) { float bv = -INFINITY; int bi = 0;
                for (int e = 0; e < 32; ++e) { const float x = lr_[e]; if (e != i0 && e != i1 && e != i2 && x > bv) { bv = x; bi = e; } }
                if (k == 0) { i0 = bi; v0 = bv; } else if (k == 1) { i1 = bi; v1 = bv; } else if (k == 2) { i2 = bi; v2 = bv; } else { i3 = bi; v3 = bv; } }
            const float e1 = expf(v1 - v0), e2 = expf(v2 - v0), e3 = expf(v3 - v0), inv = 1.f / (1.f + e1 + e2 + e3);
            const size_t t = (size_t)tile * 64 + tid;
            *(pg::f32x4*)(o.gate + t * 4) = (pg::f32x4){inv, e1 * inv, e2 * inv, e3 * inv};
            const int r0 = atomicAdd((int*)(hist + i0), 1), r1 = atomicAdd((int*)(hist + i1), 1), r2 = atomicAdd((int*)(hist + i2), 1), r3 = atomicAdd((int*)(hist + i3), 1);
            asg[tid * 4 + 0] = i0 | (r0 << 8); asg[tid * 4 + 1] = i1 | (r1 << 8); asg[tid * 4 + 2] = i2 | (r2 << 8); asg[tid * 4 + 3] = i3 | (r3 << 8); }
        __syncthreads();
        if (tid < 32) hist[32 + tid] = atomicAdd(&cnt[tid], hist[tid]);
        __syncthreads();
        if (tid < 256) { const int a_ = asg[tid], e = a_ & 255, rank = hist[32 + e] + (a_ >> 8); const int t = tile * 64 + (tid >> 2);
            o.elist[e * T + rank] = t; o.erank[(size_t)t * 4 + (tid & 3)] = (e << 16) | rank; }
    }
    __syncthreads();
}
__device__ __forceinline__ void ph_adapt_route(const OptBufs4& o, const int* start, int* row_tok, int* row_of) {
    const int gt = blockIdx.x * NT + tidf(), ngt = gridDim.x * NT;
    for (int i = gt; i < NA; i += ngt) { const int er = o.erank[i], e = er >> 16, rank = er & 0xffff; const int dest = start[e] + rank; row_tok[dest] = i >> 2; row_of[i] = dest; }
}


struct OptBufs5 { pg::bf16_t *We1T, *We2T, *ACT, *Y; float* B1P; };
constexpr int MOE_TAB_OFF = 131072 + 4096;
__device__ __forceinline__ void moe_build_tab(LAS unsigned char* lds, const int* cnt) {
    LAS int* tab = (LAS int*)(lds + MOE_TAB_OFF);
    __syncthreads();
    if (tidf() == 0) { int s = 0; for (int e = 0; e < NE; ++e) { const int c = cnt[e]; tab[e] = s; tab[40 + e] = c; s += (c + 255) >> 8; } tab[NE] = s; }
    __syncthreads();
}
struct SchedMoE {
    const LAS int* tab; const int* cnt; const int* elist; const char* A; const char* B; size_t eB; int nN, nwg, G, c, gather;
    __device__ __forceinline__ bool next(int i, pg::Unit& u) const {
        const long L = (long)i * G + c; if (L >= nwg) return false;
        int wgid = (int)L; { const int q = nwg / pg::NXCD, r = nwg % pg::NXCD, xcd = wgid % pg::NXCD, off = wgid / pg::NXCD; wgid = (xcd < r ? xcd * (q + 1) : r * (q + 1) + (xcd - r) * q) + off; }
        const int mg = wgid / nN, pn = wgid - mg * nN;
        const int ln = tidf() & 63, tv = tab[ln < NE ? ln : NE];
        const int e = __builtin_amdgcn_readfirstlane(__popcll(__ballot(ln >= 1 && ln < NE && tv <= mg)));
        const int mt = mg - __builtin_amdgcn_readlane(tv, e);
        u.g = e; u.pm = mg; u.pn = pn; u.aux = mg * 256;
        u.B = B + (size_t)e * eB + (size_t)pn * 256 * 1024;
        if (gather) { u.A = A; u.rows = elist + (size_t)e * T + mt * 256; const int rem = __builtin_amdgcn_readfirstlane(tab[40 + e]) - mt * 256; u.nvalid = rem < 256 ? rem : 256; }
        else { u.A = A + (size_t)mg * 256 * 1024; u.rows = nullptr; u.nvalid = 0; }
        return true;
    }
};
struct EpiSwiglu {
    static constexpr bool PERM = true, AFTER_DRAIN = false, BIAS = true;
    unsigned char* ACT; const float* B1P;
    __device__ __forceinline__ const float* bias_base(const pg::Unit& u) const { return B1P + u.g * 2048 + u.pn * 256; }
    __device__ __forceinline__ void operator()(const pg::f32x4 (&acc)[2][2][4][2], const pg::Unit& u, int wr, int wc, int fr, int fq) const {
        const int col0 = wc * 32 + 8 * fq;
        unsigned char* base = ACT + (size_t)(u.aux + wr * 64 + fr) * 1024 + u.pn * 128 + col0;
#pragma unroll
        for (int ai = 0; ai < 2; ++ai)
#pragma unroll
            for (int m = 0; m < 4; ++m) { float r[8];
#pragma unroll
                for (int j = 0; j < 8; ++j) { float g = (j < 4) ? acc[ai][0][m][0][j] : acc[ai][0][m][1][j - 4];
                    float l = (j < 4) ? acc[ai][1][m][0][j] : acc[ai][1][m][1][j - 4];
                    g = fminf(g, 7.f); l = fminf(fmaxf(l, -7.f), 7.f);
                    r[j] = g * (l + 1.f) * __builtin_amdgcn_rcpf(1.f + __expf(-1.702f * g)); }
                { int w0 = __builtin_amdgcn_cvt_pk_fp8_f32(r[0], r[1], 0, false); w0 = __builtin_amdgcn_cvt_pk_fp8_f32(r[2], r[3], w0, true);
                  int w1 = __builtin_amdgcn_cvt_pk_fp8_f32(r[4], r[5], 0, false); w1 = __builtin_amdgcn_cvt_pk_fp8_f32(r[6], r[7], w1, true);
                  *(pg::u32x2*)(base + (size_t)(ai * 128 + m * 16) * 1024) = (pg::u32x2){(unsigned)w0, (unsigned)w1}; }
                asm volatile("" ::: "memory"); }
    }
};
struct EpiY {
    static constexpr bool PERM = true, AFTER_DRAIN = false, BIAS = true;
    unsigned char* Y; const float* b2;
    __device__ __forceinline__ const float* bias_base(const pg::Unit& u) const { return b2 + u.g * 1024 + u.pn * 256; }
    __device__ __forceinline__ void operator()(const pg::f32x4 (&acc)[2][2][4][2], const pg::Unit& u, int wr, int wc, int fr, int fq) const {
        unsigned char* base = Y + (size_t)(u.aux + wr * 64 + fr) * 1024 + u.pn * 256 + (wc * 4 + fq) * 16;
#pragma unroll
        for (int ai = 0; ai < 2; ++ai)
#pragma unroll
            for (int m = 0; m < 4; ++m) { pg::u32x4 w;
                { const pg::f32x4 v0 = acc[ai][0][m][0] * 16.f, v1 = acc[ai][0][m][1] * 16.f;
                  int p = __builtin_amdgcn_cvt_pk_fp8_f32(v0[0], v0[1], 0, false); p = __builtin_amdgcn_cvt_pk_fp8_f32(v0[2], v0[3], p, true); w.x = (unsigned)p;
                  p = __builtin_amdgcn_cvt_pk_fp8_f32(v1[0], v1[1], 0, false); p = __builtin_amdgcn_cvt_pk_fp8_f32(v1[2], v1[3], p, true); w.y = (unsigned)p; }
                { const pg::f32x4 v0 = acc[ai][1][m][0] * 16.f, v1 = acc[ai][1][m][1] * 16.f;
                  int p = __builtin_amdgcn_cvt_pk_fp8_f32(v0[0], v0[1], 0, false); p = __builtin_amdgcn_cvt_pk_fp8_f32(v0[2], v0[3], p, true); w.z = (unsigned)p;
                  p = __builtin_amdgcn_cvt_pk_fp8_f32(v1[0], v1[1], 0, false); p = __builtin_amdgcn_cvt_pk_fp8_f32(v1[2], v1[3], p, true); w.w = (unsigned)p; }
                *(pg::u32x4*)(base + (size_t)(ai * 128 + m * 16) * 1024) = w; asm volatile("" ::: "memory"); }
    }
};
struct EpiNull { static constexpr bool PERM = true, AFTER_DRAIN = false, BIAS = false;
    float* sink;
    __device__ __forceinline__ void operator()(const pg::f32x4 (&acc)[2][2][4][2], const pg::Unit& u, int wr, int wc, int fr, int fq) const {
        float s_ = 0.f;
#pragma unroll
        for (int ai = 0; ai < 2; ++ai)
#pragma unroll
            for (int bj = 0; bj < 2; ++bj)
#pragma unroll
                for (int m = 0; m < 4; ++m)
#pragma unroll
                    for (int n = 0; n < 2; ++n) s_ += acc[ai][bj][m][n][0];
        if (s_ == 1.2345e30f) sink[0] = s_; } };
__device__ __forceinline__ void ph_moe1_probe(LAS unsigned char* lds, const OptBufs4& o4, const OptBufs5& o5, const int* cnt, int mode, unsigned char* dummy) {
    moe_build_tab(lds, cnt);
    SchedMoE S; S.tab = (const LAS int*)(lds + MOE_TAB_OFF); S.cnt = cnt; S.elist = o4.elist; S.A = (const char*)o4.H1Q; S.B = (const char*)o5.We1T; S.eB = (size_t)2048 * 1024;
    S.nN = 8; S.nwg = __builtin_amdgcn_readfirstlane(S.tab[NE]) * 8; S.G = gridDim.x; S.c = blockIdx.x; S.gather = 1;
    if (mode == 0) { EpiSwiglu E{dummy, o5.B1P}; pg::gemm_phase<EpiSwiglu, SchedMoE, true, true>(lds, 512, 512, 512, S, E); }
    if (mode == 1) { S.gather = 0; S.A = (const char*)o5.ACT; EpiSwiglu E{dummy, o5.B1P}; pg::gemm_phase<EpiSwiglu, SchedMoE, false, true>(lds, 512, 512, 512, S, E); }
    if (mode == 2) { EpiNull E{(float*)dummy}; pg::gemm_phase<EpiNull, SchedMoE, true, true>(lds, 512, 512, 512, S, E); }
    if (mode == 3) { S.gather = 0; S.A = (const char*)o5.ACT; EpiNull E{(float*)dummy}; pg::gemm_phase<EpiNull, SchedMoE, false, true>(lds, 512, 512, 512, S, E); }
}
__device__ __forceinline__ void ph_moe1(LAS unsigned char* lds, const OptBufs4& o4, const OptBufs5& o5, const int* cnt) {
    moe_build_tab(lds, cnt);
    SchedMoE S; S.tab = (const LAS int*)(lds + MOE_TAB_OFF); S.cnt = cnt; S.elist = o4.elist; S.A = (const char*)o4.H1Q; S.B = (const char*)o5.We1T; S.eB = (size_t)2048 * 1024;
    S.nN = 8; S.nwg = __builtin_amdgcn_readfirstlane(S.tab[NE]) * 8; S.G = gridDim.x; S.c = blockIdx.x; S.gather = 1;
    EpiSwiglu E{(unsigned char*)o5.ACT, o5.B1P}; pg::gemm_phase<EpiSwiglu, SchedMoE, true, true>(lds, 512, 512, 512, S, E);
}
__device__ __forceinline__ void ph_moe2(LAS unsigned char* lds, const OptBufs5& o5, const int* cnt, const float* b_e2) {
    moe_build_tab(lds, cnt);
    SchedMoE S; S.tab = (const LAS int*)(lds + MOE_TAB_OFF); S.cnt = cnt; S.elist = nullptr; S.A = (const char*)o5.ACT; S.B = (const char*)o5.We2T; S.eB = (size_t)1024 * 1024;
    S.nN = 4; S.nwg = __builtin_amdgcn_readfirstlane(S.tab[NE]) * 4; S.G = gridDim.x; S.c = blockIdx.x; S.gather = 0;
    EpiY E{(unsigned char*)o5.Y, b_e2}; pg::gemm_phase<EpiY, SchedMoE, false, true>(lds, 512, 512, 512, S, E);
}
__device__ __forceinline__ void ph_final_opt(LAS unsigned char* lds, const OptBufs4& o4, const OptBufs5& o5, const int* cnt, const float* g, const float* beta, float* out) {
    moe_build_tab(lds, cnt);
    const LAS int* tab = (const LAS int*)(lds + MOE_TAB_OFF);
    const int tid = tidf(), lane = tid & 63, gw = blockIdx.x * NW + (tid >> 6), ngw = gridDim.x * NW;
    const int cbase = (lane >> 4) * 256 + ((lane >> 2) & 3) * 32 + (lane & 3) * 8;
    const unsigned char* Y8 = (const unsigned char*)o5.Y;
    for (int t = gw; t < T; t += ngw) {
        float v[16];
        { float h[8]; ld8(o4.H1B + (size_t)t * D + cbase, h);
#pragma unroll
          for (int j = 0; j < 8; ++j) v[j] = h[j] * ALPHA;
          ld8(o4.H1B + (size_t)t * D + cbase + 128, h);
#pragma unroll
          for (int j = 0; j < 8; ++j) v[8 + j] = h[j] * ALPHA; }
#pragma unroll
        for (int k = 0; k < 4; ++k) { const int er = o4.erank[(size_t)t * 4 + k]; const float gk = o4.gate[(size_t)t * 4 + k] * 0.0625f;
            const pg::u32x4 w = *(const pg::u32x4*)(Y8 + (size_t)(tab[er >> 16] * 256 + (er & 0xffff)) * 1024 + lane * 16);
            float f[4];
            fp8x4_to_f32(w.x, f); v[0] += gk * f[0]; v[1] += gk * f[1]; v[2] += gk * f[2]; v[3] += gk * f[3];
            fp8x4_to_f32(w.y, f); v[4] += gk * f[0]; v[5] += gk * f[1]; v[6] += gk * f[2]; v[7] += gk * f[3];
            fp8x4_to_f32(w.z, f); v[8] += gk * f[0]; v[9] += gk * f[1]; v[10] += gk * f[2]; v[11] += gk * f[3];
            fp8x4_to_f32(w.w, f); v[12] += gk * f[0]; v[13] += gk * f[1]; v[14] += gk * f[2]; v[15] += gk * f[3]; }
        float s_ = 0.f;
#pragma unroll
        for (int j = 0; j < 16; ++j) s_ += v[j];
        const float mean = wsum(s_) * (1.f / D); float s2 = 0.f;
#pragma unroll
        for (int j = 0; j < 16; ++j) { v[j] -= mean; s2 += v[j] * v[j]; }
        const float rstd = rsqrtf(wsum(s2) * (1.f / D) + LN_EPS);
#pragma unroll
        for (int run = 0; run < 2; ++run)
#pragma unroll
            for (int q = 0; q < 2; ++q) { const int c0 = cbase + run * 128 + q * 4;
                const pg::f32x4 gg = *(const pg::f32x4*)(g + c0), bb = *(const pg::f32x4*)(beta + c0);
                pg::f32x4 y; y.x = v[run * 8 + q * 4 + 0] * rstd; y.y = v[run * 8 + q * 4 + 1] * rstd; y.z = v[run * 8 + q * 4 + 2] * rstd; y.w = v[run * 8 + q * 4 + 3] * rstd;
                *(pg::f32x4*)(out + (size_t)t * D + c0) = y * gg + bb; }
    }
}

__device__ __forceinline__ void ph_adapt1(const OptBufs& o, const float* b_if, float* proj) {
    const size_t gt = (size_t)blockIdx.x * NT + tidf(), ngt = (size_t)gridDim.x * NT;
    for (size_t i = gt; i < (size_t)T * INC; i += ngt) {
        const int c = (int)(i % INC); const int t = (int)(i / INC);
        float v;
        if (c < C_V) v = bf2f(o.PROJ[(size_t)t * PROJW + c]);
        else if (c < C_O) { const int e = c - C_V, h = e >> 8, el = e & 255, b = t >> 12, cc = (t & 4095) >> 8, tl = t & 255;
            v = bf2f(o.BT2[((size_t)((b * 4 + h) * 16 + cc) * 256 + el) * 512 + tl]); }
        else if (c < C_IF) v = bf2f(o.PROJ[(size_t)t * PROJW + c - 1024]);
        else if (c < C_G) v = o.gif[(size_t)t * 8 + (c - C_IF)] - b_if[c - C_IF];
        else v = bf2f(o.PROJ[(size_t)t * PROJW + c - C_G + PJ_G]);
        proj[i] = v;
    }
}

struct PrepSrc { const float *w_in, *w_q, *w_k, *w_pool, *w_bp, *w_bm, *w_out, *w_e1, *w_e2, *b_e1; };
constexpr int TI_E1 = 16384, TI_E2 = 8192, TI_IN = (WIN_ROWS / 64) * 16, TI_MO = 512, TI_QK = 128, TI_BP = 128, TI_PL = 16;
constexpr int TI_TOTAL = TI_E1 + TI_E2 + TI_IN + TI_MO + TI_QK + TI_BP + TI_PL;
__device__ __forceinline__ TItem titem_decode(int it, const PrepSrc& p, const OptBufs& ob, const OptBufs2& o2, const OptBufs4& o4, const OptBufs5& o5) {
    TItem t; t.inter = 0; t.fp8 = 0; t.valid = it < TI_TOTAL; t.src = p.w_in; t.dst = ob.WinT; t.ldw = 64; t.ldt = 64;
    if (!t.valid) return t;
    if (it < TI_E1) { const int nb = it & 31, kb = (it >> 5) & 15, e = it >> 9, j0 = nb * 32, pn = j0 >> 7, jj0 = j0 & 127;
        t.src = p.w_e1 + (size_t)e * 1024 * 2048 + (size_t)(kb * 64) * 2048 + nb * 64; t.dst = (pg::bf16_t*)((unsigned char*)o5.We1T + (size_t)e * 2048 * 1024 + (size_t)(pn * 256 + jj0) * 1024 + kb * 64); t.ldw = 2048; t.ldt = 1024; t.inter = 1; t.fp8 = 1; return t; }
    it -= TI_E1;
    if (it < TI_E2) { const int nb = it & 15, kb = (it >> 4) & 15, e = it >> 8;
        t.src = p.w_e2 + (size_t)e * 1024 * 1024 + (size_t)(kb * 64) * 1024 + nb * 64; t.dst = (pg::bf16_t*)((unsigned char*)o5.We2T + (size_t)e * 1024 * 1024 + (size_t)(nb * 64) * 1024 + kb * 64); t.ldw = 1024; t.ldt = 1024; t.fp8 = 1; return t; }
    it -= TI_E2;
    if (it < TI_IN) { const int rb = it >> 4, kb = it & 15;
        t.src = p.w_in + (size_t)(kb * 64) * INC + win_src_col(rb * 64); t.ldw = INC; t.ldt = D;
        if (rb * 64 >= PJ_O && rb * 64 < PROJW) { t.dst = (pg::bf16_t*)(ob.WinQ + (size_t)(rb * 64 - PJ_O) * D + kb * 64); t.fp8 = 1; }
        else t.dst = ob.WinT + (size_t)(rb * 64) * D + kb * 64;
        return t; }
    it -= TI_IN;
    if (it < TI_MO) { const int which = it >> 8, r = it & 255, nb = r >> 4, kb = r & 15;
        t.src = (which ? p.w_out : p.w_bm) + (size_t)(kb * 64) * 1024 + nb * 64; t.dst = (which ? o4.WoutT : o4.WbmT) + (size_t)(nb * 64) * 1024 + kb * 64; t.ldw = 1024; t.ldt = 1024; return t; }
    it -= TI_MO;
    if (it < TI_QK) { const int which = it >> 6, r = it & 63, h = r >> 4, nb = (r & 15) >> 2, kb = r & 3;
        t.src = (which ? p.w_k : p.w_q) + (size_t)h * 65536 + (size_t)(kb * 64) * 256 + nb * 64; t.dst = (which ? o2.WkT : o2.WqT) + (size_t)h * 65536 + (size_t)(nb * 64) * 256 + kb * 64; t.ldw = 256; t.ldt = 256; return t; }
    it -= TI_QK;
    if (it < TI_BP) { const int nb = it >> 3, kb = it & 7;
        t.src = p.w_bp + (size_t)(kb * 64) * 1024 + nb * 64; t.dst = o2.WbpT + (size_t)(nb * 64) * 512 + kb * 64; t.ldw = 1024; t.ldt = 512; return t; }
    it -= TI_BP;
    { const int g = it >> 2, nb = (it & 3) >> 1, kb = it & 1;
        t.src = p.w_pool + (size_t)g * 16384 + (size_t)(kb * 64) * 128 + nb * 64; t.dst = o2.WpoolT + (size_t)(g * 128 + nb * 64) * 512 + g * 128 + kb * 64; t.ldw = 128; t.ldt = 512; return t; }
}
__device__ __forceinline__ void ph_prep_all(LAS unsigned char* lds, const PrepSrc& p, const OptBufs& ob, const OptBufs2& o2, const OptBufs4& o4, const OptBufs5& o5) {
    const int tid = tidf(), lane = tid & 63, wave = tid >> 6, gw = blockIdx.x * NW + wave, ngw = gridDim.x * NW;
    LAS float* scr = (LAS float*)(lds + wave * 16384);
    int it = gw; TItem cur = titem_decode(it, p, ob, o2, o4, o5);
    pg::f32x4 r[16];
    if (cur.valid) titem_load(cur, r, lane);
    while (cur.valid) {
        const int nx = it + ngw; const TItem nxt = titem_decode(nx, p, ob, o2, o4, o5);
        pg::f32x4 rn[16];
        if (nxt.valid) titem_load(nxt, rn, lane);
        titem_store(cur, r, scr, lane);
#pragma unroll
        for (int i = 0; i < 16; ++i) r[i] = rn[i];
        cur = nxt; it = nx;
    }
    { const size_t gt = (size_t)blockIdx.x * NT + tid, ngt = (size_t)gridDim.x * NT;
      for (size_t ch = gt; ch < 512 * 64; ch += ngt) { const int n = (int)(ch >> 6), k8 = (int)(ch & 63) * 8; if ((n >> 7) != (k8 >> 7)) *(pg::u32x4*)(o2.WpoolT + (size_t)n * 512 + k8) = (pg::u32x4){0u, 0u, 0u, 0u}; } }
    for (int i = blockIdx.x * NT + tid; i < 32 * 2048; i += gridDim.x * NT) { const int e = i >> 11, rr = i & 2047, pn = rr >> 8, bj = (rr >> 7) & 1, jj = rr & 127; o5.B1P[i] = p.b_e1[e * 2048 + 2 * (pn * 128 + jj) + bj]; }
}

struct Args { const float* in[26]; float* out; unsigned char* ws; int ph_lo, ph_hi; };
constexpr size_t MiB = 1u << 20;
constexpr size_t WS_CTL = 0;
constexpr size_t CTL_ZERO_BYTES = 1 * MiB;
constexpr int CW_BAR = 4096;
constexpr int CW_CNT = 16384, CW_START = 16384 + 64, CW_FILL = 16384 + 128;

__global__ void __launch_bounds__(NT, 2) mk_fwd(Args a) {
    extern __shared__ __attribute__((aligned(16))) unsigned char lds_raw[];
    LAS unsigned char* lds = (LAS unsigned char*)lds_raw;
    volatile LAS unsigned* MISC = (volatile LAS unsigned*)(lds + MISC_OFF);
    const int tid = tidf();
    if (tid < 32) MISC[tid] = 0u;
    __syncthreads();
    unsigned char* ws = a.ws;
    unsigned* ctl = (unsigned*)(ws + WS_CTL);
    XcdBarrier bar = xcd_barrier_post(ctl + CW_BAR, MISC + 8);
    const float* x = a.in[0]; const float* ln0_g = a.in[1]; const float* ln0_b = a.in[2];
    const float* w_in = a.in[3]; const float* conv_w = a.in[4]; const float* conv_b = a.in[5];
    const float* w_q = a.in[6]; const float* w_k = a.in[7]; const float* b_if = a.in[8];
    const float* mh_gain = a.in[9]; const float* w_pool = a.in[10]; const float* b_pool = a.in[11];
    const float* ls_pool = a.in[12]; const float* w_bp = a.in[13]; const float* w_bm = a.in[14];
    const float* w_out = a.in[15]; const float* ln1_g = a.in[16]; const float* ln1_b = a.in[17];
    const float* w_router = a.in[18]; const float* b_router = a.in[19]; const float* w_e1 = a.in[20];
    const float* b_e1 = a.in[21]; const float* w_e2 = a.in[22]; const float* b_e2 = a.in[23];
    const float* ln2_g = a.in[24]; const float* ln2_b = a.in[25];
    OptBufs ob; ob.WinT = (pg::bf16_t*)(ws + 8 * MiB); ob.H0B = (pg::bf16_t*)(ws + 220 * MiB); ob.PROJ = (pg::bf16_t*)(ws + 252 * MiB); ob.BT2 = (pg::bf16_t*)(ws + 396 * MiB);
    ob.gif = (float*)(ws + 1 * MiB); ob.stats = (float*)(ws + 1 * MiB + 512 * 1024); ob.WinQ = (unsigned char*)(ws + 214 * MiB); ob.H0Q = (unsigned char*)(ws + 972 * MiB); ob.OGQ = (unsigned char*)(ws + 300 * MiB);
    OptBufs2 o2; o2.WqT = (pg::bf16_t*)(ws + 19 * MiB); o2.WkT = (pg::bf16_t*)(ws + 19 * MiB + 512 * 1024); o2.WpoolT = (pg::bf16_t*)(ws + 20 * MiB); o2.WbpT = (pg::bf16_t*)(ws + 20 * MiB + 512 * 1024);
    o2.POOLED = (pg::bf16_t*)(ws + 460 * MiB); o2.UC = (pg::bf16_t*)(ws + 476 * MiB); o2.MIXED = (pg::bf16_t*)(ws + 508 * MiB); o2.Q = (pg::bf16_t*)(ws + 524 * MiB); o2.K = (pg::bf16_t*)(ws + 556 * MiB);
    o2.YPOOL = (pg::bf16_t*)(ws + 748 * MiB);
    OptBufs3 o3; o3.KaT = (pg::bf16_t*)(ws + 588 * MiB); o3.A2 = (pg::bf16_t*)(ws + 620 * MiB); o3.U = (float*)(ws + 684 * MiB); o3.HOUT = (pg::bf16_t*)(ws + 780 * MiB);
    { float* sm = (float*)(ws + 2 * MiB); o3.rowv = sm; o3.colv = sm + 65536; o3.winter = sm + 2 * 65536; o3.aw = sm + 3 * 65536; o3.emt = sm + 4 * 65536; o3.den = sm + 5 * 65536; o3.un = sm + 6 * 65536; o3.decay = sm + 7 * 65536; }
    OptBufs4 o4; o4.WbmT = (pg::bf16_t*)(ws + 21 * MiB + 512 * 1024); o4.WoutT = (pg::bf16_t*)(ws + 23 * MiB + 512 * 1024); o4.MERGED = (pg::bf16_t*)(ws + 812 * MiB); o4.Z = (float*)(ws + 844 * MiB); o4.H1B = (pg::bf16_t*)(ws + 908 * MiB); o4.H1Q = (unsigned char*)(ws + 940 * MiB); o4.WRP = (float*)(ws + 7 * MiB + 512 * 1024); o4.CGB = (float*)(ws + 7 * MiB + 768 * 1024);
    o4.elist = (int*)(ws + 4 * MiB); o4.erank = (int*)(ws + 6 * MiB); o4.gate = (float*)(ws + 6 * MiB + 256 * 1024);
    OptBufs5 o5; o5.We1T = (pg::bf16_t*)(ws + 26 * MiB); o5.We2T = (pg::bf16_t*)(ws + 154 * MiB); o5.B1P = (float*)(ws + 7 * MiB);
    o5.ACT = (pg::bf16_t*)(ws + 252 * MiB);
    o5.Y = (pg::bf16_t*)(ws + 396 * MiB);
    int* cnt = (int*)ctl + CW_CNT;
    LAS float* ldsf = (LAS float*)lds;
    const int G = gridDim.x, bx = blockIdx.x;
#define IN(k) (a.ph_lo <= (k) && (k) < a.ph_hi)
#define SEAM(k) do { if (IN(k) && IN((k) + 1)) xcd_barrier(bar); } while (0)
    if (IN(0)) { PrepSrc ps{w_in, w_q, w_k, w_pool, w_bp, w_bm, w_out, w_e1, w_e2, b_e1}; ph_prep_all(lds, ps, ob, o2, o4, o5); ph_router_prep(o4, ln1_g, ln1_b, w_router, b_router); ph_ln0(lds, ob, x, ln0_g, ln0_b, w_in, b_if);
#if PROBE_PH == 0
        { xcd_barrier(bar); if (PROBE_MODE & 1) ph_prep_all(lds, ps, ob, o2, o4, o5); if (PROBE_MODE & 2) ph_ln0(lds, ob, x, ln0_g, ln0_b, w_in, b_if); }
#endif
    }
    SEAM(0);
    if (IN(1)) ph_inproj(lds, ob);
    SEAM(1);
    if (IN(2)) { if (bx >= G - 16) scalar_scan_wg(lds, bx - (G - 16), ob.gif, o3);
                 for (int i = bx * NT + tid; i < T * 4; i += G * NT) o3.den[i] = 0.f;
                 ph_poolconv_opt(ob.PROJ, conv_w, conv_b, o2.POOLED, o2.UC); }
    SEAM(2);
    if (IN(3)) ph_gemms_D(lds, o2, o3, b_pool, ls_pool);
    SEAM(3);
    if (IN(4)) { ph_gemm_ypool(lds, o2); ph_gemms_E(lds, ob, o2, o3);
#if PROBE_PH == 4
        { xcd_barrier(bar); OptBufs3 d3 = o3; d3.den = (float*)(ws + 980 * MiB); ph_gemm_ypool(lds, o2); ph_gemms_E(lds, ob, o2, d3); }
#endif
    }
    SEAM(4);
    if (IN(5)) { ph_state_scan(ob, o3); ph_den_inter(lds, o3);
#if PROBE_PH == 5
        { xcd_barrier(bar); OptBufs3 d3 = o3; d3.den = (float*)(ws + 980 * MiB); ph_state_scan(ob, d3); ph_den_inter(lds, d3); }
#endif
    }
    SEAM(5);
    if (IN(6)) ph_gemm_G3(lds, ob, o3, mh_gain);
    SEAM(6);
    if (IN(7)) ph_gemm_ymls(lds, ob, o2, o3, o4);
    SEAM(7);
    if (IN(8)) ph_gemm_mix(lds, ob, o4, x, ln0_g, ln0_b);
    SEAM(8);
    if (IN(9)) { ph_ln1_router(lds, o4, o4.Z, ln1_g, ln1_b, cnt);
#if PROBE_PH == 9
        { xcd_barrier(bar); OptBufs4 d4 = o4; d4.Z = (float*)(ws + 684 * MiB); d4.H1B = (pg::bf16_t*)(ws + 588 * MiB); d4.H1Q = (unsigned char*)(ws + 620 * MiB); d4.elist = (int*)(ws + 980 * MiB); d4.erank = (int*)(ws + 984 * MiB); d4.gate = (float*)(ws + 986 * MiB);
          ph_ln1_router(lds, d4, o4.Z, ln1_g, ln1_b, cnt + 256, PROBE_MODE); }
#endif
    }
    SEAM(9);
    if (IN(10)) { ph_moe1(lds, o4, o5, cnt);
#if PROBE_PH == 10
        { xcd_barrier(bar); ph_moe1_probe(lds, o4, o5, cnt, PROBE_MODE, (unsigned char*)(ws + 956 * MiB)); }
#endif
    }
    SEAM(10);
    if (IN(11)) ph_moe2(lds, o5, cnt, b_e2);
    SEAM(11);
    if (IN(12)) { ph_final_opt(lds, o4, o5, cnt, ln2_g, ln2_b, a.out);
#if PROBE_PH == 12
        { xcd_barrier(bar); ph_final_opt(lds, o4, o5, cnt, ln2_g, ln2_b, a.out); }
#endif
    }
}
constexpr int NPH = 13;
}

extern "C" void kernel_launch(void* const* d_in, const int* in_sizes, int n_in, void* d_out, int out_size, void* d_ws, size_t ws_size, hipStream_t stream) {
    using namespace mk;
    static int grid = 0;
    if (grid == 0) {
        if (n_in != 26 || ws_size < 1000 * MiB) { fprintf(stderr, "kernel_launch: unexpected n_in %d / ws %zu\n", n_in, ws_size); grid = -1; return; }
        int dev = 0, cus = 0, per_cu = 0;
        hipGetDevice(&dev); hipDeviceGetAttribute(&cus, hipDeviceAttributeMultiprocessorCount, dev);
        if (hipFuncSetAttribute((const void*)mk_fwd, hipFuncAttributeMaxDynamicSharedMemorySize, LDS_BYTES) != hipSuccess) { fprintf(stderr, "hipFuncSetAttribute failed\n"); grid = -1; return; }
        if (hipOccupancyMaxActiveBlocksPerMultiprocessor(&per_cu, (const void*)mk_fwd, NT, LDS_BYTES) != hipSuccess || per_cu < 1) { fprintf(stderr, "occupancy query failed (%d)\n", per_cu); grid = -1; return; }
        grid = cus * 1;
        fprintf(stderr, "kernel_launch: cus %d per_cu %d grid %d\n", cus, per_cu, grid);
    }
    if (grid < 0) return;
    hipMemsetAsync((char*)d_ws + WS_CTL, 0, CTL_ZERO_BYTES, stream);
    Args a{};
    for (int i = 0; i < 26; ++i) a.in[i] = (const float*)d_in[i];
    a.out = (float*)d_out; a.ws = (unsigned char*)d_ws; a.ph_lo = 0; a.ph_hi = NPH;
    void* args[] = {&a};
    hipError_t e = hipLaunchCooperativeKernel((const void*)mk_fwd, dim3(grid), dim3(NT), args, LDS_BYTES, stream);
    if (e != hipSuccess) fprintf(stderr, "cooperative launch failed: %s (grid %d)\n", hipGetErrorString(e), grid);
}
```

```cpp
#include <hip/hip_runtime.h>
#include <cstdio>
#include <cstdint>

#define LAS __attribute__((address_space(3)))
#ifndef PROBE_PH
#define PROBE_PH -1
#endif
#define PROBE_MODE 7
namespace mk {
constexpr int D = 1024, BATCH = 4, SEQ = 4096, T = BATCH * SEQ;
constexpr int INC = 5640;
constexpr int C_P = 0, C_U = 512, C_V = 1536, C_O = 2560, C_IF = 3584, C_G = 3592;
constexpr int NE = 32, TOPK = 4, NA = T * TOPK;
constexpr float LN_EPS = 1e-5f;
constexpr float ALPHA = 1.189207115002721f;
constexpr int NT = 512, NW = 8;
constexpr int LDS_BYTES = 147456, MISC_OFF = 147456 - 512;

#define XB_TMO      128
#define XB_XCNT(j)  (256  + 64 * (j))
#define XB_XSUB(j)  (1280 + 64 * (j))
#define XB_XGEN(j)  (2304 + 64 * (j))
#define XB_TOP      3328
#define XB_TOPGEN   3392
#define XCD_BAR_WORDS 3456
#define XB_SPIN_CAP (1u << 22)
__device__ __forceinline__ unsigned xb_ld(unsigned* p)              { return __hip_atomic_load(p, __ATOMIC_RELAXED, __HIP_MEMORY_SCOPE_AGENT); }
__device__ __forceinline__ unsigned xb_add(unsigned* p, unsigned v) { return __hip_atomic_fetch_add(p, v, __ATOMIC_RELAXED, __HIP_MEMORY_SCOPE_AGENT); }
__device__ __forceinline__ unsigned xb_xcc_id() { return (unsigned)__builtin_amdgcn_s_getreg((3 << 11) | 20) & 0xFu; }
#define XB_SPIN(cond, bar) do { unsigned _sp = 0; while (cond) { __builtin_amdgcn_s_sleep(1); \
    if ((++_sp & 255u) == 0u) { if (xb_ld(&(bar)[XB_TMO])) break; if (_sp > XB_SPIN_CAP) { atomicAdd(&(bar)[XB_TMO], 1u); break; } } } } while (0)
struct XcdBarrier { unsigned* bar; unsigned x; volatile LAS unsigned* st; };
__device__ __forceinline__ XcdBarrier xcd_barrier_post(unsigned* bar, volatile LAS unsigned* st) {
    XcdBarrier b; b.bar = bar; b.x = xb_xcc_id(); b.st = st;
    if (threadIdx.x == 0) (void)xb_add(&bar[XB_XCNT(b.x)], 1u);
    return b;
}
__device__ __forceinline__ void xcd_barrier_complete(unsigned* bar, unsigned x, unsigned& nloc, unsigned& nx) {
    const unsigned G = gridDim.x * gridDim.y * gridDim.z;
    unsigned sum, cnt, mine, sp = 0u;
    for (;;) {
        sum = 0u; cnt = 0u; mine = 0u;
#pragma unroll
        for (unsigned j = 0; j < 16; ++j) { const unsigned c = xb_ld(&bar[XB_XCNT(j)]); sum += c; cnt += (c > 0u) ? 1u : 0u; mine = (j == x) ? c : mine; }
        if (sum == G) break;
        __builtin_amdgcn_s_sleep(1);
        if ((++sp & 255u) == 0u) { if (xb_ld(&bar[XB_TMO])) break; if (sp > XB_SPIN_CAP) { atomicAdd(&bar[XB_TMO], 1u); break; } }
    }
    nloc = mine > 0u ? mine : 1u; nx = cnt > 0u ? cnt : 1u;
}
__device__ __forceinline__ void xcd_barrier(const XcdBarrier& b) {
    asm volatile("s_waitcnt vmcnt(0)" ::: "memory");
    __syncthreads();
    if (threadIdx.x == 0) {
        unsigned* bar = b.bar;
        __builtin_amdgcn_s_waitcnt(0);
        unsigned nloc = b.st[0], nx = b.st[1];
        if (nloc == 0u) { xcd_barrier_complete(bar, b.x, nloc, nx); b.st[0] = nloc; b.st[1] = nx; }
        const unsigned old = xb_add(&bar[XB_XSUB(b.x)], 1u);
        const unsigned gen = old / nloc;
        if (old + 1u == (gen + 1u) * nloc) {
            __builtin_amdgcn_fence(__ATOMIC_RELEASE, "agent");
            asm volatile("s_waitcnt vmcnt(0)" ::: "memory");
            const unsigned og = xb_add(&bar[XB_TOP], 1u);
            const unsigned tg = og / nx;
            if (og + 1u == (tg + 1u) * nx) xb_add(&bar[XB_TOPGEN], 1u);
            else XB_SPIN(xb_ld(&bar[XB_TOPGEN]) == tg, bar);
            __builtin_amdgcn_fence(__ATOMIC_ACQUIRE, "agent");
            xb_add(&bar[XB_XGEN(b.x)], 1u);
            asm volatile("s_waitcnt vmcnt(0)" ::: "memory");
        } else {
            XB_SPIN(xb_ld(&bar[XB_XGEN(b.x)]) == gen, bar);
            __builtin_amdgcn_fence(__ATOMIC_ACQUIRE, "agent");
            asm volatile("s_waitcnt vmcnt(0)" ::: "memory");
        }
    }
    __syncthreads();
}

__device__ __forceinline__ int tidf() { int t = threadIdx.x; asm volatile("" : "+v"(t)); return t; }
__device__ __forceinline__ float wsum(float v) {
#pragma unroll
    for (int o = 1; o < 64; o <<= 1) v += __shfl_xor(v, o);
    return v;
}
__device__ __forceinline__ float sigmoidf_(float x) { return 1.f / (1.f + expf(-x)); }
__device__ __forceinline__ float fsigmoid(float x) { return __builtin_amdgcn_rcpf(1.f + __expf(-x)); }

__device__ __forceinline__ void ph_ln(const float* a, const float* b, const float* g, const float* beta, float* y, float scale) {
    const int lane = tidf() & 63, gw = blockIdx.x * NW + (tidf() >> 6), ngw = gridDim.x * NW;
    for (int row = gw; row < T; row += ngw) {
        float v[16]; float s = 0.f;
#pragma unroll
        for (int j = 0; j < 16; ++j) { const int c = lane + 64 * j; float x = a[(size_t)row * D + c] * scale; if (b) x += b[(size_t)row * D + c]; v[j] = x; s += x; }
        const float mu = wsum(s) * (1.f / D); float q = 0.f;
#pragma unroll
        for (int j = 0; j < 16; ++j) { const float d = v[j] - mu; q += d * d; }
        const float rstd = rsqrtf(wsum(q) * (1.f / D) + LN_EPS);
#pragma unroll
        for (int j = 0; j < 16; ++j) { const int c = lane + 64 * j; y[(size_t)row * D + c] = (v[j] - mu) * rstd * g[c] + beta[c]; }
    }
}
struct EpiPlain { static constexpr bool PAIR = false; float* C; int ldc; float scale;
    __device__ void operator()(int m, int n, float v, int z) const { C[(size_t)m * ldc + n] = v * scale; } };
struct EpiPoolMix { static constexpr bool PAIR = false; float* C; const float* b; const float* ls;
    __device__ void operator()(int m, int n, float v, int z) const { const int c = z * 128 + n; C[(size_t)m * 512 + c] = (v + b[c]) * ls[c]; } };
struct EpiHead { static constexpr bool PAIR = false; float* C; float scale;
    __device__ void operator()(int m, int n, float v, int z) const { C[(size_t)m * 1024 + z * 256 + n] = v * scale; } };
struct EpiE1 { static constexpr bool PAIR = true; float* act; const float* b1;
    __device__ void pair(int m, int n, float vg, float vl, int z) const {
        float g = vg + b1[z * 2048 + n], l = vl + b1[z * 2048 + n + 1];
        g = fminf(g, 7.f); l = fminf(fmaxf(l, -7.f), 7.f);
        act[(size_t)m * 1024 + (n >> 1)] = g * sigmoidf_(1.702f * g) * (l + 1.f); } };
struct EpiE2 { static constexpr bool PAIR = false; float* Y; const float* b2;
    __device__ void operator()(int m, int n, float v, int z) const { Y[(size_t)m * 1024 + n] = v + b2[z * 1024 + n]; } };

template <class Epi>
__device__ __forceinline__ void ph_gemm(LAS float* lds, const float* A, const int* rowidx, const float* B, const int* mcount, const int* mstart,
                                        size_t strideA, size_t strideB, const Epi& epi, int lda, int ldb, int M, int N, int K, int nz, int vb0, int nvb) {
    LAS float* As = lds;
    LAS float* Bs = lds + 16 * 129;
    const int tid = tidf(), tx = tid & 15, ty = tid >> 4;
    const int ntn = (N + 63) / 64, ntm = (M + 127) / 128, per_z = ntn * ntm, total = per_z * nz;
    for (int vt = vb0; vt < total; vt += nvb) {
        const int z = vt / per_z, r = vt % per_z, bm = (r / ntn) * 128, bn = (r % ntn) * 64;
        int Mz = M, m0g = 0;
        if (mcount) { Mz = mcount[z]; m0g = mstart[z]; }
        if (bm >= Mz) continue;
        const float* Az = A + z * strideA; const float* Bz = B + z * strideB;
        float acc[4][4] = {};
        const int ar = tid >> 2, ak = (tid & 3) * 4;
        const int arow = bm + ar; const bool aval = arow < Mz; int asrc = 0;
        if (aval) { const int gr = m0g + arow; asrc = rowidx ? rowidx[gr] : gr; }
        const int bk = tid >> 5, bn2 = (tid & 31) * 2;
        for (int k0 = 0; k0 < K; k0 += 16) {
            float4 av = make_float4(0.f, 0.f, 0.f, 0.f);
            if (aval) av = *(const float4*)(Az + (size_t)asrc * lda + k0 + ak);
            As[(ak + 0) * 129 + ar] = av.x; As[(ak + 1) * 129 + ar] = av.y; As[(ak + 2) * 129 + ar] = av.z; As[(ak + 3) * 129 + ar] = av.w;
#pragma unroll
            for (int j = 0; j < 2; ++j) { const int n = bn + bn2 + j; Bs[bk * 65 + bn2 + j] = (n < N) ? Bz[(size_t)(k0 + bk) * ldb + n] : 0.f; }
            __syncthreads();
#pragma unroll
            for (int kk = 0; kk < 16; ++kk) {
                float a[4], b[4];
#pragma unroll
                for (int i = 0; i < 4; ++i) { a[i] = As[kk * 129 + ty * 4 + i]; b[i] = Bs[kk * 65 + tx * 4 + i]; }
#pragma unroll
                for (int i = 0; i < 4; ++i)
#pragma unroll
                    for (int j = 0; j < 4; ++j) acc[i][j] += a[i] * b[j];
            }
            __syncthreads();
        }
#pragma unroll
        for (int i = 0; i < 4; ++i) { const int m = bm + ty * 4 + i; if (m >= Mz) continue;
            if constexpr (Epi::PAIR) {
#pragma unroll
                for (int j = 0; j < 4; j += 2) { const int n = bn + tx * 4 + j; if (n < N) epi.pair(m0g + m, n, acc[i][j], acc[i][j + 1], z); }
            } else {
#pragma unroll
                for (int j = 0; j < 4; ++j) { const int n = bn + tx * 4 + j; if (n < N) epi(m0g + m, n, acc[i][j], z); }
            } }
    }
}
__device__ __forceinline__ void ph_pool_conv(const float* proj, const float* cw, const float* cb, float* pooled, float* uc) {
    const size_t gt = (size_t)blockIdx.x * NT + tidf(), ngt = (size_t)gridDim.x * NT;
    for (size_t i = gt; i < (size_t)T * 512; i += ngt) {
        const int c = (int)(i % 512); const int tg = (int)(i / 512); const int t = tg % SEQ;
        const int w = 2 << (c >> 7);
        const int cnt = (t + 1 < w) ? t + 1 : w; float s = 0.f;
        for (int j = 0; j < cnt; ++j) s += proj[(size_t)(tg - j) * INC + C_P + c];
        pooled[i] = s / (float)cnt - proj[(size_t)tg * INC + C_P + c];
    }
    for (size_t i = gt; i < (size_t)T * 1024; i += ngt) {
        const int c = (int)(i % 1024); const int tg = (int)(i / 1024); const int t = tg % SEQ;
        float y = cb[c];
#pragma unroll
        for (int j = 0; j < 4; ++j) { const int tt = t - 3 + j; if (tt >= 0) y += proj[(size_t)(tg - 3 + j) * INC + C_U + c] * cw[j * 1024 + c]; }
        uc[i] = y * sigmoidf_(y);
    }
}
constexpr int MB = 16;
__device__ __forceinline__ void ph_mlstm(LAS float* lds, int vb, const float* q, const float* k, const float* vv, const float* gif, float* hm) {
    const int bh = vb >> 1, b = bh >> 2, h = bh & 3;
    const int tid = tidf(), e = (vb & 1) * 128 + (tid >> 2), dq = tid & 3;
    LAS float* sq = lds; LAS float* sk = lds + MB * 256; LAS float* sv = lds + 2 * MB * 256; LAS float* si = lds + 3 * MB * 256; LAS float* sf = si + MB;
    float C[64]; float n[16];
#pragma unroll
    for (int j = 0; j < 64; ++j) C[j] = 0.f;
#pragma unroll
    for (int j = 0; j < 16; ++j) n[j] = 0.f;
    float m = 0.f;
    const int nsub = (e & 3) * 16;
    for (int t0 = 0; t0 < SEQ; t0 += MB) {
        __syncthreads();
        for (int i = tid; i < MB * 256; i += NT) { const int tt = i >> 8, d = i & 255; const size_t tg = (size_t)b * SEQ + t0 + tt;
            sq[tt * 256 + d] = q[tg * 1024 + h * 256 + d]; sk[tt * 256 + d] = k[tg * 1024 + h * 256 + d]; sv[tt * 256 + d] = vv[tg * 1024 + h * 256 + d]; }
        if (tid < MB) { const size_t tg = (size_t)b * SEQ + t0 + tid; si[tid] = gif[tg * 8 + h]; sf[tid] = gif[tg * 8 + 4 + h]; }
        __syncthreads();
        for (int tt = 0; tt < MB; ++tt) {
            const float ip = si[tt], fp = sf[tt];
            const float lf = fminf(fp, 0.f) - log1pf(expf(-fabsf(fp)));
            const float mn = fmaxf(lf + m, ip);
            const float fd = expf(lf + m - mn), iw = expf(ip - mn);
            m = mn;
            const float ve = sv[tt * 256 + e] * iw;
            float num = 0.f, den = 0.f;
#pragma unroll
            for (int j = 0; j < 64; ++j) { const float kk = sk[tt * 256 + dq * 64 + j]; C[j] = fd * C[j] + ve * kk; num += C[j] * sq[tt * 256 + dq * 64 + j]; }
#pragma unroll
            for (int j = 0; j < 16; ++j) { const int d = dq * 64 + nsub + j; n[j] = fd * n[j] + iw * sk[tt * 256 + d]; den += n[j] * sq[tt * 256 + d]; }
            num += __shfl_xor(num, 1); num += __shfl_xor(num, 2);
            den += __shfl_xor(den, 1); den += __shfl_xor(den, 2); den += __shfl_xor(den, 4); den += __shfl_xor(den, 8);
            if (dq == 0) { const float dn = fmaxf(fabsf(den), expf(-mn)); hm[((size_t)b * SEQ + t0 + tt) * 1024 + h * 256 + e] = num / dn; }
        }
    }
    __syncthreads();
}
__device__ __forceinline__ void ph_hnorm(float* hm, const float* opre, const float* gain) {
    const int lane = tidf() & 63, gw = blockIdx.x * NW + (tidf() >> 6), ngw = gridDim.x * NW;
    for (int w = gw; w < T * 4; w += ngw) {
        const int tg = w >> 2, h = w & 3;
        float v[4]; float s = 0.f;
#pragma unroll
        for (int j = 0; j < 4; ++j) { v[j] = hm[(size_t)tg * 1024 + h * 256 + lane + 64 * j]; s += v[j]; }
        const float mu = wsum(s) * (1.f / 256); float qq = 0.f;
#pragma unroll
        for (int j = 0; j < 4; ++j) { const float d = v[j] - mu; qq += d * d; }
        const float rstd = rsqrtf(wsum(qq) * (1.f / 256) + LN_EPS);
#pragma unroll
        for (int j = 0; j < 4; ++j) { const int c = h * 256 + lane + 64 * j; hm[(size_t)tg * 1024 + c] = (v[j] - mu) * rstd * gain[c] * sigmoidf_(opre[(size_t)tg * 1024 + c]); }
    }
}
__device__ __forceinline__ void ph_merge(const float* gates, const float* ypool, float* ymls) {
    const size_t gt = (size_t)blockIdx.x * NT + tidf(), ngt = (size_t)gridDim.x * NT;
    for (size_t i = gt; i < (size_t)T * 1024; i += ngt) {
        const int c = (int)(i % 1024); const size_t tg = i / 1024;
        const float g0 = sigmoidf_(gates[tg * 2048 + c]), g1 = sigmoidf_(gates[tg * 2048 + 1024 + c]);
        ymls[i] = g0 * ypool[i] + g1 * ymls[i];
    }
}
__device__ __forceinline__ void ph_router(const float* h1, const float* wr, const float* br, int* top_idx, float* top_gate, int* cnt) {
    const int lane = tidf() & 63, gw = blockIdx.x * NW + (tidf() >> 6), ngw = gridDim.x * NW;
    for (int tg = gw; tg < T; tg += ngw) {
        const int e = lane & 31, half = lane >> 5;
        float s = 0.f;
        for (int kk = 0; kk < 512; ++kk) { const int kx = half * 512 + kk; s += h1[(size_t)tg * D + kx] * wr[kx * NE + e]; }
        s += __shfl_xor(s, 32); s += br[e];
        float val = s; int idxs[4]; float vals[4];
#pragma unroll
        for (int r = 0; r < 4; ++r) {
            float bv = val; int bi = e;
#pragma unroll
            for (int o = 1; o < 32; o <<= 1) { const float ov = __shfl_xor(bv, o); const int oi = __shfl_xor(bi, o); if (ov > bv || (ov == bv && oi < bi)) { bv = ov; bi = oi; } }
            idxs[r] = bi; vals[r] = bv; if (e == bi) val = -INFINITY;
        }
        const float mx = vals[0]; float ex[4], se = 0.f;
#pragma unroll
        for (int r = 0; r < 4; ++r) { ex[r] = expf(vals[r] - mx); se += ex[r]; }
#pragma unroll
        for (int r = 0; r < 4; ++r) if (lane == r) { top_idx[tg * 4 + r] = idxs[r]; top_gate[tg * 4 + r] = ex[r] / se; atomicAdd(&cnt[idxs[r]], 1); }
    }
}
__device__ __forceinline__ void ph_place(const int* top_idx, const int* start, int* fill, int* row_tok, int* row_of) {
    const int gt = blockIdx.x * NT + tidf(), ngt = gridDim.x * NT;
    for (int i = gt; i < NA; i += ngt) { const int e = top_idx[i]; const int r = atomicAdd(&fill[e], 1); const int dest = start[e] + r; row_tok[dest] = i >> 2; row_of[i] = dest; }
}
__device__ __forceinline__ void ph_final(const float* h1, const float* Y, const int* row_of, const float* gate, const float* g, const float* beta, float* out) {
    const int lane = tidf() & 63, gw = blockIdx.x * NW + (tidf() >> 6), ngw = gridDim.x * NW;
    for (int tg = gw; tg < T; tg += ngw) {
        int ro[4]; float gt[4];
#pragma unroll
        for (int r = 0; r < 4; ++r) { ro[r] = row_of[tg * 4 + r]; gt[r] = gate[tg * 4 + r]; }
        float v[16]; float s = 0.f;
#pragma unroll
        for (int j = 0; j < 16; ++j) { const int c = lane + 64 * j; float x = ALPHA * h1[(size_t)tg * D + c];
#pragma unroll
            for (int r = 0; r < 4; ++r) x += gt[r] * Y[(size_t)ro[r] * 1024 + c];
            v[j] = x; s += x; }
        const float mu = wsum(s) * (1.f / D); float qq = 0.f;
#pragma unroll
        for (int j = 0; j < 16; ++j) { const float d = v[j] - mu; qq += d * d; }
        const float rstd = rsqrtf(wsum(qq) * (1.f / D) + LN_EPS);
#pragma unroll
        for (int j = 0; j < 16; ++j) { const int c = lane + 64 * j; out[(size_t)tg * D + c] = (v[j] - mu) * rstd * g[c] + beta[c]; }
    }
}


namespace pg {
typedef unsigned short bf16_t;
typedef short bf16x8 __attribute__((ext_vector_type(8)));
typedef float f32x4 __attribute__((ext_vector_type(4)));
typedef float f32x2 __attribute__((ext_vector_type(2)));
typedef unsigned u32x4 __attribute__((ext_vector_type(4)));
typedef unsigned u32x2 __attribute__((ext_vector_type(2)));
constexpr int BM = 256, BK = 64, HALF = 128, HTB = HALF * BK * 2, STAGE_BYTES = 8 * HTB, NXCD = 8, WGM = 8;
__host__ __device__ __forceinline__ int lds_byte(int r, int c) { const int st = (r >> 4) * 2 + (c >> 5), rr = r & 15, cc = c & 31, ob = rr * 64 + cc * 2; return st * 1024 + (ob ^ (((ob >> 9) & 1) << 5)); }
__host__ __device__ __forceinline__ void stage_rc(int b, int& R, int& C) { const int st = b / 1024, sb = b % 1024, swz = sb ^ (((sb >> 9) & 1) << 5); R = (st >> 1) * 16 + swz / 64; C = (st & 1) * 32 + (swz % 64) / 2; }
__host__ __device__ __forceinline__ int perm32(int rho) { const int n = rho >> 4, i = rho & 15; return 8 * (i >> 2) + 4 * n + (i & 3); }
__device__ __forceinline__ unsigned cvt_pk_bf16(float lo, float hi) { unsigned r; asm volatile("v_cvt_pk_bf16_f32 %0, %1, %2" : "=v"(r) : "v"(lo), "v"(hi)); return r; }

struct Unit { const char* A; const char* B; const int* rows; int nvalid; int pm, pn, g, aux; };

struct TileOrder {
    int nM, nN, per_g, nwg, G, c;
    __device__ __forceinline__ void init(int nM_, int nN_, int ng, int G_, int c_) { nM = nM_; nN = nN_; per_g = nM * nN; nwg = per_g * ng; G = G_; c = c_; }
    __device__ __forceinline__ bool tile(int i, int& g, int& pm, int& pn) const {
        const long L = (long)i * G + c; if (L >= nwg) return false;
        int wgid = (int)L; { const int q = nwg / NXCD, r = nwg % NXCD, xcd = wgid % NXCD, off = wgid / NXCD; wgid = (xcd < r ? xcd * (q + 1) : r * (q + 1) + (xcd - r) * q) + off; }
        g = wgid / per_g; wgid -= g * per_g;
        const int nig = WGM * nN, gid = wgid / nig, fm = gid * WGM, gsz = (nM - fm) < WGM ? (nM - fm) : WGM;
        pm = fm + ((wgid % nig) % gsz); pn = (wgid % nig) / gsz; return true;
    }
};

typedef int i32x8 __attribute__((ext_vector_type(8)));
typedef int i32x4 __attribute__((ext_vector_type(4)));
template <class Epi, class Sched, bool GATHER = false, bool FP8 = false>
__device__ __forceinline__ void gemm_phase(LAS unsigned char* lds, const int lda, const int ldb, const int K, const Sched& S, const Epi& E) {
    const int tid = tidf(), wid = __builtin_amdgcn_readfirstlane(tid >> 6), lane = tid & 63, wr = wid >> 2, wc = wid & 3, fr = lane & 15, fq = lane >> 4;
    const int nt = K / BK;
    unsigned voffA[2], voffB[2];
#pragma unroll
    for (int i = 0; i < 2; ++i) { int R, C; stage_rc(tid * 16 + i * 8192, R, C); const int Rb = Epi::PERM ? ((R & ~31) + perm32(R & 31)) : R;
        voffA[i] = (unsigned)(R * lda + C) * 2u; voffB[i] = (unsigned)(Rb * ldb + C) * 2u; }
    const size_t kstep = (size_t)(BK * 2);
    const size_t hstepA = GATHER ? 0 : (size_t)HALF * lda * 2, hstepB = (size_t)HALF * ldb * 2;
    const unsigned ldsw = (unsigned)wid * 1024u;
    const int aoff = lds_byte(wr * 64 + fr, fq * 8), boff = lds_byte(wc * 32 + fr, fq * 8);
#define PG_SA(b, h) (((b) * 2 + (h)) * HTB)
#define PG_SB(b, h) ((4 + (b) * 2 + (h)) * HTB)
#define PG_STAGE(bufoff, gbase, voff) do { _Pragma("unroll") for (int _i = 0; _i < 2; ++_i) \
        __builtin_amdgcn_global_load_lds((const unsigned*)((const char*)(gbase) + (voff)[_i]), (LAS unsigned*)(lds + (bufoff) + ldsw + _i * 8192), 16, 0, 0); } while (0)
#define PG_LDA(dst, b, h) do { _Pragma("unroll") for (int m = 0; m < 4; ++m) { if constexpr (FP8) { \
        const i32x4 _lo = *(const LAS i32x4*)(lds + PG_SA(b, h) + aoff + m * 2048), _hi = *(const LAS i32x4*)(lds + PG_SA(b, h) + aoff + m * 2048 + 1024); \
        dst##8[m] = __builtin_shufflevector(_lo, _hi, 0, 1, 2, 3, 4, 5, 6, 7); } \
        else { _Pragma("unroll") for (int k = 0; k < 2; ++k) dst[m][k] = *(const LAS bf16x8*)(lds + PG_SA(b, h) + aoff + m * 2048 + k * 1024); } } } while (0)
#define PG_LDB(dst, b, h) do { _Pragma("unroll") for (int n = 0; n < 2; ++n) { if constexpr (FP8) { \
        const i32x4 _lo = *(const LAS i32x4*)(lds + PG_SB(b, h) + boff + n * 2048), _hi = *(const LAS i32x4*)(lds + PG_SB(b, h) + boff + n * 2048 + 1024); \
        dst##8[n] = __builtin_shufflevector(_lo, _hi, 0, 1, 2, 3, 4, 5, 6, 7); } \
        else { _Pragma("unroll") for (int k = 0; k < 2; ++k) dst[n][k] = *(const LAS bf16x8*)(lds + PG_SB(b, h) + boff + n * 2048 + k * 1024); } } } while (0)
#define PG_MMA(ai, bj, At, Bt) do { __builtin_amdgcn_s_setprio(1); _Pragma("unroll") for (int m = 0; m < 4; ++m) _Pragma("unroll") for (int n = 0; n < 2; ++n) { \
        if constexpr (FP8) asm volatile("v_mfma_scale_f32_16x16x128_f8f6f4 %0, %1, %2, %0, %3, %4 op_sel_hi:[0,0,0]" : "+v"(acc[ai][bj][m][n]) : "v"(Bt##8[n]), "v"(At##8[m]), "v"(sc_w), "v"(sc_a)); \
        else { _Pragma("unroll") for (int k = 0; k < 2; ++k) acc[ai][bj][m][n] = __builtin_amdgcn_mfma_f32_16x16x32_bf16(Bt[n][k], At[m][k], acc[ai][bj][m][n], 0, 0, 0); } } \
        __builtin_amdgcn_s_setprio(0); } while (0)
#define PG_WAIT_V(n) asm volatile("s_waitcnt vmcnt(" #n ")" ::: "memory")
#define PG_WAIT_L(n) asm volatile("s_waitcnt lgkmcnt(" #n ")" ::: "memory")
#define PG_BAR __builtin_amdgcn_s_barrier()
#define PG_SCHED __builtin_amdgcn_sched_barrier(0)
    Unit cur, nxt; int ui = 0;
    if (!S.next(0, cur)) return;
    f32x4 acc[2][2][4][2];
    f32x4 bini[2][2];
#pragma unroll
    for (int b = 0; b < 2; ++b)
#pragma unroll
        for (int n = 0; n < 2; ++n) bini[b][n] = (f32x4){0.f, 0.f, 0.f, 0.f};
    if constexpr (Epi::BIAS) { const float* bp = E.bias_base(cur) + wc * 32 + (Epi::PERM ? 8 * fq : 4 * fq);
#pragma unroll
        for (int b = 0; b < 2; ++b)
#pragma unroll
            for (int n = 0; n < 2; ++n) bini[b][n] = *(const f32x4*)(bp + b * HALF + (Epi::PERM ? 4 * n : 16 * n)); }
#pragma unroll
    for (int a = 0; a < 2; ++a)
#pragma unroll
        for (int b = 0; b < 2; ++b)
#pragma unroll
            for (int m = 0; m < 4; ++m)
#pragma unroll
                for (int n = 0; n < 2; ++n) acc[a][b][m][n] = bini[b][n];
    bf16x8 At[4][2], B0[2][2], B1[2][2]; i32x8 At8[4], B08[2], B18[2]; const int sc_w = 0x79797979, sc_a = 0x7f7f7f7f;
    unsigned gA0[2], gA1[2], nA0[2], nA1[2];
    auto gather_offs = [&](const Unit& u, unsigned (&o0)[2], unsigned (&o1)[2]) {
#pragma unroll
        for (int i = 0; i < 2; ++i) { int R_, C_; stage_rc(tid * 16 + i * 8192, R_, C_);
            const int r0 = R_, r1 = HALF + R_;
            const int t0 = (r0 < u.nvalid) ? u.rows[r0] : 0, t1 = (r1 < u.nvalid) ? u.rows[r1] : 0;
            o0[i] = (unsigned)(t0 * lda + C_) * 2u; o1[i] = (unsigned)(t1 * lda + C_) * 2u; }
    };
    if constexpr (GATHER) { gather_offs(cur, gA0, gA1); } else {
#pragma unroll
        for (int i = 0; i < 2; ++i) { gA0[i] = voffA[i]; gA1[i] = voffA[i]; nA0[i] = voffA[i]; nA1[i] = voffA[i]; } }
    const char* cA = cur.A; const char* cB = cur.B;
    PG_STAGE(PG_SB(0, 0), cB, voffB); PG_STAGE(PG_SB(0, 1), cB + hstepB, voffB); PG_STAGE(PG_SA(0, 0), cA, gA0); PG_STAGE(PG_SA(0, 1), cA + hstepA, gA1);
    if (wr == 1) PG_BAR;
    PG_WAIT_V(2); PG_BAR;
    PG_STAGE(PG_SB(1, 0), cB + kstep, voffB); PG_STAGE(PG_SA(1, 0), cA + kstep, gA0); PG_STAGE(PG_SB(1, 1), cB + hstepB + kstep, voffB);
    PG_WAIT_V(6); PG_BAR;
    for (;;) {
        const bool has_next = S.next(ui + 1, nxt);
        const char* nA = has_next ? nxt.A : cA; const char* nB = has_next ? nxt.B : cB;
        if constexpr (GATHER) { if (has_next) gather_offs(nxt, nA0, nA1); else {
#pragma unroll
            for (int i = 0; i < 2; ++i) { nA0[i] = gA0[i]; nA1[i] = gA1[i]; } } }
#pragma unroll 1
        for (int t = 0; t < nt; t += 2) {
            const bool last = (t == nt - 2);
            const char* a1 = cA + (size_t)(t + 1) * kstep;
            const char* a2 = last ? nA : cA + (size_t)(t + 2) * kstep; const char* b2 = last ? nB : cB + (size_t)(t + 2) * kstep;
            const char* a3 = a2 + kstep; const char* b3 = b2 + kstep;
            unsigned x0[2], x1[2];
#pragma unroll
            for (int i = 0; i < 2; ++i) { x0[i] = (GATHER && last) ? nA0[i] : gA0[i]; x1[i] = (GATHER && last) ? nA1[i] : gA1[i]; }
            PG_LDB(B0, 0, 0); PG_LDB(B1, 0, 1); PG_SCHED; PG_LDA(At, 0, 0); PG_STAGE(PG_SA(1, 1), a1 + hstepA, gA1);
            PG_WAIT_V(8); PG_WAIT_L(0); PG_BAR; PG_MMA(0, 0, At, B0); PG_MMA(0, 1, At, B1); PG_BAR; PG_SCHED;
            PG_LDA(At, 0, 1); PG_STAGE(PG_SB(0, 0), b2, voffB); PG_STAGE(PG_SB(0, 1), b2 + hstepB, voffB); PG_STAGE(PG_SA(0, 0), a2, x0);
            PG_WAIT_V(8); PG_WAIT_L(0); PG_BAR; PG_MMA(1, 0, At, B0); PG_MMA(1, 1, At, B1); PG_BAR; PG_SCHED;
            PG_LDB(B0, 1, 0); PG_LDB(B1, 1, 1); PG_SCHED; PG_LDA(At, 1, 0); PG_STAGE(PG_SA(0, 1), a2 + hstepA, x1);
            PG_WAIT_V(8); PG_WAIT_L(0); PG_BAR; PG_MMA(0, 0, At, B0); PG_MMA(0, 1, At, B1); PG_BAR; PG_SCHED;
            PG_LDA(At, 1, 1); PG_STAGE(PG_SB(1, 0), b3, voffB); PG_STAGE(PG_SB(1, 1), b3 + hstepB, voffB); PG_STAGE(PG_SA(1, 0), a3, x0);
            PG_WAIT_V(8); PG_WAIT_L(0); PG_BAR; PG_MMA(1, 0, At, B0); PG_MMA(1, 1, At, B1); PG_BAR; PG_SCHED;
        }
        if (wr == 0) PG_BAR;
        if constexpr (FP8) asm volatile("s_nop 15\n\ts_nop 15" ::: "memory");
        if constexpr (Epi::BIAS && !GATHER) { if (has_next) { const float* bp = E.bias_base(nxt) + wc * 32 + (Epi::PERM ? 8 * fq : 4 * fq);
#pragma unroll
            for (int b = 0; b < 2; ++b)
#pragma unroll
                for (int n = 0; n < 2; ++n) bini[b][n] = *(const f32x4*)(bp + b * HALF + (Epi::PERM ? 4 * n : 16 * n)); } }
        if constexpr (!Epi::AFTER_DRAIN) { E(acc, cur, wr, wc, fr, fq); }
        if (!has_next) break;
        if constexpr (Epi::BIAS && GATHER) { const float* bp = E.bias_base(nxt) + wc * 32 + (Epi::PERM ? 8 * fq : 4 * fq);
#pragma unroll
            for (int b = 0; b < 2; ++b)
#pragma unroll
                for (int n = 0; n < 2; ++n) bini[b][n] = *(const f32x4*)(bp + b * HALF + (Epi::PERM ? 4 * n : 16 * n)); }
#pragma unroll
        for (int a = 0; a < 2; ++a)
#pragma unroll
            for (int b = 0; b < 2; ++b)
#pragma unroll
                for (int m = 0; m < 4; ++m)
#pragma unroll
                    for (int n = 0; n < 2; ++n) acc[a][b][m][n] = bini[b][n];
        cur = nxt; cA = nA; cB = nB; ++ui;
        if constexpr (GATHER) {
#pragma unroll
            for (int i = 0; i < 2; ++i) { gA0[i] = nA0[i]; gA1[i] = nA1[i]; } }
        if (wr == 1) PG_BAR;
    }
    PG_WAIT_V(0);
    PG_BAR;
    if constexpr (Epi::AFTER_DRAIN) { E.fused(acc, cur, wr, wc, fr, fq, lds, wid, lane); }
#undef PG_SA
#undef PG_SB
#undef PG_STAGE
#undef PG_LDA
#undef PG_LDB
#undef PG_MMA
#undef PG_WAIT_V
#undef PG_WAIT_L
#undef PG_BAR
#undef PG_SCHED
}

struct EpiStoreBf16 {
    static constexpr bool PERM = true, AFTER_DRAIN = false, BIAS = false;
    bf16_t* O; int ldc; float scale; int gcol;
    __device__ __forceinline__ void operator()(const f32x4 (&acc)[2][2][4][2], const Unit& u, int wr, int wc, int fr, int fq) const {
        bf16_t* base = O + (size_t)(u.pm * BM + wr * 64 + fr) * ldc + u.g * gcol + u.pn * BM + wc * 32 + 8 * fq;
#pragma unroll
        for (int ai = 0; ai < 2; ++ai)
#pragma unroll
            for (int m = 0; m < 4; ++m) { bf16_t* rowp = base + (size_t)(ai * HALF + m * 16) * ldc;
#pragma unroll
                for (int bj = 0; bj < 2; ++bj) { const f32x4 v0 = acc[ai][bj][m][0] * scale, v1 = acc[ai][bj][m][1] * scale;
                    u32x4 w; w.x = cvt_pk_bf16(v0[0], v0[1]); w.y = cvt_pk_bf16(v0[2], v0[3]); w.z = cvt_pk_bf16(v1[0], v1[1]); w.w = cvt_pk_bf16(v1[2], v1[3]);
                    *(u32x4*)(rowp + bj * HALF) = w; } }
    }
};
}

constexpr int PROJW = 4608;
constexpr int PJ_P = 0, PJ_U = 512, PJ_O = 1536, PJ_G = 2560;
constexpr int PROJLD = 1536;
constexpr int WIN_ROWS = 5632;

__device__ __forceinline__ unsigned f2bf(float f) { unsigned u = __builtin_bit_cast(unsigned, f); return (u + 0x7fffu + ((u >> 16) & 1u)) >> 16; }
__device__ __forceinline__ unsigned pk2(float lo, float hi) { return f2bf(lo) | (f2bf(hi) << 16); }
__device__ __forceinline__ float bf2f(unsigned short b) { return __builtin_bit_cast(float, (unsigned)b << 16); }

struct TItem { const float* src; pg::bf16_t* dst; int ldw, ldt, inter, valid, fp8; };
__device__ __forceinline__ void titem_load(const TItem& it, pg::f32x4 (&r)[16], int lane) {
    const float* src = it.src + (size_t)(4 * (lane >> 4)) * it.ldw + 4 * (lane & 15);
#pragma unroll
    for (int i = 0; i < 4; ++i)
#pragma unroll
        for (int kk = 0; kk < 4; ++kk) r[4 * i + kk] = *(const pg::f32x4*)(src + (size_t)(16 * i + kk) * it.ldw);
}
__device__ __forceinline__ void titem_store(const TItem& it, const pg::f32x4 (&r)[16], LAS float* scr, int lane) {
    const int ka = lane >> 4, nb = lane & 15, sw = nb & 7;
#pragma unroll
    for (int i = 0; i < 4; ++i) { const int a = ka + 4 * i;
        LAS float* d = scr + (4 * nb) * 64 + 4 * (a ^ sw);
        *(LAS pg::f32x4*)(d)       = (pg::f32x4){r[4 * i].x, r[4 * i + 1].x, r[4 * i + 2].x, r[4 * i + 3].x};
        *(LAS pg::f32x4*)(d + 64)  = (pg::f32x4){r[4 * i].y, r[4 * i + 1].y, r[4 * i + 2].y, r[4 * i + 3].y};
        *(LAS pg::f32x4*)(d + 128) = (pg::f32x4){r[4 * i].z, r[4 * i + 1].z, r[4 * i + 2].z, r[4 * i + 3].z};
        *(LAS pg::f32x4*)(d + 192) = (pg::f32x4){r[4 * i].w, r[4 * i + 1].w, r[4 * i + 2].w, r[4 * i + 3].w}; }
    asm volatile("s_waitcnt lgkmcnt(0)" ::: "memory");
#pragma unroll
    for (int itr = 0; itr < 8; ++itr) { const int nl = (lane >> 3) + 8 * itr, kg = lane & 7, sn = (nl >> 2) & 7;
        const pg::f32x4 p0 = *(const LAS pg::f32x4*)(scr + nl * 64 + 4 * ((2 * kg) ^ sn)), p1 = *(const LAS pg::f32x4*)(scr + nl * 64 + 4 * ((2 * kg + 1) ^ sn));
        const size_t drow = it.inter ? (size_t)(nl & 1) * 128 + (nl >> 1) : (size_t)nl;
        if (it.fp8) { int w0 = __builtin_amdgcn_cvt_pk_fp8_f32(p0.x * 64.f, p0.y * 64.f, 0, false); w0 = __builtin_amdgcn_cvt_pk_fp8_f32(p0.z * 64.f, p0.w * 64.f, w0, true);
            int w1 = __builtin_amdgcn_cvt_pk_fp8_f32(p1.x * 64.f, p1.y * 64.f, 0, false); w1 = __builtin_amdgcn_cvt_pk_fp8_f32(p1.z * 64.f, p1.w * 64.f, w1, true);
            *(pg::u32x2*)((unsigned char*)it.dst + drow * it.ldt + 8 * kg) = (pg::u32x2){(unsigned)w0, (unsigned)w1}; }
        else { pg::u32x4 o; o.x = pk2(p0.x, p0.y); o.y = pk2(p0.z, p0.w); o.z = pk2(p1.x, p1.y); o.w = pk2(p1.z, p1.w);
            *(pg::u32x4*)(it.dst + drow * it.ldt + 8 * kg) = o; } }
    asm volatile("s_waitcnt lgkmcnt(0)" ::: "memory");
}
__device__ __forceinline__ int win_src_col(int r) { return r < 1536 ? r : (r < 2560 ? r + 1024 : (r < 4608 ? r - 2560 + C_G : r - 4608 + C_V)); }

struct OptBufs {
    pg::bf16_t *WinT, *H0B, *PROJ, *BT2; unsigned char *WinQ, *H0Q, *OGQ;
    float *gif, *stats;
};
__device__ __forceinline__ void ph_ln0(LAS unsigned char* lds, const OptBufs& o, const float* x, const float* g, const float* beta, const float* w_in, const float* b_if) {
    const int tid = tidf(), lane = tid & 63, wave = tid >> 6, gw = blockIdx.x * NW + wave, ngw = gridDim.x * NW;
    LAS float* wif = (LAS float*)lds;
    __syncthreads();
    for (int i = tid; i < 1024 * 8; i += NT) wif[(i & 7) * 1024 + (i >> 3)] = w_in[(size_t)(i >> 3) * INC + C_IF + (i & 7)];
    __syncthreads();
    pg::f32x4 v[4];
    if (gw < T) {
#pragma unroll
        for (int j = 0; j < 4; ++j) v[j] = ((const pg::f32x4*)(x + (size_t)gw * D) + lane)[64 * j]; }
    for (int row = gw; row < T; row += ngw) {
        pg::f32x4 nv[4];
        if (row + ngw < T) {
#pragma unroll
            for (int j = 0; j < 4; ++j) nv[j] = ((const pg::f32x4*)(x + (size_t)(row + ngw) * D) + lane)[64 * j]; }
        float s = 0.f;
#pragma unroll
        for (int j = 0; j < 4; ++j) s += (v[j].x + v[j].y) + (v[j].z + v[j].w);
        const float mean = wsum(s) * (1.f / D); float s2 = 0.f;
#pragma unroll
        for (int j = 0; j < 4; ++j) { v[j] = v[j] - mean; s2 += (v[j].x * v[j].x + v[j].y * v[j].y) + (v[j].z * v[j].z + v[j].w * v[j].w); }
        const float rstd = rsqrtf(wsum(s2) * (1.f / D) + LN_EPS);
        float acc8[8];
#pragma unroll
        for (int q = 0; q < 8; ++q) acc8[q] = 0.f;
        unsigned long long* o8 = (unsigned long long*)(o.H0B + (size_t)row * D) + lane;
#pragma unroll
        for (int j = 0; j < 4; ++j) {
            const int c0 = 256 * j + 4 * lane;
            const pg::f32x4 gg = *(const pg::f32x4*)(g + c0), bb = *(const pg::f32x4*)(beta + c0);
            const pg::f32x4 y = v[j] * rstd * gg + bb;
            o8[64 * j] = (unsigned long long)pk2(y.x, y.y) | ((unsigned long long)pk2(y.z, y.w) << 32);
            { int w0 = __builtin_amdgcn_cvt_pk_fp8_f32(y.x, y.y, 0, false); w0 = __builtin_amdgcn_cvt_pk_fp8_f32(y.z, y.w, w0, true); *(int*)(o.H0Q + (size_t)row * D + c0) = w0; }
#pragma unroll
            for (int q = 0; q < 8; ++q) { const pg::f32x4 w4 = *(const LAS pg::f32x4*)(wif + q * 1024 + c0); acc8[q] += (y.x * w4.x + y.y * w4.y) + (y.z * w4.z + y.w * w4.w); }
        }
        float r_;
        { float a4[4];
#pragma unroll
          for (int i = 0; i < 4; ++i) { const bool up = (lane & 32) != 0; const float keep = up ? acc8[4 + i] : acc8[i], give = up ? acc8[i] : acc8[4 + i]; a4[i] = keep + __shfl_xor(give, 32); }
          float a2[2];
#pragma unroll
          for (int i = 0; i < 2; ++i) { const bool up = (lane & 16) != 0; const float keep = up ? a4[2 + i] : a4[i], give = up ? a4[i] : a4[2 + i]; a2[i] = keep + __shfl_xor(give, 16); }
          const bool up = (lane & 8) != 0; const float keep = up ? a2[1] : a2[0], give = up ? a2[0] : a2[1];
          r_ = keep + __shfl_xor(give, 8);
          r_ += __shfl_xor(r_, 4); r_ += __shfl_xor(r_, 2); r_ += __shfl_xor(r_, 1); }
        if ((lane & 7) == 0) { const int q = lane >> 3; o.gif[(size_t)row * 8 + q] = r_ + b_if[q]; }
        if (lane == 0) { o.stats[(size_t)row * 2] = mean; o.stats[(size_t)row * 2 + 1] = rstd; }
#pragma unroll
        for (int j = 0; j < 4; ++j) v[j] = nv[j];
    }
    __syncthreads();
}
struct SchedInproj {
    pg::TileOrder o; const char* A; const char* B; size_t rowbytes;
    __device__ __forceinline__ bool next(int i, pg::Unit& u) const { int g, pm, pn; if (!o.tile(i, g, pm, pn)) return false;
        u.A = A + (size_t)pm * 256 * rowbytes; u.B = B + (size_t)pn * 256 * rowbytes; u.pm = pm; u.pn = pn; u.g = 0; u.aux = 0; u.rows = nullptr; u.nvalid = 0; return true; }
};
struct SchedVT {
    pg::TileOrder o; const char* A; const char* B;
    __device__ __forceinline__ bool next(int i, pg::Unit& u) const { int g, pm, pn; if (!o.tile(i, g, pm, pn)) return false;
        u.A = A + (size_t)pm * 256 * D * 2; u.B = B + (size_t)pn * 256 * D * 2; u.pm = pm; u.pn = pn; u.g = 0; u.aux = 0; u.rows = nullptr; u.nvalid = 0; return true; }
};
struct EpiVT {
    static constexpr bool PERM = true, AFTER_DRAIN = false, BIAS = false;
    pg::bf16_t* BT2;
    __device__ __forceinline__ void operator()(const pg::f32x4 (&acc)[2][2][4][2], const pg::Unit& u, int wr, int wc, int fr, int fq) const {
        const int h = u.pm, b = u.pn >> 4, c = u.pn & 15;
        pg::bf16_t* base = BT2 + ((size_t)((b * 4 + h) * 16 + c) * 256 + wr * 64 + fr) * 512 + wc * 32 + 8 * fq;
#pragma unroll
        for (int ai = 0; ai < 2; ++ai)
#pragma unroll
            for (int m = 0; m < 4; ++m) { pg::bf16_t* rowp = base + (size_t)(ai * 128 + m * 16) * 512;
#pragma unroll
                for (int bj = 0; bj < 2; ++bj) { const pg::f32x4 v0 = acc[ai][bj][m][0], v1 = acc[ai][bj][m][1];
                    pg::u32x4 w; w.x = pg::cvt_pk_bf16(v0[0], v0[1]); w.y = pg::cvt_pk_bf16(v0[2], v0[3]); w.z = pg::cvt_pk_bf16(v1[0], v1[1]); w.w = pg::cvt_pk_bf16(v1[2], v1[3]);
                    *(pg::u32x4*)(rowp + bj * 128) = w; } }
    }
};
struct EpiOGQ {
    static constexpr bool PERM = true, AFTER_DRAIN = false, BIAS = false;
    unsigned char* O;
    __device__ __forceinline__ void operator()(const pg::f32x4 (&acc)[2][2][4][2], const pg::Unit& u, int wr, int wc, int fr, int fq) const {
        unsigned char* base = O + (size_t)(u.pm * 256 + wr * 64 + fr) * 3072 + u.pn * 256 + (wc * 4 + fq) * 16;
#pragma unroll
        for (int ai = 0; ai < 2; ++ai)
#pragma unroll
            for (int m = 0; m < 4; ++m) { pg::u32x4 w;
                { const pg::f32x4 v0 = acc[ai][0][m][0], v1 = acc[ai][0][m][1];
                  int p = __builtin_amdgcn_cvt_pk_fp8_f32(v0[0], v0[1], 0, false); p = __builtin_amdgcn_cvt_pk_fp8_f32(v0[2], v0[3], p, true); w.x = (unsigned)p;
                  p = __builtin_amdgcn_cvt_pk_fp8_f32(v1[0], v1[1], 0, false); p = __builtin_amdgcn_cvt_pk_fp8_f32(v1[2], v1[3], p, true); w.y = (unsigned)p; }
                { const pg::f32x4 v0 = acc[ai][1][m][0], v1 = acc[ai][1][m][1];
                  int p = __builtin_amdgcn_cvt_pk_fp8_f32(v0[0], v0[1], 0, false); p = __builtin_amdgcn_cvt_pk_fp8_f32(v0[2], v0[3], p, true); w.z = (unsigned)p;
                  p = __builtin_amdgcn_cvt_pk_fp8_f32(v1[0], v1[1], 0, false); p = __builtin_amdgcn_cvt_pk_fp8_f32(v1[2], v1[3], p, true); w.w = (unsigned)p; }
                *(pg::u32x4*)(base + (size_t)(ai * 128 + m * 16) * 3072) = w; asm volatile("" ::: "memory"); }
    }
};
__device__ __forceinline__ void fp8x4_to_f32(unsigned w, float (&o)[4]) {
    const pg::f32x2 lo = __builtin_amdgcn_cvt_pk_f32_fp8((int)w, false), hi = __builtin_amdgcn_cvt_pk_f32_fp8((int)w, true);
    o[0] = lo.x; o[1] = lo.y; o[2] = hi.x; o[3] = hi.y;
}
__device__ __forceinline__ void ph_inproj(LAS unsigned char* lds, const OptBufs& o) {
    const int G = gridDim.x, bx = blockIdx.x;
    { SchedInproj S; S.o.init(T / 256, 12, 1, G, bx); S.A = (const char*)o.H0Q; S.B = (const char*)o.WinQ; S.rowbytes = D;
      EpiOGQ E{o.OGQ}; pg::gemm_phase<EpiOGQ, SchedInproj, false, true>(lds, D / 2, D / 2, D / 2, S, E); }
    { SchedInproj S; S.o.init(T / 256, 6, 1, G, bx); S.A = (const char*)o.H0B; S.B = (const char*)o.WinT; S.rowbytes = (size_t)D * 2;
      pg::EpiStoreBf16 E{o.PROJ, PROJLD, 1.f, 0}; pg::gemm_phase<pg::EpiStoreBf16, SchedInproj>(lds, D, D, D, S, E); }
    { SchedVT S; S.o.init(4, T / 256, 1, G, (bx + 128) % G); S.A = (const char*)(o.WinT + (size_t)PROJW * D); S.B = (const char*)o.H0B;
      EpiVT E{o.BT2}; pg::gemm_phase<EpiVT, SchedVT>(lds, D, D, D, S, E); }
}

struct OptBufs2 { pg::bf16_t *WqT, *WkT, *WpoolT, *WbpT, *POOLED, *UC, *MIXED, *Q, *K, *YPOOL; };
__device__ __forceinline__ void ld8(const pg::bf16_t* p, float (&v)[8]) { const pg::u32x4 w = *(const pg::u32x4*)p;
    v[0] = __builtin_bit_cast(float, w.x << 16); v[1] = __builtin_bit_cast(float, w.x & 0xffff0000u); v[2] = __builtin_bit_cast(float, w.y << 16); v[3] = __builtin_bit_cast(float, w.y & 0xffff0000u);
    v[4] = __builtin_bit_cast(float, w.z << 16); v[5] = __builtin_bit_cast(float, w.z & 0xffff0000u); v[6] = __builtin_bit_cast(float, w.w << 16); v[7] = __builtin_bit_cast(float, w.w & 0xffff0000u); }
__device__ __forceinline__ void st8(pg::bf16_t* p, const float (&v)[8]) { pg::u32x4 w; w.x = pk2(v[0], v[1]); w.y = pk2(v[2], v[3]); w.z = pk2(v[4], v[5]); w.w = pk2(v[6], v[7]); *(pg::u32x4*)p = w; }
__device__ __forceinline__ void ph_poolconv_opt(const pg::bf16_t* PROJ, const float* cw, const float* cb, pg::bf16_t* POOLED, pg::bf16_t* UC) {
    const int gt = blockIdx.x * NT + tidf(), ngt = gridDim.x * NT;
    for (int it = gt; it < 512 * 192; it += ngt) {
        const int run = it / 192, oc = it % 192; const int t0 = run * 32, tpos0 = t0 & (SEQ - 1);
        if (oc < 64) {
            const int c0 = oc * 8, w = 2 << (c0 >> 7);
            const pg::bf16_t* src = PROJ + PJ_P + c0;
            float s[8];
#pragma unroll
            for (int q = 0; q < 8; ++q) s[q] = 0.f;
            { pg::u32x4 hv[15];
#pragma unroll
              for (int j = 1; j < 16; ++j) hv[j - 1] = (j < w && tpos0 - j >= 0) ? *(const pg::u32x4*)(src + (size_t)(t0 - j) * PROJLD) : (pg::u32x4){0u, 0u, 0u, 0u};
#pragma unroll
              for (int j = 0; j < 15; ++j) { s[0] += __builtin_bit_cast(float, hv[j].x << 16); s[1] += __builtin_bit_cast(float, hv[j].x & 0xffff0000u); s[2] += __builtin_bit_cast(float, hv[j].y << 16); s[3] += __builtin_bit_cast(float, hv[j].y & 0xffff0000u);
                  s[4] += __builtin_bit_cast(float, hv[j].z << 16); s[5] += __builtin_bit_cast(float, hv[j].z & 0xffff0000u); s[6] += __builtin_bit_cast(float, hv[j].w << 16); s[7] += __builtin_bit_cast(float, hv[j].w & 0xffff0000u); } }
            for (int i0 = 0; i0 < 32; i0 += 8) {
                pg::u32x4 cv[8], ov[8];
#pragma unroll
                for (int i = 0; i < 8; ++i) { const int t = t0 + i0 + i, tp = tpos0 + i0 + i; cv[i] = *(const pg::u32x4*)(src + (size_t)t * PROJLD);
                    ov[i] = (tp - w + 1 >= 0) ? *(const pg::u32x4*)(src + (size_t)(t - w + 1) * PROJLD) : (pg::u32x4){0u, 0u, 0u, 0u}; }
#pragma unroll
                for (int i = 0; i < 8; ++i) { const int t = t0 + i0 + i, tp = tpos0 + i0 + i; float cur[8], old[8], o[8];
                    cur[0] = __builtin_bit_cast(float, cv[i].x << 16); cur[1] = __builtin_bit_cast(float, cv[i].x & 0xffff0000u); cur[2] = __builtin_bit_cast(float, cv[i].y << 16); cur[3] = __builtin_bit_cast(float, cv[i].y & 0xffff0000u);
                    cur[4] = __builtin_bit_cast(float, cv[i].z << 16); cur[5] = __builtin_bit_cast(float, cv[i].z & 0xffff0000u); cur[6] = __builtin_bit_cast(float, cv[i].w << 16); cur[7] = __builtin_bit_cast(float, cv[i].w & 0xffff0000u);
                    old[0] = __builtin_bit_cast(float, ov[i].x << 16); old[1] = __builtin_bit_cast(float, ov[i].x & 0xffff0000u); old[2] = __builtin_bit_cast(float, ov[i].y << 16); old[3] = __builtin_bit_cast(float, ov[i].y & 0xffff0000u);
                    old[4] = __builtin_bit_cast(float, ov[i].z << 16); old[5] = __builtin_bit_cast(float, ov[i].z & 0xffff0000u); old[6] = __builtin_bit_cast(float, ov[i].w << 16); old[7] = __builtin_bit_cast(float, ov[i].w & 0xffff0000u);
                    const float inv = 1.f / (float)((tp + 1 < w) ? tp + 1 : w);
#pragma unroll
                    for (int q = 0; q < 8; ++q) { s[q] += cur[q]; o[q] = s[q] * inv - cur[q]; s[q] -= old[q]; }
                    st8(POOLED + (size_t)t * 512 + c0, o); }
            }
        } else {
            const int c0 = (oc - 64) * 8;
            const pg::bf16_t* src = PROJ + PJ_U + c0;
            float w0[8], w1[8], w2[8], w3[8], bb[8], u0[8], u1[8], u2[8];
#pragma unroll
            for (int q = 0; q < 8; ++q) { w0[q] = cw[c0 + q]; w1[q] = cw[1024 + c0 + q]; w2[q] = cw[2048 + c0 + q]; w3[q] = cw[3072 + c0 + q]; bb[q] = cb[c0 + q]; u0[q] = 0.f; u1[q] = 0.f; u2[q] = 0.f; }
            if (tpos0 >= 3) ld8(src + (size_t)(t0 - 3) * PROJLD, u0);
            if (tpos0 >= 2) ld8(src + (size_t)(t0 - 2) * PROJLD, u1);
            if (tpos0 >= 1) ld8(src + (size_t)(t0 - 1) * PROJLD, u2);
            for (int i0 = 0; i0 < 32; i0 += 8) {
                pg::u32x4 cv[8];
#pragma unroll
                for (int i = 0; i < 8; ++i) cv[i] = *(const pg::u32x4*)(src + (size_t)(t0 + i0 + i) * PROJLD);
#pragma unroll
                for (int i = 0; i < 8; ++i) { float u3[8], o[8];
                    u3[0] = __builtin_bit_cast(float, cv[i].x << 16); u3[1] = __builtin_bit_cast(float, cv[i].x & 0xffff0000u); u3[2] = __builtin_bit_cast(float, cv[i].y << 16); u3[3] = __builtin_bit_cast(float, cv[i].y & 0xffff0000u);
                    u3[4] = __builtin_bit_cast(float, cv[i].z << 16); u3[5] = __builtin_bit_cast(float, cv[i].z & 0xffff0000u); u3[6] = __builtin_bit_cast(float, cv[i].w << 16); u3[7] = __builtin_bit_cast(float, cv[i].w & 0xffff0000u);
#pragma unroll
                    for (int q = 0; q < 8; ++q) { const float y = bb[q] + w0[q] * u0[q] + w1[q] * u1[q] + w2[q] * u2[q] + w3[q] * u3[q]; o[q] = y * __builtin_amdgcn_rcpf(1.f + __expf(-y)); u0[q] = u1[q]; u1[q] = u2[q]; u2[q] = u3[q]; }
                    st8(UC + (size_t)(t0 + i0 + i) * 1024 + c0, o); }
            }
        }
    }
}
struct SchedG {
    pg::TileOrder o; const char* A; const char* B; size_t gA, gB, tA, tB;
    __device__ __forceinline__ bool next(int i, pg::Unit& u) const { int g, pm, pn; if (!o.tile(i, g, pm, pn)) return false;
        u.A = A + g * gA + pm * tA; u.B = B + g * gB + pn * tB; u.pm = pm; u.pn = pn; u.g = g; u.aux = 0; u.rows = nullptr; u.nvalid = 0; return true; }
};
struct EpiPoolMixB {
    static constexpr bool PERM = true, AFTER_DRAIN = false, BIAS = false;
    pg::bf16_t* O; const float* b; const float* ls;
    __device__ __forceinline__ void operator()(const pg::f32x4 (&acc)[2][2][4][2], const pg::Unit& u, int wr, int wc, int fr, int fq) const {
        const int col0 = u.pn * 256 + wc * 32 + 8 * fq;
        pg::bf16_t* base = O + (size_t)(u.pm * 256 + wr * 64 + fr) * 512 + col0;
        pg::f32x4 bv[2][2], lv[2][2];
#pragma unroll
        for (int bj = 0; bj < 2; ++bj)
#pragma unroll
            for (int n = 0; n < 2; ++n) { bv[bj][n] = *(const pg::f32x4*)(b + col0 + bj * 128 + 4 * n); lv[bj][n] = *(const pg::f32x4*)(ls + col0 + bj * 128 + 4 * n); }
#pragma unroll
        for (int ai = 0; ai < 2; ++ai)
#pragma unroll
            for (int m = 0; m < 4; ++m) { pg::bf16_t* rowp = base + (size_t)(ai * 128 + m * 16) * 512;
#pragma unroll
                for (int bj = 0; bj < 2; ++bj) { const pg::f32x4 v0 = (acc[ai][bj][m][0] + bv[bj][0]) * lv[bj][0], v1 = (acc[ai][bj][m][1] + bv[bj][1]) * lv[bj][1];
                    pg::u32x4 w; w.x = pg::cvt_pk_bf16(v0[0], v0[1]); w.y = pg::cvt_pk_bf16(v0[2], v0[3]); w.z = pg::cvt_pk_bf16(v1[0], v1[1]); w.w = pg::cvt_pk_bf16(v1[2], v1[3]);
                    *(pg::u32x4*)(rowp + bj * 128) = w; } }
    }
};
__device__ __forceinline__ void cvt_bf16_f32(const pg::bf16_t* src, size_t lds_, int cols, float* dst, size_t rows) {
    const size_t gt = (size_t)blockIdx.x * NT + tidf(), ngt = (size_t)gridDim.x * NT;
    for (size_t i = gt; i < rows * cols; i += ngt) { const size_t r = i / cols; const int c = (int)(i % cols); dst[i] = bf2f(src[r * lds_ + c]); }
}
__device__ __forceinline__ void ph_adapt_v(const OptBufs& o, float* vv) {
    const size_t gt = (size_t)blockIdx.x * NT + tidf(), ngt = (size_t)gridDim.x * NT;
    for (size_t i = gt; i < (size_t)T * 1024; i += ngt) { const int t = (int)(i >> 10), e = (int)(i & 1023), h = e >> 8, el = e & 255, b = t >> 12, cc = (t & 4095) >> 8, tl = t & 255;
        vv[i] = bf2f(o.BT2[((size_t)((b * 4 + h) * 16 + cc) * 256 + el) * 512 + tl]); }
}


struct OptBufs3 { pg::bf16_t *KaT, *A2, *HOUT; float *U, *rowv, *colv, *winter, *aw, *emt, *den, *un, *decay; };
__device__ __forceinline__ float log_sigmoidf_(float x) { return fminf(x, 0.f) - log1pf(expf(-fabsf(x))); }
__device__ __forceinline__ void scalar_scan_wg(LAS unsigned char* lds, int bh, const float* gif, const OptBufs3& o) {
    const int tid = tidf(), lane = tid & 63, wave = tid >> 6, b = bh >> 2, h = bh & 3;
    LAS float* sum = (LAS float*)lds;
    float bt[2][4], ip[2][4], pm[2][4];
#pragma unroll
    for (int cc = 0; cc < 2; ++cc) { const int c = wave * 2 + cc;
        float bs[4];
#pragma unroll
        for (int sub = 0; sub < 4; ++sub) { const size_t t = (size_t)b * SEQ + c * 256 + sub * 64 + lane; ip[cc][sub] = gif[t * 8 + h]; bs[sub] = log_sigmoidf_(gif[t * 8 + 4 + h]); }
#pragma unroll
        for (int off = 1; off < 64; off <<= 1) {
#pragma unroll
            for (int sub = 0; sub < 4; ++sub) { const float v = __shfl_up(bs[sub], off); if (lane >= off) bs[sub] += v; } }
        float carry = 0.f;
#pragma unroll
        for (int sub = 0; sub < 4; ++sub) { bt[cc][sub] = carry + bs[sub]; carry += __shfl(bs[sub], 63); pm[cc][sub] = ip[cc][sub] - bt[cc][sub]; }
#pragma unroll
        for (int off = 1; off < 64; off <<= 1) {
#pragma unroll
            for (int sub = 0; sub < 4; ++sub) { const float v = __shfl_up(pm[cc][sub], off); if (lane >= off) pm[cc][sub] = fmaxf(pm[cc][sub], v); } }
        float pmc = -INFINITY;
#pragma unroll
        for (int sub = 0; sub < 4; ++sub) { pm[cc][sub] = fmaxf(pm[cc][sub], pmc); pmc = __shfl(pm[cc][sub], 63); }
        if (lane == 0) { sum[c * 2] = carry; sum[c * 2 + 1] = pmc; }
    }
    __syncthreads();
    float mc = 0.f;
    for (int c = 0; c < wave * 2; ++c) mc = sum[c * 2] + fmaxf(mc, sum[c * 2 + 1]);
#pragma unroll
    for (int cc = 0; cc < 2; ++cc) { const int c = wave * 2 + cc; const float Gc = sum[c * 2], mnext = Gc + fmaxf(mc, sum[c * 2 + 1]);
#pragma unroll
        for (int sub = 0; sub < 4; ++sub) { const float mt = bt[cc][sub] + fmaxf(mc, pm[cc][sub]);
            const size_t idx = ((size_t)b * SEQ + c * 256 + sub * 64 + lane) * 4 + h;
            o.rowv[idx] = bt[cc][sub] - mt; o.colv[idx] = ip[cc][sub] - bt[cc][sub];
            o.winter[idx] = expf(bt[cc][sub] + mc - mt); o.aw[idx] = expf(Gc - bt[cc][sub] + ip[cc][sub] - mnext); o.emt[idx] = expf(-mt); }
        if (lane == 0) o.decay[bh * 16 + c] = expf(Gc + mc - mnext);
        mc = mnext; }
    __syncthreads();
}
struct EpiQ {
    static constexpr bool PERM = true, AFTER_DRAIN = false, BIAS = false;
    pg::bf16_t* Q; pg::bf16_t* A2; const float* winter;
    __device__ __forceinline__ void operator()(const pg::f32x4 (&acc)[2][2][4][2], const pg::Unit& u, int wr, int wc, int fr, int fq) const {
        const int h = u.g, col0 = wc * 32 + 8 * fq;
#pragma unroll
        for (int ai = 0; ai < 2; ++ai)
#pragma unroll
            for (int m = 0; m < 4; ++m) { const size_t t = (size_t)u.pm * 256 + ai * 128 + wr * 64 + m * 16 + fr; const float wi = winter[t * 4 + h];
#pragma unroll
                for (int bj = 0; bj < 2; ++bj) { const pg::f32x4 v0 = acc[ai][bj][m][0] * 0.0625f, v1 = acc[ai][bj][m][1] * 0.0625f;
                    pg::u32x4 w; w.x = pg::cvt_pk_bf16(v0[0], v0[1]); w.y = pg::cvt_pk_bf16(v0[2], v0[3]); w.z = pg::cvt_pk_bf16(v1[0], v1[1]); w.w = pg::cvt_pk_bf16(v1[2], v1[3]);
                    *(pg::u32x4*)(Q + t * 1024 + h * 256 + col0 + bj * 128) = w;
                    const pg::f32x4 x0 = v0 * wi, x1 = v1 * wi;
                    pg::u32x4 y; y.x = pg::cvt_pk_bf16(x0[0], x0[1]); y.y = pg::cvt_pk_bf16(x0[2], x0[3]); y.z = pg::cvt_pk_bf16(x1[0], x1[1]); y.w = pg::cvt_pk_bf16(x1[2], x1[3]);
                    *(pg::u32x4*)(A2 + t * 2048 + h * 512 + 256 + col0 + bj * 128) = y; }
                asm volatile("" ::: "memory"); }
    }
};
struct EpiKT {
    static constexpr bool PERM = true, AFTER_DRAIN = false, BIAS = false;
    pg::bf16_t* KaT; const float* aw;
    __device__ __forceinline__ void operator()(const pg::f32x4 (&acc)[2][2][4][2], const pg::Unit& u, int wr, int wc, int fr, int fq) const {
        const int h = u.g; const size_t t0 = (size_t)u.pn * 256 + wc * 32 + 8 * fq;
#pragma unroll
        for (int bj = 0; bj < 2; ++bj) {
            float a[8];
#pragma unroll
            for (int j = 0; j < 8; ++j) a[j] = aw[(t0 + bj * 128 + j) * 4 + h];
            pg::bf16_t* rowp = KaT + ((size_t)h * 256 + wr * 64 + fr) * T + t0 + bj * 128;
#pragma unroll
            for (int ai = 0; ai < 2; ++ai)
#pragma unroll
                for (int m = 0; m < 4; ++m) { const pg::f32x4 v0 = acc[ai][bj][m][0], v1 = acc[ai][bj][m][1];
                    pg::u32x4 w; w.x = pg::cvt_pk_bf16(v0[0] * a[0], v0[1] * a[1]); w.y = pg::cvt_pk_bf16(v0[2] * a[2], v0[3] * a[3]);
                    w.z = pg::cvt_pk_bf16(v1[0] * a[4], v1[1] * a[5]); w.w = pg::cvt_pk_bf16(v1[2] * a[6], v1[3] * a[7]);
                    *(pg::u32x4*)(rowp + (size_t)(ai * 128 + m * 16) * T) = w; asm volatile("" ::: "memory"); }
        }
    }
};
struct EpiS {
    static constexpr bool PERM = true, AFTER_DRAIN = false, BIAS = false;
    pg::bf16_t* A2; const float* rowv; const float* colv; float* den;
    __device__ __forceinline__ void operator()(const pg::f32x4 (&acc)[2][2][4][2], const pg::Unit& u, int wr, int wc, int fr, int fq) const {
        const int bh = u.g >> 4, c = u.g & 15, b = bh >> 2, h = bh & 3; const size_t tok0 = (size_t)b * SEQ + c * 256;
        const int col0 = wc * 32 + 8 * fq;
        const float* cvp = colv + (tok0 + col0) * 4 + h;
#pragma unroll
        for (int ai = 0; ai < 2; ++ai)
#pragma unroll
            for (int m = 0; m < 4; ++m) { const int tl = ai * 128 + wr * 64 + m * 16 + fr; const float rv = rowv[(tok0 + tl) * 4 + h]; float rs = 0.f;
                pg::bf16_t* op = A2 + (tok0 + tl) * 2048 + h * 512 + col0;
#pragma unroll
                for (int bj = 0; bj < 2; ++bj) { float x[8];
#pragma unroll
                    for (int j = 0; j < 8; ++j) { const int sl = col0 + bj * 128 + j; const float a_ = (j < 4) ? acc[ai][bj][m][0][j] : acc[ai][bj][m][1][j - 4];
                        const float w_ = __expf(rv + cvp[(bj * 128 + j) * 4]); x[j] = (sl <= tl) ? a_ * w_ : 0.f; rs += x[j]; }
                    pg::u32x4 w; w.x = pg::cvt_pk_bf16(x[0], x[1]); w.y = pg::cvt_pk_bf16(x[2], x[3]); w.z = pg::cvt_pk_bf16(x[4], x[5]); w.w = pg::cvt_pk_bf16(x[6], x[7]);
                    *(pg::u32x4*)(op + bj * 128) = w; asm volatile("" ::: "memory"); }
                rs += __shfl_xor(rs, 16); rs += __shfl_xor(rs, 32);
                if (fq == 0) atomicAdd(den + (tok0 + tl) * 4 + h, rs);
                asm volatile("" ::: "memory"); }
    }
};
struct EpiF32U {
    static constexpr bool PERM = false, AFTER_DRAIN = false, BIAS = false;
    float* C;
    __device__ __forceinline__ void operator()(const pg::f32x4 (&acc)[2][2][4][2], const pg::Unit& u, int wr, int wc, int fr, int fq) const {
        pg::bf16_t* base = (pg::bf16_t*)C + (size_t)u.aux * 65536 + (size_t)(wr * 64 + fr) * 256 + (wc * 4 + fq) * 16;
#pragma unroll
        for (int ai = 0; ai < 2; ++ai)
#pragma unroll
            for (int m = 0; m < 4; ++m)
#pragma unroll
                for (int bj = 0; bj < 2; ++bj) { const pg::f32x4 v0 = acc[ai][bj][m][0], v1 = acc[ai][bj][m][1];
                    pg::u32x4 w; w.x = pg::cvt_pk_bf16(v0[0], v0[1]); w.y = pg::cvt_pk_bf16(v0[2], v0[3]); w.z = pg::cvt_pk_bf16(v1[0], v1[1]); w.w = pg::cvt_pk_bf16(v1[2], v1[3]);
                    *(pg::u32x4*)(base + (size_t)(ai * 128 + m * 16) * 256 + bj * 8) = w; if (bj) asm volatile("" ::: "memory"); }
    }
};
struct EpiNum {
    static constexpr bool PERM = true, AFTER_DRAIN = true, BIAS = false;
    pg::bf16_t* HOUT; const unsigned char* OGQ; const float* den; const float* emt; const float* gain;
    __device__ __forceinline__ void fused(pg::f32x4 (&acc)[2][2][4][2], const pg::Unit& u, int wr, int wc, int fr, int fq, LAS unsigned char* lds, int wid, int lane) const {
        const int bh = u.g >> 4, c = u.g & 15, b = bh >> 2, h = bh & 3; const size_t tok0 = (size_t)b * SEQ + c * 256;
        LAS pg::f32x2* P = (LAS pg::f32x2*)lds; LAS pg::f32x2* Sx = (LAS pg::f32x2*)(lds + 8192);
#pragma unroll
        for (int ai = 0; ai < 2; ++ai)
#pragma unroll
            for (int m = 0; m < 4; ++m) { const int tl = ai * 128 + wr * 64 + m * 16 + fr; const size_t ti = (tok0 + tl) * 4 + h;
                const float inv = __builtin_amdgcn_rcpf(fmaxf(fabsf(den[ti]), emt[ti])); float s = 0.f;
#pragma unroll
                for (int bj = 0; bj < 2; ++bj)
#pragma unroll
                    for (int n = 0; n < 2; ++n) { acc[ai][bj][m][n] = acc[ai][bj][m][n] * inv; const pg::f32x4 x = acc[ai][bj][m][n]; s += (x[0] + x[1]) + (x[2] + x[3]); }
                s += __shfl_xor(s, 16); s += __shfl_xor(s, 32);
                const float mw = s * (1.f / 64.f); float q = 0.f;
#pragma unroll
                for (int bj = 0; bj < 2; ++bj)
#pragma unroll
                    for (int n = 0; n < 2; ++n) { const pg::f32x4 d = acc[ai][bj][m][n] - mw; q += (d[0] * d[0] + d[1] * d[1]) + (d[2] * d[2] + d[3] * d[3]); }
                q += __shfl_xor(q, 16); q += __shfl_xor(q, 32);
                if (fq == 0) P[tl * 4 + wc] = (pg::f32x2){mw, q}; }
        asm volatile("s_waitcnt lgkmcnt(0)" ::: "memory"); __builtin_amdgcn_s_barrier(); asm volatile("" ::: "memory");
        if (lane < 32) { const int row = wid * 32 + lane;
            const pg::f32x2 a = P[row * 4 + 0], b_ = P[row * 4 + 1], c_ = P[row * 4 + 2], d = P[row * 4 + 3];
            const float mt = (a.x + b_.x + c_.x + d.x) * 0.25f;
            const float da = a.x - mt, db = b_.x - mt, dc = c_.x - mt, dd = d.x - mt;
            const float m2 = (a.y + b_.y) + (c_.y + d.y) + 64.f * ((da * da + db * db) + (dc * dc + dd * dd));
            Sx[row] = (pg::f32x2){mt, rsqrtf(m2 * (1.f / 256.f) + LN_EPS)}; }
        asm volatile("s_waitcnt lgkmcnt(0)" ::: "memory"); __builtin_amdgcn_s_barrier(); asm volatile("" ::: "memory");
        const int col0 = wc * 32 + 8 * fq;
        pg::f32x4 gn[2][2];
#pragma unroll
        for (int bj = 0; bj < 2; ++bj) { gn[bj][0] = *(const pg::f32x4*)(gain + h * 256 + col0 + bj * 128); gn[bj][1] = *(const pg::f32x4*)(gain + h * 256 + col0 + bj * 128 + 4); }
#pragma unroll
        for (int ai = 0; ai < 2; ++ai)
#pragma unroll
            for (int m = 0; m < 4; ++m) { const int tl = ai * 128 + wr * 64 + m * 16 + fr; const pg::f32x2 sr = Sx[tl]; const size_t t = tok0 + tl;
                const pg::u32x4 ow = *(const pg::u32x4*)(OGQ + t * 3072 + h * 256 + (wc * 4 + fq) * 16);
#pragma unroll
                for (int bj = 0; bj < 2; ++bj) { const int e0 = h * 256 + col0 + bj * 128; float o0[4], o1[4];
                    fp8x4_to_f32(bj ? ow.z : ow.x, o0); fp8x4_to_f32(bj ? ow.w : ow.y, o1);
                    const pg::f32x4 v0 = (acc[ai][bj][m][0] - sr.x) * sr.y * gn[bj][0], v1 = (acc[ai][bj][m][1] - sr.x) * sr.y * gn[bj][1];
                    float r[8];
#pragma unroll
                    for (int j = 0; j < 4; ++j) { r[j] = v0[j] * fsigmoid(o0[j]); r[4 + j] = v1[j] * fsigmoid(o1[j]); }
                    st8(HOUT + t * 1024 + e0, r); } }
    }
};
struct SchedG1 { pg::TileOrder o; const char* Q; const char* K;
    __device__ __forceinline__ bool next(int i, pg::Unit& u) const { int g, pm, pn; if (!o.tile(i, g, pm, pn)) return false;
        const int bh = g >> 4, c = g & 15, b = bh >> 2, h = bh & 3; const size_t off = (((size_t)b * SEQ + c * 256) * 1024 + h * 256) * 2;
        u.A = Q + off; u.B = K + off; u.pm = 0; u.pn = 0; u.g = g; u.aux = g; u.rows = nullptr; u.nvalid = 0; return true; } };
struct SchedG2 { pg::TileOrder o; const char* BT2; const char* KaT;
    __device__ __forceinline__ bool next(int i, pg::Unit& u) const { int g, pm, pn; if (!o.tile(i, g, pm, pn)) return false;
        const int bh = g / 15, c = g % 15, b = bh >> 2, h = bh & 3;
        u.A = BT2 + (size_t)(bh * 16 + c) * 256 * 512 * 2; u.B = KaT + (((size_t)h * 256) * T + (size_t)b * SEQ + c * 256) * 2;
        u.pm = 0; u.pn = 0; u.g = bh * 16 + c; u.aux = bh * 16 + c; u.rows = nullptr; u.nvalid = 0; return true; } };
struct SchedG3 { pg::TileOrder o; const char* A2; const char* BT2;
    __device__ __forceinline__ bool next(int i, pg::Unit& u) const { int g, pm, pn; if (!o.tile(i, g, pm, pn)) return false;
        const int bh = g >> 4, c = g & 15, b = bh >> 2, h = bh & 3;
        u.A = A2 + (((size_t)b * SEQ + c * 256) * 2048 + h * 512) * 2; u.B = BT2 + (size_t)g * 256 * 512 * 2; u.pm = 0; u.pn = 0; u.g = g; u.aux = g; u.rows = nullptr; u.nvalid = 0; return true; } };
__device__ __forceinline__ void ph_un(LAS unsigned char* lds, const OptBufs2& o2, const OptBufs3& o3) {
    const int tid = tidf(), d = tid & 255, sh = tid >> 8; LAS float* red = (LAS float*)lds;
    for (int it = blockIdx.x; it < 256; it += gridDim.x) { const int bh = it >> 4, c = it & 15, b = bh >> 2, h = bh & 3; const size_t tok0 = (size_t)b * SEQ + c * 256;
        float s = 0.f;
#pragma unroll 8
        for (int j = 0; j < 128; ++j) { const size_t t = tok0 + sh * 128 + j; s += o3.aw[t * 4 + h] * bf2f(o2.K[t * 1024 + h * 256 + d]); }
        __syncthreads(); if (sh == 1) red[d] = s; __syncthreads();
        if (sh == 0) o3.un[(size_t)it * 256 + d] = s + red[d]; }
    __syncthreads();
}
__device__ __forceinline__ void ph_state_scan(const OptBufs& ob, const OptBufs3& o3) {
    const int gt = blockIdx.x * NT + tidf(), ngt = gridDim.x * NT;
    const pg::bf16_t* U16 = (const pg::bf16_t*)o3.U;
    for (int it = gt; it < 16 * 256 * 32; it += ngt) { const int bh = it >> 13, e = (it >> 5) & 255, ch = it & 31, slot = ch >> 1, bj = ch & 1;
        const int d0 = 128 * bj + 32 * (slot >> 2) + 4 * (slot & 3);
        pg::u32x4 U[15]; float dc[15];
#pragma unroll
        for (int c = 0; c < 15; ++c) { const size_t g = (size_t)bh * 16 + c; U[c] = *(const pg::u32x4*)(U16 + g * 65536 + (size_t)e * 256 + ch * 8); dc[c] = o3.decay[g]; }
        float C[8];
#pragma unroll
        for (int j = 0; j < 8; ++j) C[j] = 0.f;
#pragma unroll
        for (int c = 0; c < 16; ++c) { const size_t g = (size_t)bh * 16 + c;
            pg::bf16_t* dst = ob.BT2 + (g * 256 + e) * 512 + 256 + d0;
            *(pg::u32x2*)(dst) = (pg::u32x2){pk2(C[0], C[1]), pk2(C[2], C[3])};
            *(pg::u32x2*)(dst + 16) = (pg::u32x2){pk2(C[4], C[5]), pk2(C[6], C[7])};
            if (c < 15) { const pg::u32x4 w = U[c];
                C[0] = C[0] * dc[c] + __builtin_bit_cast(float, w.x << 16); C[1] = C[1] * dc[c] + __builtin_bit_cast(float, w.x & 0xffff0000u);
                C[2] = C[2] * dc[c] + __builtin_bit_cast(float, w.y << 16); C[3] = C[3] * dc[c] + __builtin_bit_cast(float, w.y & 0xffff0000u);
                C[4] = C[4] * dc[c] + __builtin_bit_cast(float, w.z << 16); C[5] = C[5] * dc[c] + __builtin_bit_cast(float, w.z & 0xffff0000u);
                C[6] = C[6] * dc[c] + __builtin_bit_cast(float, w.w << 16); C[7] = C[7] * dc[c] + __builtin_bit_cast(float, w.w & 0xffff0000u); } } }
}
__device__ __forceinline__ void ph_den_inter(LAS unsigned char* lds, const OptBufs3& o3) {
    const int tid = tidf(), lane = tid & 63, wave = tid >> 6; LAS float* nn = (LAS float*)lds;
    for (int it = blockIdx.x; it < 256; it += gridDim.x) { const int bh = it >> 4, c = it & 15, b = bh >> 2, h = bh & 3; const size_t tok0 = (size_t)b * SEQ + c * 256;
        __syncthreads();
        if (tid < 256) { float n = 0.f; for (int j = 0; j < c; ++j) n = n * o3.decay[bh * 16 + j] + o3.un[(size_t)(bh * 16 + j) * 256 + tid]; nn[tid] = n; }
        __syncthreads();
        const pg::f32x4 nv = *(const LAS pg::f32x4*)(nn + 4 * lane);
        for (int r0 = 0; r0 < 32; r0 += 8) { pg::u32x2 wv[8];
#pragma unroll
            for (int r = 0; r < 8; ++r) wv[r] = *(const pg::u32x2*)(o3.A2 + (tok0 + wave * 32 + r0 + r) * 2048 + h * 512 + 256 + 4 * lane);
#pragma unroll
            for (int r = 0; r < 8; ++r) { const size_t t = tok0 + wave * 32 + r0 + r; const pg::u32x2 w = wv[r];
                float s = __builtin_bit_cast(float, w.x << 16) * nv[0] + __builtin_bit_cast(float, w.x & 0xffff0000u) * nv[1] + __builtin_bit_cast(float, w.y << 16) * nv[2] + __builtin_bit_cast(float, w.y & 0xffff0000u) * nv[3];
                s = wsum(s);
                if (lane == 0) o3.den[t * 4 + h] += s; } } }
    __syncthreads();
}

__device__ __forceinline__ void ph_gemms_D(LAS unsigned char* lds, const OptBufs2& o, const OptBufs3& o3, const float* b_pool, const float* ls_pool) {
    const int G = gridDim.x, bx = blockIdx.x;
    { SchedG S; S.o.init(T / 256, 2, 1, G, bx); S.A = (const char*)o.POOLED; S.B = (const char*)o.WpoolT; S.gA = 0; S.gB = 0; S.tA = (size_t)256 * 512 * 2; S.tB = (size_t)256 * 512 * 2;
      EpiPoolMixB E{o.MIXED, b_pool, ls_pool}; pg::gemm_phase<EpiPoolMixB, SchedG>(lds, 512, 512, 512, S, E); }
    { SchedG S; S.o.init(T / 256, 1, 4, G, (bx + 128) % G); S.A = (const char*)o.UC; S.B = (const char*)o.WqT; S.gA = 256 * 2; S.gB = (size_t)65536 * 2; S.tA = (size_t)256 * 1024 * 2; S.tB = 0;
      EpiQ E{o.Q, o3.A2, o3.winter}; pg::gemm_phase<EpiQ, SchedG>(lds, 1024, 256, 256, S, E); }
    { SchedG S; S.o.init(T / 256, 1, 4, G, (bx + 128) % G); S.A = (const char*)o.UC; S.B = (const char*)o.WkT; S.gA = 256 * 2; S.gB = (size_t)65536 * 2; S.tA = (size_t)256 * 1024 * 2; S.tB = 0;
      pg::EpiStoreBf16 E{o.K, 1024, 1.f, 256}; pg::gemm_phase<pg::EpiStoreBf16, SchedG>(lds, 1024, 256, 256, S, E); }
    { SchedG S; S.o.init(1, T / 256, 4, G, bx); S.A = (const char*)o.WkT; S.B = (const char*)o.UC; S.gA = (size_t)65536 * 2; S.gB = 256 * 2; S.tA = 0; S.tB = (size_t)256 * 1024 * 2;
      EpiKT E{o3.KaT, o3.aw}; pg::gemm_phase<EpiKT, SchedG>(lds, 256, 1024, 256, S, E); }
}
__device__ __forceinline__ void ph_gemms_E(LAS unsigned char* lds, const OptBufs& ob, const OptBufs2& o2, const OptBufs3& o3) {
    const int G = gridDim.x, bx = blockIdx.x;
    ph_un(lds, o2, o3);
    { SchedG1 S; S.o.init(1, 1, 256, G, bx); S.Q = (const char*)o2.Q; S.K = (const char*)o2.K;
      EpiS E{o3.A2, o3.rowv, o3.colv, o3.den}; pg::gemm_phase<EpiS, SchedG1>(lds, 1024, 1024, 256, S, E); }
    { SchedG2 S; S.o.init(1, 1, 240, G, bx); S.BT2 = (const char*)ob.BT2; S.KaT = (const char*)o3.KaT;
      EpiF32U E{o3.U}; pg::gemm_phase<EpiF32U, SchedG2>(lds, 512, T, 256, S, E); }
}
__device__ __forceinline__ void ph_gemm_G3(LAS unsigned char* lds, const OptBufs& ob, const OptBufs3& o3, const float* gain) {
    SchedG3 S; S.o.init(1, 1, 256, gridDim.x, blockIdx.x); S.A2 = (const char*)o3.A2; S.BT2 = (const char*)ob.BT2;
    EpiNum E{o3.HOUT, ob.OGQ, o3.den, o3.emt, gain}; pg::gemm_phase<EpiNum, SchedG3>(lds, 2048, 512, 512, S, E);
}
__device__ __forceinline__ void ph_gemm_ypool(LAS unsigned char* lds, const OptBufs2& o) {
    const int G = gridDim.x, bx = blockIdx.x;
    SchedG S; S.o.init(T / 256, 4, 1, G, bx); S.A = (const char*)o.MIXED; S.B = (const char*)o.WbpT; S.gA = 0; S.gB = 0; S.tA = (size_t)256 * 512 * 2; S.tB = (size_t)256 * 512 * 2;
    pg::EpiStoreBf16 E{o.YPOOL, 1024, 1.f, 0}; pg::gemm_phase<pg::EpiStoreBf16, SchedG>(lds, 512, 512, 512, S, E);
}


struct OptBufs4 { pg::bf16_t *WbmT, *WoutT, *MERGED, *H1B; unsigned char* H1Q; float *Z, *WRP, *CGB; int *elist, *erank; float *gate; };
struct EpiMerge {
    static constexpr bool PERM = true, AFTER_DRAIN = false, BIAS = false;
    pg::bf16_t* O; const unsigned char* OGQ; const pg::bf16_t* YPOOL;
    __device__ __forceinline__ void operator()(const pg::f32x4 (&acc)[2][2][4][2], const pg::Unit& u, int wr, int wc, int fr, int fq) const {
        const int col0 = u.pn * 256 + wc * 32 + 8 * fq;
#pragma unroll
        for (int ai = 0; ai < 2; ++ai)
#pragma unroll
            for (int m = 0; m < 4; ++m) { const size_t t = (size_t)u.pm * 256 + ai * 128 + wr * 64 + m * 16 + fr;
                const unsigned char* gp = OGQ + t * 3072 + (4 + u.pn) * 256 + (wc * 4 + fq) * 16;
                const pg::u32x4 w0 = *(const pg::u32x4*)gp, w1 = *(const pg::u32x4*)(gp + 1024);
#pragma unroll
                for (int bj = 0; bj < 2; ++bj) { const int c = col0 + bj * 128; float g0[8], g1[8], yp[8], r[8]; float f[4];
                    fp8x4_to_f32(bj ? w0.z : w0.x, f); g0[0] = f[0]; g0[1] = f[1]; g0[2] = f[2]; g0[3] = f[3];
                    fp8x4_to_f32(bj ? w0.w : w0.y, f); g0[4] = f[0]; g0[5] = f[1]; g0[6] = f[2]; g0[7] = f[3];
                    fp8x4_to_f32(bj ? w1.z : w1.x, f); g1[0] = f[0]; g1[1] = f[1]; g1[2] = f[2]; g1[3] = f[3];
                    fp8x4_to_f32(bj ? w1.w : w1.y, f); g1[4] = f[0]; g1[5] = f[1]; g1[6] = f[2]; g1[7] = f[3];
                    ld8(YPOOL + t * 1024 + c, yp);
#pragma unroll
                    for (int j = 0; j < 8; ++j) { const float a_ = (j < 4) ? acc[ai][bj][m][0][j] : acc[ai][bj][m][1][j - 4]; r[j] = fsigmoid(g0[j]) * yp[j] + fsigmoid(g1[j]) * a_; }
                    st8(O + t * 1024 + c, r); }
                asm volatile("" ::: "memory"); }
    }
};
struct EpiMixRes {
    static constexpr bool PERM = true, AFTER_DRAIN = false, BIAS = false;
    pg::bf16_t* Z; const pg::bf16_t* H0B;
    __device__ __forceinline__ void operator()(const pg::f32x4 (&acc)[2][2][4][2], const pg::Unit& u, int wr, int wc, int fr, int fq) const {
        const int col0 = u.pn * 256 + wc * 32 + 8 * fq;
#pragma unroll
        for (int ai = 0; ai < 2; ++ai)
#pragma unroll
            for (int m = 0; m < 4; ++m) { const size_t t = (size_t)u.pm * 256 + ai * 128 + wr * 64 + m * 16 + fr;
#pragma unroll
                for (int bj = 0; bj < 2; ++bj) { const int c = col0 + bj * 128; float h[8], r[8]; ld8(H0B + t * 1024 + c, h);
#pragma unroll
                    for (int j = 0; j < 8; ++j) { const float a_ = (j < 4) ? acc[ai][bj][m][0][j] : acc[ai][bj][m][1][j - 4]; r[j] = h[j] * ALPHA + a_; }
                    st8(Z + t * 1024 + c, r); }
                asm volatile("" ::: "memory"); }
    }
};
__device__ __forceinline__ void ph_gemm_ymls(LAS unsigned char* lds, const OptBufs& ob, const OptBufs2& o2, const OptBufs3& o3, const OptBufs4& o4) {
    SchedG S; S.o.init(T / 256, 4, 1, gridDim.x, blockIdx.x); S.A = (const char*)o3.HOUT; S.B = (const char*)o4.WbmT; S.gA = 0; S.gB = 0; S.tA = (size_t)256 * 1024 * 2; S.tB = (size_t)256 * 1024 * 2;
    EpiMerge E{o4.MERGED, ob.OGQ, o2.YPOOL}; pg::gemm_phase<EpiMerge, SchedG>(lds, 1024, 1024, 1024, S, E);
}
__device__ __forceinline__ void ph_gemm_mix(LAS unsigned char* lds, const OptBufs& ob, const OptBufs4& o4, const float* x, const float* g, const float* beta) {
    SchedG S; S.o.init(T / 256, 4, 1, gridDim.x, blockIdx.x); S.A = (const char*)o4.MERGED; S.B = (const char*)o4.WoutT; S.gA = 0; S.gB = 0; S.tA = (size_t)256 * 1024 * 2; S.tB = (size_t)256 * 1024 * 2;
    EpiMixRes E{(pg::bf16_t*)o4.Z, ob.H0B}; pg::gemm_phase<EpiMixRes, SchedG>(lds, 1024, 1024, 1024, S, E);
}
typedef float f32x16 __attribute__((ext_vector_type(16)));
__device__ __forceinline__ void ph_router_prep(const OptBufs4& o, const float* g, const float* beta, const float* wr_, const float* br) {
    const int gt = blockIdx.x * NT + tidf(), ngt = gridDim.x * NT;
    for (int i = gt; i < 1024 * 32; i += ngt) o.WRP[i] = g[i >> 5] * wr_[i];
    const int gw = gt >> 6, lane = gt & 63;
    if (gw < 64) { const int e = gw & 31; const float* vsrc = (gw < 32) ? g : beta; float s_ = 0.f;
#pragma unroll
        for (int i = 0; i < 16; ++i) { const int k = lane + 64 * i; s_ += vsrc[k] * wr_[k * 32 + e]; }
        s_ = wsum(s_);
        if (lane == 0) o.CGB[gw] = s_ + ((gw < 32) ? 0.f : br[e]); }
}
__device__ __forceinline__ pg::f32x4 ldz4(const pg::bf16_t* p) { const pg::u32x2 w = *(const pg::u32x2*)p; return (pg::f32x4){__builtin_bit_cast(float, w.x << 16), __builtin_bit_cast(float, w.x & 0xffff0000u), __builtin_bit_cast(float, w.y << 16), __builtin_bit_cast(float, w.y & 0xffff0000u)}; }
__device__ __forceinline__ void ph_ln1_router(LAS unsigned char* lds, const OptBufs4& o, const float* Zin, const float* g, const float* beta, int* cnt, int mode = 7) {
    const int tid = tidf(), lane = tid & 63, wave = tid >> 6; const pg::bf16_t* Zb = (const pg::bf16_t*)Zin;
    LAS float* part = (LAS float*)lds;
    LAS float* stg = (LAS float*)(lds + wave * 9216);
    LAS float* L = (LAS float*)(lds + 81920);
    LAS float* st = (LAS float*)(lds + 81920 + 8448);
    LAS int* hist = (LAS int*)(lds + 131072 + 1024);
    LAS int* asg = (LAS int*)(lds + 131072 + 1024 + 256);
    for (int tile = blockIdx.x; tile < T / 64; tile += gridDim.x) {
        __syncthreads();
        if (tid < 64) hist[tid] = 0;
        const size_t tbase = (size_t)tile * 64 + wave * 8;
        pg::f32x4 va[4];
#pragma unroll
        for (int j = 0; j < 4; ++j) va[j] = ldz4(Zb + tbase * D + 256 * j + 4 * lane);
        for (int r = 0; r < ((mode & 1) ? 8 : 0); ++r) {
            pg::f32x4 na[4];
            if (r < 7) {
#pragma unroll
                for (int j = 0; j < 4; ++j) na[j] = ldz4(Zb + (tbase + r + 1) * D + 256 * j + 4 * lane); }
            float sa = 0.f;
#pragma unroll
            for (int j = 0; j < 4; ++j) sa += (va[j].x + va[j].y) + (va[j].z + va[j].w);
            const float ma = wsum(sa) * (1.f / D); float qa = 0.f;
#pragma unroll
            for (int j = 0; j < 4; ++j) { va[j] = va[j] - ma; qa += (va[j].x * va[j].x + va[j].y * va[j].y) + (va[j].z * va[j].z + va[j].w * va[j].w); }
            const float ra = rsqrtf(wsum(qa) * (1.f / D) + LN_EPS);
            const size_t ta = tbase + r;
            if (lane == 0) { st[(wave * 8 + r) * 2] = ma; st[(wave * 8 + r) * 2 + 1] = ra; }
#pragma unroll
            for (int j = 0; j < 4; ++j) { const int c0 = 256 * j + 4 * lane;
                const pg::f32x4 gg = *(const pg::f32x4*)(g + c0), bb = *(const pg::f32x4*)(beta + c0);
                const pg::f32x4 y = va[j] * ra * gg + bb;
                *(unsigned long long*)(o.H1B + ta * D + c0) = (unsigned long long)pk2(y.x, y.y) | ((unsigned long long)pk2(y.z, y.w) << 32);
                int w0 = __builtin_amdgcn_cvt_pk_fp8_f32(y.x, y.y, 0, false); w0 = __builtin_amdgcn_cvt_pk_fp8_f32(y.z, y.w, w0, true); *(int*)(o.H1Q + ta * D + c0) = w0; }
#pragma unroll
            for (int j = 0; j < 4; ++j) va[j] = na[j];
        }
        if (mode & 2) { const int hh = lane >> 5, el = lane & 31, kb = wave * 128;
          f32x16 acc0, acc1;
#pragma unroll
          for (int i = 0; i < 16; ++i) { acc0[i] = 0.f; acc1[i] = 0.f; }
          const pg::bf16_t* zt = Zb + (size_t)tile * 64 * D + kb;
          pg::f32x4 zv[8];
#pragma unroll
          for (int it = 0; it < 8; ++it) zv[it] = ldz4(zt + (size_t)(it * 8 + (lane >> 3)) * D + 4 * (lane & 7));
#pragma unroll 1
          for (int sub = 0; sub < 4; ++sub) {
              float bw[16];
#pragma unroll
              for (int s_ = 0; s_ < 16; ++s_) bw[s_] = o.WRP[(size_t)(kb + 32 * sub + 16 * hh + s_) * 32 + el];
#pragma unroll
              for (int it = 0; it < 8; ++it) *(LAS pg::f32x4*)(stg + (it * 8 + (lane >> 3)) * 36 + 4 * (lane & 7)) = zv[it];
              if (sub < 3) {
#pragma unroll
                  for (int it = 0; it < 8; ++it) zv[it] = ldz4(zt + (size_t)(it * 8 + (lane >> 3)) * D + 32 * (sub + 1) + 4 * (lane & 7)); }
              asm volatile("s_waitcnt lgkmcnt(0)" ::: "memory");
              pg::f32x4 a0[4], a1[4];
#pragma unroll
              for (int q = 0; q < 4; ++q) { a0[q] = *(const LAS pg::f32x4*)(stg + el * 36 + 16 * hh + 4 * q); a1[q] = *(const LAS pg::f32x4*)(stg + (32 + el) * 36 + 16 * hh + 4 * q); }
#pragma unroll
              for (int q = 0; q < 4; ++q) {
                  acc0 = __builtin_amdgcn_mfma_f32_32x32x2f32(a0[q].x, bw[4 * q + 0], acc0, 0, 0, 0); acc1 = __builtin_amdgcn_mfma_f32_32x32x2f32(a1[q].x, bw[4 * q + 0], acc1, 0, 0, 0);
                  acc0 = __builtin_amdgcn_mfma_f32_32x32x2f32(a0[q].y, bw[4 * q + 1], acc0, 0, 0, 0); acc1 = __builtin_amdgcn_mfma_f32_32x32x2f32(a1[q].y, bw[4 * q + 1], acc1, 0, 0, 0);
                  acc0 = __builtin_amdgcn_mfma_f32_32x32x2f32(a0[q].z, bw[4 * q + 2], acc0, 0, 0, 0); acc1 = __builtin_amdgcn_mfma_f32_32x32x2f32(a1[q].z, bw[4 * q + 2], acc1, 0, 0, 0);
                  acc0 = __builtin_amdgcn_mfma_f32_32x32x2f32(a0[q].w, bw[4 * q + 3], acc0, 0, 0, 0); acc1 = __builtin_amdgcn_mfma_f32_32x32x2f32(a1[q].w, bw[4 * q + 3], acc1, 0, 0, 0); }
              asm volatile("s_waitcnt lgkmcnt(0)" ::: "memory");
          }
          __syncthreads();
#pragma unroll
          for (int i = 0; i < 16; ++i) { part[((wave * 2 + 0) * 16 + i) * 64 + lane] = acc0[i]; part[((wave * 2 + 1) * 16 + i) * 64 + lane] = acc1[i]; }
        } else __syncthreads();
        __syncthreads();
#pragma unroll
        for (int i = 0; i < 4; ++i) { const int idx = tid + 512 * i; float sum = 0.f;
#pragma unroll
            for (int w = 0; w < 8; ++w) sum += part[w * 2048 + idx];
            const int mt = idx >> 10, rg = (idx >> 6) & 15, l2 = idx & 63, tok = mt * 32 + (rg & 3) + 8 * (rg >> 2) + 4 * (l2 >> 5), e = l2 & 31;
            L[tok * 33 + e] = st[tok * 2 + 1] * (sum - st[tok * 2] * o.CGB[e]) + o.CGB[32 + e]; }
        __syncthreads();
        if (tid < 64 && (mode & 4)) { const LAS float* lr_ = L + tid * 33; int i0 = -1, i1 = -1, i2 = -1, i3 = -1; float v0 = 0.f, v1 = 0.f, v2 = 0.f, v3 = 0.f;
#pragma unroll
            for (int k = 0; k < 4; ++k) { float bv = -INFINITY; int bi = 0;
                for (int e = 0; e < 32; ++e) { const float x = lr_[e]; if (e != i0 && e != i1 && e != i2 && x > bv) { bv = x; bi = e; } }
                if (k == 0) { i0 = bi; v0 = bv; } else if (k == 1) { i1 = bi; v1 = bv; } else if (k == 2) { i2 = bi; v2 = bv; } else { i3 = bi; v3 = bv; } }
            const float e1 = expf(v1 - v0), e2 = expf(v2 - v0), e3 = expf(v3 - v0), inv = 1.f / (1.f + e1 + e2 + e3);
            const size_t t = (size_t)tile * 64 + tid;
            *(pg::f32x4*)(o.gate + t * 4) = (pg::f32x4){inv, e1 * inv, e2 * inv, e3 * inv};
            const int r0 = atomicAdd((int*)(hist + i0), 1), r1 = atomicAdd((int*)(hist + i1), 1), r2 = atomicAdd((int*)(hist + i2), 1), r3 = atomicAdd((int*)(hist + i3), 1);
            asg[tid * 4 + 0] = i0 | (r0 << 8); asg[tid * 4 + 1] = i1 | (r1 << 8); asg[tid * 4 + 2] = i2 | (r2 << 8); asg[tid * 4 + 3] = i3 | (r3 << 8); }
        __syncthreads();
        if (tid < 32) hist[32 + tid] = atomicAdd(&cnt[tid], hist[tid]);
        __syncthreads();
        if (tid < 256) { const int a_ = asg[tid], e = a_ & 255, rank = hist[32 + e] + (a_ >> 8); const int t = tile * 64 + (tid >> 2);
            o.elist[e * T + rank] = t; o.erank[(size_t)t * 4 + (tid & 3)] = (e << 16) | rank; }
    }
    __syncthreads();
}
__device__ __forceinline__ void ph_adapt_route(const OptBufs4& o, const int* start, int* row_tok, int* row_of) {
    const int gt = blockIdx.x * NT + tidf(), ngt = gridDim.x * NT;
    for (int i = gt; i < NA; i += ngt) { const int er = o.erank[i], e = er >> 16, rank = er & 0xffff; const int dest = start[e] + rank; row_tok[dest] = i >> 2; row_of[i] = dest; }
}


struct OptBufs5 { pg::bf16_t *We1T, *We2T, *ACT, *Y; float* B1P; };
constexpr int MOE_TAB_OFF = 131072 + 4096;
__device__ __forceinline__ void moe_build_tab(LAS unsigned char* lds, const int* cnt) {
    LAS int* tab = (LAS int*)(lds + MOE_TAB_OFF);
    __syncthreads();
    if (tidf() == 0) { int s = 0; for (int e = 0; e < NE; ++e) { const int c = cnt[e]; tab[e] = s; tab[40 + e] = c; s += (c + 255) >> 8; } tab[NE] = s; }
    __syncthreads();
}
struct SchedMoE {
    const LAS int* tab; const int* cnt; const int* elist; const char* A; const char* B; size_t eB; int nN, nwg, G, c, gather;
    __device__ __forceinline__ bool next(int i, pg::Unit& u) const {
        const long L = (long)i * G + c; if (L >= nwg) return false;
        int wgid = (int)L; { const int q = nwg / pg::NXCD, r = nwg % pg::NXCD, xcd = wgid % pg::NXCD, off = wgid / pg::NXCD; wgid = (xcd < r ? xcd * (q + 1) : r * (q + 1) + (xcd - r) * q) + off; }
        const int mg = wgid / nN, pn = wgid - mg * nN;
        const int ln = tidf() & 63, tv = tab[ln < NE ? ln : NE];
        const int e = __builtin_amdgcn_readfirstlane(__popcll(__ballot(ln >= 1 && ln < NE && tv <= mg)));
        const int mt = mg - __builtin_amdgcn_readlane(tv, e);
        u.g = e; u.pm = mg; u.pn = pn; u.aux = mg * 256;
        u.B = B + (size_t)e * eB + (size_t)pn * 256 * 1024;
        if (gather) { u.A = A; u.rows = elist + (size_t)e * T + mt * 256; const int rem = __builtin_amdgcn_readfirstlane(tab[40 + e]) - mt * 256; u.nvalid = rem < 256 ? rem : 256; }
        else { u.A = A + (size_t)mg * 256 * 1024; u.rows = nullptr; u.nvalid = 0; }
        return true;
    }
};
struct EpiSwiglu {
    static constexpr bool PERM = true, AFTER_DRAIN = false, BIAS = true;
    unsigned char* ACT; const float* B1P;
    __device__ __forceinline__ const float* bias_base(const pg::Unit& u) const { return B1P + u.g * 2048 + u.pn * 256; }
    __device__ __forceinline__ void operator()(const pg::f32x4 (&acc)[2][2][4][2], const pg::Unit& u, int wr, int wc, int fr, int fq) const {
        const int col0 = wc * 32 + 8 * fq;
        unsigned char* base = ACT + (size_t)(u.aux + wr * 64 + fr) * 1024 + u.pn * 128 + col0;
#pragma unroll
        for (int ai = 0; ai < 2; ++ai)
#pragma unroll
            for (int m = 0; m < 4; ++m) { float r[8];
#pragma unroll
                for (int j = 0; j < 8; ++j) { float g = (j < 4) ? acc[ai][0][m][0][j] : acc[ai][0][m][1][j - 4];
                    float l = (j < 4) ? acc[ai][1][m][0][j] : acc[ai][1][m][1][j - 4];
                    g = fminf(g, 7.f); l = fminf(fmaxf(l, -7.f), 7.f);
                    r[j] = g * (l + 1.f) * __builtin_amdgcn_rcpf(1.f + __expf(-1.702f * g)); }
                { int w0 = __builtin_amdgcn_cvt_pk_fp8_f32(r[0], r[1], 0, false); w0 = __builtin_amdgcn_cvt_pk_fp8_f32(r[2], r[3], w0, true);
                  int w1 = __builtin_amdgcn_cvt_pk_fp8_f32(r[4], r[5], 0, false); w1 = __builtin_amdgcn_cvt_pk_fp8_f32(r[6], r[7], w1, true);
                  *(pg::u32x2*)(base + (size_t)(ai * 128 + m * 16) * 1024) = (pg::u32x2){(unsigned)w0, (unsigned)w1}; }
                asm volatile("" ::: "memory"); }
    }
};
struct EpiY {
    static constexpr bool PERM = true, AFTER_DRAIN = false, BIAS = true;
    unsigned char* Y; const float* b2;
    __device__ __forceinline__ const float* bias_base(const pg::Unit& u) const { return b2 + u.g * 1024 + u.pn * 256; }
    __device__ __forceinline__ void operator()(const pg::f32x4 (&acc)[2][2][4][2], const pg::Unit& u, int wr, int wc, int fr, int fq) const {
        unsigned char* base = Y + (size_t)(u.aux + wr * 64 + fr) * 1024 + u.pn * 256 + (wc * 4 + fq) * 16;
#pragma unroll
        for (int ai = 0; ai < 2; ++ai)
#pragma unroll
            for (int m = 0; m < 4; ++m) { pg::u32x4 w;
                { const pg::f32x4 v0 = acc[ai][0][m][0] * 16.f, v1 = acc[ai][0][m][1] * 16.f;
                  int p = __builtin_amdgcn_cvt_pk_fp8_f32(v0[0], v0[1], 0, false); p = __builtin_amdgcn_cvt_pk_fp8_f32(v0[2], v0[3], p, true); w.x = (unsigned)p;
                  p = __builtin_amdgcn_cvt_pk_fp8_f32(v1[0], v1[1], 0, false); p = __builtin_amdgcn_cvt_pk_fp8_f32(v1[2], v1[3], p, true); w.y = (unsigned)p; }
                { const pg::f32x4 v0 = acc[ai][1][m][0] * 16.f, v1 = acc[ai][1][m][1] * 16.f;
                  int p = __builtin_amdgcn_cvt_pk_fp8_f32(v0[0], v0[1], 0, false); p = __builtin_amdgcn_cvt_pk_fp8_f32(v0[2], v0[3], p, true); w.z = (unsigned)p;
                  p = __builtin_amdgcn_cvt_pk_fp8_f32(v1[0], v1[1], 0, false); p = __builtin_amdgcn_cvt_pk_fp8_f32(v1[2], v1[3], p, true); w.w = (unsigned)p; }
                *(pg::u32x4*)(base + (size_t)(ai * 128 + m * 16) * 1024) = w; asm volatile("" ::: "memory"); }
    }
};
struct EpiNull { static constexpr bool PERM = true, AFTER_DRAIN = false, BIAS = false;
    float* sink;
    __device__ __forceinline__ void operator()(const pg::f32x4 (&acc)[2][2][4][2], const pg::Unit& u, int wr, int wc, int fr, int fq) const {
        float s_ = 0.f;
#pragma unroll
        for (int ai = 0; ai < 2; ++ai)
#pragma unroll
            for (int bj = 0; bj < 2; ++bj)
#pragma unroll
                for (int m = 0; m < 4; ++m)
#pragma unroll
                    for (int n = 0; n < 2; ++n) s_ += acc[ai][bj][m][n][0];
        if (s_ == 1.2345e30f) sink[0] = s_; } };
__device__ __forceinline__ void ph_moe1_probe(LAS unsigned char* lds, const OptBufs4& o4, const OptBufs5& o5, const int* cnt, int mode, unsigned char* dummy) {
    moe_build_tab(lds, cnt);
    SchedMoE S; S.tab = (const LAS int*)(lds + MOE_TAB_OFF); S.cnt = cnt; S.elist = o4.elist; S.A = (const char*)o4.H1Q; S.B = (const char*)o5.We1T; S.eB = (size_t)2048 * 1024;
    S.nN = 8; S.nwg = __builtin_amdgcn_readfirstlane(S.tab[NE]) * 8; S.G = gridDim.x; S.c = blockIdx.x; S.gather = 1;
    if (mode == 0) { EpiSwiglu E{dummy, o5.B1P}; pg::gemm_phase<EpiSwiglu, SchedMoE, true, true>(lds, 512, 512, 512, S, E); }
    if (mode == 1) { S.gather = 0; S.A = (const char*)o5.ACT; EpiSwiglu E{dummy, o5.B1P}; pg::gemm_phase<EpiSwiglu, SchedMoE, false, true>(lds, 512, 512, 512, S, E); }
    if (mode == 2) { EpiNull E{(float*)dummy}; pg::gemm_phase<EpiNull, SchedMoE, true, true>(lds, 512, 512, 512, S, E); }
    if (mode == 3) { S.gather = 0; S.A = (const char*)o5.ACT; EpiNull E{(float*)dummy}; pg::gemm_phase<EpiNull, SchedMoE, false, true>(lds, 512, 512, 512, S, E); }
}
__device__ __forceinline__ void ph_moe1(LAS unsigned char* lds, const OptBufs4& o4, const OptBufs5& o5, const int* cnt) {
    moe_build_tab(lds, cnt);
    SchedMoE S; S.tab = (const LAS int*)(lds + MOE_TAB_OFF); S.cnt = cnt; S.elist = o4.elist; S.A = (const char*)o4.H1Q; S.B = (const char*)o5.We1T; S.eB = (size_t)2048 * 1024;
    S.nN = 8; S.nwg = __builtin_amdgcn_readfirstlane(S.tab[NE]) * 8; S.G = gridDim.x; S.c = blockIdx.x; S.gather = 1;
    EpiSwiglu E{(unsigned char*)o5.ACT, o5.B1P}; pg::gemm_phase<EpiSwiglu, SchedMoE, true, true>(lds, 512, 512, 512, S, E);
}
__device__ __forceinline__ void ph_moe2(LAS unsigned char* lds, const OptBufs5& o5, const int* cnt, const float* b_e2) {
    moe_build_tab(lds, cnt);
    SchedMoE S; S.tab = (const LAS int*)(lds + MOE_TAB_OFF); S.cnt = cnt; S.elist = nullptr; S.A = (const char*)o5.ACT; S.B = (const char*)o5.We2T; S.eB = (size_t)1024 * 1024;
    S.nN = 4; S.nwg = __builtin_amdgcn_readfirstlane(S.tab[NE]) * 4; S.G = gridDim.x; S.c = blockIdx.x; S.gather = 0;
    EpiY E{(unsigned char*)o5.Y, b_e2}; pg::gemm_phase<EpiY, SchedMoE, false, true>(lds, 512, 512, 512, S, E);
}
__device__ __forceinline__ void ph_final_opt(LAS unsigned char* lds, const OptBufs4& o4, const OptBufs5& o5, const int* cnt, const float* g, const float* beta, float* out) {
    moe_build_tab(lds, cnt);
    const LAS int* tab = (const LAS int*)(lds + MOE_TAB_OFF);
    const int tid = tidf(), lane = tid & 63, gw = blockIdx.x * NW + (tid >> 6), ngw = gridDim.x * NW;
    const int cbase = (lane >> 4) * 256 + ((lane >> 2) & 3) * 32 + (lane & 3) * 8;
    const unsigned char* Y8 = (const unsigned char*)o5.Y;
    for (int t = gw; t < T; t += ngw) {
        float v[16];
        { float h[8]; ld8(o4.H1B + (size_t)t * D + cbase, h);
#pragma unroll
          for (int j = 0; j < 8; ++j) v[j] = h[j] * ALPHA;
          ld8(o4.H1B + (size_t)t * D + cbase + 128, h);
#pragma unroll
          for (int j = 0; j < 8; ++j) v[8 + j] = h[j] * ALPHA; }
#pragma unroll
        for (int k = 0; k < 4; ++k) { const int er = o4.erank[(size_t)t * 4 + k]; const float gk = o4.gate[(size_t)t * 4 + k] * 0.0625f;
            const pg::u32x4 w = *(const pg::u32x4*)(Y8 + (size_t)(tab[er >> 16] * 256 + (er & 0xffff)) * 1024 + lane * 16);
            float f[4];
            fp8x4_to_f32(w.x, f); v[0] += gk * f[0]; v[1] += gk * f[1]; v[2] += gk * f[2]; v[3] += gk * f[3];
            fp8x4_to_f32(w.y, f); v[4] += gk * f[0]; v[5] += gk * f[1]; v[6] += gk * f[2]; v[7] += gk * f[3];
            fp8x4_to_f32(w.z, f); v[8] += gk * f[0]; v[9] += gk * f[1]; v[10] += gk * f[2]; v[11] += gk * f[3];
            fp8x4_to_f32(w.w, f); v[12] += gk * f[0]; v[13] += gk * f[1]; v[14] += gk * f[2]; v[15] += gk * f[3]; }
        float s_ = 0.f;
#pragma unroll
        for (int j = 0; j < 16; ++j) s_ += v[j];
        const float mean = wsum(s_) * (1.f / D); float s2 = 0.f;
#pragma unroll
        for (int j = 0; j < 16; ++j) { v[j] -= mean; s2 += v[j] * v[j]; }
        const float rstd = rsqrtf(wsum(s2) * (1.f / D) + LN_EPS);
#pragma unroll
        for (int run = 0; run < 2; ++run)
#pragma unroll
            for (int q = 0; q < 2; ++q) { const int c0 = cbase + run * 128 + q * 4;
                const pg::f32x4 gg = *(const pg::f32x4*)(g + c0), bb = *(const pg::f32x4*)(beta + c0);
                pg::f32x4 y; y.x = v[run * 8 + q * 4 + 0] * rstd; y.y = v[run * 8 + q * 4 + 1] * rstd; y.z = v[run * 8 + q * 4 + 2] * rstd; y.w = v[run * 8 + q * 4 + 3] * rstd;
                *(pg::f32x4*)(out + (size_t)t * D + c0) = y * gg + bb; }
    }
}

__device__ __forceinline__ void ph_adapt1(const OptBufs& o, const float* b_if, float* proj) {
    const size_t gt = (size_t)blockIdx.x * NT + tidf(), ngt = (size_t)gridDim.x * NT;
    for (size_t i = gt; i < (size_t)T * INC; i += ngt) {
        const int c = (int)(i % INC); const int t = (int)(i / INC);
        float v;
        if (c < C_V) v = bf2f(o.PROJ[(size_t)t * PROJW + c]);
        else if (c < C_O) { const int e = c - C_V, h = e >> 8, el = e & 255, b = t >> 12, cc = (t & 4095) >> 8, tl = t & 255;
            v = bf2f(o.BT2[((size_t)((b * 4 + h) * 16 + cc) * 256 + el) * 512 + tl]); }
        else if (c < C_IF) v = bf2f(o.PROJ[(size_t)t * PROJW + c - 1024]);
        else if (c < C_G) v = o.gif[(size_t)t * 8 + (c - C_IF)] - b_if[c - C_IF];
        else v = bf2f(o.PROJ[(size_t)t * PROJW + c - C_G + PJ_G]);
        proj[i] = v;
    }
}

struct PrepSrc { const float *w_in, *w_q, *w_k, *w_pool, *w_bp, *w_bm, *w_out, *w_e1, *w_e2, *b_e1; };
constexpr int TI_E1 = 16384, TI_E2 = 8192, TI_IN = (WIN_ROWS / 64) * 16, TI_MO = 512, TI_QK = 128, TI_BP = 128, TI_PL = 16;
constexpr int TI_TOTAL = TI_E1 + TI_E2 + TI_IN + TI_MO + TI_QK + TI_BP + TI_PL;
__device__ __forceinline__ TItem titem_decode(int it, const PrepSrc& p, const OptBufs& ob, const OptBufs2& o2, const OptBufs4& o4, const OptBufs5& o5) {
    TItem t; t.inter = 0; t.fp8 = 0; t.valid = it < TI_TOTAL; t.src = p.w_in; t.dst = ob.WinT; t.ldw = 64; t.ldt = 64;
    if (!t.valid) return t;
    if (it < TI_E1) { const int nb = it & 31, kb = (it >> 5) & 15, e = it >> 9, j0 = nb * 32, pn = j0 >> 7, jj0 = j0 & 127;
        t.src = p.w_e1 + (size_t)e * 1024 * 2048 + (size_t)(kb * 64) * 2048 + nb * 64; t.dst = (pg::bf16_t*)((unsigned char*)o5.We1T + (size_t)e * 2048 * 1024 + (size_t)(pn * 256 + jj0) * 1024 + kb * 64); t.ldw = 2048; t.ldt = 1024; t.inter = 1; t.fp8 = 1; return t; }
    it -= TI_E1;
    if (it < TI_E2) { const int nb = it & 15, kb = (it >> 4) & 15, e = it >> 8;
        t.src = p.w_e2 + (size_t)e * 1024 * 1024 + (size_t)(kb * 64) * 1024 + nb * 64; t.dst = (pg::bf16_t*)((unsigned char*)o5.We2T + (size_t)e * 1024 * 1024 + (size_t)(nb * 64) * 1024 + kb * 64); t.ldw = 1024; t.ldt = 1024; t.fp8 = 1; return t; }
    it -= TI_E2;
    if (it < TI_IN) { const int rb = it >> 4, kb = it & 15;
        t.src = p.w_in + (size_t)(kb * 64) * INC + win_src_col(rb * 64); t.ldw = INC; t.ldt = D;
        if (rb * 64 >= PJ_O && rb * 64 < PROJW) { t.dst = (pg::bf16_t*)(ob.WinQ + (size_t)(rb * 64 - PJ_O) * D + kb * 64); t.fp8 = 1; }
        else t.dst = ob.WinT + (size_t)(rb * 64) * D + kb * 64;
        return t; }
    it -= TI_IN;
    if (it < TI_MO) { const int which = it >> 8, r = it & 255, nb = r >> 4, kb = r & 15;
        t.src = (which ? p.w_out : p.w_bm) + (size_t)(kb * 64) * 1024 + nb * 64; t.dst = (which ? o4.WoutT : o4.WbmT) + (size_t)(nb * 64) * 1024 + kb * 64; t.ldw = 1024; t.ldt = 1024; return t; }
    it -= TI_MO;
    if (it < TI_QK) { const int which = it >> 6, r = it & 63, h = r >> 4, nb = (r & 15) >> 2, kb = r & 3;
        t.src = (which ? p.w_k : p.w_q) + (size_t)h * 65536 + (size_t)(kb * 64) * 256 + nb * 64; t.dst = (which ? o2.WkT : o2.WqT) + (size_t)h * 65536 + (size_t)(nb * 64) * 256 + kb * 64; t.ldw = 256; t.ldt = 256; return t; }
    it -= TI_QK;
    if (it < TI_BP) { const int nb = it >> 3, kb = it & 7;
        t.src = p.w_bp + (size_t)(kb * 64) * 1024 + nb * 64; t.dst = o2.WbpT + (size_t)(nb * 64) * 512 + kb * 64; t.ldw = 1024; t.ldt = 512; return t; }
    it -= TI_BP;
    { const int g = it >> 2, nb = (it & 3) >> 1, kb = it & 1;
        t.src = p.w_pool + (size_t)g * 16384 + (size_t)(kb * 64) * 128 + nb * 64; t.dst = o2.WpoolT + (size_t)(g * 128 + nb * 64) * 512 + g * 128 + kb * 64; t.ldw = 128; t.ldt = 512; return t; }
}
__device__ __forceinline__ void ph_prep_all(LAS unsigned char* lds, const PrepSrc& p, const OptBufs& ob, const OptBufs2& o2, const OptBufs4& o4, const OptBufs5& o5) {
    const int tid = tidf(), lane = tid & 63, wave = tid >> 6, gw = blockIdx.x * NW + wave, ngw = gridDim.x * NW;
    LAS float* scr = (LAS float*)(lds + wave * 16384);
    int it = gw; TItem cur = titem_decode(it, p, ob, o2, o4, o5);
    pg::f32x4 r[16];
    if (cur.valid) titem_load(cur, r, lane);
    while (cur.valid) {
        const int nx = it + ngw; const TItem nxt = titem_decode(nx, p, ob, o2, o4, o5);
        pg::f32x4 rn[16];
        if (nxt.valid) titem_load(nxt, rn, lane);
        titem_store(cur, r, scr, lane);
#pragma unroll
        for (int i = 0; i < 16; ++i) r[i] = rn[i];
        cur = nxt; it = nx;
    }
    { const size_t gt = (size_t)blockIdx.x * NT + tid, ngt = (size_t)gridDim.x * NT;
      for (size_t ch = gt; ch < 512 * 64; ch += ngt) { const int n = (int)(ch >> 6), k8 = (int)(ch & 63) * 8; if ((n >> 7) != (k8 >> 7)) *(pg::u32x4*)(o2.WpoolT + (size_t)n * 512 + k8) = (pg::u32x4){0u, 0u, 0u, 0u}; } }
    for (int i = blockIdx.x * NT + tid; i < 32 * 2048; i += gridDim.x * NT) { const int e = i >> 11, rr = i & 2047, pn = rr >> 8, bj = (rr >> 7) & 1, jj = rr & 127; o5.B1P[i] = p.b_e1[e * 2048 + 2 * (pn * 128 + jj) + bj]; }
}

struct Args { const float* in[26]; float* out; unsigned char* ws; int ph_lo, ph_hi; };
constexpr size_t MiB = 1u << 20;
constexpr size_t WS_CTL = 0;
constexpr size_t CTL_ZERO_BYTES = 1 * MiB;
constexpr int CW_BAR = 4096;
constexpr int CW_CNT = 16384, CW_START = 16384 + 64, CW_FILL = 16384 + 128;

__global__ void __launch_bounds__(NT, 2) mk_fwd(Args a) {
    extern __shared__ __attribute__((aligned(16))) unsigned char lds_raw[];
    LAS unsigned char* lds = (LAS unsigned char*)lds_raw;
    volatile LAS unsigned* MISC = (volatile LAS unsigned*)(lds + MISC_OFF);
    const int tid = tidf();
    if (tid < 32) MISC[tid] = 0u;
    __syncthreads();
    unsigned char* ws = a.ws;
    unsigned* ctl = (unsigned*)(ws + WS_CTL);
    XcdBarrier bar = xcd_barrier_post(ctl + CW_BAR, MISC + 8);
    const float* x = a.in[0]; const float* ln0_g = a.in[1]; const float* ln0_b = a.in[2];
    const float* w_in = a.in[3]; const float* conv_w = a.in[4]; const float* conv_b = a.in[5];
    const float* w_q = a.in[6]; const float* w_k = a.in[7]; const float* b_if = a.in[8];
    const float* mh_gain = a.in[9]; const float* w_pool = a.in[10]; const float* b_pool = a.in[11];
    const float* ls_pool = a.in[12]; const float* w_bp = a.in[13]; const float* w_bm = a.in[14];
    const float* w_out = a.in[15]; const float* ln1_g = a.in[16]; const float* ln1_b = a.in[17];
    const float* w_router = a.in[18]; const float* b_router = a.in[19]; const float* w_e1 = a.in[20];
    const float* b_e1 = a.in[21]; const float* w_e2 = a.in[22]; const float* b_e2 = a.in[23];
    const float* ln2_g = a.in[24]; const float* ln2_b = a.in[25];
    OptBufs ob; ob.WinT = (pg::bf16_t*)(ws + 8 * MiB); ob.H0B = (pg::bf16_t*)(ws + 220 * MiB); ob.PROJ = (pg::bf16_t*)(ws + 252 * MiB); ob.BT2 = (pg::bf16_t*)(ws + 396 * MiB);
    ob.gif = (float*)(ws + 1 * MiB); ob.stats = (float*)(ws + 1 * MiB + 512 * 1024); ob.WinQ = (unsigned char*)(ws + 214 * MiB); ob.H0Q = (unsigned char*)(ws + 972 * MiB); ob.OGQ = (unsigned char*)(ws + 300 * MiB);
    OptBufs2 o2; o2.WqT = (pg::bf16_t*)(ws + 19 * MiB); o2.WkT = (pg::bf16_t*)(ws + 19 * MiB + 512 * 1024); o2.WpoolT = (pg::bf16_t*)(ws + 20 * MiB); o2.WbpT = (pg::bf16_t*)(ws + 20 * MiB + 512 * 1024);
    o2.POOLED = (pg::bf16_t*)(ws + 460 * MiB); o2.UC = (pg::bf16_t*)(ws + 476 * MiB); o2.MIXED = (pg::bf16_t*)(ws + 508 * MiB); o2.Q = (pg::bf16_t*)(ws + 524 * MiB); o2.K = (pg::bf16_t*)(ws + 556 * MiB);
    o2.YPOOL = (pg::bf16_t*)(ws + 748 * MiB);
    OptBufs3 o3; o3.KaT = (pg::bf16_t*)(ws + 588 * MiB); o3.A2 = (pg::bf16_t*)(ws + 620 * MiB); o3.U = (float*)(ws + 684 * MiB); o3.HOUT = (pg::bf16_t*)(ws + 780 * MiB);
    { float* sm = (float*)(ws + 2 * MiB); o3.rowv = sm; o3.colv = sm + 65536; o3.winter = sm + 2 * 65536; o3.aw = sm + 3 * 65536; o3.emt = sm + 4 * 65536; o3.den = sm + 5 * 65536; o3.un = sm + 6 * 65536; o3.decay = sm + 7 * 65536; }
    OptBufs4 o4; o4.WbmT = (pg::bf16_t*)(ws + 21 * MiB + 512 * 1024); o4.WoutT = (pg::bf16_t*)(ws + 23 * MiB + 512 * 1024); o4.MERGED = (pg::bf16_t*)(ws + 812 * MiB); o4.Z = (float*)(ws + 844 * MiB); o4.H1B = (pg::bf16_t*)(ws + 908 * MiB); o4.H1Q = (unsigned char*)(ws + 940 * MiB); o4.WRP = (float*)(ws + 7 * MiB + 512 * 1024); o4.CGB = (float*)(ws + 7 * MiB + 768 * 1024);
    o4.elist = (int*)(ws + 4 * MiB); o4.erank = (int*)(ws + 6 * MiB); o4.gate = (float*)(ws + 6 * MiB + 256 * 1024);
    OptBufs5 o5; o5.We1T = (pg::bf16_t*)(ws + 26 * MiB); o5.We2T = (pg::bf16_t*)(ws + 154 * MiB); o5.B1P = (float*)(ws + 7 * MiB);
    o5.ACT = (pg::bf16_t*)(ws + 252 * MiB);
    o5.Y = (pg::bf16_t*)(ws + 396 * MiB);
    int* cnt = (int*)ctl + CW_CNT;
    LAS float* ldsf = (LAS float*)lds;
    const int G = gridDim.x, bx = blockIdx.x;
#define IN(k) (a.ph_lo <= (k) && (k) < a.ph_hi)
#define SEAM(k) do { if (IN(k) && IN((k) + 1)) xcd_barrier(bar); } while (0)
    if (IN(0)) { PrepSrc ps{w_in, w_q, w_k, w_pool, w_bp, w_bm, w_out, w_e1, w_e2, b_e1}; ph_prep_all(lds, ps, ob, o2, o4, o5); ph_router_prep(o4, ln1_g, ln1_b, w_router, b_router); ph_ln0(lds, ob, x, ln0_g, ln0_b, w_in, b_if);
#if PROBE_PH == 0
        { xcd_barrier(bar); if (PROBE_MODE & 1) ph_prep_all(lds, ps, ob, o2, o4, o5); if (PROBE_MODE & 2) ph_ln0(lds, ob, x, ln0_g, ln0_b, w_in, b_if); }
#endif
    }
    SEAM(0);
    if (IN(1)) ph_inproj(lds, ob);
    SEAM(1);
    if (IN(2)) { if (bx >= G - 16) scalar_scan_wg(lds, bx - (G - 16), ob.gif, o3);
                 for (int i = bx * NT + tid; i < T * 4; i += G * NT) o3.den[i] = 0.f;
                 ph_poolconv_opt(ob.PROJ, conv_w, conv_b, o2.POOLED, o2.UC); }
    SEAM(2);
    if (IN(3)) ph_gemms_D(lds, o2, o3, b_pool, ls_pool);
    SEAM(3);
    if (IN(4)) { ph_gemm_ypool(lds, o2); ph_gemms_E(lds, ob, o2, o3);
#if PROBE_PH == 4
        { xcd_barrier(bar); OptBufs3 d3 = o3; d3.den = (float*)(ws + 980 * MiB); ph_gemm_ypool(lds, o2); ph_gemms_E(lds, ob, o2, d3); }
#endif
    }
    SEAM(4);
    if (IN(5)) { ph_state_scan(ob, o3); ph_den_inter(lds, o3);
#if PROBE_PH == 5
        { xcd_barrier(bar); OptBufs3 d3 = o3; d3.den = (float*)(ws + 980 * MiB); ph_state_scan(ob, d3); ph_den_inter(lds, d3); }
#endif
    }
    SEAM(5);
    if (IN(6)) ph_gemm_G3(lds, ob, o3, mh_gain);
    SEAM(6);
    if (IN(7)) ph_gemm_ymls(lds, ob, o2, o3, o4);
    SEAM(7);
    if (IN(8)) ph_gemm_mix(lds, ob, o4, x, ln0_g, ln0_b);
    SEAM(8);
    if (IN(9)) { ph_ln1_router(lds, o4, o4.Z, ln1_g, ln1_b, cnt);
#if PROBE_PH == 9
        { xcd_barrier(bar); OptBufs4 d4 = o4; d4.Z = (float*)(ws + 684 * MiB); d4.H1B = (pg::bf16_t*)(ws + 588 * MiB); d4.H1Q = (unsigned char*)(ws + 620 * MiB); d4.elist = (int*)(ws + 980 * MiB); d4.erank = (int*)(ws + 984 * MiB); d4.gate = (float*)(ws + 986 * MiB);
          ph_ln1_router(lds, d4, o4.Z, ln1_g, ln1_b, cnt + 256, PROBE_MODE); }
#endif
    }
    SEAM(9);
    if (IN(10)) { ph_moe1(lds, o4, o5, cnt);
#if PROBE_PH == 10
        { xcd_barrier(bar); ph_moe1_probe(lds, o4, o5, cnt, PROBE_MODE, (unsigned char*)(ws + 956 * MiB)); }
#endif
    }
    SEAM(10);
    if (IN(11)) ph_moe2(lds, o5, cnt, b_e2);
    SEAM(11);
    if (IN(12)) { ph_final_opt(lds, o4, o5, cnt, ln2_g, ln2_b, a.out);
#if PROBE_PH == 12
        { xcd_barrier(bar); ph_final_opt(lds, o4, o5, cnt, ln2_g, ln2_b, a.out); }
#endif
    }
}
constexpr int NPH = 13;
}

extern "C" void kernel_launch(void* const* d_in, const int* in_sizes, int n_in, void* d_out, int out_size, void* d_ws, size_t ws_size, hipStream_t stream) {
    using namespace mk;
    static int grid = 0;
    if (grid == 0) {
        if (n_in != 26 || ws_size < 1000 * MiB) { fprintf(stderr, "kernel_launch: unexpected n_in %d / ws %zu\n", n_in, ws_size); grid = -1; return; }
        int dev = 0, cus = 0, per_cu = 0;
        hipGetDevice(&dev); hipDeviceGetAttribute(&cus, hipDeviceAttributeMultiprocessorCount, dev);
        if (hipFuncSetAttribute((const void*)mk_fwd, hipFuncAttributeMaxDynamicSharedMemorySize, LDS_BYTES) != hipSuccess) { fprintf(stderr, "hipFuncSetAttribute failed\n"); grid = -1; return; }
        if (hipOccupancyMaxActiveBlocksPerMultiprocessor(&per_cu, (const void*)mk_fwd, NT, LDS_BYTES) != hipSuccess || per_cu < 1) { fprintf(stderr, "occupancy query failed (%d)\n", per_cu); grid = -1; return; }
        grid = cus * 1;
        fprintf(stderr, "kernel_launch: cus %d per_cu %d grid %d\n", cus, per_cu, grid);
    }
    if (grid < 0) return;
    hipMemsetAsync((char*)d_ws + WS_CTL, 0, CTL_ZERO_BYTES, stream);
    Args a{};
    for (int i = 0; i < 26; ++i) a.in[i] = (const float*)d_in[i];
    a.out = (float*)d_out; a.ws = (unsigned char*)d_ws; a.ph_lo = 0; a.ph_hi = NPH;
    void* args[] = {&a};
    hipError_t e = hipLaunchCooperativeKernel((const void*)mk_fwd, dim3(grid), dim3(NT), args, LDS_BYTES, stream);
    if (e != hipSuccess) fprintf(stderr, "cooperative launch failed: %s (grid %d)\n", hipGetErrorString(e), grid);
}
```

```cpp
#include <hip/hip_runtime.h>
#include <cstdio>
#include <cstdint>

#define LAS __attribute__((address_space(3)))
#ifndef PROBE_PH
#define PROBE_PH -1
#endif
#define PROBE_MODE 7
namespace mk {
constexpr int D = 1024, BATCH = 4, SEQ = 4096, T = BATCH * SEQ;
constexpr int INC = 5640;
constexpr int C_P = 0, C_U = 512, C_V = 1536, C_O = 2560, C_IF = 3584, C_G = 3592;
constexpr int NE = 32, TOPK = 4, NA = T * TOPK;
constexpr float LN_EPS = 1e-5f;
constexpr float ALPHA = 1.189207115002721f;
constexpr int NT = 512, NW = 8;
constexpr int LDS_BYTES = 147456, MISC_OFF = 147456 - 512;

#define XB_TMO      128
#define XB_XCNT(j)  (256  + 64 * (j))
#define XB_XSUB(j)  (1280 + 64 * (j))
#define XB_XGEN(j)  (2304 + 64 * (j))
#define XB_TOP      3328
#define XB_TOPGEN   3392
#define XCD_BAR_WORDS 3456
#define XB_SPIN_CAP (1u << 22)
__device__ __forceinline__ unsigned xb_ld(unsigned* p)              { return __hip_atomic_load(p, __ATOMIC_RELAXED, __HIP_MEMORY_SCOPE_AGENT); }
__device__ __forceinline__ unsigned xb_add(unsigned* p, unsigned v) { return __hip_atomic_fetch_add(p, v, __ATOMIC_RELAXED, __HIP_MEMORY_SCOPE_AGENT); }
__device__ __forceinline__ unsigned xb_xcc_id() { return (unsigned)__builtin_amdgcn_s_getreg((3 << 11) | 20) & 0xFu; }
#define XB_SPIN(cond, bar) do { unsigned _sp = 0; while (cond) { __builtin_amdgcn_s_sleep(1); \
    if ((++_sp & 255u) == 0u) { if (xb_ld(&(bar)[XB_TMO])) break; if (_sp > XB_SPIN_CAP) { atomicAdd(&(bar)[XB_TMO], 1u); break; } } } } while (0)
struct XcdBarrier { unsigned* bar; unsigned x; volatile LAS unsigned* st; };
__device__ __forceinline__ XcdBarrier xcd_barrier_post(unsigned* bar, volatile LAS unsigned* st) {
    XcdBarrier b; b.bar = bar; b.x = xb_xcc_id(); b.st = st;
    if (threadIdx.x == 0) (void)xb_add(&bar[XB_XCNT(b.x)], 1u);
    return b;
}
__device__ __forceinline__ void xcd_barrier_complete(unsigned* bar, unsigned x, unsigned& nloc, unsigned& nx) {
    const unsigned G = gridDim.x * gridDim.y * gridDim.z;
    unsigned sum, cnt, mine, sp = 0u;
    for (;;) {
        sum = 0u; cnt = 0u; mine = 0u;
#pragma unroll
        for (unsigned j = 0; j < 16; ++j) { const unsigned c = xb_ld(&bar[XB_XCNT(j)]); sum += c; cnt += (c > 0u) ? 1u : 0u; mine = (j == x) ? c : mine; }
        if (sum == G) break;
        __builtin_amdgcn_s_sleep(1);
        if ((++sp & 255u) == 0u) { if (xb_ld(&bar[XB_TMO])) break; if (sp > XB_SPIN_CAP) { atomicAdd(&bar[XB_TMO], 1u); break; } }
    }
    nloc = mine > 0u ? mine : 1u; nx = cnt > 0u ? cnt : 1u;
}
__device__ __forceinline__ void xcd_barrier(const XcdBarrier& b) {
    asm volatile("s_waitcnt vmcnt(0)" ::: "memory");
    __syncthreads();
    if (threadIdx.x == 0) {
        unsigned* bar = b.bar;
        __builtin_amdgcn_s_waitcnt(0);
        unsigned nloc = b.st[0], nx = b.st[1];
        if (nloc == 0u) { xcd_barrier_complete(bar, b.x, nloc, nx); b.st[0] = nloc; b.st[1] = nx; }
        const unsigned old = xb_add(&bar[XB_XSUB(b.x)], 1u);
        const unsigned gen = old / nloc;
        if (old + 1u == (gen + 1u) * nloc) {
            __builtin_amdgcn_fence(__ATOMIC_RELEASE, "agent");
            asm volatile("s_waitcnt vmcnt(0)" ::: "memory");
            const unsigned og = xb_add(&bar[XB_TOP], 1u);
            const unsigned tg = og / nx;
            if (og + 1u == (tg + 1u) * nx) xb_add(&bar[XB_TOPGEN], 1u);
            else XB_SPIN(xb_ld(&bar[XB_TOPGEN]) == tg, bar);
            __builtin_amdgcn_fence(__ATOMIC_ACQUIRE, "agent");
            xb_add(&bar[XB_XGEN(b.x)], 1u);
            asm volatile("s_waitcnt vmcnt(0)" ::: "memory");
        } else {
            XB_SPIN(xb_ld(&bar[XB_XGEN(b.x)]) == gen, bar);
            __builtin_amdgcn_fence(__ATOMIC_ACQUIRE, "agent");
            asm volatile("s_waitcnt vmcnt(0)" ::: "memory");
        }
    }
    __syncthreads();
}

__device__ __forceinline__ int tidf() { int t = threadIdx.x; asm volatile("" : "+v"(t)); return t; }
__device__ __forceinline__ float wsum(float v) {
#pragma unroll
    for (int o = 1; o < 64; o <<= 1) v += __shfl_xor(v, o);
    return v;
}
__device__ __forceinline__ float sigmoidf_(float x) { return 1.f / (1.f + expf(-x)); }
__device__ __forceinline__ float fsigmoid(float x) { return __builtin_amdgcn_rcpf(1.f + __expf(-x)); }

namespace pg {
typedef unsigned short bf16_t;
typedef short bf16x8 __attribute__((ext_vector_type(8)));
typedef float f32x4 __attribute__((ext_vector_type(4)));
typedef float f32x2 __attribute__((ext_vector_type(2)));
typedef unsigned u32x4 __attribute__((ext_vector_type(4)));
typedef unsigned u32x2 __attribute__((ext_vector_type(2)));
constexpr int BM = 256, BK = 64, HALF = 128, HTB = HALF * BK * 2, STAGE_BYTES = 8 * HTB, NXCD = 8, WGM = 8;
__host__ __device__ __forceinline__ int lds_byte(int r, int c) { const int st = (r >> 4) * 2 + (c >> 5), rr = r & 15, cc = c & 31, ob = rr * 64 + cc * 2; return st * 1024 + (ob ^ (((ob >> 9) & 1) << 5)); }
__host__ __device__ __forceinline__ void stage_rc(int b, int& R, int& C) { const int st = b / 1024, sb = b % 1024, swz = sb ^ (((sb >> 9) & 1) << 5); R = (st >> 1) * 16 + swz / 64; C = (st & 1) * 32 + (swz % 64) / 2; }
__host__ __device__ __forceinline__ int perm32(int rho) { const int n = rho >> 4, i = rho & 15; return 8 * (i >> 2) + 4 * n + (i & 3); }
__device__ __forceinline__ unsigned cvt_pk_bf16(float lo, float hi) { unsigned r; asm volatile("v_cvt_pk_bf16_f32 %0, %1, %2" : "=v"(r) : "v"(lo), "v"(hi)); return r; }

struct Unit { const char* A; const char* B; const int* rows; int nvalid; int pm, pn, g, aux; };

struct TileOrder {
    int nM, nN, per_g, nwg, G, c;
    __device__ __forceinline__ void init(int nM_, int nN_, int ng, int G_, int c_) { nM = nM_; nN = nN_; per_g = nM * nN; nwg = per_g * ng; G = G_; c = c_; }
    __device__ __forceinline__ bool tile(int i, int& g, int& pm, int& pn) const {
        const long L = (long)i * G + c; if (L >= nwg) return false;
        int wgid = (int)L; { const int q = nwg / NXCD, r = nwg % NXCD, xcd = wgid % NXCD, off = wgid / NXCD; wgid = (xcd < r ? xcd * (q + 1) : r * (q + 1) + (xcd - r) * q) + off; }
        g = wgid / per_g; wgid -= g * per_g;
        const int nig = WGM * nN, gid = wgid / nig, fm = gid * WGM, gsz = (nM - fm) < WGM ? (nM - fm) : WGM;
        pm = fm + ((wgid % nig) % gsz); pn = (wgid % nig) / gsz; return true;
    }
};

typedef int i32x8 __attribute__((ext_vector_type(8)));
typedef int i32x4 __attribute__((ext_vector_type(4)));
template <class Epi, class Sched, bool GATHER = false, bool FP8 = false>
__device__ __forceinline__ void gemm_phase(LAS unsigned char* lds, const int lda, const int ldb, const int K, const Sched& S, const Epi& E) {
    const int tid = tidf(), wid = __builtin_amdgcn_readfirstlane(tid >> 6), lane = tid & 63, wr = wid >> 2, wc = wid & 3, fr = lane & 15, fq = lane >> 4;
    const int nt = K / BK;
    unsigned voffA[2], voffB[2];
#pragma unroll
    for (int i = 0; i < 2; ++i) { int R, C; stage_rc(tid * 16 + i * 8192, R, C); const int Rb = Epi::PERM ? ((R & ~31) + perm32(R & 31)) : R;
        voffA[i] = (unsigned)(R * lda + C) * 2u; voffB[i] = (unsigned)(Rb * ldb + C) * 2u; }
    const size_t kstep = (size_t)(BK * 2);
    const size_t hstepA = GATHER ? 0 : (size_t)HALF * lda * 2, hstepB = (size_t)HALF * ldb * 2;
    const unsigned ldsw = (unsigned)wid * 1024u;
    const int aoff = lds_byte(wr * 64 + fr, fq * 8), boff = lds_byte(wc * 32 + fr, fq * 8);
#define PG_SA(b, h) (((b) * 2 + (h)) * HTB)
#define PG_SB(b, h) ((4 + (b) * 2 + (h)) * HTB)
#define PG_STAGE(bufoff, gbase, voff) do { _Pragma("unroll") for (int _i = 0; _i < 2; ++_i) \
        __builtin_amdgcn_global_load_lds((const unsigned*)((const char*)(gbase) + (voff)[_i]), (LAS unsigned*)(lds + (bufoff) + ldsw + _i * 8192), 16, 0, 0); } while (0)
#define PG_LDA(dst, b, h) do { _Pragma("unroll") for (int m = 0; m < 4; ++m) { if constexpr (FP8) { \
        const i32x4 _lo = *(const LAS i32x4*)(lds + PG_SA(b, h) + aoff + m * 2048), _hi = *(const LAS i32x4*)(lds + PG_SA(b, h) + aoff + m * 2048 + 1024); \
        dst##8[m] = __builtin_shufflevector(_lo, _hi, 0, 1, 2, 3, 4, 5, 6, 7); } \
        else { _Pragma("unroll") for (int k = 0; k < 2; ++k) dst[m][k] = *(const LAS bf16x8*)(lds + PG_SA(b, h) + aoff + m * 2048 + k * 1024); } } } while (0)
#define PG_LDB(dst, b, h) do { _Pragma("unroll") for (int n = 0; n < 2; ++n) { if constexpr (FP8) { \
        const i32x4 _lo = *(const LAS i32x4*)(lds + PG_SB(b, h) + boff + n * 2048), _hi = *(const LAS i32x4*)(lds + PG_SB(b, h) + boff + n * 2048 + 1024); \
        dst##8[n] = __builtin_shufflevector(_lo, _hi, 0, 1, 2, 3, 4, 5, 6, 7); } \
        else { _Pragma("unroll") for (int k = 0; k < 2; ++k) dst[n][k] = *(const LAS bf16x8*)(lds + PG_SB(b, h) + boff + n * 2048 + k * 1024); } } } while (0)
#define PG_MMA(ai, bj, At, Bt) do { __builtin_amdgcn_s_setprio(1); _Pragma("unroll") for (int m = 0; m < 4; ++m) _Pragma("unroll") for (int n = 0; n < 2; ++n) { \
        if constexpr (FP8) asm volatile("v_mfma_scale_f32_16x16x128_f8f6f4 %0, %1, %2, %0, %3, %4 op_sel_hi:[0,0,0]" : "+v"(acc[ai][bj][m][n]) : "v"(Bt##8[n]), "v"(At##8[m]), "v"(sc_w), "v"(sc_a)); \
        else { _Pragma("unroll") for (int k = 0; k < 2; ++k) acc[ai][bj][m][n] = __builtin_amdgcn_mfma_f32_16x16x32_bf16(Bt[n][k], At[m][k], acc[ai][bj][m][n], 0, 0, 0); } } \
        __builtin_amdgcn_s_setprio(0); } while (0)
#define PG_WAIT_V(n) asm volatile("s_waitcnt vmcnt(" #n ")" ::: "memory")
#define PG_WAIT_L(n) asm volatile("s_waitcnt lgkmcnt(" #n ")" ::: "memory")
#define PG_BAR __builtin_amdgcn_s_barrier()
#define PG_SCHED __builtin_amdgcn_sched_barrier(0)
    Unit cur, nxt; int ui = 0;
    if (!S.next(0, cur)) return;
    f32x4 acc[2][2][4][2];
    f32x4 bini[2][2];
#pragma unroll
    for (int b = 0; b < 2; ++b)
#pragma unroll
        for (int n = 0; n < 2; ++n) bini[b][n] = (f32x4){0.f, 0.f, 0.f, 0.f};
    if constexpr (Epi::BIAS) { const float* bp = E.bias_base(cur) + wc * 32 + (Epi::PERM ? 8 * fq : 4 * fq);
#pragma unroll
        for (int b = 0; b < 2; ++b)
#pragma unroll
            for (int n = 0; n < 2; ++n) bini[b][n] = *(const f32x4*)(bp + b * HALF + (Epi::PERM ? 4 * n : 16 * n)); }
#pragma unroll
    for (int a = 0; a < 2; ++a)
#pragma unroll
        for (int b = 0; b < 2; ++b)
#pragma unroll
            for (int m = 0; m < 4; ++m)
#pragma unroll
                for (int n = 0; n < 2; ++n) acc[a][b][m][n] = bini[b][n];
    bf16x8 At[4][2], B0[2][2], B1[2][2]; i32x8 At8[4], B08[2], B18[2]; const int sc_w = 0x79797979, sc_a = 0x7f7f7f7f;
    unsigned gA0[2], gA1[2], nA0[2], nA1[2];
    auto gather_offs = [&](const Unit& u, unsigned (&o0)[2], unsigned (&o1)[2]) {
#pragma unroll
        for (int i = 0; i < 2; ++i) { int R_, C_; stage_rc(tid * 16 + i * 8192, R_, C_);
            const int r0 = R_, r1 = HALF + R_;
            const int t0 = (r0 < u.nvalid) ? u.rows[r0] : 0, t1 = (r1 < u.nvalid) ? u.rows[r1] : 0;
            o0[i] = (unsigned)(t0 * lda + C_) * 2u; o1[i] = (unsigned)(t1 * lda + C_) * 2u; }
    };
    if constexpr (GATHER) { gather_offs(cur, gA0, gA1); } else {
#pragma unroll
        for (int i = 0; i < 2; ++i) { gA0[i] = voffA[i]; gA1[i] = voffA[i]; nA0[i] = voffA[i]; nA1[i] = voffA[i]; } }
    const char* cA = cur.A; const char* cB = cur.B;
    PG_STAGE(PG_SB(0, 0), cB, voffB); PG_STAGE(PG_SB(0, 1), cB + hstepB, voffB); PG_STAGE(PG_SA(0, 0), cA, gA0); PG_STAGE(PG_SA(0, 1), cA + hstepA, gA1);
    if (wr == 1) PG_BAR;
    PG_WAIT_V(2); PG_BAR;
    PG_STAGE(PG_SB(1, 0), cB + kstep, voffB); PG_STAGE(PG_SA(1, 0), cA + kstep, gA0); PG_STAGE(PG_SB(1, 1), cB + hstepB + kstep, voffB);
    PG_WAIT_V(6); PG_BAR;
    for (;;) {
        const bool has_next = S.next(ui + 1, nxt);
        const char* nA = has_next ? nxt.A : cA; const char* nB = has_next ? nxt.B : cB;
        if constexpr (GATHER) { if (has_next) gather_offs(nxt, nA0, nA1); else {
#pragma unroll
            for (int i = 0; i < 2; ++i) { nA0[i] = gA0[i]; nA1[i] = gA1[i]; } } }
#pragma unroll 1
        for (int t = 0; t < nt; t += 2) {
            const bool last = (t == nt - 2);
            const char* a1 = cA + (size_t)(t + 1) * kstep;
            const char* a2 = last ? nA : cA + (size_t)(t + 2) * kstep; const char* b2 = last ? nB : cB + (size_t)(t + 2) * kstep;
            const char* a3 = a2 + kstep; const char* b3 = b2 + kstep;
            unsigned x0[2], x1[2];
#pragma unroll
            for (int i = 0; i < 2; ++i) { x0[i] = (GATHER && last) ? nA0[i] : gA0[i]; x1[i] = (GATHER && last) ? nA1[i] : gA1[i]; }
            PG_LDB(B0, 0, 0); PG_LDB(B1, 0, 1); PG_SCHED; PG_LDA(At, 0, 0); PG_STAGE(PG_SA(1, 1), a1 + hstepA, gA1);
            PG_WAIT_V(8); PG_WAIT_L(0); PG_BAR; PG_MMA(0, 0, At, B0); PG_MMA(0, 1, At, B1); PG_BAR; PG_SCHED;
            PG_LDA(At, 0, 1); PG_STAGE(PG_SB(0, 0), b2, voffB); PG_STAGE(PG_SB(0, 1), b2 + hstepB, voffB); PG_STAGE(PG_SA(0, 0), a2, x0);
            PG_WAIT_V(8); PG_WAIT_L(0); PG_BAR; PG_MMA(1, 0, At, B0); PG_MMA(1, 1, At, B1); PG_BAR; PG_SCHED;
            PG_LDB(B0, 1, 0); PG_LDB(B1, 1, 1); PG_SCHED; PG_LDA(At, 1, 0); PG_STAGE(PG_SA(0, 1), a2 + hstepA, x1);
            PG_WAIT_V(8); PG_WAIT_L(0); PG_BAR; PG_MMA(0, 0, At, B0); PG_MMA(0, 1, At, B1); PG_BAR; PG_SCHED;
            PG_LDA(At, 1, 1); PG_STAGE(PG_SB(1, 0), b3, voffB); PG_STAGE(PG_SB(1, 1), b3 + hstepB, voffB); PG_STAGE(PG_SA(1, 0), a3, x0);
            PG_WAIT_V(8); PG_WAIT_L(0); PG_BAR; PG_MMA(1, 0, At, B0); PG_MMA(1, 1, At, B1); PG_BAR; PG_SCHED;
        }
        if (wr == 0) PG_BAR;
        if constexpr (FP8) asm volatile("s_nop 15\n\ts_nop 15" ::: "memory");
        if constexpr (Epi::BIAS && !GATHER) { if (has_next) { const float* bp = E.bias_base(nxt) + wc * 32 + (Epi::PERM ? 8 * fq : 4 * fq);
#pragma unroll
            for (int b = 0; b < 2; ++b)
#pragma unroll
                for (int n = 0; n < 2; ++n) bini[b][n] = *(const f32x4*)(bp + b * HALF + (Epi::PERM ? 4 * n : 16 * n)); } }
        if constexpr (!Epi::AFTER_DRAIN) { E(acc, cur, wr, wc, fr, fq); }
        if (!has_next) break;
        if constexpr (Epi::BIAS && GATHER) { const float* bp = E.bias_base(nxt) + wc * 32 + (Epi::PERM ? 8 * fq : 4 * fq);
#pragma unroll
            for (int b = 0; b < 2; ++b)
#pragma unroll
                for (int n = 0; n < 2; ++n) bini[b][n] = *(const f32x4*)(bp + b * HALF + (Epi::PERM ? 4 * n : 16 * n)); }
#pragma unroll
        for (int a = 0; a < 2; ++a)
#pragma unroll
            for (int b = 0; b < 2; ++b)
#pragma unroll
                for (int m = 0; m < 4; ++m)
#pragma unroll
                    for (int n = 0; n < 2; ++n) acc[a][b][m][n] = bini[b][n];
        cur = nxt; cA = nA; cB = nB; ++ui;
        if constexpr (GATHER) {
#pragma unroll
            for (int i = 0; i < 2; ++i) { gA0[i] = nA0[i]; gA1[i] = nA1[i]; } }
        if (wr == 1) PG_BAR;
    }
    PG_WAIT_V(0);
    PG_BAR;
    if constexpr (Epi::AFTER_DRAIN) { E.fused(acc, cur, wr, wc, fr, fq, lds, wid, lane); }
#undef PG_SA
#undef PG_SB
#undef PG_STAGE
#undef PG_LDA
#undef PG_LDB
#undef PG_MMA
#undef PG_WAIT_V
#undef PG_WAIT_L
#undef PG_BAR
#undef PG_SCHED
}

struct EpiStoreBf16 {
    static constexpr bool PERM = true, AFTER_DRAIN = false, BIAS = false;
    bf16_t* O; int ldc; float scale; int gcol;
    __device__ __forceinline__ void operator()(const f32x4 (&acc)[2][2][4][2], const Unit& u, int wr, int wc, int fr, int fq) const {
        bf16_t* base = O + (size_t)(u.pm * BM + wr * 64 + fr) * ldc + u.g * gcol + u.pn * BM + wc * 32 + 8 * fq;
#pragma unroll
        for (int ai = 0; ai < 2; ++ai)
#pragma unroll
            for (int m = 0; m < 4; ++m) { bf16_t* rowp = base + (size_t)(ai * HALF + m * 16) * ldc;
#pragma unroll
                for (int bj = 0; bj < 2; ++bj) { const f32x4 v0 = acc[ai][bj][m][0] * scale, v1 = acc[ai][bj][m][1] * scale;
                    u32x4 w; w.x = cvt_pk_bf16(v0[0], v0[1]); w.y = cvt_pk_bf16(v0[2], v0[3]); w.z = cvt_pk_bf16(v1[0], v1[1]); w.w = cvt_pk_bf16(v1[2], v1[3]);
                    *(u32x4*)(rowp + bj * HALF) = w; } }
    }
};
}

constexpr int PROJW = 4608;
constexpr int PJ_P = 0, PJ_U = 512, PJ_O = 1536, PJ_G = 2560;
constexpr int PROJLD = 1536;
constexpr int WIN_ROWS = 5632;

__device__ __forceinline__ unsigned f2bf(float f) { unsigned u = __builtin_bit_cast(unsigned, f); return (u + 0x7fffu + ((u >> 16) & 1u)) >> 16; }
__device__ __forceinline__ unsigned pk2(float lo, float hi) { return f2bf(lo) | (f2bf(hi) << 16); }
__device__ __forceinline__ float bf2f(unsigned short b) { return __builtin_bit_cast(float, (unsigned)b << 16); }

struct TItem { const float* src; pg::bf16_t* dst; int ldw, ldt, inter, valid, fp8; };
__device__ __forceinline__ void titem_load(const TItem& it, pg::f32x4 (&r)[16], int lane) {
    const float* src = it.src + (size_t)(4 * (lane >> 4)) * it.ldw + 4 * (lane & 15);
#pragma unroll
    for (int i = 0; i < 4; ++i)
#pragma unroll
        for (int kk = 0; kk < 4; ++kk) r[4 * i + kk] = *(const pg::f32x4*)(src + (size_t)(16 * i + kk) * it.ldw);
}
__device__ __forceinline__ void titem_store(const TItem& it, const pg::f32x4 (&r)[16], LAS float* scr, int lane) {
    const int ka = lane >> 4, nb = lane & 15, sw = nb & 7;
#pragma unroll
    for (int i = 0; i < 4; ++i) { const int a = ka + 4 * i;
        LAS float* d = scr + (4 * nb) * 64 + 4 * (a ^ sw);
        *(LAS pg::f32x4*)(d)       = (pg::f32x4){r[4 * i].x, r[4 * i + 1].x, r[4 * i + 2].x, r[4 * i + 3].x};
        *(LAS pg::f32x4*)(d + 64)  = (pg::f32x4){r[4 * i].y, r[4 * i + 1].y, r[4 * i + 2].y, r[4 * i + 3].y};
        *(LAS pg::f32x4*)(d + 128) = (pg::f32x4){r[4 * i].z, r[4 * i + 1].z, r[4 * i + 2].z, r[4 * i + 3].z};
        *(LAS pg::f32x4*)(d + 192) = (pg::f32x4){r[4 * i].w, r[4 * i + 1].w, r[4 * i + 2].w, r[4 * i + 3].w}; }
    asm volatile("s_waitcnt lgkmcnt(0)" ::: "memory");
#pragma unroll
    for (int itr = 0; itr < 8; ++itr) { const int nl = (lane >> 3) + 8 * itr, kg = lane & 7, sn = (nl >> 2) & 7;
        const pg::f32x4 p0 = *(const LAS pg::f32x4*)(scr + nl * 64 + 4 * ((2 * kg) ^ sn)), p1 = *(const LAS pg::f32x4*)(scr + nl * 64 + 4 * ((2 * kg + 1) ^ sn));
        const size_t drow = it.inter ? (size_t)(nl & 1) * 128 + (nl >> 1) : (size_t)nl;
        if (it.fp8) { int w0 = __builtin_amdgcn_cvt_pk_fp8_f32(p0.x * 64.f, p0.y * 64.f, 0, false); w0 = __builtin_amdgcn_cvt_pk_fp8_f32(p0.z * 64.f, p0.w * 64.f, w0, true);
            int w1 = __builtin_amdgcn_cvt_pk_fp8_f32(p1.x * 64.f, p1.y * 64.f, 0, false); w1 = __builtin_amdgcn_cvt_pk_fp8_f32(p1.z * 64.f, p1.w * 64.f, w1, true);
            *(pg::u32x2*)((unsigned char*)it.dst + drow * it.ldt + 8 * kg) = (pg::u32x2){(unsigned)w0, (unsigned)w1}; }
        else { pg::u32x4 o; o.x = pk2(p0.x, p0.y); o.y = pk2(p0.z, p0.w); o.z = pk2(p1.x, p1.y); o.w = pk2(p1.z, p1.w);
            *(pg::u32x4*)(it.dst + drow * it.ldt + 8 * kg) = o; } }
    asm volatile("s_waitcnt lgkmcnt(0)" ::: "memory");
}
__device__ __forceinline__ int win_src_col(int r) { return r < 1536 ? r : (r < 2560 ? r + 1024 : (r < 4608 ? r - 2560 + C_G : r - 4608 + C_V)); }

struct OptBufs {
    pg::bf16_t *WinT, *H0B, *PROJ, *BT2; unsigned char *WinQ, *H0Q, *OGQ;
    float *gif, *stats;
};
__device__ __forceinline__ void ph_ln0(LAS unsigned char* lds, const OptBufs& o, const float* x, const float* g, const float* beta, const float* w_in, const float* b_if) {
    const int tid = tidf(), lane = tid & 63, wave = tid >> 6, gw = blockIdx.x * NW + wave, ngw = gridDim.x * NW;
    LAS float* wif = (LAS float*)lds;
    __syncthreads();
    for (int i = tid; i < 1024 * 8; i += NT) wif[(i & 7) * 1024 + (i >> 3)] = w_in[(size_t)(i >> 3) * INC + C_IF + (i & 7)];
    __syncthreads();
    pg::f32x4 v[4];
    if (gw < T) {
#pragma unroll
        for (int j = 0; j < 4; ++j) v[j] = ((const pg::f32x4*)(x + (size_t)gw * D) + lane)[64 * j]; }
    for (int row = gw; row < T; row += ngw) {
        pg::f32x4 nv[4];
        if (row + ngw < T) {
#pragma unroll
            for (int j = 0; j < 4; ++j) nv[j] = ((const pg::f32x4*)(x + (size_t)(row + ngw) * D) + lane)[64 * j]; }
        float s = 0.f;
#pragma unroll
        for (int j = 0; j < 4; ++j) s += (v[j].x + v[j].y) + (v[j].z + v[j].w);
        const float mean = wsum(s) * (1.f / D); float s2 = 0.f;
#pragma unroll
        for (int j = 0; j < 4; ++j) { v[j] = v[j] - mean; s2 += (v[j].x * v[j].x + v[j].y * v[j].y) + (v[j].z * v[j].z + v[j].w * v[j].w); }
        const float rstd = rsqrtf(wsum(s2) * (1.f / D) + LN_EPS);
        float acc8[8];
#pragma unroll
        for (int q = 0; q < 8; ++q) acc8[q] = 0.f;
        unsigned long long* o8 = (unsigned long long*)(o.H0B + (size_t)row * D) + lane;
#pragma unroll
        for (int j = 0; j < 4; ++j) {
            const int c0 = 256 * j + 4 * lane;
            const pg::f32x4 gg = *(const pg::f32x4*)(g + c0), bb = *(const pg::f32x4*)(beta + c0);
            const pg::f32x4 y = v[j] * rstd * gg + bb;
            o8[64 * j] = (unsigned long long)pk2(y.x, y.y) | ((unsigned long long)pk2(y.z, y.w) << 32);
            { int w0 = __builtin_amdgcn_cvt_pk_fp8_f32(y.x, y.y, 0, false); w0 = __builtin_amdgcn_cvt_pk_fp8_f32(y.z, y.w, w0, true); *(int*)(o.H0Q + (size_t)row * D + c0) = w0; }
#pragma unroll
            for (int q = 0; q < 8; ++q) { const pg::f32x4 w4 = *(const LAS pg::f32x4*)(wif + q * 1024 + c0); acc8[q] += (y.x * w4.x + y.y * w4.y) + (y.z * w4.z + y.w * w4.w); }
        }
        float r_;
        { float a4[4];
#pragma unroll
          for (int i = 0; i < 4; ++i) { const bool up = (lane & 32) != 0; const float keep = up ? acc8[4 + i] : acc8[i], give = up ? acc8[i] : acc8[4 + i]; a4[i] = keep + __shfl_xor(give, 32); }
          float a2[2];
#pragma unroll
          for (int i = 0; i < 2; ++i) { const bool up = (lane & 16) != 0; const float keep = up ? a4[2 + i] : a4[i], give = up ? a4[i] : a4[2 + i]; a2[i] = keep + __shfl_xor(give, 16); }
          const bool up = (lane & 8) != 0; const float keep = up ? a2[1] : a2[0], give = up ? a2[0] : a2[1];
          r_ = keep + __shfl_xor(give, 8);
          r_ += __shfl_xor(r_, 4); r_ += __shfl_xor(r_, 2); r_ += __shfl_xor(r_, 1); }
        if ((lane & 7) == 0) { const int q = lane >> 3; o.gif[(size_t)row * 8 + q] = r_ + b_if[q]; }
        if (lane == 0) { o.stats[(size_t)row * 2] = mean; o.stats[(size_t)row * 2 + 1] = rstd; }
#pragma unroll
        for (int j = 0; j < 4; ++j) v[j] = nv[j];
    }
    __syncthreads();
}
struct SchedInproj {
    pg::TileOrder o; const char* A; const char* B; size_t rowbytes;
    __device__ __forceinline__ bool next(int i, pg::Unit& u) const { int g, pm, pn; if (!o.tile(i, g, pm, pn)) return false;
        u.A = A + (size_t)pm * 256 * rowbytes; u.B = B + (size_t)pn * 256 * rowbytes; u.pm = pm; u.pn = pn; u.g = 0; u.aux = 0; u.rows = nullptr; u.nvalid = 0; return true; }
};
struct SchedVT {
    pg::TileOrder o; const char* A; const char* B;
    __device__ __forceinline__ bool next(int i, pg::Unit& u) const { int g, pm, pn; if (!o.tile(i, g, pm, pn)) return false;
        u.A = A + (size_t)pm * 256 * D * 2; u.B = B + (size_t)pn * 256 * D * 2; u.pm = pm; u.pn = pn; u.g = 0; u.aux = 0; u.rows = nullptr; u.nvalid = 0; return true; }
};
struct EpiVT {
    static constexpr bool PERM = true, AFTER_DRAIN = false, BIAS = false;
    pg::bf16_t* BT2;
    __device__ __forceinline__ void operator()(const pg::f32x4 (&acc)[2][2][4][2], const pg::Unit& u, int wr, int wc, int fr, int fq) const {
        const int h = u.pm, b = u.pn >> 4, c = u.pn & 15;
        pg::bf16_t* base = BT2 + ((size_t)((b * 4 + h) * 16 + c) * 256 + wr * 64 + fr) * 512 + wc * 32 + 8 * fq;
#pragma unroll
        for (int ai = 0; ai < 2; ++ai)
#pragma unroll
            for (int m = 0; m < 4; ++m) { pg::bf16_t* rowp = base + (size_t)(ai * 128 + m * 16) * 512;
#pragma unroll
                for (int bj = 0; bj < 2; ++bj) { const pg::f32x4 v0 = acc[ai][bj][m][0], v1 = acc[ai][bj][m][1];
                    pg::u32x4 w; w.x = pg::cvt_pk_bf16(v0[0], v0[1]); w.y = pg::cvt_pk_bf16(v0[2], v0[3]); w.z = pg::cvt_pk_bf16(v1[0], v1[1]); w.w = pg::cvt_pk_bf16(v1[2], v1[3]);
                    *(pg::u32x4*)(rowp + bj * 128) = w; } }
    }
};
struct EpiOGQ {
    static constexpr bool PERM = true, AFTER_DRAIN = false, BIAS = false;
    unsigned char* O;
    __device__ __forceinline__ void operator()(const pg::f32x4 (&acc)[2][2][4][2], const pg::Unit& u, int wr, int wc, int fr, int fq) const {
        unsigned char* base = O + (size_t)(u.pm * 256 + wr * 64 + fr) * 3072 + u.pn * 256 + (wc * 4 + fq) * 16;
#pragma unroll
        for (int ai = 0; ai < 2; ++ai)
#pragma unroll
            for (int m = 0; m < 4; ++m) { pg::u32x4 w;
                { const pg::f32x4 v0 = acc[ai][0][m][0], v1 = acc[ai][0][m][1];
                  int p = __builtin_amdgcn_cvt_pk_fp8_f32(v0[0], v0[1], 0, false); p = __builtin_amdgcn_cvt_pk_fp8_f32(v0[2], v0[3], p, true); w.x = (unsigned)p;
                  p = __builtin_amdgcn_cvt_pk_fp8_f32(v1[0], v1[1], 0, false); p = __builtin_amdgcn_cvt_pk_fp8_f32(v1[2], v1[3], p, true); w.y = (unsigned)p; }
                { const pg::f32x4 v0 = acc[ai][1][m][0], v1 = acc[ai][1][m][1];
                  int p = __builtin_amdgcn_cvt_pk_fp8_f32(v0[0], v0[1], 0, false); p = __builtin_amdgcn_cvt_pk_fp8_f32(v0[2], v0[3], p, true); w.z = (unsigned)p;
                  p = __builtin_amdgcn_cvt_pk_fp8_f32(v1[0], v1[1], 0, false); p = __builtin_amdgcn_cvt_pk_fp8_f32(v1[2], v1[3], p, true); w.w = (unsigned)p; }
                *(pg::u32x4*)(base + (size_t)(ai * 128 + m * 16) * 3072) = w; asm volatile("" ::: "memory"); }
    }
};
__device__ __forceinline__ void fp8x4_to_f32(unsigned w, float (&o)[4]) {
    const pg::f32x2 lo = __builtin_amdgcn_cvt_pk_f32_fp8((int)w, false), hi = __builtin_amdgcn_cvt_pk_f32_fp8((int)w, true);
    o[0] = lo.x; o[1] = lo.y; o[2] = hi.x; o[3] = hi.y;
}
__device__ __forceinline__ void ph_inproj(LAS unsigned char* lds, const OptBufs& o) {
    const int G = gridDim.x, bx = blockIdx.x;
    { SchedInproj S; S.o.init(T / 256, 12, 1, G, bx); S.A = (const char*)o.H0Q; S.B = (const char*)o.WinQ; S.rowbytes = D;
      EpiOGQ E{o.OGQ}; pg::gemm_phase<EpiOGQ, SchedInproj, false, true>(lds, D / 2, D / 2, D / 2, S, E); }
    { SchedInproj S; S.o.init(T / 256, 6, 1, G, bx); S.A = (const char*)o.H0B; S.B = (const char*)o.WinT; S.rowbytes = (size_t)D * 2;
      pg::EpiStoreBf16 E{o.PROJ, PROJLD, 1.f, 0}; pg::gemm_phase<pg::EpiStoreBf16, SchedInproj>(lds, D, D, D, S, E); }
    { SchedVT S; S.o.init(4, T / 256, 1, G, (bx + 128) % G); S.A = (const char*)(o.WinT + (size_t)PROJW * D); S.B = (const char*)o.H0B;
      EpiVT E{o.BT2}; pg::gemm_phase<EpiVT, SchedVT>(lds, D, D, D, S, E); }
}

struct OptBufs2 { pg::bf16_t *WqT, *WkT, *WpoolT, *WbpT, *POOLED, *UC, *MIXED, *Q, *K, *YPOOL; };
__device__ __forceinline__ void ld8(const pg::bf16_t* p, float (&v)[8]) { const pg::u32x4 w = *(const pg::u32x4*)p;
    v[0] = __builtin_bit_cast(float, w.x << 16); v[1] = __builtin_bit_cast(float, w.x & 0xffff0000u); v[2] = __builtin_bit_cast(float, w.y << 16); v[3] = __builtin_bit_cast(float, w.y & 0xffff0000u);
    v[4] = __builtin_bit_cast(float, w.z << 16); v[5] = __builtin_bit_cast(float, w.z & 0xffff0000u); v[6] = __builtin_bit_cast(float, w.w << 16); v[7] = __builtin_bit_cast(float, w.w & 0xffff0000u); }
__device__ __forceinline__ void st8(pg::bf16_t* p, const float (&v)[8]) { pg::u32x4 w; w.x = pk2(v[0], v[1]); w.y = pk2(v[2], v[3]); w.z = pk2(v[4], v[5]); w.w = pk2(v[6], v[7]); *(pg::u32x4*)p = w; }
__device__ __forceinline__ void ph_poolconv_opt(const pg::bf16_t* PROJ, const float* cw, const float* cb, pg::bf16_t* POOLED, pg::bf16_t* UC) {
    const int gt = blockIdx.x * NT + tidf(), ngt = gridDim.x * NT;
    for (int it = gt; it < 512 * 192; it += ngt) {
        const int run = it / 192, oc = it % 192; const int t0 = run * 32, tpos0 = t0 & (SEQ - 1);
        if (oc < 64) {
            const int c0 = oc * 8, w = 2 << (c0 >> 7);
            const pg::bf16_t* src = PROJ + PJ_P + c0;
            float s[8];
#pragma unroll
            for (int q = 0; q < 8; ++q) s[q] = 0.f;
            { pg::u32x4 hv[15];
#pragma unroll
              for (int j = 1; j < 16; ++j) hv[j - 1] = (j < w && tpos0 - j >= 0) ? *(const pg::u32x4*)(src + (size_t)(t0 - j) * PROJLD) : (pg::u32x4){0u, 0u, 0u, 0u};
#pragma unroll
              for (int j = 0; j < 15; ++j) { s[0] += __builtin_bit_cast(float, hv[j].x << 16); s[1] += __builtin_bit_cast(float, hv[j].x & 0xffff0000u); s[2] += __builtin_bit_cast(float, hv[j].y << 16); s[3] += __builtin_bit_cast(float, hv[j].y & 0xffff0000u);
                  s[4] += __builtin_bit_cast(float, hv[j].z << 16); s[5] += __builtin_bit_cast(float, hv[j].z & 0xffff0000u); s[6] += __builtin_bit_cast(float, hv[j].w << 16); s[7] += __builtin_bit_cast(float, hv[j].w & 0xffff0000u); } }
            for (int i0 = 0; i0 < 32; i0 += 8) {
                pg::u32x4 cv[8], ov[8];
#pragma unroll
                for (int i = 0; i < 8; ++i) { const int t = t0 + i0 + i, tp = tpos0 + i0 + i; cv[i] = *(const pg::u32x4*)(src + (size_t)t * PROJLD);
                    ov[i] = (tp - w + 1 >= 0) ? *(const pg::u32x4*)(src + (size_t)(t - w + 1) * PROJLD) : (pg::u32x4){0u, 0u, 0u, 0u}; }
#pragma unroll
                for (int i = 0; i < 8; ++i) { const int t = t0 + i0 + i, tp = tpos0 + i0 + i; float cur[8], old[8], o[8];
                    cur[0] = __builtin_bit_cast(float, cv[i].x << 16); cur[1] = __builtin_bit_cast(float, cv[i].x & 0xffff0000u); cur[2] = __builtin_bit_cast(float, cv[i].y << 16); cur[3] = __builtin_bit_cast(float, cv[i].y & 0xffff0000u);
                    cur[4] = __builtin_bit_cast(float, cv[i].z << 16); cur[5] = __builtin_bit_cast(float, cv[i].z & 0xffff0000u); cur[6] = __builtin_bit_cast(float, cv[i].w << 16); cur[7] = __builtin_bit_cast(float, cv[i].w & 0xffff0000u);
                    old[0] = __builtin_bit_cast(float, ov[i].x << 16); old[1] = __builtin_bit_cast(float, ov[i].x & 0xffff0000u); old[2] = __builtin_bit_cast(float, ov[i].y << 16); old[3] = __builtin_bit_cast(float, ov[i].y & 0xffff0000u);
                    old[4] = __builtin_bit_cast(float, ov[i].z << 16); old[5] = __builtin_bit_cast(float, ov[i].z & 0xffff0000u); old[6] = __builtin_bit_cast(float, ov[i].w << 16); old[7] = __builtin_bit_cast(float, ov[i].w & 0xffff0000u);
                    const float inv = 1.f / (float)((tp + 1 < w) ? tp + 1 : w);
#pragma unroll
                    for (int q = 0; q < 8; ++q) { s[q] += cur[q]; o[q] = s[q] * inv - cur[q]; s[q] -= old[q]; }
                    st8(POOLED + (size_t)t * 512 + c0, o); }
            }
        } else {
            const int c0 = (oc - 64) * 8;
            const pg::bf16_t* src = PROJ + PJ_U + c0;
            float w0[8], w1[8], w2[8], w3[8], bb[8], u0[8], u1[8], u2[8];
#pragma unroll
            for (int q = 0; q < 8; ++q) { w0[q] = cw[c0 + q]; w1[q] = cw[1024 + c0 + q]; w2[q] = cw[2048 + c0 + q]; w3[q] = cw[3072 + c0 + q]; bb[q] = cb[c0 + q]; u0[q] = 0.f; u1[q] = 0.f; u2[q] = 0.f; }
            if (tpos0 >= 3) ld8(src + (size_t)(t0 - 3) * PROJLD, u0);
            if (tpos0 >= 2) ld8(src + (size_t)(t0 - 2) * PROJLD, u1);
            if (tpos0 >= 1) ld8(src + (size_t)(t0 - 1) * PROJLD, u2);
            for (int i0 = 0; i0 < 32; i0 += 8) {
                pg::u32x4 cv[8];
#pragma unroll
                for (int i = 0; i < 8; ++i) cv[i] = *(const pg::u32x4*)(src + (size_t)(t0 + i0 + i) * PROJLD);
#pragma unroll
                for (int i = 0; i < 8; ++i) { float u3[8], o[8];
                    u3[0] = __builtin_bit_cast(float, cv[i].x << 16); u3[1] = __builtin_bit_cast(float, cv[i].x & 0xffff0000u); u3[2] = __builtin_bit_cast(float, cv[i].y << 16); u3[3] = __builtin_bit_cast(float, cv[i].y & 0xffff0000u);
                    u3[4] = __builtin_bit_cast(float, cv[i].z << 16); u3[5] = __builtin_bit_cast(float, cv[i].z & 0xffff0000u); u3[6] = __builtin_bit_cast(float, cv[i].w << 16); u3[7] = __builtin_bit_cast(float, cv[i].w & 0xffff0000u);
#pragma unroll
                    for (int q = 0; q < 8; ++q) { const float y = bb[q] + w0[q] * u0[q] + w1[q] * u1[q] + w2[q] * u2[q] + w3[q] * u3[q]; o[q] = y * __builtin_amdgcn_rcpf(1.f + __expf(-y)); u0[q] = u1[q]; u1[q] = u2[q]; u2[q] = u3[q]; }
                    st8(UC + (size_t)(t0 + i0 + i) * 1024 + c0, o); }
            }
        }
    }
}
struct SchedG {
    pg::TileOrder o; const char* A; const char* B; size_t gA, gB, tA, tB;
    __device__ __forceinline__ bool next(int i, pg::Unit& u) const { int g, pm, pn; if (!o.tile(i, g, pm, pn)) return false;
        u.A = A + g * gA + pm * tA; u.B = B + g * gB + pn * tB; u.pm = pm; u.pn = pn; u.g = g; u.aux = 0; u.rows = nullptr; u.nvalid = 0; return true; }
};
struct EpiPoolMixB {
    static constexpr bool PERM = true, AFTER_DRAIN = false, BIAS = false;
    pg::bf16_t* O; const float* b; const float* ls;
    __device__ __forceinline__ void operator()(const pg::f32x4 (&acc)[2][2][4][2], const pg::Unit& u, int wr, int wc, int fr, int fq) const {
        const int col0 = u.pn * 256 + wc * 32 + 8 * fq;
        pg::bf16_t* base = O + (size_t)(u.pm * 256 + wr * 64 + fr) * 512 + col0;
        pg::f32x4 bv[2][2], lv[2][2];
#pragma unroll
        for (int bj = 0; bj < 2; ++bj)
#pragma unroll
            for (int n = 0; n < 2; ++n) { bv[bj][n] = *(const pg::f32x4*)(b + col0 + bj * 128 + 4 * n); lv[bj][n] = *(const pg::f32x4*)(ls + col0 + bj * 128 + 4 * n); }
#pragma unroll
        for (int ai = 0; ai < 2; ++ai)
#pragma unroll
            for (int m = 0; m < 4; ++m) { pg::bf16_t* rowp = base + (size_t)(ai * 128 + m * 16) * 512;
#pragma unroll
                for (int bj = 0; bj < 2; ++bj) { const pg::f32x4 v0 = (acc[ai][bj][m][0] + bv[bj][0]) * lv[bj][0], v1 = (acc[ai][bj][m][1] + bv[bj][1]) * lv[bj][1];
                    pg::u32x4 w; w.x = pg::cvt_pk_bf16(v0[0], v0[1]); w.y = pg::cvt_pk_bf16(v0[2], v0[3]); w.z = pg::cvt_pk_bf16(v1[0], v1[1]); w.w = pg::cvt_pk_bf16(v1[2], v1[3]);
                    *(pg::u32x4*)(rowp + bj * 128) = w; } }
    }
};
struct OptBufs3 { pg::bf16_t *KaT, *A2, *HOUT; float *U, *rowv, *colv, *winter, *aw, *emt, *den, *un, *decay; };
__device__ __forceinline__ float log_sigmoidf_(float x) { return fminf(x, 0.f) - log1pf(expf(-fabsf(x))); }
__device__ __forceinline__ void scalar_scan_wg(LAS unsigned char* lds, int bh, const float* gif, const OptBufs3& o) {
    const int tid = tidf(), lane = tid & 63, wave = tid >> 6, b = bh >> 2, h = bh & 3;
    LAS float* sum = (LAS float*)lds;
    float bt[2][4], ip[2][4], pm[2][4];
#pragma unroll
    for (int cc = 0; cc < 2; ++cc) { const int c = wave * 2 + cc;
        float bs[4];
#pragma unroll
        for (int sub = 0; sub < 4; ++sub) { const size_t t = (size_t)b * SEQ + c * 256 + sub * 64 + lane; ip[cc][sub] = gif[t * 8 + h]; bs[sub] = log_sigmoidf_(gif[t * 8 + 4 + h]); }
#pragma unroll
        for (int off = 1; off < 64; off <<= 1) {
#pragma unroll
            for (int sub = 0; sub < 4; ++sub) { const float v = __shfl_up(bs[sub], off); if (lane >= off) bs[sub] += v; } }
        float carry = 0.f;
#pragma unroll
        for (int sub = 0; sub < 4; ++sub) { bt[cc][sub] = carry + bs[sub]; carry += __shfl(bs[sub], 63); pm[cc][sub] = ip[cc][sub] - bt[cc][sub]; }
#pragma unroll
        for (int off = 1; off < 64; off <<= 1) {
#pragma unroll
            for (int sub = 0; sub < 4; ++sub) { const float v = __shfl_up(pm[cc][sub], off); if (lane >= off) pm[cc][sub] = fmaxf(pm[cc][sub], v); } }
        float pmc = -INFINITY;
#pragma unroll
        for (int sub = 0; sub < 4; ++sub) { pm[cc][sub] = fmaxf(pm[cc][sub], pmc); pmc = __shfl(pm[cc][sub], 63); }
        if (lane == 0) { sum[c * 2] = carry; sum[c * 2 + 1] = pmc; }
    }
    __syncthreads();
    float mc = 0.f;
    for (int c = 0; c < wave * 2; ++c) mc = sum[c * 2] + fmaxf(mc, sum[c * 2 + 1]);
#pragma unroll
    for (int cc = 0; cc < 2; ++cc) { const int c = wave * 2 + cc; const float Gc = sum[c * 2], mnext = Gc + fmaxf(mc, sum[c * 2 + 1]);
#pragma unroll
        for (int sub = 0; sub < 4; ++sub) { const float mt = bt[cc][sub] + fmaxf(mc, pm[cc][sub]);
            const size_t idx = ((size_t)b * SEQ + c * 256 + sub * 64 + lane) * 4 + h;
            o.rowv[idx] = bt[cc][sub] - mt; o.colv[idx] = ip[cc][sub] - bt[cc][sub];
            o.winter[idx] = expf(bt[cc][sub] + mc - mt); o.aw[idx] = expf(Gc - bt[cc][sub] + ip[cc][sub] - mnext); o.emt[idx] = expf(-mt); }
        if (lane == 0) o.decay[bh * 16 + c] = expf(Gc + mc - mnext);
        mc = mnext; }
    __syncthreads();
}
struct EpiQ {
    static constexpr bool PERM = true, AFTER_DRAIN = false, BIAS = false;
    pg::bf16_t* Q; pg::bf16_t* A2; const float* winter;
    __device__ __forceinline__ void operator()(const pg::f32x4 (&acc)[2][2][4][2], const pg::Unit& u, int wr, int wc, int fr, int fq) const {
        const int h = u.g, col0 = wc * 32 + 8 * fq;
#pragma unroll
        for (int ai = 0; ai < 2; ++ai)
#pragma unroll
            for (int m = 0; m < 4; ++m) { const size_t t = (size_t)u.pm * 256 + ai * 128 + wr * 64 + m * 16 + fr; const float wi = winter[t * 4 + h];
#pragma unroll
                for (int bj = 0; bj < 2; ++bj) { const pg::f32x4 v0 = acc[ai][bj][m][0] * 0.0625f, v1 = acc[ai][bj][m][1] * 0.0625f;
                    pg::u32x4 w; w.x = pg::cvt_pk_bf16(v0[0], v0[1]); w.y = pg::cvt_pk_bf16(v0[2], v0[3]); w.z = pg::cvt_pk_bf16(v1[0], v1[1]); w.w = pg::cvt_pk_bf16(v1[2], v1[3]);
                    *(pg::u32x4*)(Q + t * 1024 + h * 256 + col0 + bj * 128) = w;
                    const pg::f32x4 x0 = v0 * wi, x1 = v1 * wi;
                    pg::u32x4 y; y.x = pg::cvt_pk_bf16(x0[0], x0[1]); y.y = pg::cvt_pk_bf16(x0[2], x0[3]); y.z = pg::cvt_pk_bf16(x1[0], x1[1]); y.w = pg::cvt_pk_bf16(x1[2], x1[3]);
                    *(pg::u32x4*)(A2 + t * 2048 + h * 512 + 256 + col0 + bj * 128) = y; }
                asm volatile("" ::: "memory"); }
    }
};
struct EpiKT {
    static constexpr bool PERM = true, AFTER_DRAIN = false, BIAS = false;
    pg::bf16_t* KaT; const float* aw;
    __device__ __forceinline__ void operator()(const pg::f32x4 (&acc)[2][2][4][2], const pg::Unit& u, int wr, int wc, int fr, int fq) const {
        const int h = u.g; const size_t t0 = (size_t)u.pn * 256 + wc * 32 + 8 * fq;
#pragma unroll
        for (int bj = 0; bj < 2; ++bj) {
            float a[8];
#pragma unroll
            for (int j = 0; j < 8; ++j) a[j] = aw[(t0 + bj * 128 + j) * 4 + h];
            pg::bf16_t* rowp = KaT + ((size_t)h * 256 + wr * 64 + fr) * T + t0 + bj * 128;
#pragma unroll
            for (int ai = 0; ai < 2; ++ai)
#pragma unroll
                for (int m = 0; m < 4; ++m) { const pg::f32x4 v0 = acc[ai][bj][m][0], v1 = acc[ai][bj][m][1];
                    pg::u32x4 w; w.x = pg::cvt_pk_bf16(v0[0] * a[0], v0[1] * a[1]); w.y = pg::cvt_pk_bf16(v0[2] * a[2], v0[3] * a[3]);
                    w.z = pg::cvt_pk_bf16(v1[0] * a[4], v1[1] * a[5]); w.w = pg::cvt_pk_bf16(v1[2] * a[6], v1[3] * a[7]);
                    *(pg::u32x4*)(rowp + (size_t)(ai * 128 + m * 16) * T) = w; asm volatile("" ::: "memory"); }
        }
    }
};
struct EpiS {
    static constexpr bool PERM = true, AFTER_DRAIN = false, BIAS = false;
    pg::bf16_t* A2; const float* rowv; const float* colv; float* den;
    __device__ __forceinline__ void operator()(const pg::f32x4 (&acc)[2][2][4][2], const pg::Unit& u, int wr, int wc, int fr, int fq) const {
        const int bh = u.g >> 4, c = u.g & 15, b = bh >> 2, h = bh & 3; const size_t tok0 = (size_t)b * SEQ + c * 256;
        const int col0 = wc * 32 + 8 * fq;
        const float* cvp = colv + (tok0 + col0) * 4 + h;
#pragma unroll
        for (int ai = 0; ai < 2; ++ai)
#pragma unroll
            for (int m = 0; m < 4; ++m) { const int tl = ai * 128 + wr * 64 + m * 16 + fr; const float rv = rowv[(tok0 + tl) * 4 + h]; float rs = 0.f;
                pg::bf16_t* op = A2 + (tok0 + tl) * 2048 + h * 512 + col0;
#pragma unroll
                for (int bj = 0; bj < 2; ++bj) { float x[8];
#pragma unroll
                    for (int j = 0; j < 8; ++j) { const int sl = col0 + bj * 128 + j; const float a_ = (j < 4) ? acc[ai][bj][m][0][j] : acc[ai][bj][m][1][j - 4];
                        const float w_ = __expf(rv + cvp[(bj * 128 + j) * 4]); x[j] = (sl <= tl) ? a_ * w_ : 0.f; rs += x[j]; }
                    pg::u32x4 w; w.x = pg::cvt_pk_bf16(x[0], x[1]); w.y = pg::cvt_pk_bf16(x[2], x[3]); w.z = pg::cvt_pk_bf16(x[4], x[5]); w.w = pg::cvt_pk_bf16(x[6], x[7]);
                    *(pg::u32x4*)(op + bj * 128) = w; asm volatile("" ::: "memory"); }
                rs += __shfl_xor(rs, 16); rs += __shfl_xor(rs, 32);
                if (fq == 0) atomicAdd(den + (tok0 + tl) * 4 + h, rs);
                asm volatile("" ::: "memory"); }
    }
};
struct EpiF32U {
    static constexpr bool PERM = false, AFTER_DRAIN = false, BIAS = false;
    float* C;
    __device__ __forceinline__ void operator()(const pg::f32x4 (&acc)[2][2][4][2], const pg::Unit& u, int wr, int wc, int fr, int fq) const {
        pg::bf16_t* base = (pg::bf16_t*)C + (size_t)u.aux * 65536 + (size_t)(wr * 64 + fr) * 256 + (wc * 4 + fq) * 16;
#pragma unroll
        for (int ai = 0; ai < 2; ++ai)
#pragma unroll
            for (int m = 0; m < 4; ++m)
#pragma unroll
                for (int bj = 0; bj < 2; ++bj) { const pg::f32x4 v0 = acc[ai][bj][m][0], v1 = acc[ai][bj][m][1];
                    pg::u32x4 w; w.x = pg::cvt_pk_bf16(v0[0], v0[1]); w.y = pg::cvt_pk_bf16(v0[2], v0[3]); w.z = pg::cvt_pk_bf16(v1[0], v1[1]); w.w = pg::cvt_pk_bf16(v1[2], v1[3]);
                    *(pg::u32x4*)(base + (size_t)(ai * 128 + m * 16) * 256 + bj * 8) = w; if (bj) asm volatile("" ::: "memory"); }
    }
};
struct EpiNum {
    static constexpr bool PERM = true, AFTER_DRAIN = true, BIAS = false;
    pg::bf16_t* HOUT; const unsigned char* OGQ; const float* den; const float* emt; const float* gain;
    __device__ __forceinline__ void fused(pg::f32x4 (&acc)[2][2][4][2], const pg::Unit& u, int wr, int wc, int fr, int fq, LAS unsigned char* lds, int wid, int lane) const {
        const int bh = u.g >> 4, c = u.g & 15, b = bh >> 2, h = bh & 3; const size_t tok0 = (size_t)b * SEQ + c * 256;
        LAS pg::f32x2* P = (LAS pg::f32x2*)lds; LAS pg::f32x2* Sx = (LAS pg::f32x2*)(lds + 8192);
#pragma unroll
        for (int ai = 0; ai < 2; ++ai)
#pragma unroll
            for (int m = 0; m < 4; ++m) { const int tl = ai * 128 + wr * 64 + m * 16 + fr; const size_t ti = (tok0 + tl) * 4 + h;
                const float inv = __builtin_amdgcn_rcpf(fmaxf(fabsf(den[ti]), emt[ti])); float s = 0.f;
#pragma unroll
                for (int bj = 0; bj < 2; ++bj)
#pragma unroll
                    for (int n = 0; n < 2; ++n) { acc[ai][bj][m][n] = acc[ai][bj][m][n] * inv; const pg::f32x4 x = acc[ai][bj][m][n]; s += (x[0] + x[1]) + (x[2] + x[3]); }
                s += __shfl_xor(s, 16); s += __shfl_xor(s, 32);
                const float mw = s * (1.f / 64.f); float q = 0.f;
#pragma unroll
                for (int bj = 0; bj < 2; ++bj)
#pragma unroll
                    for (int n = 0; n < 2; ++n) { const pg::f32x4 d = acc[ai][bj][m][n] - mw; q += (d[0] * d[0] + d[1] * d[1]) + (d[2] * d[2] + d[3] * d[3]); }
                q += __shfl_xor(q, 16); q += __shfl_xor(q, 32);
                if (fq == 0) P[tl * 4 + wc] = (pg::f32x2){mw, q}; }
        asm volatile("s_waitcnt lgkmcnt(0)" ::: "memory"); __builtin_amdgcn_s_barrier(); asm volatile("" ::: "memory");
        if (lane < 32) { const int row = wid * 32 + lane;
            const pg::f32x2 a = P[row * 4 + 0], b_ = P[row * 4 + 1], c_ = P[row * 4 + 2], d = P[row * 4 + 3];
            const float mt = (a.x + b_.x + c_.x + d.x) * 0.25f;
            const float da = a.x - mt, db = b_.x - mt, dc = c_.x - mt, dd = d.x - mt;
            const float m2 = (a.y + b_.y) + (c_.y + d.y) + 64.f * ((da * da + db * db) + (dc * dc + dd * dd));
            Sx[row] = (pg::f32x2){mt, rsqrtf(m2 * (1.f / 256.f) + LN_EPS)}; }
        asm volatile("s_waitcnt lgkmcnt(0)" ::: "memory"); __builtin_amdgcn_s_barrier(); asm volatile("" ::: "memory");
        const int col0 = wc * 32 + 8 * fq;
        pg::f32x4 gn[2][2];
#pragma unroll
        for (int bj = 0; bj < 2; ++bj) { gn[bj][0] = *(const pg::f32x4*)(gain + h * 256 + col0 + bj * 128); gn[bj][1] = *(const pg::f32x4*)(gain + h * 256 + col0 + bj * 128 + 4); }
#pragma unroll
        for (int ai = 0; ai < 2; ++ai)
#pragma unroll
            for (int m = 0; m < 4; ++m) { const int tl = ai * 128 + wr * 64 + m * 16 + fr; const pg::f32x2 sr = Sx[tl]; const size_t t = tok0 + tl;
                const pg::u32x4 ow = *(const pg::u32x4*)(OGQ + t * 3072 + h * 256 + (wc * 4 + fq) * 16);
#pragma unroll
                for (int bj = 0; bj < 2; ++bj) { const int e0 = h * 256 + col0 + bj * 128; float o0[4], o1[4];
                    fp8x4_to_f32(bj ? ow.z : ow.x, o0); fp8x4_to_f32(bj ? ow.w : ow.y, o1);
                    const pg::f32x4 v0 = (acc[ai][bj][m][0] - sr.x) * sr.y * gn[bj][0], v1 = (acc[ai][bj][m][1] - sr.x) * sr.y * gn[bj][1];
                    float r[8];
#pragma unroll
                    for (int j = 0; j < 4; ++j) { r[j] = v0[j] * fsigmoid(o0[j]); r[4 + j] = v1[j] * fsigmoid(o1[j]); }
                    st8(HOUT + t * 1024 + e0, r); } }
    }
};
struct SchedG1 { pg::TileOrder o; const char* Q; const char* K;
    __device__ __forceinline__ bool next(int i, pg::Unit& u) const { int g, pm, pn; if (!o.tile(i, g, pm, pn)) return false;
        const int bh = g >> 4, c = g & 15, b = bh >> 2, h = bh & 3; const size_t off = (((size_t)b * SEQ + c * 256) * 1024 + h * 256) * 2;
        u.A = Q + off; u.B = K + off; u.pm = 0; u.pn = 0; u.g = g; u.aux = g; u.rows = nullptr; u.nvalid = 0; return true; } };
struct SchedG2 { pg::TileOrder o; const char* BT2; const char* KaT;
    __device__ __forceinline__ bool next(int i, pg::Unit& u) const { int g, pm, pn; if (!o.tile(i, g, pm, pn)) return false;
        const int bh = g / 15, c = g % 15, b = bh >> 2, h = bh & 3;
        u.A = BT2 + (size_t)(bh * 16 + c) * 256 * 512 * 2; u.B = KaT + (((size_t)h * 256) * T + (size_t)b * SEQ + c * 256) * 2;
        u.pm = 0; u.pn = 0; u.g = bh * 16 + c; u.aux = bh * 16 + c; u.rows = nullptr; u.nvalid = 0; return true; } };
struct SchedG3 { pg::TileOrder o; const char* A2; const char* BT2;
    __device__ __forceinline__ bool next(int i, pg::Unit& u) const { int g, pm, pn; if (!o.tile(i, g, pm, pn)) return false;
        const int bh = g >> 4, c = g & 15, b = bh >> 2, h = bh & 3;
        u.A = A2 + (((size_t)b * SEQ + c * 256) * 2048 + h * 512) * 2; u.B = BT2 + (size_t)g * 256 * 512 * 2; u.pm = 0; u.pn = 0; u.g = g; u.aux = g; u.rows = nullptr; u.nvalid = 0; return true; } };
__device__ __forceinline__ void ph_un(LAS unsigned char* lds, const OptBufs2& o2, const OptBufs3& o3) {
    const int tid = tidf(), d = tid & 255, sh = tid >> 8; LAS float* red = (LAS float*)lds;
    for (int it = blockIdx.x; it < 256; it += gridDim.x) { const int bh = it >> 4, c = it & 15, b = bh >> 2, h = bh & 3; const size_t tok0 = (size_t)b * SEQ + c * 256;
        float s = 0.f;
#pragma unroll 8
        for (int j = 0; j < 128; ++j) { const size_t t = tok0 + sh * 128 + j; s += o3.aw[t * 4 + h] * bf2f(o2.K[t * 1024 + h * 256 + d]); }
        __syncthreads(); if (sh == 1) red[d] = s; __syncthreads();
        if (sh == 0) o3.un[(size_t)it * 256 + d] = s + red[d]; }
    __syncthreads();
}
__device__ __forceinline__ void ph_state_scan(const OptBufs& ob, const OptBufs3& o3) {
    const int gt = blockIdx.x * NT + tidf(), ngt = gridDim.x * NT;
    const pg::bf16_t* U16 = (const pg::bf16_t*)o3.U;
    for (int it = gt; it < 16 * 256 * 32; it += ngt) { const int bh = it >> 13, e = (it >> 5) & 255, ch = it & 31, slot = ch >> 1, bj = ch & 1;
        const int d0 = 128 * bj + 32 * (slot >> 2) + 4 * (slot & 3);
        pg::u32x4 U[15]; float dc[15];
#pragma unroll
        for (int c = 0; c < 15; ++c) { const size_t g = (size_t)bh * 16 + c; U[c] = *(const pg::u32x4*)(U16 + g * 65536 + (size_t)e * 256 + ch * 8); dc[c] = o3.decay[g]; }
        float C[8];
#pragma unroll
        for (int j = 0; j < 8; ++j) C[j] = 0.f;
#pragma unroll
        for (int c = 0; c < 16; ++c) { const size_t g = (size_t)bh * 16 + c;
            pg::bf16_t* dst = ob.BT2 + (g * 256 + e) * 512 + 256 + d0;
            *(pg::u32x2*)(dst) = (pg::u32x2){pk2(C[0], C[1]), pk2(C[2], C[3])};
            *(pg::u32x2*)(dst + 16) = (pg::u32x2){pk2(C[4], C[5]), pk2(C[6], C[7])};
            if (c < 15) { const pg::u32x4 w = U[c];
                C[0] = C[0] * dc[c] + __builtin_bit_cast(float, w.x << 16); C[1] = C[1] * dc[c] + __builtin_bit_cast(float, w.x & 0xffff0000u);
                C[2] = C[2] * dc[c] + __builtin_bit_cast(float, w.y << 16); C[3] = C[3] * dc[c] + __builtin_bit_cast(float, w.y & 0xffff0000u);
                C[4] = C[4] * dc[c] + __builtin_bit_cast(float, w.z << 16); C[5] = C[5] * dc[c] + __builtin_bit_cast(float, w.z & 0xffff0000u);
                C[6] = C[6] * dc[c] + __builtin_bit_cast(float, w.w << 16); C[7] = C[7] * dc[c] + __builtin_bit_cast(float, w.w & 0xffff0000u); } } }
}
__device__ __forceinline__ void ph_den_inter(LAS unsigned char* lds, const OptBufs3& o3) {
    const int tid = tidf(), lane = tid & 63, wave = tid >> 6; LAS float* nn = (LAS float*)lds;
    for (int it = blockIdx.x; it < 256; it += gridDim.x) { const int bh = it >> 4, c = it & 15, b = bh >> 2, h = bh & 3; const size_t tok0 = (size_t)b * SEQ + c * 256;
        __syncthreads();
        if (tid < 256) { float n = 0.f; for (int j = 0; j < c; ++j) n = n * o3.decay[bh * 16 + j] + o3.un[(size_t)(bh * 16 + j) * 256 + tid]; nn[tid] = n; }
        __syncthreads();
        const pg::f32x4 nv = *(const LAS pg::f32x4*)(nn + 4 * lane);
        for (int r0 = 0; r0 < 32; r0 += 8) { pg::u32x2 wv[8];
#pragma unroll
            for (int r = 0; r < 8; ++r) wv[r] = *(const pg::u32x2*)(o3.A2 + (tok0 + wave * 32 + r0 + r) * 2048 + h * 512 + 256 + 4 * lane);
#pragma unroll
            for (int r = 0; r < 8; ++r) { const size_t t = tok0 + wave * 32 + r0 + r; const pg::u32x2 w = wv[r];
                float s = __builtin_bit_cast(float, w.x << 16) * nv[0] + __builtin_bit_cast(float, w.x & 0xffff0000u) * nv[1] + __builtin_bit_cast(float, w.y << 16) * nv[2] + __builtin_bit_cast(float, w.y & 0xffff0000u) * nv[3];
                s = wsum(s);
                if (lane == 0) o3.den[t * 4 + h] += s; } } }
    __syncthreads();
}

__device__ __forceinline__ void ph_gemms_D(LAS unsigned char* lds, const OptBufs2& o, const OptBufs3& o3, const float* b_pool, const float* ls_pool) {
    const int G = gridDim.x, bx = blockIdx.x;
    { SchedG S; S.o.init(T / 256, 2, 1, G, bx); S.A = (const char*)o.POOLED; S.B = (const char*)o.WpoolT; S.gA = 0; S.gB = 0; S.tA = (size_t)256 * 512 * 2; S.tB = (size_t)256 * 512 * 2;
      EpiPoolMixB E{o.MIXED, b_pool, ls_pool}; pg::gemm_phase<EpiPoolMixB, SchedG>(lds, 512, 512, 512, S, E); }
    { SchedG S; S.o.init(T / 256, 1, 4, G, (bx + 128) % G); S.A = (const char*)o.UC; S.B = (const char*)o.WqT; S.gA = 256 * 2; S.gB = (size_t)65536 * 2; S.tA = (size_t)256 * 1024 * 2; S.tB = 0;
      EpiQ E{o.Q, o3.A2, o3.winter}; pg::gemm_phase<EpiQ, SchedG>(lds, 1024, 256, 256, S, E); }
    { SchedG S; S.o.init(T / 256, 1, 4, G, (bx + 128) % G); S.A = (const char*)o.UC; S.B = (const char*)o.WkT; S.gA = 256 * 2; S.gB = (size_t)65536 * 2; S.tA = (size_t)256 * 1024 * 2; S.tB = 0;
      pg::EpiStoreBf16 E{o.K, 1024, 1.f, 256}; pg::gemm_phase<pg::EpiStoreBf16, SchedG>(lds, 1024, 256, 256, S, E); }
    { SchedG S; S.o.init(1, T / 256, 4, G, bx); S.A = (const char*)o.WkT; S.B = (const char*)o.UC; S.gA = (size_t)65536 * 2; S.gB = 256 * 2; S.tA = 0; S.tB = (size_t)256 * 1024 * 2;
      EpiKT E{o3.KaT, o3.aw}; pg::gemm_phase<EpiKT, SchedG>(lds, 256, 1024, 256, S, E); }
}
__device__ __forceinline__ void ph_gemms_E(LAS unsigned char* lds, const OptBufs& ob, const OptBufs2& o2, const OptBufs3& o3) {
    const int G = gridDim.x, bx = blockIdx.x;
    ph_un(lds, o2, o3);
    { SchedG1 S; S.o.init(1, 1, 256, G, bx); S.Q = (const char*)o2.Q; S.K = (const char*)o2.K;
      EpiS E{o3.A2, o3.rowv, o3.colv, o3.den}; pg::gemm_phase<EpiS, SchedG1>(lds, 1024, 1024, 256, S, E); }
    { SchedG2 S; S.o.init(1, 1, 240, G, bx); S.BT2 = (const char*)ob.BT2; S.KaT = (const char*)o3.KaT;
      EpiF32U E{o3.U}; pg::gemm_phase<EpiF32U, SchedG2>(lds, 512, T, 256, S, E); }
}
__device__ __forceinline__ void ph_gemm_G3(LAS unsigned char* lds, const OptBufs& ob, const OptBufs3& o3, const float* gain) {
    SchedG3 S; S.o.init(1, 1, 256, gridDim.x, blockIdx.x); S.A2 = (const char*)o3.A2; S.BT2 = (const char*)ob.BT2;
    EpiNum E{o3.HOUT, ob.OGQ, o3.den, o3.emt, gain}; pg::gemm_phase<EpiNum, SchedG3>(lds, 2048, 512, 512, S, E);
}
__device__ __forceinline__ void ph_gemm_ypool(LAS unsigned char* lds, const OptBufs2& o) {
    const int G = gridDim.x, bx = blockIdx.x;
    SchedG S; S.o.init(T / 256, 4, 1, G, bx); S.A = (const char*)o.MIXED; S.B = (const char*)o.WbpT; S.gA = 0; S.gB = 0; S.tA = (size_t)256 * 512 * 2; S.tB = (size_t)256 * 512 * 2;
    pg::EpiStoreBf16 E{o.YPOOL, 1024, 1.f, 0}; pg::gemm_phase<pg::EpiStoreBf16, SchedG>(lds, 512, 512, 512, S, E);
}


struct OptBufs4 { pg::bf16_t *WbmT, *WoutT, *MERGED, *H1B; unsigned char* H1Q; float *Z, *WRP, *CGB; int *elist, *erank; float *gate; };
struct EpiMerge {
    static constexpr bool PERM = true, AFTER_DRAIN = false, BIAS = false;
    pg::bf16_t* O; const unsigned char* OGQ; const pg::bf16_t* YPOOL;
    __device__ __forceinline__ void operator()(const pg::f32x4 (&acc)[2][2][4][2], const pg::Unit& u, int wr, int wc, int fr, int fq) const {
        const int col0 = u.pn * 256 + wc * 32 + 8 * fq;
#pragma unroll
        for (int ai = 0; ai < 2; ++ai)
#pragma unroll
            for (int m = 0; m < 4; ++m) { const size_t t = (size_t)u.pm * 256 + ai * 128 + wr * 64 + m * 16 + fr;
                const unsigned char* gp = OGQ + t * 3072 + (4 + u.pn) * 256 + (wc * 4 + fq) * 16;
                const pg::u32x4 w0 = *(const pg::u32x4*)gp, w1 = *(const pg::u32x4*)(gp + 1024);
#pragma unroll
                for (int bj = 0; bj < 2; ++bj) { const int c = col0 + bj * 128; float g0[8], g1[8], yp[8], r[8]; float f[4];
                    fp8x4_to_f32(bj ? w0.z : w0.x, f); g0[0] = f[0]; g0[1] = f[1]; g0[2] = f[2]; g0[3] = f[3];
                    fp8x4_to_f32(bj ? w0.w : w0.y, f); g0[4] = f[0]; g0[5] = f[1]; g0[6] = f[2]; g0[7] = f[3];
                    fp8x4_to_f32(bj ? w1.z : w1.x, f); g1[0] = f[0]; g1[1] = f[1]; g1[2] = f[2]; g1[3] = f[3];
                    fp8x4_to_f32(bj ? w1.w : w1.y, f); g1[4] = f[0]; g1[5] = f[1]; g1[6] = f[2]; g1[7] = f[3];
                    ld8(YPOOL + t * 1024 + c, yp);
#pragma unroll
                    for (int j = 0; j < 8; ++j) { const float a_ = (j < 4) ? acc[ai][bj][m][0][j] : acc[ai][bj][m][1][j - 4]; r[j] = fsigmoid(g0[j]) * yp[j] + fsigmoid(g1[j]) * a_; }
                    st8(O + t * 1024 + c, r); }
                asm volatile("" ::: "memory"); }
    }
};
struct EpiMixRes {
    static constexpr bool PERM = true, AFTER_DRAIN = false, BIAS = false;
    pg::bf16_t* Z; const pg::bf16_t* H0B;
    __device__ __forceinline__ void operator()(const pg::f32x4 (&acc)[2][2][4][2], const pg::Unit& u, int wr, int wc, int fr, int fq) const {
        const int col0 = u.pn * 256 + wc * 32 + 8 * fq;
#pragma unroll
        for (int ai = 0; ai < 2; ++ai)
#pragma unroll
            for (int m = 0; m < 4; ++m) { const size_t t = (size_t)u.pm * 256 + ai * 128 + wr * 64 + m * 16 + fr;
#pragma unroll
                for (int bj = 0; bj < 2; ++bj) { const int c = col0 + bj * 128; float h[8], r[8]; ld8(H0B + t * 1024 + c, h);
#pragma unroll
                    for (int j = 0; j < 8; ++j) { const float a_ = (j < 4) ? acc[ai][bj][m][0][j] : acc[ai][bj][m][1][j - 4]; r[j] = h[j] * ALPHA + a_; }
                    st8(Z + t * 1024 + c, r); }
                asm volatile("" ::: "memory"); }
    }
};
__device__ __forceinline__ void ph_gemm_ymls(LAS unsigned char* lds, const OptBufs& ob, const OptBufs2& o2, const OptBufs3& o3, const OptBufs4& o4) {
    SchedG S; S.o.init(T / 256, 4, 1, gridDim.x, blockIdx.x); S.A = (const char*)o3.HOUT; S.B = (const char*)o4.WbmT; S.gA = 0; S.gB = 0; S.tA = (size_t)256 * 1024 * 2; S.tB = (size_t)256 * 1024 * 2;
    EpiMerge E{o4.MERGED, ob.OGQ, o2.YPOOL}; pg::gemm_phase<EpiMerge, SchedG>(lds, 1024, 1024, 1024, S, E);
}
__device__ __forceinline__ void ph_gemm_mix(LAS unsigned char* lds, const OptBufs& ob, const OptBufs4& o4, const float* x, const float* g, const float* beta) {
    SchedG S; S.o.init(T / 256, 4, 1, gridDim.x, blockIdx.x); S.A = (const char*)o4.MERGED; S.B = (const char*)o4.WoutT; S.gA = 0; S.gB = 0; S.tA = (size_t)256 * 1024 * 2; S.tB = (size_t)256 * 1024 * 2;
    EpiMixRes E{(pg::bf16_t*)o4.Z, ob.H0B}; pg::gemm_phase<EpiMixRes, SchedG>(lds, 1024, 1024, 1024, S, E);
}
typedef float f32x16 __attribute__((ext_vector_type(16)));
__device__ __forceinline__ void ph_router_prep(const OptBufs4& o, const float* g, const float* beta, const float* wr_, const float* br) {
    const int gt = blockIdx.x * NT + tidf(), ngt = gridDim.x * NT;
    for (int i = gt; i < 1024 * 32; i += ngt) o.WRP[i] = g[i >> 5] * wr_[i];
    const int gw = gt >> 6, lane = gt & 63;
    if (gw < 64) { const int e = gw & 31; const float* vsrc = (gw < 32) ? g : beta; float s_ = 0.f;
#pragma unroll
        for (int i = 0; i < 16; ++i) { const int k = lane + 64 * i; s_ += vsrc[k] * wr_[k * 32 + e]; }
        s_ = wsum(s_);
        if (lane == 0) o.CGB[gw] = s_ + ((gw < 32) ? 0.f : br[e]); }
}
__device__ __forceinline__ pg::f32x4 ldz4(const pg::bf16_t* p) { const pg::u32x2 w = *(const pg::u32x2*)p; return (pg::f32x4){__builtin_bit_cast(float, w.x << 16), __builtin_bit_cast(float, w.x & 0xffff0000u), __builtin_bit_cast(float, w.y << 16), __builtin_bit_cast(float, w.y & 0xffff0000u)}; }
__device__ __forceinline__ void ph_ln1_router(LAS unsigned char* lds, const OptBufs4& o, const float* Zin, const float* g, const float* beta, int* cnt, int mode = 7) {
    const int tid = tidf(), lane = tid & 63, wave = tid >> 6; const pg::bf16_t* Zb = (const pg::bf16_t*)Zin;
    LAS float* part = (LAS float*)lds;
    LAS float* stg = (LAS float*)(lds + wave * 9216);
    LAS float* L = (LAS float*)(lds + 81920);
    LAS float* st = (LAS float*)(lds + 81920 + 8448);
    LAS int* hist = (LAS int*)(lds + 131072 + 1024);
    LAS int* asg = (LAS int*)(lds + 131072 + 1024 + 256);
    for (int tile = blockIdx.x; tile < T / 64; tile += gridDim.x) {
        __syncthreads();
        if (tid < 64) hist[tid] = 0;
        const size_t tbase = (size_t)tile * 64 + wave * 8;
        pg::f32x4 va[4];
#pragma unroll
        for (int j = 0; j < 4; ++j) va[j] = ldz4(Zb + tbase * D + 256 * j + 4 * lane);
        for (int r = 0; r < ((mode & 1) ? 8 : 0); ++r) {
            pg::f32x4 na[4];
            if (r < 7) {
#pragma unroll
                for (int j = 0; j < 4; ++j) na[j] = ldz4(Zb + (tbase + r + 1) * D + 256 * j + 4 * lane); }
            float sa = 0.f;
#pragma unroll
            for (int j = 0; j < 4; ++j) sa += (va[j].x + va[j].y) + (va[j].z + va[j].w);
            const float ma = wsum(sa) * (1.f / D); float qa = 0.f;
#pragma unroll
            for (int j = 0; j < 4; ++j) { va[j] = va[j] - ma; qa += (va[j].x * va[j].x + va[j].y * va[j].y) + (va[j].z * va[j].z + va[j].w * va[j].w); }
            const float ra = rsqrtf(wsum(qa) * (1.f / D) + LN_EPS);
            const size_t ta = tbase + r;
            if (lane == 0) { st[(wave * 8 + r) * 2] = ma; st[(wave * 8 + r) * 2 + 1] = ra; }
#pragma unroll
            for (int j = 0; j < 4; ++j) { const int c0 = 256 * j + 4 * lane;
                const pg::f32x4 gg = *(const pg::f32x4*)(g + c0), bb = *(const pg::f32x4*)(beta + c0);
                const pg::f32x4 y = va[j] * ra * gg + bb;
                *(unsigned long long*)(o.H1B + ta * D + c0) = (unsigned long long)pk2(y.x, y.y) | ((unsigned long long)pk2(y.z, y.w) << 32);
                int w0 = __builtin_amdgcn_cvt_pk_fp8_f32(y.x, y.y, 0, false); w0 = __builtin_amdgcn_cvt_pk_fp8_f32(y.z, y.w, w0, true); *(int*)(o.H1Q + ta * D + c0) = w0; }
#pragma unroll
            for (int j = 0; j < 4; ++j) va[j] = na[j];
        }
        if (mode & 2) { const int hh = lane >> 5, el = lane & 31, kb = wave * 128;
          f32x16 acc0, acc1;
#pragma unroll
          for (int i = 0; i < 16; ++i) { acc0[i] = 0.f; acc1[i] = 0.f; }
          const pg::bf16_t* zt = Zb + (size_t)tile * 64 * D + kb;
          pg::f32x4 zv[8];
#pragma unroll
          for (int it = 0; it < 8; ++it) zv[it] = ldz4(zt + (size_t)(it * 8 + (lane >> 3)) * D + 4 * (lane & 7));
#pragma unroll 1
          for (int sub = 0; sub < 4; ++sub) {
              float bw[16];
#pragma unroll
              for (int s_ = 0; s_ < 16; ++s_) bw[s_] = o.WRP[(size_t)(kb + 32 * sub + 16 * hh + s_) * 32 + el];
#pragma unroll
              for (int it = 0; it < 8; ++it) *(LAS pg::f32x4*)(stg + (it * 8 + (lane >> 3)) * 36 + 4 * (lane & 7)) = zv[it];
              if (sub < 3) {
#pragma unroll
                  for (int it = 0; it < 8; ++it) zv[it] = ldz4(zt + (size_t)(it * 8 + (lane >> 3)) * D + 32 * (sub + 1) + 4 * (lane & 7)); }
              asm volatile("s_waitcnt lgkmcnt(0)" ::: "memory");
              pg::f32x4 a0[4], a1[4];
#pragma unroll
              for (int q = 0; q < 4; ++q) { a0[q] = *(const LAS pg::f32x4*)(stg + el * 36 + 16 * hh + 4 * q); a1[q] = *(const LAS pg::f32x4*)(stg + (32 + el) * 36 + 16 * hh + 4 * q); }
#pragma unroll
              for (int q = 0; q < 4; ++q) {
                  acc0 = __builtin_amdgcn_mfma_f32_32x32x2f32(a0[q].x, bw[4 * q + 0], acc0, 0, 0, 0); acc1 = __builtin_amdgcn_mfma_f32_32x32x2f32(a1[q].x, bw[4 * q + 0], acc1, 0, 0, 0);
                  acc0 = __builtin_amdgcn_mfma_f32_32x32x2f32(a0[q].y, bw[4 * q + 1], acc0, 0, 0, 0); acc1 = __builtin_amdgcn_mfma_f32_32x32x2f32(a1[q].y, bw[4 * q + 1], acc1, 0, 0, 0);
                  acc0 = __builtin_amdgcn_mfma_f32_32x32x2f32(a0[q].z, bw[4 * q + 2], acc0, 0, 0, 0); acc1 = __builtin_amdgcn_mfma_f32_32x32x2f32(a1[q].z, bw[4 * q + 2], acc1, 0, 0, 0);
                  acc0 = __builtin_amdgcn_mfma_f32_32x32x2f32(a0[q].w, bw[4 * q + 3], acc0, 0, 0, 0); acc1 = __builtin_amdgcn_mfma_f32_32x32x2f32(a1[q].w, bw[4 * q + 3], acc1, 0, 0, 0); }
              asm volatile("s_waitcnt lgkmcnt(0)" ::: "memory");
          }
          __syncthreads();
#pragma unroll
          for (int i = 0; i < 16; ++i) { part[((wave * 2 + 0) * 16 + i) * 64 + lane] = acc0[i]; part[((wave * 2 + 1) * 16 + i) * 64 + lane] = acc1[i]; }
        } else __syncthreads();
        __syncthreads();
#pragma unroll
        for (int i = 0; i < 4; ++i) { const int idx = tid + 512 * i; float sum = 0.f;
#pragma unroll
            for (int w = 0; w < 8; ++w) sum += part[w * 2048 + idx];
            const int mt = idx >> 10, rg = (idx >> 6) & 15, l2 = idx & 63, tok = mt * 32 + (rg & 3) + 8 * (rg >> 2) + 4 * (l2 >> 5), e = l2 & 31;
            L[tok * 33 + e] = st[tok * 2 + 1] * (sum - st[tok * 2] * o.CGB[e]) + o.CGB[32 + e]; }
        __syncthreads();
        if (tid < 64 && (mode & 4)) { const LAS float* lr_ = L + tid * 33; int i0 = -1, i1 = -1, i2 = -1, i3 = -1; float v0 = 0.f, v1 = 0.f, v2 = 0.f, v3 = 0.f;
#pragma unroll
            for (int k = 0; k < 4; ++k) { float bv = -INFINITY; int bi = 0;
                for (int e = 0; e < 32; ++e) { const float x = lr_[e]; if (e != i0 && e != i1 && e != i2 && x > bv) { bv = x; bi = e; } }
                if (k == 0) { i0 = bi; v0 = bv; } else if (k == 1) { i1 = bi; v1 = bv; } else if (k == 2) { i2 = bi; v2 = bv; } else { i3 = bi; v3 = bv; } }
            const float e1 = expf(v1 - v0), e2 = expf(v2 - v0), e3 = expf(v3 - v0), inv = 1.f / (1.f + e1 + e2 + e3);
            const size_t t = (size_t)tile * 64 + tid;
            *(pg::f32x4*)(o.gate + t * 4) = (pg::f32x4){inv, e1 * inv, e2 * inv, e3 * inv};
            const int r0 = atomicAdd((int*)(hist + i0), 1), r1 = atomicAdd((int*)(hist + i1), 1), r2 = atomicAdd((int*)(hist + i2), 1), r3 = atomicAdd((int*)(hist + i3), 1);
            asg[tid * 4 + 0] = i0 | (r0 << 8); asg[tid * 4 + 1] = i1 | (r1 << 8); asg[tid * 4 + 2] = i2 | (r2 << 8); asg[tid * 4 + 3] = i3 | (r3 << 8); }
        __syncthreads();
        if (tid < 32) hist[32 + tid] = atomicAdd(&cnt[tid], hist[tid]);
        __syncthreads();
        if (tid < 256) { const int a_ = asg[tid], e = a_ & 255, rank = hist[32 + e] + (a_ >> 8); const int t = tile * 64 + (tid >> 2);
            o.elist[e * T + rank] = t; o.erank[(size_t)t * 4 + (tid & 3)] = (e << 16) | rank; }
    }
    __syncthreads();
}
struct OptBufs5 { pg::bf16_t *We1T, *We2T, *ACT, *Y; float* B1P; };
constexpr int MOE_TAB_OFF = 131072 + 4096;
__device__ __forceinline__ void moe_build_tab(LAS unsigned char* lds, const int* cnt) {
    LAS int* tab = (LAS int*)(lds + MOE_TAB_OFF);
    __syncthreads();
    if (tidf() == 0) { int s = 0; for (int e = 0; e < NE; ++e) { const int c = cnt[e]; tab[e] = s; tab[40 + e] = c; s += (c + 255) >> 8; } tab[NE] = s; }
    __syncthreads();
}
struct SchedMoE {
    const LAS int* tab; const int* cnt; const int* elist; const char* A; const char* B; size_t eB; int nN, nwg, G, c, gather;
    __device__ __forceinline__ bool next(int i, pg::Unit& u) const {
        const long L = (long)i * G + c; if (L >= nwg) return false;
        int wgid = (int)L; { const int q = nwg / pg::NXCD, r = nwg % pg::NXCD, xcd = wgid % pg::NXCD, off = wgid / pg::NXCD; wgid = (xcd < r ? xcd * (q + 1) : r * (q + 1) + (xcd - r) * q) + off; }
        const int mg = wgid / nN, pn = wgid - mg * nN;
        const int ln = tidf() & 63, tv = tab[ln < NE ? ln : NE];
        const int e = __builtin_amdgcn_readfirstlane(__popcll(__ballot(ln >= 1 && ln < NE && tv <= mg)));
        const int mt = mg - __builtin_amdgcn_readlane(tv, e);
        u.g = e; u.pm = mg; u.pn = pn; u.aux = mg * 256;
        u.B = B + (size_t)e * eB + (size_t)pn * 256 * 1024;
        if (gather) { u.A = A; u.rows = elist + (size_t)e * T + mt * 256; const int rem = __builtin_amdgcn_readfirstlane(tab[40 + e]) - mt * 256; u.nvalid = rem < 256 ? rem : 256; }
        else { u.A = A + (size_t)mg * 256 * 1024; u.rows = nullptr; u.nvalid = 0; }
        return true;
    }
};
struct EpiSwiglu {
    static constexpr bool PERM = true, AFTER_DRAIN = false, BIAS = true;
    unsigned char* ACT; const float* B1P;
    __device__ __forceinline__ const float* bias_base(const pg::Unit& u) const { return B1P + u.g * 2048 + u.pn * 256; }
    __device__ __forceinline__ void operator()(const pg::f32x4 (&acc)[2][2][4][2], const pg::Unit& u, int wr, int wc, int fr, int fq) const {
        const int col0 = wc * 32 + 8 * fq;
        unsigned char* base = ACT + (size_t)(u.aux + wr * 64 + fr) * 1024 + u.pn * 128 + col0;
#pragma unroll
        for (int ai = 0; ai < 2; ++ai)
#pragma unroll
            for (int m = 0; m < 4; ++m) { float r[8];
#pragma unroll
                for (int j = 0; j < 8; ++j) { float g = (j < 4) ? acc[ai][0][m][0][j] : acc[ai][0][m][1][j - 4];
                    float l = (j < 4) ? acc[ai][1][m][0][j] : acc[ai][1][m][1][j - 4];
                    g = fminf(g, 7.f); l = fminf(fmaxf(l, -7.f), 7.f);
                    r[j] = g * (l + 1.f) * __builtin_amdgcn_rcpf(1.f + __expf(-1.702f * g)); }
                { int w0 = __builtin_amdgcn_cvt_pk_fp8_f32(r[0], r[1], 0, false); w0 = __builtin_amdgcn_cvt_pk_fp8_f32(r[2], r[3], w0, true);
                  int w1 = __builtin_amdgcn_cvt_pk_fp8_f32(r[4], r[5], 0, false); w1 = __builtin_amdgcn_cvt_pk_fp8_f32(r[6], r[7], w1, true);
                  *(pg::u32x2*)(base + (size_t)(ai * 128 + m * 16) * 1024) = (pg::u32x2){(unsigned)w0, (unsigned)w1}; }
                asm volatile("" ::: "memory"); }
    }
};
struct EpiY {
    static constexpr bool PERM = true, AFTER_DRAIN = false, BIAS = true;
    unsigned char* Y; const float* b2;
    __device__ __forceinline__ const float* bias_base(const pg::Unit& u) const { return b2 + u.g * 1024 + u.pn * 256; }
    __device__ __forceinline__ void operator()(const pg::f32x4 (&acc)[2][2][4][2], const pg::Unit& u, int wr, int wc, int fr, int fq) const {
        unsigned char* base = Y + (size_t)(u.aux + wr * 64 + fr) * 1024 + u.pn * 256 + (wc * 4 + fq) * 16;
#pragma unroll
        for (int ai = 0; ai < 2; ++ai)
#pragma unroll
            for (int m = 0; m < 4; ++m) { pg::u32x4 w;
                { const pg::f32x4 v0 = acc[ai][0][m][0] * 16.f, v1 = acc[ai][0][m][1] * 16.f;
                  int p = __builtin_amdgcn_cvt_pk_fp8_f32(v0[0], v0[1], 0, false); p = __builtin_amdgcn_cvt_pk_fp8_f32(v0[2], v0[3], p, true); w.x = (unsigned)p;
                  p = __builtin_amdgcn_cvt_pk_fp8_f32(v1[0], v1[1], 0, false); p = __builtin_amdgcn_cvt_pk_fp8_f32(v1[2], v1[3], p, true); w.y = (unsigned)p; }
                { const pg::f32x4 v0 = acc[ai][1][m][0] * 16.f, v1 = acc[ai][1][m][1] * 16.f;
                  int p = __builtin_amdgcn_cvt_pk_fp8_f32(v0[0], v0[1], 0, false); p = __builtin_amdgcn_cvt_pk_fp8_f32(v0[2], v0[3], p, true); w.z = (unsigned)p;
                  p = __builtin_amdgcn_cvt_pk_fp8_f32(v1[0], v1[1], 0, false); p = __builtin_amdgcn_cvt_pk_fp8_f32(v1[2], v1[3], p, true); w.w = (unsigned)p; }
                *(pg::u32x4*)(base + (size_t)(ai * 128 + m * 16) * 1024) = w; asm volatile("" ::: "memory"); }
    }
};
struct EpiNull { static constexpr bool PERM = true, AFTER_DRAIN = false, BIAS = false;
    float* sink;
    __device__ __forceinline__ void operator()(const pg::f32x4 (&acc)[2][2][4][2], const pg::Unit& u, int wr, int wc, int fr, int fq) const {
        float s_ = 0.f;
#pragma unroll
        for (int ai = 0; ai < 2; ++ai)
#pragma unroll
            for (int bj = 0; bj < 2; ++bj)
#pragma unroll
                for (int m = 0; m < 4; ++m)
#pragma unroll
                    for (int n = 0; n < 2; ++n) s_ += acc[ai][bj][m][n][0];
        if (s_ == 1.2345e30f) sink[0] = s_; } };
__device__ __forceinline__ void ph_moe1_probe(LAS unsigned char* lds, const OptBufs4& o4, const OptBufs5& o5, const int* cnt, int mode, unsigned char* dummy) {
    moe_build_tab(lds, cnt);
    SchedMoE S; S.tab = (const LAS int*)(lds + MOE_TAB_OFF); S.cnt = cnt; S.elist = o4.elist; S.A = (const char*)o4.H1Q; S.B = (const char*)o5.We1T; S.eB = (size_t)2048 * 1024;
    S.nN = 8; S.nwg = __builtin_amdgcn_readfirstlane(S.tab[NE]) * 8; S.G = gridDim.x; S.c = blockIdx.x; S.gather = 1;
    if (mode == 0) { EpiSwiglu E{dummy, o5.B1P}; pg::gemm_phase<EpiSwiglu, SchedMoE, true, true>(lds, 512, 512, 512, S, E); }
    if (mode == 1) { S.gather = 0; S.A = (const char*)o5.ACT; EpiSwiglu E{dummy, o5.B1P}; pg::gemm_phase<EpiSwiglu, SchedMoE, false, true>(lds, 512, 512, 512, S, E); }
    if (mode == 2) { EpiNull E{(float*)dummy}; pg::gemm_phase<EpiNull, SchedMoE, true, true>(lds, 512, 512, 512, S, E); }
    if (mode == 3) { S.gather = 0; S.A = (const char*)o5.ACT; EpiNull E{(float*)dummy}; pg::gemm_phase<EpiNull, SchedMoE, false, true>(lds, 512, 512, 512, S, E); }
}
__device__ __forceinline__ void ph_moe1(LAS unsigned char* lds, const OptBufs4& o4, const OptBufs5& o5, const int* cnt) {
    moe_build_tab(lds, cnt);
    SchedMoE S; S.tab = (const LAS int*)(lds + MOE_TAB_OFF); S.cnt = cnt; S.elist = o4.elist; S.A = (const char*)o4.H1Q; S.B = (const char*)o5.We1T; S.eB = (size_t)2048 * 1024;
    S.nN = 8; S.nwg = __builtin_amdgcn_readfirstlane(S.tab[NE]) * 8; S.G = gridDim.x; S.c = blockIdx.x; S.gather = 1;
    EpiSwiglu E{(unsigned char*)o5.ACT, o5.B1P}; pg::gemm_phase<EpiSwiglu, SchedMoE, true, true>(lds, 512, 512, 512, S, E);
}
__device__ __forceinline__ void ph_moe2(LAS unsigned char* lds, const OptBufs5& o5, const int* cnt, const float* b_e2) {
    moe_build_tab(lds, cnt);
    SchedMoE S; S.tab = (const LAS int*)(lds + MOE_TAB_OFF); S.cnt = cnt; S.elist = nullptr; S.A = (const char*)o5.ACT; S.B = (const char*)o5.We2T; S.eB = (size_t)1024 * 1024;
    S.nN = 4; S.nwg = __builtin_amdgcn_readfirstlane(S.tab[NE]) * 4; S.G = gridDim.x; S.c = blockIdx.x; S.gather = 0;
    EpiY E{(unsigned char*)o5.Y, b_e2}; pg::gemm_phase<EpiY, SchedMoE, false, true>(lds, 512, 512, 512, S, E);
}
__device__ __forceinline__ void ph_final_opt(LAS unsigned char* lds, const OptBufs4& o4, const OptBufs5& o5, const int* cnt, const float* g, const float* beta, float* out) {
    moe_build_tab(lds, cnt);
    const LAS int* tab = (const LAS int*)(lds + MOE_TAB_OFF);
    const int tid = tidf(), lane = tid & 63, gw = blockIdx.x * NW + (tid >> 6), ngw = gridDim.x * NW;
    const int cbase = (lane >> 4) * 256 + ((lane >> 2) & 3) * 32 + (lane & 3) * 8;
    const unsigned char* Y8 = (const unsigned char*)o5.Y;
    for (int t = gw; t < T; t += ngw) {
        float v[16];
        { float h[8]; ld8(o4.H1B + (size_t)t * D + cbase, h);
#pragma unroll
          for (int j = 0; j < 8; ++j) v[j] = h[j] * ALPHA;
          ld8(o4.H1B + (size_t)t * D + cbase + 128, h);
#pragma unroll
          for (int j = 0; j < 8; ++j) v[8 + j] = h[j] * ALPHA; }
#pragma unroll
        for (int k = 0; k < 4; ++k) { const int er = o4.erank[(size_t)t * 4 + k]; const float gk = o4.gate[(size_t)t * 4 + k] * 0.0625f;
            const pg::u32x4 w = *(const pg::u32x4*)(Y8 + (size_t)(tab[er >> 16] * 256 + (er & 0xffff)) * 1024 + lane * 16);
            float f[4];
            fp8x4_to_f32(w.x, f); v[0] += gk * f[0]; v[1] += gk * f[1]; v[2] += gk * f[2]; v[3] += gk * f[3];
            fp8x4_to_f32(w.y, f); v[4] += gk * f[0]; v[5] += gk * f[1]; v[6] += gk * f[2]; v[7] += gk * f[3];
            fp8x4_to_f32(w.z, f); v[8] += gk * f[0]; v[9] += gk * f[1]; v[10] += gk * f[2]; v[11] += gk * f[3];
            fp8x4_to_f32(w.w, f); v[12] += gk * f[0]; v[13] += gk * f[1]; v[14] += gk * f[2]; v[15] += gk * f[3]; }
        float s_ = 0.f;
#pragma unroll
        for (int j = 0; j < 16; ++j) s_ += v[j];
        const float mean = wsum(s_) * (1.f / D); float s2 = 0.f;
#pragma unroll
        for (int j = 0; j < 16; ++j) { v[j] -= mean; s2 += v[j] * v[j]; }
        const float rstd = rsqrtf(wsum(s2) * (1.f / D) + LN_EPS);
#pragma unroll
        for (int run = 0; run < 2; ++run)
#pragma unroll
            for (int q = 0; q < 2; ++q) { const int c0 = cbase + run * 128 + q * 4;
                const pg::f32x4 gg = *(const pg::f32x4*)(g + c0), bb = *(const pg::f32x4*)(beta + c0);
                pg::f32x4 y; y.x = v[run * 8 + q * 4 + 0] * rstd; y.y = v[run * 8 + q * 4 + 1] * rstd; y.z = v[run * 8 + q * 4 + 2] * rstd; y.w = v[run * 8 + q * 4 + 3] * rstd;
                *(pg::f32x4*)(out + (size_t)t * D + c0) = y * gg + bb; }
    }
}


struct PrepSrc { const float *w_in, *w_q, *w_k, *w_pool, *w_bp, *w_bm, *w_out, *w_e1, *w_e2, *b_e1; };
constexpr int TI_E1 = 16384, TI_E2 = 8192, TI_IN = (WIN_ROWS / 64) * 16, TI_MO = 512, TI_QK = 128, TI_BP = 128, TI_PL = 16;
constexpr int TI_TOTAL = TI_E1 + TI_E2 + TI_IN + TI_MO + TI_QK + TI_BP + TI_PL;
__device__ __forceinline__ TItem titem_decode(int it, const PrepSrc& p, const OptBufs& ob, const OptBufs2& o2, const OptBufs4& o4, const OptBufs5& o5) {
    TItem t; t.inter = 0; t.fp8 = 0; t.valid = it < TI_TOTAL; t.src = p.w_in; t.dst = ob.WinT; t.ldw = 64; t.ldt = 64;
    if (!t.valid) return t;
    if (it < TI_E1) { const int nb = it & 31, kb = (it >> 5) & 15, e = it >> 9, j0 = nb * 32, pn = j0 >> 7, jj0 = j0 & 127;
        t.src = p.w_e1 + (size_t)e * 1024 * 2048 + (size_t)(kb * 64) * 2048 + nb * 64; t.dst = (pg::bf16_t*)((unsigned char*)o5.We1T + (size_t)e * 2048 * 1024 + (size_t)(pn * 256 + jj0) * 1024 + kb * 64); t.ldw = 2048; t.ldt = 1024; t.inter = 1; t.fp8 = 1; return t; }
    it -= TI_E1;
    if (it < TI_E2) { const int nb = it & 15, kb = (it >> 4) & 15, e = it >> 8;
        t.src = p.w_e2 + (size_t)e * 1024 * 1024 + (size_t)(kb * 64) * 1024 + nb * 64; t.dst = (pg::bf16_t*)((unsigned char*)o5.We2T + (size_t)e * 1024 * 1024 + (size_t)(nb * 64) * 1024 + kb * 64); t.ldw = 1024; t.ldt = 1024; t.fp8 = 1; return t; }
    it -= TI_E2;
    if (it < TI_IN) { const int rb = it >> 4, kb = it & 15;
        t.src = p.w_in + (size_t)(kb * 64) * INC + win_src_col(rb * 64); t.ldw = INC; t.ldt = D;
        if (rb * 64 >= PJ_O && rb * 64 < PROJW) { t.dst = (pg::bf16_t*)(ob.WinQ + (size_t)(rb * 64 - PJ_O) * D + kb * 64); t.fp8 = 1; }
        else t.dst = ob.WinT + (size_t)(rb * 64) * D + kb * 64;
        return t; }
    it -= TI_IN;
    if (it < TI_MO) { const int which = it >> 8, r = it & 255, nb = r >> 4, kb = r & 15;
        t.src = (which ? p.w_out : p.w_bm) + (size_t)(kb * 64) * 1024 + nb * 64; t.dst = (which ? o4.WoutT : o4.WbmT) + (size_t)(nb * 64) * 1024 + kb * 64; t.ldw = 1024; t.ldt = 1024; return t; }
    it -= TI_MO;
    if (it < TI_QK) { const int which = it >> 6, r = it & 63, h = r >> 4, nb = (r & 15) >> 2, kb = r & 3;
        t.src = (which ? p.w_k : p.w_q) + (size_t)h * 65536 + (size_t)(kb * 64) * 256 + nb * 64; t.dst = (which ? o2.WkT : o2.WqT) + (size_t)h * 65536 + (size_t)(nb * 64) * 256 + kb * 64; t.ldw = 256; t.ldt = 256; return t; }
    it -= TI_QK;
    if (it < TI_BP) { const int nb = it >> 3, kb = it & 7;
        t.src = p.w_bp + (size_t)(kb * 64) * 1024 + nb * 64; t.dst = o2.WbpT + (size_t)(nb * 64) * 512 + kb * 64; t.ldw = 1024; t.ldt = 512; return t; }
    it -= TI_BP;
    { const int g = it >> 2, nb = (it & 3) >> 1, kb = it & 1;
        t.src = p.w_pool + (size_t)g * 16384 + (size_t)(kb * 64) * 128 + nb * 64; t.dst = o2.WpoolT + (size_t)(g * 128 + nb * 64) * 512 + g * 128 + kb * 64; t.ldw = 128; t.ldt = 512; return t; }
}
__device__ __forceinline__ void ph_prep_all(LAS unsigned char* lds, const PrepSrc& p, const OptBufs& ob, const OptBufs2& o2, const OptBufs4& o4, const OptBufs5& o5) {
    const int tid = tidf(), lane = tid & 63, wave = tid >> 6, gw = blockIdx.x * NW + wave, ngw = gridDim.x * NW;
    LAS float* scr = (LAS float*)(lds + wave * 16384);
    int it = gw; TItem cur = titem_decode(it, p, ob, o2, o4, o5);
    pg::f32x4 r[16];
    if (cur.valid) titem_load(cur, r, lane);
    while (cur.valid) {
        const int nx = it + ngw; const TItem nxt = titem_decode(nx, p, ob, o2, o4, o5);
        pg::f32x4 rn[16];
        if (nxt.valid) titem_load(nxt, rn, lane);
        titem_store(cur, r, scr, lane);
#pragma unroll
        for (int i = 0; i < 16; ++i) r[i] = rn[i];
        cur = nxt; it = nx;
    }
    { const size_t gt = (size_t)blockIdx.x * NT + tid, ngt = (size_t)gridDim.x * NT;
      for (size_t ch = gt; ch < 512 * 64; ch += ngt) { const int n = (int)(ch >> 6), k8 = (int)(ch & 63) * 8; if ((n >> 7) != (k8 >> 7)) *(pg::u32x4*)(o2.WpoolT + (size_t)n * 512 + k8) = (pg::u32x4){0u, 0u, 0u, 0u}; } }
    for (int i = blockIdx.x * NT + tid; i < 32 * 2048; i += gridDim.x * NT) { const int e = i >> 11, rr = i & 2047, pn = rr >> 8, bj = (rr >> 7) & 1, jj = rr & 127; o5.B1P[i] = p.b_e1[e * 2048 + 2 * (pn * 128 + jj) + bj]; }
}

struct Args { const float* in[26]; float* out; unsigned char* ws; int ph_lo, ph_hi; };
constexpr size_t MiB = 1u << 20;
constexpr size_t WS_CTL = 0;
constexpr size_t CTL_ZERO_BYTES = 1 * MiB;
constexpr int CW_BAR = 4096;
constexpr int CW_CNT = 16384, CW_START = 16384 + 64, CW_FILL = 16384 + 128;

__global__ void __launch_bounds__(NT, 2) mk_fwd(Args a) {
    extern __shared__ __attribute__((aligned(16))) unsigned char lds_raw[];
    LAS unsigned char* lds = (LAS unsigned char*)lds_raw;
    volatile LAS unsigned* MISC = (volatile LAS unsigned*)(lds + MISC_OFF);
    const int tid = tidf();
    if (tid < 32) MISC[tid] = 0u;
    __syncthreads();
    unsigned char* ws = a.ws;
    unsigned* ctl = (unsigned*)(ws + WS_CTL);
    XcdBarrier bar = xcd_barrier_post(ctl + CW_BAR, MISC + 8);
    const float* x = a.in[0]; const float* ln0_g = a.in[1]; const float* ln0_b = a.in[2];
    const float* w_in = a.in[3]; const float* conv_w = a.in[4]; const float* conv_b = a.in[5];
    const float* w_q = a.in[6]; const float* w_k = a.in[7]; const float* b_if = a.in[8];
    const float* mh_gain = a.in[9]; const float* w_pool = a.in[10]; const float* b_pool = a.in[11];
    const float* ls_pool = a.in[12]; const float* w_bp = a.in[13]; const float* w_bm = a.in[14];
    const float* w_out = a.in[15]; const float* ln1_g = a.in[16]; const float* ln1_b = a.in[17];
    const float* w_router = a.in[18]; const float* b_router = a.in[19]; const float* w_e1 = a.in[20];
    const float* b_e1 = a.in[21]; const float* w_e2 = a.in[22]; const float* b_e2 = a.in[23];
    const float* ln2_g = a.in[24]; const float* ln2_b = a.in[25];
    OptBufs ob; ob.WinT = (pg::bf16_t*)(ws + 8 * MiB); ob.H0B = (pg::bf16_t*)(ws + 220 * MiB); ob.PROJ = (pg::bf16_t*)(ws + 252 * MiB); ob.BT2 = (pg::bf16_t*)(ws + 396 * MiB);
    ob.gif = (float*)(ws + 1 * MiB); ob.stats = (float*)(ws + 1 * MiB + 512 * 1024); ob.WinQ = (unsigned char*)(ws + 214 * MiB); ob.H0Q = (unsigned char*)(ws + 972 * MiB); ob.OGQ = (unsigned char*)(ws + 300 * MiB);
    OptBufs2 o2; o2.WqT = (pg::bf16_t*)(ws + 19 * MiB); o2.WkT = (pg::bf16_t*)(ws + 19 * MiB + 512 * 1024); o2.WpoolT = (pg::bf16_t*)(ws + 20 * MiB); o2.WbpT = (pg::bf16_t*)(ws + 20 * MiB + 512 * 1024);
    o2.POOLED = (pg::bf16_t*)(ws + 460 * MiB); o2.UC = (pg::bf16_t*)(ws + 476 * MiB); o2.MIXED = (pg::bf16_t*)(ws + 508 * MiB); o2.Q = (pg::bf16_t*)(ws + 524 * MiB); o2.K = (pg::bf16_t*)(ws + 556 * MiB);
    o2.YPOOL = (pg::bf16_t*)(ws + 748 * MiB);
    OptBufs3 o3; o3.KaT = (pg::bf16_t*)(ws + 588 * MiB); o3.A2 = (pg::bf16_t*)(ws + 620 * MiB); o3.U = (float*)(ws + 684 * MiB); o3.HOUT = (pg::bf16_t*)(ws + 780 * MiB);
    { float* sm = (float*)(ws + 2 * MiB); o3.rowv = sm; o3.colv = sm + 65536; o3.winter = sm + 2 * 65536; o3.aw = sm + 3 * 65536; o3.emt = sm + 4 * 65536; o3.den = sm + 5 * 65536; o3.un = sm + 6 * 65536; o3.decay = sm + 7 * 65536; }
    OptBufs4 o4; o4.WbmT = (pg::bf16_t*)(ws + 21 * MiB + 512 * 1024); o4.WoutT = (pg::bf16_t*)(ws + 23 * MiB + 512 * 1024); o4.MERGED = (pg::bf16_t*)(ws + 812 * MiB); o4.Z = (float*)(ws + 844 * MiB); o4.H1B = (pg::bf16_t*)(ws + 908 * MiB); o4.H1Q = (unsigned char*)(ws + 940 * MiB); o4.WRP = (float*)(ws + 7 * MiB + 512 * 1024); o4.CGB = (float*)(ws + 7 * MiB + 768 * 1024);
    o4.elist = (int*)(ws + 4 * MiB); o4.erank = (int*)(ws + 6 * MiB); o4.gate = (float*)(ws + 6 * MiB + 256 * 1024);
    OptBufs5 o5; o5.We1T = (pg::bf16_t*)(ws + 26 * MiB); o5.We2T = (pg::bf16_t*)(ws + 154 * MiB); o5.B1P = (float*)(ws + 7 * MiB);
    o5.ACT = (pg::bf16_t*)(ws + 252 * MiB);
    o5.Y = (pg::bf16_t*)(ws + 396 * MiB);
    int* cnt = (int*)ctl + CW_CNT;
    LAS float* ldsf = (LAS float*)lds;
    const int G = gridDim.x, bx = blockIdx.x;
#define IN(k) (a.ph_lo <= (k) && (k) < a.ph_hi)
#if PROBE_PH >= 100
    unsigned long long tp0 = 0, tp1 = 0;
#define TSTAMP(k) do { if (PROBE_PH - 100 == (k)) tp0 = __builtin_amdgcn_s_memrealtime(); if (PROBE_PH - 100 + 1 == (k)) tp1 = __builtin_amdgcn_s_memrealtime(); } while (0)
#else
#define TSTAMP(k) do { } while (0)
#endif
#define SEAM(k) do { if (IN(k) && IN((k) + 1)) xcd_barrier(bar); TSTAMP((k) + 1); } while (0)
    TSTAMP(0);
    if (IN(0)) { PrepSrc ps{w_in, w_q, w_k, w_pool, w_bp, w_bm, w_out, w_e1, w_e2, b_e1}; ph_prep_all(lds, ps, ob, o2, o4, o5); ph_router_prep(o4, ln1_g, ln1_b, w_router, b_router); ph_ln0(lds, ob, x, ln0_g, ln0_b, w_in, b_if);
#if PROBE_PH == 0
        { xcd_barrier(bar); if (PROBE_MODE & 1) ph_prep_all(lds, ps, ob, o2, o4, o5); if (PROBE_MODE & 2) ph_ln0(lds, ob, x, ln0_g, ln0_b, w_in, b_if); }
#endif
    }
    SEAM(0);
    if (IN(1)) ph_inproj(lds, ob);
    SEAM(1);
    if (IN(2)) { if (bx >= G - 16) scalar_scan_wg(lds, bx - (G - 16), ob.gif, o3);
                 for (int i = bx * NT + tid; i < T * 4; i += G * NT) o3.den[i] = 0.f;
                 ph_poolconv_opt(ob.PROJ, conv_w, conv_b, o2.POOLED, o2.UC); }
    SEAM(2);
    if (IN(3)) ph_gemms_D(lds, o2, o3, b_pool, ls_pool);
    SEAM(3);
    if (IN(4)) { ph_gemm_ypool(lds, o2); ph_gemms_E(lds, ob, o2, o3);
#if PROBE_PH == 4
        { xcd_barrier(bar); OptBufs3 d3 = o3; d3.den = (float*)(ws + 980 * MiB); ph_gemm_ypool(lds, o2); ph_gemms_E(lds, ob, o2, d3); }
#endif
    }
    SEAM(4);
    if (IN(5)) { ph_state_scan(ob, o3); ph_den_inter(lds, o3);
#if PROBE_PH == 5
        { xcd_barrier(bar); OptBufs3 d3 = o3; d3.den = (float*)(ws + 980 * MiB); ph_state_scan(ob, d3); ph_den_inter(lds, d3); }
#endif
    }
    SEAM(5);
    if (IN(6)) ph_gemm_G3(lds, ob, o3, mh_gain);
    SEAM(6);
#if PROBE_PH == 107 && PROBE_MODE == 3
    { OptBufs3 d3 = o3; d3.HOUT = ob.H0B; OptBufs4 d4 = o4; d4.WbmT = o4.WoutT; d4.MERGED = o3.KaT; ph_gemm_ymls(lds, ob, o2, d3, d4); xcd_barrier(bar); tp0 = __builtin_amdgcn_s_memrealtime(); }
#endif
    if (IN(7)) ph_gemm_ymls(lds, ob, o2, o3, o4);
    SEAM(7);
    if (IN(8)) ph_gemm_mix(lds, ob, o4, x, ln0_g, ln0_b);
    SEAM(8);
    if (IN(9)) { ph_ln1_router(lds, o4, o4.Z, ln1_g, ln1_b, cnt);
#if PROBE_PH == 9
        { xcd_barrier(bar); OptBufs4 d4 = o4; d4.Z = (float*)(ws + 684 * MiB); d4.H1B = (pg::bf16_t*)(ws + 588 * MiB); d4.H1Q = (unsigned char*)(ws + 620 * MiB); d4.elist = (int*)(ws + 980 * MiB); d4.erank = (int*)(ws + 984 * MiB); d4.gate = (float*)(ws + 986 * MiB);
          ph_ln1_router(lds, d4, o4.Z, ln1_g, ln1_b, cnt + 256, PROBE_MODE); }
#endif
    }
    SEAM(9);
    if (IN(10)) { ph_moe1(lds, o4, o5, cnt);
#if PROBE_PH == 10
        { xcd_barrier(bar); ph_moe1_probe(lds, o4, o5, cnt, PROBE_MODE, (unsigned char*)(ws + 956 * MiB)); }
#endif
    }
    SEAM(10);
    if (IN(11)) ph_moe2(lds, o5, cnt, b_e2);
    SEAM(11);
    if (IN(12)) { ph_final_opt(lds, o4, o5, cnt, ln2_g, ln2_b, a.out);
#if PROBE_PH >= 100
        if (PROBE_PH - 100 == 12) { __syncthreads(); tp1 = __builtin_amdgcn_s_memrealtime(); }
        if (bx == 0) { const unsigned long long t0_ = __builtin_amdgcn_s_memrealtime(), dt = tp1 - tp0; while (__builtin_amdgcn_s_memrealtime() - t0_ < dt) __builtin_amdgcn_s_sleep(4); }
#endif
#if PROBE_PH == 12
        { xcd_barrier(bar); ph_final_opt(lds, o4, o5, cnt, ln2_g, ln2_b, a.out); }
#endif
    }
}
constexpr int NPH = 13;
}

extern "C" void kernel_launch(void* const* d_in, const int* in_sizes, int n_in, void* d_out, int out_size, void* d_ws, size_t ws_size, hipStream_t stream) {
    using namespace mk;
    static int grid = 0;
    if (grid == 0) {
        if (n_in != 26 || ws_size < 1000 * MiB) { fprintf(stderr, "kernel_launch: unexpected n_in %d / ws %zu\n", n_in, ws_size); grid = -1; return; }
        int dev = 0, cus = 0, per_cu = 0;
        hipGetDevice(&dev); hipDeviceGetAttribute(&cus, hipDeviceAttributeMultiprocessorCount, dev);
        if (hipFuncSetAttribute((const void*)mk_fwd, hipFuncAttributeMaxDynamicSharedMemorySize, LDS_BYTES) != hipSuccess) { fprintf(stderr, "hipFuncSetAttribute failed\n"); grid = -1; return; }
        if (hipOccupancyMaxActiveBlocksPerMultiprocessor(&per_cu, (const void*)mk_fwd, NT, LDS_BYTES) != hipSuccess || per_cu < 1) { fprintf(stderr, "occupancy query failed (%d)\n", per_cu); grid = -1; return; }
        grid = cus * 1;
        fprintf(stderr, "kernel_launch: cus %d per_cu %d grid %d\n", cus, per_cu, grid);
    }
    if (grid < 0) return;
    hipMemsetAsync((char*)d_ws + WS_CTL, 0, CTL_ZERO_BYTES, stream);
    Args a{};
    for (int i = 0; i < 26; ++i) a.in[i] = (const float*)d_in[i];
    a.out = (float*)d_out; a.ws = (unsigned char*)d_ws; a.ph_lo = 0; a.ph_hi = NPH;
    void* args[] = {&a};
    hipError_t e = hipLaunchCooperativeKernel((const void*)mk_fwd, dim3(grid), dim3(NT), args, LDS_BYTES, stream);
    if (e != hipSuccess) fprintf(stderr, "cooperative launch failed: %s (grid %d)\n", hipGetErrorString(e), grid);
}
```

```cpp
#include <hip/hip_runtime.h>
#include <cstdio>
#include <cstdint>

#define LAS __attribute__((address_space(3)))
#ifndef PROBE_PH
#define PROBE_PH -1
#endif
#define PROBE_MODE 7
namespace mk {
constexpr int D = 1024, BATCH = 4, SEQ = 4096, T = BATCH * SEQ;
constexpr int INC = 5640;
constexpr int C_P = 0, C_U = 512, C_V = 1536, C_O = 2560, C_IF = 3584, C_G = 3592;
constexpr int NE = 32, TOPK = 4, NA = T * TOPK;
constexpr float LN_EPS = 1e-5f;
constexpr float ALPHA = 1.189207115002721f;
constexpr int NT = 512, NW = 8;
constexpr int LDS_BYTES = 147456, MISC_OFF = 147456 - 512;

#define XB_TMO      128
#define XB_XCNT(j)  (256  + 64 * (j))
#define XB_XSUB(j)  (1280 + 64 * (j))
#define XB_XGEN(j)  (2304 + 64 * (j))
#define XB_TOP      3328
#define XB_TOPGEN   3392
#define XCD_BAR_WORDS 3456
#define XB_SPIN_CAP (1u << 22)
__device__ __forceinline__ unsigned xb_ld(unsigned* p)              { return __hip_atomic_load(p, __ATOMIC_RELAXED, __HIP_MEMORY_SCOPE_AGENT); }
__device__ __forceinline__ unsigned xb_add(unsigned* p, unsigned v) { return __hip_atomic_fetch_add(p, v, __ATOMIC_RELAXED, __HIP_MEMORY_SCOPE_AGENT); }
__device__ __forceinline__ unsigned xb_xcc_id() { return (unsigned)__builtin_amdgcn_s_getreg((3 << 11) | 20) & 0xFu; }
#define XB_SPIN(cond, bar) do { unsigned _sp = 0; while (cond) { __builtin_amdgcn_s_sleep(1); \
    if ((++_sp & 255u) == 0u) { if (xb_ld(&(bar)[XB_TMO])) break; if (_sp > XB_SPIN_CAP) { atomicAdd(&(bar)[XB_TMO], 1u); break; } } } } while (0)
struct XcdBarrier { unsigned* bar; unsigned x; volatile LAS unsigned* st; };
__device__ __forceinline__ XcdBarrier xcd_barrier_post(unsigned* bar, volatile LAS unsigned* st) {
    XcdBarrier b; b.bar = bar; b.x = xb_xcc_id(); b.st = st;
    if (threadIdx.x == 0) (void)xb_add(&bar[XB_XCNT(b.x)], 1u);
    return b;
}
__device__ __forceinline__ void xcd_barrier_complete(unsigned* bar, unsigned x, unsigned& nloc, unsigned& nx) {
    const unsigned G = gridDim.x * gridDim.y * gridDim.z;
    unsigned sum, cnt, mine, sp = 0u;
    for (;;) {
        sum = 0u; cnt = 0u; mine = 0u;
#pragma unroll
        for (unsigned j = 0; j < 16; ++j) { const unsigned c = xb_ld(&bar[XB_XCNT(j)]); sum += c; cnt += (c > 0u) ? 1u : 0u; mine = (j == x) ? c : mine; }
        if (sum == G) break;
        __builtin_amdgcn_s_sleep(1);
        if ((++sp & 255u) == 0u) { if (xb_ld(&bar[XB_TMO])) break; if (sp > XB_SPIN_CAP) { atomicAdd(&bar[XB_TMO], 1u); break; } }
    }
    nloc = mine > 0u ? mine : 1u; nx = cnt > 0u ? cnt : 1u;
}
__device__ __forceinline__ void xcd_barrier(const XcdBarrier& b) {
    asm volatile("s_waitcnt vmcnt(0)" ::: "memory");
    __syncthreads();
    if (threadIdx.x == 0) {
        unsigned* bar = b.bar;
        __builtin_amdgcn_s_waitcnt(0);
        unsigned nloc = b.st[0], nx = b.st[1];
        if (nloc == 0u) { xcd_barrier_complete(bar, b.x, nloc, nx); b.st[0] = nloc; b.st[1] = nx; }
        const unsigned old = xb_add(&bar[XB_XSUB(b.x)], 1u);
        const unsigned gen = old / nloc;
        if (old + 1u == (gen + 1u) * nloc) {
            __builtin_amdgcn_fence(__ATOMIC_RELEASE, "agent");
            asm volatile("s_waitcnt vmcnt(0)" ::: "memory");
            asm volatile("buffer_inv sc1" ::: "memory");
            const unsigned og = xb_add(&bar[XB_TOP], 1u);
            const unsigned tg = og / nx;
            if (og + 1u == (tg + 1u) * nx) xb_add(&bar[XB_TOPGEN], 1u);
            else XB_SPIN(xb_ld(&bar[XB_TOPGEN]) == tg, bar);
            asm volatile("s_waitcnt vmcnt(0)" ::: "memory");
        } else {
            asm volatile("buffer_inv sc1" ::: "memory");
            XB_SPIN(xb_ld(&bar[XB_TOPGEN]) == gen, bar);
            asm volatile("s_waitcnt vmcnt(0)" ::: "memory");
        }
    }
    __syncthreads();
}

__device__ __forceinline__ int tidf() { int t = threadIdx.x; asm volatile("" : "+v"(t)); return t; }
__device__ __forceinline__ float wsum(float v) {
#pragma unroll
    for (int o = 1; o < 64; o <<= 1) v += __shfl_xor(v, o);
    return v;
}
__device__ __forceinline__ float sigmoidf_(float x) { return 1.f / (1.f + expf(-x)); }
__device__ __forceinline__ float fsigmoid(float x) { return __builtin_amdgcn_rcpf(1.f + __expf(-x)); }

namespace pg {
typedef unsigned short bf16_t;
typedef short bf16x8 __attribute__((ext_vector_type(8)));
typedef float f32x4 __attribute__((ext_vector_type(4)));
typedef float f32x2 __attribute__((ext_vector_type(2)));
typedef unsigned u32x4 __attribute__((ext_vector_type(4)));
typedef unsigned u32x2 __attribute__((ext_vector_type(2)));
constexpr int BM = 256, BK = 64, HALF = 128, HTB = HALF * BK * 2, STAGE_BYTES = 8 * HTB, NXCD = 8, WGM = 8;
__host__ __device__ __forceinline__ int lds_byte(int r, int c) { const int st = (r >> 4) * 2 + (c >> 5), rr = r & 15, cc = c & 31, ob = rr * 64 + cc * 2; return st * 1024 + (ob ^ (((ob >> 9) & 1) << 5)); }
__host__ __device__ __forceinline__ void stage_rc(int b, int& R, int& C) { const int st = b / 1024, sb = b % 1024, swz = sb ^ (((sb >> 9) & 1) << 5); R = (st >> 1) * 16 + swz / 64; C = (st & 1) * 32 + (swz % 64) / 2; }
__host__ __device__ __forceinline__ int perm32(int rho) { const int n = rho >> 4, i = rho & 15; return 8 * (i >> 2) + 4 * n + (i & 3); }
__device__ __forceinline__ unsigned cvt_pk_bf16(float lo, float hi) { unsigned r; asm("v_cvt_pk_bf16_f32 %0, %1, %2" : "=v"(r) : "v"(lo), "v"(hi)); return r; }

struct Unit { const char* A; const char* B; const int* rows; int nvalid; int pm, pn, g, aux; int lda, ldb, nt, perm; };

struct TileOrder {
    int nM, nN, per_g, nwg, G, c;
    __device__ __forceinline__ void init(int nM_, int nN_, int ng, int G_, int c_) { nM = nM_; nN = nN_; per_g = nM * nN; nwg = per_g * ng; G = G_; c = c_; }
    __device__ __forceinline__ bool tile(int i, int& g, int& pm, int& pn) const {
        const long L = (long)i * G + c; if (L >= nwg) return false;
        int wgid = (int)L; { const int q = nwg / NXCD, r = nwg % NXCD, xcd = wgid % NXCD, off = wgid / NXCD; wgid = (xcd < r ? xcd * (q + 1) : r * (q + 1) + (xcd - r) * q) + off; }
        g = wgid / per_g; wgid -= g * per_g;
        const int nig = WGM * nN, gid = wgid / nig, fm = gid * WGM, gsz = (nM - fm) < WGM ? (nM - fm) : WGM;
        pm = fm + ((wgid % nig) % gsz); pn = (wgid % nig) / gsz; return true;
    }
};

typedef int i32x8 __attribute__((ext_vector_type(8)));
typedef int i32x4 __attribute__((ext_vector_type(4)));
template <class Epi, class Sched, bool GATHER = false, bool FP8 = false, bool VG = false>
__device__ __forceinline__ void gemm_phase(LAS unsigned char* lds, const int lda_, const int ldb_, const int K, const Sched& S, const Epi& E) {
    static_assert(!(VG && GATHER), "variable geometry is for plain operands");
    int lda = lda_, ldb = ldb_;
    const int tid = tidf(), wid = __builtin_amdgcn_readfirstlane(tid >> 6), lane = tid & 63, wr = wid >> 2, wc = wid & 3, fr = lane & 15, fq = lane >> 4;
    int nt = K / BK;
    unsigned voffA[2], voffB[2];
#pragma unroll
    for (int i = 0; i < 2; ++i) { int R, C; stage_rc(tid * 16 + i * 8192, R, C); const int Rb = Epi::PERM ? ((R & ~31) + perm32(R & 31)) : R;
        voffA[i] = (unsigned)(R * lda + C) * 2u; voffB[i] = (unsigned)(Rb * ldb + C) * 2u; }
    const size_t kstep = (size_t)(BK * 2);
    size_t hstepA = GATHER ? 0 : (size_t)HALF * lda * 2, hstepB = (size_t)HALF * ldb * 2;
    auto vg_offs = [&](int la, int lb, int pf, unsigned (&oa)[2], unsigned (&ob)[2]) {
#pragma unroll
        for (int i = 0; i < 2; ++i) { int R, C; stage_rc(tid * 16 + i * 8192, R, C); const int Rb = pf ? ((R & ~31) + perm32(R & 31)) : R;
            oa[i] = (unsigned)(R * la + C) * 2u; ob[i] = (unsigned)(Rb * lb + C) * 2u; } };
    const unsigned ldsw = (unsigned)wid * 1024u;
    const int aoff = lds_byte(wr * 64 + fr, fq * 8), boff = lds_byte(wc * 32 + fr, fq * 8);
#define PG_SA(b, h) (((b) * 2 + (h)) * HTB)
#define PG_SB(b, h) ((4 + (b) * 2 + (h)) * HTB)
#define PG_STAGE(bufoff, gbase, voff) do { _Pragma("unroll") for (int _i = 0; _i < 2; ++_i) \
        __builtin_amdgcn_global_load_lds((const unsigned*)((const char*)(gbase) + (voff)[_i]), (LAS unsigned*)(lds + (bufoff) + ldsw + _i * 8192), 16, 0, 0); } while (0)
#define PG_LDA(dst, b, h) do { _Pragma("unroll") for (int m = 0; m < 4; ++m) { if constexpr (FP8) { \
        const i32x4 _lo = *(const LAS i32x4*)(lds + PG_SA(b, h) + aoff + m * 2048), _hi = *(const LAS i32x4*)(lds + PG_SA(b, h) + aoff + m * 2048 + 1024); \
        dst##8[m] = __builtin_shufflevector(_lo, _hi, 0, 1, 2, 3, 4, 5, 6, 7); } \
        else { _Pragma("unroll") for (int k = 0; k < 2; ++k) dst[m][k] = *(const LAS bf16x8*)(lds + PG_SA(b, h) + aoff + m * 2048 + k * 1024); } } } while (0)
#define PG_LDB(dst, b, h) do { _Pragma("unroll") for (int n = 0; n < 2; ++n) { if constexpr (FP8) { \
        const i32x4 _lo = *(const LAS i32x4*)(lds + PG_SB(b, h) + boff + n * 2048), _hi = *(const LAS i32x4*)(lds + PG_SB(b, h) + boff + n * 2048 + 1024); \
        dst##8[n] = __builtin_shufflevector(_lo, _hi, 0, 1, 2, 3, 4, 5, 6, 7); } \
        else { _Pragma("unroll") for (int k = 0; k < 2; ++k) dst[n][k] = *(const LAS bf16x8*)(lds + PG_SB(b, h) + boff + n * 2048 + k * 1024); } } } while (0)
#define PG_MMA(ai, bj, At, Bt) do { __builtin_amdgcn_s_setprio(1); _Pragma("unroll") for (int m = 0; m < 4; ++m) _Pragma("unroll") for (int n = 0; n < 2; ++n) { \
        if constexpr (FP8) asm volatile("v_mfma_scale_f32_16x16x128_f8f6f4 %0, %1, %2, %0, %3, %4 op_sel_hi:[0,0,0]" : "+v"(acc[ai][bj][m][n]) : "v"(Bt##8[n]), "v"(At##8[m]), "v"(sc_w), "v"(sc_a)); \
        else { _Pragma("unroll") for (int k = 0; k < 2; ++k) acc[ai][bj][m][n] = __builtin_amdgcn_mfma_f32_16x16x32_bf16(Bt[n][k], At[m][k], acc[ai][bj][m][n], 0, 0, 0); } } \
        __builtin_amdgcn_s_setprio(0); } while (0)
#define PG_WAIT_V(n) asm volatile("s_waitcnt vmcnt(" #n ")" ::: "memory")
#define PG_WAIT_L(n) asm volatile("s_waitcnt lgkmcnt(" #n ")" ::: "memory")
#define PG_BAR __builtin_amdgcn_s_barrier()
#define PG_SCHED __builtin_amdgcn_sched_barrier(0)
    Unit cur, nxt; int ui = 0;
    if (!S.next(0, cur)) return;
    if constexpr (VG) { lda = cur.lda; ldb = cur.ldb; nt = cur.nt; vg_offs(lda, ldb, cur.perm, voffA, voffB); hstepA = (size_t)HALF * lda * 2; hstepB = (size_t)HALF * ldb * 2; }
    f32x4 acc[2][2][4][2];
    f32x4 bini[2][2];
#pragma unroll
    for (int b = 0; b < 2; ++b)
#pragma unroll
        for (int n = 0; n < 2; ++n) bini[b][n] = (f32x4){0.f, 0.f, 0.f, 0.f};
    LAS unsigned char* side = lds + 131072 + 8192;
    auto issue_side = [&](const Unit& u, int buf) { if constexpr (GATHER) { if (wid == 0) {
        __builtin_amdgcn_global_load_lds((const unsigned*)(u.rows + 4 * lane), (LAS unsigned*)(side + buf * 2048), 16, 0, 0);
        __builtin_amdgcn_global_load_lds((const unsigned*)(E.bias_base(u) + 4 * lane), (LAS unsigned*)(side + buf * 2048 + 1024), 16, 0, 0); } } };
    auto side_bias = [&](int buf) { const LAS float* bp = (const LAS float*)(side + buf * 2048 + 1024) + wc * 32 + (Epi::PERM ? 8 * fq : 4 * fq);
#pragma unroll
        for (int b = 0; b < 2; ++b)
#pragma unroll
            for (int n = 0; n < 2; ++n) bini[b][n] = *(const LAS f32x4*)(bp + b * HALF + (Epi::PERM ? 4 * n : 16 * n)); };
    if constexpr (GATHER) { issue_side(cur, 0); asm volatile("s_waitcnt vmcnt(0)" ::: "memory"); __builtin_amdgcn_s_barrier(); asm volatile("" ::: "memory"); side_bias(0); }
    else if constexpr (Epi::BIAS) { const float* bp = E.bias_base(cur) + wc * 32 + (Epi::PERM ? 8 * fq : 4 * fq);
#pragma unroll
        for (int b = 0; b < 2; ++b)
#pragma unroll
            for (int n = 0; n < 2; ++n) bini[b][n] = *(const f32x4*)(bp + b * HALF + (Epi::PERM ? 4 * n : 16 * n)); }
#pragma unroll
    for (int a = 0; a < 2; ++a)
#pragma unroll
        for (int b = 0; b < 2; ++b)
#pragma unroll
            for (int m = 0; m < 4; ++m)
#pragma unroll
                for (int n = 0; n < 2; ++n) acc[a][b][m][n] = bini[b][n];
    bf16x8 At[4][2], B0[2][2], B1[2][2]; i32x8 At8[4], B08[2], B18[2]; const int sc_w = 0x79797979, sc_a = 0x7f7f7f7f;
    unsigned gA0[2], gA1[2];
    auto gather_offs = [&](int nvalid, int buf, unsigned (&o0)[2], unsigned (&o1)[2]) {
        const LAS int* ids = (const LAS int*)(side + buf * 2048);
#pragma unroll
        for (int i = 0; i < 2; ++i) { int R_, C_; stage_rc(tid * 16 + i * 8192, R_, C_);
            const int r0 = R_, r1 = HALF + R_;
            const int i0 = ids[r0], i1 = ids[r1];
            const int t0 = (r0 < nvalid) ? i0 : 0, t1 = (r1 < nvalid) ? i1 : 0;
            o0[i] = (unsigned)(t0 * lda + C_) * 2u; o1[i] = (unsigned)(t1 * lda + C_) * 2u; }
    };
    if constexpr (GATHER) { gather_offs(cur.nvalid, 0, gA0, gA1); } else {
#pragma unroll
        for (int i = 0; i < 2; ++i) { gA0[i] = voffA[i]; gA1[i] = voffA[i]; }
    }
    const char* cA = cur.A; const char* cB = cur.B;
    PG_STAGE(PG_SB(0, 0), cB, voffB); PG_STAGE(PG_SB(0, 1), cB + hstepB, voffB); PG_STAGE(PG_SA(0, 0), cA, gA0); PG_STAGE(PG_SA(0, 1), cA + hstepA, gA1);
    if (wr == 1) PG_BAR;
    PG_WAIT_V(2); PG_BAR;
    PG_STAGE(PG_SB(1, 0), cB + kstep, voffB); PG_STAGE(PG_SA(1, 0), cA + kstep, gA0); PG_STAGE(PG_SB(1, 1), cB + hstepB + kstep, voffB);
    PG_WAIT_V(6); PG_BAR;
    for (;;) {
        const bool has_next = S.next(ui + 1, nxt);
        const char* nA = has_next ? nxt.A : cA; const char* nB = has_next ? nxt.B : cB;
        if constexpr (GATHER) { if (has_next) issue_side(nxt, (ui + 1) & 1); }
#pragma unroll 1
        for (int t = 0; t < nt; t += 2) {
            const bool last = (t == nt - 2);
            const char* a1 = cA + (size_t)(t + 1) * kstep;
            const char* a2 = last ? nA : cA + (size_t)(t + 2) * kstep; const char* b2 = last ? nB : cB + (size_t)(t + 2) * kstep;
            const char* a3 = a2 + kstep; const char* b3 = b2 + kstep;
            unsigned x0[2], x1[2], yb[2];
            size_t hA2 = hstepA, hB2 = hstepB;
#pragma unroll
            for (int i = 0; i < 2; ++i) { x0[i] = gA0[i]; x1[i] = gA1[i]; yb[i] = voffB[i]; }
            if constexpr (VG) { if (last && has_next) { vg_offs(nxt.lda, nxt.ldb, nxt.perm, x0, yb); x1[0] = x0[0]; x1[1] = x0[1]; hA2 = (size_t)HALF * nxt.lda * 2; hB2 = (size_t)HALF * nxt.ldb * 2; } }
            if constexpr (GATHER) { if (last && has_next) gather_offs(nxt.nvalid, (ui + 1) & 1, x0, x1); }
            PG_LDB(B0, 0, 0); PG_LDB(B1, 0, 1); PG_SCHED; PG_LDA(At, 0, 0); PG_STAGE(PG_SA(1, 1), a1 + hstepA, gA1);
            PG_WAIT_V(8); PG_WAIT_L(0); PG_BAR; PG_MMA(0, 0, At, B0); PG_MMA(0, 1, At, B1); PG_BAR; PG_SCHED;
            PG_LDA(At, 0, 1); PG_STAGE(PG_SB(0, 0), b2, yb); PG_STAGE(PG_SB(0, 1), b2 + hB2, yb); PG_STAGE(PG_SA(0, 0), a2, x0);
            PG_WAIT_V(8); PG_WAIT_L(0); PG_BAR; PG_MMA(1, 0, At, B0); PG_MMA(1, 1, At, B1); PG_BAR; PG_SCHED;
            PG_LDB(B0, 1, 0); PG_LDB(B1, 1, 1); PG_SCHED; PG_LDA(At, 1, 0); PG_STAGE(PG_SA(0, 1), a2 + hA2, x1);
            PG_WAIT_V(8); PG_WAIT_L(0); PG_BAR; PG_MMA(0, 0, At, B0); PG_MMA(0, 1, At, B1); PG_BAR; PG_SCHED;
            PG_LDA(At, 1, 1); PG_STAGE(PG_SB(1, 0), b3, yb); PG_STAGE(PG_SB(1, 1), b3 + hB2, yb); PG_STAGE(PG_SA(1, 0), a3, x0);
            PG_WAIT_V(8); PG_WAIT_L(0); PG_BAR; PG_MMA(1, 0, At, B0); PG_MMA(1, 1, At, B1); PG_BAR; PG_SCHED;
        }
        if (wr == 0) PG_BAR;
        if constexpr (FP8) asm volatile("s_nop 15\n\ts_nop 15" ::: "memory");
        if constexpr (Epi::BIAS && !GATHER) { if (has_next) { const float* bp = E.bias_base(nxt) + wc * 32 + (Epi::PERM ? 8 * fq : 4 * fq);
#pragma unroll
            for (int b = 0; b < 2; ++b)
#pragma unroll
                for (int n = 0; n < 2; ++n) bini[b][n] = *(const f32x4*)(bp + b * HALF + (Epi::PERM ? 4 * n : 16 * n)); } }
        if constexpr (!Epi::AFTER_DRAIN) { E(acc, cur, wr, wc, fr, fq); }
        else if constexpr (Epi::MIXED_DRAIN) { if (!E.is_drain(cur)) E(acc, cur, wr, wc, fr, fq); }
        if (!has_next) break;
        if constexpr (GATHER) side_bias((ui + 1) & 1);
#pragma unroll
        for (int a = 0; a < 2; ++a)
#pragma unroll
            for (int b = 0; b < 2; ++b)
#pragma unroll
                for (int m = 0; m < 4; ++m)
#pragma unroll
                    for (int n = 0; n < 2; ++n) acc[a][b][m][n] = bini[b][n];
        cur = nxt; cA = nA; cB = nB; ++ui;
        if constexpr (VG) { lda = cur.lda; ldb = cur.ldb; nt = cur.nt; vg_offs(lda, ldb, cur.perm, voffA, voffB); hstepA = (size_t)HALF * lda * 2; hstepB = (size_t)HALF * ldb * 2;
#pragma unroll
            for (int i = 0; i < 2; ++i) { gA0[i] = voffA[i]; gA1[i] = voffA[i]; } }
        if constexpr (GATHER) gather_offs(cur.nvalid, ui & 1, gA0, gA1);
        if (wr == 1) PG_BAR;
    }
    PG_WAIT_V(0);
    PG_BAR;
    if constexpr (Epi::AFTER_DRAIN) { if constexpr (Epi::MIXED_DRAIN) { if (E.is_drain(cur)) E.fused(acc, cur, wr, wc, fr, fq, lds, wid, lane); } else E.fused(acc, cur, wr, wc, fr, fq, lds, wid, lane); }
#undef PG_SA
#undef PG_SB
#undef PG_STAGE
#undef PG_LDA
#undef PG_LDB
#undef PG_MMA
#undef PG_WAIT_V
#undef PG_WAIT_L
#undef PG_BAR
#undef PG_SCHED
}

struct EpiStoreBf16 {
    static constexpr bool PERM = true, AFTER_DRAIN = false, BIAS = false;
    bf16_t* O; int ldc; float scale; int gcol;
    __device__ __forceinline__ void operator()(const f32x4 (&acc)[2][2][4][2], const Unit& u, int wr, int wc, int fr, int fq) const {
        bf16_t* base = O + (size_t)(u.pm * BM + wr * 64 + fr) * ldc + u.g * gcol + u.pn * BM + wc * 32 + 8 * fq;
#pragma unroll
        for (int ai = 0; ai < 2; ++ai)
#pragma unroll
            for (int m = 0; m < 4; ++m) { bf16_t* rowp = base + (size_t)(ai * HALF + m * 16) * ldc;
#pragma unroll
                for (int bj = 0; bj < 2; ++bj) { const f32x4 v0 = acc[ai][bj][m][0] * scale, v1 = acc[ai][bj][m][1] * scale;
                    u32x4 w; w.x = cvt_pk_bf16(v0[0], v0[1]); w.y = cvt_pk_bf16(v0[2], v0[3]); w.z = cvt_pk_bf16(v1[0], v1[1]); w.w = cvt_pk_bf16(v1[2], v1[3]);
                    *(u32x4*)(rowp + bj * HALF) = w; } }
    }
};
}

constexpr int PROJW = 4608;
constexpr int PJ_P = 0, PJ_U = 512, PJ_O = 1536, PJ_G = 2560;
constexpr int PROJLD = 1536;
constexpr int WIN_ROWS = 5632;

__device__ __forceinline__ unsigned f2bf(float f) { unsigned u = __builtin_bit_cast(unsigned, f); return (u + 0x7fffu + ((u >> 16) & 1u)) >> 16; }
__device__ __forceinline__ unsigned pk2(float lo, float hi) { return pg::cvt_pk_bf16(lo, hi); }
__device__ __forceinline__ float bf2f(unsigned short b) { return __builtin_bit_cast(float, (unsigned)b << 16); }

struct TItem { const float* src; pg::bf16_t* dst; int ldw, ldt, inter, valid, fp8; };
__device__ __forceinline__ void titem_load(const TItem& it, pg::f32x4 (&r)[16], int lane) {
    const float* src = it.src + (size_t)(4 * (lane >> 4)) * it.ldw + 4 * (lane & 15);
#pragma unroll
    for (int i = 0; i < 4; ++i)
#pragma unroll
        for (int kk = 0; kk < 4; ++kk) r[4 * i + kk] = __builtin_nontemporal_load((const pg::f32x4*)(src + (size_t)(16 * i + kk) * it.ldw));
}
__device__ __forceinline__ void titem_store(const TItem& it, const pg::f32x4 (&r)[16], LAS float* scr, int lane) {
    const int ka = lane >> 4, nb = lane & 15, sw = nb & 7;
#pragma unroll
    for (int i = 0; i < 4; ++i) { const int a = ka + 4 * i;
        LAS float* d = scr + (4 * nb) * 64 + 4 * (a ^ sw);
        *(LAS pg::f32x4*)(d)       = (pg::f32x4){r[4 * i].x, r[4 * i + 1].x, r[4 * i + 2].x, r[4 * i + 3].x};
        *(LAS pg::f32x4*)(d + 64)  = (pg::f32x4){r[4 * i].y, r[4 * i + 1].y, r[4 * i + 2].y, r[4 * i + 3].y};
        *(LAS pg::f32x4*)(d + 128) = (pg::f32x4){r[4 * i].z, r[4 * i + 1].z, r[4 * i + 2].z, r[4 * i + 3].z};
        *(LAS pg::f32x4*)(d + 192) = (pg::f32x4){r[4 * i].w, r[4 * i + 1].w, r[4 * i + 2].w, r[4 * i + 3].w}; }
    asm volatile("s_waitcnt lgkmcnt(0)" ::: "memory");
#pragma unroll
    for (int itr = 0; itr < 8; ++itr) { const int nl = (lane >> 3) + 8 * itr, kg = lane & 7, sn = (nl >> 2) & 7;
        const pg::f32x4 p0 = *(const LAS pg::f32x4*)(scr + nl * 64 + 4 * ((2 * kg) ^ sn)), p1 = *(const LAS pg::f32x4*)(scr + nl * 64 + 4 * ((2 * kg + 1) ^ sn));
        const size_t drow = it.inter ? (size_t)(nl & 1) * 128 + (nl >> 1) : (size_t)nl;
        if (it.fp8) { int w0 = __builtin_amdgcn_cvt_pk_fp8_f32(p0.x * 64.f, p0.y * 64.f, 0, false); w0 = __builtin_amdgcn_cvt_pk_fp8_f32(p0.z * 64.f, p0.w * 64.f, w0, true);
            int w1 = __builtin_amdgcn_cvt_pk_fp8_f32(p1.x * 64.f, p1.y * 64.f, 0, false); w1 = __builtin_amdgcn_cvt_pk_fp8_f32(p1.z * 64.f, p1.w * 64.f, w1, true);
            *(pg::u32x2*)((unsigned char*)it.dst + drow * it.ldt + 8 * kg) = (pg::u32x2){(unsigned)w0, (unsigned)w1}; }
        else { pg::u32x4 o; o.x = pk2(p0.x, p0.y); o.y = pk2(p0.z, p0.w); o.z = pk2(p1.x, p1.y); o.w = pk2(p1.z, p1.w);
            *(pg::u32x4*)(it.dst + drow * it.ldt + 8 * kg) = o; } }
    asm volatile("s_waitcnt lgkmcnt(0)" ::: "memory");
}
__device__ __forceinline__ int win_src_col(int r) { return r < 1536 ? r : (r < 2560 ? r + 1024 : (r < 4608 ? r - 2560 + C_G : r - 4608 + C_V)); }

struct OptBufs {
    pg::bf16_t *WinT, *H0B, *PROJ, *BT2; unsigned char *WinQ, *H0Q, *OGQ;
    float *gif, *stats;
};
__device__ __forceinline__ void ph_ln0(LAS unsigned char* lds, const OptBufs& o, const float* x, const float* g, const float* beta, const float* w_in, const float* b_if) {
    const int tid = tidf(), lane = tid & 63, wave = tid >> 6, gw = blockIdx.x * NW + wave, ngw = gridDim.x * NW;
    LAS float* wif = (LAS float*)lds;
    __syncthreads();
    for (int i = tid; i < 1024 * 8; i += NT) wif[(i & 7) * 1024 + (i >> 3)] = w_in[(size_t)(i >> 3) * INC + C_IF + (i & 7)];
    __syncthreads();
    pg::f32x4 v[4];
    if (gw < T) {
#pragma unroll
        for (int j = 0; j < 4; ++j) v[j] = __builtin_nontemporal_load((const pg::f32x4*)(x + (size_t)gw * D) + lane + 64 * j); }
    for (int row = gw; row < T; row += ngw) {
        pg::f32x4 nv[4];
        if (row + ngw < T) {
#pragma unroll
            for (int j = 0; j < 4; ++j) nv[j] = __builtin_nontemporal_load((const pg::f32x4*)(x + (size_t)(row + ngw) * D) + lane + 64 * j); }
        float s = 0.f;
#pragma unroll
        for (int j = 0; j < 4; ++j) s += (v[j].x + v[j].y) + (v[j].z + v[j].w);
        const float mean = wsum(s) * (1.f / D); float s2 = 0.f;
#pragma unroll
        for (int j = 0; j < 4; ++j) { v[j] = v[j] - mean; s2 += (v[j].x * v[j].x + v[j].y * v[j].y) + (v[j].z * v[j].z + v[j].w * v[j].w); }
        const float rstd = rsqrtf(wsum(s2) * (1.f / D) + LN_EPS);
        float acc8[8];
#pragma unroll
        for (int q = 0; q < 8; ++q) acc8[q] = 0.f;
        unsigned long long* o8 = (unsigned long long*)(o.H0B + (size_t)row * D) + lane;
#pragma unroll
        for (int j = 0; j < 4; ++j) {
            const int c0 = 256 * j + 4 * lane;
            const pg::f32x4 gg = *(const pg::f32x4*)(g + c0), bb = *(const pg::f32x4*)(beta + c0);
            const pg::f32x4 y = v[j] * rstd * gg + bb;
            o8[64 * j] = (unsigned long long)pk2(y.x, y.y) | ((unsigned long long)pk2(y.z, y.w) << 32);
            { int w0 = __builtin_amdgcn_cvt_pk_fp8_f32(y.x, y.y, 0, false); w0 = __builtin_amdgcn_cvt_pk_fp8_f32(y.z, y.w, w0, true); *(int*)(o.H0Q + (size_t)row * D + c0) = w0; }
#pragma unroll
            for (int q = 0; q < 8; ++q) { const pg::f32x4 w4 = *(const LAS pg::f32x4*)(wif + q * 1024 + c0); acc8[q] += (y.x * w4.x + y.y * w4.y) + (y.z * w4.z + y.w * w4.w); }
        }
        float r_;
        { float a4[4];
#pragma unroll
          for (int i = 0; i < 4; ++i) { const bool up = (lane & 32) != 0; const float keep = up ? acc8[4 + i] : acc8[i], give = up ? acc8[i] : acc8[4 + i]; a4[i] = keep + __shfl_xor(give, 32); }
          float a2[2];
#pragma unroll
          for (int i = 0; i < 2; ++i) { const bool up = (lane & 16) != 0; const float keep = up ? a4[2 + i] : a4[i], give = up ? a4[i] : a4[2 + i]; a2[i] = keep + __shfl_xor(give, 16); }
          const bool up = (lane & 8) != 0; const float keep = up ? a2[1] : a2[0], give = up ? a2[0] : a2[1];
          r_ = keep + __shfl_xor(give, 8);
          r_ += __shfl_xor(r_, 4); r_ += __shfl_xor(r_, 2); r_ += __shfl_xor(r_, 1); }
        if ((lane & 7) == 0) { const int q = lane >> 3; o.gif[(size_t)row * 8 + q] = r_ + b_if[q]; }
        if (lane == 0) { o.stats[(size_t)row * 2] = mean; o.stats[(size_t)row * 2 + 1] = rstd; }
#pragma unroll
        for (int j = 0; j < 4; ++j) v[j] = nv[j];
    }
    __syncthreads();
}
template <class S1, class S2>
struct SchedPair {
    S1 s1; S2 s2; int n1, G, c; int cap2 = 1 << 30;
    __device__ __forceinline__ bool next(int i, pg::Unit& u) const {
        const long L = (long)i * G + c;
        if (L < n1) return s1.next(i, u);
        if (L - n1 >= cap2) return false;
        if (!s2.next(i, u)) return false;
        u.nvalid = 1; return true; }
};
template <class E1, class E2>
struct EpiPair {
    static_assert(E1::PERM == E2::PERM && !E1::AFTER_DRAIN && !E2::AFTER_DRAIN && !E1::BIAS && !E2::BIAS, "pair needs matching layouts");
    static constexpr bool PERM = E1::PERM, AFTER_DRAIN = false, BIAS = false;
    E1 e1; E2 e2;
    __device__ __forceinline__ void operator()(const pg::f32x4 (&acc)[2][2][4][2], const pg::Unit& u, int wr, int wc, int fr, int fq) const {
        if (u.nvalid) e2(acc, u, wr, wc, fr, fq); else e1(acc, u, wr, wc, fr, fq); }
};
struct SchedNone { __device__ __forceinline__ bool next(int, pg::Unit&) const { return false; } };
struct EpiNone { static constexpr bool PERM = true, AFTER_DRAIN = false, BIAS = false;
    __device__ __forceinline__ void operator()(const pg::f32x4 (&)[2][2][4][2], const pg::Unit&, int, int, int, int) const {} };
template <class S0, class S1, class S2, class S3>
struct SchedMulti {
    S0 s0; S1 s1; S2 s2; S3 s3; int b1, b2, b3, G, c;
    int la0, lb0, nt0, pf0, la1, lb1, nt1, pf1, la2, lb2, nt2, pf2, la3, lb3, nt3, pf3;
    __device__ __forceinline__ void geo(int p, int la, int lb, int K, int pf) { if (p == 0) { la0 = la; lb0 = lb; nt0 = K / pg::BK; pf0 = pf; } else if (p == 1) { la1 = la; lb1 = lb; nt1 = K / pg::BK; pf1 = pf; }
        else if (p == 2) { la2 = la; lb2 = lb; nt2 = K / pg::BK; pf2 = pf; } else { la3 = la; lb3 = lb; nt3 = K / pg::BK; pf3 = pf; } }
    __device__ __forceinline__ bool next(int i, pg::Unit& u) const {
        const long L = (long)i * G + c;
        if (L < b1) { if (!s0.next(i, u)) return false; u.nvalid = 0; u.lda = la0; u.ldb = lb0; u.nt = nt0; u.perm = pf0; return true; }
        if (L < b2) { if (!s1.next(i, u)) return false; u.nvalid = 1; u.lda = la1; u.ldb = lb1; u.nt = nt1; u.perm = pf1; return true; }
        if (L < b3) { if (!s2.next(i, u)) return false; u.nvalid = 2; u.lda = la2; u.ldb = lb2; u.nt = nt2; u.perm = pf2; return true; }
        if (!s3.next(i, u)) return false; u.nvalid = 3; u.lda = la3; u.ldb = lb3; u.nt = nt3; u.perm = pf3; return true; }
};
template <class E0, class E1, class E2, class E3, int DR>
struct EpiMulti {
    static constexpr bool PERM = true, BIAS = false, AFTER_DRAIN = (DR >= 0), MIXED_DRAIN = (DR >= 0);
    E0 e0; E1 e1; E2 e2; E3 e3;
    __device__ __forceinline__ bool is_drain(const pg::Unit& u) const { return u.nvalid == DR; }
    __device__ __forceinline__ void operator()(const pg::f32x4 (&acc)[2][2][4][2], const pg::Unit& u, int wr, int wc, int fr, int fq) const {
        if (u.nvalid == 0) { if constexpr (DR != 0) e0(acc, u, wr, wc, fr, fq); }
        else if (u.nvalid == 1) { if constexpr (DR != 1) e1(acc, u, wr, wc, fr, fq); }
        else if (u.nvalid == 2) { if constexpr (DR != 2) e2(acc, u, wr, wc, fr, fq); }
        else { if constexpr (DR != 3) e3(acc, u, wr, wc, fr, fq); } }
    __device__ __forceinline__ void fused(pg::f32x4 (&acc)[2][2][4][2], const pg::Unit& u, int wr, int wc, int fr, int fq, LAS unsigned char* lds, int wid, int lane) const {
        if constexpr (DR == 0) e0.fused(acc, u, wr, wc, fr, fq, lds, wid, lane); else if constexpr (DR == 1) e1.fused(acc, u, wr, wc, fr, fq, lds, wid, lane);
        else if constexpr (DR == 2) e2.fused(acc, u, wr, wc, fr, fq, lds, wid, lane); else if constexpr (DR == 3) e3.fused(acc, u, wr, wc, fr, fq, lds, wid, lane); }
};
struct SchedInproj {
    pg::TileOrder o; const char* A; const char* B; size_t rowbytes;
    __device__ __forceinline__ bool next(int i, pg::Unit& u) const { int g, pm, pn; if (!o.tile(i, g, pm, pn)) return false;
        u.A = A + (size_t)pm * 256 * rowbytes; u.B = B + (size_t)pn * 256 * rowbytes; u.pm = pm; u.pn = pn; u.g = 0; u.aux = 0; u.rows = nullptr; u.nvalid = 0; return true; }
};
struct SchedVT {
    pg::TileOrder o; const char* A; const char* B;
    __device__ __forceinline__ bool next(int i, pg::Unit& u) const { int g, pm, pn; if (!o.tile(i, g, pm, pn)) return false;
        u.A = A + (size_t)pm * 256 * D * 2; u.B = B + (size_t)pn * 256 * D * 2; u.pm = pm; u.pn = pn; u.g = 0; u.aux = 0; u.rows = nullptr; u.nvalid = 0; return true; }
};
struct EpiVT {
    static constexpr bool PERM = true, AFTER_DRAIN = false, BIAS = false;
    pg::bf16_t* BT2;
    __device__ __forceinline__ void operator()(const pg::f32x4 (&acc)[2][2][4][2], const pg::Unit& u, int wr, int wc, int fr, int fq) const {
        const int h = u.pm, b = u.pn >> 4, c = u.pn & 15;
        pg::bf16_t* base = BT2 + ((size_t)((b * 4 + h) * 16 + c) * 256 + wr * 64 + fr) * 512 + wc * 32 + 8 * fq;
#pragma unroll
        for (int ai = 0; ai < 2; ++ai)
#pragma unroll
            for (int m = 0; m < 4; ++m) { pg::bf16_t* rowp = base + (size_t)(ai * 128 + m * 16) * 512;
#pragma unroll
                for (int bj = 0; bj < 2; ++bj) { const pg::f32x4 v0 = acc[ai][bj][m][0], v1 = acc[ai][bj][m][1];
                    pg::u32x4 w; w.x = pg::cvt_pk_bf16(v0[0], v0[1]); w.y = pg::cvt_pk_bf16(v0[2], v0[3]); w.z = pg::cvt_pk_bf16(v1[0], v1[1]); w.w = pg::cvt_pk_bf16(v1[2], v1[3]);
                    *(pg::u32x4*)(rowp + bj * 128) = w; } }
    }
};
struct EpiOGQ {
    static constexpr bool PERM = true, AFTER_DRAIN = false, BIAS = false;
    unsigned char* O; int pitch;
    __device__ __forceinline__ void operator()(const pg::f32x4 (&acc)[2][2][4][2], const pg::Unit& u, int wr, int wc, int fr, int fq) const {
        unsigned char* base = O + (size_t)(u.pm * 256 + wr * 64 + fr) * pitch + u.pn * 256 + (wc * 4 + fq) * 16;
#pragma unroll
        for (int ai = 0; ai < 2; ++ai)
#pragma unroll
            for (int m = 0; m < 4; ++m) { pg::u32x4 w;
                { const pg::f32x4 v0 = acc[ai][0][m][0], v1 = acc[ai][0][m][1];
                  int p = __builtin_amdgcn_cvt_pk_fp8_f32(v0[0], v0[1], 0, false); p = __builtin_amdgcn_cvt_pk_fp8_f32(v0[2], v0[3], p, true); w.x = (unsigned)p;
                  p = __builtin_amdgcn_cvt_pk_fp8_f32(v1[0], v1[1], 0, false); p = __builtin_amdgcn_cvt_pk_fp8_f32(v1[2], v1[3], p, true); w.y = (unsigned)p; }
                { const pg::f32x4 v0 = acc[ai][1][m][0], v1 = acc[ai][1][m][1];
                  int p = __builtin_amdgcn_cvt_pk_fp8_f32(v0[0], v0[1], 0, false); p = __builtin_amdgcn_cvt_pk_fp8_f32(v0[2], v0[3], p, true); w.z = (unsigned)p;
                  p = __builtin_amdgcn_cvt_pk_fp8_f32(v1[0], v1[1], 0, false); p = __builtin_amdgcn_cvt_pk_fp8_f32(v1[2], v1[3], p, true); w.w = (unsigned)p; }
                *(pg::u32x4*)(base + (size_t)(ai * 128 + m * 16) * pitch) = w; asm volatile("" ::: "memory"); }
    }
};
__device__ __forceinline__ void fp8x4_to_f32(unsigned w, float (&o)[4]) {
    const pg::f32x2 lo = __builtin_amdgcn_cvt_pk_f32_fp8((int)w, false), hi = __builtin_amdgcn_cvt_pk_f32_fp8((int)w, true);
    o[0] = lo.x; o[1] = lo.y; o[2] = hi.x; o[3] = hi.y;
}
constexpr int VT_P1 = 208;
__device__ __forceinline__ void ph_inproj(LAS unsigned char* lds, const OptBufs& o, int W) {
    const int G = W, bx = blockIdx.x;
    if (bx >= W) return;
    { SchedInproj S; S.o.init(T / 256, 12, 1, G, bx); S.A = (const char*)o.H0Q; S.B = (const char*)o.WinQ; S.rowbytes = D;
      EpiOGQ E{o.OGQ, 3072}; pg::gemm_phase<EpiOGQ, SchedInproj, false, true>(lds, D / 2, D / 2, D / 2, S, E); }
    { typedef SchedPair<SchedInproj, SchedVT> SP; typedef EpiPair<pg::EpiStoreBf16, EpiVT> EP;
      SP S; S.G = G; S.c = bx; S.n1 = (T / 256) * 6; S.cap2 = VT_P1;
      S.s1.o.init(T / 256, 6, 1, G, bx); S.s1.A = (const char*)o.H0B; S.s1.B = (const char*)o.WinT; S.s1.rowbytes = (size_t)D * 2;
      S.s2.o.init(4, T / 256, 1, G, bx - S.n1); S.s2.A = (const char*)(o.WinT + (size_t)PROJW * D); S.s2.B = (const char*)o.H0B;
      EP E{pg::EpiStoreBf16{o.PROJ, PROJLD, 1.f, 0}, EpiVT{o.BT2}}; pg::gemm_phase<EP, SP>(lds, D, D, D, S, E); }
}
__device__ __forceinline__ void ph_inproj_vt(LAS unsigned char* lds, const OptBufs& o, int unit) {
    { SchedVT S; S.o.init(4, T / 256, 1, 1 << 20, unit); S.A = (const char*)(o.WinT + (size_t)PROJW * D); S.B = (const char*)o.H0B;
      EpiVT E{o.BT2}; pg::gemm_phase<EpiVT, SchedVT>(lds, D, D, D, S, E); }
}

struct OptBufs2 { pg::bf16_t *WqT, *WkT, *WpoolT, *WbpT, *POOLED, *UC, *MIXED, *Q, *K, *YPOOL; };
__device__ __forceinline__ void ld8(const pg::bf16_t* p, float (&v)[8]) { const pg::u32x4 w = *(const pg::u32x4*)p;
    v[0] = __builtin_bit_cast(float, w.x << 16); v[1] = __builtin_bit_cast(float, w.x & 0xffff0000u); v[2] = __builtin_bit_cast(float, w.y << 16); v[3] = __builtin_bit_cast(float, w.y & 0xffff0000u);
    v[4] = __builtin_bit_cast(float, w.z << 16); v[5] = __builtin_bit_cast(float, w.z & 0xffff0000u); v[6] = __builtin_bit_cast(float, w.w << 16); v[7] = __builtin_bit_cast(float, w.w & 0xffff0000u); }
__device__ __forceinline__ void st8(pg::bf16_t* p, const float (&v)[8]) { pg::u32x4 w; w.x = pk2(v[0], v[1]); w.y = pk2(v[2], v[3]); w.z = pk2(v[4], v[5]); w.w = pk2(v[6], v[7]); *(pg::u32x4*)p = w; }
__device__ __forceinline__ void ph_poolconv_opt(const pg::bf16_t* PROJ, const float* cw, const float* cb, pg::bf16_t* POOLED, pg::bf16_t* UC) {
    const int gt = blockIdx.x * NT + tidf(), ngt = gridDim.x * NT;
    for (int it = gt; it < 512 * 192; it += ngt) {
        const int run = it / 192, oc = it % 192; const int t0 = run * 32, tpos0 = t0 & (SEQ - 1);
        if (oc < 64) {
            const int c0 = oc * 8, w = 2 << (c0 >> 7);
            const pg::bf16_t* src = PROJ + PJ_P + c0;
            float s[8];
#pragma unroll
            for (int q = 0; q < 8; ++q) s[q] = 0.f;
            { pg::u32x4 hv[15];
#pragma unroll
              for (int j = 1; j < 16; ++j) hv[j - 1] = (j < w && tpos0 - j >= 0) ? __builtin_nontemporal_load((const pg::u32x4*)(src + (size_t)(t0 - j) * PROJLD)) : (pg::u32x4){0u, 0u, 0u, 0u};
#pragma unroll
              for (int j = 0; j < 15; ++j) { s[0] += __builtin_bit_cast(float, hv[j].x << 16); s[1] += __builtin_bit_cast(float, hv[j].x & 0xffff0000u); s[2] += __builtin_bit_cast(float, hv[j].y << 16); s[3] += __builtin_bit_cast(float, hv[j].y & 0xffff0000u);
                  s[4] += __builtin_bit_cast(float, hv[j].z << 16); s[5] += __builtin_bit_cast(float, hv[j].z & 0xffff0000u); s[6] += __builtin_bit_cast(float, hv[j].w << 16); s[7] += __builtin_bit_cast(float, hv[j].w & 0xffff0000u); } }
            for (int i0 = 0; i0 < 32; i0 += 8) {
                pg::u32x4 cv[8], ov[8];
#pragma unroll
                for (int i = 0; i < 8; ++i) { const int t = t0 + i0 + i, tp = tpos0 + i0 + i; cv[i] = __builtin_nontemporal_load((const pg::u32x4*)(src + (size_t)t * PROJLD));
                    ov[i] = (tp - w + 1 >= 0) ? __builtin_nontemporal_load((const pg::u32x4*)(src + (size_t)(t - w + 1) * PROJLD)) : (pg::u32x4){0u, 0u, 0u, 0u}; }
#pragma unroll
                for (int i = 0; i < 8; ++i) { const int t = t0 + i0 + i, tp = tpos0 + i0 + i; float cur[8], old[8], o[8];
                    cur[0] = __builtin_bit_cast(float, cv[i].x << 16); cur[1] = __builtin_bit_cast(float, cv[i].x & 0xffff0000u); cur[2] = __builtin_bit_cast(float, cv[i].y << 16); cur[3] = __builtin_bit_cast(float, cv[i].y & 0xffff0000u);
                    cur[4] = __builtin_bit_cast(float, cv[i].z << 16); cur[5] = __builtin_bit_cast(float, cv[i].z & 0xffff0000u); cur[6] = __builtin_bit_cast(float, cv[i].w << 16); cur[7] = __builtin_bit_cast(float, cv[i].w & 0xffff0000u);
                    old[0] = __builtin_bit_cast(float, ov[i].x << 16); old[1] = __builtin_bit_cast(float, ov[i].x & 0xffff0000u); old[2] = __builtin_bit_cast(float, ov[i].y << 16); old[3] = __builtin_bit_cast(float, ov[i].y & 0xffff0000u);
                    old[4] = __builtin_bit_cast(float, ov[i].z << 16); old[5] = __builtin_bit_cast(float, ov[i].z & 0xffff0000u); old[6] = __builtin_bit_cast(float, ov[i].w << 16); old[7] = __builtin_bit_cast(float, ov[i].w & 0xffff0000u);
                    const float inv = 1.f / (float)((tp + 1 < w) ? tp + 1 : w);
#pragma unroll
                    for (int q = 0; q < 8; ++q) { s[q] += cur[q]; o[q] = s[q] * inv - cur[q]; s[q] -= old[q]; }
                    st8(POOLED + (size_t)t * 512 + c0, o); }
            }
        } else {
            const int c0 = (oc - 64) * 8;
            const pg::bf16_t* src = PROJ + PJ_U + c0;
            float w0[8], w1[8], w2[8], w3[8], bb[8], u0[8], u1[8], u2[8];
#pragma unroll
            for (int q = 0; q < 8; ++q) { w0[q] = cw[c0 + q]; w1[q] = cw[1024 + c0 + q]; w2[q] = cw[2048 + c0 + q]; w3[q] = cw[3072 + c0 + q]; bb[q] = cb[c0 + q]; u0[q] = 0.f; u1[q] = 0.f; u2[q] = 0.f; }
            if (tpos0 >= 3) ld8(src + (size_t)(t0 - 3) * PROJLD, u0);
            if (tpos0 >= 2) ld8(src + (size_t)(t0 - 2) * PROJLD, u1);
            if (tpos0 >= 1) ld8(src + (size_t)(t0 - 1) * PROJLD, u2);
            for (int i0 = 0; i0 < 32; i0 += 8) {
                pg::u32x4 cv[8];
#pragma unroll
                for (int i = 0; i < 8; ++i) cv[i] = __builtin_nontemporal_load((const pg::u32x4*)(src + (size_t)(t0 + i0 + i) * PROJLD));
#pragma unroll
                for (int i = 0; i < 8; ++i) { float u3[8], o[8];
                    u3[0] = __builtin_bit_cast(float, cv[i].x << 16); u3[1] = __builtin_bit_cast(float, cv[i].x & 0xffff0000u); u3[2] = __builtin_bit_cast(float, cv[i].y << 16); u3[3] = __builtin_bit_cast(float, cv[i].y & 0xffff0000u);
                    u3[4] = __builtin_bit_cast(float, cv[i].z << 16); u3[5] = __builtin_bit_cast(float, cv[i].z & 0xffff0000u); u3[6] = __builtin_bit_cast(float, cv[i].w << 16); u3[7] = __builtin_bit_cast(float, cv[i].w & 0xffff0000u);
#pragma unroll
                    for (int q = 0; q < 8; ++q) { const float y = bb[q] + w0[q] * u0[q] + w1[q] * u1[q] + w2[q] * u2[q] + w3[q] * u3[q]; o[q] = y * __builtin_amdgcn_rcpf(1.f + __expf(-y)); u0[q] = u1[q]; u1[q] = u2[q]; u2[q] = u3[q]; }
                    st8(UC + (size_t)(t0 + i0 + i) * 1024 + c0, o); }
            }
        }
    }
}
struct SchedG {
    pg::TileOrder o; const char* A; const char* B; size_t gA, gB, tA, tB;
    __device__ __forceinline__ bool next(int i, pg::Unit& u) const { int g, pm, pn; if (!o.tile(i, g, pm, pn)) return false;
        u.A = A + g * gA + pm * tA; u.B = B + g * gB + pn * tB; u.pm = pm; u.pn = pn; u.g = g; u.aux = 0; u.rows = nullptr; u.nvalid = 0; return true; }
};
struct EpiPoolMixB {
    static constexpr bool PERM = true, AFTER_DRAIN = false, BIAS = false;
    pg::bf16_t* O; const float* b; const float* ls;
    __device__ __forceinline__ void operator()(const pg::f32x4 (&acc)[2][2][4][2], const pg::Unit& u, int wr, int wc, int fr, int fq) const {
        const int col0 = u.pn * 256 + wc * 32 + 8 * fq;
        pg::bf16_t* base = O + (size_t)(u.pm * 256 + wr * 64 + fr) * 512 + col0;
        pg::f32x4 bv[2][2], lv[2][2];
#pragma unroll
        for (int bj = 0; bj < 2; ++bj)
#pragma unroll
            for (int n = 0; n < 2; ++n) { bv[bj][n] = *(const pg::f32x4*)(b + col0 + bj * 128 + 4 * n); lv[bj][n] = *(const pg::f32x4*)(ls + col0 + bj * 128 + 4 * n); }
#pragma unroll
        for (int ai = 0; ai < 2; ++ai)
#pragma unroll
            for (int m = 0; m < 4; ++m) { pg::bf16_t* rowp = base + (size_t)(ai * 128 + m * 16) * 512;
#pragma unroll
                for (int bj = 0; bj < 2; ++bj) { const pg::f32x4 v0 = (acc[ai][bj][m][0] + bv[bj][0]) * lv[bj][0], v1 = (acc[ai][bj][m][1] + bv[bj][1]) * lv[bj][1];
                    pg::u32x4 w; w.x = pg::cvt_pk_bf16(v0[0], v0[1]); w.y = pg::cvt_pk_bf16(v0[2], v0[3]); w.z = pg::cvt_pk_bf16(v1[0], v1[1]); w.w = pg::cvt_pk_bf16(v1[2], v1[3]);
                    *(pg::u32x4*)(rowp + bj * 128) = w; } }
    }
};
struct OptBufs3 { pg::bf16_t *KaT, *A2, *HOUT; float *U, *rowv, *colv, *winter, *aw, *emt, *den, *un, *decay, *den2; };
__device__ __forceinline__ float log_sigmoidf_(float x) { return fminf(x, 0.f) - log1pf(expf(-fabsf(x))); }
__device__ __forceinline__ void scalar_scan_wg(LAS unsigned char* lds, int bh, const float* gif, const OptBufs3& o) {
    const int tid = tidf(), lane = tid & 63, wave = tid >> 6, b = bh >> 2, h = bh & 3;
    LAS float* sum = (LAS float*)lds;
    float bt[2][4], ip[2][4], pm[2][4];
#pragma unroll
    for (int cc = 0; cc < 2; ++cc) { const int c = wave * 2 + cc;
        float bs[4];
#pragma unroll
        for (int sub = 0; sub < 4; ++sub) { const size_t t = (size_t)b * SEQ + c * 256 + sub * 64 + lane; ip[cc][sub] = gif[t * 8 + h]; bs[sub] = log_sigmoidf_(gif[t * 8 + 4 + h]); }
#pragma unroll
        for (int off = 1; off < 64; off <<= 1) {
#pragma unroll
            for (int sub = 0; sub < 4; ++sub) { const float v = __shfl_up(bs[sub], off); if (lane >= off) bs[sub] += v; } }
        float carry = 0.f;
#pragma unroll
        for (int sub = 0; sub < 4; ++sub) { bt[cc][sub] = carry + bs[sub]; carry += __shfl(bs[sub], 63); pm[cc][sub] = ip[cc][sub] - bt[cc][sub]; }
#pragma unroll
        for (int off = 1; off < 64; off <<= 1) {
#pragma unroll
            for (int sub = 0; sub < 4; ++sub) { const float v = __shfl_up(pm[cc][sub], off); if (lane >= off) pm[cc][sub] = fmaxf(pm[cc][sub], v); } }
        float pmc = -INFINITY;
#pragma unroll
        for (int sub = 0; sub < 4; ++sub) { pm[cc][sub] = fmaxf(pm[cc][sub], pmc); pmc = __shfl(pm[cc][sub], 63); }
        if (lane == 0) { sum[c * 2] = carry; sum[c * 2 + 1] = pmc; }
    }
    __syncthreads();
    float mc = 0.f;
    for (int c = 0; c < wave * 2; ++c) mc = sum[c * 2] + fmaxf(mc, sum[c * 2 + 1]);
#pragma unroll
    for (int cc = 0; cc < 2; ++cc) { const int c = wave * 2 + cc; const float Gc = sum[c * 2], mnext = Gc + fmaxf(mc, sum[c * 2 + 1]);
#pragma unroll
        for (int sub = 0; sub < 4; ++sub) { const float mt = bt[cc][sub] + fmaxf(mc, pm[cc][sub]);
            const size_t idx = ((size_t)b * SEQ + c * 256 + sub * 64 + lane) * 4 + h;
            o.rowv[idx] = bt[cc][sub] - mt; o.colv[idx] = ip[cc][sub] - bt[cc][sub];
            o.winter[idx] = expf(bt[cc][sub] + mc - mt); o.aw[idx] = expf(Gc - bt[cc][sub] + ip[cc][sub] - mnext); o.emt[idx] = expf(-mt); }
        if (lane == 0) o.decay[bh * 16 + c] = expf(Gc + mc - mnext);
        mc = mnext; }
    __syncthreads();
}
struct EpiQ {
    static constexpr bool PERM = true, AFTER_DRAIN = false, BIAS = false;
    pg::bf16_t* Q; pg::bf16_t* A2; const float* winter;
    __device__ __forceinline__ void operator()(const pg::f32x4 (&acc)[2][2][4][2], const pg::Unit& u, int wr, int wc, int fr, int fq) const {
        const int h = u.g, col0 = wc * 32 + 8 * fq;
#pragma unroll
        for (int ai = 0; ai < 2; ++ai)
#pragma unroll
            for (int m = 0; m < 4; ++m) { const size_t t = (size_t)u.pm * 256 + ai * 128 + wr * 64 + m * 16 + fr; const float wi = winter[t * 4 + h];
#pragma unroll
                for (int bj = 0; bj < 2; ++bj) { const pg::f32x4 v0 = acc[ai][bj][m][0] * 0.0625f, v1 = acc[ai][bj][m][1] * 0.0625f;
                    pg::u32x4 w; w.x = pg::cvt_pk_bf16(v0[0], v0[1]); w.y = pg::cvt_pk_bf16(v0[2], v0[3]); w.z = pg::cvt_pk_bf16(v1[0], v1[1]); w.w = pg::cvt_pk_bf16(v1[2], v1[3]);
                    *(pg::u32x4*)(Q + t * 1024 + h * 256 + col0 + bj * 128) = w;
                    const pg::f32x4 x0 = v0 * wi, x1 = v1 * wi;
                    pg::u32x4 y; y.x = pg::cvt_pk_bf16(x0[0], x0[1]); y.y = pg::cvt_pk_bf16(x0[2], x0[3]); y.z = pg::cvt_pk_bf16(x1[0], x1[1]); y.w = pg::cvt_pk_bf16(x1[2], x1[3]);
                    *(pg::u32x4*)(A2 + t * 2048 + h * 512 + 256 + col0 + bj * 128) = y; }
                asm volatile("" ::: "memory"); }
    }
};
struct EpiKT {
    static constexpr bool PERM = true, AFTER_DRAIN = false, BIAS = false;
    pg::bf16_t* KaT; const float* aw;
    __device__ __forceinline__ void operator()(const pg::f32x4 (&acc)[2][2][4][2], const pg::Unit& u, int wr, int wc, int fr, int fq) const {
        const int h = u.g; const size_t t0 = (size_t)u.pn * 256 + wc * 32 + 8 * fq;
#pragma unroll
        for (int bj = 0; bj < 2; ++bj) {
            float a[8];
#pragma unroll
            for (int j = 0; j < 8; ++j) a[j] = aw[(t0 + bj * 128 + j) * 4 + h];
            pg::bf16_t* rowp = KaT + ((size_t)h * 256 + wr * 64 + fr) * T + t0 + bj * 128;
#pragma unroll
            for (int ai = 0; ai < 2; ++ai)
#pragma unroll
                for (int m = 0; m < 4; ++m) { const pg::f32x4 v0 = acc[ai][bj][m][0], v1 = acc[ai][bj][m][1];
                    pg::u32x4 w; w.x = pg::cvt_pk_bf16(v0[0] * a[0], v0[1] * a[1]); w.y = pg::cvt_pk_bf16(v0[2] * a[2], v0[3] * a[3]);
                    w.z = pg::cvt_pk_bf16(v1[0] * a[4], v1[1] * a[5]); w.w = pg::cvt_pk_bf16(v1[2] * a[6], v1[3] * a[7]);
                    *(pg::u32x4*)(rowp + (size_t)(ai * 128 + m * 16) * T) = w; asm volatile("" ::: "memory"); }
        }
    }
};
struct EpiS {
    static constexpr bool PERM = true, AFTER_DRAIN = true, BIAS = false, MIXED_DRAIN = false;
    pg::bf16_t* A2; const float* rowv; const float* colv; float* den;
    __device__ __forceinline__ void fused(pg::f32x4 (&acc)[2][2][4][2], const pg::Unit& u, int wr, int wc, int fr, int fq, LAS unsigned char* lds, int wid, int lane) const {
        const int bh = u.g >> 4, c = u.g & 15, b = bh >> 2, h = bh & 3; const size_t tok0 = (size_t)b * SEQ + c * 256;
        LAS float* Lr = (LAS float*)lds; LAS float* Lc = Lr + 256; LAS float* P = Lc + 256;
        { const int tid = wid * 64 + lane; if (tid < 256) Lr[tid] = rowv[(tok0 + tid) * 4 + h]; else Lc[tid - 256] = colv[(tok0 + tid - 256) * 4 + h]; }
        asm volatile("s_waitcnt vmcnt(0) lgkmcnt(0)" ::: "memory"); __builtin_amdgcn_s_barrier(); asm volatile("" ::: "memory");
        const int col0 = wc * 32 + 8 * fq;
        float cv[2][8];
#pragma unroll
        for (int bj = 0; bj < 2; ++bj) { const pg::f32x4 c0 = *(const LAS pg::f32x4*)(Lc + col0 + bj * 128), c1 = *(const LAS pg::f32x4*)(Lc + col0 + bj * 128 + 4);
            cv[bj][0] = c0.x; cv[bj][1] = c0.y; cv[bj][2] = c0.z; cv[bj][3] = c0.w; cv[bj][4] = c1.x; cv[bj][5] = c1.y; cv[bj][6] = c1.z; cv[bj][7] = c1.w; }
#pragma unroll
        for (int ai = 0; ai < 2; ++ai)
#pragma unroll
            for (int m = 0; m < 4; ++m) { const int tl = ai * 128 + wr * 64 + m * 16 + fr; const float rv = Lr[tl]; float rs = 0.f;
                pg::bf16_t* op = A2 + (tok0 + tl) * 2048 + h * 512 + col0;
#pragma unroll
                for (int bj = 0; bj < 2; ++bj) { float x[8];
#pragma unroll
                    for (int j = 0; j < 8; ++j) { const int sl = col0 + bj * 128 + j; const float a_ = (j < 4) ? acc[ai][bj][m][0][j] : acc[ai][bj][m][1][j - 4];
                        const float w_ = __expf(rv + cv[bj][j]); x[j] = (sl <= tl) ? a_ * w_ : 0.f; rs += x[j]; }
                    pg::u32x4 w; w.x = pg::cvt_pk_bf16(x[0], x[1]); w.y = pg::cvt_pk_bf16(x[2], x[3]); w.z = pg::cvt_pk_bf16(x[4], x[5]); w.w = pg::cvt_pk_bf16(x[6], x[7]);
                    *(pg::u32x4*)(op + bj * 128) = w; }
                rs += __shfl_xor(rs, 16); rs += __shfl_xor(rs, 32);
                if (fq == 0) P[tl * 4 + wc] = rs; }
        asm volatile("s_waitcnt lgkmcnt(0)" ::: "memory"); __builtin_amdgcn_s_barrier(); asm volatile("" ::: "memory");
        { const int tid = wid * 64 + lane; if (tid < 256) { const pg::f32x4 p = *(const LAS pg::f32x4*)(P + tid * 4); den[(tok0 + tid) * 4 + h] = (p.x + p.y) + (p.z + p.w); } }
    }
};
struct EpiF32U {
    static constexpr bool PERM = false, AFTER_DRAIN = false, BIAS = false;
    float* C;
    __device__ __forceinline__ void operator()(const pg::f32x4 (&acc)[2][2][4][2], const pg::Unit& u, int wr, int wc, int fr, int fq) const {
        pg::bf16_t* base = (pg::bf16_t*)C + (size_t)u.aux * 65536 + (size_t)(wr * 64 + fr) * 256 + (wc * 4 + fq) * 16;
#pragma unroll
        for (int ai = 0; ai < 2; ++ai)
#pragma unroll
            for (int m = 0; m < 4; ++m)
#pragma unroll
                for (int bj = 0; bj < 2; ++bj) { const pg::f32x4 v0 = acc[ai][bj][m][0], v1 = acc[ai][bj][m][1];
                    pg::u32x4 w; w.x = pg::cvt_pk_bf16(v0[0], v0[1]); w.y = pg::cvt_pk_bf16(v0[2], v0[3]); w.z = pg::cvt_pk_bf16(v1[0], v1[1]); w.w = pg::cvt_pk_bf16(v1[2], v1[3]);
                    *(pg::u32x4*)(base + (size_t)(ai * 128 + m * 16) * 256 + bj * 8) = w; if (bj) asm volatile("" ::: "memory"); }
    }
};
struct EpiNum {
    static constexpr bool PERM = true, AFTER_DRAIN = true, BIAS = false, MIXED_DRAIN = false;
    pg::bf16_t* HOUT; const unsigned char* OGQ; const float* den; const float* emt; const float* gain; const float* den2;
    __device__ __forceinline__ void fused(pg::f32x4 (&acc)[2][2][4][2], const pg::Unit& u, int wr, int wc, int fr, int fq, LAS unsigned char* lds, int wid, int lane) const {
        const int bh = u.g >> 4, c = u.g & 15, b = bh >> 2, h = bh & 3; const size_t tok0 = (size_t)b * SEQ + c * 256;
        LAS pg::f32x2* P = (LAS pg::f32x2*)lds; LAS pg::f32x2* Sx = (LAS pg::f32x2*)(lds + 8192);
        LAS float* Li = (LAS float*)(lds + 8192 + 2048);
        { const int tid = wid * 64 + lane; if (tid < 256) { const size_t ti = (tok0 + tid) * 4 + h; Li[tid] = __builtin_amdgcn_rcpf(fmaxf(fabsf(den[ti] + den2[ti]), emt[ti])); } }
        asm volatile("s_waitcnt vmcnt(0) lgkmcnt(0)" ::: "memory"); __builtin_amdgcn_s_barrier(); asm volatile("" ::: "memory");
#pragma unroll
        for (int ai = 0; ai < 2; ++ai)
#pragma unroll
            for (int m = 0; m < 4; ++m) { const int tl = ai * 128 + wr * 64 + m * 16 + fr;
                const float inv = Li[tl]; float s = 0.f;
#pragma unroll
                for (int bj = 0; bj < 2; ++bj)
#pragma unroll
                    for (int n = 0; n < 2; ++n) { acc[ai][bj][m][n] = acc[ai][bj][m][n] * inv; const pg::f32x4 x = acc[ai][bj][m][n]; s += (x[0] + x[1]) + (x[2] + x[3]); }
                s += __shfl_xor(s, 16); s += __shfl_xor(s, 32);
                const float mw = s * (1.f / 64.f); float q = 0.f;
#pragma unroll
                for (int bj = 0; bj < 2; ++bj)
#pragma unroll
                    for (int n = 0; n < 2; ++n) { const pg::f32x4 d = acc[ai][bj][m][n] - mw; q += (d[0] * d[0] + d[1] * d[1]) + (d[2] * d[2] + d[3] * d[3]); }
                q += __shfl_xor(q, 16); q += __shfl_xor(q, 32);
                if (fq == 0) P[tl * 4 + wc] = (pg::f32x2){mw, q}; }
        asm volatile("s_waitcnt lgkmcnt(0)" ::: "memory"); __builtin_amdgcn_s_barrier(); asm volatile("" ::: "memory");
        if (lane < 32) { const int row = wid * 32 + lane;
            const pg::f32x2 a = P[row * 4 + 0], b_ = P[row * 4 + 1], c_ = P[row * 4 + 2], d = P[row * 4 + 3];
            const float mt = (a.x + b_.x + c_.x + d.x) * 0.25f;
            const float da = a.x - mt, db = b_.x - mt, dc = c_.x - mt, dd = d.x - mt;
            const float m2 = (a.y + b_.y) + (c_.y + d.y) + 64.f * ((da * da + db * db) + (dc * dc + dd * dd));
            Sx[row] = (pg::f32x2){mt, rsqrtf(m2 * (1.f / 256.f) + LN_EPS)}; }
        asm volatile("s_waitcnt lgkmcnt(0)" ::: "memory"); __builtin_amdgcn_s_barrier(); asm volatile("" ::: "memory");
        const int col0 = wc * 32 + 8 * fq;
        pg::f32x4 gn[2][2];
#pragma unroll
        for (int bj = 0; bj < 2; ++bj) { gn[bj][0] = *(const pg::f32x4*)(gain + h * 256 + col0 + bj * 128); gn[bj][1] = *(const pg::f32x4*)(gain + h * 256 + col0 + bj * 128 + 4); }
        const unsigned char* op0 = OGQ + (tok0 + wr * 64 + fr) * 3072 + h * 256 + (wc * 4 + fq) * 16;
        pg::u32x4 ow = *(const pg::u32x4*)op0;
#pragma unroll
        for (int rg = 0; rg < 8; ++rg) { const int ai = rg >> 2, m = rg & 3; const int tl = ai * 128 + wr * 64 + m * 16 + fr; const pg::f32x2 sr = Sx[tl]; const size_t t = tok0 + tl;
            pg::u32x4 on;
            if (rg < 7) on = *(const pg::u32x4*)(op0 + (size_t)(((rg + 1) >> 2) * 128 + ((rg + 1) & 3) * 16) * 3072);
#pragma unroll
            for (int bj = 0; bj < 2; ++bj) { const int e0 = h * 256 + col0 + bj * 128; float o0[4], o1[4];
                fp8x4_to_f32(bj ? ow.z : ow.x, o0); fp8x4_to_f32(bj ? ow.w : ow.y, o1);
                const pg::f32x4 v0 = (acc[ai][bj][m][0] - sr.x) * sr.y * gn[bj][0], v1 = (acc[ai][bj][m][1] - sr.x) * sr.y * gn[bj][1];
                float r[8];
#pragma unroll
                for (int j = 0; j < 4; ++j) { r[j] = v0[j] * fsigmoid(o0[j]); r[4 + j] = v1[j] * fsigmoid(o1[j]); }
                st8(HOUT + t * 1024 + e0, r); }
            ow = on; }
    }
};
struct SchedG1 { pg::TileOrder o; const char* Q; const char* K;
    __device__ __forceinline__ bool next(int i, pg::Unit& u) const { int g, pm, pn; if (!o.tile(i, g, pm, pn)) return false;
        const int bh = g >> 4, c = g & 15, b = bh >> 2, h = bh & 3; const size_t off = (((size_t)b * SEQ + c * 256) * 1024 + h * 256) * 2;
        u.A = Q + off; u.B = K + off; u.pm = 0; u.pn = 0; u.g = g; u.aux = g; u.rows = nullptr; u.nvalid = 0; return true; } };
struct SchedG2 { pg::TileOrder o; const char* BT2; const char* KaT;
    __device__ __forceinline__ bool next(int i, pg::Unit& u) const { int g, pm, pn; if (!o.tile(i, g, pm, pn)) return false;
        const int bh = g / 15, c = g % 15, b = bh >> 2, h = bh & 3;
        u.A = BT2 + (size_t)(bh * 16 + c) * 256 * 512 * 2; u.B = KaT + (((size_t)h * 256) * T + (size_t)b * SEQ + c * 256) * 2;
        u.pm = 0; u.pn = 0; u.g = bh * 16 + c; u.aux = bh * 16 + c; u.rows = nullptr; u.nvalid = 0; return true; } };
struct SchedG3 { pg::TileOrder o; const char* A2; const char* BT2;
    __device__ __forceinline__ bool next(int i, pg::Unit& u) const { int g, pm, pn; if (!o.tile(i, g, pm, pn)) return false;
        const int bh = g >> 4, c = g & 15, b = bh >> 2, h = bh & 3;
        u.A = A2 + (((size_t)b * SEQ + c * 256) * 2048 + h * 512) * 2; u.B = BT2 + (size_t)g * 256 * 512 * 2; u.pm = 0; u.pn = 0; u.g = g; u.aux = g; u.rows = nullptr; u.nvalid = 0; return true; } };
__device__ __forceinline__ void ph_un(LAS unsigned char* lds, const OptBufs2& o2, const OptBufs3& o3) {
    const int tid = tidf(), lane = tid & 63, wave = tid >> 6; LAS float* red = (LAS float*)lds;
    for (int it = blockIdx.x; it < 256; it += gridDim.x) { const int bh = it >> 4, c = it & 15, b = bh >> 2, h = bh & 3; const size_t tok0 = (size_t)b * SEQ + c * 256 + wave * 32;
        pg::u32x2 kv[32]; float av[32];
#pragma unroll
        for (int j = 0; j < 32; ++j) { kv[j] = *(const pg::u32x2*)(o2.K + (tok0 + j) * 1024 + h * 256 + 4 * lane); av[j] = o3.aw[(tok0 + j) * 4 + h]; }
        float s0 = 0.f, s1 = 0.f, s2 = 0.f, s3 = 0.f;
#pragma unroll
        for (int j = 0; j < 32; ++j) { s0 += av[j] * __builtin_bit_cast(float, kv[j].x << 16); s1 += av[j] * __builtin_bit_cast(float, kv[j].x & 0xffff0000u);
            s2 += av[j] * __builtin_bit_cast(float, kv[j].y << 16); s3 += av[j] * __builtin_bit_cast(float, kv[j].y & 0xffff0000u); }
        __syncthreads();
        *(LAS pg::f32x4*)(red + wave * 256 + 4 * lane) = (pg::f32x4){s0, s1, s2, s3};
        __syncthreads();
        if (tid < 256) { float s_ = 0.f;
#pragma unroll
            for (int w = 0; w < 8; ++w) s_ += red[w * 256 + tid];
            o3.un[(size_t)it * 256 + tid] = s_; } }
    __syncthreads();
}
__device__ __forceinline__ void ph_state_scan(const OptBufs& ob, const OptBufs3& o3) {
    const int gt = blockIdx.x * NT + tidf(), ngt = gridDim.x * NT;
    const pg::bf16_t* U16 = (const pg::bf16_t*)o3.U;
    for (int it = gt; it < 16 * 256 * 32; it += ngt) { const int bh = it >> 13, e = (it >> 5) & 255, ch = it & 31, slot = ch >> 1, bj = ch & 1;
        const int d0 = 128 * bj + 32 * (slot >> 2) + 4 * (slot & 3);
        pg::u32x4 U[15]; float dc[15];
#pragma unroll
        for (int c = 0; c < 15; ++c) { const size_t g = (size_t)bh * 16 + c; U[c] = __builtin_nontemporal_load((const pg::u32x4*)(U16 + g * 65536 + (size_t)e * 256 + ch * 8)); dc[c] = o3.decay[g]; }
        float C[8];
#pragma unroll
        for (int j = 0; j < 8; ++j) C[j] = 0.f;
#pragma unroll
        for (int c = 0; c < 16; ++c) { const size_t g = (size_t)bh * 16 + c;
            pg::bf16_t* dst = ob.BT2 + (g * 256 + e) * 512 + 256 + d0;
            *(pg::u32x2*)(dst) = (pg::u32x2){pk2(C[0], C[1]), pk2(C[2], C[3])};
            *(pg::u32x2*)(dst + 16) = (pg::u32x2){pk2(C[4], C[5]), pk2(C[6], C[7])};
            if (c < 15) { const pg::u32x4 w = U[c];
                C[0] = C[0] * dc[c] + __builtin_bit_cast(float, w.x << 16); C[1] = C[1] * dc[c] + __builtin_bit_cast(float, w.x & 0xffff0000u);
                C[2] = C[2] * dc[c] + __builtin_bit_cast(float, w.y << 16); C[3] = C[3] * dc[c] + __builtin_bit_cast(float, w.y & 0xffff0000u);
                C[4] = C[4] * dc[c] + __builtin_bit_cast(float, w.z << 16); C[5] = C[5] * dc[c] + __builtin_bit_cast(float, w.z & 0xffff0000u);
                C[6] = C[6] * dc[c] + __builtin_bit_cast(float, w.w << 16); C[7] = C[7] * dc[c] + __builtin_bit_cast(float, w.w & 0xffff0000u); } } }
}
__device__ __forceinline__ void ph_den_inter(LAS unsigned char* lds, const OptBufs3& o3) {
    const int tid = tidf(), lane = tid & 63, wave = tid >> 6; LAS float* nn = (LAS float*)lds;
    for (int it = blockIdx.x; it < 256; it += gridDim.x) { const int bh = it >> 4, c = it & 15, b = bh >> 2, h = bh & 3; const size_t tok0 = (size_t)b * SEQ + c * 256;
        __syncthreads();
        if (tid < 256) { float uv[15], dv[15];
#pragma unroll
            for (int j = 0; j < 15; ++j) { const bool on = j < c; uv[j] = on ? o3.un[(size_t)(bh * 16 + j) * 256 + tid] : 0.f; dv[j] = on ? o3.decay[bh * 16 + j] : 1.f; }
            float n = 0.f;
#pragma unroll
            for (int j = 0; j < 15; ++j) n = n * dv[j] + uv[j];
            nn[tid] = n; }
        __syncthreads();
        const pg::f32x4 nv = *(const LAS pg::f32x4*)(nn + 4 * lane);
        for (int r0 = 0; r0 < 32; r0 += 8) { pg::u32x2 wv[8];
#pragma unroll
            for (int r = 0; r < 8; ++r) wv[r] = *(const pg::u32x2*)(o3.A2 + (tok0 + wave * 32 + r0 + r) * 2048 + h * 512 + 256 + 4 * lane);
#pragma unroll
            for (int r = 0; r < 8; ++r) { const size_t t = tok0 + wave * 32 + r0 + r; const pg::u32x2 w = wv[r];
                float s = __builtin_bit_cast(float, w.x << 16) * nv[0] + __builtin_bit_cast(float, w.x & 0xffff0000u) * nv[1] + __builtin_bit_cast(float, w.y << 16) * nv[2] + __builtin_bit_cast(float, w.y & 0xffff0000u) * nv[3];
                s = wsum(s);
                if (lane == 0) o3.den2[t * 4 + h] = s; } } }
    __syncthreads();
}

__device__ __forceinline__ void ph_gemm_poolmix(LAS unsigned char* lds, const OptBufs2& o, const float* b_pool, const float* ls_pool) {
    const int G = gridDim.x, bx = blockIdx.x;
    { SchedG S; S.o.init(T / 256, 2, 1, G, bx); S.A = (const char*)o.POOLED; S.B = (const char*)o.WpoolT; S.gA = 0; S.gB = 0; S.tA = (size_t)256 * 512 * 2; S.tB = (size_t)256 * 512 * 2;
      EpiPoolMixB E{o.MIXED, b_pool, ls_pool}; pg::gemm_phase<EpiPoolMixB, SchedG>(lds, 512, 512, 512, S, E); }
}
__device__ __forceinline__ void ph_gemms_D(LAS unsigned char* lds, const OptBufs2& o, const OptBufs3& o3, const float* b_pool, const float* ls_pool) {
    const int G = gridDim.x, bx = blockIdx.x;
    { typedef SchedPair<SchedG, SchedG> SP; typedef EpiPair<EpiQ, pg::EpiStoreBf16> EP;
      const int c = (bx + 128) % G;
      SP S; S.G = G; S.c = c; S.n1 = (T / 256) * 4;
      S.s1.o.init(T / 256, 1, 4, G, c); S.s1.A = (const char*)o.UC; S.s1.B = (const char*)o.WqT; S.s1.gA = 256 * 2; S.s1.gB = (size_t)65536 * 2; S.s1.tA = (size_t)256 * 1024 * 2; S.s1.tB = 0;
      S.s2 = S.s1; S.s2.o.init(T / 256, 1, 4, G, c - S.n1); S.s2.B = (const char*)o.WkT;
      EP E{EpiQ{o.Q, o3.A2, o3.winter}, pg::EpiStoreBf16{o.K, 1024, 1.f, 256}}; pg::gemm_phase<EP, SP>(lds, 1024, 256, 256, S, E); }
    { SchedG S; S.o.init(1, T / 256, 4, G, bx); S.A = (const char*)o.WkT; S.B = (const char*)o.UC; S.gA = (size_t)65536 * 2; S.gB = 256 * 2; S.tA = 0; S.tB = (size_t)256 * 1024 * 2;
      EpiKT E{o3.KaT, o3.aw}; pg::gemm_phase<EpiKT, SchedG>(lds, 256, 1024, 256, S, E); }
}
__device__ __forceinline__ void ph_gemms_E(LAS unsigned char* lds, const OptBufs& ob, const OptBufs2& o2, const OptBufs3& o3) {
    const int G = gridDim.x, bx = blockIdx.x;
    ph_un(lds, o2, o3);
    { SchedG1 S; S.o.init(1, 1, 256, G, bx); S.Q = (const char*)o2.Q; S.K = (const char*)o2.K;
      EpiS E{o3.A2, o3.rowv, o3.colv, o3.den}; pg::gemm_phase<EpiS, SchedG1>(lds, 1024, 1024, 256, S, E); }
    { SchedG2 S; S.o.init(1, 1, 240, G, bx); S.BT2 = (const char*)ob.BT2; S.KaT = (const char*)o3.KaT;
      EpiF32U E{o3.U}; pg::gemm_phase<EpiF32U, SchedG2>(lds, 512, T, 256, S, E); }
}
__device__ __forceinline__ void ph_gemms_P3(LAS unsigned char* lds, const OptBufs2& o, const OptBufs3& o3, const float* b_pool, const float* ls_pool) {
    const int G = gridDim.x, bx = blockIdx.x;
    typedef SchedMulti<SchedG, SchedG, SchedG, SchedG> SM; typedef EpiMulti<EpiPoolMixB, EpiQ, pg::EpiStoreBf16, EpiKT, -1> EM;
    SM S; S.G = G; S.c = bx; S.b1 = (T / 256) * 2; S.b2 = S.b1 + (T / 256) * 4; S.b3 = S.b2 + (T / 256) * 4;
    S.s0.o.init(T / 256, 2, 1, G, bx); S.s0.A = (const char*)o.POOLED; S.s0.B = (const char*)o.WpoolT; S.s0.gA = 0; S.s0.gB = 0; S.s0.tA = (size_t)256 * 512 * 2; S.s0.tB = (size_t)256 * 512 * 2; S.geo(0, 512, 512, 512, 1);
    S.s1.o.init(T / 256, 1, 4, G, bx - S.b1); S.s1.A = (const char*)o.UC; S.s1.B = (const char*)o.WqT; S.s1.gA = 256 * 2; S.s1.gB = (size_t)65536 * 2; S.s1.tA = (size_t)256 * 1024 * 2; S.s1.tB = 0; S.geo(1, 1024, 256, 256, 1);
    S.s2 = S.s1; S.s2.o.init(T / 256, 1, 4, G, bx - S.b2); S.s2.B = (const char*)o.WkT; S.geo(2, 1024, 256, 256, 1);
    S.s3.o.init(1, T / 256, 4, G, bx - S.b3); S.s3.A = (const char*)o.WkT; S.s3.B = (const char*)o.UC; S.s3.gA = (size_t)65536 * 2; S.s3.gB = 256 * 2; S.s3.tA = 0; S.s3.tB = (size_t)256 * 1024 * 2; S.geo(3, 256, 1024, 256, 1);
    EM E{EpiPoolMixB{o.MIXED, b_pool, ls_pool}, EpiQ{o.Q, o3.A2, o3.winter}, pg::EpiStoreBf16{o.K, 1024, 1.f, 256}, EpiKT{o3.KaT, o3.aw}};
    pg::gemm_phase<EM, SM, false, false, true>(lds, 0, 0, 0, S, E);
}
__device__ __forceinline__ void ph_gemms_P4(LAS unsigned char* lds, const OptBufs& ob, const OptBufs2& o2, const OptBufs3& o3) {
    const int G = gridDim.x, bx = blockIdx.x;
    ph_un(lds, o2, o3);
    typedef SchedMulti<SchedG, SchedG2, SchedG1, SchedNone> SM; typedef EpiMulti<EpiOGQ, EpiF32U, EpiS, EpiNone, 2> EM;
    SM S; S.G = G; S.c = bx; S.b1 = (T / 256) * 4; S.b2 = S.b1 + 240; S.b3 = S.b2 + 256;
    S.s0.o.init(T / 256, 4, 1, G, bx); S.s0.A = (const char*)o2.MIXED; S.s0.B = (const char*)o2.WbpT; S.s0.gA = 0; S.s0.gB = 0; S.s0.tA = (size_t)256 * 512 * 2; S.s0.tB = (size_t)256 * 512 * 2; S.geo(0, 512, 512, 512, 1);
    S.s1.o.init(1, 1, 240, G, bx - S.b1); S.s1.BT2 = (const char*)ob.BT2; S.s1.KaT = (const char*)o3.KaT; S.geo(1, 512, T, 256, 0);
    S.s2.o.init(1, 1, 256, G, bx - S.b2); S.s2.Q = (const char*)o2.Q; S.s2.K = (const char*)o2.K; S.geo(2, 1024, 1024, 256, 1);
    S.geo(3, 512, 512, 256, 1);
    EM E{EpiOGQ{(unsigned char*)o2.YPOOL, 1024}, EpiF32U{o3.U}, EpiS{o3.A2, o3.rowv, o3.colv, o3.den}, EpiNone{}};
    pg::gemm_phase<EM, SM, false, false, true>(lds, 0, 0, 0, S, E);
}
__device__ __forceinline__ void ph_gemm_G3(LAS unsigned char* lds, const OptBufs& ob, const OptBufs3& o3, const float* gain) {
    SchedG3 S; S.o.init(1, 1, 256, gridDim.x, blockIdx.x); S.A2 = (const char*)o3.A2; S.BT2 = (const char*)ob.BT2;
    EpiNum E{o3.HOUT, ob.OGQ, o3.den, o3.emt, gain, o3.den2}; pg::gemm_phase<EpiNum, SchedG3>(lds, 2048, 512, 512, S, E);
}
__device__ __forceinline__ void ph_gemm_ypool(LAS unsigned char* lds, const OptBufs2& o) {
    const int G = gridDim.x, bx = blockIdx.x;
    SchedG S; S.o.init(T / 256, 4, 1, G, bx); S.A = (const char*)o.MIXED; S.B = (const char*)o.WbpT; S.gA = 0; S.gB = 0; S.tA = (size_t)256 * 512 * 2; S.tB = (size_t)256 * 512 * 2;
    EpiOGQ E{(unsigned char*)o.YPOOL, 1024}; pg::gemm_phase<EpiOGQ, SchedG>(lds, 512, 512, 512, S, E);
}


struct OptBufs4 { pg::bf16_t *WbmT, *WoutT, *MERGED, *H1B; unsigned char* H1Q; float *Z, *WRP, *CGB; int *elist, *erank; float *gate; };
struct EpiMerge {
    static constexpr bool PERM = true, AFTER_DRAIN = false, BIAS = false;
    pg::bf16_t* O; const unsigned char* OGQ; const unsigned char* YPOOL;
    __device__ __forceinline__ void operator()(const pg::f32x4 (&acc)[2][2][4][2], const pg::Unit& u, int wr, int wc, int fr, int fq) const {
        const int col0 = u.pn * 256 + wc * 32 + 8 * fq;
        const size_t t00 = (size_t)u.pm * 256 + wr * 64 + fr;
        const unsigned char* gp0 = OGQ + t00 * 3072 + (4 + u.pn) * 256 + (wc * 4 + fq) * 16;
        const int yslot = u.pn * 256 + (wc * 4 + fq) * 16;
        pg::u32x4 w0 = *(const pg::u32x4*)gp0, w1 = *(const pg::u32x4*)(gp0 + 1024), y0 = *(const pg::u32x4*)(YPOOL + t00 * 1024 + yslot);
#pragma unroll
        for (int rg = 0; rg < 8; ++rg) { const int ai = rg >> 2, m = rg & 3; const size_t t = t00 + ai * 128 + m * 16;
            pg::u32x4 nw0, nw1, ny0;
            if (rg < 7) { const size_t tn = t00 + ((rg + 1) >> 2) * 128 + ((rg + 1) & 3) * 16; const unsigned char* gp = OGQ + tn * 3072 + (4 + u.pn) * 256 + (wc * 4 + fq) * 16;
                nw0 = *(const pg::u32x4*)gp; nw1 = *(const pg::u32x4*)(gp + 1024); ny0 = *(const pg::u32x4*)(YPOOL + tn * 1024 + yslot); }
#pragma unroll
            for (int bj = 0; bj < 2; ++bj) { const int c = col0 + bj * 128; float g0[8], g1[8], yp[8], r[8]; float f[4];
                fp8x4_to_f32(bj ? w0.z : w0.x, f); g0[0] = f[0]; g0[1] = f[1]; g0[2] = f[2]; g0[3] = f[3];
                fp8x4_to_f32(bj ? w0.w : w0.y, f); g0[4] = f[0]; g0[5] = f[1]; g0[6] = f[2]; g0[7] = f[3];
                fp8x4_to_f32(bj ? w1.z : w1.x, f); g1[0] = f[0]; g1[1] = f[1]; g1[2] = f[2]; g1[3] = f[3];
                fp8x4_to_f32(bj ? w1.w : w1.y, f); g1[4] = f[0]; g1[5] = f[1]; g1[6] = f[2]; g1[7] = f[3];
                fp8x4_to_f32(bj ? y0.z : y0.x, f); yp[0] = f[0]; yp[1] = f[1]; yp[2] = f[2]; yp[3] = f[3];
                fp8x4_to_f32(bj ? y0.w : y0.y, f); yp[4] = f[0]; yp[5] = f[1]; yp[6] = f[2]; yp[7] = f[3];
#pragma unroll
                for (int j = 0; j < 8; ++j) { const float a_ = (j < 4) ? acc[ai][bj][m][0][j] : acc[ai][bj][m][1][j - 4]; r[j] = fsigmoid(g0[j]) * yp[j] + fsigmoid(g1[j]) * a_; }
                st8(O + t * 1024 + c, r); }
            w0 = nw0; w1 = nw1; y0 = ny0; }
    }
};
struct EpiMixRes {
    static constexpr bool PERM = true, AFTER_DRAIN = false, BIAS = false;
    pg::bf16_t* Z; const pg::bf16_t* H0B;
    __device__ __forceinline__ void operator()(const pg::f32x4 (&acc)[2][2][4][2], const pg::Unit& u, int wr, int wc, int fr, int fq) const {
        const int col0 = u.pn * 256 + wc * 32 + 8 * fq; const size_t t00 = (size_t)u.pm * 256 + wr * 64 + fr;
        pg::u32x4 h0 = *(const pg::u32x4*)(H0B + t00 * 1024 + col0), h1 = *(const pg::u32x4*)(H0B + t00 * 1024 + col0 + 128);
#pragma unroll
        for (int rg = 0; rg < 8; ++rg) { const int ai = rg >> 2, m = rg & 3; const size_t t = t00 + ai * 128 + m * 16;
            pg::u32x4 n0, n1;
            if (rg < 7) { const size_t tn = t00 + ((rg + 1) >> 2) * 128 + ((rg + 1) & 3) * 16; n0 = *(const pg::u32x4*)(H0B + tn * 1024 + col0); n1 = *(const pg::u32x4*)(H0B + tn * 1024 + col0 + 128); }
#pragma unroll
            for (int bj = 0; bj < 2; ++bj) { const int c = col0 + bj * 128; const pg::u32x4 hw = bj ? h1 : h0; float h[8], r[8];
                h[0] = __builtin_bit_cast(float, hw.x << 16); h[1] = __builtin_bit_cast(float, hw.x & 0xffff0000u); h[2] = __builtin_bit_cast(float, hw.y << 16); h[3] = __builtin_bit_cast(float, hw.y & 0xffff0000u);
                h[4] = __builtin_bit_cast(float, hw.z << 16); h[5] = __builtin_bit_cast(float, hw.z & 0xffff0000u); h[6] = __builtin_bit_cast(float, hw.w << 16); h[7] = __builtin_bit_cast(float, hw.w & 0xffff0000u);
#pragma unroll
                for (int j = 0; j < 8; ++j) { const float a_ = (j < 4) ? acc[ai][bj][m][0][j] : acc[ai][bj][m][1][j - 4]; r[j] = h[j] * ALPHA + a_; }
                st8(Z + t * 1024 + c, r); }
            h0 = n0; h1 = n1; }
    }
};
__device__ __forceinline__ void ph_gemm_ymls(LAS unsigned char* lds, const OptBufs& ob, const OptBufs2& o2, const OptBufs3& o3, const OptBufs4& o4) {
    SchedG S; S.o.init(T / 256, 4, 1, gridDim.x, blockIdx.x); S.A = (const char*)o3.HOUT; S.B = (const char*)o4.WbmT; S.gA = 0; S.gB = 0; S.tA = (size_t)256 * 1024 * 2; S.tB = (size_t)256 * 1024 * 2;
    EpiMerge E{o4.MERGED, ob.OGQ, (const unsigned char*)o2.YPOOL}; pg::gemm_phase<EpiMerge, SchedG>(lds, 1024, 1024, 1024, S, E);
}
__device__ __forceinline__ void ph_gemm_mix(LAS unsigned char* lds, const OptBufs& ob, const OptBufs4& o4, const float* x, const float* g, const float* beta) {
    SchedG S; S.o.init(T / 256, 4, 1, gridDim.x, blockIdx.x); S.A = (const char*)o4.MERGED; S.B = (const char*)o4.WoutT; S.gA = 0; S.gB = 0; S.tA = (size_t)256 * 1024 * 2; S.tB = (size_t)256 * 1024 * 2;
    EpiMixRes E{(pg::bf16_t*)o4.Z, ob.H0B}; pg::gemm_phase<EpiMixRes, SchedG>(lds, 1024, 1024, 1024, S, E);
}
typedef float f32x16 __attribute__((ext_vector_type(16)));
__device__ __forceinline__ void ph_router_prep(const OptBufs4& o, const float* g, const float* beta, const float* wr_, const float* br, int wgi, int nwg) {
    const int gt = wgi * NT + tidf(), ngt = nwg * NT;
    for (int i = gt; i < 1024 * 32; i += ngt) o.WRP[i] = g[i >> 5] * wr_[i];
    const int gw = gt >> 6, lane = gt & 63;
    if (gw < 64) { const int e = gw & 31; const float* vsrc = (gw < 32) ? g : beta; float s_ = 0.f;
#pragma unroll
        for (int i = 0; i < 16; ++i) { const int k = lane + 64 * i; s_ += vsrc[k] * wr_[k * 32 + e]; }
        s_ = wsum(s_);
        if (lane == 0) o.CGB[gw] = s_ + ((gw < 32) ? 0.f : br[e]); }
}
__device__ __forceinline__ pg::f32x4 ldz4(const pg::bf16_t* p) { const pg::u32x2 w = *(const pg::u32x2*)p; return (pg::f32x4){__builtin_bit_cast(float, w.x << 16), __builtin_bit_cast(float, w.x & 0xffff0000u), __builtin_bit_cast(float, w.y << 16), __builtin_bit_cast(float, w.y & 0xffff0000u)}; }
__device__ __forceinline__ void ph_ln1_router(LAS unsigned char* lds, const OptBufs4& o, const float* Zin, const float* g, const float* beta, int* cnt, int mode = 7) {
    const int tid = tidf(), lane = tid & 63, wave = tid >> 6; const pg::bf16_t* Zb = (const pg::bf16_t*)Zin;
    LAS float* part = (LAS float*)lds;
    LAS float* stg = (LAS float*)(lds + wave * 9216);
    LAS float* L = (LAS float*)(lds + 81920);
    LAS float* st = (LAS float*)(lds + 81920 + 8448);
    LAS int* hist = (LAS int*)(lds + 131072 + 1024);
    LAS int* asg = (LAS int*)(lds + 131072 + 1024 + 256);
    for (int tile = blockIdx.x; tile < T / 64; tile += gridDim.x) {
        __syncthreads();
        if (tid < 64) hist[tid] = 0;
        const size_t tbase = (size_t)tile * 64 + wave * 8;
        auto ln_row = [&](pg::f32x4 (&v)[4], int r) {
            float sa = 0.f;
#pragma unroll
            for (int j = 0; j < 4; ++j) sa += (v[j].x + v[j].y) + (v[j].z + v[j].w);
            const float ma = wsum(sa) * (1.f / D); float qa = 0.f;
#pragma unroll
            for (int j = 0; j < 4; ++j) { v[j] = v[j] - ma; qa += (v[j].x * v[j].x + v[j].y * v[j].y) + (v[j].z * v[j].z + v[j].w * v[j].w); }
            const float ra = rsqrtf(wsum(qa) * (1.f / D) + LN_EPS);
            const size_t ta = tbase + r;
            if (lane == 0) { st[(wave * 8 + r) * 2] = ma; st[(wave * 8 + r) * 2 + 1] = ra; }
#pragma unroll
            for (int jh = 0; jh < 2; ++jh) { pg::u32x4 wb; pg::u32x2 wq;
#pragma unroll
                for (int k = 0; k < 2; ++k) { const int c0 = 512 * jh + 8 * lane + 4 * k;
                    const pg::f32x4 gg = *(const pg::f32x4*)(g + c0), bb = *(const pg::f32x4*)(beta + c0);
                    const pg::f32x4 y = v[2 * jh + k] * ra * gg + bb;
                    const unsigned p0 = pk2(y.x, y.y), p1 = pk2(y.z, y.w);
                    int w0 = __builtin_amdgcn_cvt_pk_fp8_f32(y.x, y.y, 0, false); w0 = __builtin_amdgcn_cvt_pk_fp8_f32(y.z, y.w, w0, true);
                    if (k == 0) { wb.x = p0; wb.y = p1; wq.x = (unsigned)w0; } else { wb.z = p0; wb.w = p1; wq.y = (unsigned)w0; } }
                *(pg::u32x4*)(o.H1B + ta * D + 512 * jh + 8 * lane) = wb;
                *(pg::u32x2*)(o.H1Q + ta * D + 512 * jh + 8 * lane) = wq; }
        };
        { const int hh = lane >> 5, el = lane & 31, kb = wave * 128;
          f32x16 acc0, acc1;
#pragma unroll
          for (int i = 0; i < 16; ++i) { acc0[i] = 0.f; acc1[i] = 0.f; }
          const pg::bf16_t* zt = Zb + (size_t)tile * 64 * D + kb;
          pg::f32x4 va[4], vb[4], zv[8];
          { _Pragma("unroll") for (int jh = 0; jh < 2; ++jh) { const pg::u32x4 w_ = *(const pg::u32x4*)(Zb + (tbase) * D + 512 * jh + 8 * lane); va[2 * jh] = (pg::f32x4){__builtin_bit_cast(float, w_.x << 16), __builtin_bit_cast(float, w_.x & 0xffff0000u), __builtin_bit_cast(float, w_.y << 16), __builtin_bit_cast(float, w_.y & 0xffff0000u)}; va[2 * jh + 1] = (pg::f32x4){__builtin_bit_cast(float, w_.z << 16), __builtin_bit_cast(float, w_.z & 0xffff0000u), __builtin_bit_cast(float, w_.w << 16), __builtin_bit_cast(float, w_.w & 0xffff0000u)}; } }
#pragma unroll
          for (int it = 0; it < 4; ++it) { const pg::u32x4 w_ = *(const pg::u32x4*)(zt + (size_t)(it * 16 + (lane >> 2)) * D + 8 * (lane & 3)); zv[2 * it] = (pg::f32x4){__builtin_bit_cast(float, w_.x << 16), __builtin_bit_cast(float, w_.x & 0xffff0000u), __builtin_bit_cast(float, w_.y << 16), __builtin_bit_cast(float, w_.y & 0xffff0000u)}; zv[2 * it + 1] = (pg::f32x4){__builtin_bit_cast(float, w_.z << 16), __builtin_bit_cast(float, w_.z & 0xffff0000u), __builtin_bit_cast(float, w_.w << 16), __builtin_bit_cast(float, w_.w & 0xffff0000u)}; }
#pragma unroll 1
          for (int sub = 0; sub < 4; ++sub) {
              { _Pragma("unroll") for (int jh = 0; jh < 2; ++jh) { const pg::u32x4 w_ = *(const pg::u32x4*)(Zb + (tbase + 2 * sub + 1) * D + 512 * jh + 8 * lane); vb[2 * jh] = (pg::f32x4){__builtin_bit_cast(float, w_.x << 16), __builtin_bit_cast(float, w_.x & 0xffff0000u), __builtin_bit_cast(float, w_.y << 16), __builtin_bit_cast(float, w_.y & 0xffff0000u)}; vb[2 * jh + 1] = (pg::f32x4){__builtin_bit_cast(float, w_.z << 16), __builtin_bit_cast(float, w_.z & 0xffff0000u), __builtin_bit_cast(float, w_.w << 16), __builtin_bit_cast(float, w_.w & 0xffff0000u)}; } }
              ln_row(va, 2 * sub);
              if (sub < 3) {
                  { _Pragma("unroll") for (int jh = 0; jh < 2; ++jh) { const pg::u32x4 w_ = *(const pg::u32x4*)(Zb + (tbase + 2 * sub + 2) * D + 512 * jh + 8 * lane); va[2 * jh] = (pg::f32x4){__builtin_bit_cast(float, w_.x << 16), __builtin_bit_cast(float, w_.x & 0xffff0000u), __builtin_bit_cast(float, w_.y << 16), __builtin_bit_cast(float, w_.y & 0xffff0000u)}; va[2 * jh + 1] = (pg::f32x4){__builtin_bit_cast(float, w_.z << 16), __builtin_bit_cast(float, w_.z & 0xffff0000u), __builtin_bit_cast(float, w_.w << 16), __builtin_bit_cast(float, w_.w & 0xffff0000u)}; } } }
              ln_row(vb, 2 * sub + 1);
              float bw[16];
#pragma unroll
              for (int s_ = 0; s_ < 16; ++s_) bw[s_] = o.WRP[(size_t)(kb + 32 * sub + 16 * hh + s_) * 32 + el];
#pragma unroll
              for (int it = 0; it < 4; ++it) { LAS float* sp = stg + (it * 16 + (lane >> 2)) * 36 + 8 * (lane & 3); *(LAS pg::f32x4*)sp = zv[2 * it]; *(LAS pg::f32x4*)(sp + 4) = zv[2 * it + 1]; }
              if (sub < 3) {
#pragma unroll
                  for (int it = 0; it < 4; ++it) { const pg::u32x4 w_ = *(const pg::u32x4*)(zt + (size_t)(it * 16 + (lane >> 2)) * D + 32 * (sub + 1) + 8 * (lane & 3)); zv[2 * it] = (pg::f32x4){__builtin_bit_cast(float, w_.x << 16), __builtin_bit_cast(float, w_.x & 0xffff0000u), __builtin_bit_cast(float, w_.y << 16), __builtin_bit_cast(float, w_.y & 0xffff0000u)}; zv[2 * it + 1] = (pg::f32x4){__builtin_bit_cast(float, w_.z << 16), __builtin_bit_cast(float, w_.z & 0xffff0000u), __builtin_bit_cast(float, w_.w << 16), __builtin_bit_cast(float, w_.w & 0xffff0000u)}; } }
              asm volatile("s_waitcnt lgkmcnt(0)" ::: "memory");
              pg::f32x4 a0[4], a1[4];
#pragma unroll
              for (int q = 0; q < 4; ++q) { a0[q] = *(const LAS pg::f32x4*)(stg + el * 36 + 16 * hh + 4 * q); a1[q] = *(const LAS pg::f32x4*)(stg + (32 + el) * 36 + 16 * hh + 4 * q); }
#pragma unroll
              for (int q = 0; q < 4; ++q) {
                  acc0 = __builtin_amdgcn_mfma_f32_32x32x2f32(a0[q].x, bw[4 * q + 0], acc0, 0, 0, 0); acc1 = __builtin_amdgcn_mfma_f32_32x32x2f32(a1[q].x, bw[4 * q + 0], acc1, 0, 0, 0);
                  acc0 = __builtin_amdgcn_mfma_f32_32x32x2f32(a0[q].y, bw[4 * q + 1], acc0, 0, 0, 0); acc1 = __builtin_amdgcn_mfma_f32_32x32x2f32(a1[q].y, bw[4 * q + 1], acc1, 0, 0, 0);
                  acc0 = __builtin_amdgcn_mfma_f32_32x32x2f32(a0[q].z, bw[4 * q + 2], acc0, 0, 0, 0); acc1 = __builtin_amdgcn_mfma_f32_32x32x2f32(a1[q].z, bw[4 * q + 2], acc1, 0, 0, 0);
                  acc0 = __builtin_amdgcn_mfma_f32_32x32x2f32(a0[q].w, bw[4 * q + 3], acc0, 0, 0, 0); acc1 = __builtin_amdgcn_mfma_f32_32x32x2f32(a1[q].w, bw[4 * q + 3], acc1, 0, 0, 0); }
              asm volatile("s_waitcnt lgkmcnt(0)" ::: "memory");
          }
          __syncthreads();
#pragma unroll
          for (int i = 0; i < 16; ++i) { part[((wave * 2 + 0) * 16 + i) * 64 + lane] = acc0[i]; part[((wave * 2 + 1) * 16 + i) * 64 + lane] = acc1[i]; }
        }
        __syncthreads();
#pragma unroll
        for (int i = 0; i < 4; ++i) { const int idx = tid + 512 * i; float sum = 0.f;
#pragma unroll
            for (int w = 0; w < 8; ++w) sum += part[w * 2048 + idx];
            const int mt = idx >> 10, rg = (idx >> 6) & 15, l2 = idx & 63, tok = mt * 32 + (rg & 3) + 8 * (rg >> 2) + 4 * (l2 >> 5), e = l2 & 31;
            L[tok * 33 + e] = st[tok * 2 + 1] * (sum - st[tok * 2] * o.CGB[e]) + o.CGB[32 + e]; }
        __syncthreads();
        int i0 = -1, i1 = -1, i2 = -1, i3 = -1; float v0 = 0.f, v1 = 0.f, v2 = 0.f, v3 = 0.f;
        { const int tok_ = tid >> 3, sub = tid & 7; const LAS float* lr_ = L + tok_ * 33 + sub * 4;
          float xv[4];
#pragma unroll
          for (int j = 0; j < 4; ++j) xv[j] = lr_[j];
          unsigned taken = 0u;
#pragma unroll
          for (int k = 0; k < 4; ++k) { float bv = -INFINITY; int bi = 64;
#pragma unroll
              for (int j = 0; j < 4; ++j) { if (!((taken >> j) & 1u) && xv[j] > bv) { bv = xv[j]; bi = sub * 4 + j; } }
#pragma unroll
              for (int off = 1; off < 8; off <<= 1) { const float ov = __shfl_xor(bv, off); const int oi = __shfl_xor(bi, off); if (ov > bv || (ov == bv && oi < bi)) { bv = ov; bi = oi; } }
              if ((bi >> 2) == sub) taken |= 1u << (bi & 3);
              if (k == 0) { i0 = bi; v0 = bv; } else if (k == 1) { i1 = bi; v1 = bv; } else if (k == 2) { i2 = bi; v2 = bv; } else { i3 = bi; v3 = bv; } } }
        if ((tid & 7) == 0 && (mode & 4)) { const int tk = tid >> 3;
            const float e1 = expf(v1 - v0), e2 = expf(v2 - v0), e3 = expf(v3 - v0), inv = 1.f / (1.f + e1 + e2 + e3);
            const size_t t = (size_t)tile * 64 + tk;
            *(pg::f32x4*)(o.gate + t * 4) = (pg::f32x4){inv, e1 * inv, e2 * inv, e3 * inv};
            const int r0 = atomicAdd((int*)(hist + i0), 1), r1 = atomicAdd((int*)(hist + i1), 1), r2 = atomicAdd((int*)(hist + i2), 1), r3 = atomicAdd((int*)(hist + i3), 1);
            asg[tk * 4 + 0] = i0 | (r0 << 8); asg[tk * 4 + 1] = i1 | (r1 << 8); asg[tk * 4 + 2] = i2 | (r2 << 8); asg[tk * 4 + 3] = i3 | (r3 << 8); }
        __syncthreads();
        if (tid < 32) hist[32 + tid] = atomicAdd(&cnt[tid], hist[tid]);
        __syncthreads();
        if (tid < 256) { const int a_ = asg[tid], e = a_ & 255, rank = hist[32 + e] + (a_ >> 8); const int t = tile * 64 + (tid >> 2);
            o.elist[e * T + rank] = t; o.erank[(size_t)t * 4 + (tid & 3)] = (e << 16) | rank; }
    }
    __syncthreads();
}
struct OptBufs5 { pg::bf16_t *We1T, *We2T, *ACT, *Y; float* B1P; };
constexpr int MOE_TAB_OFF = 131072 + 4096;
__device__ __forceinline__ void moe_build_tab(LAS unsigned char* lds, const int* cnt) {
    LAS int* tab = (LAS int*)(lds + MOE_TAB_OFF);
    __syncthreads();
    const int tid = tidf();
    if (tid < 64) { const int e = tid & 31; const int c = cnt[e]; int incl = (c + 255) >> 8;
#pragma unroll
        for (int off = 1; off < 32; off <<= 1) { const int v = __shfl_up(incl, off, 32); if (e >= off) incl += v; }
        if (tid < 32) { tab[e] = incl - ((c + 255) >> 8); tab[40 + e] = c; if (e == 31) tab[NE] = incl; } }
    __syncthreads();
}
struct SchedMoE {
    const LAS int* tab; const int* cnt; const int* elist; const char* A; const char* B; size_t eB; int nN, nwg, G, c, gather;
    __device__ __forceinline__ bool next(int i, pg::Unit& u) const {
        const long L = (long)i * G + c; if (L >= nwg) return false;
        int wgid = (int)L; { const int q = nwg / pg::NXCD, r = nwg % pg::NXCD, xcd = wgid % pg::NXCD, off = wgid / pg::NXCD; wgid = (xcd < r ? xcd * (q + 1) : r * (q + 1) + (xcd - r) * q) + off; }
        const int mg = wgid / nN, pn = wgid - mg * nN;
        const int ln = tidf() & 63, tv = tab[ln < NE ? ln : NE];
        const int e = __builtin_amdgcn_readfirstlane(__popcll(__ballot(ln >= 1 && ln < NE && tv <= mg)));
        const int mt = mg - __builtin_amdgcn_readlane(tv, e);
        u.g = e; u.pm = mg; u.pn = pn; u.aux = mg * 256;
        u.B = B + (size_t)e * eB + (size_t)pn * 256 * 1024;
        if (gather) { u.A = A; u.rows = elist + (size_t)e * T + mt * 256; const int rem = __builtin_amdgcn_readfirstlane(tab[40 + e]) - mt * 256; u.nvalid = rem < 256 ? rem : 256; }
        else { u.A = A + (size_t)mg * 256 * 1024; u.rows = nullptr; u.nvalid = 0; }
        return true;
    }
};
struct EpiSwiglu {
    static constexpr bool PERM = true, AFTER_DRAIN = false, BIAS = true;
    unsigned char* ACT; const float* B1P;
    __device__ __forceinline__ const float* bias_base(const pg::Unit& u) const { return B1P + u.g * 2048 + u.pn * 256; }
    __device__ __forceinline__ void operator()(const pg::f32x4 (&acc)[2][2][4][2], const pg::Unit& u, int wr, int wc, int fr, int fq) const {
        const int col0 = wc * 32 + 8 * fq;
        unsigned char* base = ACT + (size_t)(u.aux + wr * 64 + fr) * 1024 + u.pn * 128 + col0;
#pragma unroll
        for (int ai = 0; ai < 2; ++ai)
#pragma unroll
            for (int m = 0; m < 4; ++m) { float r[8];
#pragma unroll
                for (int jp = 0; jp < 4; ++jp) { const int h = jp >> 1, j = (jp & 1) * 2;
                    typedef float f2 __attribute__((ext_vector_type(2)));
                    f2 g, l;
                    g.x = __builtin_amdgcn_fmed3f(acc[ai][0][m][h][j], -3.0e38f, 7.f); g.y = __builtin_amdgcn_fmed3f(acc[ai][0][m][h][j + 1], -3.0e38f, 7.f);
                    l.x = __builtin_amdgcn_fmed3f(acc[ai][1][m][h][j], -7.f, 7.f); l.y = __builtin_amdgcn_fmed3f(acc[ai][1][m][h][j + 1], -7.f, 7.f);
                    const f2 t = g * (f2){-2.45546696f, -2.45546696f};
                    f2 d; d.x = __builtin_amdgcn_exp2f(t.x); d.y = __builtin_amdgcn_exp2f(t.y);
                    d = d + (f2){1.f, 1.f};
                    f2 rc; rc.x = __builtin_amdgcn_rcpf(d.x); rc.y = __builtin_amdgcn_rcpf(d.y);
                    const f2 gl = __builtin_elementwise_fma(g, l, g);
                    const f2 o = gl * rc;
                    r[2 * jp] = o.x; r[2 * jp + 1] = o.y; }
                { int w0 = __builtin_amdgcn_cvt_pk_fp8_f32(r[0], r[1], 0, false); w0 = __builtin_amdgcn_cvt_pk_fp8_f32(r[2], r[3], w0, true);
                  int w1 = __builtin_amdgcn_cvt_pk_fp8_f32(r[4], r[5], 0, false); w1 = __builtin_amdgcn_cvt_pk_fp8_f32(r[6], r[7], w1, true);
                  *(pg::u32x2*)(base + (size_t)(ai * 128 + m * 16) * 1024) = (pg::u32x2){(unsigned)w0, (unsigned)w1}; }
                asm volatile("" ::: "memory"); }
    }
};
struct EpiY {
    static constexpr bool PERM = true, AFTER_DRAIN = false, BIAS = true;
    unsigned char* Y; const float* b2;
    __device__ __forceinline__ const float* bias_base(const pg::Unit& u) const { return b2 + u.g * 1024 + u.pn * 256; }
    __device__ __forceinline__ void operator()(const pg::f32x4 (&acc)[2][2][4][2], const pg::Unit& u, int wr, int wc, int fr, int fq) const {
        unsigned char* base = Y + (size_t)(u.aux + wr * 64 + fr) * 1024 + u.pn * 256 + (wc * 4 + fq) * 16;
#pragma unroll
        for (int ai = 0; ai < 2; ++ai)
#pragma unroll
            for (int m = 0; m < 4; ++m) { pg::u32x4 w;
                { const pg::f32x4 v0 = acc[ai][0][m][0] * 16.f, v1 = acc[ai][0][m][1] * 16.f;
                  int p = __builtin_amdgcn_cvt_pk_fp8_f32(v0[0], v0[1], 0, false); p = __builtin_amdgcn_cvt_pk_fp8_f32(v0[2], v0[3], p, true); w.x = (unsigned)p;
                  p = __builtin_amdgcn_cvt_pk_fp8_f32(v1[0], v1[1], 0, false); p = __builtin_amdgcn_cvt_pk_fp8_f32(v1[2], v1[3], p, true); w.y = (unsigned)p; }
                { const pg::f32x4 v0 = acc[ai][1][m][0] * 16.f, v1 = acc[ai][1][m][1] * 16.f;
                  int p = __builtin_amdgcn_cvt_pk_fp8_f32(v0[0], v0[1], 0, false); p = __builtin_amdgcn_cvt_pk_fp8_f32(v0[2], v0[3], p, true); w.z = (unsigned)p;
                  p = __builtin_amdgcn_cvt_pk_fp8_f32(v1[0], v1[1], 0, false); p = __builtin_amdgcn_cvt_pk_fp8_f32(v1[2], v1[3], p, true); w.w = (unsigned)p; }
                *(pg::u32x4*)(base + (size_t)(ai * 128 + m * 16) * 1024) = w; asm volatile("" ::: "memory"); }
    }
};
struct EpiNull { static constexpr bool PERM = true, AFTER_DRAIN = false, BIAS = false;
    float* sink; __device__ __forceinline__ const float* bias_base(const pg::Unit& u) const { return sink; }
    __device__ __forceinline__ void operator()(const pg::f32x4 (&acc)[2][2][4][2], const pg::Unit& u, int wr, int wc, int fr, int fq) const {
        float s_ = 0.f;
#pragma unroll
        for (int ai = 0; ai < 2; ++ai)
#pragma unroll
            for (int bj = 0; bj < 2; ++bj)
#pragma unroll
                for (int m = 0; m < 4; ++m)
#pragma unroll
                    for (int n = 0; n < 2; ++n) s_ += acc[ai][bj][m][n][0];
        if (s_ == 1.2345e30f) sink[0] = s_; } };
__device__ __forceinline__ void ph_moe1_probe(LAS unsigned char* lds, const OptBufs4& o4, const OptBufs5& o5, const int* cnt, int mode, unsigned char* dummy) {
    moe_build_tab(lds, cnt);
    SchedMoE S; S.tab = (const LAS int*)(lds + MOE_TAB_OFF); S.cnt = cnt; S.elist = o4.elist; S.A = (const char*)o4.H1Q; S.B = (const char*)o5.We1T; S.eB = (size_t)2048 * 1024;
    S.nN = 8; S.nwg = __builtin_amdgcn_readfirstlane(S.tab[NE]) * 8; S.G = gridDim.x; S.c = blockIdx.x; S.gather = 1;
    if (mode == 0) { EpiSwiglu E{dummy, o5.B1P}; pg::gemm_phase<EpiSwiglu, SchedMoE, true, true>(lds, 512, 512, 512, S, E); }
    if (mode == 1) { S.gather = 0; S.A = (const char*)o5.ACT; EpiSwiglu E{dummy, o5.B1P}; pg::gemm_phase<EpiSwiglu, SchedMoE, false, true>(lds, 512, 512, 512, S, E); }
    if (mode == 2) { EpiNull E{(float*)dummy}; pg::gemm_phase<EpiNull, SchedMoE, true, true>(lds, 512, 512, 512, S, E); }
    if (mode == 3) { S.gather = 0; S.A = (const char*)o5.ACT; EpiNull E{(float*)dummy}; pg::gemm_phase<EpiNull, SchedMoE, false, true>(lds, 512, 512, 512, S, E); }
}
__device__ __forceinline__ void ph_moe1(LAS unsigned char* lds, const OptBufs4& o4, const OptBufs5& o5, const int* cnt) {
    moe_build_tab(lds, cnt);
    SchedMoE S; S.tab = (const LAS int*)(lds + MOE_TAB_OFF); S.cnt = cnt; S.elist = o4.elist; S.A = (const char*)o4.H1Q; S.B = (const char*)o5.We1T; S.eB = (size_t)2048 * 1024;
    S.nN = 8; S.nwg = __builtin_amdgcn_readfirstlane(S.tab[NE]) * 8; S.G = gridDim.x; S.c = blockIdx.x; S.gather = 1;
    EpiSwiglu E{(unsigned char*)o5.ACT, o5.B1P}; pg::gemm_phase<EpiSwiglu, SchedMoE, true, true>(lds, 512, 512, 512, S, E);
}
__device__ __forceinline__ void ph_moe2(LAS unsigned char* lds, const OptBufs5& o5, const int* cnt, const float* b_e2) {
    moe_build_tab(lds, cnt);
    SchedMoE S; S.tab = (const LAS int*)(lds + MOE_TAB_OFF); S.cnt = cnt; S.elist = nullptr; S.A = (const char*)o5.ACT; S.B = (const char*)o5.We2T; S.eB = (size_t)1024 * 1024;
    S.nN = 4; S.nwg = __builtin_amdgcn_readfirstlane(S.tab[NE]) * 4; S.G = gridDim.x; S.c = blockIdx.x; S.gather = 0;
    EpiY E{(unsigned char*)o5.Y, b_e2}; pg::gemm_phase<EpiY, SchedMoE, false, true>(lds, 512, 512, 512, S, E);
}
__device__ __forceinline__ void ph_final_opt(LAS unsigned char* lds, const OptBufs4& o4, const OptBufs5& o5, const int* cnt, const float* g, const float* beta, float* out) {
    moe_build_tab(lds, cnt);
    const LAS int* tab = (const LAS int*)(lds + MOE_TAB_OFF);
    const int tid = tidf(), lane = tid & 63, gw = blockIdx.x * NW + (tid >> 6), ngw = gridDim.x * NW;
    const int cbase = (lane >> 4) * 256 + ((lane >> 2) & 3) * 32 + (lane & 3) * 8;
    const unsigned char* Y8 = (const unsigned char*)o5.Y;
    int erA[4], erB[4]; float gA[4], gB[4]; pg::u32x4 yA[4], hA[2];
    auto ld_route = [&](int t, int (&er)[4], float (&gg)[4]) { if (t < T) {
#pragma unroll
        for (int k = 0; k < 4; ++k) { er[k] = o4.erank[(size_t)t * 4 + k]; gg[k] = o4.gate[(size_t)t * 4 + k]; } } };
    auto ld_rows = [&](int t, const int (&er)[4], pg::u32x4 (&yy)[4], pg::u32x4 (&hh)[2]) { if (t < T) {
#pragma unroll
        for (int k = 0; k < 4; ++k) yy[k] = __builtin_nontemporal_load((const pg::u32x4*)(Y8 + (size_t)(tab[er[k] >> 16] * 256 + (er[k] & 0xffff)) * 1024 + lane * 16));
        hh[0] = __builtin_nontemporal_load((const pg::u32x4*)(o4.H1B + (size_t)t * D + cbase)); hh[1] = __builtin_nontemporal_load((const pg::u32x4*)(o4.H1B + (size_t)t * D + cbase + 128)); } };
    ld_route(gw, erA, gA); ld_rows(gw, erA, yA, hA); ld_route(gw + ngw, erB, gB);
    for (int t = gw; t < T; t += ngw) {
        pg::u32x4 yN[4], hN[2]; int erN[4]; float gN[4];
        ld_rows(t + ngw, erB, yN, hN); ld_route(t + 2 * ngw, erN, gN);
        float v[16];
#pragma unroll
        for (int r = 0; r < 2; ++r) { const pg::u32x4 w = hA[r];
            v[8 * r + 0] = __builtin_bit_cast(float, w.x << 16) * ALPHA; v[8 * r + 1] = __builtin_bit_cast(float, w.x & 0xffff0000u) * ALPHA; v[8 * r + 2] = __builtin_bit_cast(float, w.y << 16) * ALPHA; v[8 * r + 3] = __builtin_bit_cast(float, w.y & 0xffff0000u) * ALPHA;
            v[8 * r + 4] = __builtin_bit_cast(float, w.z << 16) * ALPHA; v[8 * r + 5] = __builtin_bit_cast(float, w.z & 0xffff0000u) * ALPHA; v[8 * r + 6] = __builtin_bit_cast(float, w.w << 16) * ALPHA; v[8 * r + 7] = __builtin_bit_cast(float, w.w & 0xffff0000u) * ALPHA; }
#pragma unroll
        for (int k = 0; k < 4; ++k) { const float gk = gA[k] * 0.0625f; const pg::u32x4 w = yA[k];
            float f[4];
            fp8x4_to_f32(w.x, f); v[0] += gk * f[0]; v[1] += gk * f[1]; v[2] += gk * f[2]; v[3] += gk * f[3];
            fp8x4_to_f32(w.y, f); v[4] += gk * f[0]; v[5] += gk * f[1]; v[6] += gk * f[2]; v[7] += gk * f[3];
            fp8x4_to_f32(w.z, f); v[8] += gk * f[0]; v[9] += gk * f[1]; v[10] += gk * f[2]; v[11] += gk * f[3];
            fp8x4_to_f32(w.w, f); v[12] += gk * f[0]; v[13] += gk * f[1]; v[14] += gk * f[2]; v[15] += gk * f[3]; }
#pragma unroll
        for (int k = 0; k < 4; ++k) { yA[k] = yN[k]; erB[k] = erN[k]; gA[k] = gB[k]; gB[k] = gN[k]; }
        hA[0] = hN[0]; hA[1] = hN[1];
        float s_ = 0.f;
#pragma unroll
        for (int j = 0; j < 16; ++j) s_ += v[j];
        const float mean = wsum(s_) * (1.f / D); float s2 = 0.f;
#pragma unroll
        for (int j = 0; j < 16; ++j) { v[j] -= mean; s2 += v[j] * v[j]; }
        const float rstd = rsqrtf(wsum(s2) * (1.f / D) + LN_EPS);
#pragma unroll
        for (int run = 0; run < 2; ++run)
#pragma unroll
            for (int q = 0; q < 2; ++q) { const int c0 = cbase + run * 128 + q * 4;
                const pg::f32x4 gg = *(const pg::f32x4*)(g + c0), bb = *(const pg::f32x4*)(beta + c0);
                pg::f32x4 y; y.x = v[run * 8 + q * 4 + 0] * rstd; y.y = v[run * 8 + q * 4 + 1] * rstd; y.z = v[run * 8 + q * 4 + 2] * rstd; y.w = v[run * 8 + q * 4 + 3] * rstd;
                *(pg::f32x4*)(out + (size_t)t * D + c0) = y * gg + bb; }
    }
}


struct PrepSrc { const float *w_in, *w_q, *w_k, *w_pool, *w_bp, *w_bm, *w_out, *w_e1, *w_e2, *b_e1; };
constexpr int TI_E1 = 16384, TI_E2 = 8192, TI_IN = (WIN_ROWS / 64) * 16, TI_MO = 512, TI_QK = 128, TI_BP = 128, TI_PL = 16;
constexpr int TI_TOTAL = TI_E1 + TI_E2 + TI_IN + TI_MO + TI_QK + TI_BP + TI_PL;
__device__ __forceinline__ TItem titem_decode(int it, const PrepSrc& p, const OptBufs& ob, const OptBufs2& o2, const OptBufs4& o4, const OptBufs5& o5) {
    TItem t; t.inter = 0; t.fp8 = 0; t.valid = it < TI_TOTAL; t.src = p.w_in; t.dst = ob.WinT; t.ldw = 64; t.ldt = 64;
    if (!t.valid) return t;
    if (it < TI_E1) { const int nb = it & 31, kb = (it >> 5) & 15, e = it >> 9, j0 = nb * 32, pn = j0 >> 7, jj0 = j0 & 127;
        t.src = p.w_e1 + (size_t)e * 1024 * 2048 + (size_t)(kb * 64) * 2048 + nb * 64; t.dst = (pg::bf16_t*)((unsigned char*)o5.We1T + (size_t)e * 2048 * 1024 + (size_t)(pn * 256 + jj0) * 1024 + kb * 64); t.ldw = 2048; t.ldt = 1024; t.inter = 1; t.fp8 = 1; return t; }
    it -= TI_E1;
    if (it < TI_E2) { const int nb = it & 15, kb = (it >> 4) & 15, e = it >> 8;
        t.src = p.w_e2 + (size_t)e * 1024 * 1024 + (size_t)(kb * 64) * 1024 + nb * 64; t.dst = (pg::bf16_t*)((unsigned char*)o5.We2T + (size_t)e * 1024 * 1024 + (size_t)(nb * 64) * 1024 + kb * 64); t.ldw = 1024; t.ldt = 1024; t.fp8 = 1; return t; }
    it -= TI_E2;
    if (it < TI_IN) { const int rb = it >> 4, kb = it & 15;
        t.src = p.w_in + (size_t)(kb * 64) * INC + win_src_col(rb * 64); t.ldw = INC; t.ldt = D;
        if (rb * 64 >= PJ_O && rb * 64 < PROJW) { t.dst = (pg::bf16_t*)(ob.WinQ + (size_t)(rb * 64 - PJ_O) * D + kb * 64); t.fp8 = 1; }
        else t.dst = ob.WinT + (size_t)(rb * 64) * D + kb * 64;
        return t; }
    it -= TI_IN;
    if (it < TI_MO) { const int which = it >> 8, r = it & 255, nb = r >> 4, kb = r & 15;
        t.src = (which ? p.w_out : p.w_bm) + (size_t)(kb * 64) * 1024 + nb * 64; t.dst = (which ? o4.WoutT : o4.WbmT) + (size_t)(nb * 64) * 1024 + kb * 64; t.ldw = 1024; t.ldt = 1024; return t; }
    it -= TI_MO;
    if (it < TI_QK) { const int which = it >> 6, r = it & 63, h = r >> 4, nb = (r & 15) >> 2, kb = r & 3;
        t.src = (which ? p.w_k : p.w_q) + (size_t)h * 65536 + (size_t)(kb * 64) * 256 + nb * 64; t.dst = (which ? o2.WkT : o2.WqT) + (size_t)h * 65536 + (size_t)(nb * 64) * 256 + kb * 64; t.ldw = 256; t.ldt = 256; return t; }
    it -= TI_QK;
    if (it < TI_BP) { const int nb = it >> 3, kb = it & 7;
        t.src = p.w_bp + (size_t)(kb * 64) * 1024 + nb * 64; t.dst = o2.WbpT + (size_t)(nb * 64) * 512 + kb * 64; t.ldw = 1024; t.ldt = 512; return t; }
    it -= TI_BP;
    { const int g = it >> 2, nb = (it & 3) >> 1, kb = it & 1;
        t.src = p.w_pool + (size_t)g * 16384 + (size_t)(kb * 64) * 128 + nb * 64; t.dst = o2.WpoolT + (size_t)(g * 128 + nb * 64) * 512 + g * 128 + kb * 64; t.ldw = 128; t.ldt = 512; return t; }
}
constexpr int DEF_A_LO = 0, DEF_A_HI = 3072, DEF_B_LO = 3072, DEF_B_HI = 5632, DEF_C_LO = TI_E1, DEF_C_HI = TI_E1 + 1536;
constexpr int P0_N1 = TI_E1 - DEF_B_HI, P0_N2 = TI_E1 + TI_E2 - DEF_C_HI, P0_N3 = TI_TOTAL - TI_E1 - TI_E2, P0_N = P0_N1 + P0_N2 + P0_N3;
constexpr int Q_SMALL = TI_MO + TI_QK + TI_BP + TI_PL;
__device__ __forceinline__ int p0_item(int j) { return j < Q_SMALL ? TI_E1 + TI_E2 + TI_IN + j : j - Q_SMALL; }
template <bool P0MAP>
__device__ __forceinline__ void prep_range(LAS unsigned char* lds, const PrepSrc& p, const OptBufs& ob, const OptBufs2& o2, const OptBufs4& o4, const OptBufs5& o5, int lo, int hi, int vw, int nvw) {
    const int tid = tidf(), lane = tid & 63, wave = tid >> 6;
    LAS float* scr = (LAS float*)(lds + wave * 16384);
    int j = lo + vw; if (j >= hi) return;
    TItem cur = titem_decode(P0MAP ? p0_item(j) : j, p, ob, o2, o4, o5);
    pg::f32x4 r[16];
    titem_load(cur, r, lane);
    for (;;) {
        const int nj = j + nvw; const bool more = nj < hi; TItem nxt = cur;
        pg::f32x4 rn[16];
        if (more) { nxt = titem_decode(P0MAP ? p0_item(nj) : nj, p, ob, o2, o4, o5); titem_load(nxt, rn, lane); }
        titem_store(cur, r, scr, lane);
        if (!more) break;
#pragma unroll
        for (int i = 0; i < 16; ++i) r[i] = rn[i];
        cur = nxt; j = nj;
    }
}
__device__ __forceinline__ void ph_prep_all(LAS unsigned char* lds, const PrepSrc& p, const OptBufs& ob, const OptBufs2& o2, const OptBufs4& o4, const OptBufs5& o5) {
    const int tid = tidf(), wave = tid >> 6;
    prep_range<false>(lds, p, ob, o2, o4, o5, TI_E1 + TI_E2, TI_E1 + TI_E2 + TI_IN, blockIdx.x * NW + wave, gridDim.x * NW);
}
__device__ __forceinline__ void ph_prep_side(const PrepSrc& p, const OptBufs2& o2, const OptBufs5& o5, int wgi, int nwg) {
    const int tid = tidf();
    { const size_t gt = (size_t)wgi * NT + tid, ngt = (size_t)nwg * NT;
      for (size_t ch = gt; ch < 512 * 64; ch += ngt) { const int n = (int)(ch >> 6), k8 = (int)(ch & 63) * 8; if ((n >> 7) != (k8 >> 7)) *(pg::u32x4*)(o2.WpoolT + (size_t)n * 512 + k8) = (pg::u32x4){0u, 0u, 0u, 0u}; } }
    for (int i = wgi * NT + tid; i < 32 * 2048; i += nwg * NT) { const int e = i >> 11, rr = i & 2047, pn = rr >> 8, bj = (rr >> 7) & 1, jj = rr & 127; o5.B1P[i] = p.b_e1[e * 2048 + 2 * (pn * 128 + jj) + bj]; }
}
constexpr int Q_I1 = 21504, Q_I3 = 1536, Q_I10 = TI_E1 + TI_E2 - Q_I1 - Q_I3;
constexpr int Q_CH1 = 1, Q_CH3 = 1, Q_CH10 = 1;
constexpr int P1_WORKERS = 160;
static_assert((Q_I1 + Q_SMALL) % (8 * Q_CH1) == 0 && Q_I1 + Q_I3 >= TI_E1 && Q_I10 >= 0 && Q_I1 % (8 * Q_CH1) == 0 && Q_I3 % (8 * Q_CH3) == 0 && Q_I10 % (8 * Q_CH10) == 0 && P1_WORKERS % 8 == 0, "queue split");
template <bool REMAP>
__device__ __forceinline__ void convert_queue(LAS unsigned char* lds, const PrepSrc& p, const OptBufs& ob, const OptBufs2& o2, const OptBufs4& o4, const OptBufs5& o5, unsigned* head, int base, int nitems, int ch) {
    volatile LAS int* slot = (volatile LAS int*)(lds + 131072 + 512);
    const int tid = tidf(), wave = tid >> 6, n = nitems / (8 * ch);
    __syncthreads();
    if (tid == 0) slot[0] = (int)__hip_atomic_fetch_add(head, 1u, __ATOMIC_RELAXED, __HIP_MEMORY_SCOPE_AGENT);
    __syncthreads();
    int cur = slot[0], par = 0;
    while (cur < n) {
        int nx = 0;
        if (tid == 0) nx = (int)__hip_atomic_fetch_add(head, 1u, __ATOMIC_RELAXED, __HIP_MEMORY_SCOPE_AGENT);
        const int lo = base + cur * 8 * ch;
        prep_range<REMAP>(lds, p, ob, o2, o4, o5, lo, lo + 8 * ch, wave, 8);
        par ^= 1;
        if (tid == 0) slot[par] = nx;
        __syncthreads();
        cur = slot[par];
    }
    __syncthreads();
}
__device__ __forceinline__ void prep_deferred(LAS unsigned char* lds, const PrepSrc& p, const OptBufs& ob, const OptBufs2& o2, const OptBufs4& o4, const OptBufs5& o5, int lo, int hi) {
    const int half = gridDim.x / 2;
    if ((int)blockIdx.x >= half) { __syncthreads(); prep_range<false>(lds, p, ob, o2, o4, o5, lo, hi, ((int)blockIdx.x - half) * NW + (tidf() >> 6), (gridDim.x - half) * NW); __syncthreads(); }
}

struct Args { const float* in[26]; float* out; unsigned char* ws; int ph_lo, ph_hi; };
constexpr size_t MiB = 1u << 20;
constexpr size_t WS_CTL = 0;
constexpr size_t CTL_ZERO_BYTES = 1 * MiB;
constexpr int CW_BAR = 4096;
constexpr int CW_CNT = 16384, CW_START = 16384 + 64, CW_FILL = 16384 + 128;
constexpr int CW_Q1 = 20480, CW_Q3 = 20480 + 32, CW_Q10 = 20480 + 64;

__global__ void __launch_bounds__(NT, 2) mk_fwd(Args a) {
    extern __shared__ __attribute__((aligned(16))) unsigned char lds_raw[];
    LAS unsigned char* lds = (LAS unsigned char*)lds_raw;
    volatile LAS unsigned* MISC = (volatile LAS unsigned*)(lds + MISC_OFF);
    const int tid = tidf();
    if (tid < 32) MISC[tid] = 0u;
    __syncthreads();
    unsigned char* ws = a.ws;
    unsigned* ctl = (unsigned*)(ws + WS_CTL);
    XcdBarrier bar = xcd_barrier_post(ctl + CW_BAR, MISC + 8);
    const float* x = a.in[0]; const float* ln0_g = a.in[1]; const float* ln0_b = a.in[2];
    const float* w_in = a.in[3]; const float* conv_w = a.in[4]; const float* conv_b = a.in[5];
    const float* w_q = a.in[6]; const float* w_k = a.in[7]; const float* b_if = a.in[8];
    const float* mh_gain = a.in[9]; const float* w_pool = a.in[10]; const float* b_pool = a.in[11];
    const float* ls_pool = a.in[12]; const float* w_bp = a.in[13]; const float* w_bm = a.in[14];
    const float* w_out = a.in[15]; const float* ln1_g = a.in[16]; const float* ln1_b = a.in[17];
    const float* w_router = a.in[18]; const float* b_router = a.in[19]; const float* w_e1 = a.in[20];
    const float* b_e1 = a.in[21]; const float* w_e2 = a.in[22]; const float* b_e2 = a.in[23];
    const float* ln2_g = a.in[24]; const float* ln2_b = a.in[25];
    OptBufs ob; ob.WinT = (pg::bf16_t*)(ws + 8 * MiB); ob.H0B = (pg::bf16_t*)(ws + 220 * MiB); ob.PROJ = (pg::bf16_t*)(ws + 252 * MiB); ob.BT2 = (pg::bf16_t*)(ws + 396 * MiB);
    ob.gif = (float*)(ws + 1 * MiB); ob.stats = (float*)(ws + 1 * MiB + 512 * 1024); ob.WinQ = (unsigned char*)(ws + 214 * MiB); ob.H0Q = (unsigned char*)(ws + 972 * MiB); ob.OGQ = (unsigned char*)(ws + 300 * MiB);
    OptBufs2 o2; o2.WqT = (pg::bf16_t*)(ws + 19 * MiB); o2.WkT = (pg::bf16_t*)(ws + 19 * MiB + 512 * 1024); o2.WpoolT = (pg::bf16_t*)(ws + 20 * MiB); o2.WbpT = (pg::bf16_t*)(ws + 20 * MiB + 512 * 1024);
    o2.POOLED = (pg::bf16_t*)(ws + 460 * MiB); o2.UC = (pg::bf16_t*)(ws + 476 * MiB); o2.MIXED = (pg::bf16_t*)(ws + 508 * MiB); o2.Q = (pg::bf16_t*)(ws + 524 * MiB); o2.K = (pg::bf16_t*)(ws + 556 * MiB);
    o2.YPOOL = (pg::bf16_t*)(ws + 748 * MiB);
    OptBufs3 o3; o3.KaT = (pg::bf16_t*)(ws + 588 * MiB); o3.A2 = (pg::bf16_t*)(ws + 620 * MiB); o3.U = (float*)(ws + 684 * MiB); o3.HOUT = (pg::bf16_t*)(ws + 780 * MiB);
    { float* sm = (float*)(ws + 2 * MiB); o3.rowv = sm; o3.colv = sm + 65536; o3.winter = sm + 2 * 65536; o3.aw = sm + 3 * 65536; o3.emt = sm + 4 * 65536; o3.den = sm + 5 * 65536; o3.un = sm + 6 * 65536; o3.decay = sm + 7 * 65536; o3.den2 = (float*)(ws + 1 * MiB + 640 * 1024); }
    OptBufs4 o4; o4.WbmT = (pg::bf16_t*)(ws + 21 * MiB + 512 * 1024); o4.WoutT = (pg::bf16_t*)(ws + 23 * MiB + 512 * 1024); o4.MERGED = (pg::bf16_t*)(ws + 812 * MiB); o4.Z = (float*)(ws + 844 * MiB); o4.H1B = (pg::bf16_t*)(ws + 908 * MiB); o4.H1Q = (unsigned char*)(ws + 940 * MiB); o4.WRP = (float*)(ws + 7 * MiB + 512 * 1024); o4.CGB = (float*)(ws + 7 * MiB + 768 * 1024);
    o4.elist = (int*)(ws + 4 * MiB); o4.erank = (int*)(ws + 6 * MiB); o4.gate = (float*)(ws + 6 * MiB + 256 * 1024);
    OptBufs5 o5; o5.We1T = (pg::bf16_t*)(ws + 26 * MiB); o5.We2T = (pg::bf16_t*)(ws + 154 * MiB); o5.B1P = (float*)(ws + 7 * MiB);
    o5.ACT = (pg::bf16_t*)(ws + 252 * MiB);
    o5.Y = (pg::bf16_t*)(ws + 396 * MiB);
    int* cnt = (int*)ctl + CW_CNT;
    LAS float* ldsf = (LAS float*)lds;
    const int G = gridDim.x, bx = blockIdx.x;
#define IN(k) (a.ph_lo <= (k) && (k) < a.ph_hi)
#if PROBE_PH >= 100
    unsigned long long tp0 = 0, tp1 = 0;
#define TSTAMP(k) do { if (PROBE_PH - 100 == (k)) tp0 = __builtin_amdgcn_s_memrealtime(); if (PROBE_PH - 100 + 1 == (k)) tp1 = __builtin_amdgcn_s_memrealtime(); } while (0)
#else
#define TSTAMP(k) do { } while (0)
#endif
#define SEAM(k) do { if (IN(k) && IN((k) + 1)) xcd_barrier(bar); TSTAMP((k) + 1); } while (0)
    TSTAMP(0);
    const PrepSrc ps{w_in, w_q, w_k, w_pool, w_bp, w_bm, w_out, w_e1, w_e2, b_e1};
    if (IN(0)) {
        const int wv = tid >> 6, vw0 = bx * NW + wv, nvw0 = G * NW; TItem wi; pg::f32x4 wreg[16]; wi.valid = vw0 < TI_IN;
        if (wi.valid) { wi = titem_decode(TI_E1 + TI_E2 + vw0, ps, ob, o2, o4, o5); wi.valid = 1; titem_load(wi, wreg, tid & 63); }
        ph_ln0(lds, ob, x, ln0_g, ln0_b, w_in, b_if);
        if (wi.valid) titem_store(wi, wreg, (LAS float*)(lds + wv * 16384), tid & 63);
        if (nvw0 < TI_IN) prep_range<false>(lds, ps, ob, o2, o4, o5, TI_E1 + TI_E2 + nvw0, TI_E1 + TI_E2 + TI_IN, vw0, nvw0);
#if PROBE_PH == 0
        { xcd_barrier(bar); if (PROBE_MODE & 1) ph_prep_all(lds, ps, ob, o2, o4, o5); if (PROBE_MODE & 2) ph_ln0(lds, ob, x, ln0_g, ln0_b, w_in, b_if); }
#endif
    }
    SEAM(0);
    if (IN(1)) { ph_inproj(lds, ob, P1_WORKERS);
                 if (bx >= P1_WORKERS) { ph_prep_side(ps, o2, o5, bx - P1_WORKERS, G - P1_WORKERS); ph_router_prep(o4, ln1_g, ln1_b, w_router, b_router, bx - P1_WORKERS, G - P1_WORKERS); }
                 convert_queue<true>(lds, ps, ob, o2, o4, o5, ctl + CW_Q1, 0, Q_I1 + Q_SMALL, Q_CH1); }
    SEAM(1);
    if (IN(2)) { if (bx >= 192 && bx < 192 + (256 - VT_P1)) ph_inproj_vt(lds, ob, VT_P1 + (bx - 192));
                 if (bx >= G - 16) scalar_scan_wg(lds, bx - (G - 16), ob.gif, o3);
                 ph_poolconv_opt(ob.PROJ, conv_w, conv_b, o2.POOLED, o2.UC); }
    SEAM(2);
    if (IN(3)) { ph_gemms_P3(lds, o2, o3, b_pool, ls_pool); convert_queue<false>(lds, ps, ob, o2, o4, o5, ctl + CW_Q3, Q_I1, Q_I3, Q_CH3); }
    SEAM(3);
    if (IN(4)) { ph_gemms_P4(lds, ob, o2, o3);
#if PROBE_PH == 4
        { xcd_barrier(bar); OptBufs3 d3 = o3; d3.den = (float*)(ws + 980 * MiB); ph_gemm_ypool(lds, o2); ph_gemms_E(lds, ob, o2, d3); }
#endif
    }
    SEAM(4);
    if (IN(5)) { ph_state_scan(ob, o3); ph_den_inter(lds, o3);
#if PROBE_PH == 5
        { xcd_barrier(bar); OptBufs3 d3 = o3; d3.den = (float*)(ws + 980 * MiB); ph_state_scan(ob, d3); ph_den_inter(lds, d3); }
#endif
    }
    SEAM(5);
    if (IN(6)) ph_gemm_G3(lds, ob, o3, mh_gain);
    SEAM(6);
#if PROBE_PH == 107 && PROBE_MODE == 3
    { OptBufs3 d3 = o3; d3.HOUT = ob.H0B; OptBufs4 d4 = o4; d4.WbmT = o4.WoutT; d4.MERGED = o3.KaT; ph_gemm_ymls(lds, ob, o2, d3, d4); xcd_barrier(bar); tp0 = __builtin_amdgcn_s_memrealtime(); }
#endif
    if (IN(7)) ph_gemm_ymls(lds, ob, o2, o3, o4);
    SEAM(7);
    if (IN(8)) ph_gemm_mix(lds, ob, o4, x, ln0_g, ln0_b);
    SEAM(8);
    if (IN(9)) { ph_ln1_router(lds, o4, o4.Z, ln1_g, ln1_b, cnt);
#if PROBE_PH == 9
        { xcd_barrier(bar); OptBufs4 d4 = o4; d4.Z = (float*)(ws + 684 * MiB); d4.H1B = (pg::bf16_t*)(ws + 588 * MiB); d4.H1Q = (unsigned char*)(ws + 620 * MiB); d4.elist = (int*)(ws + 980 * MiB); d4.erank = (int*)(ws + 984 * MiB); d4.gate = (float*)(ws + 986 * MiB);
          ph_ln1_router(lds, d4, o4.Z, ln1_g, ln1_b, cnt + 256, PROBE_MODE); }
#endif
    }
    SEAM(9);
    if (IN(10)) { ph_moe1(lds, o4, o5, cnt); convert_queue<false>(lds, ps, ob, o2, o4, o5, ctl + CW_Q10, Q_I1 + Q_I3, Q_I10, Q_CH10);
#if PROBE_PH == 10
        { xcd_barrier(bar); ph_moe1_probe(lds, o4, o5, cnt, PROBE_MODE, (unsigned char*)(ws + 956 * MiB)); }
#endif
    }
    SEAM(10);
    if (IN(11)) ph_moe2(lds, o5, cnt, b_e2);
    SEAM(11);
    if (IN(12)) { ph_final_opt(lds, o4, o5, cnt, ln2_g, ln2_b, a.out);
#if PROBE_PH >= 100
        if (PROBE_PH - 100 == 12) { __syncthreads(); tp1 = __builtin_amdgcn_s_memrealtime(); }
        if (bx == 0) { const unsigned long long t0_ = __builtin_amdgcn_s_memrealtime(), dt = tp1 - tp0; while (__builtin_amdgcn_s_memrealtime() - t0_ < dt) __builtin_amdgcn_s_sleep(4); }
#endif
#if PROBE_PH == 12
        { xcd_barrier(bar); ph_final_opt(lds, o4, o5, cnt, ln2_g, ln2_b, a.out); }
#endif
    }
}
constexpr int NPH = 13;
}

extern "C" void kernel_launch(void* const* d_in, const int* in_sizes, int n_in, void* d_out, int out_size, void* d_ws, size_t ws_size, hipStream_t stream) {
    using namespace mk;
    static int grid = 0;
    if (grid == 0) {
        if (n_in != 26 || ws_size < 1000 * MiB) { fprintf(stderr, "kernel_launch: unexpected n_in %d / ws %zu\n", n_in, ws_size); grid = -1; return; }
        int dev = 0, cus = 0, per_cu = 0;
        hipGetDevice(&dev); hipDeviceGetAttribute(&cus, hipDeviceAttributeMultiprocessorCount, dev);
        if (hipFuncSetAttribute((const void*)mk_fwd, hipFuncAttributeMaxDynamicSharedMemorySize, LDS_BYTES) != hipSuccess) { fprintf(stderr, "hipFuncSetAttribute failed\n"); grid = -1; return; }
        if (hipOccupancyMaxActiveBlocksPerMultiprocessor(&per_cu, (const void*)mk_fwd, NT, LDS_BYTES) != hipSuccess || per_cu < 1) { fprintf(stderr, "occupancy query failed (%d)\n", per_cu); grid = -1; return; }
        grid = cus * 1;
        fprintf(stderr, "kernel_launch: cus %d per_cu %d grid %d\n", cus, per_cu, grid);
    }
    if (grid < 0) return;
    hipMemsetAsync((char*)d_ws + WS_CTL, 0, CTL_ZERO_BYTES, stream);
    Args a{};
    for (int i = 0; i < 26; ++i) a.in[i] = (const float*)d_in[i];
    a.out = (float*)d_out; a.ws = (unsigned char*)d_ws; a.ph_lo = 0; a.ph_hi = NPH;
    void* args[] = {&a};
    hipError_t e = hipLaunchCooperativeKernel((const void*)mk_fwd, dim3(grid), dim3(NT), args, LDS_BYTES, stream);
    if (e != hipSuccess) fprintf(stderr, "cooperative launch failed: %s (grid %d)\n", hipGetErrorString(e), grid);
}
```
